# Optimizing an MI355X kernel written in HIP

```python
import math
import jax
import jax.numpy as jnp
from jax import lax
import numpy as np

D_MODEL = 1024
BATCH = 4
SEQ = 4096
DEPTH = 2

GRID_W = 64
CTX_LEN = 256

A_HEADS = 4
A_QK_DIM = 64
A_V_DIM = 2 * A_QK_DIM
A_WIDTH = A_HEADS * A_V_DIM
A_QK_COLS = A_HEADS * 2 * A_QK_DIM
ROPE_THETA = 10000.0
Q_BLOCK = 128
B_CHUNK = 128
B_GROUPS = 4
B_WIDTH = 512
B_GROUP_DIM = B_WIDTH // B_GROUPS
C_WIDTH = 512
C_BLOCKS = 8
C_BLOCK_DIM = C_WIDTH // C_BLOCKS
C_CONV = 4
CONV_PAD = (C_CONV // 2, (C_CONV - 1) // 2)
C_POW = 8.0
N_BRANCH = 3
BRANCH_WIDTH = 512
IN_SIZES = (A_QK_COLS, A_QK_COLS, A_WIDTH, B_WIDTH, B_WIDTH, C_WIDTH, C_WIDTH, N_BRANCH * D_MODEL)
IN_COLS = sum(IN_SIZES)
IN_SPLITS = tuple(int(v) for v in np.cumsum(IN_SIZES)[:-1])
N_EXPERTS = 64
TOP_K = 8
N_GROUPS = 8
TOPK_GROUPS = 4
D_EXPERT = 256
D_SHARED = 256
ROUTED_SCALE = 2.5
MOE_BLOCK = 128
DN_ALPHA = (2 * DEPTH) ** 0.25
DN_BETA = (8 * DEPTH) ** -0.25
LN_EPS = 1e-6
RMS_EPS = 1e-5
F32 = jnp.float32

kernel_name = "hybrid_diffusion_block"


def layer_norm(x, gain=None, bias=None):
    xf = x.astype(F32)
    mu = jnp.mean(xf, -1, keepdims=True)
    var = jnp.mean(jnp.square(xf - mu), -1, keepdims=True)
    y = (xf - mu) * lax.rsqrt(var + LN_EPS)
    if gain is not None:
        y = y * gain.astype(F32) + bias.astype(F32)
    return y.astype(x.dtype)


def rms_norm(x, gain):
    xf = x.astype(F32)
    y = xf * lax.rsqrt(jnp.mean(jnp.square(xf), -1, keepdims=True) + RMS_EPS)
    return (y * gain.astype(F32)).astype(x.dtype)


def modulate(h, shift, scale):
    return h * (1.0 + scale) + shift


def axial_rope_tables(n):
    rows = n // GRID_W
    pos_row = jnp.repeat(jnp.arange(rows), GRID_W).astype(F32)
    pos_col = jnp.tile(jnp.arange(GRID_W), rows).astype(F32)
    quarter = A_QK_DIM // 4
    inv = ROPE_THETA ** (-jnp.arange(quarter, dtype=F32) / quarter)
    ang_r = pos_row[:, None] * inv
    ang_c = pos_col[:, None] * inv
    ang = jnp.concatenate([ang_r, ang_r, ang_c, ang_c], axis=-1)
    return jnp.cos(ang)[:, None, None, :], jnp.sin(ang)[:, None, None, :]


def apply_rope(t, cos, sin):
    tr = t.reshape(*t.shape[:-1], 2, 2, A_QK_DIM // 4)
    rot = jnp.stack([-tr[..., 1, :], tr[..., 0, :]], axis=-2).reshape(t.shape)
    return t * cos + rot * sin


def _qk_heads(t):
    return t.reshape(*t.shape[:-1], A_HEADS, 2, A_QK_DIM)


def _v_heads(t):
    return t.reshape(*t.shape[:-1], A_HEADS, A_V_DIM)


def diff_attn_core(q, k, v, lam):
    s = jnp.einsum("bqhcd,bkhcd->bhcqk", q, k, preferred_element_type=F32) * (A_QK_DIM ** -0.5)
    p = jax.nn.softmax(s, axis=-1)
    w = p[:, :, 0] - lam * p[:, :, 1]
    return jnp.einsum("bhqk,bkhe->bqhe", w.astype(v.dtype), v)


def diff_attn_latent(q, k, v, k_ctx, v_ctx, lam):
    b, n = q.shape[:2]
    k_all = jnp.concatenate([k_ctx, k.astype(k_ctx.dtype)], axis=1)
    v_all = jnp.concatenate([v_ctx, v], axis=1)
    qb = jnp.moveaxis(q.reshape(b, n // Q_BLOCK, Q_BLOCK, *q.shape[2:]), 1, 0)
    out = lax.map(lambda qi: diff_attn_core(qi, k_all, v_all, lam), qb)
    return jnp.moveaxis(out, 0, 1).reshape(b, n, A_HEADS, A_V_DIM)


def _diff_post(o, gain, lam_init):
    return (rms_norm(o, gain) * (1.0 - lam_init)).reshape(*o.shape[:2], A_WIDTH)


def spatial_gating(u, v, ln_g, ln_b, w_s, b_s):
    b, n, _ = v.shape
    vg = v.reshape(b, n // B_CHUNK, B_CHUNK, B_GROUPS, B_GROUP_DIM)
    vg = layer_norm(vg, ln_g.reshape(B_GROUPS, B_GROUP_DIM), ln_b.reshape(B_GROUPS, B_GROUP_DIM))
    mixed = jnp.einsum("gpq,bnqgc->bnpgc", w_s, vg) + b_s.T[:, :, None]
    return u * mixed.reshape(b, n, B_WIDTH)


def depthwise_conv(x, w, bias):
    y = lax.conv_general_dilated(
        x, w.astype(x.dtype)[:, None, :], window_strides=(1,), padding=[CONV_PAD],
        dimension_numbers=("NWC", "WIO", "NWC"), feature_group_count=x.shape[-1])
    return y + bias


def block_diag(x, w, bias):
    xb = x.reshape(*x.shape[:-1], C_BLOCKS, C_BLOCK_DIM)
    return jnp.einsum("bnhi,hij->bnhj", xb, w).reshape(x.shape) + bias


def rglru_coeffs(x, w_a, b_a, w_x, b_x, lam):
    xf = x.astype(F32)
    r = jax.nn.sigmoid(block_diag(xf, w_a, b_a).astype(F32))
    i = jax.nn.sigmoid(block_diag(xf, w_x, b_x).astype(F32))
    log_a = -C_POW * r * jax.nn.softplus(-lam.astype(F32))
    a = jnp.exp(log_a)
    return a, jnp.sqrt(-jnp.expm1(2.0 * log_a)) * (i * xf)


def _lin_combine(left, right):
    a_l, h_l = left
    a_r, h_r = right
    return a_l * a_r, a_r * h_l + h_r


def rglru_direction(x_ctx, x_lat, w_a, b_a, w_x, b_x, lam, reverse):
    if reverse:
        x_ctx, x_lat = x_ctx[:, ::-1], x_lat[:, ::-1]
    a_c, u_c = rglru_coeffs(x_ctx, w_a, b_a, w_x, b_x, lam)
    _, h_c = lax.associative_scan(_lin_combine, (a_c, u_c), axis=1)
    a_l, u_l = rglru_coeffs(x_lat, w_a, b_a, w_x, b_x, lam)
    a_cum, h_l = lax.associative_scan(_lin_combine, (a_l, u_l), axis=1)
    h_l = h_l + a_cum * h_c[:, -1:, :]
    if reverse:
        h_c, h_l = h_c[:, ::-1], h_l[:, ::-1]
    return h_c.astype(x_ctx.dtype), h_l.astype(x_lat.dtype)


def merge_branches(o_a, o_b, o_c, g, w_branch, w_out):
    o = jnp.stack([o_a, o_b, o_c], axis=-2)
    proj = jnp.einsum("bnrc,rcd->bnrd", o, w_branch)
    gates = jax.nn.sigmoid(g.reshape(*g.shape[:-1], N_BRANCH, D_MODEL).astype(F32)).astype(proj.dtype)
    return jnp.sum(gates * proj, axis=-2) @ w_out


def token_mixer(h_lat, h_ctx, cos, sin, layer_idx, need_ctx_out,
                w_in, b_in, lam_q1, lam_k1, lam_q2, lam_k2, attn_norm_g,
                sg_ln_g, sg_ln_b, sg_w, sg_b,
                conv_w, conv_b, lru_wa, lru_ba, lru_wx, lru_bx, lru_lam,
                w_branch, w_out):
    q_l, k_l, v_l, u_l, s_l, x_l, y_l, g_l = jnp.split(h_lat @ w_in + b_in, IN_SPLITS, axis=-1)
    q_c, k_c, v_c, u_c, s_c, x_c, y_c, g_c = jnp.split(h_ctx @ w_in + b_in, IN_SPLITS, axis=-1)

    lam_init = 0.8 - 0.6 * math.exp(-0.3 * layer_idx)
    lam = (jnp.exp(jnp.sum(lam_q1.astype(F32) * lam_k1.astype(F32)))
           - jnp.exp(jnp.sum(lam_q2.astype(F32) * lam_k2.astype(F32))) + lam_init)
    kc = _qk_heads(k_c)
    vc = _v_heads(v_c)
    attn_l = diff_attn_latent(apply_rope(_qk_heads(q_l), cos, sin), apply_rope(_qk_heads(k_l), cos, sin),
                              _v_heads(v_l), kc, vc, lam)
    o_a_l = _diff_post(attn_l, attn_norm_g, lam_init)

    o_b_l = spatial_gating(jax.nn.gelu(u_l), jax.nn.gelu(s_l), sg_ln_g, sg_ln_b, sg_w, sg_b)

    xs_l = depthwise_conv(x_l, conv_w, conv_b)
    xs_c = depthwise_conv(x_c, conv_w, conv_b)
    hc_f, hl_f = rglru_direction(xs_c, xs_l, lru_wa[0], lru_ba[0], lru_wx[0], lru_bx[0], lru_lam[0], False)
    hc_b, hl_b = rglru_direction(xs_c, xs_l, lru_wa[1], lru_ba[1], lru_wx[1], lru_bx[1], lru_lam[1], True)
    o_c_l = jax.nn.gelu(y_l) * (hl_f + hl_b)

    mix_lat = merge_branches(o_a_l, o_b_l, o_c_l, g_l, w_branch, w_out)
    if not need_ctx_out:
        return mix_lat, None
    o_a_c = _diff_post(diff_attn_core(_qk_heads(q_c), kc, vc, lam), attn_norm_g, lam_init)
    o_b_c = spatial_gating(jax.nn.gelu(u_c), jax.nn.gelu(s_c), sg_ln_g, sg_ln_b, sg_w, sg_b)
    o_c_c = jax.nn.gelu(y_c) * (hc_f + hc_b)
    mix_ctx = merge_branches(o_a_c, o_b_c, o_c_c, g_c, w_branch, w_out)
    return mix_lat, mix_ctx


def moe_ffn(h, w_router, router_bias, w_gate, w_up, w_down, sh_gate, sh_up, sh_down):
    n_tok = h.shape[0]
    per_group = N_EXPERTS // N_GROUPS
    scores = jax.nn.sigmoid(jnp.matmul(h, w_router, preferred_element_type=F32))
    biased = scores + router_bias.astype(F32)
    group_score = jnp.sum(lax.top_k(biased.reshape(n_tok, N_GROUPS, per_group), 2)[0], axis=-1)
    _, top_groups = lax.top_k(group_score, TOPK_GROUPS)
    tok_rows = jnp.arange(n_tok)[:, None]
    group_ok = jnp.zeros((n_tok, N_GROUPS), bool).at[tok_rows, top_groups].set(True)
    expert_ok = jnp.repeat(group_ok, per_group, axis=1)
    _, top_e = lax.top_k(jnp.where(expert_ok, biased, -jnp.inf), TOP_K)
    s_sel = jnp.take_along_axis(scores, top_e, axis=1)
    weights = s_sel / jnp.sum(s_sel, -1, keepdims=True) * ROUTED_SCALE

    n_assign = n_tok * TOP_K
    flat_e = top_e.reshape(n_assign)
    flat_tok = jnp.repeat(jnp.arange(n_tok, dtype=jnp.int32), TOP_K)
    flat_w = weights.reshape(n_assign)
    order = jnp.argsort(flat_e)
    e_sorted = flat_e[order]
    counts = jnp.bincount(flat_e, length=N_EXPERTS)
    padded = (counts + MOE_BLOCK - 1) // MOE_BLOCK * MOE_BLOCK
    pad_end = jnp.cumsum(padded)
    pad_start = pad_end - padded
    start = jnp.cumsum(counts) - counts
    dest = pad_start[e_sorted] + (jnp.arange(n_assign) - start[e_sorted])
    n_slots = n_assign + N_EXPERTS * MOE_BLOCK
    n_blocks = n_slots // MOE_BLOCK
    slot_tok = jnp.zeros((n_slots,), jnp.int32).at[dest].set(flat_tok[order])
    slot_w = jnp.zeros((n_slots,), h.dtype).at[dest].set(flat_w[order].astype(h.dtype))
    block_e = jnp.minimum(jnp.searchsorted(pad_end, jnp.arange(n_blocks) * MOE_BLOCK, side="right"),
                          N_EXPERTS - 1)

    def expert_block(args):
        tok, wts, e = args
        xb = h[tok]
        act = jax.nn.silu(xb @ w_gate[e]) * (xb @ w_up[e])
        return (act @ w_down[e]) * wts[:, None]

    routed_slots = lax.map(expert_block, (slot_tok.reshape(n_blocks, MOE_BLOCK),
                                          slot_w.reshape(n_blocks, MOE_BLOCK), block_e))
    routed = jnp.zeros_like(h).at[slot_tok].add(routed_slots.reshape(n_slots, D_MODEL).astype(h.dtype))
    shared = (jax.nn.silu(h @ sh_gate) * (h @ sh_up)) @ sh_down
    return routed + shared


def setup_inputs(seed: int = 0) -> dict:
    key = jax.random.key(seed)
    ks = iter(jax.random.split(key, 48))

    def nrm(shape, scale):
        return jax.random.normal(next(ks), shape, F32) * scale

    def gain(shape):
        return 1.0 + nrm(shape, 0.02)

    L = DEPTH
    u_lam = jax.random.uniform(next(ks), (L, 2, C_WIDTH), F32, minval=0.9, maxval=0.999)
    s_lam = u_lam ** (1.0 / C_POW)
    return {
        "x": nrm((BATCH, SEQ, D_MODEL), 1.0),
        "c": nrm((BATCH, D_MODEL), 1.0),
        "ctx": nrm((BATCH, CTX_LEN, D_MODEL), 1.0),
        "c_ctx": nrm((D_MODEL,), 1.0),
        "w_mod": nrm((L, D_MODEL, 6 * D_MODEL), 0.5 * D_MODEL ** -0.5),
        "b_mod": nrm((L, 6 * D_MODEL), 0.02),
        "w_in": nrm((L, D_MODEL, IN_COLS), D_MODEL ** -0.5),
        "b_in": nrm((L, IN_COLS), 0.02),
        "lam_q1": nrm((L, A_QK_DIM), 0.1),
        "lam_k1": nrm((L, A_QK_DIM), 0.1),
        "lam_q2": nrm((L, A_QK_DIM), 0.1),
        "lam_k2": nrm((L, A_QK_DIM), 0.1),
        "attn_norm_g": gain((L, A_HEADS, A_V_DIM)),
        "sg_ln_g": gain((L, B_WIDTH)),
        "sg_ln_b": nrm((L, B_WIDTH), 0.02),
        "sg_w": nrm((L, B_GROUPS, B_CHUNK, B_CHUNK), B_CHUNK ** -0.5),
        "sg_b": 1.0 + nrm((L, B_GROUPS, B_CHUNK), 0.01),
        "conv_w": nrm((L, C_CONV, C_WIDTH), C_CONV ** -0.5),
        "conv_b": nrm((L, C_WIDTH), 0.02),
        "lru_wa": nrm((L, 2, C_BLOCKS, C_BLOCK_DIM, C_BLOCK_DIM), C_BLOCK_DIM ** -0.5),
        "lru_ba": nrm((L, 2, C_WIDTH), 0.02),
        "lru_wx": nrm((L, 2, C_BLOCKS, C_BLOCK_DIM, C_BLOCK_DIM), C_BLOCK_DIM ** -0.5),
        "lru_bx": nrm((L, 2, C_WIDTH), 0.02),
        "lru_lam": jnp.log(s_lam) - jnp.log1p(-s_lam),
        "w_branch": nrm((L, N_BRANCH, BRANCH_WIDTH, D_MODEL), BRANCH_WIDTH ** -0.5),
        "w_out": nrm((L, D_MODEL, D_MODEL), DN_BETA * D_MODEL ** -0.5),
        "ln1_g": gain((L, D_MODEL)),
        "ln1_b": nrm((L, D_MODEL), 0.02),
        "w_router": nrm((L, D_MODEL, N_EXPERTS), D_MODEL ** -0.5),
        "router_bias": nrm((L, N_EXPERTS), 0.01),
        "moe_w_gate": nrm((L, N_EXPERTS, D_MODEL, D_EXPERT), D_MODEL ** -0.5),
        "moe_w_up": nrm((L, N_EXPERTS, D_MODEL, D_EXPERT), D_MODEL ** -0.5),
        "moe_w_down": nrm((L, N_EXPERTS, D_EXPERT, D_MODEL), DN_BETA * D_EXPERT ** -0.5),
        "sh_w_gate": nrm((L, D_MODEL, D_SHARED), D_MODEL ** -0.5),
        "sh_w_up": nrm((L, D_MODEL, D_SHARED), D_MODEL ** -0.5),
        "sh_w_down": nrm((L, D_SHARED, D_MODEL), DN_BETA * D_SHARED ** -0.5),
        "ln2_g": gain((L, D_MODEL)),
        "ln2_b": nrm((L, D_MODEL), 0.02),
    }


def reference(x, c, ctx, c_ctx, w_mod, b_mod, w_in, b_in, lam_q1, lam_k1, lam_q2, lam_k2, attn_norm_g,
              sg_ln_g, sg_ln_b, sg_w, sg_b, conv_w, conv_b, lru_wa, lru_ba, lru_wx, lru_bx, lru_lam,
              w_branch, w_out, ln1_g, ln1_b, w_router, router_bias, moe_w_gate, moe_w_up, moe_w_down,
              sh_w_gate, sh_w_up, sh_w_down, ln2_g, ln2_b):
    b, n, _ = x.shape
    n_ctx = ctx.shape[1]
    cos, sin = axial_rope_tables(n)
    for i in range(DEPTH):
        last = i == DEPTH - 1
        mod = jax.nn.silu(c) @ w_mod[i] + b_mod[i]
        mod_c = jax.nn.silu(c_ctx) @ w_mod[i] + b_mod[i]
        sh1, sc1, g1, sh2, sc2, g2 = jnp.split(mod[:, None, :], 6, axis=-1)
        csh1, csc1, cg1, csh2, csc2, cg2 = jnp.split(mod_c, 6, axis=-1)

        h_lat = modulate(layer_norm(x), sh1, sc1)
        h_ctx = modulate(layer_norm(ctx), csh1, csc1)
        mix_lat, mix_ctx = token_mixer(
            h_lat, h_ctx, cos, sin, i, not last,
            w_in[i], b_in[i], lam_q1[i], lam_k1[i], lam_q2[i], lam_k2[i], attn_norm_g[i],
            sg_ln_g[i], sg_ln_b[i], sg_w[i], sg_b[i],
            conv_w[i], conv_b[i], lru_wa[i], lru_ba[i], lru_wx[i], lru_bx[i], lru_lam[i],
            w_branch[i], w_out[i])
        x = layer_norm(DN_ALPHA * x + g1 * mix_lat, ln1_g[i], ln1_b[i])
        h2 = modulate(layer_norm(x), sh2, sc2).reshape(b * n, D_MODEL)
        moe_args = (w_router[i], router_bias[i], moe_w_gate[i], moe_w_up[i], moe_w_down[i],
                    sh_w_gate[i], sh_w_up[i], sh_w_down[i])
        if last:
            y = moe_ffn(h2, *moe_args)
            x = layer_norm(DN_ALPHA * x + g2 * y.reshape(b, n, D_MODEL), ln2_g[i], ln2_b[i])
        else:
            ctx = layer_norm(DN_ALPHA * ctx + cg1 * mix_ctx, ln1_g[i], ln1_b[i])
            h2c = modulate(layer_norm(ctx), csh2, csc2).reshape(b * n_ctx, D_MODEL)
            y = moe_ffn(jnp.concatenate([h2, h2c], axis=0), *moe_args)
            x = layer_norm(DN_ALPHA * x + g2 * y[: b * n].reshape(b, n, D_MODEL), ln2_g[i], ln2_b[i])
            ctx = layer_norm(DN_ALPHA * ctx + cg2 * y[b * n:].reshape(b, n_ctx, D_MODEL), ln2_g[i], ln2_b[i])
    return x
```

```cpp
#include <hip/hip_runtime.h>
#include <cstdio>
#include <cstdint>
#include <cmath>

#ifndef MK_MULTI
#define MK_MULTI 0
#endif
#ifndef NAIVE_GEMM
#define NAIVE_GEMM 0
#endif

#define LAS __attribute__((address_space(3)))
#define GAS __attribute__((address_space(1)))
typedef unsigned short bf16_t;
typedef short bf16x8 __attribute__((ext_vector_type(8)));
typedef short s16x4 __attribute__((ext_vector_type(4)));
typedef float f32x4 __attribute__((ext_vector_type(4)));
typedef float f32x16 __attribute__((ext_vector_type(16)));
typedef unsigned u32x4 __attribute__((ext_vector_type(4)));
typedef unsigned u32x2 __attribute__((ext_vector_type(2)));

constexpr int DM = 1024, NBATCH = 4, SEQ = 4096, CTX = 256, TPB = SEQ + CTX  , T = NBATCH * TPB  ;
constexpr int INC = 6656, NEXP = 64;
constexpr float DN_ALPHA = 1.41421356237309515f;
constexpr float LN_EPS = 1e-6f, RMS_EPS = 1e-5f;
constexpr int NWAVES = 8, NTHR = 512;

constexpr size_t MiB = 1u << 20;
constexpr size_t WS_CTL = 0, CTL_ZERO_BYTES = 1 * MiB;
constexpr size_t CW_BAR_BYTE = 16384;
constexpr size_t WS_CNT = 65536;
constexpr size_t WS_MOD = 131072;
constexpr size_t WS_ROPE = 1 * MiB;
constexpr size_t WS_LAM = 1 * MiB + 8192;
constexpr size_t WS_SUM = 1 * MiB + 65536;
constexpr size_t WS_HIN = WS_SUM + 2304 * 1024;
constexpr size_t WS_TOKE = 5 * MiB, WS_TOKP = 6 * MiB, WS_TOKW = 7 * MiB;
constexpr size_t WS_LIST = 8 * MiB;
constexpr size_t WS_XC = 13 * MiB;
constexpr size_t WS_WLRU = 17 * MiB;
constexpr size_t WS_WSG = 17 * MiB + 512 * 1024;
constexpr size_t WS_WSH1 = 18 * MiB;
constexpr size_t WS_WSH2 = 20 * MiB;
constexpr size_t WS_WOUT = 21 * MiB;
constexpr size_t WS_WBR = 25 * MiB;
constexpr size_t WS_WIN = 31 * MiB;
constexpr size_t WS_WM1 = 57 * MiB;
constexpr size_t WS_WM2 = 121 * MiB;
constexpr size_t WS_H = 153 * MiB;
constexpr size_t WS_OV = 187 * MiB;
constexpr size_t OV_Q = WS_OV, OV_K = WS_OV + 17 * MiB, OV_V = WS_OV + 34 * MiB, OV_U = WS_OV + 51 * MiB, OV_S = WS_OV + 68 * MiB,
                 OV_X = WS_OV + 85 * MiB, OV_Y = WS_OV + 102 * MiB, OV_G = WS_OV + 119 * MiB, OV_OA = WS_OV + 221 * MiB,
                 OV_OB = WS_OV + 238 * MiB, OV_OC = WS_OV + 255 * MiB, OV_MG = WS_OV + 272 * MiB;
constexpr size_t OV_ACT = WS_OV, OV_ACTSH = WS_OV + 69 * MiB, OV_YS = WS_OV + 78 * MiB;
constexpr size_t WS_END = WS_OV + 350 * MiB;

constexpr int LDS_SCRATCH = 147456;
constexpr int LDS_CTL = LDS_SCRATCH;
constexpr int LDS_BYTES = LDS_SCRATCH + 4096;
constexpr int LC_BAR = 0;
constexpr int LC_TCNT = 64, LC_TBASE = 64 + 80, LC_SBASE = 64 + 160;

struct Args { const float* in[38]; float* out; unsigned char* ws; int ph_lo, ph_hi; };
typedef const Args __attribute__((address_space(4)))* CArgsP;

__device__ __forceinline__ unsigned f2bf(float f) { unsigned u = __builtin_bit_cast(unsigned, f); return (u + 0x7fffu + ((u >> 16) & 1u)) >> 16; }
__device__ __forceinline__ unsigned pk2(float lo, float hi) { return f2bf(lo) | (f2bf(hi) << 16); }
__device__ __forceinline__ float bflo(unsigned w) { return __builtin_bit_cast(float, w << 16); }
__device__ __forceinline__ float bfhi(unsigned w) { return __builtin_bit_cast(float, w & 0xffff0000u); }
__device__ __forceinline__ float bf2f(bf16_t b) { return __builtin_bit_cast(float, (unsigned)b << 16); }
__device__ __forceinline__ float wave_sum(float v) {
#pragma unroll
    for (int o = 1; o < 64; o <<= 1) v += __shfl_xor(v, o);
    return v;
}
__device__ __forceinline__ float sigmoidf_(float x) { return 1.f / (1.f + __expf(-x)); }
__device__ __forceinline__ float gelu_tanh(float x) { const float u = 0.7978845608028654f * (x + 0.044715f * x * x * x); return x / (1.f + __expf(-2.f * u)); }
__device__ __forceinline__ float silu_(float x) { return x / (1.f + __expf(-x)); }
#define LDS_WAIT() asm volatile("s_waitcnt lgkmcnt(0)" ::: "memory")
#define VM_WAIT() asm volatile("s_waitcnt vmcnt(0)" ::: "memory")

#define XB_TMO      128
#define XB_XCNT(j)  (256  + 64 * (j))
#define XB_XSUB(j)  (1280 + 64 * (j))
#define XB_XGEN(j)  (2304 + 64 * (j))
#define XB_TOP      3328
#define XB_TOPGEN   3392
#define XCD_BAR_WORDS 3456
#define XB_SPIN_CAP (1u << 22)
__device__ __forceinline__ unsigned xb_ld(unsigned* p)              { return __hip_atomic_load(p, __ATOMIC_RELAXED, __HIP_MEMORY_SCOPE_AGENT); }
__device__ __forceinline__ unsigned xb_add(unsigned* p, unsigned v) { return __hip_atomic_fetch_add(p, v, __ATOMIC_RELAXED, __HIP_MEMORY_SCOPE_AGENT); }
__device__ __forceinline__ unsigned xb_xcc_id() { return (unsigned)__builtin_amdgcn_s_getreg((3 << 11) | 20) & 0xFu; }
#define XB_SPIN(cond, bar) do { unsigned _sp = 0; while (cond) { __builtin_amdgcn_s_sleep(1); \
    if ((++_sp & 255u) == 0u) { if (xb_ld(&(bar)[XB_TMO])) break; if (_sp > XB_SPIN_CAP) { atomicAdd(&(bar)[XB_TMO], 1u); break; } } } } while (0)
struct XcdBarrier { unsigned* bar; unsigned x; volatile LAS unsigned* st; };
__device__ __forceinline__ XcdBarrier xcd_barrier_post(unsigned* bar, volatile LAS unsigned* st) {
    XcdBarrier b; b.bar = bar; b.x = xb_xcc_id(); b.st = st;
    if (threadIdx.x == 0) (void)xb_add(&bar[XB_XCNT(b.x)], 1u);
    return b;
}
__device__ __forceinline__ void xcd_barrier_complete(unsigned* bar, unsigned x, unsigned& nloc, unsigned& nx) {
    const unsigned G = gridDim.x * gridDim.y * gridDim.z;
    unsigned sum, cnt, mine, sp = 0u;
    for (;;) {
        sum = 0u; cnt = 0u; mine = 0u;
#pragma unroll
        for (unsigned j = 0; j < 16; ++j) { const unsigned c = xb_ld(&bar[XB_XCNT(j)]); sum += c; cnt += (c > 0u) ? 1u : 0u; mine = (j == x) ? c : mine; }
        if (sum == G) break;
        __builtin_amdgcn_s_sleep(1);
        if ((++sp & 255u) == 0u) { if (xb_ld(&bar[XB_TMO])) break; if (sp > XB_SPIN_CAP) { atomicAdd(&bar[XB_TMO], 1u); break; } }
    }
    nloc = mine > 0u ? mine : 1u; nx = cnt > 0u ? cnt : 1u;
}
__device__ __forceinline__ void xcd_barrier(const XcdBarrier& b) {
    asm volatile("s_waitcnt vmcnt(0)" ::: "memory");
    __syncthreads();
    if (threadIdx.x == 0) {
        unsigned* bar = b.bar; asm volatile("" : "+s"(bar));
        __builtin_amdgcn_s_waitcnt(0);
        unsigned nloc = b.st[0], nx = b.st[1];
        if (nloc == 0u) { xcd_barrier_complete(bar, b.x, nloc, nx); b.st[0] = nloc; b.st[1] = nx; }
        const unsigned old = xb_add(&bar[XB_XSUB(b.x)], 1u);
        const unsigned gen = old / nloc;
        if (old + 1u == (gen + 1u) * nloc) {
            __builtin_amdgcn_fence(__ATOMIC_RELEASE, "agent");
            asm volatile("s_waitcnt vmcnt(0)" ::: "memory");
            const unsigned og = xb_add(&bar[XB_TOP], 1u);
            const unsigned tg = og / nx;
            if (og + 1u == (tg + 1u) * nx) xb_add(&bar[XB_TOPGEN], 1u);
            else XB_SPIN(xb_ld(&bar[XB_TOPGEN]) == tg, bar);
            __builtin_amdgcn_fence(__ATOMIC_ACQUIRE, "agent");
            xb_add(&bar[XB_XGEN(b.x)], 1u);
            asm volatile("s_waitcnt vmcnt(0)" ::: "memory");
        } else {
            XB_SPIN(xb_ld(&bar[XB_XGEN(b.x)]) == gen, bar);
            __builtin_amdgcn_fence(__ATOMIC_ACQUIRE, "agent");
            asm volatile("s_waitcnt vmcnt(0)" ::: "memory");
        }
    }
    __syncthreads();
}

namespace pg8 {
constexpr int BM = 256, BK = 64, HALF = 128, HTB = HALF * BK * 2, STAGE_BYTES = 8 * HTB, NXCD = 8, WGM = 8;
__host__ __device__ __forceinline__ int lds_byte(int r, int c) { const int st = (r >> 4) * 2 + (c >> 5), rr = r & 15, cc = c & 31, ob = rr * 64 + cc * 2; return st * 1024 + (ob ^ (((ob >> 9) & 1) << 5)); }
__host__ __device__ __forceinline__ void stage_rc(int b, int& R, int& C) { const int st = b / 1024, sb = b % 1024, swz = sb ^ (((sb >> 9) & 1) << 5); R = (st >> 1) * 16 + swz / 64; C = (st & 1) * 32 + (swz % 64) / 2; }
struct Unit { int pm, pn, e, ti, nrows, row0; };
typedef f32x4 Acc[2][2][4][2];

template <class Epi, class Sched>
__device__ __forceinline__ void gemm_phase(LAS unsigned char* lds, const int K, const Sched& S, const Epi& E) {
    int tid_ = threadIdx.x; asm volatile("" : "+v"(tid_));
    const int tid = tid_, wid = __builtin_amdgcn_readfirstlane(tid >> 6), lane = tid & 63, wr = wid >> 2, wc = wid & 3, fr = lane & 15, fq = lane >> 4;
    (void)fr; (void)fq; (void)wc;
    Unit cur, nxt; int ui = 0;
    if (!S.next(0, cur)) return;
    Acc acc;
#pragma unroll
    for (int a = 0; a < 2; ++a)
#pragma unroll
        for (int b = 0; b < 2; ++b)
#pragma unroll
            for (int m = 0; m < 4; ++m)
#pragma unroll
                for (int n = 0; n < 2; ++n) acc[a][b][m][n] = (f32x4){0.f, 0.f, 0.f, 0.f};
#if NAIVE_GEMM
    for (;;) {
        const char* Ab = S.a_base(); const char* Bb = S.b_ptr(cur);
#pragma unroll 1
        for (int ai = 0; ai < 2; ++ai)
#pragma unroll 1
            for (int m = 0; m < 4; ++m) {
                const int rr = ai * 128 + wr * 64 + m * 16 + fr;
                const bf16_t* ap = (const bf16_t*)(Ab + S.a_off(cur, rr));
#pragma unroll
                for (int bj = 0; bj < 2; ++bj)
#pragma unroll
                    for (int n = 0; n < 2; ++n)
#pragma unroll
                        for (int j = 0; j < 4; ++j) {
                            const int cc = bj * 128 + wc * 32 + n * 16 + fq * 4 + j;
                            const bf16_t* bp = (const bf16_t*)(Bb + (size_t)cc * K * 2);
                            float s = 0.f;
                            for (int k = 0; k < K; k += 8) {
                                const u32x4 av = *(const u32x4*)(ap + k), bv = *(const u32x4*)(bp + k);
                                s += bflo(av.x) * bflo(bv.x) + bfhi(av.x) * bfhi(bv.x) + bflo(av.y) * bflo(bv.y) + bfhi(av.y) * bfhi(bv.y)
                                   + bflo(av.z) * bflo(bv.z) + bfhi(av.z) * bfhi(bv.z) + bflo(av.w) * bflo(bv.w) + bfhi(av.w) * bfhi(bv.w);
                            }
                            acc[ai][bj][m][n][j] = s;
                        }
            }
        E(acc, cur, wr, wc, fr, fq);
        ++ui;
        if (!S.next(ui, cur)) break;
    }
    return;
#else
    const int nt = K / BK;
    unsigned voffB[2];
    { int Rr[2], Cc[2];
#pragma unroll
      for (int i = 0; i < 2; ++i) { stage_rc(tid * 16 + i * 8192, Rr[i], Cc[i]); voffB[i] = (unsigned)(Rr[i] * K + Cc[i]) * 2u; } }
#define PG8_AOFFS(U, o00, o01, o10, o11) do { int t3_ = threadIdx.x; asm volatile("" : "+v"(t3_)); int R0_, C0_, R1_, C1_; stage_rc(t3_ * 16, R0_, C0_); stage_rc(t3_ * 16 + 8192, R1_, C1_); \
        o00 = S.a_off(U, R0_) + (unsigned)C0_ * 2u; o01 = S.a_off(U, R1_) + (unsigned)C1_ * 2u; o10 = S.a_off(U, HALF + R0_) + (unsigned)C0_ * 2u; o11 = S.a_off(U, HALF + R1_) + (unsigned)C1_ * 2u; } while (0)
    const size_t kstep = (size_t)(BK * 2);
    const size_t hstep = (size_t)HALF * K * 2;
    const unsigned ldsw = (unsigned)wid * 1024u;
    const int aoff = lds_byte(wr * 64 + fr, fq * 8), boff = lds_byte(wc * 32 + fr, fq * 8);
#define PG8_SA(b, h) (((b) * 2 + (h)) * HTB)
#define PG8_SB(b, h) ((4 + (b) * 2 + (h)) * HTB)
#define PG8_STAGE(bufoff, gbase, v0, v1) do { \
        __builtin_amdgcn_global_load_lds((const unsigned*)((const char*)(gbase) + (v0)), (LAS unsigned*)(lds + (bufoff) + ldsw), 16, 0, 0); \
        __builtin_amdgcn_global_load_lds((const unsigned*)((const char*)(gbase) + (v1)), (LAS unsigned*)(lds + (bufoff) + ldsw + 8192), 16, 0, 0); } while (0)
#define PG8_LDA(dst, b, h) do { _Pragma("unroll") for (int m = 0; m < 4; ++m) _Pragma("unroll") for (int k = 0; k < 2; ++k) dst[m][k] = *(const LAS bf16x8*)(lds + PG8_SA(b, h) + aoff + m * 2048 + k * 1024); } while (0)
#define PG8_LDB(dst, b, h) do { _Pragma("unroll") for (int n = 0; n < 2; ++n) _Pragma("unroll") for (int k = 0; k < 2; ++k) dst[n][k] = *(const LAS bf16x8*)(lds + PG8_SB(b, h) + boff + n * 2048 + k * 1024); } while (0)
#define PG8_MMA(ai, bj, At, Bt) do { __builtin_amdgcn_s_setprio(1); _Pragma("unroll") for (int m = 0; m < 4; ++m) _Pragma("unroll") for (int n = 0; n < 2; ++n) _Pragma("unroll") for (int k = 0; k < 2; ++k) \
        acc[ai][bj][m][n] = __builtin_amdgcn_mfma_f32_16x16x32_bf16(Bt[n][k], At[m][k], acc[ai][bj][m][n], 0, 0, 0); __builtin_amdgcn_s_setprio(0); } while (0)
#define PG8_WAIT_V(n) asm volatile("s_waitcnt vmcnt(" #n ")" ::: "memory")
#define PG8_WAIT_L(n) asm volatile("s_waitcnt lgkmcnt(" #n ")" ::: "memory")
#define PG8_BAR __builtin_amdgcn_s_barrier()
#define PG8_SCHED __builtin_amdgcn_sched_barrier(0)
    bf16x8 At[4][2], B0[2][2], B1[2][2];
    const char* const Ab = S.a_base();
    unsigned vA00, vA01, vA10, vA11;
    PG8_AOFFS(cur, vA00, vA01, vA10, vA11);
    const char* cB = S.b_ptr(cur);
    PG8_STAGE(PG8_SB(0, 0), cB, voffB[0], voffB[1]); PG8_STAGE(PG8_SB(0, 1), cB + hstep, voffB[0], voffB[1]); PG8_STAGE(PG8_SA(0, 0), Ab, vA00, vA01); PG8_STAGE(PG8_SA(0, 1), Ab, vA10, vA11);
    if (wr == 1) PG8_BAR;
    PG8_WAIT_V(2); PG8_BAR;
    PG8_STAGE(PG8_SB(1, 0), cB + kstep, voffB[0], voffB[1]); PG8_STAGE(PG8_SA(1, 0), Ab + kstep, vA00, vA01); PG8_STAGE(PG8_SB(1, 1), cB + hstep + kstep, voffB[0], voffB[1]);
    PG8_WAIT_V(6); PG8_BAR;
    for (;;) {
        const bool has_next = S.next(ui + 1, nxt);
        unsigned vN00 = vA00, vN01 = vA01, vN10 = vA10, vN11 = vA11; const char* nB = cB;
        if (has_next) { PG8_AOFFS(nxt, vN00, vN01, vN10, vN11); nB = S.b_ptr(nxt); }
        for (int t = 0; t < nt; t += 2) {
            const bool last = (t == nt - 2);
            const char* a1 = Ab + (size_t)(t + 1) * kstep;
            const char* a2 = last ? Ab : Ab + (size_t)(t + 2) * kstep; const char* b2 = last ? nB : cB + (size_t)(t + 2) * kstep;
            const char* a3 = a2 + kstep; const char* b3 = b2 + kstep;
            const unsigned w00 = last ? vN00 : vA00, w01 = last ? vN01 : vA01, w10 = last ? vN10 : vA10, w11 = last ? vN11 : vA11;
            PG8_LDB(B0, 0, 0); PG8_LDB(B1, 0, 1); PG8_SCHED; PG8_LDA(At, 0, 0); PG8_STAGE(PG8_SA(1, 1), a1, vA10, vA11);
            PG8_WAIT_V(8); PG8_WAIT_L(0); PG8_BAR; PG8_MMA(0, 0, At, B0); PG8_MMA(0, 1, At, B1); PG8_BAR; PG8_SCHED;
            PG8_LDA(At, 0, 1); PG8_STAGE(PG8_SB(0, 0), b2, voffB[0], voffB[1]); PG8_STAGE(PG8_SB(0, 1), b2 + hstep, voffB[0], voffB[1]); PG8_STAGE(PG8_SA(0, 0), a2, w00, w01);
            PG8_WAIT_V(8); PG8_WAIT_L(0); PG8_BAR; PG8_MMA(1, 0, At, B0); PG8_MMA(1, 1, At, B1); PG8_BAR; PG8_SCHED;
            PG8_LDB(B0, 1, 0); PG8_LDB(B1, 1, 1); PG8_SCHED; PG8_LDA(At, 1, 0); PG8_STAGE(PG8_SA(0, 1), a2, w10, w11);
            PG8_WAIT_V(8); PG8_WAIT_L(0); PG8_BAR; PG8_MMA(0, 0, At, B0); PG8_MMA(0, 1, At, B1); PG8_BAR; PG8_SCHED;
            PG8_LDA(At, 1, 1); PG8_STAGE(PG8_SB(1, 0), b3, voffB[0], voffB[1]); PG8_STAGE(PG8_SB(1, 1), b3 + hstep, voffB[0], voffB[1]); PG8_STAGE(PG8_SA(1, 0), a3, w00, w01);
            PG8_WAIT_V(8); PG8_WAIT_L(0); PG8_BAR; PG8_MMA(1, 0, At, B0); PG8_MMA(1, 1, At, B1); PG8_BAR; PG8_SCHED;
        }
        if (wr == 0) PG8_BAR;
        { int t2_ = threadIdx.x; asm volatile("" : "+v"(t2_)); const int l2_ = t2_ & 63; E(acc, cur, wr, wc, l2_ & 15, l2_ >> 4); }
        if (!has_next) break;
#pragma unroll
        for (int a = 0; a < 2; ++a)
#pragma unroll
            for (int b = 0; b < 2; ++b)
#pragma unroll
                for (int m = 0; m < 4; ++m)
#pragma unroll
                    for (int n = 0; n < 2; ++n) acc[a][b][m][n] = (f32x4){0.f, 0.f, 0.f, 0.f};
        cur = nxt; vA00 = vN00; vA01 = vN01; vA10 = vN10; vA11 = vN11; cB = nB; ++ui;
        if (wr == 1) PG8_BAR;
    }
    PG8_WAIT_V(0);
    PG8_BAR;
#undef PG8_SA
#undef PG8_AOFFS
#undef PG8_SB
#undef PG8_STAGE
#undef PG8_LDA
#undef PG8_LDB
#undef PG8_MMA
#undef PG8_WAIT_V
#undef PG8_WAIT_L
#undef PG8_BAR
#undef PG8_SCHED
#endif
}
}
using pg8::Unit;
using pg8::Acc;

__device__ __forceinline__ float* resid_row(float* out, float* xc, int tok) {
    const int b = tok / TPB, j = tok - b * TPB;
    return j < CTX ? xc + ((size_t)(b * CTX + j)) * DM : out + ((size_t)(b * SEQ + j - CTX)) * DM;
}
__device__ __forceinline__ int tile_to_pm(int i, bool latent_only) { return latent_only ? (i >> 4) * 17 + 1 + (i & 15) : i; }

__device__ __forceinline__ bool static_order(int i, int G, int c, int nM, int nN, int& pm, int& pn) {
    const int nwg = nM * nN; const long L = (long)i * G + c; if (L >= nwg) return false;
    int wgid = (int)L; { const int q = nwg / 8, r = nwg % 8, xcd = wgid % 8, off = wgid / 8; wgid = (xcd < r ? xcd * (q + 1) : r * (q + 1) + (xcd - r) * q) + off; }
    const int nig = 8 * nN, gid = wgid / nig, fm = gid * 8, gsz = (nM - fm) < 8 ? (nM - fm) : 8;
    pm = fm + ((wgid % nig) % gsz); pn = (wgid % nig) / gsz; return true;
}

struct SchedPlain {
    const char* A; const char* Bt; int K, nM, nN, G, c; bool lat;
    __device__ __forceinline__ bool next(int i, Unit& u) const {
        int pm, pn; if (!static_order(i, G, c, nM, nN, pm, pn)) return false;
        u.pm = tile_to_pm(pm, lat); u.pn = pn; u.e = 0; u.ti = 0; u.nrows = 256; u.row0 = u.pm * 256; return true;
    }
    __device__ __forceinline__ const char* a_base() const { return A; }
    __device__ __forceinline__ unsigned a_off(const Unit& u, int rr) const { return (unsigned)(u.row0 + rr) * (unsigned)(K * 2); }
    __device__ __forceinline__ const char* b_ptr(const Unit& u) const { return Bt + (size_t)u.pn * 256 * K * 2; }
};

struct SchedMoe {
    const char* A;
    const char* Ash;
    const char* Bt; const char* Btsh; const int* list;
    const LAS int* tb;
    int K, nN, G, c, nsh; bool lat, gather; size_t bstride;
    __device__ __forceinline__ bool next(int i, Unit& u) const {
        const int nrt = tb[LC_TBASE + 64], L = i * G + c, tot = (nrt + nsh) * nN;
        if (L >= tot) return false;
        const int rt = L / nN; u.pn = L - rt * nN;
        if (rt < nrt) {
            int e = 0;
#pragma unroll 1
            for (int s = 32; s > 0; s >>= 1) if (e + s < 64 && tb[LC_TBASE + e + s] <= rt) e += s;
            u.e = e; u.ti = rt - tb[LC_TBASE + e]; const int cnt = tb[LC_TCNT + e]; const int rem = cnt - u.ti * 256;
            u.nrows = rem < 256 ? rem : 256; u.row0 = tb[LC_SBASE + e] + u.ti * 256; u.pm = 0;
        } else { u.e = 64; u.ti = rt - nrt; u.pm = tile_to_pm(u.ti, lat); u.nrows = 256; u.row0 = u.pm * 256; }
        return true;
    }
    __device__ __forceinline__ const char* a_base() const { return A; }
    __device__ __forceinline__ unsigned a_off(const Unit& u, int rr) const {
        if (u.e == 64) return (unsigned)(Ash - A) + (unsigned)(u.row0 + rr) * (unsigned)(K * 2);
        if (gather) { const int r2 = rr < u.nrows ? rr : u.nrows - 1; const int tok = list[(size_t)u.e * T + u.ti * 256 + r2]; return (unsigned)tok * (unsigned)(K * 2); }
        return (unsigned)(u.row0 + rr) * (unsigned)(K * 2);
    }
    __device__ __forceinline__ const char* b_ptr(const Unit& u) const { return (u.e == 64 ? Btsh : Bt + (size_t)u.e * bstride) + (size_t)u.pn * 256 * K * 2; }
};

#define EPI_FOR_ROWS  _Pragma("unroll") for (int ai = 0; ai < 2; ++ai) _Pragma("unroll") for (int m = 0; m < 4; ++m)
#define EPI_FOR_COLS  _Pragma("unroll") for (int bj = 0; bj < 2; ++bj) _Pragma("unroll") for (int n = 0; n < 2; ++n)

struct EpiInproj {
    unsigned char* ws; const float* bias; const float* rope;
    __device__ __forceinline__ void operator()(const Acc& acc, const Unit& u, int wr, int wc, int fr, int fq) const {
        const int pn = u.pn; const bool isg = pn >= 14; const int seg = pn >> 1;
        bf16_t* base = (bf16_t*)(ws + (isg ? OV_G : OV_Q + (size_t)seg * 17 * MiB));
        const int ld = isg ? 3072 : 512, coff = isg ? (pn - 14) * 256 : (pn & 1) * 256;
        const bool latent = (u.pm % 17) != 0;
        f32x4 bv[2][2];
        EPI_FOR_COLS bv[bj][n] = *(const f32x4*)(bias + pn * 256 + bj * 128 + wc * 32 + n * 16 + fq * 4);
        EPI_FOR_ROWS {
            const int row = u.row0 + ai * 128 + wr * 64 + m * 16 + fr;
            bf16_t* rp = base + (size_t)row * ld + coff + wc * 32 + fq * 4;
            f32x4 v[2][2];
            EPI_FOR_COLS v[bj][n] = acc[ai][bj][m][n] + bv[bj][n];
            if (seg < 2 && !isg) {
                if (latent) {
                    const int pos = (row % TPB) - CTX; const int pa = (wc & 1) ? (pos & 63) : (pos >> 6);
                    const f32x4 c0 = *(const f32x4*)(rope + (pa * 16 + fq * 4) * 2), c1 = *(const f32x4*)(rope + (pa * 16 + fq * 4) * 2 + 4);
                    const float cs[4] = {c0[0], c0[2], c1[0], c1[2]}, sn[4] = {c0[1], c0[3], c1[1], c1[3]};
#pragma unroll
                    for (int bj = 0; bj < 2; ++bj)
#pragma unroll
                        for (int j = 0; j < 4; ++j) { const float a = v[bj][0][j], b = v[bj][1][j]; v[bj][0][j] = a * cs[j] - b * sn[j]; v[bj][1][j] = b * cs[j] + a * sn[j]; }
                }
            } else if (isg) {
                EPI_FOR_COLS {
#pragma unroll
                    for (int j = 0; j < 4; ++j) v[bj][n][j] = sigmoidf_(v[bj][n][j]); }
            } else if (seg == 3 || seg == 4 || seg == 6) {
                EPI_FOR_COLS {
#pragma unroll
                    for (int j = 0; j < 4; ++j) v[bj][n][j] = gelu_tanh(v[bj][n][j]); }
            }
            EPI_FOR_COLS { u32x2 w; w.x = pk2(v[bj][n][0], v[bj][n][1]); w.y = pk2(v[bj][n][2], v[bj][n][3]); *(u32x2*)(rp + bj * 128 + n * 16) = w; }
        }
    }
};

struct EpiMerge {
    bf16_t* mg; const bf16_t* gate; int r;
    __device__ __forceinline__ void operator()(const Acc& acc, const Unit& u, int wr, int wc, int fr, int fq) const {
        EPI_FOR_ROWS {
            const int row = u.row0 + ai * 128 + wr * 64 + m * 16 + fr;
            EPI_FOR_COLS {
                const int col = u.pn * 256 + bj * 128 + wc * 32 + n * 16 + fq * 4;
                const u32x2 g = *(const u32x2*)(gate + (size_t)row * 3072 + r * 1024 + col);
                f32x4 v = acc[ai][bj][m][n]; v[0] *= bflo(g.x); v[1] *= bfhi(g.x); v[2] *= bflo(g.y); v[3] *= bfhi(g.y);
                u32x2* mp = (u32x2*)(mg + (size_t)row * DM + col);
                if (r > 0) { const u32x2 o = *mp; v[0] += bflo(o.x); v[1] += bfhi(o.x); v[2] += bflo(o.y); v[3] += bfhi(o.y); }
                u32x2 w; w.x = pk2(v[0], v[1]); w.y = pk2(v[2], v[3]); *mp = w;
            }
        }
    }
};

struct EpiWout {
    float* out; float* xc; const float* modl;
    __device__ __forceinline__ void operator()(const Acc& acc, const Unit& u, int wr, int wc, int fr, int fq) const {
        const int b = u.pm / 17; const int bsel = (u.pm % 17) == 0 ? 4 : b;
        const float* g1 = modl + bsel * 6144 + 2048;
        f32x4 gv[2][2];
        EPI_FOR_COLS gv[bj][n] = *(const f32x4*)(g1 + u.pn * 256 + bj * 128 + wc * 32 + n * 16 + fq * 4);
        EPI_FOR_ROWS {
            const int row = u.row0 + ai * 128 + wr * 64 + m * 16 + fr;
            float* rp = resid_row(out, xc, row) + u.pn * 256 + wc * 32 + fq * 4;
            EPI_FOR_COLS { f32x4* p = (f32x4*)(rp + bj * 128 + n * 16); const f32x4 x = *p; *p = x * DN_ALPHA + gv[bj][n] * acc[ai][bj][m][n]; }
        }
    }
};

struct EpiMoe1 {
    bf16_t* act; bf16_t* actsh;
    __device__ __forceinline__ void operator()(const Acc& acc, const Unit& u, int wr, int wc, int fr, int fq) const {
        bf16_t* base = u.e == 64 ? actsh : act;
        EPI_FOR_ROWS {
            const int rl = ai * 128 + wr * 64 + m * 16 + fr;
            if (rl < u.nrows) {
                bf16_t* rp = base + (size_t)(u.row0 + rl) * 256 + u.pn * 128 + wc * 32 + fq * 4;
#pragma unroll
                for (int n = 0; n < 2; ++n) {
                    const f32x4 g = acc[ai][0][m][n], p = acc[ai][1][m][n];
                    u32x2 w; w.x = pk2(silu_(g[0]) * p[0], silu_(g[1]) * p[1]); w.y = pk2(silu_(g[2]) * p[2], silu_(g[3]) * p[3]);
                    *(u32x2*)(rp + n * 16) = w;
                }
            }
        }
    }
};

struct EpiMoe2 {
    bf16_t* ys; bf16_t* sho;
    __device__ __forceinline__ void operator()(const Acc& acc, const Unit& u, int wr, int wc, int fr, int fq) const {
        bf16_t* base = u.e == 64 ? sho : ys;
        EPI_FOR_ROWS {
            const int rl = ai * 128 + wr * 64 + m * 16 + fr;
            if (rl < u.nrows) {
                bf16_t* rp = base + (size_t)(u.row0 + rl) * DM + u.pn * 256 + wc * 32 + fq * 4;
                EPI_FOR_COLS { const f32x4 v = acc[ai][bj][m][n]; u32x2 w; w.x = pk2(v[0], v[1]); w.y = pk2(v[2], v[3]); *(u32x2*)(rp + bj * 128 + n * 16) = w; }
            }
        }
    }
};

struct Frame {
    LAS unsigned char* lds; int tid, lane, wave, G, bid, gw, NGW;
    unsigned char* ws; float* out;
};

__device__ __forceinline__ void transpose_item(const float* W, int ldw, int k0, int n0, bf16_t* WT, int ldt, int drow0, LAS float* scr, int lane) {
#pragma unroll 8
    for (int i = 0; i < 32; ++i) { const int kk = 2 * i + (lane >> 5); scr[kk * 33 + (lane & 31)] = W[(size_t)(k0 + kk) * ldw + n0 + (lane & 31)]; }
    LDS_WAIT(); asm volatile("" ::: "memory");
    const int c = lane & 7;
#pragma unroll
    for (int j = 0; j < 4; ++j) { const int n = (lane >> 3) + 8 * j; const LAS float* s = scr + (8 * c) * 33 + n;
        u32x4 o; o.x = pk2(s[0 * 33], s[1 * 33]); o.y = pk2(s[2 * 33], s[3 * 33]); o.z = pk2(s[4 * 33], s[5 * 33]); o.w = pk2(s[6 * 33], s[7 * 33]);
        *(u32x4*)(WT + (size_t)(drow0 + n) * ldt + k0 + 8 * c) = o; }
    LDS_WAIT(); asm volatile("" ::: "memory");
}
__device__ __forceinline__ void conv_expert_item(const float* wg, const float* wu, const float* wd, bf16_t* t1, bf16_t* t2, int which, int rr, LAS float* scr, int lane) {
    if (which < 2) { const int kb = rr >> 3, nb = rr & 7, n0 = 32 * nb;
        transpose_item(which == 0 ? wg : wu, 256, 64 * kb, n0, t1, 1024, (n0 >> 7) * 256 + (n0 & 127) + which * 128, scr, lane);
    } else { const int kb = rr >> 5, nb = rr & 31; transpose_item(wd, 1024, 64 * kb, 32 * nb, t2, 256, 32 * nb, scr, lane); }
}
__device__ __forceinline__ void conv_moe_layer(const Frame& F, CArgsP a, int l) {
    LAS float* scr = (LAS float*)(F.lds + F.wave * 8704);
    for (int it = F.gw; it < 64 * 3 * 128; it += F.NGW) {
        const int idx = it >> 7, e = idx / 3, which = idx - e * 3, rr = it & 127; const size_t eo = (size_t)(l * 64 + e) * 262144;
        conv_expert_item(a->in[30] + eo, a->in[31] + eo, a->in[32] + eo, (bf16_t*)(F.ws + WS_WM1) + (size_t)e * 524288, (bf16_t*)(F.ws + WS_WM2) + (size_t)e * 262144, which, rr, scr, F.lane);
    }
}

__device__ __forceinline__ void phase_prologue(const Frame& F, CArgsP a) {
    LAS float* scr = (LAS float*)(F.lds + F.wave * 8704);
    constexpr int I_IN = 2 * 3328, I_BR = 6 * 256, I_OUT = 2 * 512, I_SH = 6 * 128;
    for (int it0 = F.gw; it0 < I_IN + I_BR + I_OUT + I_SH; it0 += F.NGW) {
        int it = it0;
        if (it < I_IN) { const int l = it / 3328, r = it - l * 3328, kb = r / 208, nb = r - kb * 208;
            transpose_item(a->in[6] + (size_t)l * 1024 * INC, INC, 64 * kb, 32 * nb, (bf16_t*)(F.ws + WS_WIN) + (size_t)l * INC * 1024, 1024, 32 * nb, scr, F.lane); continue; }
        it -= I_IN;
        if (it < I_BR) { const int idx = it >> 8, rr = it & 255, kb = rr >> 5, nb = rr & 31;
            transpose_item(a->in[24] + (size_t)idx * 512 * 1024, 1024, 64 * kb, 32 * nb, (bf16_t*)(F.ws + WS_WBR) + (size_t)idx * 1024 * 512, 512, 32 * nb, scr, F.lane); continue; }
        it -= I_BR;
        if (it < I_OUT) { const int l = it >> 9, rr = it & 511, kb = rr >> 5, nb = rr & 31;
            transpose_item(a->in[25] + (size_t)l * 1048576, 1024, 64 * kb, 32 * nb, (bf16_t*)(F.ws + WS_WOUT) + (size_t)l * 1048576, 1024, 32 * nb, scr, F.lane); continue; }
        it -= I_OUT;
        { const int idx = it >> 7, l = idx / 3, which = idx - l * 3, rr = it & 127; const size_t lo = (size_t)l * 262144;
          conv_expert_item(a->in[33] + lo, a->in[34] + lo, a->in[35] + lo, (bf16_t*)(F.ws + WS_WSH1) + (size_t)l * 524288, (bf16_t*)(F.ws + WS_WSH2) + (size_t)l * 262144, which, rr, scr, F.lane); }
    }
    conv_moe_layer(F, a, 0);
    { const int gt = F.bid * NTHR + F.tid, NG = F.G * NTHR;
      bf16_t* wl = (bf16_t*)(F.ws + WS_WLRU);
      for (int i = gt; i < 2 * 2 * 2 * 8 * 4096; i += NG) {
          const int ii = i & 63, j = (i >> 6) & 63, cb = (i >> 12) & 7, ax = (i >> 15) & 1, d = (i >> 16) & 1, l = i >> 17;
          const float* src = ax == 0 ? a->in[19] : a->in[21];
          wl[i] = (bf16_t)f2bf(src[(size_t)((l * 2 + d) * 8 + cb) * 4096 + ii * 64 + j]); }
      bf16_t* wsg = (bf16_t*)(F.ws + WS_WSG);
      for (int i = gt; i < 2 * 4 * 128 * 128; i += NG) wsg[i] = (bf16_t)f2bf(a->in[15][i]);
      if (F.bid == 0) { float* rope = (float*)(F.ws + WS_ROPE);
          for (int t = F.tid; t < 1024; t += NTHR) { const int p = t >> 4, f = t & 15; const float inv = powf(10000.0f, -(float)f / 16.0f); const float ang = (float)p * inv; rope[2 * t] = cosf(ang); rope[2 * t + 1] = sinf(ang); } }
      if (F.bid == (1 % F.G) && F.wave == 0) { float* lam = (float*)(F.ws + WS_LAM);
#pragma unroll
          for (int l = 0; l < 2; ++l) { const float s1 = wave_sum(a->in[8][l * 64 + F.lane] * a->in[9][l * 64 + F.lane]), s2 = wave_sum(a->in[10][l * 64 + F.lane] * a->in[11][l * 64 + F.lane]);
              const float li = 0.8f - 0.6f * expf(-0.3f * (float)l); if (F.lane == 0) lam[l] = expf(s1) - expf(s2) + li; } }
    }
    __syncthreads();
    LAS float* sl = (LAS float*)(F.lds + 73728);
    for (int i = F.tid; i < 5 * 1024; i += NTHR) { const int b = i >> 10, k = i & 1023; const float cv = b < 4 ? a->in[1][b * 1024 + k] : a->in[3][k]; sl[i] = silu_(cv); }
    __syncthreads();
    float* mod = (float*)(F.ws + WS_MOD);
    LAS float* part = (LAS float*)(F.lds + 94208);
    for (int c = F.bid; c < 192; c += F.G) {
        const int l = c / 96, cg = c - l * 96, col = F.tid & 63, ks = F.wave, n = cg * 64 + col;
        const float* w = a->in[4] + ((size_t)l * 1024 + ks * 128) * 6144 + n;
        float acc[5] = {0.f, 0.f, 0.f, 0.f, 0.f};
#pragma unroll 8
        for (int k = 0; k < 128; ++k) { const float wv = w[(size_t)k * 6144];
#pragma unroll
            for (int b = 0; b < 5; ++b) acc[b] += sl[b * 1024 + ks * 128 + k] * wv; }
#pragma unroll
        for (int b = 0; b < 5; ++b) part[(ks * 5 + b) * 64 + col] = acc[b];
        __syncthreads();
        if (F.tid < 320) { const int b = F.tid >> 6; float s = a->in[5][l * 6144 + n];
#pragma unroll
            for (int k8 = 0; k8 < 8; ++k8) s += part[(k8 * 5 + b) * 64 + col];
            mod[(l * 5 + b) * 6144 + n] = s; }
        __syncthreads();
    }
}

__device__ __forceinline__ void row_load(const float* p, int lane, f32x4 (&v)[4]) {
#pragma unroll
    for (int j = 0; j < 4; ++j) v[j] = *(const f32x4*)(p + 4 * lane + 256 * j);
}
__device__ __forceinline__ void row_store(float* p, int lane, const f32x4 (&v)[4]) {
#pragma unroll
    for (int j = 0; j < 4; ++j) *(f32x4*)(p + 4 * lane + 256 * j) = v[j];
}
__device__ __forceinline__ void row_ln(f32x4 (&v)[4]) {
    float s = 0.f;
#pragma unroll
    for (int j = 0; j < 4; ++j) s += (v[j][0] + v[j][1]) + (v[j][2] + v[j][3]);
    const float mean = wave_sum(s) * (1.f / DM); float q = 0.f;
#pragma unroll
    for (int j = 0; j < 4; ++j) { v[j] = v[j] - mean; q += (v[j][0] * v[j][0] + v[j][1] * v[j][1]) + (v[j][2] * v[j][2] + v[j][3] * v[j][3]); }
    const float rstd = 1.f / sqrtf(wave_sum(q) * (1.f / DM) + LN_EPS);
#pragma unroll
    for (int j = 0; j < 4; ++j) v[j] = v[j] * rstd;
}
__device__ __forceinline__ void row_affine(f32x4 (&v)[4], const float* scale1p  , bool plus1, const float* shift, int lane) {
#pragma unroll
    for (int j = 0; j < 4; ++j) { const f32x4 sc = *(const f32x4*)(scale1p + 4 * lane + 256 * j), sh = *(const f32x4*)(shift + 4 * lane + 256 * j);
        v[j] = plus1 ? v[j] * (sc + 1.0f) + sh : v[j] * sc + sh; }
}
__device__ __forceinline__ void row_store_bf16(bf16_t* p, int lane, const f32x4 (&v)[4]) {
#pragma unroll
    for (int j = 0; j < 4; ++j) { u32x2 w; w.x = pk2(v[j][0], v[j][1]); w.y = pk2(v[j][2], v[j][3]); *(u32x2*)(p + 4 * lane + 256 * j) = w; }
}

__device__ __forceinline__ void phase_rows0(const Frame& F, CArgsP a) {
    const float* mod = (const float*)(F.ws + WS_MOD); float* xc = (float*)(F.ws + WS_XC); bf16_t* H = (bf16_t*)(F.ws + WS_H);
    for (int tok = F.gw; tok < T; tok += F.NGW) {
        const int b = tok / TPB, j = tok - b * TPB; const bool isc = j < CTX;
        const float* src = isc ? a->in[2] + (size_t)(b * CTX + j) * DM : a->in[0] + (size_t)(b * SEQ + j - CTX) * DM;
        f32x4 v[4]; row_load(src, F.lane, v);
        row_store(resid_row(F.out, xc, tok), F.lane, v);
        row_ln(v);
        const float* mrow = mod + (isc ? 4 : b) * 6144;
        row_affine(v, mrow + 1024, true, mrow, F.lane);
        row_store_bf16(H + (size_t)tok * DM, F.lane, v);
    }
}

__device__ __forceinline__ void sg_item(const Frame& F, CArgsP a, int l, int chunk, int g) {
    LAS bf16_t* vgT = (LAS bf16_t*)F.lds;
    const bf16_t* Sb = (const bf16_t*)(F.ws + OV_S); const bf16_t* Ub = (const bf16_t*)(F.ws + OV_U); bf16_t* OB = (bf16_t*)(F.ws + OV_OB);
    const int tok0 = chunk * 128;
    { const int q = F.tid >> 2, qt = F.tid & 3;
      const bf16_t* sp = Sb + (size_t)(tok0 + q) * 512 + g * 128 + qt * 32;
      float x[32];
#pragma unroll
      for (int i = 0; i < 4; ++i) { const u32x4 w = *(const u32x4*)(sp + 8 * i);
          x[8 * i + 0] = bflo(w.x); x[8 * i + 1] = bfhi(w.x); x[8 * i + 2] = bflo(w.y); x[8 * i + 3] = bfhi(w.y); x[8 * i + 4] = bflo(w.z); x[8 * i + 5] = bfhi(w.z); x[8 * i + 6] = bflo(w.w); x[8 * i + 7] = bfhi(w.w); }
      float s = 0.f;
#pragma unroll
      for (int i = 0; i < 32; ++i) s += x[i];
      s += __shfl_xor(s, 1); s += __shfl_xor(s, 2); const float mean = s * (1.f / 128.f); float qq = 0.f;
#pragma unroll
      for (int i = 0; i < 32; ++i) { x[i] -= mean; qq += x[i] * x[i]; }
      qq += __shfl_xor(qq, 1); qq += __shfl_xor(qq, 2); const float rstd = 1.f / sqrtf(qq * (1.f / 128.f) + LN_EPS);
      const float* lg = a->in[13] + l * 512 + g * 128 + qt * 32; const float* lb = a->in[14] + l * 512 + g * 128 + qt * 32;
#pragma unroll
      for (int i = 0; i < 32; ++i) vgT[(qt * 32 + i) * 136 + q] = (bf16_t)f2bf(x[i] * rstd * lg[i] + lb[i]);
    }
    __syncthreads();
    const int w = F.wave, fr = F.lane & 15, fq = F.lane >> 4;
    bf16x8 af[4];
#pragma unroll
    for (int ks = 0; ks < 4; ++ks) af[ks] = *(const LAS bf16x8*)(vgT + (w * 16 + fr) * 136 + ks * 32 + fq * 8);
    const bf16_t* W = (const bf16_t*)(F.ws + WS_WSG) + (size_t)(l * 4 + g) * 16384;
    const float* bs = a->in[16] + (l * 4 + g) * 128;
#pragma unroll 2
    for (int n = 0; n < 8; ++n) {
        f32x4 d = {0.f, 0.f, 0.f, 0.f};
#pragma unroll
        for (int ks = 0; ks < 4; ++ks) { const bf16x8 bfv = *(const bf16x8*)(W + (n * 16 + fr) * 128 + ks * 32 + fq * 8); d = __builtin_amdgcn_mfma_f32_16x16x32_bf16(af[ks], bfv, d, 0, 0, 0); }
        const int p = n * 16 + fr, c0 = w * 16 + fq * 4; const float bsp = bs[p];
        const size_t off = (size_t)(tok0 + p) * 512 + g * 128 + c0;
        const u32x2 uu = *(const u32x2*)(Ub + off);
        u32x2 o; o.x = pk2(bflo(uu.x) * (d[0] + bsp), bfhi(uu.x) * (d[1] + bsp)); o.y = pk2(bflo(uu.y) * (d[2] + bsp), bfhi(uu.y) * (d[3] + bsp));
        *(u32x2*)(OB + off) = o;
    }
    __syncthreads();
}

__device__ __forceinline__ void lru_item(const Frame& F, CArgsP a, int l, int b, int chunk, int cb, int mode) {
    LAS float* xin = (LAS float*)F.lds;
    LAS float* xs = (LAS float*)(F.lds + 17408);
    LAS bf16_t* xsb = (LAS bf16_t*)(F.lds + 33792);
    LAS float* gt = (LAS float*)(F.lds + 43008);
    LAS float* sg = (LAS float*)(F.lds + 108544);
    const bf16_t* Xb = (const bf16_t*)(F.ws + OV_X); const bf16_t* Yb = (const bf16_t*)(F.ws + OV_Y); bf16_t* OC = (bf16_t*)(F.ws + OV_OC);
    const int tok0 = b * TPB + chunk * 64, ch0 = cb * 64;
    const int seg_lo = chunk < 4 ? 0 : 256, seg_hi = chunk < 4 ? 256 : TPB, j0 = chunk * 64;
    for (int i = F.tid; i < 67 * 64; i += NTHR) { const int r = i >> 6, c = i & 63, j = j0 + r - 2;
        xin[i] = (j >= seg_lo && j < seg_hi) ? bf2f(Xb[(size_t)(b * TPB + j) * 512 + ch0 + c]) : 0.f; }
    __syncthreads();
    { const int c = F.tid & 63; const float* cw = a->in[17] + l * 2048 + ch0 + c; const float w0 = cw[0], w1 = cw[512], w2 = cw[1024], w3 = cw[1536], cbv = a->in[18][l * 512 + ch0 + c];
      for (int t = F.tid >> 6; t < 64; t += 8) { const float v = w0 * xin[t * 64 + c] + w1 * xin[(t + 1) * 64 + c] + w2 * xin[(t + 2) * 64 + c] + w3 * xin[(t + 3) * 64 + c] + cbv;
          xs[t * 64 + c] = v; xsb[t * 72 + c] = (bf16_t)f2bf(v); } }
    __syncthreads();
    {
      const int w = F.wave, mat = w >> 1, fr = F.lane & 15, fq = F.lane >> 4;
      const bf16_t* Wt = (const bf16_t*)(F.ws + WS_WLRU) + (size_t)((l * 4 + mat) * 8 + cb) * 4096;
      const float* bias = (mat & 1) ? a->in[22] : a->in[20];
      const int d = mat >> 1;
#pragma unroll
      for (int nn = 0; nn < 2; ++nn) { const int n = (w & 1) * 2 + nn;
          const bf16x8 b0 = *(const bf16x8*)(Wt + (n * 16 + fr) * 64 + fq * 8), b1 = *(const bf16x8*)(Wt + (n * 16 + fr) * 64 + 32 + fq * 8);
          const float bv = bias[(l * 2 + d) * 512 + ch0 + n * 16 + fr];
#pragma unroll
          for (int m = 0; m < 4; ++m) {
              const bf16x8 a0 = *(const LAS bf16x8*)(xsb + (m * 16 + fr) * 72 + fq * 8), a1 = *(const LAS bf16x8*)(xsb + (m * 16 + fr) * 72 + 32 + fq * 8);
              f32x4 dd = {0.f, 0.f, 0.f, 0.f};
              dd = __builtin_amdgcn_mfma_f32_16x16x32_bf16(a0, b0, dd, 0, 0, 0); dd = __builtin_amdgcn_mfma_f32_16x16x32_bf16(a1, b1, dd, 0, 0, 0);
#pragma unroll
              for (int r = 0; r < 4; ++r) gt[mat * 4096 + (m * 16 + fq * 4 + r) * 64 + n * 16 + fr] = sigmoidf_(dd[r] + bv);
          } } }
    __syncthreads();
    { const int c = F.tid & 63;
#pragma unroll
      for (int d = 0; d < 2; ++d) { const float lamv = a->in[23][(l * 2 + d) * 512 + ch0 + c]; const float sp = log1pf(expf(-lamv));
          for (int t = F.tid >> 6; t < 64; t += 8) { const float r = gt[(d * 2) * 4096 + t * 64 + c], ig = gt[(d * 2 + 1) * 4096 + t * 64 + c];
              const float la = -8.0f * r * sp; const float av = expf(la); const float bv = sqrtf(-expm1f(2.0f * la)) * (ig * xs[t * 64 + c]);
              gt[(d * 2) * 4096 + t * 64 + c] = av; gt[(d * 2 + 1) * 4096 + t * 64 + c] = bv; } } }
    __syncthreads();
    const int c = F.tid & 63, d = (F.tid >> 6) & 1, sgm = F.tid >> 7;
    LAS float* aL = gt + (d * 2) * 4096; LAS float* bL = gt + (d * 2 + 1) * 4096;
    { float A = 1.f, h = 0.f;
#pragma unroll 4
      for (int k = 0; k < 16; ++k) { const int pos = d == 0 ? sgm * 16 + k : 63 - (sgm * 16 + k); const float av = aL[pos * 64 + c]; h = av * h + bL[pos * 64 + c]; A *= av; }
      sg[(d * 4 + sgm) * 64 + c] = A; sg[512 + (d * 4 + sgm) * 64 + c] = h; }
    __syncthreads();
    if (mode == 0) {
        if (sgm == 0) { float A = 1.f, h = 0.f;
#pragma unroll
            for (int s = 0; s < 4; ++s) { const float As = sg[(d * 4 + s) * 64 + c], Hs = sg[512 + (d * 4 + s) * 64 + c]; h = As * h + Hs; A *= As; }
            float* sum = (float*)(F.ws + WS_SUM) + ((size_t)((b * 2 + d) * 68 + chunk) * 512 + ch0 + c) * 2; sum[0] = A; sum[1] = h; }
        __syncthreads();
        return;
    }
    { float h = ((const float*)(F.ws + WS_HIN))[(size_t)((b * 2 + d) * 68 + chunk) * 512 + ch0 + c];
#pragma unroll
      for (int s = 0; s < 3; ++s) if (s < sgm) h = sg[(d * 4 + s) * 64 + c] * h + sg[512 + (d * 4 + s) * 64 + c];
#pragma unroll 4
      for (int k = 0; k < 16; ++k) { const int pos = d == 0 ? sgm * 16 + k : 63 - (sgm * 16 + k); h = aL[pos * 64 + c] * h + bL[pos * 64 + c]; bL[pos * 64 + c] = h; } }
    __syncthreads();
    for (int i = F.tid; i < 64 * 16; i += NTHR) { const int t = i >> 4, c4 = (i & 15) * 4; const size_t off = (size_t)(tok0 + t) * 512 + ch0 + c4;
        const u32x2 y = *(const u32x2*)(Yb + off); const f32x4 hf = *(const LAS f32x4*)(gt + 4096 + t * 64 + c4), hb = *(const LAS f32x4*)(gt + 3 * 4096 + t * 64 + c4);
        u32x2 o; o.x = pk2(bflo(y.x) * (hf[0] + hb[0]), bfhi(y.x) * (hf[1] + hb[1])); o.y = pk2(bflo(y.y) * (hf[2] + hb[2]), bfhi(y.y) * (hf[3] + hb[3]));
        *(u32x2*)(OC + off) = o; }
    __syncthreads();
}

__device__ __forceinline__ void phase_carry(const Frame& F) {
    const int gt = F.bid * NTHR + F.tid; if (gt >= 4 * 2 * 512) return;
    const int c = gt & 511, d = (gt >> 9) & 1, b = gt >> 10;
    const float* sum = (const float*)(F.ws + WS_SUM) + (size_t)((b * 2 + d) * 68) * 1024 + c * 2;
    float* hin = (float*)(F.ws + WS_HIN) + (size_t)((b * 2 + d) * 68) * 512 + c;
    float h = 0.f;
#pragma unroll 1
    for (int g0 = 0; g0 < 68; g0 += 17) {
        float A[17], Hh[17];
#pragma unroll
        for (int i = 0; i < 17; ++i) { const int o = g0 + i; const int ck = d == 0 ? o : (o < 4 ? 3 - o : 71 - o); const float2 v = *(const float2*)(sum + (size_t)ck * 1024); A[i] = v.x; Hh[i] = v.y; }
#pragma unroll
        for (int i = 0; i < 17; ++i) { const int o = g0 + i; const int ck = d == 0 ? o : (o < 4 ? 3 - o : 71 - o); hin[(size_t)ck * 512] = h; h = A[i] * h + Hh[i]; }
    }
}

constexpr int AT_KST = 272, AT_VST = 320;
constexpr int AT_KOFF = 0, AT_VOFF = 2 * 64 * AT_KST, AT_XOFF = AT_VOFF + 2 * 64 * AT_VST;
__device__ __forceinline__ void attn_unit(const Frame& F, int tokq0, int tokk0, int ntiles, int h, float lam, const float* gain, float oscale) {
    const bf16_t* Q = (const bf16_t*)(F.ws + OV_Q); const bf16_t* Kg = (const bf16_t*)(F.ws + OV_K); const bf16_t* Vg = (const bf16_t*)(F.ws + OV_V); bf16_t* OA = (bf16_t*)(F.ws + OV_OA);
    const int lane = F.lane, r32 = lane & 31, hi = lane >> 5, rb = F.wave >> 1, c = F.wave & 1;
    constexpr float SC = 0.125f * 1.4426950408889634f, THR = 8.0f;
    bf16x8 qr[4];
    { const bf16_t* qp = Q + (size_t)(tokq0 + rb * 32 + r32) * 512 + h * 128 + c * 64 + hi * 8;
#pragma unroll
      for (int ks = 0; ks < 4; ++ks) qr[ks] = *(const bf16x8*)(qp + ks * 16); }
    const int srow0 = F.tid >> 4, sch = F.tid & 15;
    const bf16_t* kgp = Kg + (size_t)(tokk0 + srow0) * 512 + h * 128 + sch * 8;
    const bf16_t* vgp = Vg + (size_t)(tokk0 + srow0) * 512 + h * 128 + sch * 8;
    LAS unsigned char* kl = F.lds + AT_KOFF + srow0 * AT_KST + sch * 16;
    LAS unsigned char* vl = F.lds + AT_VOFF + srow0 * AT_VST + sch * 16;
    u32x4 kreg0, kreg1, vreg0, vreg1;
    kreg0 = *(const u32x4*)(kgp); kreg1 = *(const u32x4*)(kgp + 32 * 512); vreg0 = *(const u32x4*)(vgp); vreg1 = *(const u32x4*)(vgp + 32 * 512);
    *(LAS u32x4*)(kl) = kreg0; *(LAS u32x4*)(kl + 32 * AT_KST) = kreg1; *(LAS u32x4*)(vl) = vreg0; *(LAS u32x4*)(vl + 32 * AT_VST) = vreg1;
    __syncthreads();
    float mrun = -1e30f, lrun = 0.f;
    f32x16 o[4];
#pragma unroll
    for (int db = 0; db < 4; ++db)
#pragma unroll
        for (int r = 0; r < 16; ++r) o[db][r] = 0.f;
    const LAS unsigned char* kfb = F.lds + AT_KOFF + r32 * AT_KST + (c * 64 + hi * 8) * 2;
    const LAS unsigned char* vfb = F.lds + AT_VOFF + (4 * hi + ((lane & 15) >> 2)) * AT_VST + (((lane >> 4) & 1) * 16 + (lane & 3) * 4) * 2;
#pragma unroll 1
    for (int t = 0; t < ntiles; ++t) {
        const int cur = t & 1; const bool more = t + 1 < ntiles;
        if (more) { const size_t go = (size_t)(t + 1) * 64 * 512; kreg0 = *(const u32x4*)(kgp + go); kreg1 = *(const u32x4*)(kgp + go + 32 * 512); vreg0 = *(const u32x4*)(vgp + go); vreg1 = *(const u32x4*)(vgp + go + 32 * 512); }
        f32x16 p0, p1;
#pragma unroll
        for (int r = 0; r < 16; ++r) { p0[r] = 0.f; p1[r] = 0.f; }
        const LAS unsigned char* kf = kfb + cur * (64 * AT_KST);
#pragma unroll
        for (int ks = 0; ks < 4; ++ks) {
            const bf16x8 a0 = *(const LAS bf16x8*)(kf + ks * 32), a1 = *(const LAS bf16x8*)(kf + 32 * AT_KST + ks * 32);
            p0 = __builtin_amdgcn_mfma_f32_32x32x16_bf16(a0, qr[ks], p0, 0, 0, 0);
            p1 = __builtin_amdgcn_mfma_f32_32x32x16_bf16(a1, qr[ks], p1, 0, 0, 0);
        }
        float tm = fmaxf(p0[0], p1[0]);
#pragma unroll
        for (int r = 1; r < 16; ++r) tm = fmaxf(tm, fmaxf(p0[r], p1[r]));
        tm = fmaxf(tm, __shfl_xor(tm, 32)) * SC;
        if (__any(tm > mrun + THR)) {
            const float mn = fmaxf(mrun, tm); const float al = exp2f(mrun - mn);
#pragma unroll
            for (int db = 0; db < 4; ++db)
#pragma unroll
                for (int r = 0; r < 16; ++r) o[db][r] *= al;
            lrun *= al; mrun = mn;
        }
        const float nm = -mrun; float ls = 0.f;
#pragma unroll
        for (int r = 0; r < 16; ++r) { p0[r] = exp2f(__builtin_fmaf(p0[r], SC, nm)); p1[r] = exp2f(__builtin_fmaf(p1[r], SC, nm)); ls += p0[r] + p1[r]; }
        lrun += ls;
        bf16x8 pf[4];
        { u32x4 w;
          w.x = pk2(p0[0], p0[1]); w.y = pk2(p0[2], p0[3]); w.z = pk2(p0[4], p0[5]); w.w = pk2(p0[6], p0[7]); pf[0] = __builtin_bit_cast(bf16x8, w);
          w.x = pk2(p0[8], p0[9]); w.y = pk2(p0[10], p0[11]); w.z = pk2(p0[12], p0[13]); w.w = pk2(p0[14], p0[15]); pf[1] = __builtin_bit_cast(bf16x8, w);
          w.x = pk2(p1[0], p1[1]); w.y = pk2(p1[2], p1[3]); w.z = pk2(p1[4], p1[5]); w.w = pk2(p1[6], p1[7]); pf[2] = __builtin_bit_cast(bf16x8, w);
          w.x = pk2(p1[8], p1[9]); w.y = pk2(p1[10], p1[11]); w.z = pk2(p1[12], p1[13]); w.w = pk2(p1[14], p1[15]); pf[3] = __builtin_bit_cast(bf16x8, w); }
        const LAS unsigned char* vf = vfb + cur * (64 * AT_VST);
#pragma unroll
        for (int db = 0; db < 4; ++db)
#pragma unroll
            for (int kk = 0; kk < 4; ++kk) {
                const LAS unsigned char* vp = vf + (kk * 16) * AT_VST + db * 64;
                const s16x4 lo = __builtin_bit_cast(s16x4, __builtin_amdgcn_ds_read_tr16_b64_v4i16((LAS s16x4*)(vp)));
                const s16x4 hh = __builtin_bit_cast(s16x4, __builtin_amdgcn_ds_read_tr16_b64_v4i16((LAS s16x4*)(vp + 8 * AT_VST)));
                const bf16x8 vfr = {lo[0], lo[1], lo[2], lo[3], hh[0], hh[1], hh[2], hh[3]};
                o[db] = __builtin_amdgcn_mfma_f32_32x32x16_bf16(vfr, pf[kk], o[db], 0, 0, 0);
            }
        if (more) { const int nb = cur ^ 1;
            *(LAS u32x4*)(kl + nb * (64 * AT_KST)) = kreg0; *(LAS u32x4*)(kl + nb * (64 * AT_KST) + 32 * AT_KST) = kreg1;
            *(LAS u32x4*)(vl + nb * (64 * AT_VST)) = vreg0; *(LAS u32x4*)(vl + nb * (64 * AT_VST) + 32 * AT_VST) = vreg1; }
        __syncthreads();
    }
    lrun += __shfl_xor(lrun, 32);
    const float il = 1.f / lrun;
    LAS float* ex = (LAS float*)(F.lds + AT_XOFF) + rb * 4096;
    if (c == 1) {
#pragma unroll
        for (int db = 0; db < 4; ++db)
#pragma unroll
            for (int r = 0; r < 16; ++r) ex[(db * 16 + r) * 64 + lane] = o[db][r] * il;
    }
    __syncthreads();
    if (c == 0) {
        float ss = 0.f;
#pragma unroll
        for (int db = 0; db < 4; ++db)
#pragma unroll
            for (int r = 0; r < 16; ++r) { const float dv = o[db][r] * il - lam * ex[(db * 16 + r) * 64 + lane]; o[db][r] = dv; ss += dv * dv; }
        ss += __shfl_xor(ss, 32);
        const float rinv = oscale / sqrtf(ss * (1.f / 128.f) + RMS_EPS);
        bf16_t* op = OA + (size_t)(tokq0 + rb * 32 + r32) * 512 + h * 128;
#pragma unroll
        for (int db = 0; db < 4; ++db)
#pragma unroll
            for (int r4 = 0; r4 < 4; ++r4) { const int dv0 = db * 32 + 8 * r4 + 4 * hi; const f32x4 gv = *(const f32x4*)(gain + dv0);
                u32x2 w; w.x = pk2(o[db][4 * r4] * rinv * gv[0], o[db][4 * r4 + 1] * rinv * gv[1]); w.y = pk2(o[db][4 * r4 + 2] * rinv * gv[2], o[db][4 * r4 + 3] * rinv * gv[3]);
                *(u32x2*)(op + dv0) = w; }
    }
    __syncthreads();
}

__device__ __forceinline__ void phase_attn(const Frame& F, CArgsP a, int l) {
    const float lam = ((const float*)(F.ws + WS_LAM))[l]; const float li = 0.8f - 0.6f * expf(-0.3f * (float)l);
    for (int it = F.bid; it < 4 * 68 * 8; it += F.G) { const int cb = it & 7, r = it >> 3, chunk = r % 68, b = r / 68;
        if (l == 1 && chunk < 4) continue;
        lru_item(F, a, l, b, chunk, cb, 1); }
    const int nlat = 4 * 4 * 32, nctx = (l == 0) ? 4 * 4 * 2 : 0;
    for (int it = F.bid; it < nlat + nctx; it += F.G) {
        int b, h, qb, tq0, nt;
        if (it < nlat) { qb = it & 31; h = (it >> 5) & 3; b = it >> 7; tq0 = b * TPB + CTX + qb * 128; nt = 68; }
        else { const int i2 = it - nlat; qb = i2 & 1; h = (i2 >> 1) & 3; b = i2 >> 3; tq0 = b * TPB + qb * 128; nt = 4; }
        attn_unit(F, tq0, b * TPB, nt, h, lam, a->in[12] + (l * 4 + h) * 128, 1.0f - li);
    }
}

__device__ __forceinline__ void phase_router(const Frame& F, CArgsP a, int l) {
    const float* mod = (const float*)(F.ws + WS_MOD) + l * 5 * 6144; float* xc = (float*)(F.ws + WS_XC); bf16_t* H = (bf16_t*)(F.ws + WS_H);
    LAS float* hs = (LAS float*)(F.lds + F.wave * 16384);
    const float* Wr = a->in[28] + (size_t)l * 1024 * 64; const float rb_ = a->in[29][l * 64 + F.lane];
    unsigned* cnt = (unsigned*)(F.ws + WS_CNT) + l * 64; int* list = (int*)(F.ws + WS_LIST);
    int* toke = (int*)(F.ws + WS_TOKE); int* tokp = (int*)(F.ws + WS_TOKP); float* tokw = (float*)(F.ws + WS_TOKW);
    const int nrows = l == 0 ? T : NBATCH * SEQ, ngroups = nrows / 4;
    for (int grp = F.gw; grp < ngroups; grp += F.NGW) {
        int toks[4];
#pragma unroll
        for (int r = 0; r < 4; ++r) { const int ridx = grp * 4 + r; const int tok = l == 0 ? ridx : (ridx >> 12) * TPB + CTX + (ridx & 4095); toks[r] = tok;
            const int b = tok / TPB; const int bsel = (tok - b * TPB) < CTX ? 4 : b;
            float* xr = resid_row(F.out, xc, tok);
            f32x4 v[4]; row_load(xr, F.lane, v); row_ln(v); row_affine(v, a->in[26] + l * DM, false, a->in[27] + l * DM, F.lane); row_store(xr, F.lane, v);
            row_ln(v); const float* mrow = mod + bsel * 6144; row_affine(v, mrow + 4096, true, mrow + 3072, F.lane);
            row_store_bf16(H + (size_t)tok * DM, F.lane, v);
#pragma unroll
            for (int j = 0; j < 4; ++j) *(LAS f32x4*)(hs + r * 1024 + 4 * F.lane + 256 * j) = v[j];
        }
        LDS_WAIT();
        float acc[4] = {0.f, 0.f, 0.f, 0.f};
#pragma unroll 2
        for (int k4 = 0; k4 < 256; ++k4) {
            const float w0 = Wr[(4 * k4) * 64 + F.lane], w1 = Wr[(4 * k4 + 1) * 64 + F.lane], w2 = Wr[(4 * k4 + 2) * 64 + F.lane], w3 = Wr[(4 * k4 + 3) * 64 + F.lane];
#pragma unroll
            for (int r = 0; r < 4; ++r) { const f32x4 hv = *(const LAS f32x4*)(hs + r * 1024 + 4 * k4); acc[r] += hv[0] * w0 + hv[1] * w1 + hv[2] * w2 + hv[3] * w3; }
        }
#pragma unroll
        for (int r = 0; r < 4; ++r) {
            const float s = 1.f / (1.f + expf(-acc[r])); const float bsc = s + rb_;
            float m1 = bsc; m1 = fmaxf(m1, __shfl_xor(m1, 1)); m1 = fmaxf(m1, __shfl_xor(m1, 2)); m1 = fmaxf(m1, __shfl_xor(m1, 4));
            const unsigned long long eq = __ballot(bsc == m1); const unsigned gm = (unsigned)(eq >> (F.lane & ~7)) & 0xffu; const int first = __ffs(gm) - 1;
            float m2 = ((F.lane & 7) == first) ? -INFINITY : bsc; m2 = fmaxf(m2, __shfl_xor(m2, 1)); m2 = fmaxf(m2, __shfl_xor(m2, 2)); m2 = fmaxf(m2, __shfl_xor(m2, 4));
            const float gs = m1 + m2; const int myg = F.lane >> 3; int grank = 0;
#pragma unroll
            for (int g = 0; g < 8; ++g) { const float og = __shfl(gs, g * 8); grank += (og > gs || (og == gs && g < myg)) ? 1 : 0; }
            const bool gsel = grank < 4; const float mk = gsel ? bsc : -INFINITY; int rk = 0;
#pragma unroll
            for (int j = 0; j < 64; ++j) { const float vj = __shfl(mk, j); rk += (vj > mk || (vj == mk && j < F.lane)) ? 1 : 0; }
            const bool sel = gsel && rk < 8;
            const float ssum = wave_sum(sel ? s : 0.f);
            if (sel) { const int tok = toks[r]; const unsigned pos = atomicAdd(cnt + F.lane, 1u);
                list[(size_t)F.lane * T + pos] = tok; toke[tok * 8 + rk] = F.lane; tokp[tok * 8 + rk] = (int)pos; tokw[tok * 8 + rk] = s / ssum * 2.5f; }
        }
        LDS_WAIT();
    }
}

__device__ __forceinline__ void build_tables(const Frame& F, int l) {
    LAS int* tb = (LAS int*)(F.lds + LDS_CTL);
    __syncthreads();
    if (F.tid < 64) tb[LC_TCNT + F.tid] = (int)__hip_atomic_load((unsigned*)(F.ws + WS_CNT) + l * 64 + F.tid, __ATOMIC_RELAXED, __HIP_MEMORY_SCOPE_AGENT);
    __syncthreads();
    if (F.tid == 0) { int tbs = 0, sbs = 0;
        for (int e = 0; e < 64; ++e) { const int c = tb[LC_TCNT + e]; tb[LC_TBASE + e] = tbs; tb[LC_SBASE + e] = sbs; tbs += (c + 255) >> 8; sbs += c; }
        tb[LC_TBASE + 64] = tbs; tb[LC_SBASE + 64] = sbs; }
    __syncthreads();
}

__device__ __forceinline__ void phase_combine(const Frame& F, CArgsP a, int l) {
    const float* mod = (const float*)(F.ws + WS_MOD) + l * 5 * 6144; float* xc = (float*)(F.ws + WS_XC); bf16_t* H = (bf16_t*)(F.ws + WS_H);
    const bf16_t* YS = (const bf16_t*)(F.ws + OV_YS); const LAS int* tb = (const LAS int*)(F.lds + LDS_CTL);
    const int* toke = (const int*)(F.ws + WS_TOKE); const int* tokp = (const int*)(F.ws + WS_TOKP); const float* tokw = (const float*)(F.ws + WS_TOKW);
    const int nrows = l == 0 ? T : NBATCH * SEQ;
    for (int ridx = F.gw; ridx < nrows; ridx += F.NGW) {
        const int tok = l == 0 ? ridx : (ridx >> 12) * TPB + CTX + (ridx & 4095);
        const int b = tok / TPB; const int bsel = (tok - b * TPB) < CTX ? 4 : b;
        int me = 0, mp = 0; float mw = 0.f;
        if (F.lane < 8) { me = toke[tok * 8 + F.lane]; mp = tokp[tok * 8 + F.lane]; mw = tokw[tok * 8 + F.lane]; }
        f32x4 y[4];
        { const bf16_t* sp = H + (size_t)tok * DM;
#pragma unroll
          for (int j = 0; j < 4; ++j) { const u32x2 w = *(const u32x2*)(sp + 4 * F.lane + 256 * j); y[j] = (f32x4){bflo(w.x), bfhi(w.x), bflo(w.y), bfhi(w.y)}; } }
#pragma unroll
        for (int k = 0; k < 8; ++k) { const int e = __shfl(me, k), p = __shfl(mp, k); const float wv = __shfl(mw, k);
            const bf16_t* yp = YS + (size_t)(tb[LC_SBASE + e] + p) * DM;
#pragma unroll
            for (int j = 0; j < 4; ++j) { const u32x2 w = *(const u32x2*)(yp + 4 * F.lane + 256 * j); y[j][0] += wv * bflo(w.x); y[j][1] += wv * bfhi(w.x); y[j][2] += wv * bflo(w.y); y[j][3] += wv * bfhi(w.y); } }
        float* xr = resid_row(F.out, xc, tok);
        f32x4 v[4]; row_load(xr, F.lane, v);
        const float* g2 = mod + bsel * 6144 + 5120;
#pragma unroll
        for (int j = 0; j < 4; ++j) { const f32x4 gv = *(const f32x4*)(g2 + 4 * F.lane + 256 * j); v[j] = v[j] * DN_ALPHA + gv * y[j]; }
        row_ln(v); row_affine(v, a->in[36] + l * DM, false, a->in[37] + l * DM, F.lane); row_store(xr, F.lane, v);
        if (l == 0) { row_ln(v); const float* mrow = mod + 5 * 6144 + bsel * 6144; row_affine(v, mrow + 1024, true, mrow, F.lane); row_store_bf16(H + (size_t)tok * DM, F.lane, v); }
    }
}

constexpr int NPHASE = 22;
__global__ void __launch_bounds__(NTHR, 2) mk_fwd(Args args) {
    extern __shared__ __attribute__((aligned(16))) unsigned char lds_raw[];
    Frame F; F.lds = (LAS unsigned char*)lds_raw; F.tid = threadIdx.x; F.lane = F.tid & 63; F.wave = __builtin_amdgcn_readfirstlane(F.tid >> 6);
    F.G = gridDim.x; F.bid = blockIdx.x; F.gw = F.bid * NWAVES + F.wave; F.NGW = F.G * NWAVES; F.ws = args.ws; F.out = args.out;
    for (int u = F.tid; u < (LDS_BYTES - LDS_CTL) / 4; u += NTHR) ((LAS unsigned*)(F.lds + LDS_CTL))[u] = 0u;
    __syncthreads();
    const int lo = args.ph_lo, hi = args.ph_hi;
    CArgsP A4 = (CArgsP)__builtin_amdgcn_kernarg_segment_ptr();
    XcdBarrier bar; bar.bar = (unsigned*)(F.ws + CW_BAR_BYTE); bar.x = 0; bar.st = nullptr;
    if (hi - lo > 1) bar = xcd_barrier_post((unsigned*)(F.ws + CW_BAR_BYTE), (volatile LAS unsigned*)(F.lds + LDS_CTL) + LC_BAR);
#ifndef PHMASK
#define PHMASK 0xfff
#endif
#define PH_EN(k) ((PHMASK >> ((k) < 2 ? (k) : 2 + (((k) - 2) % 10))) & 1)
#define IN(k) (PH_EN(k) && lo <= (k) && (k) < hi)
#define SEAM(k) do { if (IN(k) && IN((k) + 1)) xcd_barrier(bar); FRESH(); } while (0)
#define FRESH() do { int t_ = threadIdx.x, b_ = blockIdx.x; CArgsP p_ = (CArgsP)__builtin_amdgcn_kernarg_segment_ptr(); asm volatile("" : "+v"(t_)); asm volatile("" : "+s"(b_), "+s"(p_)); A4 = p_; unsigned char* w_ = p_->ws; float* o_ = p_->out; \
    F.tid = t_; F.lane = t_ & 63; F.wave = __builtin_amdgcn_readfirstlane(t_ >> 6); F.bid = b_; F.gw = b_ * NWAVES + F.wave; F.ws = w_; F.out = o_; } while (0)
    if (IN(0)) { phase_prologue(F, A4); } SEAM(0);
    if (IN(1)) { phase_rows0(F, A4); } SEAM(1);
#pragma unroll 1
    for (int l = 0; l < 2; ++l) {
        const int pb = 2 + 10 * l; const bool lat = (l == 1);
        if (IN(pb + 0)) {
            SchedPlain S{(const char*)(F.ws + WS_H), (const char*)(F.ws + WS_WIN) + (size_t)l * INC * 1024 * 2, 1024, 68, 26, F.G, F.bid, false};
            EpiInproj E{F.ws, A4->in[7] + l * INC, (const float*)(F.ws + WS_ROPE)};
            pg8::gemm_phase(F.lds, 1024, S, E);
        } SEAM(pb + 0);
        if (IN(pb + 1)) {
            for (int it = F.bid; it < 4 * 68 * 8; it += F.G) { const int cb = it & 7, r = it >> 3; lru_item(F, A4, l, r / 68, r % 68, cb, 0); }
            for (int it = F.bid; it < 136 * 4; it += F.G) { const int chunk = it >> 2; if (lat && (chunk % 34) < 2) continue; sg_item(F, A4, l, chunk, it & 3); }
        } SEAM(pb + 1);
        if (IN(pb + 2)) { phase_carry(F); } SEAM(pb + 2);
        if (IN(pb + 3)) { phase_attn(F, A4, l); } SEAM(pb + 3);
        if (IN(pb + 4)) {
#pragma unroll 1
            for (int r = 0; r < 3; ++r) {
                SchedPlain S{(const char*)(F.ws + OV_OA + (size_t)r * 17 * MiB), (const char*)(F.ws + WS_WBR) + (size_t)(l * 3 + r) * 1024 * 512 * 2, 512, lat ? 64 : 68, 4, F.G, F.bid, lat};
                EpiMerge E{(bf16_t*)(F.ws + OV_MG), (const bf16_t*)(F.ws + OV_G), r};
                pg8::gemm_phase(F.lds, 512, S, E);
            }
        } SEAM(pb + 4);
        if (IN(pb + 5)) {
            SchedPlain S{(const char*)(F.ws + OV_MG), (const char*)(F.ws + WS_WOUT) + (size_t)l * 1048576 * 2, 1024, lat ? 64 : 68, 4, F.G, F.bid, lat};
            EpiWout E{F.out, (float*)(F.ws + WS_XC), (const float*)(F.ws + WS_MOD) + l * 5 * 6144};
            pg8::gemm_phase(F.lds, 1024, S, E);
        } SEAM(pb + 5);
        if (IN(pb + 6)) { phase_router(F, A4, l); } SEAM(pb + 6);
        if (IN(pb + 7)) {
            build_tables(F, l);
            SchedMoe S{(const char*)(F.ws + WS_H), (const char*)(F.ws + WS_H), (const char*)(F.ws + WS_WM1), (const char*)(F.ws + WS_WSH1) + (size_t)l * 524288 * 2,
                       (const int*)(F.ws + WS_LIST), (const LAS int*)(F.lds + LDS_CTL), 1024, 2, F.G, F.bid, lat ? 64 : 68, lat, true, (size_t)524288 * 2};
            EpiMoe1 E{(bf16_t*)(F.ws + OV_ACT), (bf16_t*)(F.ws + OV_ACTSH)};
            pg8::gemm_phase(F.lds, 1024, S, E);
        } SEAM(pb + 7);
        if (IN(pb + 8)) {
            build_tables(F, l);
            SchedMoe S{(const char*)(F.ws + OV_ACT), (const char*)(F.ws + OV_ACTSH), (const char*)(F.ws + WS_WM2), (const char*)(F.ws + WS_WSH2) + (size_t)l * 262144 * 2,
                       (const int*)(F.ws + WS_LIST), (const LAS int*)(F.lds + LDS_CTL), 256, 4, F.G, F.bid, lat ? 64 : 68, lat, false, (size_t)262144 * 2};
            EpiMoe2 E{(bf16_t*)(F.ws + OV_YS), (bf16_t*)(F.ws + WS_H)};
            pg8::gemm_phase(F.lds, 256, S, E);
        } SEAM(pb + 8);
        if (IN(pb + 9)) {
            build_tables(F, l);
            phase_combine(F, A4, l);
            if (l == 0) conv_moe_layer(F, A4, 1);
        } SEAM(pb + 9);
    }
#undef IN
#undef SEAM
}

extern "C" void kernel_launch(void* const* d_in, const int* in_sizes, int n_in, void* d_out, int out_size, void* d_ws, size_t ws_size, hipStream_t stream) {
    static int grid = 0;
    if (grid == 0) {
        if (n_in != 38 || out_size != NBATCH * SEQ * DM || ws_size < WS_END) { fprintf(stderr, "kernel_launch: unexpected shapes (n_in %d out %d ws %zu need %zu)\n", n_in, out_size, ws_size, (size_t)WS_END); grid = -1; return; }
        int dev = 0, cus = 0;
        if (hipGetDevice(&dev) != hipSuccess || hipDeviceGetAttribute(&cus, hipDeviceAttributeMultiprocessorCount, dev) != hipSuccess) { grid = -1; return; }
        if (hipFuncSetAttribute((const void*)mk_fwd, hipFuncAttributeMaxDynamicSharedMemorySize, LDS_BYTES) != hipSuccess) { fprintf(stderr, "kernel_launch: hipFuncSetAttribute failed\n"); grid = -1; return; }
        int per_cu = 0;
        if (hipOccupancyMaxActiveBlocksPerMultiprocessor(&per_cu, (const void*)mk_fwd, NTHR, LDS_BYTES) != hipSuccess || per_cu < 1) fprintf(stderr, "kernel_launch: occupancy query says %d\n", per_cu);
        (void)hipGetLastError();
        grid = cus;
    }
    if (grid < 0) return;
    (void)hipMemsetAsync((char*)d_ws + WS_CTL, 0, CTL_ZERO_BYTES, stream);
    Args a{};
    for (int i = 0; i < 38; ++i) a.in[i] = (const float*)d_in[i];
    a.out = (float*)d_out; a.ws = (unsigned char*)d_ws;
#if MK_MULTI
    for (int p = 0; p < NPHASE; ++p) { a.ph_lo = p; a.ph_hi = p + 1; hipLaunchKernelGGL(mk_fwd, dim3(grid), dim3(NTHR), LDS_BYTES, stream, a); }
#else
    a.ph_lo = 0; a.ph_hi = NPHASE; hipLaunchKernelGGL(mk_fwd, dim3(grid), dim3(NTHR), LDS_BYTES, stream, a);
#endif
}
```

```cpp
#include <hip/hip_runtime.h>
#include <cstdio>
#include <cstdint>
#include <cmath>

#ifndef MK_MULTI
#define MK_MULTI 0
#endif
#ifndef DUPMASK
#define DUPMASK 0
#endif
#define NDUP(c) (1 + ((DUPMASK >> (c)) & 1))
#ifndef TSMASK
#define TSMASK 0
#endif
#ifndef NAIVE_GEMM
#define NAIVE_GEMM 0
#endif

#define LAS __attribute__((address_space(3)))
#define GAS __attribute__((address_space(1)))
typedef unsigned short bf16_t;
typedef short bf16x8 __attribute__((ext_vector_type(8)));
typedef short s16x4 __attribute__((ext_vector_type(4)));
typedef float f32x4 __attribute__((ext_vector_type(4)));
typedef float f32x16 __attribute__((ext_vector_type(16)));
typedef unsigned u32x4 __attribute__((ext_vector_type(4)));
typedef unsigned u32x2 __attribute__((ext_vector_type(2)));

constexpr int DM = 1024, NBATCH = 4, SEQ = 4096, CTX = 256, TPB = SEQ + CTX  , T = NBATCH * TPB  ;
constexpr int INC = 6656, NEXP = 64;
constexpr float DN_ALPHA = 1.41421356237309515f;
constexpr float LN_EPS = 1e-6f, RMS_EPS = 1e-5f;
constexpr int NWAVES = 8, NTHR = 512;

constexpr size_t MiB = 1u << 20;
constexpr size_t WS_CTL = 0, CTL_ZERO_BYTES = 1 * MiB;
constexpr size_t CW_BAR_BYTE = 16384;
constexpr size_t WS_CNT = 65536;
constexpr size_t WS_MOD = 131072;
constexpr size_t WS_ROPE = 1 * MiB;
constexpr size_t WS_LAM = 1 * MiB + 8192;
constexpr size_t WS_SUM = 1 * MiB + 65536;
constexpr size_t WS_HIN = WS_SUM + 2304 * 1024;
constexpr size_t WS_TOKE = 5 * MiB, WS_TOKP = 6 * MiB, WS_TOKW = 7 * MiB;
constexpr size_t WS_LIST = 8 * MiB;
constexpr size_t WS_XC = 13 * MiB;
constexpr size_t WS_WLRU = 17 * MiB;
constexpr size_t WS_WSG = 17 * MiB + 512 * 1024;
constexpr size_t WS_WRT = 17 * MiB + 768 * 1024;
constexpr size_t WS_WSH1 = 18 * MiB;
constexpr size_t WS_WSH2 = 20 * MiB;
constexpr size_t WS_WOUT = 21 * MiB;
constexpr size_t WS_WBR = 25 * MiB;
constexpr size_t WS_WIN = 31 * MiB;
constexpr size_t WS_WM1 = 57 * MiB;
constexpr size_t WS_WM2 = 121 * MiB;
constexpr size_t WS_H = 153 * MiB;
constexpr size_t WS_OV = 187 * MiB;
constexpr size_t OV_Q = WS_OV, OV_K = WS_OV + 17 * MiB, OV_V = WS_OV + 34 * MiB, OV_U = WS_OV + 51 * MiB, OV_S = WS_OV + 68 * MiB,
                 OV_X = WS_OV + 85 * MiB, OV_Y = WS_OV + 102 * MiB, OV_G = WS_OV + 119 * MiB, OV_OA = WS_OV + 221 * MiB,
                 OV_OB = WS_OV + 238 * MiB, OV_OC = WS_OV + 255 * MiB, OV_MG = WS_OV + 272 * MiB;
constexpr size_t OV_ACT = WS_OV, OV_ACTSH = WS_OV + 69 * MiB, OV_YS = WS_OV + 78 * MiB;
constexpr size_t WS_END = WS_OV + 350 * MiB;

constexpr int LDS_SCRATCH = 147456;
constexpr int LDS_CTL = LDS_SCRATCH;
constexpr int LDS_BYTES = LDS_SCRATCH + 4096;
constexpr int LC_BAR = 0;
constexpr int LC_TCNT = 64, LC_TBASE = 64 + 80, LC_SBASE = 64 + 160;

struct Args { const float* in[38]; float* out; unsigned char* ws; int ph_lo, ph_hi; };
typedef const Args __attribute__((address_space(4)))* CArgsP;

__device__ __forceinline__ unsigned f2bf(float f) { unsigned u = __builtin_bit_cast(unsigned, f); return (u + 0x7fffu + ((u >> 16) & 1u)) >> 16; }
typedef float f32x2 __attribute__((ext_vector_type(2))); typedef __bf16 bf16x2_t __attribute__((ext_vector_type(2)));
__device__ __forceinline__ unsigned pk2(float lo, float hi) { const f32x2 v = {lo, hi}; const bf16x2_t b = __builtin_convertvector(v, bf16x2_t); return __builtin_bit_cast(unsigned, b); }
__device__ __forceinline__ float bflo(unsigned w) { return __builtin_bit_cast(float, w << 16); }
__device__ __forceinline__ float bfhi(unsigned w) { return __builtin_bit_cast(float, w & 0xffff0000u); }
__device__ __forceinline__ float bf2f(bf16_t b) { return __builtin_bit_cast(float, (unsigned)b << 16); }
__device__ __forceinline__ float wave_sum(float v) {
#pragma unroll
    for (int o = 1; o < 64; o <<= 1) v += __shfl_xor(v, o);
    return v;
}
__device__ __forceinline__ float sigmoidf_(float x) { return 1.f / (1.f + __expf(-x)); }
__device__ __forceinline__ float gelu_tanh(float x) { const float u = 0.7978845608028654f * (x + 0.044715f * x * x * x); return x / (1.f + __expf(-2.f * u)); }
__device__ __forceinline__ float silu_(float x) { return x / (1.f + __expf(-x)); }
__device__ __forceinline__ float expm1_fast(float x) {
    if (x > -0.5f && x < 0.5f) { float p = 1.0f + x * (1.0f / 8.0f); p = 1.0f + x * (1.0f / 7.0f) * p; p = 1.0f + x * (1.0f / 6.0f) * p; p = 1.0f + x * 0.2f * p; p = 1.0f + x * 0.25f * p; p = 1.0f + x * (1.0f / 3.0f) * p; p = 1.0f + x * 0.5f * p; return x * p; }
    return expm1f(x);
}
#define LDS_WAIT() asm volatile("s_waitcnt lgkmcnt(0)" ::: "memory")
#define VM_WAIT() asm volatile("s_waitcnt vmcnt(0)" ::: "memory")

#define XB_TMO      128
#define XB_XCNT(j)  (256  + 64 * (j))
#define XB_XSUB(j)  (1280 + 64 * (j))
#define XB_XGEN(j)  (2304 + 64 * (j))
#define XB_TOP      3328
#define XB_TOPGEN   3392
#define XCD_BAR_WORDS 3456
#define XB_SPIN_CAP (1u << 22)
__device__ __forceinline__ unsigned xb_ld(unsigned* p)              { return __hip_atomic_load(p, __ATOMIC_RELAXED, __HIP_MEMORY_SCOPE_AGENT); }
__device__ __forceinline__ unsigned xb_add(unsigned* p, unsigned v) { return __hip_atomic_fetch_add(p, v, __ATOMIC_RELAXED, __HIP_MEMORY_SCOPE_AGENT); }
__device__ __forceinline__ unsigned xb_xcc_id() { return (unsigned)__builtin_amdgcn_s_getreg((3 << 11) | 20) & 0xFu; }
#define XB_SPIN(cond, bar) do { unsigned _sp = 0; while (cond) { __builtin_amdgcn_s_sleep(1); \
    if ((++_sp & 255u) == 0u) { if (xb_ld(&(bar)[XB_TMO])) break; if (_sp > XB_SPIN_CAP) { atomicAdd(&(bar)[XB_TMO], 1u); break; } } } } while (0)
struct XcdBarrier { unsigned* bar; unsigned x; volatile LAS unsigned* st; };
__device__ __forceinline__ XcdBarrier xcd_barrier_post(unsigned* bar, volatile LAS unsigned* st) {
    XcdBarrier b; b.bar = bar; b.x = xb_xcc_id(); b.st = st;
    if (threadIdx.x == 0) (void)xb_add(&bar[XB_XCNT(b.x)], 1u);
    return b;
}
__device__ __forceinline__ void xcd_barrier_complete(unsigned* bar, unsigned x, unsigned& nloc, unsigned& nx) {
    const unsigned G = gridDim.x * gridDim.y * gridDim.z;
    unsigned sum, cnt, mine, sp = 0u;
    for (;;) {
        sum = 0u; cnt = 0u; mine = 0u;
#pragma unroll
        for (unsigned j = 0; j < 16; ++j) { const unsigned c = xb_ld(&bar[XB_XCNT(j)]); sum += c; cnt += (c > 0u) ? 1u : 0u; mine = (j == x) ? c : mine; }
        if (sum == G) break;
        __builtin_amdgcn_s_sleep(1);
        if ((++sp & 255u) == 0u) { if (xb_ld(&bar[XB_TMO])) break; if (sp > XB_SPIN_CAP) { atomicAdd(&bar[XB_TMO], 1u); break; } }
    }
    nloc = mine > 0u ? mine : 1u; nx = cnt > 0u ? cnt : 1u;
}
__device__ __forceinline__ void xcd_barrier(const XcdBarrier& b) {
    asm volatile("s_waitcnt vmcnt(0)" ::: "memory");
    __syncthreads();
    if (threadIdx.x == 0) {
        unsigned* bar = b.bar; asm volatile("" : "+s"(bar));
        __builtin_amdgcn_s_waitcnt(0);
        unsigned nloc = b.st[0], nx = b.st[1];
        if (nloc == 0u) { xcd_barrier_complete(bar, b.x, nloc, nx); b.st[0] = nloc; b.st[1] = nx; }
        const unsigned old = xb_add(&bar[XB_XSUB(b.x)], 1u);
        const unsigned gen = old / nloc;
        if (old + 1u == (gen + 1u) * nloc) {
            __builtin_amdgcn_fence(__ATOMIC_RELEASE, "agent");
            asm volatile("s_waitcnt vmcnt(0)" ::: "memory");
            const unsigned og = xb_add(&bar[XB_TOP], 1u);
            const unsigned tg = og / nx;
            if (og + 1u == (tg + 1u) * nx) xb_add(&bar[XB_TOPGEN], 1u);
            else XB_SPIN(xb_ld(&bar[XB_TOPGEN]) == tg, bar);
            __builtin_amdgcn_fence(__ATOMIC_ACQUIRE, "agent");
            xb_add(&bar[XB_XGEN(b.x)], 1u);
            asm volatile("s_waitcnt vmcnt(0)" ::: "memory");
        } else {
            XB_SPIN(xb_ld(&bar[XB_XGEN(b.x)]) == gen, bar);
            __builtin_amdgcn_fence(__ATOMIC_ACQUIRE, "agent");
            asm volatile("s_waitcnt vmcnt(0)" ::: "memory");
        }
    }
    __syncthreads();
}

namespace pg8 {
constexpr int BM = 256, BK = 64, HALF = 128, HTB = HALF * BK * 2, STAGE_BYTES = 8 * HTB, NXCD = 8, WGM = 8;
__host__ __device__ __forceinline__ int lds_byte(int r, int c) { const int st = (r >> 4) * 2 + (c >> 5), rr = r & 15, cc = c & 31, ob = rr * 64 + cc * 2; return st * 1024 + (ob ^ (((ob >> 9) & 1) << 5)); }
__host__ __device__ __forceinline__ void stage_rc(int b, int& R, int& C) { const int st = b / 1024, sb = b % 1024, swz = sb ^ (((sb >> 9) & 1) << 5); R = (st >> 1) * 16 + swz / 64; C = (st & 1) * 32 + (swz % 64) / 2; }
struct Unit { int pm, pn, e, ti, nrows, row0; };
typedef f32x4 Acc[2][2][4][2];

template <class Epi, class Sched>
__device__ __forceinline__ void gemm_phase(LAS unsigned char* lds, const int K, const Sched& S, const Epi& E) {
    int tid_ = threadIdx.x; asm volatile("" : "+v"(tid_));
    const int tid = tid_, wid = __builtin_amdgcn_readfirstlane(tid >> 6), lane = tid & 63, wr = wid >> 2, wc = wid & 3, fr = lane & 15, fq = lane >> 4;
    (void)fr; (void)fq; (void)wc;
    Unit cur, nxt; int ui = 0;
    if (!S.next(0, cur)) return;
    Acc acc;
#pragma unroll
    for (int a = 0; a < 2; ++a)
#pragma unroll
        for (int b = 0; b < 2; ++b)
#pragma unroll
            for (int m = 0; m < 4; ++m)
#pragma unroll
                for (int n = 0; n < 2; ++n) acc[a][b][m][n] = (f32x4){0.f, 0.f, 0.f, 0.f};
#if NAIVE_GEMM
    for (;;) {
        const char* Ab = S.a_base(); const char* Bb = S.b_ptr(cur);
#pragma unroll 1
        for (int ai = 0; ai < 2; ++ai)
#pragma unroll 1
            for (int m = 0; m < 4; ++m) {
                const int rr = ai * 128 + wr * 64 + m * 16 + fr;
                const bf16_t* ap = (const bf16_t*)(Ab + S.a_off(cur, rr));
#pragma unroll
                for (int bj = 0; bj < 2; ++bj)
#pragma unroll
                    for (int n = 0; n < 2; ++n)
#pragma unroll
                        for (int j = 0; j < 4; ++j) {
                            const int cc = bj * 128 + wc * 32 + n * 16 + fq * 4 + j;
                            const bf16_t* bp = (const bf16_t*)(Bb + (size_t)cc * K * 2);
                            float s = 0.f;
                            for (int k = 0; k < K; k += 8) {
                                const u32x4 av = *(const u32x4*)(ap + k), bv = *(const u32x4*)(bp + k);
                                s += bflo(av.x) * bflo(bv.x) + bfhi(av.x) * bfhi(bv.x) + bflo(av.y) * bflo(bv.y) + bfhi(av.y) * bfhi(bv.y)
                                   + bflo(av.z) * bflo(bv.z) + bfhi(av.z) * bfhi(bv.z) + bflo(av.w) * bflo(bv.w) + bfhi(av.w) * bfhi(bv.w);
                            }
                            acc[ai][bj][m][n][j] = s;
                        }
            }
        E(acc, cur, wr, wc, fr, fq);
        ++ui;
        if (!S.next(ui, cur)) break;
    }
    return;
#else
    const int nt = K / BK;
    unsigned voffB[2];
    { int Rr[2], Cc[2];
#pragma unroll
      for (int i = 0; i < 2; ++i) { stage_rc(tid * 16 + i * 8192, Rr[i], Cc[i]); voffB[i] = (unsigned)(Rr[i] * K + Cc[i]) * 2u; } }
#define PG8_AOFFS(U, o00, o01, o10, o11) do { int t3_ = threadIdx.x; asm volatile("" : "+v"(t3_)); int R0_, C0_, R1_, C1_; stage_rc(t3_ * 16, R0_, C0_); stage_rc(t3_ * 16 + 8192, R1_, C1_); \
        o00 = S.a_off(U, R0_) + (unsigned)C0_ * 2u; o01 = S.a_off(U, R1_) + (unsigned)C1_ * 2u; o10 = S.a_off(U, HALF + R0_) + (unsigned)C0_ * 2u; o11 = S.a_off(U, HALF + R1_) + (unsigned)C1_ * 2u; } while (0)
    const size_t kstep = (size_t)(BK * 2);
    const size_t hstep = (size_t)HALF * K * 2;
    const unsigned ldsw = (unsigned)wid * 1024u;
    const int aoff = lds_byte(wr * 64 + fr, fq * 8), boff = lds_byte(wc * 32 + fr, fq * 8);
#define PG8_SA(b, h) (((b) * 2 + (h)) * HTB)
#define PG8_SB(b, h) ((4 + (b) * 2 + (h)) * HTB)
#define PG8_STAGE(bufoff, gbase, v0, v1) do { \
        __builtin_amdgcn_global_load_lds((const unsigned*)((const char*)(gbase) + (v0)), (LAS unsigned*)(lds + (bufoff) + ldsw), 16, 0, 0); \
        __builtin_amdgcn_global_load_lds((const unsigned*)((const char*)(gbase) + (v1)), (LAS unsigned*)(lds + (bufoff) + ldsw + 8192), 16, 0, 0); } while (0)
#define PG8_LDA(dst, b, h) do { _Pragma("unroll") for (int m = 0; m < 4; ++m) _Pragma("unroll") for (int k = 0; k < 2; ++k) dst[m][k] = *(const LAS bf16x8*)(lds + PG8_SA(b, h) + aoff + m * 2048 + k * 1024); } while (0)
#define PG8_LDB(dst, b, h) do { _Pragma("unroll") for (int n = 0; n < 2; ++n) _Pragma("unroll") for (int k = 0; k < 2; ++k) dst[n][k] = *(const LAS bf16x8*)(lds + PG8_SB(b, h) + boff + n * 2048 + k * 1024); } while (0)
#define PG8_MMA(ai, bj, At, Bt) do { __builtin_amdgcn_s_setprio(1); _Pragma("unroll") for (int m = 0; m < 4; ++m) _Pragma("unroll") for (int n = 0; n < 2; ++n) _Pragma("unroll") for (int k = 0; k < 2; ++k) \
        acc[ai][bj][m][n] = __builtin_amdgcn_mfma_f32_16x16x32_bf16(Bt[n][k], At[m][k], acc[ai][bj][m][n], 0, 0, 0); __builtin_amdgcn_s_setprio(0); } while (0)
#define PG8_WAIT_V(n) asm volatile("s_waitcnt vmcnt(" #n ")" ::: "memory")
#define PG8_WAIT_L(n) asm volatile("s_waitcnt lgkmcnt(" #n ")" ::: "memory")
#define PG8_BAR __builtin_amdgcn_s_barrier()
#define PG8_SCHED __builtin_amdgcn_sched_barrier(0)
    bf16x8 At[4][2], B0[2][2], B1[2][2];
    const char* const Ab = S.a_base();
    unsigned vA00, vA01, vA10, vA11;
    PG8_AOFFS(cur, vA00, vA01, vA10, vA11);
    const char* cB = S.b_ptr(cur);
    PG8_STAGE(PG8_SB(0, 0), cB, voffB[0], voffB[1]); PG8_STAGE(PG8_SB(0, 1), cB + hstep, voffB[0], voffB[1]); PG8_STAGE(PG8_SA(0, 0), Ab, vA00, vA01); PG8_STAGE(PG8_SA(0, 1), Ab, vA10, vA11);
    if (wr == 1) PG8_BAR;
    PG8_WAIT_V(2); PG8_BAR;
    PG8_STAGE(PG8_SB(1, 0), cB + kstep, voffB[0], voffB[1]); PG8_STAGE(PG8_SA(1, 0), Ab + kstep, vA00, vA01); PG8_STAGE(PG8_SB(1, 1), cB + hstep + kstep, voffB[0], voffB[1]);
    PG8_WAIT_V(6); PG8_BAR;
    for (;;) {
        const bool has_next = S.next(ui + 1, nxt);
        unsigned vN00 = vA00, vN01 = vA01, vN10 = vA10, vN11 = vA11; const char* nB = cB;
        if (has_next) { PG8_AOFFS(nxt, vN00, vN01, vN10, vN11); nB = S.b_ptr(nxt); }
        for (int t = 0; t < nt; t += 2) {
            const bool last = (t == nt - 2);
            const char* a1 = Ab + (size_t)(t + 1) * kstep;
            const char* a2 = last ? Ab : Ab + (size_t)(t + 2) * kstep; const char* b2 = last ? nB : cB + (size_t)(t + 2) * kstep;
            const char* a3 = a2 + kstep; const char* b3 = b2 + kstep;
            const unsigned w00 = last ? vN00 : vA00, w01 = last ? vN01 : vA01, w10 = last ? vN10 : vA10, w11 = last ? vN11 : vA11;
            PG8_LDB(B0, 0, 0); PG8_LDB(B1, 0, 1); PG8_SCHED; PG8_LDA(At, 0, 0); PG8_STAGE(PG8_SA(1, 1), a1, vA10, vA11);
            PG8_WAIT_V(8); PG8_WAIT_L(0); PG8_BAR; PG8_MMA(0, 0, At, B0); PG8_MMA(0, 1, At, B1); PG8_BAR; PG8_SCHED;
            PG8_LDA(At, 0, 1); PG8_STAGE(PG8_SB(0, 0), b2, voffB[0], voffB[1]); PG8_STAGE(PG8_SB(0, 1), b2 + hstep, voffB[0], voffB[1]); PG8_STAGE(PG8_SA(0, 0), a2, w00, w01);
            PG8_WAIT_V(8); PG8_WAIT_L(0); PG8_BAR; PG8_MMA(1, 0, At, B0); PG8_MMA(1, 1, At, B1); PG8_BAR; PG8_SCHED;
            PG8_LDB(B0, 1, 0); PG8_LDB(B1, 1, 1); PG8_SCHED; PG8_LDA(At, 1, 0); PG8_STAGE(PG8_SA(0, 1), a2, w10, w11);
            PG8_WAIT_V(8); PG8_WAIT_L(0); PG8_BAR; PG8_MMA(0, 0, At, B0); PG8_MMA(0, 1, At, B1); PG8_BAR; PG8_SCHED;
            PG8_LDA(At, 1, 1); PG8_STAGE(PG8_SB(1, 0), b3, voffB[0], voffB[1]); PG8_STAGE(PG8_SB(1, 1), b3 + hstep, voffB[0], voffB[1]); PG8_STAGE(PG8_SA(1, 0), a3, w00, w01);
            PG8_WAIT_V(8); PG8_WAIT_L(0); PG8_BAR; PG8_MMA(1, 0, At, B0); PG8_MMA(1, 1, At, B1); PG8_BAR; PG8_SCHED;
        }
        if (wr == 0) PG8_BAR;
        { int t2_ = threadIdx.x; asm volatile("" : "+v"(t2_)); const int l2_ = t2_ & 63; E(acc, cur, wr, wc, l2_ & 15, l2_ >> 4); }
        if (!has_next) break;
#pragma unroll
        for (int a = 0; a < 2; ++a)
#pragma unroll
            for (int b = 0; b < 2; ++b)
#pragma unroll
                for (int m = 0; m < 4; ++m)
#pragma unroll
                    for (int n = 0; n < 2; ++n) acc[a][b][m][n] = (f32x4){0.f, 0.f, 0.f, 0.f};
        cur = nxt; vA00 = vN00; vA01 = vN01; vA10 = vN10; vA11 = vN11; cB = nB; ++ui;
        if (wr == 1) PG8_BAR;
    }
    PG8_WAIT_V(0);
    PG8_BAR;
#undef PG8_SA
#undef PG8_AOFFS
#undef PG8_SB
#undef PG8_STAGE
#undef PG8_LDA
#undef PG8_LDB
#undef PG8_MMA
#undef PG8_WAIT_V
#undef PG8_WAIT_L
#undef PG8_BAR
#undef PG8_SCHED
#endif
}
}
using pg8::Unit;
using pg8::Acc;

__device__ __forceinline__ float* resid_row(float* out, float* xc, int tok) {
    const int b = tok / TPB, j = tok - b * TPB;
    return j < CTX ? xc + ((size_t)(b * CTX + j)) * DM : out + ((size_t)(b * SEQ + j - CTX)) * DM;
}
__device__ __forceinline__ int tile_to_pm(int i, bool latent_only) { return latent_only ? (i >> 4) * 17 + 1 + (i & 15) : i; }

__device__ __forceinline__ bool static_order(int i, int G, int c, int nM, int nN, int& pm, int& pn) {
    const int nwg = nM * nN; const long L = (long)i * G + c; if (L >= nwg) return false;
    int wgid = (int)L; { const int q = nwg / 8, r = nwg % 8, xcd = wgid % 8, off = wgid / 8; wgid = (xcd < r ? xcd * (q + 1) : r * (q + 1) + (xcd - r) * q) + off; }
    const int nig = 8 * nN, gid = wgid / nig, fm = gid * 8, gsz = (nM - fm) < 8 ? (nM - fm) : 8;
    pm = fm + ((wgid % nig) % gsz); pn = (wgid % nig) / gsz; return true;
}

struct SchedPlain {
    const char* A; const char* Bt; int K, nM, nN, G, c; bool lat;
    __device__ __forceinline__ bool next(int i, Unit& u) const {
        int pm, pn; if (!static_order(i, G, c, nM, nN, pm, pn)) return false;
        u.pm = tile_to_pm(pm, lat); u.pn = pn; u.e = 0; u.ti = 0; u.nrows = 256; u.row0 = u.pm * 256; return true;
    }
    __device__ __forceinline__ const char* a_base() const { return A; }
    __device__ __forceinline__ unsigned a_off(const Unit& u, int rr) const { return (unsigned)(u.row0 + rr) * (unsigned)(K * 2); }
    __device__ __forceinline__ const char* b_ptr(const Unit& u) const { return Bt + (size_t)u.pn * 256 * K * 2; }
};

struct SchedMoe {
    const char* A;
    const char* Ash;
    const char* Bt; const char* Btsh; const int* list;
    const LAS int* tb;
    int K, nN, G, c, nsh; bool lat, gather; size_t bstride;
    __device__ __forceinline__ bool next(int i, Unit& u) const {
        const int nrt = tb[LC_TBASE + 64], L = i * G + c, tot = (nrt + nsh) * nN;
        if (L >= tot) return false;
        const int rt = L / nN; u.pn = L - rt * nN;
        if (rt < nrt) {
            int e = 0;
#pragma unroll 1
            for (int s = 32; s > 0; s >>= 1) if (e + s < 64 && tb[LC_TBASE + e + s] <= rt) e += s;
            u.e = e; u.ti = rt - tb[LC_TBASE + e]; const int cnt = tb[LC_TCNT + e]; const int rem = cnt - u.ti * 256;
            u.nrows = rem < 256 ? rem : 256; u.row0 = tb[LC_SBASE + e] + u.ti * 256; u.pm = 0;
        } else { u.e = 64; u.ti = rt - nrt; u.pm = tile_to_pm(u.ti, lat); u.nrows = 256; u.row0 = u.pm * 256; }
        return true;
    }
    __device__ __forceinline__ const char* a_base() const { return A; }
    __device__ __forceinline__ unsigned a_off(const Unit& u, int rr) const {
        if (u.e == 64) return (unsigned)(Ash - A) + (unsigned)(u.row0 + rr) * (unsigned)(K * 2);
        if (gather) { const int r2 = rr < u.nrows ? rr : u.nrows - 1; const int tok = list[(size_t)u.e * T + u.ti * 256 + r2]; return (unsigned)tok * (unsigned)(K * 2); }
        return (unsigned)(u.row0 + rr) * (unsigned)(K * 2);
    }
    __device__ __forceinline__ const char* b_ptr(const Unit& u) const { return (u.e == 64 ? Btsh : Bt + (size_t)u.e * bstride) + (size_t)u.pn * 256 * K * 2; }
};

#define EPI_FOR_ROWS  _Pragma("unroll") for (int ai = 0; ai < 2; ++ai) _Pragma("unroll") for (int m = 0; m < 4; ++m)
#define EPI_FOR_COLS  _Pragma("unroll") for (int bj = 0; bj < 2; ++bj) _Pragma("unroll") for (int n = 0; n < 2; ++n)

struct EpiInproj {
    unsigned char* ws; const float* bias; const float* rope;
    __device__ __forceinline__ void operator()(const Acc& acc, const Unit& u, int wr, int wc, int fr, int fq) const {
        const int pn = u.pn; const bool isg = pn >= 14; const int seg = pn >> 1;
        bf16_t* base = (bf16_t*)(ws + (isg ? OV_G : OV_Q + (size_t)seg * 17 * MiB));
        const int ld = isg ? 3072 : 512, coff = isg ? (pn - 14) * 256 : (pn & 1) * 256;
        const bool latent = (u.pm % 17) != 0;
        f32x4 bv[2][2];
        EPI_FOR_COLS bv[bj][n] = *(const f32x4*)(bias + pn * 256 + bj * 128 + wc * 32 + n * 16 + fq * 4);
        EPI_FOR_ROWS {
            const int row = u.row0 + ai * 128 + wr * 64 + m * 16 + fr;
            bf16_t* rp = base + (size_t)row * ld + coff + wc * 32 + fq * 4;
            f32x4 v[2][2];
            EPI_FOR_COLS v[bj][n] = acc[ai][bj][m][n] + bv[bj][n];
            if (seg < 2 && !isg) {
                if (latent) {
                    const int pos = (row % TPB) - CTX; const int pa = (wc & 1) ? (pos & 63) : (pos >> 6);
                    const f32x4 c0 = *(const f32x4*)(rope + (pa * 16 + fq * 4) * 2), c1 = *(const f32x4*)(rope + (pa * 16 + fq * 4) * 2 + 4);
                    const float cs[4] = {c0[0], c0[2], c1[0], c1[2]}, sn[4] = {c0[1], c0[3], c1[1], c1[3]};
#pragma unroll
                    for (int bj = 0; bj < 2; ++bj)
#pragma unroll
                        for (int j = 0; j < 4; ++j) { const float a = v[bj][0][j], b = v[bj][1][j]; v[bj][0][j] = a * cs[j] - b * sn[j]; v[bj][1][j] = b * cs[j] + a * sn[j]; }
                }
            } else if (isg) {
                EPI_FOR_COLS {
#pragma unroll
                    for (int j = 0; j < 4; ++j) v[bj][n][j] = sigmoidf_(v[bj][n][j]); }
            } else if (seg == 3 || seg == 4 || seg == 6) {
                EPI_FOR_COLS {
#pragma unroll
                    for (int j = 0; j < 4; ++j) v[bj][n][j] = gelu_tanh(v[bj][n][j]); }
            }
            EPI_FOR_COLS { u32x2 w; w.x = pk2(v[bj][n][0], v[bj][n][1]); w.y = pk2(v[bj][n][2], v[bj][n][3]); *(u32x2*)(rp + bj * 128 + n * 16) = w; }
        }
    }
};

struct EpiMerge {
    bf16_t* mg; const bf16_t* gate; int r;
    __device__ __forceinline__ void operator()(const Acc& acc, const Unit& u, int wr, int wc, int fr, int fq) const {
        EPI_FOR_ROWS {
            const int row = u.row0 + ai * 128 + wr * 64 + m * 16 + fr;
            EPI_FOR_COLS {
                const int col = u.pn * 256 + bj * 128 + wc * 32 + n * 16 + fq * 4;
                const u32x2 g = *(const u32x2*)(gate + (size_t)row * 3072 + r * 1024 + col);
                f32x4 v = acc[ai][bj][m][n]; v[0] *= bflo(g.x); v[1] *= bfhi(g.x); v[2] *= bflo(g.y); v[3] *= bfhi(g.y);
                u32x2* mp = (u32x2*)(mg + (size_t)row * DM + col);
                if (r > 0) { const u32x2 o = *mp; v[0] += bflo(o.x); v[1] += bfhi(o.x); v[2] += bflo(o.y); v[3] += bfhi(o.y); }
                u32x2 w; w.x = pk2(v[0], v[1]); w.y = pk2(v[2], v[3]); *mp = w;
            }
        }
    }
};

struct EpiWout {
    float* out; float* xc; const float* modl; bool dry;
    __device__ __forceinline__ void operator()(const Acc& acc, const Unit& u, int wr, int wc, int fr, int fq) const {
        const int b = u.pm / 17; const int bsel = (u.pm % 17) == 0 ? 4 : b;
        const float* g1 = modl + bsel * 6144 + 2048;
        f32x4 gv[2][2];
        EPI_FOR_COLS gv[bj][n] = *(const f32x4*)(g1 + u.pn * 256 + bj * 128 + wc * 32 + n * 16 + fq * 4);
        EPI_FOR_ROWS {
            const int row = u.row0 + ai * 128 + wr * 64 + m * 16 + fr;
            float* rp = resid_row(out, xc, row) + u.pn * 256 + wc * 32 + fq * 4;
            EPI_FOR_COLS { f32x4* p = (f32x4*)(rp + bj * 128 + n * 16); const f32x4 x = *p; const f32x4 y = x * DN_ALPHA + gv[bj][n] * acc[ai][bj][m][n]; if (!dry) *p = y; else asm volatile("" :: "v"(y)); }
        }
    }
};

struct EpiMoe1 {
    bf16_t* act; bf16_t* actsh;
    __device__ __forceinline__ void operator()(const Acc& acc, const Unit& u, int wr, int wc, int fr, int fq) const {
        bf16_t* base = u.e == 64 ? actsh : act;
        EPI_FOR_ROWS {
            const int rl = ai * 128 + wr * 64 + m * 16 + fr;
            if (rl < u.nrows) {
                bf16_t* rp = base + (size_t)(u.row0 + rl) * 256 + u.pn * 128 + wc * 32 + fq * 4;
#pragma unroll
                for (int n = 0; n < 2; ++n) {
                    const f32x4 g = acc[ai][0][m][n], p = acc[ai][1][m][n];
                    u32x2 w; w.x = pk2(silu_(g[0]) * p[0], silu_(g[1]) * p[1]); w.y = pk2(silu_(g[2]) * p[2], silu_(g[3]) * p[3]);
                    *(u32x2*)(rp + n * 16) = w;
                }
            }
        }
    }
};

struct EpiMoe2 {
    bf16_t* ys; bf16_t* sho;
    __device__ __forceinline__ void operator()(const Acc& acc, const Unit& u, int wr, int wc, int fr, int fq) const {
        bf16_t* base = u.e == 64 ? sho : ys;
        EPI_FOR_ROWS {
            const int rl = ai * 128 + wr * 64 + m * 16 + fr;
            if (rl < u.nrows) {
                bf16_t* rp = base + (size_t)(u.row0 + rl) * DM + u.pn * 256 + wc * 32 + fq * 4;
                EPI_FOR_COLS { const f32x4 v = acc[ai][bj][m][n]; u32x2 w; w.x = pk2(v[0], v[1]); w.y = pk2(v[2], v[3]); *(u32x2*)(rp + bj * 128 + n * 16) = w; }
            }
        }
    }
};

struct Frame {
    LAS unsigned char* lds; int tid, lane, wave, G, bid, gw, NGW;
    unsigned char* ws; float* out;
};

__device__ __forceinline__ void transpose_item(const float* W, int ldw, int k0, int n0, bf16_t* WT, int ldt, int drow0, LAS float* scr, int lane) {
#pragma unroll 8
    for (int i = 0; i < 32; ++i) { const int kk = 2 * i + (lane >> 5); scr[kk * 33 + (lane & 31)] = W[(size_t)(k0 + kk) * ldw + n0 + (lane & 31)]; }
    LDS_WAIT(); asm volatile("" ::: "memory");
    const int c = lane & 7;
#pragma unroll
    for (int j = 0; j < 4; ++j) { const int n = (lane >> 3) + 8 * j; const LAS float* s = scr + (8 * c) * 33 + n;
        u32x4 o; o.x = pk2(s[0 * 33], s[1 * 33]); o.y = pk2(s[2 * 33], s[3 * 33]); o.z = pk2(s[4 * 33], s[5 * 33]); o.w = pk2(s[6 * 33], s[7 * 33]);
        *(u32x4*)(WT + (size_t)(drow0 + n) * ldt + k0 + 8 * c) = o; }
    LDS_WAIT(); asm volatile("" ::: "memory");
}
__device__ __forceinline__ void conv_expert_item(const float* wg, const float* wu, const float* wd, bf16_t* t1, bf16_t* t2, int which, int rr, LAS float* scr, int lane) {
    if (which < 2) { const int kb = rr >> 3, nb = rr & 7, n0 = 32 * nb;
        transpose_item(which == 0 ? wg : wu, 256, 64 * kb, n0, t1, 1024, (n0 >> 7) * 256 + (n0 & 127) + which * 128, scr, lane);
    } else { const int kb = rr >> 5, nb = rr & 31; transpose_item(wd, 1024, 64 * kb, 32 * nb, t2, 256, 32 * nb, scr, lane); }
}
__device__ __forceinline__ void conv_moe_layer(const Frame& F, CArgsP a, int l) {
    LAS float* scr = (LAS float*)(F.lds + F.wave * 8704);
    for (int it = F.gw; it < 64 * 3 * 128; it += F.NGW) {
        const int idx = it >> 7, e = idx / 3, which = idx - e * 3, rr = it & 127; const size_t eo = (size_t)(l * 64 + e) * 262144;
        conv_expert_item(a->in[30] + eo, a->in[31] + eo, a->in[32] + eo, (bf16_t*)(F.ws + WS_WM1) + (size_t)e * 524288, (bf16_t*)(F.ws + WS_WM2) + (size_t)e * 262144, which, rr, scr, F.lane);
    }
}

__device__ __forceinline__ void phase_prologue(const Frame& F, CArgsP a) {
    LAS float* scr = (LAS float*)(F.lds + F.wave * 8704);
    constexpr int I_IN = 2 * 3328, I_BR = 6 * 256, I_OUT = 2 * 512, I_SH = 6 * 128;
    for (int it0 = F.gw; it0 < I_IN + I_BR + I_OUT + I_SH; it0 += F.NGW) {
        int it = it0;
        if (it < I_IN) { const int l = it / 3328, r = it - l * 3328, kb = r / 208, nb = r - kb * 208;
            transpose_item(a->in[6] + (size_t)l * 1024 * INC, INC, 64 * kb, 32 * nb, (bf16_t*)(F.ws + WS_WIN) + (size_t)l * INC * 1024, 1024, 32 * nb, scr, F.lane); continue; }
        it -= I_IN;
        if (it < I_BR) { const int idx = it >> 8, rr = it & 255, kb = rr >> 5, nb = rr & 31;
            transpose_item(a->in[24] + (size_t)idx * 512 * 1024, 1024, 64 * kb, 32 * nb, (bf16_t*)(F.ws + WS_WBR) + (size_t)idx * 1024 * 512, 512, 32 * nb, scr, F.lane); continue; }
        it -= I_BR;
        if (it < I_OUT) { const int l = it >> 9, rr = it & 511, kb = rr >> 5, nb = rr & 31;
            transpose_item(a->in[25] + (size_t)l * 1048576, 1024, 64 * kb, 32 * nb, (bf16_t*)(F.ws + WS_WOUT) + (size_t)l * 1048576, 1024, 32 * nb, scr, F.lane); continue; }
        it -= I_OUT;
        { const int idx = it >> 7, l = idx / 3, which = idx - l * 3, rr = it & 127; const size_t lo = (size_t)l * 262144;
          conv_expert_item(a->in[33] + lo, a->in[34] + lo, a->in[35] + lo, (bf16_t*)(F.ws + WS_WSH1) + (size_t)l * 524288, (bf16_t*)(F.ws + WS_WSH2) + (size_t)l * 262144, which, rr, scr, F.lane); }
    }
    conv_moe_layer(F, a, 0);
    { const int gt = F.bid * NTHR + F.tid, NG = F.G * NTHR;
      bf16_t* wl = (bf16_t*)(F.ws + WS_WLRU);
      for (int i = gt; i < 2 * 2 * 2 * 8 * 4096; i += NG) {
          const int ii = i & 63, j = (i >> 6) & 63, cb = (i >> 12) & 7, ax = (i >> 15) & 1, d = (i >> 16) & 1, l = i >> 17;
          const float* src = ax == 0 ? a->in[19] : a->in[21];
          wl[i] = (bf16_t)f2bf(src[(size_t)((l * 2 + d) * 8 + cb) * 4096 + ii * 64 + j]); }
      bf16_t* wrt = (bf16_t*)(F.ws + WS_WRT);
      for (int i = gt; i < 2 * 64 * 1024; i += NG) { const int k = i & 1023, e = (i >> 10) & 63, l = i >> 16; wrt[i] = (bf16_t)f2bf(a->in[28][(size_t)(l * 1024 + k) * 64 + e]); }
      bf16_t* wsg = (bf16_t*)(F.ws + WS_WSG);
      for (int i = gt; i < 2 * 4 * 128 * 128; i += NG) wsg[i] = (bf16_t)f2bf(a->in[15][i]);
      if (F.bid == 0) { float* rope = (float*)(F.ws + WS_ROPE);
          for (int t = F.tid; t < 1024; t += NTHR) { const int p = t >> 4, f = t & 15; const float inv = powf(10000.0f, -(float)f / 16.0f); const float ang = (float)p * inv; rope[2 * t] = cosf(ang); rope[2 * t + 1] = sinf(ang); } }
      if (F.bid == (1 % F.G) && F.wave == 0) { float* lam = (float*)(F.ws + WS_LAM);
#pragma unroll
          for (int l = 0; l < 2; ++l) { const float s1 = wave_sum(a->in[8][l * 64 + F.lane] * a->in[9][l * 64 + F.lane]), s2 = wave_sum(a->in[10][l * 64 + F.lane] * a->in[11][l * 64 + F.lane]);
              const float li = 0.8f - 0.6f * expf(-0.3f * (float)l); if (F.lane == 0) lam[l] = expf(s1) - expf(s2) + li; } }
    }
    __syncthreads();
    LAS float* sl = (LAS float*)(F.lds + 73728);
    for (int i = F.tid; i < 5 * 1024; i += NTHR) { const int b = i >> 10, k = i & 1023; const float cv = b < 4 ? a->in[1][b * 1024 + k] : a->in[3][k]; sl[i] = silu_(cv); }
    __syncthreads();
    float* mod = (float*)(F.ws + WS_MOD);
    LAS float* part = (LAS float*)(F.lds + 94208);
    for (int c = F.bid; c < 192; c += F.G) {
        const int l = c / 96, cg = c - l * 96, col = F.tid & 63, ks = F.wave, n = cg * 64 + col;
        const float* w = a->in[4] + ((size_t)l * 1024 + ks * 128) * 6144 + n;
        float acc[5] = {0.f, 0.f, 0.f, 0.f, 0.f};
#pragma unroll 8
        for (int k = 0; k < 128; ++k) { const float wv = w[(size_t)k * 6144];
#pragma unroll
            for (int b = 0; b < 5; ++b) acc[b] += sl[b * 1024 + ks * 128 + k] * wv; }
#pragma unroll
        for (int b = 0; b < 5; ++b) part[(ks * 5 + b) * 64 + col] = acc[b];
        __syncthreads();
        if (F.tid < 320) { const int b = F.tid >> 6; float s = a->in[5][l * 6144 + n];
#pragma unroll
            for (int k8 = 0; k8 < 8; ++k8) s += part[(k8 * 5 + b) * 64 + col];
            mod[(l * 5 + b) * 6144 + n] = s; }
        __syncthreads();
    }
}

__device__ __forceinline__ void row_load(const float* p, int lane, f32x4 (&v)[4]) {
#pragma unroll
    for (int j = 0; j < 4; ++j) v[j] = *(const f32x4*)(p + 4 * lane + 256 * j);
}
__device__ __forceinline__ void row_store(float* p, int lane, const f32x4 (&v)[4]) {
#pragma unroll
    for (int j = 0; j < 4; ++j) *(f32x4*)(p + 4 * lane + 256 * j) = v[j];
}
__device__ __forceinline__ void row_ln(f32x4 (&v)[4]) {
    float s = 0.f;
#pragma unroll
    for (int j = 0; j < 4; ++j) s += (v[j][0] + v[j][1]) + (v[j][2] + v[j][3]);
    const float mean = wave_sum(s) * (1.f / DM); float q = 0.f;
#pragma unroll
    for (int j = 0; j < 4; ++j) { v[j] = v[j] - mean; q += (v[j][0] * v[j][0] + v[j][1] * v[j][1]) + (v[j][2] * v[j][2] + v[j][3] * v[j][3]); }
    const float rstd = 1.f / sqrtf(wave_sum(q) * (1.f / DM) + LN_EPS);
#pragma unroll
    for (int j = 0; j < 4; ++j) v[j] = v[j] * rstd;
}
__device__ __forceinline__ void row_affine(f32x4 (&v)[4], const float* scale1p  , bool plus1, const float* shift, int lane) {
#pragma unroll
    for (int j = 0; j < 4; ++j) { const f32x4 sc = *(const f32x4*)(scale1p + 4 * lane + 256 * j), sh = *(const f32x4*)(shift + 4 * lane + 256 * j);
        v[j] = plus1 ? v[j] * (sc + 1.0f) + sh : v[j] * sc + sh; }
}
__device__ __forceinline__ void row_store_bf16(bf16_t* p, int lane, const f32x4 (&v)[4]) {
#pragma unroll
    for (int j = 0; j < 4; ++j) { u32x2 w; w.x = pk2(v[j][0], v[j][1]); w.y = pk2(v[j][2], v[j][3]); *(u32x2*)(p + 4 * lane + 256 * j) = w; }
}

__device__ __forceinline__ void phase_rows0(const Frame& F, CArgsP a) {
    const float* mod = (const float*)(F.ws + WS_MOD); float* xc = (float*)(F.ws + WS_XC); bf16_t* H = (bf16_t*)(F.ws + WS_H);
    for (int tok = F.gw; tok < T; tok += F.NGW) {
        const int b = tok / TPB, j = tok - b * TPB; const bool isc = j < CTX;
        const float* src = isc ? a->in[2] + (size_t)(b * CTX + j) * DM : a->in[0] + (size_t)(b * SEQ + j - CTX) * DM;
        f32x4 v[4]; row_load(src, F.lane, v);
        row_store(resid_row(F.out, xc, tok), F.lane, v);
        row_ln(v);
        const float* mrow = mod + (isc ? 4 : b) * 6144;
        row_affine(v, mrow + 1024, true, mrow, F.lane);
        row_store_bf16(H + (size_t)tok * DM, F.lane, v);
    }
}

__device__ __forceinline__ void sg_item(const Frame& F, CArgsP a, int l, int chunk, int g) {
    LAS bf16_t* vgT = (LAS bf16_t*)F.lds;
    const bf16_t* Sb = (const bf16_t*)(F.ws + OV_S); const bf16_t* Ub = (const bf16_t*)(F.ws + OV_U); bf16_t* OB = (bf16_t*)(F.ws + OV_OB);
    const int tok0 = chunk * 128;
    { const int q = F.tid >> 2, qt = F.tid & 3;
      const bf16_t* sp = Sb + (size_t)(tok0 + q) * 512 + g * 128 + qt * 32;
      float x[32];
#pragma unroll
      for (int i = 0; i < 4; ++i) { const u32x4 w = *(const u32x4*)(sp + 8 * i);
          x[8 * i + 0] = bflo(w.x); x[8 * i + 1] = bfhi(w.x); x[8 * i + 2] = bflo(w.y); x[8 * i + 3] = bfhi(w.y); x[8 * i + 4] = bflo(w.z); x[8 * i + 5] = bfhi(w.z); x[8 * i + 6] = bflo(w.w); x[8 * i + 7] = bfhi(w.w); }
      float s = 0.f;
#pragma unroll
      for (int i = 0; i < 32; ++i) s += x[i];
      s += __shfl_xor(s, 1); s += __shfl_xor(s, 2); const float mean = s * (1.f / 128.f); float qq = 0.f;
#pragma unroll
      for (int i = 0; i < 32; ++i) { x[i] -= mean; qq += x[i] * x[i]; }
      qq += __shfl_xor(qq, 1); qq += __shfl_xor(qq, 2); const float rstd = 1.f / sqrtf(qq * (1.f / 128.f) + LN_EPS);
      const float* lg = a->in[13] + l * 512 + g * 128 + qt * 32; const float* lb = a->in[14] + l * 512 + g * 128 + qt * 32;
#pragma unroll
      for (int i = 0; i < 32; ++i) vgT[(qt * 32 + i) * 136 + q] = (bf16_t)f2bf(x[i] * rstd * lg[i] + lb[i]);
    }
    __syncthreads();
    const int w = F.wave, fr = F.lane & 15, fq = F.lane >> 4;
    bf16x8 af[4];
#pragma unroll
    for (int ks = 0; ks < 4; ++ks) af[ks] = *(const LAS bf16x8*)(vgT + (w * 16 + fr) * 136 + ks * 32 + fq * 8);
    const bf16_t* W = (const bf16_t*)(F.ws + WS_WSG) + (size_t)(l * 4 + g) * 16384;
    const float* bs = a->in[16] + (l * 4 + g) * 128;
#pragma unroll 2
    for (int n = 0; n < 8; ++n) {
        f32x4 d = {0.f, 0.f, 0.f, 0.f};
#pragma unroll
        for (int ks = 0; ks < 4; ++ks) { const bf16x8 bfv = *(const bf16x8*)(W + (n * 16 + fr) * 128 + ks * 32 + fq * 8); d = __builtin_amdgcn_mfma_f32_16x16x32_bf16(af[ks], bfv, d, 0, 0, 0); }
        const int p = n * 16 + fr, c0 = w * 16 + fq * 4; const float bsp = bs[p];
        const size_t off = (size_t)(tok0 + p) * 512 + g * 128 + c0;
        const u32x2 uu = *(const u32x2*)(Ub + off);
        u32x2 o; o.x = pk2(bflo(uu.x) * (d[0] + bsp), bfhi(uu.x) * (d[1] + bsp)); o.y = pk2(bflo(uu.y) * (d[2] + bsp), bfhi(uu.y) * (d[3] + bsp));
        *(u32x2*)(OB + off) = o;
    }
    __syncthreads();
}

__device__ __forceinline__ void lru_item(const Frame& F, CArgsP a, int l, int b, int chunk, int cb, int mode) {
    LAS float* xin = (LAS float*)F.lds;
    LAS float* xs = (LAS float*)(F.lds + 17408);
    LAS bf16_t* xsb = (LAS bf16_t*)(F.lds + 33792);
    LAS float* gt = (LAS float*)(F.lds + 43008);
    LAS float* sg = (LAS float*)(F.lds + 108544);
    const bf16_t* Xb = (const bf16_t*)(F.ws + OV_X); const bf16_t* Yb = (const bf16_t*)(F.ws + OV_Y); bf16_t* OC = (bf16_t*)(F.ws + OV_OC);
    const int tok0 = b * TPB + chunk * 64, ch0 = cb * 64;
    const int seg_lo = chunk < 4 ? 0 : 256, seg_hi = chunk < 4 ? 256 : TPB, j0 = chunk * 64;
    for (int i = F.tid; i < 67 * 8; i += NTHR) { const int r = i >> 3, c8 = (i & 7) * 8, j = j0 + r - 2;
        u32x4 w = {0u, 0u, 0u, 0u}; if (j >= seg_lo && j < seg_hi) w = *(const u32x4*)(Xb + (size_t)(b * TPB + j) * 512 + ch0 + c8);
        *(LAS f32x4*)(xin + r * 64 + c8) = (f32x4){bflo(w.x), bfhi(w.x), bflo(w.y), bfhi(w.y)}; *(LAS f32x4*)(xin + r * 64 + c8 + 4) = (f32x4){bflo(w.z), bfhi(w.z), bflo(w.w), bfhi(w.w)}; }
    __syncthreads();
    { const int c = F.tid & 63; const float* cw = a->in[17] + l * 2048 + ch0 + c; const float w0 = cw[0], w1 = cw[512], w2 = cw[1024], w3 = cw[1536], cbv = a->in[18][l * 512 + ch0 + c];
      for (int t = F.tid >> 6; t < 64; t += 8) { const float v = w0 * xin[t * 64 + c] + w1 * xin[(t + 1) * 64 + c] + w2 * xin[(t + 2) * 64 + c] + w3 * xin[(t + 3) * 64 + c] + cbv;
          xs[t * 64 + c] = v; xsb[t * 72 + c] = (bf16_t)f2bf(v); } }
    __syncthreads();
    {
      const int w = F.wave, mat = w >> 1, fr = F.lane & 15, fq = F.lane >> 4;
      const bf16_t* Wt = (const bf16_t*)(F.ws + WS_WLRU) + (size_t)((l * 4 + mat) * 8 + cb) * 4096;
      const float* bias = (mat & 1) ? a->in[22] : a->in[20];
      const int d = mat >> 1;
#pragma unroll
      for (int nn = 0; nn < 2; ++nn) { const int n = (w & 1) * 2 + nn;
          const bf16x8 b0 = *(const bf16x8*)(Wt + (n * 16 + fr) * 64 + fq * 8), b1 = *(const bf16x8*)(Wt + (n * 16 + fr) * 64 + 32 + fq * 8);
          const float bv = bias[(l * 2 + d) * 512 + ch0 + n * 16 + fr];
#pragma unroll
          for (int m = 0; m < 4; ++m) {
              const bf16x8 a0 = *(const LAS bf16x8*)(xsb + (m * 16 + fr) * 72 + fq * 8), a1 = *(const LAS bf16x8*)(xsb + (m * 16 + fr) * 72 + 32 + fq * 8);
              f32x4 dd = {0.f, 0.f, 0.f, 0.f};
              dd = __builtin_amdgcn_mfma_f32_16x16x32_bf16(a0, b0, dd, 0, 0, 0); dd = __builtin_amdgcn_mfma_f32_16x16x32_bf16(a1, b1, dd, 0, 0, 0);
#pragma unroll
              for (int r = 0; r < 4; ++r) gt[mat * 4096 + (m * 16 + fq * 4 + r) * 64 + n * 16 + fr] = sigmoidf_(dd[r] + bv);
          } } }
    __syncthreads();
    { const int c = F.tid & 63;
#pragma unroll
      for (int d = 0; d < 2; ++d) { const float lamv = a->in[23][(l * 2 + d) * 512 + ch0 + c]; const float sp = log1pf(expf(-lamv));
          for (int t = F.tid >> 6; t < 64; t += 8) { const float r = gt[(d * 2) * 4096 + t * 64 + c], ig = gt[(d * 2 + 1) * 4096 + t * 64 + c];
              const float la = -8.0f * r * sp; const float av = 1.0f + expm1_fast(la); const float bv = __builtin_sqrtf(-expm1_fast(2.0f * la)) * (ig * xs[t * 64 + c]);
              gt[(d * 2) * 4096 + t * 64 + c] = av; gt[(d * 2 + 1) * 4096 + t * 64 + c] = bv; } } }
    __syncthreads();
    const int c = F.tid & 63, d = (F.tid >> 6) & 1, sgm = F.tid >> 7;
    LAS float* aL = gt + (d * 2) * 4096; LAS float* bL = gt + (d * 2 + 1) * 4096;
    { float A = 1.f, h = 0.f;
#pragma unroll 4
      for (int k = 0; k < 16; ++k) { const int pos = d == 0 ? sgm * 16 + k : 63 - (sgm * 16 + k); const float av = aL[pos * 64 + c]; h = av * h + bL[pos * 64 + c]; A *= av; }
      sg[(d * 4 + sgm) * 64 + c] = A; sg[512 + (d * 4 + sgm) * 64 + c] = h; }
    __syncthreads();
    if (mode == 0) {
        if (sgm == 0) { float A = 1.f, h = 0.f;
#pragma unroll
            for (int s = 0; s < 4; ++s) { const float As = sg[(d * 4 + s) * 64 + c], Hs = sg[512 + (d * 4 + s) * 64 + c]; h = As * h + Hs; A *= As; }
            float* sum = (float*)(F.ws + WS_SUM) + ((size_t)((b * 2 + d) * 68 + chunk) * 512 + ch0 + c) * 2; sum[0] = A; sum[1] = h; }
        __syncthreads();
        return;
    }
    { float h = ((const float*)(F.ws + WS_HIN))[(size_t)((b * 2 + d) * 68 + chunk) * 512 + ch0 + c];
#pragma unroll
      for (int s = 0; s < 3; ++s) if (s < sgm) h = sg[(d * 4 + s) * 64 + c] * h + sg[512 + (d * 4 + s) * 64 + c];
#pragma unroll 4
      for (int k = 0; k < 16; ++k) { const int pos = d == 0 ? sgm * 16 + k : 63 - (sgm * 16 + k); h = aL[pos * 64 + c] * h + bL[pos * 64 + c]; bL[pos * 64 + c] = h; } }
    __syncthreads();
    for (int i = F.tid; i < 64 * 16; i += NTHR) { const int t = i >> 4, c4 = (i & 15) * 4; const size_t off = (size_t)(tok0 + t) * 512 + ch0 + c4;
        const u32x2 y = *(const u32x2*)(Yb + off); const f32x4 hf = *(const LAS f32x4*)(gt + 4096 + t * 64 + c4), hb = *(const LAS f32x4*)(gt + 3 * 4096 + t * 64 + c4);
        u32x2 o; o.x = pk2(bflo(y.x) * (hf[0] + hb[0]), bfhi(y.x) * (hf[1] + hb[1])); o.y = pk2(bflo(y.y) * (hf[2] + hb[2]), bfhi(y.y) * (hf[3] + hb[3]));
        *(u32x2*)(OC + off) = o; }
    __syncthreads();
}

__device__ __forceinline__ void phase_carry(const Frame& F) {
    const int gt = F.bid * NTHR + F.tid; if (gt >= 4 * 2 * 512) return;
    const int c = gt & 511, d = (gt >> 9) & 1, b = gt >> 10;
    const float* sum = (const float*)(F.ws + WS_SUM) + (size_t)((b * 2 + d) * 68) * 1024 + c * 2;
    float* hin = (float*)(F.ws + WS_HIN) + (size_t)((b * 2 + d) * 68) * 512 + c;
    float h = 0.f;
#pragma unroll 1
    for (int g0 = 0; g0 < 68; g0 += 17) {
        float A[17], Hh[17];
#pragma unroll
        for (int i = 0; i < 17; ++i) { const int o = g0 + i; const int ck = d == 0 ? o : (o < 4 ? 3 - o : 71 - o); const float2 v = *(const float2*)(sum + (size_t)ck * 1024); A[i] = v.x; Hh[i] = v.y; }
#pragma unroll
        for (int i = 0; i < 17; ++i) { const int o = g0 + i; const int ck = d == 0 ? o : (o < 4 ? 3 - o : 71 - o); hin[(size_t)ck * 512] = h; h = A[i] * h + Hh[i]; }
    }
}

constexpr int AT_KST = 272, AT_VST = 320;
constexpr int AT_KOFF = 0, AT_VOFF = 2 * 64 * AT_KST, AT_XOFF = AT_VOFF + 2 * 64 * AT_VST;
#define AT_SBAR() __builtin_amdgcn_sched_barrier(0)
struct AttnState { f32x16 o[4]; bf16x8 pfp[4]; float mrun, lrun; };
#define AT_PIN1(x) asm volatile("" : "+v"(x))
__device__ __forceinline__ bf16x8 at_vfrag(const LAS unsigned char* vp) {
    const s16x4 lo = __builtin_bit_cast(s16x4, __builtin_amdgcn_ds_read_tr16_b64_v4i16((LAS s16x4*)(vp)));
    const s16x4 hh = __builtin_bit_cast(s16x4, __builtin_amdgcn_ds_read_tr16_b64_v4i16((LAS s16x4*)(vp + 8 * AT_VST)));
    return (bf16x8){lo[0], lo[1], lo[2], lo[3], hh[0], hh[1], hh[2], hh[3]};
}
__device__ __forceinline__ float attn_stage1(const f32x16& p0, const f32x16& p1, f32x16& n0, f32x16& n1, const bf16x8 (&qr)[4], const LAS unsigned char* kf) {
    float mx = fmaxf(fmaxf(p0[0], p0[1]), fmaxf(p1[0], p1[1]));
    bf16x8 a0 = *(const LAS bf16x8*)(kf), a1 = *(const LAS bf16x8*)(kf + 32 * AT_KST);
    AT_SBAR();
#pragma unroll
    for (int ks = 0; ks < 4; ++ks) {
        bf16x8 b0 = a0, b1 = a1;
        if (ks < 3) { b0 = *(const LAS bf16x8*)(kf + (ks + 1) * 32); b1 = *(const LAS bf16x8*)(kf + 32 * AT_KST + (ks + 1) * 32); }
        if (ks == 0) n0 = __builtin_amdgcn_mfma_f32_32x32x16_bf16(a0, qr[0], (f32x16){0.f, 0.f, 0.f, 0.f, 0.f, 0.f, 0.f, 0.f, 0.f, 0.f, 0.f, 0.f, 0.f, 0.f, 0.f, 0.f}, 0, 0, 0);
        else n0 = __builtin_amdgcn_mfma_f32_32x32x16_bf16(a0, qr[ks], n0, 0, 0, 0);
        mx = fmaxf(mx, fmaxf(fmaxf(p0[4 * ks + 2], p0[4 * ks + 3]), fmaxf(p1[4 * ks + 2], p1[4 * ks + 3]))); AT_PIN1(mx); AT_SBAR();
        if (ks == 0) n1 = __builtin_amdgcn_mfma_f32_32x32x16_bf16(a1, qr[0], (f32x16){0.f, 0.f, 0.f, 0.f, 0.f, 0.f, 0.f, 0.f, 0.f, 0.f, 0.f, 0.f, 0.f, 0.f, 0.f, 0.f}, 0, 0, 0);
        else n1 = __builtin_amdgcn_mfma_f32_32x32x16_bf16(a1, qr[ks], n1, 0, 0, 0);
        if (ks < 3) { mx = fmaxf(mx, fmaxf(fmaxf(p0[4 * ks + 4], p0[4 * ks + 5]), fmaxf(p1[4 * ks + 4], p1[4 * ks + 5]))); AT_PIN1(mx); } AT_SBAR();
        a0 = b0; a1 = b1;
    }
    return mx;
}
template <bool FIRST>
__device__ __forceinline__ void attn_stage2(AttnState& st, const f32x16& p0, const f32x16& p1, float mx, const LAS unsigned char* vf) {
    constexpr float SC = 0.125f * 1.4426950408889634f, THR = 8.0f;
    bf16x8 vcur; if (!FIRST) vcur = at_vfrag(vf);
    float tm = fmaxf(mx, __shfl_xor(mx, 32)) * SC;
    if (__any(tm > st.mrun + THR)) {
        const float mn = fmaxf(st.mrun, tm); const float al = __builtin_amdgcn_exp2f(fmaxf(st.mrun - mn, -126.f));
#pragma unroll
        for (int db = 0; db < 4; ++db)
#pragma unroll
            for (int r = 0; r < 16; ++r) st.o[db][r] *= al;
        if (!FIRST) {
#pragma unroll
            for (int kk = 0; kk < 4; ++kk) { u32x4 w = __builtin_bit_cast(u32x4, st.pfp[kk]);
                w.x = pk2(bflo(w.x) * al, bfhi(w.x) * al); w.y = pk2(bflo(w.y) * al, bfhi(w.y) * al); w.z = pk2(bflo(w.z) * al, bfhi(w.z) * al); w.w = pk2(bflo(w.w) * al, bfhi(w.w) * al);
                st.pfp[kk] = __builtin_bit_cast(bf16x8, w); }
        }
        st.lrun *= al; st.mrun = mn;
    }
    const float nm = -st.mrun; float ls = 0.f;
    AT_SBAR();
#pragma unroll
    for (int kk = 0; kk < 4; ++kk) {
        unsigned pw0 = 0, pw1 = 0, pw2 = 0, pw3 = 0;
#pragma unroll
        for (int db = 0; db < 4; ++db) {
            const int g = kk * 4 + db;
            if (!FIRST) {
                bf16x8 vnext = vcur;
                if (g < 15) { const int g2 = g + 1; vnext = at_vfrag(vf + ((g2 >> 2) * 16) * AT_VST + (g2 & 3) * 64); }
                st.o[db] = __builtin_amdgcn_mfma_f32_32x32x16_bf16(vcur, st.pfp[kk], st.o[db], 0, 0, 0);
                vcur = vnext;
            }
            const float x0 = g < 8 ? p0[2 * g] : p1[2 * g - 16], x1 = g < 8 ? p0[2 * g + 1] : p1[2 * g - 15];
            const float e0 = __builtin_amdgcn_exp2f(__builtin_fmaf(x0, SC, nm)), e1 = __builtin_amdgcn_exp2f(__builtin_fmaf(x1, SC, nm));
            ls += e0 + e1; unsigned w = pk2(e0, e1); AT_PIN1(ls); AT_PIN1(w);
            if (db == 0) pw0 = w; else if (db == 1) pw1 = w; else if (db == 2) pw2 = w; else pw3 = w;
            AT_SBAR();
        }
        st.pfp[kk] = __builtin_bit_cast(bf16x8, (u32x4){pw0, pw1, pw2, pw3});
    }
    st.lrun += ls;
}
__device__ __forceinline__ void attn_unit(const Frame& F, int tokq0, int tokk0, int ntiles, int h, float lam, const float* gain, float oscale) {
    const bf16_t* Q = (const bf16_t*)(F.ws + OV_Q); const char* Kg = (const char*)(F.ws + OV_K); const char* Vg = (const char*)(F.ws + OV_V); bf16_t* OA = (bf16_t*)(F.ws + OV_OA);
    const int lane = F.lane, r32 = lane & 31, hi = lane >> 5, rb = F.wave >> 1, c = F.wave & 1;
    bf16x8 qr[4];
    { const bf16_t* qp = Q + (size_t)(tokq0 + rb * 32 + r32) * 512 + h * 128 + c * 64 + hi * 8;
#pragma unroll
      for (int ks = 0; ks < 4; ++ks) qr[ks] = *(const bf16x8*)(qp + ks * 16); }
    const int srow0 = F.tid >> 4, sch = F.tid & 15;
    const unsigned goff = (unsigned)(((tokk0 + srow0) * 512 + h * 128 + sch * 8) * 2);
    LAS unsigned char* kl = F.lds + AT_KOFF + srow0 * AT_KST + sch * 16;
    LAS unsigned char* vl = F.lds + AT_VOFF + srow0 * AT_VST + sch * 16;
    const LAS unsigned char* kfb = F.lds + AT_KOFF + r32 * AT_KST + (c * 64 + hi * 8) * 2;
    const LAS unsigned char* vfb = F.lds + AT_VOFF + (4 * hi + ((lane & 15) >> 2)) * AT_VST + (((lane >> 4) & 1) * 16 + (lane & 3) * 4) * 2;
    {
      const u32x4 k0 = *(const u32x4*)(Kg + goff), k1 = *(const u32x4*)(Kg + goff + 32 * 1024), k2 = *(const u32x4*)(Kg + goff + 64 * 1024), k3 = *(const u32x4*)(Kg + goff + 96 * 1024);
      *(LAS u32x4*)(kl) = k0; *(LAS u32x4*)(kl + 32 * AT_KST) = k1; *(LAS u32x4*)(kl + 64 * AT_KST) = k2; *(LAS u32x4*)(kl + 96 * AT_KST) = k3; }
    __syncthreads();
    AttnState st; st.mrun = -1e30f; st.lrun = 0.f;
#pragma unroll
    for (int db = 0; db < 4; ++db)
#pragma unroll
        for (int r = 0; r < 16; ++r) st.o[db][r] = 0.f;
    f32x16 pa0, pa1, pb0, pb1;
#pragma unroll
    for (int r = 0; r < 16; ++r) { pa0[r] = 0.f; pa1[r] = 0.f; }
#pragma unroll
    for (int ks = 0; ks < 4; ++ks) {
        const bf16x8 a0 = *(const LAS bf16x8*)(kfb + ks * 32), a1 = *(const LAS bf16x8*)(kfb + 32 * AT_KST + ks * 32);
        pa0 = __builtin_amdgcn_mfma_f32_32x32x16_bf16(a0, qr[ks], pa0, 0, 0, 0); pa1 = __builtin_amdgcn_mfma_f32_32x32x16_bf16(a1, qr[ks], pa1, 0, 0, 0);
    }
    u32x4 sv0 = *(const u32x4*)(Vg + goff), sv1 = *(const u32x4*)(Vg + goff + 32 * 1024);
#define AT_ITER(I, FIRSTF, PC0, PC1, PN0, PN1) do { \
        const int i_ = (I); const bool ldk_ = i_ + 2 < ntiles; const int sl_ = i_ & 1; \
        const float mx_ = attn_stage1(PC0, PC1, PN0, PN1, qr, kfb + ((i_ + 1) & 1) * (64 * AT_KST)); \
        *(LAS u32x4*)(vl + sl_ * (64 * AT_VST)) = sv0; *(LAS u32x4*)(vl + sl_ * (64 * AT_VST) + 32 * AT_VST) = sv1; \
        u32x4 sk0_, sk1_; if (ldk_) { const unsigned go_ = goff + (unsigned)(i_ + 2) * 65536u; sk0_ = *(const u32x4*)(Kg + go_); sk1_ = *(const u32x4*)(Kg + go_ + 32 * 1024); } \
        attn_stage2<FIRSTF>(st, PC0, PC1, mx_, vfb + ((i_ + 1) & 1) * (64 * AT_VST)); \
        if (ldk_) { *(LAS u32x4*)(kl + sl_ * (64 * AT_KST)) = sk0_; *(LAS u32x4*)(kl + sl_ * (64 * AT_KST) + 32 * AT_KST) = sk1_; } \
        if (i_ + 1 < ntiles) { const unsigned gv_ = goff + (unsigned)(i_ + 1) * 65536u; sv0 = *(const u32x4*)(Vg + gv_); sv1 = *(const u32x4*)(Vg + gv_ + 32 * 1024); } \
        __syncthreads(); } while (0)
    AT_ITER(0, true, pa0, pa1, pb0, pb1);
    AT_ITER(1, false, pb0, pb1, pa0, pa1);
#pragma unroll 1
    for (int i = 2; i < ntiles; i += 2) {
        AT_ITER(i, false, pa0, pa1, pb0, pb1);
        AT_ITER(i + 1, false, pb0, pb1, pa0, pa1);
    }
#undef AT_ITER
    {
      const LAS unsigned char* vf = vfb + ((ntiles - 1) & 1) * (64 * AT_VST);
#pragma unroll
      for (int db = 0; db < 4; ++db)
#pragma unroll
          for (int kk = 0; kk < 4; ++kk) {
              const LAS unsigned char* vp = vf + (kk * 16) * AT_VST + db * 64;
              const s16x4 lo = __builtin_bit_cast(s16x4, __builtin_amdgcn_ds_read_tr16_b64_v4i16((LAS s16x4*)(vp)));
              const s16x4 hh = __builtin_bit_cast(s16x4, __builtin_amdgcn_ds_read_tr16_b64_v4i16((LAS s16x4*)(vp + 8 * AT_VST)));
              const bf16x8 vfr = {lo[0], lo[1], lo[2], lo[3], hh[0], hh[1], hh[2], hh[3]};
              st.o[db] = __builtin_amdgcn_mfma_f32_32x32x16_bf16(vfr, st.pfp[kk], st.o[db], 0, 0, 0);
          } }
    float lrun = st.lrun; lrun += __shfl_xor(lrun, 32);
    const float il = 1.f / lrun;
    LAS float* ex = (LAS float*)(F.lds + AT_XOFF) + rb * 4096;
    if (c == 1) {
#pragma unroll
        for (int db = 0; db < 4; ++db)
#pragma unroll
            for (int r = 0; r < 16; ++r) ex[(db * 16 + r) * 64 + lane] = st.o[db][r] * il;
    }
    __syncthreads();
    if (c == 0) {
        float ss = 0.f;
#pragma unroll
        for (int db = 0; db < 4; ++db)
#pragma unroll
            for (int r = 0; r < 16; ++r) { const float dv = st.o[db][r] * il - lam * ex[(db * 16 + r) * 64 + lane]; st.o[db][r] = dv; ss += dv * dv; }
        ss += __shfl_xor(ss, 32);
        const float rinv = oscale / sqrtf(ss * (1.f / 128.f) + RMS_EPS);
        bf16_t* op = OA + (size_t)(tokq0 + rb * 32 + r32) * 512 + h * 128;
#pragma unroll
        for (int db = 0; db < 4; ++db)
#pragma unroll
            for (int r4 = 0; r4 < 4; ++r4) { const int dv0 = db * 32 + 8 * r4 + 4 * hi; const f32x4 gv = *(const f32x4*)(gain + dv0);
                u32x2 w; w.x = pk2(st.o[db][4 * r4] * rinv * gv[0], st.o[db][4 * r4 + 1] * rinv * gv[1]); w.y = pk2(st.o[db][4 * r4 + 2] * rinv * gv[2], st.o[db][4 * r4 + 3] * rinv * gv[3]);
                *(u32x2*)(op + dv0) = w; }
    }
    __syncthreads();
}

__device__ __forceinline__ void phase_attn(const Frame& F, CArgsP a, int l) {
    const float lam = ((const float*)(F.ws + WS_LAM))[l]; const float li = 0.8f - 0.6f * expf(-0.3f * (float)l);
    for (int dd = 0; dd < NDUP(6); ++dd)
    for (int it = F.bid; it < 4 * 68 * 8; it += F.G) { const int cb = it & 7, r = it >> 3, chunk = r % 68, b = r / 68;
        if (l == 1 && chunk < 4) continue;
        lru_item(F, a, l, b, chunk, cb, 1); }
    const int nlat = 4 * 4 * 32, nctx = (l == 0) ? 4 * 4 * 2 : 0;
    for (int dd = 0; dd < NDUP(7); ++dd)
    for (int it = F.bid; it < nlat + nctx; it += F.G) {
        int b, h, qb, tq0, nt;
        if (it < nlat) { qb = it & 31; h = (it >> 5) & 3; b = it >> 7; tq0 = b * TPB + CTX + qb * 128; nt = 68; }
        else { const int i2 = it - nlat; qb = i2 & 1; h = (i2 >> 1) & 3; b = i2 >> 3; tq0 = b * TPB + qb * 128; nt = 4; }
        attn_unit(F, tq0, b * TPB, nt, h, lam, a->in[12] + (l * 4 + h) * 128, 1.0f - li);
    }
}

constexpr int RT_AST = 1032;
__device__ __forceinline__ void phase_router(const Frame& F, CArgsP a, int l, bool dry) {
    const float* mod = (const float*)(F.ws + WS_MOD) + l * 5 * 6144; float* xc = (float*)(F.ws + WS_XC); bf16_t* H = (bf16_t*)(F.ws + WS_H);
    LAS bf16_t* AT = (LAS bf16_t*)F.lds;
    LAS float* LG = (LAS float*)(F.lds + 32 * RT_AST * 2);
    LAS unsigned* LC = (LAS unsigned*)(F.lds + 32 * RT_AST * 2 + 8192);
    const bf16_t* Wt = (const bf16_t*)(F.ws + WS_WRT) + (size_t)l * 65536; const float rb_ = a->in[29][l * 64 + F.lane];
    unsigned* cnt = (unsigned*)(F.ws + WS_CNT) + l * 64; int* list = (int*)(F.ws + WS_LIST);
    int* toke = (int*)(F.ws + WS_TOKE); int* tokp = (int*)(F.ws + WS_TOKP); float* tokw = (float*)(F.ws + WS_TOKW);
    const int nrows = l == 0 ? T : NBATCH * SEQ, nbatch = nrows / 32;
    const int fr = F.lane & 15, fq = F.lane >> 4, mt = F.wave & 1, nt = F.wave >> 1;
    if (F.tid < 64) LC[F.tid] = 0u;
    for (int bt = F.bid; bt < nbatch; bt += F.G) {
        int toks[4];
#pragma unroll
        for (int r = 0; r < 4; ++r) { const int ridx = bt * 32 + F.wave * 4 + r; const int tok = l == 0 ? ridx : (ridx >> 12) * TPB + CTX + (ridx & 4095); toks[r] = tok;
            const int b = tok / TPB; const int bsel = (tok - b * TPB) < CTX ? 4 : b;
            float* xr = resid_row(F.out, xc, tok);
            f32x4 v[4]; row_load(xr, F.lane, v); row_ln(v); row_affine(v, a->in[26] + l * DM, false, a->in[27] + l * DM, F.lane); if (!dry) row_store(xr, F.lane, v);
            row_ln(v); const float* mrow = mod + bsel * 6144; row_affine(v, mrow + 4096, true, mrow + 3072, F.lane);
#pragma unroll
            for (int j = 0; j < 4; ++j) { u32x2 w; w.x = pk2(v[j][0], v[j][1]); w.y = pk2(v[j][2], v[j][3]);
                if (!dry) *(u32x2*)(H + (size_t)tok * DM + 4 * F.lane + 256 * j) = w; *(LAS u32x2*)(AT + (F.wave * 4 + r) * RT_AST + 4 * F.lane + 256 * j) = w; }
        }
        __syncthreads();
        { f32x4 d = {0.f, 0.f, 0.f, 0.f};
          const LAS bf16_t* ap = AT + (mt * 16 + fr) * RT_AST + fq * 8; const bf16_t* bp = Wt + (size_t)(nt * 16 + fr) * 1024 + fq * 8;
#pragma unroll 8
          for (int ks = 0; ks < 32; ++ks) { const bf16x8 av = *(const LAS bf16x8*)(ap + ks * 32); const bf16x8 bv = *(const bf16x8*)(bp + ks * 32); d = __builtin_amdgcn_mfma_f32_16x16x32_bf16(av, bv, d, 0, 0, 0); }
#pragma unroll
          for (int r = 0; r < 4; ++r) LG[(mt * 16 + fq * 4 + r) * 64 + nt * 16 + fr] = d[r]; }
        __syncthreads();
        bool selr[4]; int rkr[4], lpr[4]; float wr_[4];
#pragma unroll
        for (int r = 0; r < 4; ++r) {
            const float lg = LG[(F.wave * 4 + r) * 64 + F.lane];
            const float s = 1.f / (1.f + expf(-lg)); const float bsc = s + rb_;
            float m1 = bsc; m1 = fmaxf(m1, __shfl_xor(m1, 1)); m1 = fmaxf(m1, __shfl_xor(m1, 2)); m1 = fmaxf(m1, __shfl_xor(m1, 4));
            const unsigned long long eq = __ballot(bsc == m1); const unsigned gm = (unsigned)(eq >> (F.lane & ~7)) & 0xffu; const int first = __ffs(gm) - 1;
            float m2 = ((F.lane & 7) == first) ? -INFINITY : bsc; m2 = fmaxf(m2, __shfl_xor(m2, 1)); m2 = fmaxf(m2, __shfl_xor(m2, 2)); m2 = fmaxf(m2, __shfl_xor(m2, 4));
            const float gs = m1 + m2; const int myg = F.lane >> 3; int grank = 0;
#pragma unroll
            for (int g = 0; g < 8; ++g) { const float og = __shfl(gs, g * 8); grank += (og > gs || (og == gs && g < myg)) ? 1 : 0; }
            const bool gsel = grank < 4; const float mk = gsel ? bsc : -INFINITY; int rk = 0;
#pragma unroll
            for (int j = 0; j < 64; ++j) { const float vj = __shfl(mk, j); rk += (vj > mk || (vj == mk && j < F.lane)) ? 1 : 0; }
            const bool sel = gsel && rk < 8 && !dry;
            const float ssum = wave_sum((gsel && rk < 8) ? s : 0.f);
            selr[r] = sel; rkr[r] = rk; wr_[r] = s / ssum * 2.5f; lpr[r] = 0;
            if (sel) lpr[r] = (int)__hip_atomic_fetch_add((LAS unsigned*)(LC + F.lane), 1u, __ATOMIC_RELAXED, __HIP_MEMORY_SCOPE_WORKGROUP);
        }
        __syncthreads();
        if (F.tid < 64) { const unsigned n = LC[F.tid]; unsigned base = 0; if (n) base = atomicAdd(cnt + F.tid, n); LC[64 + F.tid] = base; LC[F.tid] = 0u; }
        __syncthreads();
#pragma unroll
        for (int r = 0; r < 4; ++r)
            if (selr[r]) { const int tok = toks[r]; const int pos = (int)LC[64 + F.lane] + lpr[r];
                list[(size_t)F.lane * T + pos] = tok; toke[tok * 8 + rkr[r]] = F.lane; tokp[tok * 8 + rkr[r]] = pos; tokw[tok * 8 + rkr[r]] = wr_[r]; }
        __syncthreads();
    }
}

__device__ __forceinline__ void build_tables(const Frame& F, int l) {
    LAS int* tb = (LAS int*)(F.lds + LDS_CTL);
    __syncthreads();
    if (F.tid < 64) tb[LC_TCNT + F.tid] = (int)__hip_atomic_load((unsigned*)(F.ws + WS_CNT) + l * 64 + F.tid, __ATOMIC_RELAXED, __HIP_MEMORY_SCOPE_AGENT);
    __syncthreads();
    if (F.tid == 0) { int tbs = 0, sbs = 0;
        for (int e = 0; e < 64; ++e) { const int c = tb[LC_TCNT + e]; tb[LC_TBASE + e] = tbs; tb[LC_SBASE + e] = sbs; tbs += (c + 255) >> 8; sbs += c; }
        tb[LC_TBASE + 64] = tbs; tb[LC_SBASE + 64] = sbs; }
    __syncthreads();
}

__device__ __forceinline__ void phase_combine(const Frame& F, CArgsP a, int l, bool dry) {
    const float* mod = (const float*)(F.ws + WS_MOD) + l * 5 * 6144; float* xc = (float*)(F.ws + WS_XC); bf16_t* H = (bf16_t*)(F.ws + WS_H);
    const bf16_t* YS = (const bf16_t*)(F.ws + OV_YS); const LAS int* tb = (const LAS int*)(F.lds + LDS_CTL);
    const int* toke = (const int*)(F.ws + WS_TOKE); const int* tokp = (const int*)(F.ws + WS_TOKP); const float* tokw = (const float*)(F.ws + WS_TOKW);
    const int nrows = l == 0 ? T : NBATCH * SEQ;
    for (int ridx = F.gw; ridx < nrows; ridx += F.NGW) {
        const int tok = l == 0 ? ridx : (ridx >> 12) * TPB + CTX + (ridx & 4095);
        const int b = tok / TPB; const int bsel = (tok - b * TPB) < CTX ? 4 : b;
        int me = 0, mp = 0; float mw = 0.f;
        if (F.lane < 8) { me = toke[tok * 8 + F.lane]; mp = tokp[tok * 8 + F.lane]; mw = tokw[tok * 8 + F.lane]; }
        f32x4 y[4];
        { const bf16_t* sp = H + (size_t)tok * DM;
#pragma unroll
          for (int j = 0; j < 4; ++j) { const u32x2 w = *(const u32x2*)(sp + 4 * F.lane + 256 * j); y[j] = (f32x4){bflo(w.x), bfhi(w.x), bflo(w.y), bfhi(w.y)}; } }
#pragma unroll
        for (int k = 0; k < 8; ++k) { const int e = __shfl(me, k), p = __shfl(mp, k); const float wv = __shfl(mw, k);
            const bf16_t* yp = YS + (size_t)(tb[LC_SBASE + e] + p) * DM;
#pragma unroll
            for (int j = 0; j < 4; ++j) { const u32x2 w = *(const u32x2*)(yp + 4 * F.lane + 256 * j); y[j][0] += wv * bflo(w.x); y[j][1] += wv * bfhi(w.x); y[j][2] += wv * bflo(w.y); y[j][3] += wv * bfhi(w.y); } }
        float* xr = resid_row(F.out, xc, tok);
        f32x4 v[4]; row_load(xr, F.lane, v);
        const float* g2 = mod + bsel * 6144 + 5120;
#pragma unroll
        for (int j = 0; j < 4; ++j) { const f32x4 gv = *(const f32x4*)(g2 + 4 * F.lane + 256 * j); v[j] = v[j] * DN_ALPHA + gv * y[j]; }
        row_ln(v); row_affine(v, a->in[36] + l * DM, false, a->in[37] + l * DM, F.lane); if (!dry) row_store(xr, F.lane, v); else asm volatile("" :: "v"(v[0]), "v"(v[1]), "v"(v[2]), "v"(v[3]));
        if (l == 0 && !dry) { row_ln(v); const float* mrow = mod + 5 * 6144 + bsel * 6144; row_affine(v, mrow + 1024, true, mrow, F.lane); row_store_bf16(H + (size_t)tok * DM, F.lane, v); }
    }
}

constexpr int NPHASE = 22;
__global__ void __launch_bounds__(NTHR, 2) mk_fwd(Args args) {
    extern __shared__ __attribute__((aligned(16))) unsigned char lds_raw[];
    Frame F; F.lds = (LAS unsigned char*)lds_raw; F.tid = threadIdx.x; F.lane = F.tid & 63; F.wave = __builtin_amdgcn_readfirstlane(F.tid >> 6);
    F.G = gridDim.x; F.bid = blockIdx.x; F.gw = F.bid * NWAVES + F.wave; F.NGW = F.G * NWAVES; F.ws = args.ws; F.out = args.out;
    for (int u = F.tid; u < (LDS_BYTES - LDS_CTL) / 4; u += NTHR) ((LAS unsigned*)(F.lds + LDS_CTL))[u] = 0u;
    __syncthreads();
    const int lo = args.ph_lo, hi = args.ph_hi;
    CArgsP A4 = (CArgsP)__builtin_amdgcn_kernarg_segment_ptr();
    XcdBarrier bar; bar.bar = (unsigned*)(F.ws + CW_BAR_BYTE); bar.x = 0; bar.st = nullptr;
    if (hi - lo > 1) bar = xcd_barrier_post((unsigned*)(F.ws + CW_BAR_BYTE), (volatile LAS unsigned*)(F.lds + LDS_CTL) + LC_BAR);
#ifndef PHMASK
#define PHMASK 0xfff
#endif
#define PH_EN(k) ((PHMASK >> ((k) < 2 ? (k) : 2 + (((k) - 2) % 10))) & 1)
#define IN(k) (PH_EN(k) && lo <= (k) && (k) < hi)
#define SEAM(k) do { if (IN(k) && IN((k) + 1)) { for (int dd = 0; dd < NDUP(14); ++dd) xcd_barrier(bar); } if (TSMASK != 0 && blockIdx.x == 0 && threadIdx.x == 0) { ((volatile LAS unsigned long long*)(F.lds + LDS_CTL + 2048))[(k) + 1] = __builtin_amdgcn_s_memrealtime(); } FRESH(); } while (0)
#define FRESH() do { int t_ = threadIdx.x, b_ = blockIdx.x; CArgsP p_ = (CArgsP)__builtin_amdgcn_kernarg_segment_ptr(); asm volatile("" : "+v"(t_)); asm volatile("" : "+s"(b_), "+s"(p_)); A4 = p_; unsigned char* w_ = p_->ws; float* o_ = p_->out; \
    F.tid = t_; F.lane = t_ & 63; F.wave = __builtin_amdgcn_readfirstlane(t_ >> 6); F.bid = b_; F.gw = b_ * NWAVES + F.wave; F.ws = w_; F.out = o_; } while (0)
    if (TSMASK != 0 && blockIdx.x == 0 && threadIdx.x == 0) ((volatile LAS unsigned long long*)(F.lds + LDS_CTL + 2048))[0] = __builtin_amdgcn_s_memrealtime();
    if (IN(0)) { for (int dd = 0; dd < NDUP(0); ++dd) phase_prologue(F, A4); } SEAM(0);
    if (IN(1)) { for (int dd = 0; dd < NDUP(1); ++dd) phase_rows0(F, A4); } SEAM(1);
#pragma unroll 1
    for (int l = 0; l < 2; ++l) {
        const int pb = 2 + 10 * l; const bool lat = (l == 1);
        if (IN(pb + 0)) {
            SchedPlain S{(const char*)(F.ws + WS_H), (const char*)(F.ws + WS_WIN) + (size_t)l * INC * 1024 * 2, 1024, 68, 26, F.G, F.bid, false};
            EpiInproj E{F.ws, A4->in[7] + l * INC, (const float*)(F.ws + WS_ROPE)};
            for (int dd = 0; dd < NDUP(2); ++dd) pg8::gemm_phase(F.lds, 1024, S, E);
        } SEAM(pb + 0);
        if (IN(pb + 1)) {
            for (int dd = 0; dd < NDUP(3); ++dd)
            for (int it = F.bid; it < 4 * 68 * 8; it += F.G) { const int cb = it & 7, r = it >> 3; lru_item(F, A4, l, r / 68, r % 68, cb, 0); }
            for (int dd = 0; dd < NDUP(4); ++dd)
            for (int it = F.bid; it < 136 * 4; it += F.G) { const int chunk = it >> 2; if (lat && (chunk % 34) < 2) continue; sg_item(F, A4, l, chunk, it & 3); }
        } SEAM(pb + 1);
        if (IN(pb + 2)) { for (int dd = 0; dd < NDUP(5); ++dd) phase_carry(F); } SEAM(pb + 2);
        if (IN(pb + 3)) { phase_attn(F, A4, l); } SEAM(pb + 3);
        if (IN(pb + 4)) {
            for (int dd = 0; dd < NDUP(8); ++dd)
#pragma unroll 1
            for (int r = 0; r < 3; ++r) {
                SchedPlain S{(const char*)(F.ws + OV_OA + (size_t)r * 17 * MiB), (const char*)(F.ws + WS_WBR) + (size_t)(l * 3 + r) * 1024 * 512 * 2, 512, lat ? 64 : 68, 4, F.G, F.bid, lat};
                EpiMerge E{(bf16_t*)(F.ws + OV_MG), (const bf16_t*)(F.ws + OV_G), r};
                pg8::gemm_phase(F.lds, 512, S, E);
            }
        } SEAM(pb + 4);
        if (IN(pb + 5)) {
            SchedPlain S{(const char*)(F.ws + OV_MG), (const char*)(F.ws + WS_WOUT) + (size_t)l * 1048576 * 2, 1024, lat ? 64 : 68, 4, F.G, F.bid, lat};
            EpiWout E{F.out, (float*)(F.ws + WS_XC), (const float*)(F.ws + WS_MOD) + l * 5 * 6144, false};
            pg8::gemm_phase(F.lds, 1024, S, E);
            if (NDUP(11) > 1) { EpiWout E2{F.out, (float*)(F.ws + WS_XC), (const float*)(F.ws + WS_MOD) + l * 5 * 6144, true}; pg8::gemm_phase(F.lds, 1024, S, E2); }
        } SEAM(pb + 5);
        if (IN(pb + 6)) { phase_router(F, A4, l, false); if (NDUP(12) > 1) phase_router(F, A4, l, F.G != 12345); } SEAM(pb + 6);
        if (IN(pb + 7)) {
            build_tables(F, l);
            SchedMoe S{(const char*)(F.ws + WS_H), (const char*)(F.ws + WS_H), (const char*)(F.ws + WS_WM1), (const char*)(F.ws + WS_WSH1) + (size_t)l * 524288 * 2,
                       (const int*)(F.ws + WS_LIST), (const LAS int*)(F.lds + LDS_CTL), 1024, 2, F.G, F.bid, lat ? 64 : 68, lat, true, (size_t)524288 * 2};
            EpiMoe1 E{(bf16_t*)(F.ws + OV_ACT), (bf16_t*)(F.ws + OV_ACTSH)};
            for (int dd = 0; dd < NDUP(9); ++dd) pg8::gemm_phase(F.lds, 1024, S, E);
        } SEAM(pb + 7);
        if (IN(pb + 8)) {
            build_tables(F, l);
            SchedMoe S{(const char*)(F.ws + OV_ACT), (const char*)(F.ws + OV_ACTSH), (const char*)(F.ws + WS_WM2), (const char*)(F.ws + WS_WSH2) + (size_t)l * 262144 * 2,
                       (const int*)(F.ws + WS_LIST), (const LAS int*)(F.lds + LDS_CTL), 256, 4, F.G, F.bid, lat ? 64 : 68, lat, false, (size_t)262144 * 2};
            EpiMoe2 E{(bf16_t*)(F.ws + OV_YS), (bf16_t*)(F.ws + WS_H)};
            for (int dd = 0; dd < NDUP(10); ++dd) pg8::gemm_phase(F.lds, 256, S, E);
        } SEAM(pb + 8);
        if (IN(pb + 9)) {
            build_tables(F, l);
            phase_combine(F, A4, l, false);
            if (NDUP(13) > 1) phase_combine(F, A4, l, F.G != 12345);
            if (l == 0) for (int dd = 0; dd < NDUP(15); ++dd) conv_moe_layer(F, A4, 1);
        } SEAM(pb + 9);
    }
    if (TSMASK != 0 && hi - lo == NPHASE) { __syncthreads(); asm volatile("s_waitcnt vmcnt(0)" ::: "memory");
        if (blockIdx.x == 0 && threadIdx.x == 0) { volatile LAS unsigned long long* ts = (volatile LAS unsigned long long*)(F.lds + LDS_CTL + 2048);
            unsigned long long sel = 0; for (int k = 0; k < NPHASE; ++k) if ((TSMASK >> k) & 1) sel += ts[k + 1] - ts[k];
            const float frac = (float)sel / (float)(ts[NPHASE] - ts[0]); args.out[0] += 1.0f + floorf(90.0f * frac + 0.5f); } }
#undef IN
#undef SEAM
}

extern "C" void kernel_launch(void* const* d_in, const int* in_sizes, int n_in, void* d_out, int out_size, void* d_ws, size_t ws_size, hipStream_t stream) {
    static int grid = 0;
    if (grid == 0) {
        if (n_in != 38 || out_size != NBATCH * SEQ * DM || ws_size < WS_END) { fprintf(stderr, "kernel_launch: unexpected shapes (n_in %d out %d ws %zu need %zu)\n", n_in, out_size, ws_size, (size_t)WS_END); grid = -1; return; }
        int dev = 0, cus = 0;
        if (hipGetDevice(&dev) != hipSuccess || hipDeviceGetAttribute(&cus, hipDeviceAttributeMultiprocessorCount, dev) != hipSuccess) { grid = -1; return; }
        if (hipFuncSetAttribute((const void*)mk_fwd, hipFuncAttributeMaxDynamicSharedMemorySize, LDS_BYTES) != hipSuccess) { fprintf(stderr, "kernel_launch: hipFuncSetAttribute failed\n"); grid = -1; return; }
        int per_cu = 0;
        if (hipOccupancyMaxActiveBlocksPerMultiprocessor(&per_cu, (const void*)mk_fwd, NTHR, LDS_BYTES) != hipSuccess || per_cu < 1) fprintf(stderr, "kernel_launch: occupancy query says %d\n", per_cu);
        (void)hipGetLastError();
        grid = cus;
    }
    if (grid < 0) return;
    (void)hipMemsetAsync((char*)d_ws + WS_CTL, 0, CTL_ZERO_BYTES, stream);
    Args a{};
    for (int i = 0; i < 38; ++i) a.in[i] = (const float*)d_in[i];
    a.out = (float*)d_out; a.ws = (unsigned char*)d_ws;
#if MK_MULTI
    for (int p = 0; p < NPHASE; ++p) { a.ph_lo = p; a.ph_hi = p + 1; hipLaunchKernelGGL(mk_fwd, dim3(grid), dim3(NTHR), LDS_BYTES, stream, a); }
#else
    a.ph_lo = 0; a.ph_hi = NPHASE; hipLaunchKernelGGL(mk_fwd, dim3(grid), dim3(NTHR), LDS_BYTES, stream, a);
#endif
}
```

```cpp
#include <hip/hip_runtime.h>
#include <cstdio>
#include <cstdint>
#include <cmath>

#ifndef MK_MULTI
#define MK_MULTI 0
#endif
#ifndef DUPMASK
#define DUPMASK 0
#endif
#define NDUP(c) (1 + ((DUPMASK >> (c)) & 1))
#ifndef TSMASK
#define TSMASK 0
#endif
#ifndef NAIVE_GEMM
#define NAIVE_GEMM 0
#endif

#define LAS __attribute__((address_space(3)))
#define GAS __attribute__((address_space(1)))
typedef unsigned short bf16_t;
typedef short bf16x8 __attribute__((ext_vector_type(8)));
typedef short s16x4 __attribute__((ext_vector_type(4)));
typedef float f32x4 __attribute__((ext_vector_type(4)));
typedef float f32x16 __attribute__((ext_vector_type(16)));
typedef unsigned u32x4 __attribute__((ext_vector_type(4)));
typedef unsigned u32x2 __attribute__((ext_vector_type(2)));

constexpr int DM = 1024, NBATCH = 4, SEQ = 4096, CTX = 256, TPB = SEQ + CTX  , T = NBATCH * TPB  ;
constexpr int INC = 6656, NEXP = 64;
constexpr float DN_ALPHA = 1.41421356237309515f;
constexpr float LN_EPS = 1e-6f, RMS_EPS = 1e-5f;
constexpr int NWAVES = 8, NTHR = 512;

constexpr size_t MiB = 1u << 20;
constexpr size_t WS_CTL = 0, CTL_ZERO_BYTES = 1 * MiB;
constexpr size_t CW_BAR_BYTE = 16384;
constexpr size_t WS_CNT = 65536;
constexpr size_t WS_MOD = 131072;
constexpr size_t WS_ROPE = 1 * MiB;
constexpr size_t WS_LAM = 1 * MiB + 8192;
constexpr size_t WS_SUM = 1 * MiB + 65536;
constexpr size_t WS_HIN = WS_SUM + 2304 * 1024;
constexpr size_t WS_TOKE = 5 * MiB, WS_TOKP = 6 * MiB, WS_TOKW = 7 * MiB;
constexpr size_t WS_LIST = 8 * MiB;
constexpr size_t WS_XC = 13 * MiB;
constexpr size_t WS_WLRU = 17 * MiB;
constexpr size_t WS_WSG = 17 * MiB + 512 * 1024;
constexpr size_t WS_WRT = 17 * MiB + 768 * 1024;
constexpr size_t WS_WSH1 = 18 * MiB;
constexpr size_t WS_WSH2 = 20 * MiB;
constexpr size_t WS_WOUT = 21 * MiB;
constexpr size_t WS_WBR = 25 * MiB;
constexpr size_t WS_WIN = 31 * MiB;
constexpr size_t WS_WM1 = 57 * MiB;
constexpr size_t WS_WM2 = 121 * MiB;
constexpr size_t WS_H = 153 * MiB;
constexpr size_t WS_OV = 187 * MiB;
constexpr size_t OV_Q = WS_OV, OV_K = WS_OV + 17 * MiB, OV_V = WS_OV + 34 * MiB, OV_U = WS_OV + 51 * MiB, OV_S = WS_OV + 68 * MiB,
                 OV_X = WS_OV + 85 * MiB, OV_Y = WS_OV + 102 * MiB, OV_G = WS_OV + 119 * MiB, OV_OA = WS_OV + 221 * MiB,
                 OV_OB = WS_OV + 238 * MiB, OV_OC = WS_OV + 255 * MiB, OV_MG = WS_OV + 272 * MiB;
constexpr size_t OV_ACT = WS_OV, OV_ACTSH = WS_OV + 69 * MiB, OV_YS = WS_OV + 78 * MiB;
constexpr size_t WS_END = WS_OV + 350 * MiB;

constexpr int LDS_SCRATCH = 147456;
constexpr int LDS_CTL = LDS_SCRATCH;
constexpr int LDS_BYTES = LDS_SCRATCH + 4096;
constexpr int LC_BAR = 0;
constexpr int LC_TCNT = 64, LC_TBASE = 64 + 80, LC_SBASE = 64 + 160;

struct Args { const float* in[38]; float* out; unsigned char* ws; int ph_lo, ph_hi; };
typedef const Args __attribute__((address_space(4)))* CArgsP;

__device__ __forceinline__ unsigned f2bf(float f) { unsigned u = __builtin_bit_cast(unsigned, f); return (u + 0x7fffu + ((u >> 16) & 1u)) >> 16; }
typedef float f32x2 __attribute__((ext_vector_type(2))); typedef __bf16 bf16x2_t __attribute__((ext_vector_type(2)));
__device__ __forceinline__ unsigned pk2(float lo, float hi) { const f32x2 v = {lo, hi}; const bf16x2_t b = __builtin_convertvector(v, bf16x2_t); return __builtin_bit_cast(unsigned, b); }
__device__ __forceinline__ float bflo(unsigned w) { return __builtin_bit_cast(float, w << 16); }
__device__ __forceinline__ float bfhi(unsigned w) { return __builtin_bit_cast(float, w & 0xffff0000u); }
__device__ __forceinline__ float bf2f(bf16_t b) { return __builtin_bit_cast(float, (unsigned)b << 16); }
__device__ __forceinline__ float wave_sum(float v) {
#pragma unroll
    for (int o = 1; o < 64; o <<= 1) v += __shfl_xor(v, o);
    return v;
}
__device__ __forceinline__ float sigmoidf_(float x) { return 1.f / (1.f + __expf(-x)); }
__device__ __forceinline__ float gelu_tanh(float x) { const float u = 0.7978845608028654f * (x + 0.044715f * x * x * x); return x / (1.f + __expf(-2.f * u)); }
__device__ __forceinline__ float silu_(float x) { return x / (1.f + __expf(-x)); }
__device__ __forceinline__ float expm1_fast(float x) {
    if (x > -0.5f && x < 0.5f) { float p = 1.0f + x * (1.0f / 8.0f); p = 1.0f + x * (1.0f / 7.0f) * p; p = 1.0f + x * (1.0f / 6.0f) * p; p = 1.0f + x * 0.2f * p; p = 1.0f + x * 0.25f * p; p = 1.0f + x * (1.0f / 3.0f) * p; p = 1.0f + x * 0.5f * p; return x * p; }
    return expm1f(x);
}
#define LDS_WAIT() asm volatile("s_waitcnt lgkmcnt(0)" ::: "memory")
#define VM_WAIT() asm volatile("s_waitcnt vmcnt(0)" ::: "memory")

#define XB_TMO      128
#define XB_XCNT(j)  (256  + 64 * (j))
#define XB_XSUB(j)  (1280 + 64 * (j))
#define XB_XGEN(j)  (2304 + 64 * (j))
#define XB_TOP      3328
#define XB_TOPGEN   3392
#define XCD_BAR_WORDS 3456
#define XB_SPIN_CAP (1u << 22)
__device__ __forceinline__ unsigned xb_ld(unsigned* p)              { return __hip_atomic_load(p, __ATOMIC_RELAXED, __HIP_MEMORY_SCOPE_AGENT); }
__device__ __forceinline__ unsigned xb_add(unsigned* p, unsigned v) { return __hip_atomic_fetch_add(p, v, __ATOMIC_RELAXED, __HIP_MEMORY_SCOPE_AGENT); }
__device__ __forceinline__ unsigned xb_xcc_id() { return (unsigned)__builtin_amdgcn_s_getreg((3 << 11) | 20) & 0xFu; }
#define XB_SPIN(cond, bar) do { unsigned _sp = 0; while (cond) { __builtin_amdgcn_s_sleep(1); \
    if ((++_sp & 255u) == 0u) { if (xb_ld(&(bar)[XB_TMO])) break; if (_sp > XB_SPIN_CAP) { atomicAdd(&(bar)[XB_TMO], 1u); break; } } } } while (0)
struct XcdBarrier { unsigned* bar; unsigned x; volatile LAS unsigned* st; };
__device__ __forceinline__ XcdBarrier xcd_barrier_post(unsigned* bar, volatile LAS unsigned* st) {
    XcdBarrier b; b.bar = bar; b.x = xb_xcc_id(); b.st = st;
    if (threadIdx.x == 0) (void)xb_add(&bar[XB_XCNT(b.x)], 1u);
    return b;
}
__device__ __forceinline__ void xcd_barrier_complete(unsigned* bar, unsigned x, unsigned& nloc, unsigned& nx) {
    const unsigned G = gridDim.x * gridDim.y * gridDim.z;
    unsigned sum, cnt, mine, sp = 0u;
    for (;;) {
        sum = 0u; cnt = 0u; mine = 0u;
#pragma unroll
        for (unsigned j = 0; j < 16; ++j) { const unsigned c = xb_ld(&bar[XB_XCNT(j)]); sum += c; cnt += (c > 0u) ? 1u : 0u; mine = (j == x) ? c : mine; }
        if (sum == G) break;
        __builtin_amdgcn_s_sleep(1);
        if ((++sp & 255u) == 0u) { if (xb_ld(&bar[XB_TMO])) break; if (sp > XB_SPIN_CAP) { atomicAdd(&bar[XB_TMO], 1u); break; } }
    }
    nloc = mine > 0u ? mine : 1u; nx = cnt > 0u ? cnt : 1u;
}
__device__ __forceinline__ void xcd_barrier(const XcdBarrier& b) {
    asm volatile("s_waitcnt vmcnt(0)" ::: "memory");
    __syncthreads();
    if (threadIdx.x == 0) {
        unsigned* bar = b.bar; asm volatile("" : "+s"(bar));
        __builtin_amdgcn_s_waitcnt(0);
        unsigned nloc = b.st[0], nx = b.st[1];
        if (nloc == 0u) { xcd_barrier_complete(bar, b.x, nloc, nx); b.st[0] = nloc; b.st[1] = nx; }
        const unsigned old = xb_add(&bar[XB_XSUB(b.x)], 1u);
        const unsigned gen = old / nloc;
        if (old + 1u == (gen + 1u) * nloc) {
            __builtin_amdgcn_fence(__ATOMIC_RELEASE, "agent");
            asm volatile("s_waitcnt vmcnt(0)" ::: "memory");
            const unsigned og = xb_add(&bar[XB_TOP], 1u);
            const unsigned tg = og / nx;
            if (og + 1u == (tg + 1u) * nx) xb_add(&bar[XB_TOPGEN], 1u);
            else XB_SPIN(xb_ld(&bar[XB_TOPGEN]) == tg, bar);
            __builtin_amdgcn_fence(__ATOMIC_ACQUIRE, "agent");
            xb_add(&bar[XB_XGEN(b.x)], 1u);
            asm volatile("s_waitcnt vmcnt(0)" ::: "memory");
        } else {
            XB_SPIN(xb_ld(&bar[XB_XGEN(b.x)]) == gen, bar);
            __builtin_amdgcn_fence(__ATOMIC_ACQUIRE, "agent");
            asm volatile("s_waitcnt vmcnt(0)" ::: "memory");
        }
    }
    __syncthreads();
}

namespace pg8 {
constexpr int BM = 256, BK = 64, HALF = 128, HTB = HALF * BK * 2, STAGE_BYTES = 8 * HTB, NXCD = 8, WGM = 8;
__host__ __device__ __forceinline__ int lds_byte(int r, int c) { const int st = (r >> 4) * 2 + (c >> 5), rr = r & 15, cc = c & 31, ob = rr * 64 + cc * 2; return st * 1024 + (ob ^ (((ob >> 9) & 1) << 5)); }
__host__ __device__ __forceinline__ void stage_rc(int b, int& R, int& C) { const int st = b / 1024, sb = b % 1024, swz = sb ^ (((sb >> 9) & 1) << 5); R = (st >> 1) * 16 + swz / 64; C = (st & 1) * 32 + (swz % 64) / 2; }
struct Unit { int pm, pn, e, ti, nrows, row0; };
typedef f32x4 Acc[2][2][4][2];

template <class Epi, class Sched>
__device__ __forceinline__ void gemm_phase(LAS unsigned char* lds, const int K, const Sched& S, const Epi& E) {
    int tid_ = threadIdx.x; asm volatile("" : "+v"(tid_));
    const int tid = tid_, wid = __builtin_amdgcn_readfirstlane(tid >> 6), lane = tid & 63, wr = wid >> 2, wc = wid & 3, fr = lane & 15, fq = lane >> 4;
    (void)fr; (void)fq; (void)wc;
    Unit cur, nxt; int ui = 0;
    if (!S.next(0, cur)) return;
    Acc acc;
#pragma unroll
    for (int a = 0; a < 2; ++a)
#pragma unroll
        for (int b = 0; b < 2; ++b)
#pragma unroll
            for (int m = 0; m < 4; ++m)
#pragma unroll
                for (int n = 0; n < 2; ++n) acc[a][b][m][n] = (f32x4){0.f, 0.f, 0.f, 0.f};
#if NAIVE_GEMM
    for (;;) {
        const char* Ab = S.a_base(); const char* Bb = S.b_ptr(cur);
#pragma unroll 1
        for (int ai = 0; ai < 2; ++ai)
#pragma unroll 1
            for (int m = 0; m < 4; ++m) {
                const int rr = ai * 128 + wr * 64 + m * 16 + fr;
                const bf16_t* ap = (const bf16_t*)(Ab + S.a_off(cur, rr));
#pragma unroll
                for (int bj = 0; bj < 2; ++bj)
#pragma unroll
                    for (int n = 0; n < 2; ++n)
#pragma unroll
                        for (int j = 0; j < 4; ++j) {
                            const int cc = bj * 128 + wc * 32 + n * 16 + fq * 4 + j;
                            const bf16_t* bp = (const bf16_t*)(Bb + (size_t)cc * K * 2);
                            float s = 0.f;
                            for (int k = 0; k < K; k += 8) {
                                const u32x4 av = *(const u32x4*)(ap + k), bv = *(const u32x4*)(bp + k);
                                s += bflo(av.x) * bflo(bv.x) + bfhi(av.x) * bfhi(bv.x) + bflo(av.y) * bflo(bv.y) + bfhi(av.y) * bfhi(bv.y)
                                   + bflo(av.z) * bflo(bv.z) + bfhi(av.z) * bfhi(bv.z) + bflo(av.w) * bflo(bv.w) + bfhi(av.w) * bfhi(bv.w);
                            }
                            acc[ai][bj][m][n][j] = s;
                        }
            }
        E(acc, cur, wr, wc, fr, fq);
        ++ui;
        if (!S.next(ui, cur)) break;
    }
    return;
#else
    const int nt = K / BK;
    unsigned voffB[2];
    { int Rr[2], Cc[2];
#pragma unroll
      for (int i = 0; i < 2; ++i) { stage_rc(tid * 16 + i * 8192, Rr[i], Cc[i]); voffB[i] = (unsigned)(Rr[i] * K + Cc[i]) * 2u; } }
#define PG8_AOFFS(U, o00, o01, o10, o11) do { int t3_ = threadIdx.x; asm volatile("" : "+v"(t3_)); int R0_, C0_, R1_, C1_; stage_rc(t3_ * 16, R0_, C0_); stage_rc(t3_ * 16 + 8192, R1_, C1_); \
        o00 = S.a_off(U, R0_) + (unsigned)C0_ * 2u; o01 = S.a_off(U, R1_) + (unsigned)C1_ * 2u; o10 = S.a_off(U, HALF + R0_) + (unsigned)C0_ * 2u; o11 = S.a_off(U, HALF + R1_) + (unsigned)C1_ * 2u; } while (0)
    const size_t kstep = (size_t)(BK * 2);
    const size_t hstep = (size_t)HALF * K * 2;
    const unsigned ldsw = (unsigned)wid * 1024u;
    const int aoff = lds_byte(wr * 64 + fr, fq * 8), boff = lds_byte(wc * 32 + fr, fq * 8);
#define PG8_SA(b, h) (((b) * 2 + (h)) * HTB)
#define PG8_SB(b, h) ((4 + (b) * 2 + (h)) * HTB)
#define PG8_STAGE(bufoff, gbase, v0, v1) do { \
        __builtin_amdgcn_global_load_lds((const unsigned*)((const char*)(gbase) + (v0)), (LAS unsigned*)(lds + (bufoff) + ldsw), 16, 0, 0); \
        __builtin_amdgcn_global_load_lds((const unsigned*)((const char*)(gbase) + (v1)), (LAS unsigned*)(lds + (bufoff) + ldsw + 8192), 16, 0, 0); } while (0)
#define PG8_LDA(dst, b, h) do { _Pragma("unroll") for (int m = 0; m < 4; ++m) _Pragma("unroll") for (int k = 0; k < 2; ++k) dst[m][k] = *(const LAS bf16x8*)(lds + PG8_SA(b, h) + aoff + m * 2048 + k * 1024); } while (0)
#define PG8_LDB(dst, b, h) do { _Pragma("unroll") for (int n = 0; n < 2; ++n) _Pragma("unroll") for (int k = 0; k < 2; ++k) dst[n][k] = *(const LAS bf16x8*)(lds + PG8_SB(b, h) + boff + n * 2048 + k * 1024); } while (0)
#define PG8_MMA(ai, bj, At, Bt) do { __builtin_amdgcn_s_setprio(1); _Pragma("unroll") for (int m = 0; m < 4; ++m) _Pragma("unroll") for (int n = 0; n < 2; ++n) _Pragma("unroll") for (int k = 0; k < 2; ++k) \
        acc[ai][bj][m][n] = __builtin_amdgcn_mfma_f32_16x16x32_bf16(Bt[n][k], At[m][k], acc[ai][bj][m][n], 0, 0, 0); __builtin_amdgcn_s_setprio(0); } while (0)
#define PG8_WAIT_V(n) asm volatile("s_waitcnt vmcnt(" #n ")" ::: "memory")
#define PG8_WAIT_L(n) asm volatile("s_waitcnt lgkmcnt(" #n ")" ::: "memory")
#define PG8_BAR __builtin_amdgcn_s_barrier()
#define PG8_SCHED __builtin_amdgcn_sched_barrier(0)
    bf16x8 At[4][2], B0[2][2], B1[2][2];
    const char* const Ab = S.a_base();
    unsigned vA00, vA01, vA10, vA11;
    PG8_AOFFS(cur, vA00, vA01, vA10, vA11);
    const char* cB = S.b_ptr(cur);
    PG8_STAGE(PG8_SB(0, 0), cB, voffB[0], voffB[1]); PG8_STAGE(PG8_SB(0, 1), cB + hstep, voffB[0], voffB[1]); PG8_STAGE(PG8_SA(0, 0), Ab, vA00, vA01); PG8_STAGE(PG8_SA(0, 1), Ab, vA10, vA11);
    if (wr == 1) PG8_BAR;
    PG8_WAIT_V(2); PG8_BAR;
    PG8_STAGE(PG8_SB(1, 0), cB + kstep, voffB[0], voffB[1]); PG8_STAGE(PG8_SA(1, 0), Ab + kstep, vA00, vA01); PG8_STAGE(PG8_SB(1, 1), cB + hstep + kstep, voffB[0], voffB[1]);
    PG8_WAIT_V(6); PG8_BAR;
    for (;;) {
        const bool has_next = S.next(ui + 1, nxt);
        unsigned vN00 = vA00, vN01 = vA01, vN10 = vA10, vN11 = vA11; const char* nB = cB;
        if (has_next) { PG8_AOFFS(nxt, vN00, vN01, vN10, vN11); nB = S.b_ptr(nxt); }
        for (int t = 0; t < nt; t += 2) {
            const bool last = (t == nt - 2);
            const char* a1 = Ab + (size_t)(t + 1) * kstep;
            const char* a2 = last ? Ab : Ab + (size_t)(t + 2) * kstep; const char* b2 = last ? nB : cB + (size_t)(t + 2) * kstep;
            const char* a3 = a2 + kstep; const char* b3 = b2 + kstep;
            const unsigned w00 = last ? vN00 : vA00, w01 = last ? vN01 : vA01, w10 = last ? vN10 : vA10, w11 = last ? vN11 : vA11;
            PG8_LDB(B0, 0, 0); PG8_LDB(B1, 0, 1); PG8_SCHED; PG8_LDA(At, 0, 0); PG8_STAGE(PG8_SA(1, 1), a1, vA10, vA11);
            PG8_WAIT_V(8); PG8_WAIT_L(0); PG8_BAR; PG8_MMA(0, 0, At, B0); PG8_MMA(0, 1, At, B1); PG8_BAR; PG8_SCHED;
            PG8_LDA(At, 0, 1); PG8_STAGE(PG8_SB(0, 0), b2, voffB[0], voffB[1]); PG8_STAGE(PG8_SB(0, 1), b2 + hstep, voffB[0], voffB[1]); PG8_STAGE(PG8_SA(0, 0), a2, w00, w01);
            PG8_WAIT_V(8); PG8_WAIT_L(0); PG8_BAR; PG8_MMA(1, 0, At, B0); PG8_MMA(1, 1, At, B1); PG8_BAR; PG8_SCHED;
            PG8_LDB(B0, 1, 0); PG8_LDB(B1, 1, 1); PG8_SCHED; PG8_LDA(At, 1, 0); PG8_STAGE(PG8_SA(0, 1), a2, w10, w11);
            PG8_WAIT_V(8); PG8_WAIT_L(0); PG8_BAR; PG8_MMA(0, 0, At, B0); PG8_MMA(0, 1, At, B1); PG8_BAR; PG8_SCHED;
            PG8_LDA(At, 1, 1); PG8_STAGE(PG8_SB(1, 0), b3, voffB[0], voffB[1]); PG8_STAGE(PG8_SB(1, 1), b3 + hstep, voffB[0], voffB[1]); PG8_STAGE(PG8_SA(1, 0), a3, w00, w01);
            PG8_WAIT_V(8); PG8_WAIT_L(0); PG8_BAR; PG8_MMA(1, 0, At, B0); PG8_MMA(1, 1, At, B1); PG8_BAR; PG8_SCHED;
        }
        if (wr == 0) PG8_BAR;
        { int t2_ = threadIdx.x; asm volatile("" : "+v"(t2_)); const int l2_ = t2_ & 63; E(acc, cur, wr, wc, l2_ & 15, l2_ >> 4); }
        if (!has_next) break;
#pragma unroll
        for (int a = 0; a < 2; ++a)
#pragma unroll
            for (int b = 0; b < 2; ++b)
#pragma unroll
                for (int m = 0; m < 4; ++m)
#pragma unroll
                    for (int n = 0; n < 2; ++n) acc[a][b][m][n] = (f32x4){0.f, 0.f, 0.f, 0.f};
        cur = nxt; vA00 = vN00; vA01 = vN01; vA10 = vN10; vA11 = vN11; cB = nB; ++ui;
        if (wr == 1) PG8_BAR;
    }
    PG8_WAIT_V(0);
    PG8_BAR;
#undef PG8_SA
#undef PG8_AOFFS
#undef PG8_SB
#undef PG8_STAGE
#undef PG8_LDA
#undef PG8_LDB
#undef PG8_MMA
#undef PG8_WAIT_V
#undef PG8_WAIT_L
#undef PG8_BAR
#undef PG8_SCHED
#endif
}
}
using pg8::Unit;
using pg8::Acc;

__device__ __forceinline__ float* resid_row(float* out, float* xc, int tok) {
    const int b = tok / TPB, j = tok - b * TPB;
    return j < CTX ? xc + ((size_t)(b * CTX + j)) * DM : out + ((size_t)(b * SEQ + j - CTX)) * DM;
}
__device__ __forceinline__ int tile_to_pm(int i, bool latent_only) { return latent_only ? (i >> 4) * 17 + 1 + (i & 15) : i; }

__device__ __forceinline__ bool static_order(int i, int G, int c, int nM, int nN, int& pm, int& pn) {
    const int nwg = nM * nN; const long L = (long)i * G + c; if (L >= nwg) return false;
    int wgid = (int)L; { const int q = nwg / 8, r = nwg % 8, xcd = wgid % 8, off = wgid / 8; wgid = (xcd < r ? xcd * (q + 1) : r * (q + 1) + (xcd - r) * q) + off; }
    const int nig = 8 * nN, gid = wgid / nig, fm = gid * 8, gsz = (nM - fm) < 8 ? (nM - fm) : 8;
    pm = fm + ((wgid % nig) % gsz); pn = (wgid % nig) / gsz; return true;
}

struct SchedPlain {
    const char* A; const char* Bt; int K, nM, nN, G, c; bool lat;
    __device__ __forceinline__ bool next(int i, Unit& u) const {
        int pm, pn; if (!static_order(i, G, c, nM, nN, pm, pn)) return false;
        u.pm = tile_to_pm(pm, lat); u.pn = pn; u.e = 0; u.ti = 0; u.nrows = 256; u.row0 = u.pm * 256; return true;
    }
    __device__ __forceinline__ const char* a_base() const { return A; }
    __device__ __forceinline__ unsigned a_off(const Unit& u, int rr) const { return (unsigned)(u.row0 + rr) * (unsigned)(K * 2); }
    __device__ __forceinline__ const char* b_ptr(const Unit& u) const { return Bt + (size_t)u.pn * 256 * K * 2; }
};

struct SchedMoe {
    const char* A;
    const char* Ash;
    const char* Bt; const char* Btsh; const int* list;
    const LAS int* tb;
    int K, nN, G, c, nsh; bool lat, gather; size_t bstride;
    __device__ __forceinline__ bool next(int i, Unit& u) const {
        const int nrt = tb[LC_TBASE + 64], L = i * G + c, tot = (nrt + nsh) * nN;
        if (L >= tot) return false;
        const int rt = L / nN; u.pn = L - rt * nN;
        if (rt < nrt) {
            int e = 0;
#pragma unroll 1
            for (int s = 32; s > 0; s >>= 1) if (e + s < 64 && tb[LC_TBASE + e + s] <= rt) e += s;
            u.e = e; u.ti = rt - tb[LC_TBASE + e]; const int cnt = tb[LC_TCNT + e]; const int rem = cnt - u.ti * 256;
            u.nrows = rem < 256 ? rem : 256; u.row0 = tb[LC_SBASE + e] + u.ti * 256; u.pm = 0;
        } else { u.e = 64; u.ti = rt - nrt; u.pm = tile_to_pm(u.ti, lat); u.nrows = 256; u.row0 = u.pm * 256; }
        return true;
    }
    __device__ __forceinline__ const char* a_base() const { return A; }
    __device__ __forceinline__ unsigned a_off(const Unit& u, int rr) const {
        if (u.e == 64) return (unsigned)(Ash - A) + (unsigned)(u.row0 + rr) * (unsigned)(K * 2);
        if (gather) { const int r2 = rr < u.nrows ? rr : u.nrows - 1; const int tok = list[(size_t)u.e * T + u.ti * 256 + r2]; return (unsigned)tok * (unsigned)(K * 2); }
        return (unsigned)(u.row0 + rr) * (unsigned)(K * 2);
    }
    __device__ __forceinline__ const char* b_ptr(const Unit& u) const { return (u.e == 64 ? Btsh : Bt + (size_t)u.e * bstride) + (size_t)u.pn * 256 * K * 2; }
};

#define EPI_FOR_ROWS  _Pragma("unroll") for (int ai = 0; ai < 2; ++ai) _Pragma("unroll") for (int m = 0; m < 4; ++m)
#define EPI_FOR_COLS  _Pragma("unroll") for (int bj = 0; bj < 2; ++bj) _Pragma("unroll") for (int n = 0; n < 2; ++n)

struct EpiInproj {
    unsigned char* ws; const float* bias; const float* rope;
    __device__ __forceinline__ void operator()(const Acc& acc, const Unit& u, int wr, int wc, int fr, int fq) const {
        const int pn = u.pn; const bool isg = pn >= 14; const int seg = pn >> 1;
        bf16_t* base = (bf16_t*)(ws + (isg ? OV_G : OV_Q + (size_t)seg * 17 * MiB));
        const int ld = isg ? 3072 : 512, coff = isg ? (pn - 14) * 256 : (pn & 1) * 256;
        const bool latent = (u.pm % 17) != 0;
        f32x4 bv[2][2];
        EPI_FOR_COLS bv[bj][n] = *(const f32x4*)(bias + pn * 256 + bj * 128 + wc * 32 + n * 16 + fq * 4);
        EPI_FOR_ROWS {
            const int row = u.row0 + ai * 128 + wr * 64 + m * 16 + fr;
            bf16_t* rp = base + (size_t)row * ld + coff + wc * 32 + fq * 4;
            f32x4 v[2][2];
            EPI_FOR_COLS v[bj][n] = acc[ai][bj][m][n] + bv[bj][n];
            if (seg < 2 && !isg) {
                if (latent) {
                    const int pos = (row % TPB) - CTX; const int pa = (wc & 1) ? (pos & 63) : (pos >> 6);
                    const f32x4 c0 = *(const f32x4*)(rope + (pa * 16 + fq * 4) * 2), c1 = *(const f32x4*)(rope + (pa * 16 + fq * 4) * 2 + 4);
                    const float cs[4] = {c0[0], c0[2], c1[0], c1[2]}, sn[4] = {c0[1], c0[3], c1[1], c1[3]};
#pragma unroll
                    for (int bj = 0; bj < 2; ++bj)
#pragma unroll
                        for (int j = 0; j < 4; ++j) { const float a = v[bj][0][j], b = v[bj][1][j]; v[bj][0][j] = a * cs[j] - b * sn[j]; v[bj][1][j] = b * cs[j] + a * sn[j]; }
                }
            } else if (isg) {
                EPI_FOR_COLS {
#pragma unroll
                    for (int j = 0; j < 4; ++j) v[bj][n][j] = sigmoidf_(v[bj][n][j]); }
            } else if (seg == 3 || seg == 4 || seg == 6) {
                EPI_FOR_COLS {
#pragma unroll
                    for (int j = 0; j < 4; ++j) v[bj][n][j] = gelu_tanh(v[bj][n][j]); }
            }
            EPI_FOR_COLS { u32x2 w; w.x = pk2(v[bj][n][0], v[bj][n][1]); w.y = pk2(v[bj][n][2], v[bj][n][3]); *(u32x2*)(rp + bj * 128 + n * 16) = w; }
        }
    }
};

struct EpiMerge {
    bf16_t* mg; const bf16_t* gate; int r;
    __device__ __forceinline__ void operator()(const Acc& acc, const Unit& u, int wr, int wc, int fr, int fq) const {
        EPI_FOR_ROWS {
            const int row = u.row0 + ai * 128 + wr * 64 + m * 16 + fr;
            EPI_FOR_COLS {
                const int col = u.pn * 256 + bj * 128 + wc * 32 + n * 16 + fq * 4;
                const u32x2 g = *(const u32x2*)(gate + (size_t)row * 3072 + r * 1024 + col);
                f32x4 v = acc[ai][bj][m][n]; v[0] *= bflo(g.x); v[1] *= bfhi(g.x); v[2] *= bflo(g.y); v[3] *= bfhi(g.y);
                u32x2* mp = (u32x2*)(mg + (size_t)row * DM + col);
                if (r > 0) { const u32x2 o = *mp; v[0] += bflo(o.x); v[1] += bfhi(o.x); v[2] += bflo(o.y); v[3] += bfhi(o.y); }
                u32x2 w; w.x = pk2(v[0], v[1]); w.y = pk2(v[2], v[3]); *mp = w;
            }
        }
    }
};

struct EpiWout {
    float* out; float* xc; const float* modl; bool dry;
    __device__ __forceinline__ void operator()(const Acc& acc, const Unit& u, int wr, int wc, int fr, int fq) const {
        const int b = u.pm / 17; const int bsel = (u.pm % 17) == 0 ? 4 : b;
        const float* g1 = modl + bsel * 6144 + 2048;
        f32x4 gv[2][2];
        EPI_FOR_COLS gv[bj][n] = *(const f32x4*)(g1 + u.pn * 256 + bj * 128 + wc * 32 + n * 16 + fq * 4);
        EPI_FOR_ROWS {
            const int row = u.row0 + ai * 128 + wr * 64 + m * 16 + fr;
            float* rp = resid_row(out, xc, row) + u.pn * 256 + wc * 32 + fq * 4;
            EPI_FOR_COLS { f32x4* p = (f32x4*)(rp + bj * 128 + n * 16); const f32x4 x = *p; const f32x4 y = x * DN_ALPHA + gv[bj][n] * acc[ai][bj][m][n]; if (!dry) *p = y; else asm volatile("" :: "v"(y)); }
        }
    }
};

struct EpiMoe1 {
    bf16_t* act; bf16_t* actsh;
    __device__ __forceinline__ void operator()(const Acc& acc, const Unit& u, int wr, int wc, int fr, int fq) const {
        bf16_t* base = u.e == 64 ? actsh : act;
        EPI_FOR_ROWS {
            const int rl = ai * 128 + wr * 64 + m * 16 + fr;
            if (rl < u.nrows) {
                bf16_t* rp = base + (size_t)(u.row0 + rl) * 256 + u.pn * 128 + wc * 32 + fq * 4;
#pragma unroll
                for (int n = 0; n < 2; ++n) {
                    const f32x4 g = acc[ai][0][m][n], p = acc[ai][1][m][n];
                    u32x2 w; w.x = pk2(silu_(g[0]) * p[0], silu_(g[1]) * p[1]); w.y = pk2(silu_(g[2]) * p[2], silu_(g[3]) * p[3]);
                    *(u32x2*)(rp + n * 16) = w;
                }
            }
        }
    }
};

struct EpiMoe2 {
    bf16_t* ys; bf16_t* sho;
    __device__ __forceinline__ void operator()(const Acc& acc, const Unit& u, int wr, int wc, int fr, int fq) const {
        bf16_t* base = u.e == 64 ? sho : ys;
        EPI_FOR_ROWS {
            const int rl = ai * 128 + wr * 64 + m * 16 + fr;
            if (rl < u.nrows) {
                bf16_t* rp = base + (size_t)(u.row0 + rl) * DM + u.pn * 256 + wc * 32 + fq * 4;
                EPI_FOR_COLS { const f32x4 v = acc[ai][bj][m][n]; u32x2 w; w.x = pk2(v[0], v[1]); w.y = pk2(v[2], v[3]); *(u32x2*)(rp + bj * 128 + n * 16) = w; }
            }
        }
    }
};

struct Frame {
    LAS unsigned char* lds; int tid, lane, wave, G, bid, gw, NGW, vcu;
    unsigned char* ws; float* out;
};

__device__ __forceinline__ void transpose_item(const float* W, int ldw, int k0, int n0, bf16_t* WT, int ldt, int drow0, LAS float* scr, int lane) {
#pragma unroll 8
    for (int i = 0; i < 32; ++i) { const int kk = 2 * i + (lane >> 5); scr[kk * 33 + (lane & 31)] = W[(size_t)(k0 + kk) * ldw + n0 + (lane & 31)]; }
    LDS_WAIT(); asm volatile("" ::: "memory");
    const int c = lane & 7;
#pragma unroll
    for (int j = 0; j < 4; ++j) { const int n = (lane >> 3) + 8 * j; const LAS float* s = scr + (8 * c) * 33 + n;
        u32x4 o; o.x = pk2(s[0 * 33], s[1 * 33]); o.y = pk2(s[2 * 33], s[3 * 33]); o.z = pk2(s[4 * 33], s[5 * 33]); o.w = pk2(s[6 * 33], s[7 * 33]);
        *(u32x4*)(WT + (size_t)(drow0 + n) * ldt + k0 + 8 * c) = o; }
    LDS_WAIT(); asm volatile("" ::: "memory");
}
__device__ __forceinline__ void conv_expert_item(const float* wg, const float* wu, const float* wd, bf16_t* t1, bf16_t* t2, int which, int rr, LAS float* scr, int lane) {
    if (which < 2) { const int kb = rr >> 3, nb = rr & 7, n0 = 32 * nb;
        transpose_item(which == 0 ? wg : wu, 256, 64 * kb, n0, t1, 1024, (n0 >> 7) * 256 + (n0 & 127) + which * 128, scr, lane);
    } else { const int kb = rr >> 5, nb = rr & 31; transpose_item(wd, 1024, 64 * kb, 32 * nb, t2, 256, 32 * nb, scr, lane); }
}
__device__ __forceinline__ void conv_moe_layer(const Frame& F, CArgsP a, int l) {
    LAS float* scr = (LAS float*)(F.lds + F.wave * 8704);
    for (int it = F.gw; it < 64 * 3 * 128; it += F.NGW) {
        const int idx = it >> 7, e = idx / 3, which = idx - e * 3, rr = it & 127; const size_t eo = (size_t)(l * 64 + e) * 262144;
        conv_expert_item(a->in[30] + eo, a->in[31] + eo, a->in[32] + eo, (bf16_t*)(F.ws + WS_WM1) + (size_t)e * 524288, (bf16_t*)(F.ws + WS_WM2) + (size_t)e * 262144, which, rr, scr, F.lane);
    }
}

__device__ __forceinline__ void phase_prologue(const Frame& F, CArgsP a) {
    LAS float* scr = (LAS float*)(F.lds + F.wave * 8704);
    constexpr int I_IN = 2 * 3328, I_BR = 6 * 256, I_OUT = 2 * 512, I_SH = 6 * 128;
    for (int it0 = F.gw; it0 < I_IN + I_BR + I_OUT + I_SH; it0 += F.NGW) {
        int it = it0;
        if (it < I_IN) { const int l = it / 3328, r = it - l * 3328, kb = r / 208, nb = r - kb * 208;
            transpose_item(a->in[6] + (size_t)l * 1024 * INC, INC, 64 * kb, 32 * nb, (bf16_t*)(F.ws + WS_WIN) + (size_t)l * INC * 1024, 1024, 32 * nb, scr, F.lane); continue; }
        it -= I_IN;
        if (it < I_BR) { const int idx = it >> 8, rr = it & 255, kb = rr >> 5, nb = rr & 31;
            transpose_item(a->in[24] + (size_t)idx * 512 * 1024, 1024, 64 * kb, 32 * nb, (bf16_t*)(F.ws + WS_WBR) + (size_t)idx * 1024 * 512, 512, 32 * nb, scr, F.lane); continue; }
        it -= I_BR;
        if (it < I_OUT) { const int l = it >> 9, rr = it & 511, kb = rr >> 5, nb = rr & 31;
            transpose_item(a->in[25] + (size_t)l * 1048576, 1024, 64 * kb, 32 * nb, (bf16_t*)(F.ws + WS_WOUT) + (size_t)l * 1048576, 1024, 32 * nb, scr, F.lane); continue; }
        it -= I_OUT;
        { const int idx = it >> 7, l = idx / 3, which = idx - l * 3, rr = it & 127; const size_t lo = (size_t)l * 262144;
          conv_expert_item(a->in[33] + lo, a->in[34] + lo, a->in[35] + lo, (bf16_t*)(F.ws + WS_WSH1) + (size_t)l * 524288, (bf16_t*)(F.ws + WS_WSH2) + (size_t)l * 262144, which, rr, scr, F.lane); }
    }
    conv_moe_layer(F, a, 0);
    { const int gt = F.bid * NTHR + F.tid, NG = F.G * NTHR;
      bf16_t* wl = (bf16_t*)(F.ws + WS_WLRU);
      for (int i = gt; i < 2 * 2 * 2 * 8 * 4096; i += NG) {
          const int ii = i & 63, j = (i >> 6) & 63, cb = (i >> 12) & 7, ax = (i >> 15) & 1, d = (i >> 16) & 1, l = i >> 17;
          const float* src = ax == 0 ? a->in[19] : a->in[21];
          wl[i] = (bf16_t)f2bf(src[(size_t)((l * 2 + d) * 8 + cb) * 4096 + ii * 64 + j]); }
      bf16_t* wrt = (bf16_t*)(F.ws + WS_WRT);
      for (int i = gt; i < 2 * 64 * 1024; i += NG) { const int k = i & 1023, e = (i >> 10) & 63, l = i >> 16; wrt[i] = (bf16_t)f2bf(a->in[28][(size_t)(l * 1024 + k) * 64 + e]); }
      bf16_t* wsg = (bf16_t*)(F.ws + WS_WSG);
      for (int i = gt; i < 2 * 4 * 128 * 128; i += NG) wsg[i] = (bf16_t)f2bf(a->in[15][i]);
      if (F.bid == 0) { float* rope = (float*)(F.ws + WS_ROPE);
          for (int t = F.tid; t < 1024; t += NTHR) { const int p = t >> 4, f = t & 15; const float inv = powf(10000.0f, -(float)f / 16.0f); const float ang = (float)p * inv; rope[2 * t] = cosf(ang); rope[2 * t + 1] = sinf(ang); } }
      if (F.bid == (1 % F.G) && F.wave == 0) { float* lam = (float*)(F.ws + WS_LAM);
#pragma unroll
          for (int l = 0; l < 2; ++l) { const float s1 = wave_sum(a->in[8][l * 64 + F.lane] * a->in[9][l * 64 + F.lane]), s2 = wave_sum(a->in[10][l * 64 + F.lane] * a->in[11][l * 64 + F.lane]);
              const float li = 0.8f - 0.6f * expf(-0.3f * (float)l); if (F.lane == 0) lam[l] = expf(s1) - expf(s2) + li; } }
    }
    __syncthreads();
    LAS float* sl = (LAS float*)(F.lds + 73728);
    for (int i = F.tid; i < 5 * 1024; i += NTHR) { const int b = i >> 10, k = i & 1023; const float cv = b < 4 ? a->in[1][b * 1024 + k] : a->in[3][k]; sl[i] = silu_(cv); }
    __syncthreads();
    float* mod = (float*)(F.ws + WS_MOD);
    LAS float* part = (LAS float*)(F.lds + 94208);
    for (int c = F.bid; c < 192; c += F.G) {
        const int l = c / 96, cg = c - l * 96, col = F.tid & 63, ks = F.wave, n = cg * 64 + col;
        const float* w = a->in[4] + ((size_t)l * 1024 + ks * 128) * 6144 + n;
        float acc[5] = {0.f, 0.f, 0.f, 0.f, 0.f};
#pragma unroll 8
        for (int k = 0; k < 128; ++k) { const float wv = w[(size_t)k * 6144];
#pragma unroll
            for (int b = 0; b < 5; ++b) acc[b] += sl[b * 1024 + ks * 128 + k] * wv; }
#pragma unroll
        for (int b = 0; b < 5; ++b) part[(ks * 5 + b) * 64 + col] = acc[b];
        __syncthreads();
        if (F.tid < 320) { const int b = F.tid >> 6; float s = a->in[5][l * 6144 + n];
#pragma unroll
            for (int k8 = 0; k8 < 8; ++k8) s += part[(k8 * 5 + b) * 64 + col];
            mod[(l * 5 + b) * 6144 + n] = s; }
        __syncthreads();
    }
}

__device__ __forceinline__ void row_load(const float* p, int lane, f32x4 (&v)[4]) {
#pragma unroll
    for (int j = 0; j < 4; ++j) v[j] = *(const f32x4*)(p + 4 * lane + 256 * j);
}
__device__ __forceinline__ void row_store(float* p, int lane, const f32x4 (&v)[4]) {
#pragma unroll
    for (int j = 0; j < 4; ++j) *(f32x4*)(p + 4 * lane + 256 * j) = v[j];
}
__device__ __forceinline__ void row_ln(f32x4 (&v)[4]) {
    float s = 0.f;
#pragma unroll
    for (int j = 0; j < 4; ++j) s += (v[j][0] + v[j][1]) + (v[j][2] + v[j][3]);
    const float mean = wave_sum(s) * (1.f / DM); float q = 0.f;
#pragma unroll
    for (int j = 0; j < 4; ++j) { v[j] = v[j] - mean; q += (v[j][0] * v[j][0] + v[j][1] * v[j][1]) + (v[j][2] * v[j][2] + v[j][3] * v[j][3]); }
    const float rstd = 1.f / sqrtf(wave_sum(q) * (1.f / DM) + LN_EPS);
#pragma unroll
    for (int j = 0; j < 4; ++j) v[j] = v[j] * rstd;
}
__device__ __forceinline__ void row_affine(f32x4 (&v)[4], const float* scale1p  , bool plus1, const float* shift, int lane) {
#pragma unroll
    for (int j = 0; j < 4; ++j) { const f32x4 sc = *(const f32x4*)(scale1p + 4 * lane + 256 * j), sh = *(const f32x4*)(shift + 4 * lane + 256 * j);
        v[j] = plus1 ? v[j] * (sc + 1.0f) + sh : v[j] * sc + sh; }
}
__device__ __forceinline__ void row_store_bf16(bf16_t* p, int lane, const f32x4 (&v)[4]) {
#pragma unroll
    for (int j = 0; j < 4; ++j) { u32x2 w; w.x = pk2(v[j][0], v[j][1]); w.y = pk2(v[j][2], v[j][3]); *(u32x2*)(p + 4 * lane + 256 * j) = w; }
}

__device__ __forceinline__ void phase_rows0(const Frame& F, CArgsP a) {
    const float* mod = (const float*)(F.ws + WS_MOD); float* xc = (float*)(F.ws + WS_XC); bf16_t* H = (bf16_t*)(F.ws + WS_H);
    for (int tok = F.gw; tok < T; tok += F.NGW) {
        const int b = tok / TPB, j = tok - b * TPB; const bool isc = j < CTX;
        const float* src = isc ? a->in[2] + (size_t)(b * CTX + j) * DM : a->in[0] + (size_t)(b * SEQ + j - CTX) * DM;
        f32x4 v[4]; row_load(src, F.lane, v);
        row_store(resid_row(F.out, xc, tok), F.lane, v);
        row_ln(v);
        const float* mrow = mod + (isc ? 4 : b) * 6144;
        row_affine(v, mrow + 1024, true, mrow, F.lane);
        row_store_bf16(H + (size_t)tok * DM, F.lane, v);
    }
}

__device__ __forceinline__ void sg_item(const Frame& F, CArgsP a, int l, int chunk, int g) {
    LAS bf16_t* vgT = (LAS bf16_t*)F.lds;
    const bf16_t* Sb = (const bf16_t*)(F.ws + OV_S); const bf16_t* Ub = (const bf16_t*)(F.ws + OV_U); bf16_t* OB = (bf16_t*)(F.ws + OV_OB);
    const int tok0 = chunk * 128;
    { const int q = F.tid >> 2, qt = F.tid & 3;
      const bf16_t* sp = Sb + (size_t)(tok0 + q) * 512 + g * 128 + qt * 32;
      float x[32];
#pragma unroll
      for (int i = 0; i < 4; ++i) { const u32x4 w = *(const u32x4*)(sp + 8 * i);
          x[8 * i + 0] = bflo(w.x); x[8 * i + 1] = bfhi(w.x); x[8 * i + 2] = bflo(w.y); x[8 * i + 3] = bfhi(w.y); x[8 * i + 4] = bflo(w.z); x[8 * i + 5] = bfhi(w.z); x[8 * i + 6] = bflo(w.w); x[8 * i + 7] = bfhi(w.w); }
      float s = 0.f;
#pragma unroll
      for (int i = 0; i < 32; ++i) s += x[i];
      s += __shfl_xor(s, 1); s += __shfl_xor(s, 2); const float mean = s * (1.f / 128.f); float qq = 0.f;
#pragma unroll
      for (int i = 0; i < 32; ++i) { x[i] -= mean; qq += x[i] * x[i]; }
      qq += __shfl_xor(qq, 1); qq += __shfl_xor(qq, 2); const float rstd = 1.f / sqrtf(qq * (1.f / 128.f) + LN_EPS);
      const float* lg = a->in[13] + l * 512 + g * 128 + qt * 32; const float* lb = a->in[14] + l * 512 + g * 128 + qt * 32;
#pragma unroll
      for (int i = 0; i < 32; ++i) vgT[(qt * 32 + i) * 136 + q] = (bf16_t)f2bf(x[i] * rstd * lg[i] + lb[i]);
    }
    __syncthreads();
    const int w = F.wave, fr = F.lane & 15, fq = F.lane >> 4;
    bf16x8 af[4];
#pragma unroll
    for (int ks = 0; ks < 4; ++ks) af[ks] = *(const LAS bf16x8*)(vgT + (w * 16 + fr) * 136 + ks * 32 + fq * 8);
    const bf16_t* W = (const bf16_t*)(F.ws + WS_WSG) + (size_t)(l * 4 + g) * 16384;
    const float* bs = a->in[16] + (l * 4 + g) * 128;
#pragma unroll 2
    for (int n = 0; n < 8; ++n) {
        f32x4 d = {0.f, 0.f, 0.f, 0.f};
#pragma unroll
        for (int ks = 0; ks < 4; ++ks) { const bf16x8 bfv = *(const bf16x8*)(W + (n * 16 + fr) * 128 + ks * 32 + fq * 8); d = __builtin_amdgcn_mfma_f32_16x16x32_bf16(af[ks], bfv, d, 0, 0, 0); }
        const int p = n * 16 + fr, c0 = w * 16 + fq * 4; const float bsp = bs[p];
        const size_t off = (size_t)(tok0 + p) * 512 + g * 128 + c0;
        const u32x2 uu = *(const u32x2*)(Ub + off);
        u32x2 o; o.x = pk2(bflo(uu.x) * (d[0] + bsp), bfhi(uu.x) * (d[1] + bsp)); o.y = pk2(bflo(uu.y) * (d[2] + bsp), bfhi(uu.y) * (d[3] + bsp));
        *(u32x2*)(OB + off) = o;
    }
    __syncthreads();
}

template <bool REV>
__device__ __forceinline__ void lru_scan(const f32x4 (&av)[4], const f32x4 (&bv)[4], f32x4 (&hv)[4], int lane, int mode, float hin, float& sumA, float& sumH) {
#define LRU_MI(k) (REV ? 3 - (k) : (k))
    const int fr = lane & 15, fq = lane >> 4, q = REV ? 3 - fq : fq;
    const int s1 = REV ? lane + 16 : lane - 16, s2 = REV ? lane + 32 : lane - 32, st = REV ? fr : 48 + fr;
    float Ea[4], Eh[4], Ta[4], Th[4];
#pragma unroll
    for (int m = 0; m < 4; ++m) {
        float A = 1.f, H = 0.f;
#pragma unroll
        for (int rk = 0; rk < 4; ++rk) { const int r = LRU_MI(rk); H = av[m][r] * H + bv[m][r]; A *= av[m][r]; }
        float pa = __shfl(A, s1), ph = __shfl(H, s1); if (q >= 1) { H = A * ph + H; A *= pa; }
        pa = __shfl(A, s2); ph = __shfl(H, s2); if (q >= 2) { H = A * ph + H; A *= pa; }
        float ea = __shfl(A, s1), eh = __shfl(H, s1); if (q == 0) { ea = 1.f; eh = 0.f; }
        Ea[m] = ea; Eh[m] = eh; Ta[m] = __shfl(A, st); Th[m] = __shfl(H, st);
    }
    if (mode == 0) {
        float A = 1.f, H = 0.f;
#pragma unroll
        for (int mk = 0; mk < 4; ++mk) { const int m = LRU_MI(mk); H = Ta[m] * H + Th[m]; A *= Ta[m]; }
        sumA = A; sumH = H;
    } else {
        float S = hin;
#pragma unroll
        for (int mk = 0; mk < 4; ++mk) { const int m = LRU_MI(mk); float h = Ea[m] * S + Eh[m];
#pragma unroll
            for (int rk = 0; rk < 4; ++rk) { const int r = LRU_MI(rk); h = av[m][r] * h + bv[m][r]; hv[m][r] = h; }
            S = Ta[m] * S + Th[m]; }
    }
#undef LRU_MI
}
struct LruConst { f32x4 cw[4][2]; f32x4 cbias[2]; bf16x8 wa0, wa1, wx0, wx1; float ba, bx, sp; };
struct LruIn { u32x4 x[4]; u32x4 y; float hin; };
__device__ __forceinline__ void lru_load_const(const Frame& F, CArgsP a, int l, int cb, LruConst& c) {
    const int lane = F.lane, fr = lane & 15, fq = lane >> 4, d = F.wave >> 2, nt = F.wave & 3, ch0 = cb * 64, c8 = (F.tid & 7) * 8;
    const bf16_t* Wa = (const bf16_t*)(F.ws + WS_WLRU) + (size_t)((l * 4 + d * 2) * 8 + cb) * 4096 + (nt * 16 + fr) * 64 + fq * 8;
    c.wa0 = *(const bf16x8*)(Wa); c.wa1 = *(const bf16x8*)(Wa + 32); c.wx0 = *(const bf16x8*)(Wa + 8 * 4096); c.wx1 = *(const bf16x8*)(Wa + 8 * 4096 + 32);
    const int pidx = (l * 2 + d) * 512 + ch0 + nt * 16 + fr;
    c.ba = a->in[20][pidx]; c.bx = a->in[22][pidx]; c.sp = log1pf(expf(-a->in[23][pidx]));
#pragma unroll
    for (int jj = 0; jj < 4; ++jj) { c.cw[jj][0] = *(const f32x4*)(a->in[17] + l * 2048 + jj * 512 + ch0 + c8); c.cw[jj][1] = *(const f32x4*)(a->in[17] + l * 2048 + jj * 512 + ch0 + c8 + 4); }
    c.cbias[0] = *(const f32x4*)(a->in[18] + l * 512 + ch0 + c8); c.cbias[1] = *(const f32x4*)(a->in[18] + l * 512 + ch0 + c8 + 4);
}
__device__ __forceinline__ void lru_load_in(const Frame& F, int b, int chunk, int cb, int mode, LruIn& in) {
    const bf16_t* Xb = (const bf16_t*)(F.ws + OV_X); const bf16_t* Yb = (const bf16_t*)(F.ws + OV_Y);
    const int ch0 = cb * 64, ct = F.tid >> 3, c8 = (F.tid & 7) * 8, d = F.wave >> 2, ch = (F.wave & 3) * 16 + (F.lane & 15);
    const int seg_lo = chunk < 4 ? 0 : 256, seg_hi = chunk < 4 ? 256 : TPB, j0 = chunk * 64;
#pragma unroll
    for (int jj = 0; jj < 4; ++jj) { const int j = j0 + ct + jj - 2; in.x[jj] = (u32x4){0u, 0u, 0u, 0u}; if (j >= seg_lo && j < seg_hi) in.x[jj] = *(const u32x4*)(Xb + (size_t)(b * TPB + j) * 512 + ch0 + c8); }
    in.y = (u32x4){0u, 0u, 0u, 0u}; in.hin = 0.f;
    if (mode == 1) { in.y = *(const u32x4*)(Yb + (size_t)(b * TPB + j0 + ct) * 512 + ch0 + c8); in.hin = ((const float*)(F.ws + WS_HIN))[(size_t)((b * 2 + d) * 68 + chunk) * 512 + ch0 + ch]; }
}
__device__ __forceinline__ void lru_compute(const Frame& F, const LruConst& c, const LruIn& in, int b, int chunk, int cb, int mode) {
    LAS float* xs = (LAS float*)F.lds;
    LAS bf16_t* xsb = (LAS bf16_t*)(F.lds + 16384);
    LAS float* hx = (LAS float*)(F.lds + 25600);
    bf16_t* OC = (bf16_t*)(F.ws + OV_OC);
    const int tok0 = b * TPB + chunk * 64, ch0 = cb * 64;
    const int lane = F.lane, fr = lane & 15, fq = lane >> 4, d = F.wave >> 2, nt = F.wave & 3, ch = nt * 16 + fr;
    const int ct = F.tid >> 3, c8 = (F.tid & 7) * 8;
    {
      f32x4 a0 = c.cbias[0], a1 = c.cbias[1];
#pragma unroll
      for (int jj = 0; jj < 4; ++jj) { const u32x4 w = in.x[jj];
          a0 += c.cw[jj][0] * (f32x4){bflo(w.x), bfhi(w.x), bflo(w.y), bfhi(w.y)}; a1 += c.cw[jj][1] * (f32x4){bflo(w.z), bfhi(w.z), bflo(w.w), bfhi(w.w)}; }
      *(LAS f32x4*)(xs + ct * 64 + c8) = a0; *(LAS f32x4*)(xs + ct * 64 + c8 + 4) = a1;
      u32x4 pw; pw.x = pk2(a0[0], a0[1]); pw.y = pk2(a0[2], a0[3]); pw.z = pk2(a1[0], a1[1]); pw.w = pk2(a1[2], a1[3]);
      *(LAS u32x4*)(xsb + ct * 72 + c8) = pw; }
    __syncthreads();
    f32x4 av[4], bv[4], hv[4];
#pragma unroll
    for (int m = 0; m < 4; ++m) {
        const bf16x8 a0 = *(const LAS bf16x8*)(xsb + (m * 16 + fr) * 72 + fq * 8), a1 = *(const LAS bf16x8*)(xsb + (m * 16 + fr) * 72 + 32 + fq * 8);
        f32x4 da = {0.f, 0.f, 0.f, 0.f}, dx = {0.f, 0.f, 0.f, 0.f};
        da = __builtin_amdgcn_mfma_f32_16x16x32_bf16(a0, c.wa0, da, 0, 0, 0); da = __builtin_amdgcn_mfma_f32_16x16x32_bf16(a1, c.wa1, da, 0, 0, 0);
        dx = __builtin_amdgcn_mfma_f32_16x16x32_bf16(a0, c.wx0, dx, 0, 0, 0); dx = __builtin_amdgcn_mfma_f32_16x16x32_bf16(a1, c.wx1, dx, 0, 0, 0);
#pragma unroll
        for (int r = 0; r < 4; ++r) { const float rg = sigmoidf_(da[r] + c.ba), ig = sigmoidf_(dx[r] + c.bx); const float la = -8.0f * rg * c.sp;
            const float e1 = expm1_fast(la);
            av[m][r] = 1.0f + e1; bv[m][r] = __builtin_sqrtf(-e1 * (2.0f + e1)) * (ig * xs[(m * 16 + fq * 4 + r) * 64 + ch]); hv[m][r] = 0.f; }
    }
    float sumA = 1.f, sumH = 0.f;
    if (d == 0) lru_scan<false>(av, bv, hv, lane, mode, in.hin, sumA, sumH); else lru_scan<true>(av, bv, hv, lane, mode, in.hin, sumA, sumH);
    if (mode == 0) {
        if (fq == 0) { float* sum = (float*)(F.ws + WS_SUM) + ((size_t)((b * 2 + d) * 68 + chunk) * 512 + ch0 + ch) * 2; *(float2*)sum = make_float2(sumA, sumH); }
        __syncthreads();
        return;
    }
#pragma unroll
    for (int m = 0; m < 4; ++m)
#pragma unroll
        for (int r = 0; r < 4; ++r) hx[d * 4096 + (m * 16 + fq * 4 + r) * 64 + ch] = hv[m][r];
    __syncthreads();
    { const u32x4 yv = in.y;
      const f32x4 f0 = *(const LAS f32x4*)(hx + ct * 64 + c8), f1 = *(const LAS f32x4*)(hx + ct * 64 + c8 + 4), g0 = *(const LAS f32x4*)(hx + 4096 + ct * 64 + c8), g1 = *(const LAS f32x4*)(hx + 4096 + ct * 64 + c8 + 4);
      u32x4 o; o.x = pk2(bflo(yv.x) * (f0[0] + g0[0]), bfhi(yv.x) * (f0[1] + g0[1])); o.y = pk2(bflo(yv.y) * (f0[2] + g0[2]), bfhi(yv.y) * (f0[3] + g0[3]));
      o.z = pk2(bflo(yv.z) * (f1[0] + g1[0]), bfhi(yv.z) * (f1[1] + g1[1])); o.w = pk2(bflo(yv.w) * (f1[2] + g1[2]), bfhi(yv.w) * (f1[3] + g1[3]));
      *(u32x4*)(OC + (size_t)(tok0 + ct) * 512 + ch0 + c8) = o; }
}
__device__ __forceinline__ void lru_phase(const Frame& F, CArgsP a, int l, int mode, bool skip_ctx) {
    constexpr int NIT = 4 * 68 * 8;
    int it = F.bid;
    while (it < NIT && skip_ctx && ((it >> 3) % 68) < 4) it += F.G;
    if (it >= NIT) return;
    LruConst c; LruIn cur, nxt;
    int cb = it & 7; lru_load_const(F, a, l, cb, c);
    lru_load_in(F, (it >> 3) / 68, (it >> 3) % 68, cb, mode, cur);
    for (;;) {
        int nit = it + F.G;
        while (nit < NIT && skip_ctx && ((nit >> 3) % 68) < 4) nit += F.G;
        const bool has = nit < NIT;
        if (has) lru_load_in(F, (nit >> 3) / 68, (nit >> 3) % 68, nit & 7, mode, nxt);
        lru_compute(F, c, cur, (it >> 3) / 68, (it >> 3) % 68, cb, mode);
        if (!has) break;
        if ((nit & 7) != cb) { cb = nit & 7; lru_load_const(F, a, l, cb, c); }
        it = nit; cur = nxt;
    }
}

__device__ __forceinline__ void phase_carry(const Frame& F) {
    const int gt = F.bid * NTHR + F.tid; if (gt >= 4 * 2 * 512) return;
    const int c = gt & 511, d = (gt >> 9) & 1, b = gt >> 10;
    const float* sum = (const float*)(F.ws + WS_SUM) + (size_t)((b * 2 + d) * 68) * 1024 + c * 2;
    float* hin = (float*)(F.ws + WS_HIN) + (size_t)((b * 2 + d) * 68) * 512 + c;
    float h = 0.f;
#pragma unroll 1
    for (int g0 = 0; g0 < 68; g0 += 17) {
        float A[17], Hh[17];
#pragma unroll
        for (int i = 0; i < 17; ++i) { const int o = g0 + i; const int ck = d == 0 ? o : (o < 4 ? 3 - o : 71 - o); const float2 v = *(const float2*)(sum + (size_t)ck * 1024); A[i] = v.x; Hh[i] = v.y; }
#pragma unroll
        for (int i = 0; i < 17; ++i) { const int o = g0 + i; const int ck = d == 0 ? o : (o < 4 ? 3 - o : 71 - o); hin[(size_t)ck * 512] = h; h = A[i] * h + Hh[i]; }
    }
}

constexpr int AT_KST = 272, AT_VST = 320;
constexpr int AT_KOFF = 0, AT_VOFF = 2 * 64 * AT_KST, AT_XOFF = AT_VOFF + 2 * 64 * AT_VST;
#define AT_SBAR() __builtin_amdgcn_sched_barrier(0)
struct AttnState { f32x16 o[4]; bf16x8 pfp[4]; float mrun, lrun; };
#define AT_PIN1(x) asm volatile("" : "+v"(x))
__device__ __forceinline__ float at_max3(float a, float b, float c) { float r; asm("v_max3_f32 %0, %1, %2, %3" : "=v"(r) : "v"(a), "v"(b), "v"(c)); return r; }
__device__ __forceinline__ bf16x8 at_vfrag(const LAS unsigned char* vp) {
    const s16x4 lo = __builtin_bit_cast(s16x4, __builtin_amdgcn_ds_read_tr16_b64_v4i16((LAS s16x4*)(vp)));
    const s16x4 hh = __builtin_bit_cast(s16x4, __builtin_amdgcn_ds_read_tr16_b64_v4i16((LAS s16x4*)(vp + 8 * AT_VST)));
    return (bf16x8){lo[0], lo[1], lo[2], lo[3], hh[0], hh[1], hh[2], hh[3]};
}
__device__ __forceinline__ float attn_stage1(const f32x16& p0, const f32x16& p1, f32x16& n0, f32x16& n1, const bf16x8 (&qr)[4], const LAS unsigned char* kf) {
    float mx = at_max3(p0[0], p0[1], at_max3(p1[0], p1[1], p1[1]));
    bf16x8 a0 = *(const LAS bf16x8*)(kf), a1 = *(const LAS bf16x8*)(kf + 32 * AT_KST);
    AT_SBAR();
#pragma unroll
    for (int ks = 0; ks < 4; ++ks) {
        bf16x8 b0 = a0, b1 = a1;
        if (ks < 3) { b0 = *(const LAS bf16x8*)(kf + (ks + 1) * 32); b1 = *(const LAS bf16x8*)(kf + 32 * AT_KST + (ks + 1) * 32); }
        if (ks == 0) n0 = __builtin_amdgcn_mfma_f32_32x32x16_bf16(a0, qr[0], (f32x16){0.f, 0.f, 0.f, 0.f, 0.f, 0.f, 0.f, 0.f, 0.f, 0.f, 0.f, 0.f, 0.f, 0.f, 0.f, 0.f}, 0, 0, 0);
        else n0 = __builtin_amdgcn_mfma_f32_32x32x16_bf16(a0, qr[ks], n0, 0, 0, 0);
        mx = at_max3(at_max3(mx, p0[4 * ks + 2], p0[4 * ks + 3]), p1[4 * ks + 2], p1[4 * ks + 3]); AT_PIN1(mx); AT_SBAR();
        if (ks == 0) n1 = __builtin_amdgcn_mfma_f32_32x32x16_bf16(a1, qr[0], (f32x16){0.f, 0.f, 0.f, 0.f, 0.f, 0.f, 0.f, 0.f, 0.f, 0.f, 0.f, 0.f, 0.f, 0.f, 0.f, 0.f}, 0, 0, 0);
        else n1 = __builtin_amdgcn_mfma_f32_32x32x16_bf16(a1, qr[ks], n1, 0, 0, 0);
        if (ks < 3) { mx = at_max3(at_max3(mx, p0[4 * ks + 4], p0[4 * ks + 5]), p1[4 * ks + 4], p1[4 * ks + 5]); AT_PIN1(mx); } AT_SBAR();
        a0 = b0; a1 = b1;
    }
    return mx;
}
template <bool FIRST>
__device__ __forceinline__ void attn_stage2(AttnState& st, const f32x16& p0, const f32x16& p1, float mx, const LAS unsigned char* vf) {
    constexpr float SC = 0.125f * 1.4426950408889634f, THR = 8.0f;
    bf16x8 vcur; if (!FIRST) vcur = at_vfrag(vf);
    float tm = fmaxf(mx, __shfl_xor(mx, 32)) * SC;
    if (__any(tm > st.mrun + THR)) {
        const float mn = fmaxf(st.mrun, tm); const float al = __builtin_amdgcn_exp2f(fmaxf(st.mrun - mn, -126.f));
#pragma unroll
        for (int db = 0; db < 4; ++db)
#pragma unroll
            for (int r = 0; r < 16; ++r) st.o[db][r] *= al;
        if (!FIRST) {
#pragma unroll
            for (int kk = 0; kk < 4; ++kk) { u32x4 w = __builtin_bit_cast(u32x4, st.pfp[kk]);
                w.x = pk2(bflo(w.x) * al, bfhi(w.x) * al); w.y = pk2(bflo(w.y) * al, bfhi(w.y) * al); w.z = pk2(bflo(w.z) * al, bfhi(w.z) * al); w.w = pk2(bflo(w.w) * al, bfhi(w.w) * al);
                st.pfp[kk] = __builtin_bit_cast(bf16x8, w); }
        }
        st.lrun *= al; st.mrun = mn;
    }
    const float nm = -st.mrun; float ls = 0.f;
    AT_SBAR();
#pragma unroll
    for (int kk = 0; kk < 4; ++kk) {
        unsigned pw0 = 0, pw1 = 0, pw2 = 0, pw3 = 0;
#pragma unroll
        for (int db = 0; db < 4; ++db) {
            const int g = kk * 4 + db;
            if (!FIRST) {
                bf16x8 vnext = vcur;
                if (g < 15) { const int g2 = g + 1; vnext = at_vfrag(vf + ((g2 >> 2) * 16) * AT_VST + (g2 & 3) * 64); }
                st.o[db] = __builtin_amdgcn_mfma_f32_32x32x16_bf16(vcur, st.pfp[kk], st.o[db], 0, 0, 0);
                vcur = vnext;
            }
            const float x0 = g < 8 ? p0[2 * g] : p1[2 * g - 16], x1 = g < 8 ? p0[2 * g + 1] : p1[2 * g - 15];
            const float e0 = __builtin_amdgcn_exp2f(__builtin_fmaf(x0, SC, nm)), e1 = __builtin_amdgcn_exp2f(__builtin_fmaf(x1, SC, nm));
            ls += e0 + e1; unsigned w = pk2(e0, e1); AT_PIN1(ls); AT_PIN1(w);
            if (db == 0) pw0 = w; else if (db == 1) pw1 = w; else if (db == 2) pw2 = w; else pw3 = w;
            AT_SBAR();
        }
        st.pfp[kk] = __builtin_bit_cast(bf16x8, (u32x4){pw0, pw1, pw2, pw3});
    }
    st.lrun += ls;
}
__device__ __forceinline__ void attn_unit(const Frame& F, int tokq0, int tokk0, int ntiles, int h, float lam, const float* gain, float oscale) {
    const bf16_t* Q = (const bf16_t*)(F.ws + OV_Q); const char* Kg = (const char*)(F.ws + OV_K); const char* Vg = (const char*)(F.ws + OV_V); bf16_t* OA = (bf16_t*)(F.ws + OV_OA);
    const int lane = F.lane, r32 = lane & 31, hi = lane >> 5, rb = F.wave >> 1, c = F.wave & 1;
    bf16x8 qr[4];
    { const bf16_t* qp = Q + (size_t)(tokq0 + rb * 32 + r32) * 512 + h * 128 + c * 64 + hi * 8;
#pragma unroll
      for (int ks = 0; ks < 4; ++ks) qr[ks] = *(const bf16x8*)(qp + ks * 16); }
    const int srow0 = F.tid >> 4, sch = F.tid & 15;
    const unsigned goff = (unsigned)(((tokk0 + srow0) * 512 + h * 128 + sch * 8) * 2);
    LAS unsigned char* kl = F.lds + AT_KOFF + srow0 * AT_KST + sch * 16;
    LAS unsigned char* vl = F.lds + AT_VOFF + srow0 * AT_VST + sch * 16;
    const LAS unsigned char* kfb = F.lds + AT_KOFF + r32 * AT_KST + (c * 64 + hi * 8) * 2;
    const LAS unsigned char* vfb = F.lds + AT_VOFF + (4 * hi + ((lane & 15) >> 2)) * AT_VST + (((lane >> 4) & 1) * 16 + (lane & 3) * 4) * 2;
    {
      const u32x4 k0 = *(const u32x4*)(Kg + goff), k1 = *(const u32x4*)(Kg + goff + 32 * 1024), k2 = *(const u32x4*)(Kg + goff + 64 * 1024), k3 = *(const u32x4*)(Kg + goff + 96 * 1024);
      *(LAS u32x4*)(kl) = k0; *(LAS u32x4*)(kl + 32 * AT_KST) = k1; *(LAS u32x4*)(kl + 64 * AT_KST) = k2; *(LAS u32x4*)(kl + 96 * AT_KST) = k3; }
    __syncthreads();
    AttnState st; st.mrun = -1e30f; st.lrun = 0.f;
#pragma unroll
    for (int db = 0; db < 4; ++db)
#pragma unroll
        for (int r = 0; r < 16; ++r) st.o[db][r] = 0.f;
    f32x16 pa0, pa1, pb0, pb1;
#pragma unroll
    for (int r = 0; r < 16; ++r) { pa0[r] = 0.f; pa1[r] = 0.f; }
#pragma unroll
    for (int ks = 0; ks < 4; ++ks) {
        const bf16x8 a0 = *(const LAS bf16x8*)(kfb + ks * 32), a1 = *(const LAS bf16x8*)(kfb + 32 * AT_KST + ks * 32);
        pa0 = __builtin_amdgcn_mfma_f32_32x32x16_bf16(a0, qr[ks], pa0, 0, 0, 0); pa1 = __builtin_amdgcn_mfma_f32_32x32x16_bf16(a1, qr[ks], pa1, 0, 0, 0);
    }
    asm volatile("s_nop 15\n\ts_nop 7" : "+v"(pa0), "+v"(pa1));
    u32x4 sv0 = *(const u32x4*)(Vg + goff), sv1 = *(const u32x4*)(Vg + goff + 32 * 1024);
#define AT_ITER(I, FIRSTF, PC0, PC1, PN0, PN1) do { \
        const int i_ = (I); const bool ldk_ = i_ + 2 < ntiles; const int sl_ = i_ & 1; \
        const float mx_ = attn_stage1(PC0, PC1, PN0, PN1, qr, kfb + ((i_ + 1) & 1) * (64 * AT_KST)); \
        *(LAS u32x4*)(vl + sl_ * (64 * AT_VST)) = sv0; *(LAS u32x4*)(vl + sl_ * (64 * AT_VST) + 32 * AT_VST) = sv1; \
        u32x4 sk0_, sk1_; if (ldk_) { const unsigned go_ = goff + (unsigned)(i_ + 2) * 65536u; sk0_ = *(const u32x4*)(Kg + go_); sk1_ = *(const u32x4*)(Kg + go_ + 32 * 1024); } \
        attn_stage2<FIRSTF>(st, PC0, PC1, mx_, vfb + ((i_ + 1) & 1) * (64 * AT_VST)); \
        if (ldk_) { *(LAS u32x4*)(kl + sl_ * (64 * AT_KST)) = sk0_; *(LAS u32x4*)(kl + sl_ * (64 * AT_KST) + 32 * AT_KST) = sk1_; } \
        if (i_ + 1 < ntiles) { const unsigned gv_ = goff + (unsigned)(i_ + 1) * 65536u; sv0 = *(const u32x4*)(Vg + gv_); sv1 = *(const u32x4*)(Vg + gv_ + 32 * 1024); } \
        __syncthreads(); } while (0)
    AT_ITER(0, true, pa0, pa1, pb0, pb1);
    AT_ITER(1, false, pb0, pb1, pa0, pa1);
#pragma unroll 1
    for (int i = 2; i < ntiles; i += 2) {
        AT_ITER(i, false, pa0, pa1, pb0, pb1);
        AT_ITER(i + 1, false, pb0, pb1, pa0, pa1);
    }
#undef AT_ITER
    {
      const LAS unsigned char* vf = vfb + ((ntiles - 1) & 1) * (64 * AT_VST);
#pragma unroll
      for (int db = 0; db < 4; ++db)
#pragma unroll
          for (int kk = 0; kk < 4; ++kk) {
              const LAS unsigned char* vp = vf + (kk * 16) * AT_VST + db * 64;
              const s16x4 lo = __builtin_bit_cast(s16x4, __builtin_amdgcn_ds_read_tr16_b64_v4i16((LAS s16x4*)(vp)));
              const s16x4 hh = __builtin_bit_cast(s16x4, __builtin_amdgcn_ds_read_tr16_b64_v4i16((LAS s16x4*)(vp + 8 * AT_VST)));
              const bf16x8 vfr = {lo[0], lo[1], lo[2], lo[3], hh[0], hh[1], hh[2], hh[3]};
              st.o[db] = __builtin_amdgcn_mfma_f32_32x32x16_bf16(vfr, st.pfp[kk], st.o[db], 0, 0, 0);
          } }
    float lrun = st.lrun; lrun += __shfl_xor(lrun, 32);
    const float il = 1.f / lrun;
    LAS float* ex = (LAS float*)(F.lds + AT_XOFF) + rb * 4096;
    if (c == 1) {
#pragma unroll
        for (int db = 0; db < 4; ++db)
#pragma unroll
            for (int r = 0; r < 16; ++r) ex[(db * 16 + r) * 64 + lane] = st.o[db][r] * il;
    }
    __syncthreads();
    if (c == 0) {
        float ss = 0.f;
#pragma unroll
        for (int db = 0; db < 4; ++db)
#pragma unroll
            for (int r = 0; r < 16; ++r) { const float dv = st.o[db][r] * il - lam * ex[(db * 16 + r) * 64 + lane]; st.o[db][r] = dv; ss += dv * dv; }
        ss += __shfl_xor(ss, 32);
        const float rinv = oscale / sqrtf(ss * (1.f / 128.f) + RMS_EPS);
        bf16_t* op = OA + (size_t)(tokq0 + rb * 32 + r32) * 512 + h * 128;
#pragma unroll
        for (int db = 0; db < 4; ++db)
#pragma unroll
            for (int r4 = 0; r4 < 4; ++r4) { const int dv0 = db * 32 + 8 * r4 + 4 * hi; const f32x4 gv = *(const f32x4*)(gain + dv0);
                u32x2 w; w.x = pk2(st.o[db][4 * r4] * rinv * gv[0], st.o[db][4 * r4 + 1] * rinv * gv[1]); w.y = pk2(st.o[db][4 * r4 + 2] * rinv * gv[2], st.o[db][4 * r4 + 3] * rinv * gv[3]);
                *(u32x2*)(op + dv0) = w; }
    }
    __syncthreads();
}

__device__ __forceinline__ void phase_attn(const Frame& F, CArgsP a, int l) {
    const float lam = ((const float*)(F.ws + WS_LAM))[l]; const float li = 0.8f - 0.6f * expf(-0.3f * (float)l);
    for (int dd = 0; dd < NDUP(6); ++dd) lru_phase(F, a, l, 1, l == 1);
    __syncthreads();
    const int nlat = 4 * 4 * 32, nctx = (l == 0) ? 4 * 4 * 2 : 0;
    for (int dd = 0; dd < NDUP(7); ++dd)
    for (int it = F.vcu; it < nlat + nctx; it += F.G) {
        int b, h, qb, tq0, nt;
        if (it < nlat) { qb = it & 31; h = (it >> 5) & 3; b = it >> 7; tq0 = b * TPB + CTX + qb * 128; nt = 68; }
        else { const int i2 = it - nlat; qb = i2 & 1; h = (i2 >> 1) & 3; b = i2 >> 3; tq0 = b * TPB + qb * 128; nt = 4; }
        attn_unit(F, tq0, b * TPB, nt, h, lam, a->in[12] + (l * 4 + h) * 128, 1.0f - li);
    }
}

__device__ __forceinline__ void mini_tile(const bf16_t* A, int lda, const bf16_t* Bt, int K, int lane, int wave, f32x4 (&acc)[2]) {
    const int fr = lane & 15, fq = lane >> 4;
    const bf16_t* ap = A + (size_t)((wave >> 1) * 16 + fr) * lda + fq * 8;
    const bf16_t* bp0 = Bt + (size_t)((wave & 1) * 32 + fr) * K + fq * 8; const bf16_t* bp1 = bp0 + (size_t)16 * K;
    acc[0] = (f32x4){0.f, 0.f, 0.f, 0.f}; acc[1] = (f32x4){0.f, 0.f, 0.f, 0.f};
#pragma unroll 8
    for (int k = 0; k < K; k += 32) {
        const bf16x8 av = *(const bf16x8*)(ap + k), b0 = *(const bf16x8*)(bp0 + k), b1 = *(const bf16x8*)(bp1 + k);
        acc[0] = __builtin_amdgcn_mfma_f32_16x16x32_bf16(b0, av, acc[0], 0, 0, 0); acc[1] = __builtin_amdgcn_mfma_f32_16x16x32_bf16(b1, av, acc[1], 0, 0, 0);
    }
}
__device__ __forceinline__ void mini_merge_ctx(const Frame& F, int l) {
    const int fr = F.lane & 15, fq = F.lane >> 4;
    for (int t = F.bid; t < 256; t += F.G) {
        const int rb = t >> 4, cbk = t & 15, cr = rb * 64, tok0 = (cr >> 8) * TPB + (cr & 255), col0 = cbk * 64;
        const int row = tok0 + (F.wave >> 1) * 16 + fr, colw = col0 + (F.wave & 1) * 32 + fq * 4;
        f32x4 mg[2] = {{0.f, 0.f, 0.f, 0.f}, {0.f, 0.f, 0.f, 0.f}};
#pragma unroll 1
        for (int r = 0; r < 3; ++r) {
            f32x4 acc[2];
            mini_tile((const bf16_t*)(F.ws + OV_OA + (size_t)r * 17 * MiB) + (size_t)tok0 * 512, 512, (const bf16_t*)(F.ws + WS_WBR) + (size_t)(l * 3 + r) * 1024 * 512 + (size_t)col0 * 512, 512, F.lane, F.wave, acc);
#pragma unroll
            for (int n = 0; n < 2; ++n) { const u32x2 g = *(const u32x2*)((const bf16_t*)(F.ws + OV_G) + (size_t)row * 3072 + r * 1024 + colw + n * 16);
                mg[n][0] += bflo(g.x) * acc[n][0]; mg[n][1] += bfhi(g.x) * acc[n][1]; mg[n][2] += bflo(g.y) * acc[n][2]; mg[n][3] += bfhi(g.y) * acc[n][3]; }
        }
#pragma unroll
        for (int n = 0; n < 2; ++n) { u32x2 w; w.x = pk2(mg[n][0], mg[n][1]); w.y = pk2(mg[n][2], mg[n][3]); *(u32x2*)((bf16_t*)(F.ws + OV_MG) + (size_t)row * DM + colw + n * 16) = w; }
    }
}
__device__ __forceinline__ void mini_wout_ctx(const Frame& F, int l) {
    const int fr = F.lane & 15, fq = F.lane >> 4;
    const float* g1 = (const float*)(F.ws + WS_MOD) + (l * 5 + 4) * 6144 + 2048;
    for (int t = F.bid; t < 256; t += F.G) {
        const int rb = t >> 4, cbk = t & 15, cr = rb * 64, tok0 = (cr >> 8) * TPB + (cr & 255), col0 = cbk * 64;
        const int crow = cr + (F.wave >> 1) * 16 + fr, colw = col0 + (F.wave & 1) * 32 + fq * 4;
        f32x4 acc[2];
        mini_tile((const bf16_t*)(F.ws + OV_MG) + (size_t)tok0 * DM, DM, (const bf16_t*)(F.ws + WS_WOUT) + (size_t)l * 1048576 + (size_t)col0 * 1024, 1024, F.lane, F.wave, acc);
#pragma unroll
        for (int n = 0; n < 2; ++n) { f32x4* p = (f32x4*)((float*)(F.ws + WS_XC) + (size_t)crow * DM + colw + n * 16); const f32x4 gv = *(const f32x4*)(g1 + colw + n * 16); const f32x4 x = *p; *p = x * DN_ALPHA + gv * acc[n]; }
    }
}

constexpr int RT_AST = 1032;
__device__ __forceinline__ void phase_router(const Frame& F, CArgsP a, int l, bool dry) {
    const float* mod = (const float*)(F.ws + WS_MOD) + l * 5 * 6144; float* xc = (float*)(F.ws + WS_XC); bf16_t* H = (bf16_t*)(F.ws + WS_H);
    LAS bf16_t* AT = (LAS bf16_t*)F.lds;
    LAS float* LG = (LAS float*)(F.lds + 32 * RT_AST * 2);
    LAS unsigned* LC = (LAS unsigned*)(F.lds + 32 * RT_AST * 2 + 8192);
    const bf16_t* Wt = (const bf16_t*)(F.ws + WS_WRT) + (size_t)l * 65536; const float rb_ = a->in[29][l * 64 + F.lane];
    unsigned* cnt = (unsigned*)(F.ws + WS_CNT) + l * 64; int* list = (int*)(F.ws + WS_LIST);
    int* toke = (int*)(F.ws + WS_TOKE); int* tokp = (int*)(F.ws + WS_TOKP); float* tokw = (float*)(F.ws + WS_TOKW);
    const int nrows = l == 0 ? T : NBATCH * SEQ, nbatch = nrows / 32;
    const int fr = F.lane & 15, fq = F.lane >> 4, mt = F.wave & 1, nt = F.wave >> 1;
    if (F.tid < 64) LC[F.tid] = 0u;
    for (int bt = F.bid; bt < nbatch; bt += F.G) {
        int toks[4];
#pragma unroll
        for (int r = 0; r < 4; ++r) { const int ridx = bt * 32 + F.wave * 4 + r; const int tok = l == 0 ? ridx : (ridx >> 12) * TPB + CTX + (ridx & 4095); toks[r] = tok;
            const int b = tok / TPB; const int bsel = (tok - b * TPB) < CTX ? 4 : b;
            float* xr = resid_row(F.out, xc, tok);
            f32x4 v[4]; row_load(xr, F.lane, v); row_ln(v); row_affine(v, a->in[26] + l * DM, false, a->in[27] + l * DM, F.lane); if (!dry) row_store(xr, F.lane, v);
            row_ln(v); const float* mrow = mod + bsel * 6144; row_affine(v, mrow + 4096, true, mrow + 3072, F.lane);
#pragma unroll
            for (int j = 0; j < 4; ++j) { u32x2 w; w.x = pk2(v[j][0], v[j][1]); w.y = pk2(v[j][2], v[j][3]);
                if (!dry) *(u32x2*)(H + (size_t)tok * DM + 4 * F.lane + 256 * j) = w; *(LAS u32x2*)(AT + (F.wave * 4 + r) * RT_AST + 4 * F.lane + 256 * j) = w; }
        }
        __syncthreads();
        { f32x4 d = {0.f, 0.f, 0.f, 0.f};
          const LAS bf16_t* ap = AT + (mt * 16 + fr) * RT_AST + fq * 8; const bf16_t* bp = Wt + (size_t)(nt * 16 + fr) * 1024 + fq * 8;
#pragma unroll 8
          for (int ks = 0; ks < 32; ++ks) { const bf16x8 av = *(const LAS bf16x8*)(ap + ks * 32); const bf16x8 bv = *(const bf16x8*)(bp + ks * 32); d = __builtin_amdgcn_mfma_f32_16x16x32_bf16(av, bv, d, 0, 0, 0); }
#pragma unroll
          for (int r = 0; r < 4; ++r) LG[(mt * 16 + fq * 4 + r) * 64 + nt * 16 + fr] = d[r]; }
        __syncthreads();
        bool selr[4]; int rkr[4], lpr[4]; float wr_[4];
#pragma unroll
        for (int r = 0; r < 4; ++r) {
            const float lg = LG[(F.wave * 4 + r) * 64 + F.lane];
            const float s = 1.f / (1.f + expf(-lg)); const float bsc = s + rb_;
            float m1 = bsc; m1 = fmaxf(m1, __shfl_xor(m1, 1)); m1 = fmaxf(m1, __shfl_xor(m1, 2)); m1 = fmaxf(m1, __shfl_xor(m1, 4));
            const unsigned long long eq = __ballot(bsc == m1); const unsigned gm = (unsigned)(eq >> (F.lane & ~7)) & 0xffu; const int first = __ffs(gm) - 1;
            float m2 = ((F.lane & 7) == first) ? -INFINITY : bsc; m2 = fmaxf(m2, __shfl_xor(m2, 1)); m2 = fmaxf(m2, __shfl_xor(m2, 2)); m2 = fmaxf(m2, __shfl_xor(m2, 4));
            const float gs = m1 + m2; const int myg = F.lane >> 3; int grank = 0;
#pragma unroll
            for (int g = 0; g < 8; ++g) { const float og = __shfl(gs, g * 8); grank += (og > gs || (og == gs && g < myg)) ? 1 : 0; }
            const bool gsel = grank < 4; const float mk = gsel ? bsc : -INFINITY; int rk = 0;
#pragma unroll
            for (int j = 0; j < 64; ++j) { const float vj = __shfl(mk, j); rk += (vj > mk || (vj == mk && j < F.lane)) ? 1 : 0; }
            const bool sel = gsel && rk < 8 && !dry;
            const float ssum = wave_sum((gsel && rk < 8) ? s : 0.f);
            selr[r] = sel; rkr[r] = rk; wr_[r] = s / ssum * 2.5f; lpr[r] = 0;
            if (sel) lpr[r] = (int)__hip_atomic_fetch_add((LAS unsigned*)(LC + F.lane), 1u, __ATOMIC_RELAXED, __HIP_MEMORY_SCOPE_WORKGROUP);
        }
        __syncthreads();
        if (F.tid < 64) { const unsigned n = LC[F.tid]; unsigned base = 0; if (n) base = atomicAdd(cnt + F.tid, n); LC[64 + F.tid] = base; LC[F.tid] = 0u; }
        __syncthreads();
#pragma unroll
        for (int r = 0; r < 4; ++r)
            if (selr[r]) { const int tok = toks[r]; const int pos = (int)LC[64 + F.lane] + lpr[r];
                list[(size_t)F.lane * T + pos] = tok; toke[tok * 8 + rkr[r]] = F.lane; tokp[tok * 8 + rkr[r]] = pos; tokw[tok * 8 + rkr[r]] = wr_[r]; }
        __syncthreads();
    }
}

__device__ __forceinline__ void build_tables(const Frame& F, int l) {
    LAS int* tb = (LAS int*)(F.lds + LDS_CTL);
    __syncthreads();
    if (F.tid < 64) tb[LC_TCNT + F.tid] = (int)__hip_atomic_load((unsigned*)(F.ws + WS_CNT) + l * 64 + F.tid, __ATOMIC_RELAXED, __HIP_MEMORY_SCOPE_AGENT);
    __syncthreads();
    if (F.tid == 0) { int tbs = 0, sbs = 0;
        for (int e = 0; e < 64; ++e) { const int c = tb[LC_TCNT + e]; tb[LC_TBASE + e] = tbs; tb[LC_SBASE + e] = sbs; tbs += (c + 255) >> 8; sbs += c; }
        tb[LC_TBASE + 64] = tbs; tb[LC_SBASE + 64] = sbs; }
    __syncthreads();
}

__device__ __forceinline__ void phase_combine(const Frame& F, CArgsP a, int l, bool dry) {
    const float* mod = (const float*)(F.ws + WS_MOD) + l * 5 * 6144; float* xc = (float*)(F.ws + WS_XC); bf16_t* H = (bf16_t*)(F.ws + WS_H);
    const bf16_t* YS = (const bf16_t*)(F.ws + OV_YS); const LAS int* tb = (const LAS int*)(F.lds + LDS_CTL);
    const int* toke = (const int*)(F.ws + WS_TOKE); const int* tokp = (const int*)(F.ws + WS_TOKP); const float* tokw = (const float*)(F.ws + WS_TOKW);
    const int nrows = l == 0 ? T : NBATCH * SEQ;
    for (int ridx = F.gw; ridx < nrows; ridx += F.NGW) {
        const int tok = l == 0 ? ridx : (ridx >> 12) * TPB + CTX + (ridx & 4095);
        const int b = tok / TPB; const int bsel = (tok - b * TPB) < CTX ? 4 : b;
        int me = 0, mp = 0; float mw = 0.f;
        if (F.lane < 8) { me = toke[tok * 8 + F.lane]; mp = tokp[tok * 8 + F.lane]; mw = tokw[tok * 8 + F.lane]; }
        f32x4 y[4];
        { const bf16_t* sp = H + (size_t)tok * DM;
#pragma unroll
          for (int j = 0; j < 4; ++j) { const u32x2 w = *(const u32x2*)(sp + 4 * F.lane + 256 * j); y[j] = (f32x4){bflo(w.x), bfhi(w.x), bflo(w.y), bfhi(w.y)}; } }
#pragma unroll
        for (int k = 0; k < 8; ++k) { const int e = __shfl(me, k), p = __shfl(mp, k); const float wv = __shfl(mw, k);
            const bf16_t* yp = YS + (size_t)(tb[LC_SBASE + e] + p) * DM;
#pragma unroll
            for (int j = 0; j < 4; ++j) { const u32x2 w = *(const u32x2*)(yp + 4 * F.lane + 256 * j); y[j][0] += wv * bflo(w.x); y[j][1] += wv * bfhi(w.x); y[j][2] += wv * bflo(w.y); y[j][3] += wv * bfhi(w.y); } }
        float* xr = resid_row(F.out, xc, tok);
        f32x4 v[4]; row_load(xr, F.lane, v);
        const float* g2 = mod + bsel * 6144 + 5120;
#pragma unroll
        for (int j = 0; j < 4; ++j) { const f32x4 gv = *(const f32x4*)(g2 + 4 * F.lane + 256 * j); v[j] = v[j] * DN_ALPHA + gv * y[j]; }
        row_ln(v); row_affine(v, a->in[36] + l * DM, false, a->in[37] + l * DM, F.lane); if (!dry) row_store(xr, F.lane, v); else asm volatile("" :: "v"(v[0]), "v"(v[1]), "v"(v[2]), "v"(v[3]));
        if (l == 0 && !dry) { row_ln(v); const float* mrow = mod + 5 * 6144 + bsel * 6144; row_affine(v, mrow + 1024, true, mrow, F.lane); row_store_bf16(H + (size_t)tok * DM, F.lane, v); }
    }
}

constexpr int NPHASE = 22;
__global__ void __launch_bounds__(NTHR, 2) mk_fwd(Args args) {
    extern __shared__ __attribute__((aligned(16))) unsigned char lds_raw[];
    Frame F; F.lds = (LAS unsigned char*)lds_raw; F.tid = threadIdx.x; F.lane = F.tid & 63; F.wave = __builtin_amdgcn_readfirstlane(F.tid >> 6);
    F.G = gridDim.x; F.bid = blockIdx.x; F.gw = F.bid * NWAVES + F.wave; F.NGW = F.G * NWAVES; F.ws = args.ws; F.out = args.out; F.vcu = (F.G % 8 == 0) ? (F.bid % 8) * (F.G / 8) + F.bid / 8 : F.bid;
    for (int u = F.tid; u < (LDS_BYTES - LDS_CTL) / 4; u += NTHR) ((LAS unsigned*)(F.lds + LDS_CTL))[u] = 0u;
    __syncthreads();
    const int lo = args.ph_lo, hi = args.ph_hi;
    CArgsP A4 = (CArgsP)__builtin_amdgcn_kernarg_segment_ptr();
    XcdBarrier bar; bar.bar = (unsigned*)(F.ws + CW_BAR_BYTE); bar.x = 0; bar.st = nullptr;
    if (hi - lo > 1) bar = xcd_barrier_post((unsigned*)(F.ws + CW_BAR_BYTE), (volatile LAS unsigned*)(F.lds + LDS_CTL) + LC_BAR);
#ifndef PHMASK
#define PHMASK 0xfff
#endif
#define PH_EN(k) ((PHMASK >> ((k) < 2 ? (k) : 2 + (((k) - 2) % 10))) & 1)
#define IN(k) (PH_EN(k) && lo <= (k) && (k) < hi)
#define SEAM(k) do { if (IN(k) && IN((k) + 1)) { for (int dd = 0; dd < NDUP(14); ++dd) xcd_barrier(bar); } if (TSMASK != 0 && blockIdx.x == 0 && threadIdx.x == 0) { ((volatile LAS unsigned long long*)(F.lds + LDS_CTL + 2048))[(k) + 1] = __builtin_amdgcn_s_memrealtime(); } FRESH(); } while (0)
#define FRESH() do { int t_ = threadIdx.x, b_ = blockIdx.x; CArgsP p_ = (CArgsP)__builtin_amdgcn_kernarg_segment_ptr(); asm volatile("" : "+v"(t_)); asm volatile("" : "+s"(b_), "+s"(p_)); A4 = p_; unsigned char* w_ = p_->ws; float* o_ = p_->out; \
    F.tid = t_; F.lane = t_ & 63; F.wave = __builtin_amdgcn_readfirstlane(t_ >> 6); F.bid = b_; F.gw = b_ * NWAVES + F.wave; F.ws = w_; F.out = o_; F.vcu = (F.G % 8 == 0) ? (b_ % 8) * (F.G / 8) + b_ / 8 : b_; } while (0)
    if (TSMASK != 0 && blockIdx.x == 0 && threadIdx.x == 0) ((volatile LAS unsigned long long*)(F.lds + LDS_CTL + 2048))[0] = __builtin_amdgcn_s_memrealtime();
    if (IN(0)) { for (int dd = 0; dd < NDUP(0); ++dd) phase_prologue(F, A4); } SEAM(0);
    if (IN(1)) { for (int dd = 0; dd < NDUP(1); ++dd) phase_rows0(F, A4); } SEAM(1);
#pragma unroll 1
    for (int l = 0; l < 2; ++l) {
        const int pb = 2 + 10 * l; const bool lat = (l == 1);
        if (IN(pb + 0)) {
            SchedPlain S{(const char*)(F.ws + WS_H), (const char*)(F.ws + WS_WIN) + (size_t)l * INC * 1024 * 2, 1024, 68, 26, F.G, F.bid, false};
            EpiInproj E{F.ws, A4->in[7] + l * INC, (const float*)(F.ws + WS_ROPE)};
            for (int dd = 0; dd < NDUP(2); ++dd) pg8::gemm_phase(F.lds, 1024, S, E);
        } SEAM(pb + 0);
        if (IN(pb + 1)) {
            for (int dd = 0; dd < NDUP(3); ++dd) lru_phase(F, A4, l, 0, false);
            for (int dd = 0; dd < NDUP(4); ++dd)
            for (int it = F.bid; it < 136 * 4; it += F.G) { const int chunk = it >> 2; if (lat && (chunk % 34) < 2) continue; sg_item(F, A4, l, chunk, it & 3); }
        } SEAM(pb + 1);
        if (IN(pb + 2)) { for (int dd = 0; dd < NDUP(5); ++dd) phase_carry(F); } SEAM(pb + 2);
        if (IN(pb + 3)) { phase_attn(F, A4, l); } SEAM(pb + 3);
        if (IN(pb + 4)) {
            for (int dd = 0; dd < NDUP(8); ++dd)
#pragma unroll 1
            for (int r = 0; r < 3; ++r) {
                SchedPlain S{(const char*)(F.ws + OV_OA + (size_t)r * 17 * MiB), (const char*)(F.ws + WS_WBR) + (size_t)(l * 3 + r) * 1024 * 512 * 2, 512, 64, 4, F.G, F.bid, true};
                EpiMerge E{(bf16_t*)(F.ws + OV_MG), (const bf16_t*)(F.ws + OV_G), r};
                pg8::gemm_phase(F.lds, 512, S, E);
            }
            if (!lat) mini_merge_ctx(F, l);
        } SEAM(pb + 4);
        if (IN(pb + 5)) {
            SchedPlain S{(const char*)(F.ws + OV_MG), (const char*)(F.ws + WS_WOUT) + (size_t)l * 1048576 * 2, 1024, 64, 4, F.G, F.bid, true};
            EpiWout E{F.out, (float*)(F.ws + WS_XC), (const float*)(F.ws + WS_MOD) + l * 5 * 6144, false};
            pg8::gemm_phase(F.lds, 1024, S, E);
            if (NDUP(11) > 1) { EpiWout E2{F.out, (float*)(F.ws + WS_XC), (const float*)(F.ws + WS_MOD) + l * 5 * 6144, true}; pg8::gemm_phase(F.lds, 1024, S, E2); }
            if (!lat) mini_wout_ctx(F, l);
        } SEAM(pb + 5);
        if (IN(pb + 6)) { phase_router(F, A4, l, false); if (NDUP(12) > 1) phase_router(F, A4, l, F.G != 12345); } SEAM(pb + 6);
        if (IN(pb + 7)) {
            build_tables(F, l);
            SchedMoe S{(const char*)(F.ws + WS_H), (const char*)(F.ws + WS_H), (const char*)(F.ws + WS_WM1), (const char*)(F.ws + WS_WSH1) + (size_t)l * 524288 * 2,
                       (const int*)(F.ws + WS_LIST), (const LAS int*)(F.lds + LDS_CTL), 1024, 2, F.G, F.vcu, lat ? 64 : 68, lat, true, (size_t)524288 * 2};
            EpiMoe1 E{(bf16_t*)(F.ws + OV_ACT), (bf16_t*)(F.ws + OV_ACTSH)};
            for (int dd = 0; dd < NDUP(9); ++dd) pg8::gemm_phase(F.lds, 1024, S, E);
        } SEAM(pb + 7);
        if (IN(pb + 8)) {
            build_tables(F, l);
            SchedMoe S{(const char*)(F.ws + OV_ACT), (const char*)(F.ws + OV_ACTSH), (const char*)(F.ws + WS_WM2), (const char*)(F.ws + WS_WSH2) + (size_t)l * 262144 * 2,
                       (const int*)(F.ws + WS_LIST), (const LAS int*)(F.lds + LDS_CTL), 256, 4, F.G, F.vcu, lat ? 64 : 68, lat, false, (size_t)262144 * 2};
            EpiMoe2 E{(bf16_t*)(F.ws + OV_YS), (bf16_t*)(F.ws + WS_H)};
            for (int dd = 0; dd < NDUP(10); ++dd) pg8::gemm_phase(F.lds, 256, S, E);
        } SEAM(pb + 8);
        if (IN(pb + 9)) {
            build_tables(F, l);
            phase_combine(F, A4, l, false);
            if (NDUP(13) > 1) phase_combine(F, A4, l, F.G != 12345);
            if (l == 0) for (int dd = 0; dd < NDUP(15); ++dd) conv_moe_layer(F, A4, 1);
        } SEAM(pb + 9);
    }
    if (TSMASK != 0 && hi - lo == NPHASE) { __syncthreads(); asm volatile("s_waitcnt vmcnt(0)" ::: "memory");
        if (blockIdx.x == 0 && threadIdx.x == 0) { volatile LAS unsigned long long* ts = (volatile LAS unsigned long long*)(F.lds + LDS_CTL + 2048);
            unsigned long long sel = 0; for (int k = 0; k < NPHASE; ++k) if ((TSMASK >> k) & 1) sel += ts[k + 1] - ts[k];
            const float frac = (float)sel / (float)(ts[NPHASE] - ts[0]); args.out[0] += 1.0f + floorf(90.0f * frac + 0.5f); } }
#undef IN
#undef SEAM
}

extern "C" void kernel_launch(void* const* d_in, const int* in_sizes, int n_in, void* d_out, int out_size, void* d_ws, size_t ws_size, hipStream_t stream) {
    static int grid = 0;
    if (grid == 0) {
        if (n_in != 38 || out_size != NBATCH * SEQ * DM || ws_size < WS_END) { fprintf(stderr, "kernel_launch: unexpected shapes (n_in %d out %d ws %zu need %zu)\n", n_in, out_size, ws_size, (size_t)WS_END); grid = -1; return; }
        int dev = 0, cus = 0;
        if (hipGetDevice(&dev) != hipSuccess || hipDeviceGetAttribute(&cus, hipDeviceAttributeMultiprocessorCount, dev) != hipSuccess) { grid = -1; return; }
        if (hipFuncSetAttribute((const void*)mk_fwd, hipFuncAttributeMaxDynamicSharedMemorySize, LDS_BYTES) != hipSuccess) { fprintf(stderr, "kernel_launch: hipFuncSetAttribute failed\n"); grid = -1; return; }
        int per_cu = 0;
        if (hipOccupancyMaxActiveBlocksPerMultiprocessor(&per_cu, (const void*)mk_fwd, NTHR, LDS_BYTES) != hipSuccess || per_cu < 1) fprintf(stderr, "kernel_launch: occupancy query says %d\n", per_cu);
        (void)hipGetLastError();
        grid = cus;
    }
    if (grid < 0) return;
    (void)hipMemsetAsync((char*)d_ws + WS_CTL, 0, CTL_ZERO_BYTES, stream);
    Args a{};
    for (int i = 0; i < 38; ++i) a.in[i] = (const float*)d_in[i];
    a.out = (float*)d_out; a.ws = (unsigned char*)d_ws;
#if MK_MULTI
    for (int p = 0; p < NPHASE; ++p) { a.ph_lo = p; a.ph_hi = p + 1; hipLaunchKernelGGL(mk_fwd, dim3(grid), dim3(NTHR), LDS_BYTES, stream, a); }
#else
    a.ph_lo = 0; a.ph_hi = NPHASE; hipLaunchKernelGGL(mk_fwd, dim3(grid), dim3(NTHR), LDS_BYTES, stream, a);
#endif
}
```

```cpp
#include <hip/hip_runtime.h>
#include <cstdio>
#include <cstdint>
#include <cmath>

#ifndef MK_MULTI
#define MK_MULTI 0
#endif
#ifndef DUPMASK
#define DUPMASK 0
#endif
#define NDUP(c) (1 + ((DUPMASK >> (c)) & 1))
#ifndef TSMASK
#define TSMASK 0
#endif
#ifndef NAIVE_GEMM
#define NAIVE_GEMM 0
#endif

#define LAS __attribute__((address_space(3)))
#define GAS __attribute__((address_space(1)))
typedef unsigned short bf16_t;
typedef short bf16x8 __attribute__((ext_vector_type(8)));
typedef short s16x4 __attribute__((ext_vector_type(4)));
typedef float f32x4 __attribute__((ext_vector_type(4)));
typedef float f32x16 __attribute__((ext_vector_type(16)));
typedef unsigned u32x4 __attribute__((ext_vector_type(4)));
typedef unsigned u32x2 __attribute__((ext_vector_type(2)));

constexpr int DM = 1024, NBATCH = 4, SEQ = 4096, CTX = 256, TPB = SEQ + CTX  , T = NBATCH * TPB  ;
constexpr int INC = 6656, NEXP = 64;
constexpr float DN_ALPHA = 1.41421356237309515f;
constexpr float LN_EPS = 1e-6f, RMS_EPS = 1e-5f;
constexpr int NWAVES = 8, NTHR = 512;

constexpr size_t MiB = 1u << 20;
constexpr size_t WS_CTL = 0, CTL_ZERO_BYTES = 1 * MiB;
constexpr size_t CW_BAR_BYTE = 16384;
constexpr size_t WS_CNT = 65536;
constexpr size_t WS_MOD = 131072;
constexpr size_t WS_ROPE = 1 * MiB;
constexpr size_t WS_LAM = 1 * MiB + 8192;
constexpr size_t WS_SUM = 1 * MiB + 65536;
constexpr size_t WS_HIN = WS_SUM + 2304 * 1024;
constexpr size_t WS_TOKE = 5 * MiB, WS_TOKP = 6 * MiB, WS_TOKW = 7 * MiB;
constexpr size_t WS_LIST = 8 * MiB;
constexpr size_t WS_XC = 13 * MiB;
constexpr size_t WS_WLRU = 17 * MiB;
constexpr size_t WS_WSG = 17 * MiB + 512 * 1024;
constexpr size_t WS_WRT = 17 * MiB + 768 * 1024;
constexpr size_t WS_WSH1 = 18 * MiB;
constexpr size_t WS_WSH2 = 20 * MiB;
constexpr size_t WS_WOUT = 21 * MiB;
constexpr size_t WS_WBR = 25 * MiB;
constexpr size_t WS_WIN = 31 * MiB;
constexpr size_t WS_WM1 = 57 * MiB;
constexpr size_t WS_WM2 = 121 * MiB;
constexpr size_t WS_H = 153 * MiB;
constexpr size_t WS_OV = 187 * MiB;
constexpr size_t OV_Q = WS_OV, OV_K = WS_OV + 17 * MiB, OV_V = WS_OV + 34 * MiB, OV_U = WS_OV + 51 * MiB, OV_S = WS_OV + 68 * MiB,
                 OV_X = WS_OV + 85 * MiB, OV_Y = WS_OV + 102 * MiB, OV_G = WS_OV + 119 * MiB, OV_OA = WS_OV + 221 * MiB,
                 OV_OB = WS_OV + 238 * MiB, OV_OC = WS_OV + 255 * MiB, OV_MG = WS_OV + 272 * MiB;
constexpr size_t OV_ACT = WS_OV, OV_ACTSH = WS_OV + 69 * MiB, OV_YS = WS_OV + 78 * MiB;
constexpr size_t WS_END = WS_OV + 350 * MiB;

constexpr int LDS_SCRATCH = 147456;
constexpr int LDS_CTL = LDS_SCRATCH;
constexpr int LDS_BYTES = LDS_SCRATCH + 4096;
constexpr int LC_BAR = 0;
constexpr int LC_TCNT = 64, LC_TBASE = 64 + 80, LC_SBASE = 64 + 160;

struct Args { const float* in[38]; float* out; unsigned char* ws; int ph_lo, ph_hi; };
typedef const Args __attribute__((address_space(4)))* CArgsP;

__device__ __forceinline__ unsigned f2bf(float f) { unsigned u = __builtin_bit_cast(unsigned, f); return (u + 0x7fffu + ((u >> 16) & 1u)) >> 16; }
typedef float f32x2 __attribute__((ext_vector_type(2))); typedef __bf16 bf16x2_t __attribute__((ext_vector_type(2)));
__device__ __forceinline__ unsigned pk2(float lo, float hi) { const f32x2 v = {lo, hi}; const bf16x2_t b = __builtin_convertvector(v, bf16x2_t); return __builtin_bit_cast(unsigned, b); }
__device__ __forceinline__ float bflo(unsigned w) { return __builtin_bit_cast(float, w << 16); }
__device__ __forceinline__ float bfhi(unsigned w) { return __builtin_bit_cast(float, w & 0xffff0000u); }
__device__ __forceinline__ float bf2f(bf16_t b) { return __builtin_bit_cast(float, (unsigned)b << 16); }
__device__ __forceinline__ float wave_sum(float v) {
#pragma unroll
    for (int o = 1; o < 64; o <<= 1) v += __shfl_xor(v, o);
    return v;
}
__device__ __forceinline__ float sigmoidf_(float x) { return 1.f / (1.f + __expf(-x)); }
__device__ __forceinline__ float gelu_tanh(float x) { const float u = 0.7978845608028654f * (x + 0.044715f * x * x * x); return x / (1.f + __expf(-2.f * u)); }
__device__ __forceinline__ float silu_(float x) { return x / (1.f + __expf(-x)); }
__device__ __forceinline__ float expm1_fast(float x) {
    if (x > -0.5f && x < 0.5f) { float p = 1.0f + x * (1.0f / 8.0f); p = 1.0f + x * (1.0f / 7.0f) * p; p = 1.0f + x * (1.0f / 6.0f) * p; p = 1.0f + x * 0.2f * p; p = 1.0f + x * 0.25f * p; p = 1.0f + x * (1.0f / 3.0f) * p; p = 1.0f + x * 0.5f * p; return x * p; }
    return expm1f(x);
}
#define LDS_WAIT() asm volatile("s_waitcnt lgkmcnt(0)" ::: "memory")
#define VM_WAIT() asm volatile("s_waitcnt vmcnt(0)" ::: "memory")

#define XB_TMO      128
#define XB_XCNT(j)  (256  + 64 * (j))
#define XB_XSUB(j)  (1280 + 64 * (j))
#define XB_XGEN(j)  (2304 + 64 * (j))
#define XB_TOP      3328
#define XB_TOPGEN   3392
#define XCD_BAR_WORDS 3456
#define XB_SPIN_CAP (1u << 22)
__device__ __forceinline__ unsigned xb_ld(unsigned* p)              { return __hip_atomic_load(p, __ATOMIC_RELAXED, __HIP_MEMORY_SCOPE_AGENT); }
__device__ __forceinline__ unsigned xb_add(unsigned* p, unsigned v) { return __hip_atomic_fetch_add(p, v, __ATOMIC_RELAXED, __HIP_MEMORY_SCOPE_AGENT); }
__device__ __forceinline__ unsigned xb_xcc_id() { return (unsigned)__builtin_amdgcn_s_getreg((3 << 11) | 20) & 0xFu; }
#define XB_SPIN(cond, bar) do { unsigned _sp = 0; while (cond) { __builtin_amdgcn_s_sleep(1); \
    if ((++_sp & 255u) == 0u) { if (xb_ld(&(bar)[XB_TMO])) break; if (_sp > XB_SPIN_CAP) { atomicAdd(&(bar)[XB_TMO], 1u); break; } } } } while (0)
struct XcdBarrier { unsigned* bar; unsigned x; volatile LAS unsigned* st; };
__device__ __forceinline__ XcdBarrier xcd_barrier_post(unsigned* bar, volatile LAS unsigned* st) {
    XcdBarrier b; b.bar = bar; b.x = xb_xcc_id(); b.st = st;
    if (threadIdx.x == 0) (void)xb_add(&bar[XB_XCNT(b.x)], 1u);
    return b;
}
__device__ __forceinline__ void xcd_barrier_complete(unsigned* bar, unsigned x, unsigned& nloc, unsigned& nx) {
    const unsigned G = gridDim.x * gridDim.y * gridDim.z;
    unsigned sum, cnt, mine, sp = 0u;
    for (;;) {
        sum = 0u; cnt = 0u; mine = 0u;
#pragma unroll
        for (unsigned j = 0; j < 16; ++j) { const unsigned c = xb_ld(&bar[XB_XCNT(j)]); sum += c; cnt += (c > 0u) ? 1u : 0u; mine = (j == x) ? c : mine; }
        if (sum == G) break;
        __builtin_amdgcn_s_sleep(1);
        if ((++sp & 255u) == 0u) { if (xb_ld(&bar[XB_TMO])) break; if (sp > XB_SPIN_CAP) { atomicAdd(&bar[XB_TMO], 1u); break; } }
    }
    nloc = mine > 0u ? mine : 1u; nx = cnt > 0u ? cnt : 1u;
}
__device__ __forceinline__ void xcd_barrier(const XcdBarrier& b) {
    asm volatile("s_waitcnt vmcnt(0)" ::: "memory");
    __syncthreads();
    if (threadIdx.x == 0) {
        unsigned* bar = b.bar; asm volatile("" : "+s"(bar));
        __builtin_amdgcn_s_waitcnt(0);
        unsigned nloc = b.st[0], nx = b.st[1];
        if (nloc == 0u) { xcd_barrier_complete(bar, b.x, nloc, nx); b.st[0] = nloc; b.st[1] = nx; }
        const unsigned old = xb_add(&bar[XB_XSUB(b.x)], 1u);
        const unsigned gen = old / nloc;
        if (old + 1u == (gen + 1u) * nloc) {
            __builtin_amdgcn_fence(__ATOMIC_RELEASE, "agent");
            asm volatile("s_waitcnt vmcnt(0)" ::: "memory");
            const unsigned og = xb_add(&bar[XB_TOP], 1u);
            const unsigned tg = og / nx;
            if (og + 1u == (tg + 1u) * nx) xb_add(&bar[XB_TOPGEN], 1u);
            else XB_SPIN(xb_ld(&bar[XB_TOPGEN]) == tg, bar);
            __builtin_amdgcn_fence(__ATOMIC_ACQUIRE, "agent");
            xb_add(&bar[XB_XGEN(b.x)], 1u);
            asm volatile("s_waitcnt vmcnt(0)" ::: "memory");
        } else {
            XB_SPIN(xb_ld(&bar[XB_XGEN(b.x)]) == gen, bar);
            __builtin_amdgcn_fence(__ATOMIC_ACQUIRE, "agent");
            asm volatile("s_waitcnt vmcnt(0)" ::: "memory");
        }
    }
    __syncthreads();
}

namespace pg8 {
constexpr int BM = 256, BK = 64, HALF = 128, HTB = HALF * BK * 2, STAGE_BYTES = 8 * HTB, NXCD = 8, WGM = 8;
__host__ __device__ __forceinline__ int lds_byte(int r, int c) { const int st = (r >> 4) * 2 + (c >> 5), rr = r & 15, cc = c & 31, ob = rr * 64 + cc * 2; return st * 1024 + (ob ^ (((ob >> 9) & 1) << 5)); }
__host__ __device__ __forceinline__ void stage_rc(int b, int& R, int& C) { const int st = b / 1024, sb = b % 1024, swz = sb ^ (((sb >> 9) & 1) << 5); R = (st >> 1) * 16 + swz / 64; C = (st & 1) * 32 + (swz % 64) / 2; }
__host__ __device__ __forceinline__ int perm32(int rho) { const int n = rho >> 4, i = rho & 15; return 8 * (i >> 2) + 4 * n + (i & 3); }
struct Unit { int pm, pn, e, ti, nrows, row0; };
typedef f32x4 Acc[2][2][4][2];

template <class Epi, class Sched>
__device__ __forceinline__ void gemm_phase(LAS unsigned char* lds, const int K, const Sched& S, const Epi& E) {
    int tid_ = threadIdx.x; asm volatile("" : "+v"(tid_));
    const int tid = tid_, wid = __builtin_amdgcn_readfirstlane(tid >> 6), lane = tid & 63, wr = wid >> 2, wc = wid & 3, fr = lane & 15, fq = lane >> 4;
    (void)fr; (void)fq; (void)wc;
    Unit cur, nxt; int ui = 0;
    if (!S.next(0, cur)) return;
    Acc acc;
#pragma unroll
    for (int a = 0; a < 2; ++a)
#pragma unroll
        for (int b = 0; b < 2; ++b)
#pragma unroll
            for (int m = 0; m < 4; ++m)
#pragma unroll
                for (int n = 0; n < 2; ++n) acc[a][b][m][n] = (f32x4){0.f, 0.f, 0.f, 0.f};
#if NAIVE_GEMM
    for (;;) {
        const char* Ab = S.a_base(); const char* Bb = S.b_ptr(cur);
#pragma unroll 1
        for (int ai = 0; ai < 2; ++ai)
#pragma unroll 1
            for (int m = 0; m < 4; ++m) {
                const int rr = ai * 128 + wr * 64 + m * 16 + fr;
                const bf16_t* ap = (const bf16_t*)(Ab + S.a_off(cur, rr));
#pragma unroll
                for (int bj = 0; bj < 2; ++bj)
#pragma unroll
                    for (int n = 0; n < 2; ++n)
#pragma unroll
                        for (int j = 0; j < 4; ++j) {
                            const int cc = Epi::PERM ? bj * 128 + wc * 32 + fq * 8 + n * 4 + j : bj * 128 + wc * 32 + n * 16 + fq * 4 + j;
                            const bf16_t* bp = (const bf16_t*)(Bb + (size_t)cc * K * 2);
                            float s = 0.f;
                            for (int k = 0; k < K; k += 8) {
                                const u32x4 av = *(const u32x4*)(ap + k), bv = *(const u32x4*)(bp + k);
                                s += bflo(av.x) * bflo(bv.x) + bfhi(av.x) * bfhi(bv.x) + bflo(av.y) * bflo(bv.y) + bfhi(av.y) * bfhi(bv.y)
                                   + bflo(av.z) * bflo(bv.z) + bfhi(av.z) * bfhi(bv.z) + bflo(av.w) * bflo(bv.w) + bfhi(av.w) * bfhi(bv.w);
                            }
                            acc[ai][bj][m][n][j] = s;
                        }
            }
        E(acc, cur, wr, wc, fr, fq);
        ++ui;
        if (!S.next(ui, cur)) break;
    }
    return;
#else
    const int nt = K / BK;
    unsigned voffB[2];
    { int Rr[2], Cc[2];
#pragma unroll
      for (int i = 0; i < 2; ++i) { stage_rc(tid * 16 + i * 8192, Rr[i], Cc[i]); const int Rb = Epi::PERM ? ((Rr[i] & ~31) + perm32(Rr[i] & 31)) : Rr[i]; voffB[i] = (unsigned)(Rb * K + Cc[i]) * 2u; } }
#define PG8_AOFFS(U, o00, o01, o10, o11) do { int t3_ = threadIdx.x; asm volatile("" : "+v"(t3_)); int R0_, C0_, R1_, C1_; stage_rc(t3_ * 16, R0_, C0_); stage_rc(t3_ * 16 + 8192, R1_, C1_); \
        o00 = S.a_off(U, R0_) + (unsigned)C0_ * 2u; o01 = S.a_off(U, R1_) + (unsigned)C1_ * 2u; o10 = S.a_off(U, HALF + R0_) + (unsigned)C0_ * 2u; o11 = S.a_off(U, HALF + R1_) + (unsigned)C1_ * 2u; } while (0)
    const size_t kstep = (size_t)(BK * 2);
    const size_t hstep = (size_t)HALF * K * 2;
    const unsigned ldsw = (unsigned)wid * 1024u;
    const int aoff = lds_byte(wr * 64 + fr, fq * 8), boff = lds_byte(wc * 32 + fr, fq * 8);
#define PG8_SA(b, h) (((b) * 2 + (h)) * HTB)
#define PG8_SB(b, h) ((4 + (b) * 2 + (h)) * HTB)
#define PG8_STAGE(bufoff, gbase, v0, v1) do { \
        __builtin_amdgcn_global_load_lds((const unsigned*)((const char*)(gbase) + (v0)), (LAS unsigned*)(lds + (bufoff) + ldsw), 16, 0, 0); \
        __builtin_amdgcn_global_load_lds((const unsigned*)((const char*)(gbase) + (v1)), (LAS unsigned*)(lds + (bufoff) + ldsw + 8192), 16, 0, 0); } while (0)
#define PG8_LDA(dst, b, h) do { _Pragma("unroll") for (int m = 0; m < 4; ++m) _Pragma("unroll") for (int k = 0; k < 2; ++k) dst[m][k] = *(const LAS bf16x8*)(lds + PG8_SA(b, h) + aoff + m * 2048 + k * 1024); } while (0)
#define PG8_LDB(dst, b, h) do { _Pragma("unroll") for (int n = 0; n < 2; ++n) _Pragma("unroll") for (int k = 0; k < 2; ++k) dst[n][k] = *(const LAS bf16x8*)(lds + PG8_SB(b, h) + boff + n * 2048 + k * 1024); } while (0)
#define PG8_MMA(ai, bj, At, Bt) do { __builtin_amdgcn_s_setprio(1); _Pragma("unroll") for (int m = 0; m < 4; ++m) _Pragma("unroll") for (int n = 0; n < 2; ++n) _Pragma("unroll") for (int k = 0; k < 2; ++k) \
        acc[ai][bj][m][n] = __builtin_amdgcn_mfma_f32_16x16x32_bf16(Bt[n][k], At[m][k], acc[ai][bj][m][n], 0, 0, 0); __builtin_amdgcn_s_setprio(0); } while (0)
#define PG8_WAIT_V(n) asm volatile("s_waitcnt vmcnt(" #n ")" ::: "memory")
#define PG8_WAIT_L(n) asm volatile("s_waitcnt lgkmcnt(" #n ")" ::: "memory")
#define PG8_BAR __builtin_amdgcn_s_barrier()
#define PG8_SCHED __builtin_amdgcn_sched_barrier(0)
    bf16x8 At[4][2], B0[2][2], B1[2][2];
    const char* const Ab = S.a_base();
    unsigned vA00, vA01, vA10, vA11;
    PG8_AOFFS(cur, vA00, vA01, vA10, vA11);
    const char* cB = S.b_ptr(cur);
    PG8_STAGE(PG8_SB(0, 0), cB, voffB[0], voffB[1]); PG8_STAGE(PG8_SB(0, 1), cB + hstep, voffB[0], voffB[1]); PG8_STAGE(PG8_SA(0, 0), Ab, vA00, vA01); PG8_STAGE(PG8_SA(0, 1), Ab, vA10, vA11);
    if (wr == 1) PG8_BAR;
    PG8_WAIT_V(2); PG8_BAR;
    PG8_STAGE(PG8_SB(1, 0), cB + kstep, voffB[0], voffB[1]); PG8_STAGE(PG8_SA(1, 0), Ab + kstep, vA00, vA01); PG8_STAGE(PG8_SB(1, 1), cB + hstep + kstep, voffB[0], voffB[1]);
    PG8_WAIT_V(6); PG8_BAR;
    for (;;) {
        const bool has_next = S.next(ui + 1, nxt);
        unsigned vN00 = vA00, vN01 = vA01, vN10 = vA10, vN11 = vA11; const char* nB = cB;
        if (has_next) { PG8_AOFFS(nxt, vN00, vN01, vN10, vN11); nB = S.b_ptr(nxt); }
        for (int t = 0; t < nt; t += 2) {
            const bool last = (t == nt - 2);
            const char* a1 = Ab + (size_t)(t + 1) * kstep;
            const char* a2 = last ? Ab : Ab + (size_t)(t + 2) * kstep; const char* b2 = last ? nB : cB + (size_t)(t + 2) * kstep;
            const char* a3 = a2 + kstep; const char* b3 = b2 + kstep;
            const unsigned w00 = last ? vN00 : vA00, w01 = last ? vN01 : vA01, w10 = last ? vN10 : vA10, w11 = last ? vN11 : vA11;
            PG8_LDB(B0, 0, 0); PG8_LDB(B1, 0, 1); PG8_SCHED; PG8_LDA(At, 0, 0); PG8_STAGE(PG8_SA(1, 1), a1, vA10, vA11);
            PG8_WAIT_V(8); PG8_WAIT_L(0); PG8_BAR; PG8_MMA(0, 0, At, B0); PG8_MMA(0, 1, At, B1); PG8_BAR; PG8_SCHED;
            PG8_LDA(At, 0, 1); PG8_STAGE(PG8_SB(0, 0), b2, voffB[0], voffB[1]); PG8_STAGE(PG8_SB(0, 1), b2 + hstep, voffB[0], voffB[1]); PG8_STAGE(PG8_SA(0, 0), a2, w00, w01);
            PG8_WAIT_V(8); PG8_WAIT_L(0); PG8_BAR; PG8_MMA(1, 0, At, B0); PG8_MMA(1, 1, At, B1); PG8_BAR; PG8_SCHED;
            PG8_LDB(B0, 1, 0); PG8_LDB(B1, 1, 1); PG8_SCHED; PG8_LDA(At, 1, 0); PG8_STAGE(PG8_SA(0, 1), a2, w10, w11);
            PG8_WAIT_V(8); PG8_WAIT_L(0); PG8_BAR; PG8_MMA(0, 0, At, B0); PG8_MMA(0, 1, At, B1); PG8_BAR; PG8_SCHED;
            PG8_LDA(At, 1, 1); PG8_STAGE(PG8_SB(1, 0), b3, voffB[0], voffB[1]); PG8_STAGE(PG8_SB(1, 1), b3 + hstep, voffB[0], voffB[1]); PG8_STAGE(PG8_SA(1, 0), a3, w00, w01);
            PG8_WAIT_V(8); PG8_WAIT_L(0); PG8_BAR; PG8_MMA(1, 0, At, B0); PG8_MMA(1, 1, At, B1); PG8_BAR; PG8_SCHED;
        }
        if (wr == 0) PG8_BAR;
        { int t2_ = threadIdx.x; asm volatile("" : "+v"(t2_)); const int l2_ = t2_ & 63; E(acc, cur, wr, wc, l2_ & 15, l2_ >> 4); }
        if (!has_next) break;
#pragma unroll
        for (int a = 0; a < 2; ++a)
#pragma unroll
            for (int b = 0; b < 2; ++b)
#pragma unroll
                for (int m = 0; m < 4; ++m)
#pragma unroll
                    for (int n = 0; n < 2; ++n) acc[a][b][m][n] = (f32x4){0.f, 0.f, 0.f, 0.f};
        cur = nxt; vA00 = vN00; vA01 = vN01; vA10 = vN10; vA11 = vN11; cB = nB; ++ui;
        if (wr == 1) PG8_BAR;
    }
    PG8_WAIT_V(0);
    PG8_BAR;
#undef PG8_SA
#undef PG8_AOFFS
#undef PG8_SB
#undef PG8_STAGE
#undef PG8_LDA
#undef PG8_LDB
#undef PG8_MMA
#undef PG8_WAIT_V
#undef PG8_WAIT_L
#undef PG8_BAR
#undef PG8_SCHED
#endif
}
}
using pg8::Unit;
using pg8::Acc;

__device__ __forceinline__ float* resid_row(float* out, float* xc, int tok) {
    const int b = tok / TPB, j = tok - b * TPB;
    return j < CTX ? xc + ((size_t)(b * CTX + j)) * DM : out + ((size_t)(b * SEQ + j - CTX)) * DM;
}
__device__ __forceinline__ int tile_to_pm(int i, bool latent_only) { return latent_only ? (i >> 4) * 17 + 1 + (i & 15) : i; }

__device__ __forceinline__ bool static_order(int i, int G, int c, int nM, int nN, int& pm, int& pn) {
    const int nwg = nM * nN; const long L = (long)i * G + c; if (L >= nwg) return false;
    int wgid = (int)L; { const int q = nwg / 8, r = nwg % 8, xcd = wgid % 8, off = wgid / 8; wgid = (xcd < r ? xcd * (q + 1) : r * (q + 1) + (xcd - r) * q) + off; }
    const int nig = 8 * nN, gid = wgid / nig, fm = gid * 8, gsz = (nM - fm) < 8 ? (nM - fm) : 8;
    pm = fm + ((wgid % nig) % gsz); pn = (wgid % nig) / gsz; return true;
}

struct SchedPlain {
    const char* A; const char* Bt; int K, nM, nN, G, c; bool lat;
    __device__ __forceinline__ bool next(int i, Unit& u) const {
        int pm, pn; if (!static_order(i, G, c, nM, nN, pm, pn)) return false;
        u.pm = tile_to_pm(pm, lat); u.pn = pn; u.e = 0; u.ti = 0; u.nrows = 256; u.row0 = u.pm * 256; return true;
    }
    __device__ __forceinline__ const char* a_base() const { return A; }
    __device__ __forceinline__ unsigned a_off(const Unit& u, int rr) const { return (unsigned)(u.row0 + rr) * (unsigned)(K * 2); }
    __device__ __forceinline__ const char* b_ptr(const Unit& u) const { return Bt + (size_t)u.pn * 256 * K * 2; }
};

struct SchedMerge {
    const char* A0; const char* Bt0; int G, c;
    __device__ __forceinline__ bool next(int i, Unit& u) const {
        const int ti = i / 3, r = i - 3 * ti; int pm, pn; if (!static_order(ti, G, c, 64, 4, pm, pn)) return false;
        u.pm = tile_to_pm(pm, true); u.pn = pn; u.e = r; u.ti = 0; u.nrows = 256; u.row0 = u.pm * 256; return true;
    }
    __device__ __forceinline__ const char* a_base() const { return A0; }
    __device__ __forceinline__ unsigned a_off(const Unit& u, int rr) const { return (unsigned)u.e * (unsigned)(17 * MiB) + (unsigned)(u.row0 + rr) * 1024u; }
    __device__ __forceinline__ const char* b_ptr(const Unit& u) const { return Bt0 + ((size_t)u.e * 1024 * 512 + (size_t)u.pn * 256 * 512) * 2; }
};

struct SchedMoe {
    const char* A;
    const char* Ash;
    const char* Bt; const char* Btsh; const int* list;
    const LAS int* tb;
    int K, nN, G, c, nsh; bool lat, gather; size_t bstride;
    __device__ __forceinline__ bool next(int i, Unit& u) const {
        const int nrt = tb[LC_TBASE + 64], L = i * G + c, tot = (nrt + nsh) * nN;
        if (L >= tot) return false;
        const int rt = L / nN; u.pn = L - rt * nN;
        if (rt < nrt) {
            int e = 0;
#pragma unroll 1
            for (int s = 32; s > 0; s >>= 1) if (e + s < 64 && tb[LC_TBASE + e + s] <= rt) e += s;
            u.e = e; u.ti = rt - tb[LC_TBASE + e]; const int cnt = tb[LC_TCNT + e]; const int rem = cnt - u.ti * 256;
            u.nrows = rem < 256 ? rem : 256; u.row0 = tb[LC_SBASE + e] + u.ti * 256; u.pm = 0;
        } else { u.e = 64; u.ti = rt - nrt; u.pm = tile_to_pm(u.ti, lat); u.nrows = 256; u.row0 = u.pm * 256; }
        return true;
    }
    __device__ __forceinline__ const char* a_base() const { return A; }
    __device__ __forceinline__ unsigned a_off(const Unit& u, int rr) const {
        if (u.e == 64) return (unsigned)(Ash - A) + (unsigned)(u.row0 + rr) * (unsigned)(K * 2);
        if (gather) { const int r2 = rr < u.nrows ? rr : u.nrows - 1; const int tok = list[(size_t)u.e * T + u.ti * 256 + r2]; return (unsigned)tok * (unsigned)(K * 2); }
        return (unsigned)(u.row0 + rr) * (unsigned)(K * 2);
    }
    __device__ __forceinline__ const char* b_ptr(const Unit& u) const { return (u.e == 64 ? Btsh : Bt + (size_t)u.e * bstride) + (size_t)u.pn * 256 * K * 2; }
};

#define EPI_FOR_ROWS  _Pragma("unroll") for (int ai = 0; ai < 2; ++ai) _Pragma("unroll") for (int m = 0; m < 4; ++m)
#define EPI_FOR_COLS  _Pragma("unroll") for (int bj = 0; bj < 2; ++bj) _Pragma("unroll") for (int n = 0; n < 2; ++n)

struct EpiInproj {
    static constexpr bool PERM = false;
    unsigned char* ws; const float* bias; const float* rope;
    __device__ __forceinline__ void operator()(const Acc& acc, const Unit& u, int wr, int wc, int fr, int fq) const {
        const int pn = u.pn; const bool isg = pn >= 14; const int seg = pn >> 1;
        bf16_t* base = (bf16_t*)(ws + (isg ? OV_G : OV_Q + (size_t)seg * 17 * MiB));
        const int ld = isg ? 3072 : 512, coff = isg ? (pn - 14) * 256 : (pn & 1) * 256;
        const bool latent = (u.pm % 17) != 0;
        f32x4 bv[2][2];
        EPI_FOR_COLS bv[bj][n] = *(const f32x4*)(bias + pn * 256 + bj * 128 + wc * 32 + n * 16 + fq * 4);
        EPI_FOR_ROWS {
            const int row = u.row0 + ai * 128 + wr * 64 + m * 16 + fr;
            bf16_t* rp = base + (size_t)row * ld + coff + wc * 32 + fq * 4;
            f32x4 v[2][2];
            EPI_FOR_COLS v[bj][n] = acc[ai][bj][m][n] + bv[bj][n];
            if (seg < 2 && !isg) {
                if (latent) {
                    const int pos = (row % TPB) - CTX; const int pa = (wc & 1) ? (pos & 63) : (pos >> 6);
                    const f32x4 c0 = *(const f32x4*)(rope + (pa * 16 + fq * 4) * 2), c1 = *(const f32x4*)(rope + (pa * 16 + fq * 4) * 2 + 4);
                    const float cs[4] = {c0[0], c0[2], c1[0], c1[2]}, sn[4] = {c0[1], c0[3], c1[1], c1[3]};
#pragma unroll
                    for (int bj = 0; bj < 2; ++bj)
#pragma unroll
                        for (int j = 0; j < 4; ++j) { const float a = v[bj][0][j], b = v[bj][1][j]; v[bj][0][j] = a * cs[j] - b * sn[j]; v[bj][1][j] = b * cs[j] + a * sn[j]; }
                }
            } else if (isg) {
                EPI_FOR_COLS {
#pragma unroll
                    for (int j = 0; j < 4; ++j) v[bj][n][j] = sigmoidf_(v[bj][n][j]); }
            } else if (seg == 3 || seg == 4 || seg == 6) {
                EPI_FOR_COLS {
#pragma unroll
                    for (int j = 0; j < 4; ++j) v[bj][n][j] = gelu_tanh(v[bj][n][j]); }
            }
            EPI_FOR_COLS { u32x2 w; w.x = pk2(v[bj][n][0], v[bj][n][1]); w.y = pk2(v[bj][n][2], v[bj][n][3]); *(u32x2*)(rp + bj * 128 + n * 16) = w; }
        }
    }
};

struct EpiMerge {
    static constexpr bool PERM = true;
    bf16_t* mg; const bf16_t* gate;
    __device__ __forceinline__ void operator()(const Acc& acc, const Unit& u, int wr, int wc, int fr, int fq) const {
        const int r = u.e;
        EPI_FOR_ROWS {
            const int row = u.row0 + ai * 128 + wr * 64 + m * 16 + fr;
#pragma unroll
            for (int bj = 0; bj < 2; ++bj) {
                const int col = u.pn * 256 + bj * 128 + wc * 32 + fq * 8;
                const u32x4 g = *(const u32x4*)(gate + (size_t)row * 3072 + r * 1024 + col);
                f32x4 v0 = acc[ai][bj][m][0], v1 = acc[ai][bj][m][1];
                v0[0] *= bflo(g.x); v0[1] *= bfhi(g.x); v0[2] *= bflo(g.y); v0[3] *= bfhi(g.y); v1[0] *= bflo(g.z); v1[1] *= bfhi(g.z); v1[2] *= bflo(g.w); v1[3] *= bfhi(g.w);
                u32x4* mp = (u32x4*)(mg + (size_t)row * DM + col);
                if (r > 0) { const u32x4 o = *mp; v0[0] += bflo(o.x); v0[1] += bfhi(o.x); v0[2] += bflo(o.y); v0[3] += bfhi(o.y); v1[0] += bflo(o.z); v1[1] += bfhi(o.z); v1[2] += bflo(o.w); v1[3] += bfhi(o.w); }
                u32x4 w; w.x = pk2(v0[0], v0[1]); w.y = pk2(v0[2], v0[3]); w.z = pk2(v1[0], v1[1]); w.w = pk2(v1[2], v1[3]); *mp = w;
            }
        }
    }
};

struct EpiWout {
    static constexpr bool PERM = true;
    float* out; float* xc; const float* modl; bool dry;
    __device__ __forceinline__ void operator()(const Acc& acc, const Unit& u, int wr, int wc, int fr, int fq) const {
        const int b = u.pm / 17; const int bsel = (u.pm % 17) == 0 ? 4 : b;
        const float* g1 = modl + bsel * 6144 + 2048;
        f32x4 gv[2][2];
        EPI_FOR_COLS gv[bj][n] = *(const f32x4*)(g1 + u.pn * 256 + bj * 128 + wc * 32 + fq * 8 + n * 4);
        EPI_FOR_ROWS {
            const int row = u.row0 + ai * 128 + wr * 64 + m * 16 + fr;
            float* rp = resid_row(out, xc, row) + u.pn * 256 + wc * 32 + fq * 8;
            EPI_FOR_COLS { f32x4* p = (f32x4*)(rp + bj * 128 + n * 4); const f32x4 x = *p; const f32x4 y = x * DN_ALPHA + gv[bj][n] * acc[ai][bj][m][n]; if (!dry) *p = y; else asm volatile("" :: "v"(y)); }
        }
    }
};

struct EpiMoe1 {
    static constexpr bool PERM = true;
    bf16_t* act; bf16_t* actsh;
    __device__ __forceinline__ void operator()(const Acc& acc, const Unit& u, int wr, int wc, int fr, int fq) const {
        bf16_t* base = u.e == 64 ? actsh : act;
        EPI_FOR_ROWS {
            const int rl = ai * 128 + wr * 64 + m * 16 + fr;
            if (rl < u.nrows) {
                const f32x4 g0 = acc[ai][0][m][0], g1 = acc[ai][0][m][1], p0 = acc[ai][1][m][0], p1 = acc[ai][1][m][1];
                u32x4 w; w.x = pk2(silu_(g0[0]) * p0[0], silu_(g0[1]) * p0[1]); w.y = pk2(silu_(g0[2]) * p0[2], silu_(g0[3]) * p0[3]);
                w.z = pk2(silu_(g1[0]) * p1[0], silu_(g1[1]) * p1[1]); w.w = pk2(silu_(g1[2]) * p1[2], silu_(g1[3]) * p1[3]);
                *(u32x4*)(base + (size_t)(u.row0 + rl) * 256 + u.pn * 128 + wc * 32 + fq * 8) = w;
            }
        }
    }
};

struct EpiMoe2 {
    static constexpr bool PERM = true;
    unsigned char* ys; bf16_t* sho;
    __device__ __forceinline__ void operator()(const Acc& acc, const Unit& u, int wr, int wc, int fr, int fq) const {
        EPI_FOR_ROWS {
            const int rl = ai * 128 + wr * 64 + m * 16 + fr;
            if (rl < u.nrows) {
                if (u.e == 64) {
                    bf16_t* rp = sho + (size_t)(u.row0 + rl) * DM + u.pn * 256 + wc * 32 + fq * 8;
#pragma unroll
                    for (int bj = 0; bj < 2; ++bj) { const f32x4 v0 = acc[ai][bj][m][0], v1 = acc[ai][bj][m][1];
                        u32x4 w; w.x = pk2(v0[0], v0[1]); w.y = pk2(v0[2], v0[3]); w.z = pk2(v1[0], v1[1]); w.w = pk2(v1[2], v1[3]); *(u32x4*)(rp + bj * 128) = w; }
                } else {
                    unsigned char* rp = ys + (size_t)(u.row0 + rl) * DM + u.pn * 256 + wc * 32 + fq * 8;
#pragma unroll
                    for (int bj = 0; bj < 2; ++bj) { const f32x4 v0 = acc[ai][bj][m][0] * 16.0f, v1 = acc[ai][bj][m][1] * 16.0f;
                        int w0 = 0, w1 = 0;
                        w0 = __builtin_amdgcn_cvt_pk_fp8_f32(v0[0], v0[1], w0, false); w0 = __builtin_amdgcn_cvt_pk_fp8_f32(v0[2], v0[3], w0, true);
                        w1 = __builtin_amdgcn_cvt_pk_fp8_f32(v1[0], v1[1], w1, false); w1 = __builtin_amdgcn_cvt_pk_fp8_f32(v1[2], v1[3], w1, true);
                        *(u32x2*)(rp + bj * 128) = (u32x2){(unsigned)w0, (unsigned)w1}; }
                }
            }
        }
    }
};

struct Frame {
    LAS unsigned char* lds; int tid, lane, wave, G, bid, gw, NGW, vcu;
    unsigned char* ws; float* out;
};

__device__ __forceinline__ void transpose_item(const float* W, int ldw, int k0, int n0, bf16_t* WT, int ldt, int drow0, LAS float* scr, int lane) {
    const int lk = lane >> 4, n4 = (lane & 15) * 4;
#pragma unroll 8
    for (int i = 0; i < 16; ++i) { const int k = 4 * i + lk; const f32x4 v = *(const f32x4*)(W + (size_t)(k0 + k) * ldw + n0 + n4);
        *(LAS f32x4*)(scr + k * 64 + (n4 ^ (((k >> 3) & 7) << 2))) = v; }
    LDS_WAIT(); asm volatile("" ::: "memory");
    const int c = lane & 7;
#pragma unroll
    for (int j = 0; j < 8; ++j) { const int n = (lane >> 3) + 8 * j; const LAS float* sp = scr + (8 * c) * 64 + (n ^ (c << 2));
        u32x4 o; o.x = pk2(sp[0 * 64], sp[1 * 64]); o.y = pk2(sp[2 * 64], sp[3 * 64]); o.z = pk2(sp[4 * 64], sp[5 * 64]); o.w = pk2(sp[6 * 64], sp[7 * 64]);
        *(u32x4*)(WT + (size_t)(drow0 + n) * ldt + k0 + 8 * c) = o; }
    LDS_WAIT(); asm volatile("" ::: "memory");
}
__device__ __forceinline__ void conv_expert_item(const float* wg, const float* wu, const float* wd, bf16_t* t1, bf16_t* t2, int which, int rr, LAS float* scr, int lane) {
    if (which < 2) { const int kb = rr >> 2, nb = rr & 3, n0 = 64 * nb;
        transpose_item(which == 0 ? wg : wu, 256, 64 * kb, n0, t1, 1024, (n0 >> 7) * 256 + (n0 & 127) + which * 128, scr, lane);
    } else { const int kb = rr >> 4, nb = rr & 15; transpose_item(wd, 1024, 64 * kb, 64 * nb, t2, 256, 64 * nb, scr, lane); }
}
__device__ __forceinline__ void conv_moe_layer(const Frame& F, CArgsP a, int l) {
    LAS float* scr = (LAS float*)(F.lds + F.wave * 16384);
    for (int it = F.gw; it < 64 * 3 * 64; it += F.NGW) {
        const int idx = it >> 6, e = idx / 3, which = idx - e * 3, rr = it & 63; const size_t eo = (size_t)(l * 64 + e) * 262144;
        conv_expert_item(a->in[30] + eo, a->in[31] + eo, a->in[32] + eo, (bf16_t*)(F.ws + WS_WM1) + (size_t)e * 524288, (bf16_t*)(F.ws + WS_WM2) + (size_t)e * 262144, which, rr, scr, F.lane);
    }
}

__device__ __forceinline__ void phase_prologue(const Frame& F, CArgsP a) {
    LAS float* scr = (LAS float*)(F.lds + F.wave * 16384);
    constexpr int I_IN = 2 * 1664, I_BR = 6 * 128, I_OUT = 2 * 256, I_SH = 6 * 64;
    for (int it0 = F.gw; it0 < I_IN + I_BR + I_OUT + I_SH; it0 += F.NGW) {
        int it = it0;
        if (it < I_IN) { const int l = it / 1664, r = it - l * 1664, kb = r / 104, nb = r - kb * 104;
            transpose_item(a->in[6] + (size_t)l * 1024 * INC, INC, 64 * kb, 64 * nb, (bf16_t*)(F.ws + WS_WIN) + (size_t)l * INC * 1024, 1024, 64 * nb, scr, F.lane); continue; }
        it -= I_IN;
        if (it < I_BR) { const int idx = it >> 7, rr = it & 127, kb = rr >> 4, nb = rr & 15;
            transpose_item(a->in[24] + (size_t)idx * 512 * 1024, 1024, 64 * kb, 64 * nb, (bf16_t*)(F.ws + WS_WBR) + (size_t)idx * 1024 * 512, 512, 64 * nb, scr, F.lane); continue; }
        it -= I_BR;
        if (it < I_OUT) { const int l = it >> 8, rr = it & 255, kb = rr >> 4, nb = rr & 15;
            transpose_item(a->in[25] + (size_t)l * 1048576, 1024, 64 * kb, 64 * nb, (bf16_t*)(F.ws + WS_WOUT) + (size_t)l * 1048576, 1024, 64 * nb, scr, F.lane); continue; }
        it -= I_OUT;
        { const int idx = it >> 6, l = idx / 3, which = idx - l * 3, rr = it & 63; const size_t lo = (size_t)l * 262144;
          conv_expert_item(a->in[33] + lo, a->in[34] + lo, a->in[35] + lo, (bf16_t*)(F.ws + WS_WSH1) + (size_t)l * 524288, (bf16_t*)(F.ws + WS_WSH2) + (size_t)l * 262144, which, rr, scr, F.lane); }
    }
    conv_moe_layer(F, a, 0);
    { const int gt = F.bid * NTHR + F.tid, NG = F.G * NTHR;
      bf16_t* wl = (bf16_t*)(F.ws + WS_WLRU);
      for (int i = gt; i < 2 * 2 * 2 * 8 * 4096; i += NG) {
          const int ii = i & 63, j = (i >> 6) & 63, cb = (i >> 12) & 7, ax = (i >> 15) & 1, d = (i >> 16) & 1, l = i >> 17;
          const float* src = ax == 0 ? a->in[19] : a->in[21];
          wl[i] = (bf16_t)f2bf(src[(size_t)((l * 2 + d) * 8 + cb) * 4096 + ii * 64 + j]); }
      bf16_t* wrt = (bf16_t*)(F.ws + WS_WRT);
      for (int i = gt; i < 2 * 64 * 1024; i += NG) { const int k = i & 1023, e = (i >> 10) & 63, l = i >> 16; wrt[i] = (bf16_t)f2bf(a->in[28][(size_t)(l * 1024 + k) * 64 + e]); }
      bf16_t* wsg = (bf16_t*)(F.ws + WS_WSG);
      for (int i = gt; i < 2 * 4 * 128 * 128; i += NG) wsg[i] = (bf16_t)f2bf(a->in[15][i]);
      if (F.bid == 0) { float* rope = (float*)(F.ws + WS_ROPE);
          for (int t = F.tid; t < 1024; t += NTHR) { const int p = t >> 4, f = t & 15; const float inv = powf(10000.0f, -(float)f / 16.0f); const float ang = (float)p * inv; rope[2 * t] = cosf(ang); rope[2 * t + 1] = sinf(ang); } }
      if (F.bid == (1 % F.G) && F.wave == 0) { float* lam = (float*)(F.ws + WS_LAM);
#pragma unroll
          for (int l = 0; l < 2; ++l) { const float s1 = wave_sum(a->in[8][l * 64 + F.lane] * a->in[9][l * 64 + F.lane]), s2 = wave_sum(a->in[10][l * 64 + F.lane] * a->in[11][l * 64 + F.lane]);
              const float li = 0.8f - 0.6f * expf(-0.3f * (float)l); if (F.lane == 0) lam[l] = expf(s1) - expf(s2) + li; } }
    }
    __syncthreads();
    LAS float* sl = (LAS float*)(F.lds);
    for (int i = F.tid; i < 5 * 1024; i += NTHR) { const int b = i >> 10, k = i & 1023; const float cv = b < 4 ? a->in[1][b * 1024 + k] : a->in[3][k]; sl[i] = silu_(cv); }
    __syncthreads();
    float* mod = (float*)(F.ws + WS_MOD);
    LAS float* part = (LAS float*)(F.lds + 20480);
    for (int c = F.bid; c < 192; c += F.G) {
        const int l = c / 96, cg = c - l * 96, col = F.tid & 63, ks = F.wave, n = cg * 64 + col;
        const float* w = a->in[4] + ((size_t)l * 1024 + ks * 128) * 6144 + n;
        float acc[5] = {0.f, 0.f, 0.f, 0.f, 0.f};
#pragma unroll 8
        for (int k = 0; k < 128; ++k) { const float wv = w[(size_t)k * 6144];
#pragma unroll
            for (int b = 0; b < 5; ++b) acc[b] += sl[b * 1024 + ks * 128 + k] * wv; }
#pragma unroll
        for (int b = 0; b < 5; ++b) part[(ks * 5 + b) * 64 + col] = acc[b];
        __syncthreads();
        if (F.tid < 320) { const int b = F.tid >> 6; float s = a->in[5][l * 6144 + n];
#pragma unroll
            for (int k8 = 0; k8 < 8; ++k8) s += part[(k8 * 5 + b) * 64 + col];
            mod[(l * 5 + b) * 6144 + n] = s; }
        __syncthreads();
    }
}

__device__ __forceinline__ void row_load(const float* p, int lane, f32x4 (&v)[4]) {
#pragma unroll
    for (int j = 0; j < 4; ++j) v[j] = *(const f32x4*)(p + 4 * lane + 256 * j);
}
__device__ __forceinline__ void row_store(float* p, int lane, const f32x4 (&v)[4]) {
#pragma unroll
    for (int j = 0; j < 4; ++j) *(f32x4*)(p + 4 * lane + 256 * j) = v[j];
}
__device__ __forceinline__ void row_ln(f32x4 (&v)[4]) {
    float s = 0.f;
#pragma unroll
    for (int j = 0; j < 4; ++j) s += (v[j][0] + v[j][1]) + (v[j][2] + v[j][3]);
    const float mean = wave_sum(s) * (1.f / DM); float q = 0.f;
#pragma unroll
    for (int j = 0; j < 4; ++j) { v[j] = v[j] - mean; q += (v[j][0] * v[j][0] + v[j][1] * v[j][1]) + (v[j][2] * v[j][2] + v[j][3] * v[j][3]); }
    const float rstd = 1.f / sqrtf(wave_sum(q) * (1.f / DM) + LN_EPS);
#pragma unroll
    for (int j = 0; j < 4; ++j) v[j] = v[j] * rstd;
}
__device__ __forceinline__ void row_affine(f32x4 (&v)[4], const float* scale1p  , bool plus1, const float* shift, int lane) {
#pragma unroll
    for (int j = 0; j < 4; ++j) { const f32x4 sc = *(const f32x4*)(scale1p + 4 * lane + 256 * j), sh = *(const f32x4*)(shift + 4 * lane + 256 * j);
        v[j] = plus1 ? v[j] * (sc + 1.0f) + sh : v[j] * sc + sh; }
}
__device__ __forceinline__ void row_store_bf16(bf16_t* p, int lane, const f32x4 (&v)[4]) {
#pragma unroll
    for (int j = 0; j < 4; ++j) { u32x2 w; w.x = pk2(v[j][0], v[j][1]); w.y = pk2(v[j][2], v[j][3]); *(u32x2*)(p + 4 * lane + 256 * j) = w; }
}

__device__ __forceinline__ void phase_rows0(const Frame& F, CArgsP a) {
    const float* mod = (const float*)(F.ws + WS_MOD); float* xc = (float*)(F.ws + WS_XC); bf16_t* H = (bf16_t*)(F.ws + WS_H);
    for (int tok = F.gw; tok < T; tok += F.NGW) {
        const int b = tok / TPB, j = tok - b * TPB; const bool isc = j < CTX;
        const float* src = isc ? a->in[2] + (size_t)(b * CTX + j) * DM : a->in[0] + (size_t)(b * SEQ + j - CTX) * DM;
        f32x4 v[4]; row_load(src, F.lane, v);
        row_store(resid_row(F.out, xc, tok), F.lane, v);
        row_ln(v);
        const float* mrow = mod + (isc ? 4 : b) * 6144;
        row_affine(v, mrow + 1024, true, mrow, F.lane);
        row_store_bf16(H + (size_t)tok * DM, F.lane, v);
    }
}

__device__ __forceinline__ void sg_item(const Frame& F, CArgsP a, int l, int chunk, int g) {
    LAS bf16_t* vgT = (LAS bf16_t*)F.lds;
    const bf16_t* Sb = (const bf16_t*)(F.ws + OV_S); const bf16_t* Ub = (const bf16_t*)(F.ws + OV_U); bf16_t* OB = (bf16_t*)(F.ws + OV_OB);
    const int tok0 = chunk * 128;
    { const int q = F.tid >> 2, qt = F.tid & 3;
      const bf16_t* sp = Sb + (size_t)(tok0 + q) * 512 + g * 128 + qt * 32;
      float x[32];
#pragma unroll
      for (int i = 0; i < 4; ++i) { const u32x4 w = *(const u32x4*)(sp + 8 * i);
          x[8 * i + 0] = bflo(w.x); x[8 * i + 1] = bfhi(w.x); x[8 * i + 2] = bflo(w.y); x[8 * i + 3] = bfhi(w.y); x[8 * i + 4] = bflo(w.z); x[8 * i + 5] = bfhi(w.z); x[8 * i + 6] = bflo(w.w); x[8 * i + 7] = bfhi(w.w); }
      float s = 0.f;
#pragma unroll
      for (int i = 0; i < 32; ++i) s += x[i];
      s += __shfl_xor(s, 1); s += __shfl_xor(s, 2); const float mean = s * (1.f / 128.f); float qq = 0.f;
#pragma unroll
      for (int i = 0; i < 32; ++i) { x[i] -= mean; qq += x[i] * x[i]; }
      qq += __shfl_xor(qq, 1); qq += __shfl_xor(qq, 2); const float rstd = 1.f / sqrtf(qq * (1.f / 128.f) + LN_EPS);
      const float* lg = a->in[13] + l * 512 + g * 128 + qt * 32; const float* lb = a->in[14] + l * 512 + g * 128 + qt * 32;
#pragma unroll
      for (int i = 0; i < 32; ++i) vgT[(qt * 32 + i) * 136 + q] = (bf16_t)f2bf(x[i] * rstd * lg[i] + lb[i]);
    }
    __syncthreads();
    const int w = F.wave, fr = F.lane & 15, fq = F.lane >> 4;
    bf16x8 af[4];
#pragma unroll
    for (int ks = 0; ks < 4; ++ks) af[ks] = *(const LAS bf16x8*)(vgT + (w * 16 + fr) * 136 + ks * 32 + fq * 8);
    const bf16_t* W = (const bf16_t*)(F.ws + WS_WSG) + (size_t)(l * 4 + g) * 16384;
    const float* bs = a->in[16] + (l * 4 + g) * 128;
#pragma unroll 2
    for (int n = 0; n < 8; ++n) {
        f32x4 d = {0.f, 0.f, 0.f, 0.f};
#pragma unroll
        for (int ks = 0; ks < 4; ++ks) { const bf16x8 bfv = *(const bf16x8*)(W + (n * 16 + fr) * 128 + ks * 32 + fq * 8); d = __builtin_amdgcn_mfma_f32_16x16x32_bf16(af[ks], bfv, d, 0, 0, 0); }
        const int p = n * 16 + fr, c0 = w * 16 + fq * 4; const float bsp = bs[p];
        const size_t off = (size_t)(tok0 + p) * 512 + g * 128 + c0;
        const u32x2 uu = *(const u32x2*)(Ub + off);
        u32x2 o; o.x = pk2(bflo(uu.x) * (d[0] + bsp), bfhi(uu.x) * (d[1] + bsp)); o.y = pk2(bflo(uu.y) * (d[2] + bsp), bfhi(uu.y) * (d[3] + bsp));
        *(u32x2*)(OB + off) = o;
    }
    __syncthreads();
}

template <bool REV>
__device__ __forceinline__ void lru_scan(const f32x4 (&av)[4], const f32x4 (&bv)[4], f32x4 (&hv)[4], int lane, int mode, float hin, float& sumA, float& sumH) {
#define LRU_MI(k) (REV ? 3 - (k) : (k))
    const int fr = lane & 15, fq = lane >> 4, q = REV ? 3 - fq : fq;
    const int s1 = REV ? lane + 16 : lane - 16, s2 = REV ? lane + 32 : lane - 32, st = REV ? fr : 48 + fr;
    float Ea[4], Eh[4], Ta[4], Th[4];
#pragma unroll
    for (int m = 0; m < 4; ++m) {
        float A = 1.f, H = 0.f;
#pragma unroll
        for (int rk = 0; rk < 4; ++rk) { const int r = LRU_MI(rk); H = av[m][r] * H + bv[m][r]; A *= av[m][r]; }
        float pa = __shfl(A, s1), ph = __shfl(H, s1); if (q >= 1) { H = A * ph + H; A *= pa; }
        pa = __shfl(A, s2); ph = __shfl(H, s2); if (q >= 2) { H = A * ph + H; A *= pa; }
        float ea = __shfl(A, s1), eh = __shfl(H, s1); if (q == 0) { ea = 1.f; eh = 0.f; }
        Ea[m] = ea; Eh[m] = eh; Ta[m] = __shfl(A, st); Th[m] = __shfl(H, st);
    }
    if (mode == 0) {
        float A = 1.f, H = 0.f;
#pragma unroll
        for (int mk = 0; mk < 4; ++mk) { const int m = LRU_MI(mk); H = Ta[m] * H + Th[m]; A *= Ta[m]; }
        sumA = A; sumH = H;
    } else {
        float S = hin;
#pragma unroll
        for (int mk = 0; mk < 4; ++mk) { const int m = LRU_MI(mk); float h = Ea[m] * S + Eh[m];
#pragma unroll
            for (int rk = 0; rk < 4; ++rk) { const int r = LRU_MI(rk); h = av[m][r] * h + bv[m][r]; hv[m][r] = h; }
            S = Ta[m] * S + Th[m]; }
    }
#undef LRU_MI
}
struct LruConst { f32x4 cw[4][2]; f32x4 cbias[2]; bf16x8 wa0, wa1, wx0, wx1; float ba, bx, sp; };
struct LruIn { u32x4 x[4]; u32x4 y; float hin; };
__device__ __forceinline__ void lru_load_const(const Frame& F, CArgsP a, int l, int cb, LruConst& c) {
    const int lane = F.lane, fr = lane & 15, fq = lane >> 4, d = F.wave >> 2, nt = F.wave & 3, ch0 = cb * 64, c8 = (F.tid & 7) * 8;
    const bf16_t* Wa = (const bf16_t*)(F.ws + WS_WLRU) + (size_t)((l * 4 + d * 2) * 8 + cb) * 4096 + (nt * 16 + fr) * 64 + fq * 8;
    c.wa0 = *(const bf16x8*)(Wa); c.wa1 = *(const bf16x8*)(Wa + 32); c.wx0 = *(const bf16x8*)(Wa + 8 * 4096); c.wx1 = *(const bf16x8*)(Wa + 8 * 4096 + 32);
    const int pidx = (l * 2 + d) * 512 + ch0 + nt * 16 + fr;
    c.ba = a->in[20][pidx]; c.bx = a->in[22][pidx]; c.sp = log1pf(expf(-a->in[23][pidx]));
#pragma unroll
    for (int jj = 0; jj < 4; ++jj) { c.cw[jj][0] = *(const f32x4*)(a->in[17] + l * 2048 + jj * 512 + ch0 + c8); c.cw[jj][1] = *(const f32x4*)(a->in[17] + l * 2048 + jj * 512 + ch0 + c8 + 4); }
    c.cbias[0] = *(const f32x4*)(a->in[18] + l * 512 + ch0 + c8); c.cbias[1] = *(const f32x4*)(a->in[18] + l * 512 + ch0 + c8 + 4);
}
__device__ __forceinline__ void lru_load_in(const Frame& F, int b, int chunk, int cb, int mode, LruIn& in) {
    const bf16_t* Xb = (const bf16_t*)(F.ws + OV_X); const bf16_t* Yb = (const bf16_t*)(F.ws + OV_Y);
    const int ch0 = cb * 64, ct = F.tid >> 3, c8 = (F.tid & 7) * 8, d = F.wave >> 2, ch = (F.wave & 3) * 16 + (F.lane & 15);
    const int seg_lo = chunk < 4 ? 0 : 256, seg_hi = chunk < 4 ? 256 : TPB, j0 = chunk * 64;
#pragma unroll
    for (int jj = 0; jj < 4; ++jj) { const int j = j0 + ct + jj - 2; in.x[jj] = (u32x4){0u, 0u, 0u, 0u}; if (j >= seg_lo && j < seg_hi) in.x[jj] = *(const u32x4*)(Xb + (size_t)(b * TPB + j) * 512 + ch0 + c8); }
    in.y = (u32x4){0u, 0u, 0u, 0u}; in.hin = 0.f;
    if (mode == 1) { in.y = *(const u32x4*)(Yb + (size_t)(b * TPB + j0 + ct) * 512 + ch0 + c8); in.hin = ((const float*)(F.ws + WS_HIN))[(size_t)((b * 2 + d) * 68 + chunk) * 512 + ch0 + ch]; }
}
__device__ __forceinline__ void lru_compute(const Frame& F, const LruConst& c, const LruIn& in, int b, int chunk, int cb, int mode) {
    LAS float* xs = (LAS float*)F.lds;
    LAS bf16_t* xsb = (LAS bf16_t*)(F.lds + 16384);
    LAS float* hx = (LAS float*)(F.lds + 25600);
    bf16_t* OC = (bf16_t*)(F.ws + OV_OC);
    const int tok0 = b * TPB + chunk * 64, ch0 = cb * 64;
    const int lane = F.lane, fr = lane & 15, fq = lane >> 4, d = F.wave >> 2, nt = F.wave & 3, ch = nt * 16 + fr;
    const int ct = F.tid >> 3, c8 = (F.tid & 7) * 8;
    {
      f32x4 a0 = c.cbias[0], a1 = c.cbias[1];
#pragma unroll
      for (int jj = 0; jj < 4; ++jj) { const u32x4 w = in.x[jj];
          a0 += c.cw[jj][0] * (f32x4){bflo(w.x), bfhi(w.x), bflo(w.y), bfhi(w.y)}; a1 += c.cw[jj][1] * (f32x4){bflo(w.z), bfhi(w.z), bflo(w.w), bfhi(w.w)}; }
      *(LAS f32x4*)(xs + ct * 64 + c8) = a0; *(LAS f32x4*)(xs + ct * 64 + c8 + 4) = a1;
      u32x4 pw; pw.x = pk2(a0[0], a0[1]); pw.y = pk2(a0[2], a0[3]); pw.z = pk2(a1[0], a1[1]); pw.w = pk2(a1[2], a1[3]);
      *(LAS u32x4*)(xsb + ct * 72 + c8) = pw; }
    __syncthreads();
    f32x4 av[4], bv[4], hv[4];
#pragma unroll
    for (int m = 0; m < 4; ++m) {
        const bf16x8 a0 = *(const LAS bf16x8*)(xsb + (m * 16 + fr) * 72 + fq * 8), a1 = *(const LAS bf16x8*)(xsb + (m * 16 + fr) * 72 + 32 + fq * 8);
        f32x4 da = {0.f, 0.f, 0.f, 0.f}, dx = {0.f, 0.f, 0.f, 0.f};
        da = __builtin_amdgcn_mfma_f32_16x16x32_bf16(a0, c.wa0, da, 0, 0, 0); da = __builtin_amdgcn_mfma_f32_16x16x32_bf16(a1, c.wa1, da, 0, 0, 0);
        dx = __builtin_amdgcn_mfma_f32_16x16x32_bf16(a0, c.wx0, dx, 0, 0, 0); dx = __builtin_amdgcn_mfma_f32_16x16x32_bf16(a1, c.wx1, dx, 0, 0, 0);
#pragma unroll
        for (int r = 0; r < 4; ++r) { const float rg = sigmoidf_(da[r] + c.ba), ig = sigmoidf_(dx[r] + c.bx); const float la = -8.0f * rg * c.sp;
            const float e1 = expm1_fast(la);
            av[m][r] = 1.0f + e1; bv[m][r] = __builtin_sqrtf(-e1 * (2.0f + e1)) * (ig * xs[(m * 16 + fq * 4 + r) * 64 + ch]); hv[m][r] = 0.f; }
    }
    float sumA = 1.f, sumH = 0.f;
    if (d == 0) lru_scan<false>(av, bv, hv, lane, mode, in.hin, sumA, sumH); else lru_scan<true>(av, bv, hv, lane, mode, in.hin, sumA, sumH);
    if (mode == 0) {
        if (fq == 0) { float* sum = (float*)(F.ws + WS_SUM) + ((size_t)((b * 2 + d) * 68 + chunk) * 512 + ch0 + ch) * 2; *(float2*)sum = make_float2(sumA, sumH); }
        __syncthreads();
        return;
    }
#pragma unroll
    for (int m = 0; m < 4; ++m)
#pragma unroll
        for (int r = 0; r < 4; ++r) hx[d * 4096 + (m * 16 + fq * 4 + r) * 64 + ch] = hv[m][r];
    __syncthreads();
    { const u32x4 yv = in.y;
      const f32x4 f0 = *(const LAS f32x4*)(hx + ct * 64 + c8), f1 = *(const LAS f32x4*)(hx + ct * 64 + c8 + 4), g0 = *(const LAS f32x4*)(hx + 4096 + ct * 64 + c8), g1 = *(const LAS f32x4*)(hx + 4096 + ct * 64 + c8 + 4);
      u32x4 o; o.x = pk2(bflo(yv.x) * (f0[0] + g0[0]), bfhi(yv.x) * (f0[1] + g0[1])); o.y = pk2(bflo(yv.y) * (f0[2] + g0[2]), bfhi(yv.y) * (f0[3] + g0[3]));
      o.z = pk2(bflo(yv.z) * (f1[0] + g1[0]), bfhi(yv.z) * (f1[1] + g1[1])); o.w = pk2(bflo(yv.w) * (f1[2] + g1[2]), bfhi(yv.w) * (f1[3] + g1[3]));
      *(u32x4*)(OC + (size_t)(tok0 + ct) * 512 + ch0 + c8) = o; }
}
__device__ __forceinline__ void lru_phase(const Frame& F, CArgsP a, int l, int mode, bool skip_ctx) {
    constexpr int NIT = 4 * 68 * 8;
    int it = F.bid;
    while (it < NIT && skip_ctx && ((it >> 3) % 68) < 4) it += F.G;
    if (it >= NIT) return;
    LruConst c; LruIn cur, nxt;
    int cb = it & 7; lru_load_const(F, a, l, cb, c);
    lru_load_in(F, (it >> 3) / 68, (it >> 3) % 68, cb, mode, cur);
    for (;;) {
        int nit = it + F.G;
        while (nit < NIT && skip_ctx && ((nit >> 3) % 68) < 4) nit += F.G;
        const bool has = nit < NIT;
        if (has) lru_load_in(F, (nit >> 3) / 68, (nit >> 3) % 68, nit & 7, mode, nxt);
        lru_compute(F, c, cur, (it >> 3) / 68, (it >> 3) % 68, cb, mode);
        if (!has) break;
        if ((nit & 7) != cb) { cb = nit & 7; lru_load_const(F, a, l, cb, c); }
        it = nit; cur = nxt;
    }
}

__device__ __forceinline__ void phase_carry(const Frame& F) {
    const int gt = F.bid * NTHR + F.tid; if (gt >= 4 * 2 * 512) return;
    const int c = gt & 511, d = (gt >> 9) & 1, b = gt >> 10;
    const float* sum = (const float*)(F.ws + WS_SUM) + (size_t)((b * 2 + d) * 68) * 1024 + c * 2;
    float* hin = (float*)(F.ws + WS_HIN) + (size_t)((b * 2 + d) * 68) * 512 + c;
    float h = 0.f;
#pragma unroll 1
    for (int g0 = 0; g0 < 68; g0 += 17) {
        float A[17], Hh[17];
#pragma unroll
        for (int i = 0; i < 17; ++i) { const int o = g0 + i; const int ck = d == 0 ? o : (o < 4 ? 3 - o : 71 - o); const float2 v = *(const float2*)(sum + (size_t)ck * 1024); A[i] = v.x; Hh[i] = v.y; }
#pragma unroll
        for (int i = 0; i < 17; ++i) { const int o = g0 + i; const int ck = d == 0 ? o : (o < 4 ? 3 - o : 71 - o); hin[(size_t)ck * 512] = h; h = A[i] * h + Hh[i]; }
    }
}

constexpr int AT_KST = 272, AT_VST = 320;
constexpr int AT_KOFF = 0, AT_VOFF = 2 * 64 * AT_KST, AT_XOFF = AT_VOFF + 2 * 64 * AT_VST;
#define AT_SBAR() __builtin_amdgcn_sched_barrier(0)
struct AttnState { f32x16 o[4]; bf16x8 pfp[4]; float mrun, lrun; };
#define AT_PIN1(x) asm volatile("" : "+v"(x))
__device__ __forceinline__ float at_max3(float a, float b, float c) { float r; asm("v_max3_f32 %0, %1, %2, %3" : "=v"(r) : "v"(a), "v"(b), "v"(c)); return r; }
__device__ __forceinline__ bf16x8 at_vfrag(const LAS unsigned char* vp) {
    const s16x4 lo = __builtin_bit_cast(s16x4, __builtin_amdgcn_ds_read_tr16_b64_v4i16((LAS s16x4*)(vp)));
    const s16x4 hh = __builtin_bit_cast(s16x4, __builtin_amdgcn_ds_read_tr16_b64_v4i16((LAS s16x4*)(vp + 8 * AT_VST)));
    return (bf16x8){lo[0], lo[1], lo[2], lo[3], hh[0], hh[1], hh[2], hh[3]};
}
__device__ __forceinline__ float attn_stage1(const f32x16& p0, const f32x16& p1, f32x16& n0, f32x16& n1, const bf16x8 (&qr)[4], const LAS unsigned char* kf) {
    float mx = at_max3(p0[0], p0[1], at_max3(p1[0], p1[1], p1[1]));
    bf16x8 a0 = *(const LAS bf16x8*)(kf), a1 = *(const LAS bf16x8*)(kf + 32 * AT_KST);
    AT_SBAR();
#pragma unroll
    for (int ks = 0; ks < 4; ++ks) {
        bf16x8 b0 = a0, b1 = a1;
        if (ks < 3) { b0 = *(const LAS bf16x8*)(kf + (ks + 1) * 32); b1 = *(const LAS bf16x8*)(kf + 32 * AT_KST + (ks + 1) * 32); }
        if (ks == 0) n0 = __builtin_amdgcn_mfma_f32_32x32x16_bf16(a0, qr[0], (f32x16){0.f, 0.f, 0.f, 0.f, 0.f, 0.f, 0.f, 0.f, 0.f, 0.f, 0.f, 0.f, 0.f, 0.f, 0.f, 0.f}, 0, 0, 0);
        else n0 = __builtin_amdgcn_mfma_f32_32x32x16_bf16(a0, qr[ks], n0, 0, 0, 0);
        mx = at_max3(at_max3(mx, p0[4 * ks + 2], p0[4 * ks + 3]), p1[4 * ks + 2], p1[4 * ks + 3]); AT_PIN1(mx); AT_SBAR();
        if (ks == 0) n1 = __builtin_amdgcn_mfma_f32_32x32x16_bf16(a1, qr[0], (f32x16){0.f, 0.f, 0.f, 0.f, 0.f, 0.f, 0.f, 0.f, 0.f, 0.f, 0.f, 0.f, 0.f, 0.f, 0.f, 0.f}, 0, 0, 0);
        else n1 = __builtin_amdgcn_mfma_f32_32x32x16_bf16(a1, qr[ks], n1, 0, 0, 0);
        if (ks < 3) { mx = at_max3(at_max3(mx, p0[4 * ks + 4], p0[4 * ks + 5]), p1[4 * ks + 4], p1[4 * ks + 5]); AT_PIN1(mx); } AT_SBAR();
        a0 = b0; a1 = b1;
    }
    return mx;
}
template <bool FIRST>
__device__ __forceinline__ void attn_stage2(AttnState& st, const f32x16& p0, const f32x16& p1, float mx, const LAS unsigned char* vf) {
    constexpr float SC = 0.125f * 1.4426950408889634f, THR = 8.0f;
    bf16x8 vcur; if (!FIRST) vcur = at_vfrag(vf);
    float tm = fmaxf(mx, __shfl_xor(mx, 32)) * SC;
    if (__any(tm > st.mrun + THR)) {
        const float mn = fmaxf(st.mrun, tm); const float al = __builtin_amdgcn_exp2f(fmaxf(st.mrun - mn, -126.f));
#pragma unroll
        for (int db = 0; db < 4; ++db)
#pragma unroll
            for (int r = 0; r < 16; ++r) st.o[db][r] *= al;
        if (!FIRST) {
#pragma unroll
            for (int kk = 0; kk < 4; ++kk) { u32x4 w = __builtin_bit_cast(u32x4, st.pfp[kk]);
                w.x = pk2(bflo(w.x) * al, bfhi(w.x) * al); w.y = pk2(bflo(w.y) * al, bfhi(w.y) * al); w.z = pk2(bflo(w.z) * al, bfhi(w.z) * al); w.w = pk2(bflo(w.w) * al, bfhi(w.w) * al);
                st.pfp[kk] = __builtin_bit_cast(bf16x8, w); }
        }
        st.lrun *= al; st.mrun = mn;
    }
    const float nm = -st.mrun; float ls = 0.f;
    AT_SBAR();
#pragma unroll
    for (int kk = 0; kk < 4; ++kk) {
        unsigned pw0 = 0, pw1 = 0, pw2 = 0, pw3 = 0;
#pragma unroll
        for (int db = 0; db < 4; ++db) {
            const int g = kk * 4 + db;
            if (!FIRST) {
                bf16x8 vnext = vcur;
                if (g < 15) { const int g2 = g + 1; vnext = at_vfrag(vf + ((g2 >> 2) * 16) * AT_VST + (g2 & 3) * 64); }
                st.o[db] = __builtin_amdgcn_mfma_f32_32x32x16_bf16(vcur, st.pfp[kk], st.o[db], 0, 0, 0);
                vcur = vnext;
            }
            const float x0 = g < 8 ? p0[2 * g] : p1[2 * g - 16], x1 = g < 8 ? p0[2 * g + 1] : p1[2 * g - 15];
            const float e0 = __builtin_amdgcn_exp2f(__builtin_fmaf(x0, SC, nm)), e1 = __builtin_amdgcn_exp2f(__builtin_fmaf(x1, SC, nm));
            ls += e0 + e1; unsigned w = pk2(e0, e1); AT_PIN1(ls); AT_PIN1(w);
            if (db == 0) pw0 = w; else if (db == 1) pw1 = w; else if (db == 2) pw2 = w; else pw3 = w;
            AT_SBAR();
        }
        st.pfp[kk] = __builtin_bit_cast(bf16x8, (u32x4){pw0, pw1, pw2, pw3});
    }
    st.lrun += ls;
}
__device__ __forceinline__ void attn_unit(const Frame& F, int tokq0, int tokk0, int ntiles, int h, float lam, const float* gain, float oscale) {
    const bf16_t* Q = (const bf16_t*)(F.ws + OV_Q); const char* Kg = (const char*)(F.ws + OV_K); const char* Vg = (const char*)(F.ws + OV_V); bf16_t* OA = (bf16_t*)(F.ws + OV_OA);
    const int lane = F.lane, r32 = lane & 31, hi = lane >> 5, rb = F.wave >> 1, c = F.wave & 1;
    bf16x8 qr[4];
    { const bf16_t* qp = Q + (size_t)(tokq0 + rb * 32 + r32) * 512 + h * 128 + c * 64 + hi * 8;
#pragma unroll
      for (int ks = 0; ks < 4; ++ks) qr[ks] = *(const bf16x8*)(qp + ks * 16); }
    const int srow0 = F.tid >> 4, sch = F.tid & 15;
    const unsigned goff = (unsigned)(((tokk0 + srow0) * 512 + h * 128 + sch * 8) * 2);
    LAS unsigned char* kl = F.lds + AT_KOFF + srow0 * AT_KST + sch * 16;
    LAS unsigned char* vl = F.lds + AT_VOFF + srow0 * AT_VST + sch * 16;
    const LAS unsigned char* kfb = F.lds + AT_KOFF + r32 * AT_KST + (c * 64 + hi * 8) * 2;
    const LAS unsigned char* vfb = F.lds + AT_VOFF + (4 * hi + ((lane & 15) >> 2)) * AT_VST + (((lane >> 4) & 1) * 16 + (lane & 3) * 4) * 2;
    {
      const u32x4 k0 = *(const u32x4*)(Kg + goff), k1 = *(const u32x4*)(Kg + goff + 32 * 1024), k2 = *(const u32x4*)(Kg + goff + 64 * 1024), k3 = *(const u32x4*)(Kg + goff + 96 * 1024);
      *(LAS u32x4*)(kl) = k0; *(LAS u32x4*)(kl + 32 * AT_KST) = k1; *(LAS u32x4*)(kl + 64 * AT_KST) = k2; *(LAS u32x4*)(kl + 96 * AT_KST) = k3; }
    __syncthreads();
    AttnState st; st.mrun = -1e30f; st.lrun = 0.f;
#pragma unroll
    for (int db = 0; db < 4; ++db)
#pragma unroll
        for (int r = 0; r < 16; ++r) st.o[db][r] = 0.f;
    f32x16 pa0, pa1, pb0, pb1;
#pragma unroll
    for (int r = 0; r < 16; ++r) { pa0[r] = 0.f; pa1[r] = 0.f; }
#pragma unroll
    for (int ks = 0; ks < 4; ++ks) {
        const bf16x8 a0 = *(const LAS bf16x8*)(kfb + ks * 32), a1 = *(const LAS bf16x8*)(kfb + 32 * AT_KST + ks * 32);
        pa0 = __builtin_amdgcn_mfma_f32_32x32x16_bf16(a0, qr[ks], pa0, 0, 0, 0); pa1 = __builtin_amdgcn_mfma_f32_32x32x16_bf16(a1, qr[ks], pa1, 0, 0, 0);
    }
    asm volatile("s_nop 15\n\ts_nop 7" : "+v"(pa0), "+v"(pa1));
    u32x4 sv0 = *(const u32x4*)(Vg + goff), sv1 = *(const u32x4*)(Vg + goff + 32 * 1024);
#define AT_ITER(I, FIRSTF, PC0, PC1, PN0, PN1) do { \
        const int i_ = (I); const bool ldk_ = i_ + 2 < ntiles; const int sl_ = i_ & 1; \
        const float mx_ = attn_stage1(PC0, PC1, PN0, PN1, qr, kfb + ((i_ + 1) & 1) * (64 * AT_KST)); \
        *(LAS u32x4*)(vl + sl_ * (64 * AT_VST)) = sv0; *(LAS u32x4*)(vl + sl_ * (64 * AT_VST) + 32 * AT_VST) = sv1; \
        u32x4 sk0_, sk1_; if (ldk_) { const unsigned go_ = goff + (unsigned)(i_ + 2) * 65536u; sk0_ = *(const u32x4*)(Kg + go_); sk1_ = *(const u32x4*)(Kg + go_ + 32 * 1024); } \
        attn_stage2<FIRSTF>(st, PC0, PC1, mx_, vfb + ((i_ + 1) & 1) * (64 * AT_VST)); \
        if (ldk_) { *(LAS u32x4*)(kl + sl_ * (64 * AT_KST)) = sk0_; *(LAS u32x4*)(kl + sl_ * (64 * AT_KST) + 32 * AT_KST) = sk1_; } \
        if (i_ + 1 < ntiles) { const unsigned gv_ = goff + (unsigned)(i_ + 1) * 65536u; sv0 = *(const u32x4*)(Vg + gv_); sv1 = *(const u32x4*)(Vg + gv_ + 32 * 1024); } \
        __syncthreads(); } while (0)
    AT_ITER(0, true, pa0, pa1, pb0, pb1);
    AT_ITER(1, false, pb0, pb1, pa0, pa1);
#pragma unroll 1
    for (int i = 2; i < ntiles; i += 2) {
        AT_ITER(i, false, pa0, pa1, pb0, pb1);
        AT_ITER(i + 1, false, pb0, pb1, pa0, pa1);
    }
#undef AT_ITER
    {
      const LAS unsigned char* vf = vfb + ((ntiles - 1) & 1) * (64 * AT_VST);
#pragma unroll
      for (int db = 0; db < 4; ++db)
#pragma unroll
          for (int kk = 0; kk < 4; ++kk) {
              const LAS unsigned char* vp = vf + (kk * 16) * AT_VST + db * 64;
              const s16x4 lo = __builtin_bit_cast(s16x4, __builtin_amdgcn_ds_read_tr16_b64_v4i16((LAS s16x4*)(vp)));
              const s16x4 hh = __builtin_bit_cast(s16x4, __builtin_amdgcn_ds_read_tr16_b64_v4i16((LAS s16x4*)(vp + 8 * AT_VST)));
              const bf16x8 vfr = {lo[0], lo[1], lo[2], lo[3], hh[0], hh[1], hh[2], hh[3]};
              st.o[db] = __builtin_amdgcn_mfma_f32_32x32x16_bf16(vfr, st.pfp[kk], st.o[db], 0, 0, 0);
          } }
    float lrun = st.lrun; lrun += __shfl_xor(lrun, 32);
    const float il = 1.f / lrun;
    LAS float* ex = (LAS float*)(F.lds + AT_XOFF) + rb * 4096;
    if (c == 1) {
#pragma unroll
        for (int db = 0; db < 4; ++db)
#pragma unroll
            for (int r = 0; r < 16; ++r) ex[(db * 16 + r) * 64 + lane] = st.o[db][r] * il;
    }
    __syncthreads();
    if (c == 0) {
        float ss = 0.f;
#pragma unroll
        for (int db = 0; db < 4; ++db)
#pragma unroll
            for (int r = 0; r < 16; ++r) { const float dv = st.o[db][r] * il - lam * ex[(db * 16 + r) * 64 + lane]; st.o[db][r] = dv; ss += dv * dv; }
        ss += __shfl_xor(ss, 32);
        const float rinv = oscale / sqrtf(ss * (1.f / 128.f) + RMS_EPS);
        bf16_t* op = OA + (size_t)(tokq0 + rb * 32 + r32) * 512 + h * 128;
#pragma unroll
        for (int db = 0; db < 4; ++db)
#pragma unroll
            for (int r4 = 0; r4 < 4; ++r4) { const int dv0 = db * 32 + 8 * r4 + 4 * hi; const f32x4 gv = *(const f32x4*)(gain + dv0);
                u32x2 w; w.x = pk2(st.o[db][4 * r4] * rinv * gv[0], st.o[db][4 * r4 + 1] * rinv * gv[1]); w.y = pk2(st.o[db][4 * r4 + 2] * rinv * gv[2], st.o[db][4 * r4 + 3] * rinv * gv[3]);
                *(u32x2*)(op + dv0) = w; }
    }
    __syncthreads();
}

__device__ __forceinline__ void phase_attn(const Frame& F, CArgsP a, int l) {
    const float lam = ((const float*)(F.ws + WS_LAM))[l]; const float li = 0.8f - 0.6f * expf(-0.3f * (float)l);
    for (int dd = 0; dd < NDUP(6); ++dd) lru_phase(F, a, l, 1, l == 1);
    __syncthreads();
    const int nlat = 4 * 4 * 32, nctx = (l == 0) ? 4 * 4 * 2 : 0;
    for (int dd = 0; dd < NDUP(7); ++dd)
    for (int it = F.vcu; it < nlat + nctx; it += F.G) {
        int b, h, qb, tq0, nt;
        if (it < nlat) { qb = it & 31; h = (it >> 5) & 3; b = it >> 7; tq0 = b * TPB + CTX + qb * 128; nt = 68; }
        else { const int i2 = it - nlat; qb = i2 & 1; h = (i2 >> 1) & 3; b = i2 >> 3; tq0 = b * TPB + qb * 128; nt = 4; }
        attn_unit(F, tq0, b * TPB, nt, h, lam, a->in[12] + (l * 4 + h) * 128, 1.0f - li);
    }
}

__device__ __forceinline__ void mini_tile(const bf16_t* A, int lda, const bf16_t* Bt, int K, int lane, int wave, f32x4 (&acc)[2]) {
    const int fr = lane & 15, fq = lane >> 4;
    const bf16_t* ap = A + (size_t)((wave >> 1) * 16 + fr) * lda + fq * 8;
    const bf16_t* bp0 = Bt + (size_t)((wave & 1) * 32 + fr) * K + fq * 8; const bf16_t* bp1 = bp0 + (size_t)16 * K;
    acc[0] = (f32x4){0.f, 0.f, 0.f, 0.f}; acc[1] = (f32x4){0.f, 0.f, 0.f, 0.f};
#pragma unroll 8
    for (int k = 0; k < K; k += 32) {
        const bf16x8 av = *(const bf16x8*)(ap + k), b0 = *(const bf16x8*)(bp0 + k), b1 = *(const bf16x8*)(bp1 + k);
        acc[0] = __builtin_amdgcn_mfma_f32_16x16x32_bf16(b0, av, acc[0], 0, 0, 0); acc[1] = __builtin_amdgcn_mfma_f32_16x16x32_bf16(b1, av, acc[1], 0, 0, 0);
    }
}
__device__ __forceinline__ void mini_merge_ctx(const Frame& F, int l) {
    const int fr = F.lane & 15, fq = F.lane >> 4;
    for (int t = F.bid; t < 256; t += F.G) {
        const int rb = t >> 4, cbk = t & 15, cr = rb * 64, tok0 = (cr >> 8) * TPB + (cr & 255), col0 = cbk * 64;
        const int row = tok0 + (F.wave >> 1) * 16 + fr, colw = col0 + (F.wave & 1) * 32 + fq * 4;
        f32x4 mg[2] = {{0.f, 0.f, 0.f, 0.f}, {0.f, 0.f, 0.f, 0.f}};
#pragma unroll 1
        for (int r = 0; r < 3; ++r) {
            f32x4 acc[2];
            mini_tile((const bf16_t*)(F.ws + OV_OA + (size_t)r * 17 * MiB) + (size_t)tok0 * 512, 512, (const bf16_t*)(F.ws + WS_WBR) + (size_t)(l * 3 + r) * 1024 * 512 + (size_t)col0 * 512, 512, F.lane, F.wave, acc);
#pragma unroll
            for (int n = 0; n < 2; ++n) { const u32x2 g = *(const u32x2*)((const bf16_t*)(F.ws + OV_G) + (size_t)row * 3072 + r * 1024 + colw + n * 16);
                mg[n][0] += bflo(g.x) * acc[n][0]; mg[n][1] += bfhi(g.x) * acc[n][1]; mg[n][2] += bflo(g.y) * acc[n][2]; mg[n][3] += bfhi(g.y) * acc[n][3]; }
        }
#pragma unroll
        for (int n = 0; n < 2; ++n) { u32x2 w; w.x = pk2(mg[n][0], mg[n][1]); w.y = pk2(mg[n][2], mg[n][3]); *(u32x2*)((bf16_t*)(F.ws + OV_MG) + (size_t)row * DM + colw + n * 16) = w; }
    }
}
__device__ __forceinline__ void mini_wout_ctx(const Frame& F, int l) {
    const int fr = F.lane & 15, fq = F.lane >> 4;
    const float* g1 = (const float*)(F.ws + WS_MOD) + (l * 5 + 4) * 6144 + 2048;
    for (int t = F.bid; t < 256; t += F.G) {
        const int rb = t >> 4, cbk = t & 15, cr = rb * 64, tok0 = (cr >> 8) * TPB + (cr & 255), col0 = cbk * 64;
        const int crow = cr + (F.wave >> 1) * 16 + fr, colw = col0 + (F.wave & 1) * 32 + fq * 4;
        f32x4 acc[2];
        mini_tile((const bf16_t*)(F.ws + OV_MG) + (size_t)tok0 * DM, DM, (const bf16_t*)(F.ws + WS_WOUT) + (size_t)l * 1048576 + (size_t)col0 * 1024, 1024, F.lane, F.wave, acc);
#pragma unroll
        for (int n = 0; n < 2; ++n) { f32x4* p = (f32x4*)((float*)(F.ws + WS_XC) + (size_t)crow * DM + colw + n * 16); const f32x4 gv = *(const f32x4*)(g1 + colw + n * 16); const f32x4 x = *p; *p = x * DN_ALPHA + gv * acc[n]; }
    }
}

constexpr int RT_AST = 1032;
__device__ __forceinline__ void phase_router(const Frame& F, CArgsP a, int l, bool dry) {
    const float* mod = (const float*)(F.ws + WS_MOD) + l * 5 * 6144; float* xc = (float*)(F.ws + WS_XC); bf16_t* H = (bf16_t*)(F.ws + WS_H);
    LAS bf16_t* AT = (LAS bf16_t*)F.lds;
    LAS float* LG = (LAS float*)(F.lds + 32 * RT_AST * 2);
    LAS unsigned* LC = (LAS unsigned*)(F.lds + 32 * RT_AST * 2 + 8192);
    const bf16_t* Wt = (const bf16_t*)(F.ws + WS_WRT) + (size_t)l * 65536; const float rb_ = a->in[29][l * 64 + F.lane];
    unsigned* cnt = (unsigned*)(F.ws + WS_CNT) + l * 4096; int* list = (int*)(F.ws + WS_LIST);
    int* toke = (int*)(F.ws + WS_TOKE); int* tokp = (int*)(F.ws + WS_TOKP); float* tokw = (float*)(F.ws + WS_TOKW);
    const int nrows = l == 0 ? T : NBATCH * SEQ, nbatch = nrows / 32;
    const int fr = F.lane & 15, fq = F.lane >> 4, mt = F.wave & 1, nt = F.wave >> 1;
    if (F.tid < 64) LC[F.tid] = 0u;
    for (int bt = F.bid; bt < nbatch; bt += F.G) {
        int toks[4];
#pragma unroll
        for (int r = 0; r < 4; ++r) { const int ridx = bt * 32 + F.wave * 4 + r; toks[r] = l == 0 ? ridx : (ridx >> 12) * TPB + CTX + (ridx & 4095); }
#pragma unroll
        for (int rp = 0; rp < 4; rp += 2) {
        f32x4 vv[2][4];
        row_load(resid_row(F.out, xc, toks[rp]), F.lane, vv[0]); row_load(resid_row(F.out, xc, toks[rp + 1]), F.lane, vv[1]);
#pragma unroll
        for (int r2 = 0; r2 < 2; ++r2) { const int r = rp + r2; const int tok = toks[r];
            const int b = tok / TPB; const int bsel = (tok - b * TPB) < CTX ? 4 : b;
            float* xr = resid_row(F.out, xc, tok);
            f32x4 (&v)[4] = vv[r2]; row_ln(v); row_affine(v, a->in[26] + l * DM, false, a->in[27] + l * DM, F.lane); if (!dry) row_store(xr, F.lane, v);
            row_ln(v); const float* mrow = mod + bsel * 6144; row_affine(v, mrow + 4096, true, mrow + 3072, F.lane);
#pragma unroll
            for (int j = 0; j < 4; ++j) { u32x2 w; w.x = pk2(v[j][0], v[j][1]); w.y = pk2(v[j][2], v[j][3]);
                if (!dry) *(u32x2*)(H + (size_t)tok * DM + 4 * F.lane + 256 * j) = w; *(LAS u32x2*)(AT + (F.wave * 4 + r) * RT_AST + 4 * F.lane + 256 * j) = w; }
        }
        }
        __syncthreads();
        { f32x4 d = {0.f, 0.f, 0.f, 0.f};
          const LAS bf16_t* ap = AT + (mt * 16 + fr) * RT_AST + fq * 8; const bf16_t* bp = Wt + (size_t)(nt * 16 + fr) * 1024 + fq * 8;
#pragma unroll 8
          for (int ks = 0; ks < 32; ++ks) { const bf16x8 av = *(const LAS bf16x8*)(ap + ks * 32); const bf16x8 bv = *(const bf16x8*)(bp + ks * 32); d = __builtin_amdgcn_mfma_f32_16x16x32_bf16(av, bv, d, 0, 0, 0); }
#pragma unroll
          for (int r = 0; r < 4; ++r) LG[(mt * 16 + fq * 4 + r) * 64 + nt * 16 + fr] = d[r]; }
        __syncthreads();
        bool selr[4]; int rkr[4], lpr[4]; float wr_[4];
#pragma unroll
        for (int r = 0; r < 4; ++r) {
            const float lg = LG[(F.wave * 4 + r) * 64 + F.lane];
            const float s = 1.f / (1.f + expf(-lg)); const float bsc = s + rb_;
            float m1 = bsc; m1 = fmaxf(m1, __shfl_xor(m1, 1)); m1 = fmaxf(m1, __shfl_xor(m1, 2)); m1 = fmaxf(m1, __shfl_xor(m1, 4));
            const unsigned long long eq = __ballot(bsc == m1); const unsigned gm = (unsigned)(eq >> (F.lane & ~7)) & 0xffu; const int first = __ffs(gm) - 1;
            float m2 = ((F.lane & 7) == first) ? -INFINITY : bsc; m2 = fmaxf(m2, __shfl_xor(m2, 1)); m2 = fmaxf(m2, __shfl_xor(m2, 2)); m2 = fmaxf(m2, __shfl_xor(m2, 4));
            const float gs = m1 + m2; const int myg = F.lane >> 3; int grank = 0;
#pragma unroll
            for (int g = 0; g < 8; ++g) { const float og = __builtin_bit_cast(float, __builtin_amdgcn_readlane(__builtin_bit_cast(int, gs), g * 8)); grank += (int)(og > gs) + (int)((og == gs) & (g < myg)); }
            const bool gsel = grank < 4; const float mk = gsel ? bsc : -INFINITY; int rk = 0;
#pragma unroll
            for (int j = 0; j < 64; ++j) { const float vj = __builtin_bit_cast(float, __builtin_amdgcn_readlane(__builtin_bit_cast(int, mk), j)); rk += (int)(vj > mk) + (int)((vj == mk) & (j < F.lane)); }
            const bool sel = gsel && rk < 8 && !dry;
            const float ssum = wave_sum((gsel && rk < 8) ? s : 0.f);
            selr[r] = sel; rkr[r] = rk; wr_[r] = s / ssum * 2.5f; lpr[r] = 0;
            if (sel) lpr[r] = (int)__hip_atomic_fetch_add((LAS unsigned*)(LC + F.lane), 1u, __ATOMIC_RELAXED, __HIP_MEMORY_SCOPE_WORKGROUP);
        }
        __syncthreads();
        if (F.tid < 64) { const unsigned n = LC[F.tid]; unsigned base = 0; if (n) base = atomicAdd(cnt + F.tid * 64, n); LC[64 + F.tid] = base; LC[F.tid] = 0u; }
        __syncthreads();
#pragma unroll
        for (int r = 0; r < 4; ++r)
            if (selr[r]) { const int tok = toks[r]; const int pos = (int)LC[64 + F.lane] + lpr[r];
                list[(size_t)F.lane * T + pos] = tok; toke[tok * 8 + rkr[r]] = F.lane; tokp[tok * 8 + rkr[r]] = pos; tokw[tok * 8 + rkr[r]] = wr_[r]; }
        __syncthreads();
    }
}

__device__ __forceinline__ void build_tables(const Frame& F, int l) {
    LAS int* tb = (LAS int*)(F.lds + LDS_CTL);
    __syncthreads();
    if (F.tid < 64) tb[LC_TCNT + F.tid] = (int)__hip_atomic_load((unsigned*)(F.ws + WS_CNT) + l * 4096 + F.tid * 64, __ATOMIC_RELAXED, __HIP_MEMORY_SCOPE_AGENT);
    __syncthreads();
    if (F.tid == 0) { int tbs = 0, sbs = 0;
        for (int e = 0; e < 64; ++e) { const int c = tb[LC_TCNT + e]; tb[LC_TBASE + e] = tbs; tb[LC_SBASE + e] = sbs; tbs += (c + 255) >> 8; sbs += c; }
        tb[LC_TBASE + 64] = tbs; tb[LC_SBASE + 64] = sbs; }
    __syncthreads();
}

__device__ __forceinline__ void phase_combine(const Frame& F, CArgsP a, int l, bool dry) {
    const float* mod = (const float*)(F.ws + WS_MOD) + l * 5 * 6144; float* xc = (float*)(F.ws + WS_XC); bf16_t* H = (bf16_t*)(F.ws + WS_H);
    const unsigned char* YS = (const unsigned char*)(F.ws + OV_YS); const LAS int* tb = (const LAS int*)(F.lds + LDS_CTL);
    const int* toke = (const int*)(F.ws + WS_TOKE); const int* tokp = (const int*)(F.ws + WS_TOKP); const float* tokw = (const float*)(F.ws + WS_TOKW);
    const int nrows = l == 0 ? T : NBATCH * SEQ;
    for (int rp = F.gw * 2; rp < nrows; rp += F.NGW * 2) {
        int tok[2], bsel[2]; float* xr[2]; f32x4 y[2][4], v[2][4]; int me, mp; float mw;
#pragma unroll
        for (int q = 0; q < 2; ++q) { const int ridx = rp + q; tok[q] = l == 0 ? ridx : (ridx >> 12) * TPB + CTX + (ridx & 4095);
            const int b = tok[q] / TPB; bsel[q] = (tok[q] - b * TPB) < CTX ? 4 : b; xr[q] = resid_row(F.out, xc, tok[q]); }
        { const int q = (F.lane >> 3) & 1, k = F.lane & 7; me = toke[tok[q] * 8 + k]; mp = tokp[tok[q] * 8 + k]; mw = tokw[tok[q] * 8 + k]; }
#pragma unroll
        for (int q = 0; q < 2; ++q) { const bf16_t* sp = H + (size_t)tok[q] * DM;
#pragma unroll
            for (int j = 0; j < 4; ++j) { const u32x2 w = *(const u32x2*)(sp + 4 * F.lane + 256 * j); y[q][j] = (f32x4){bflo(w.x), bfhi(w.x), bflo(w.y), bfhi(w.y)}; }
            row_load(xr[q], F.lane, v[q]); }
#pragma unroll
        for (int q = 0; q < 2; ++q)
#pragma unroll
            for (int k = 0; k < 8; ++k) { const int e = __shfl(me, q * 8 + k), p = __shfl(mp, q * 8 + k); const float wv = __shfl(mw, q * 8 + k) * 0.0625f;
                const unsigned char* yp = YS + (size_t)(tb[LC_SBASE + e] + p) * DM;
#pragma unroll
                for (int j = 0; j < 4; ++j) { const int w = (int)*(const unsigned*)(yp + 4 * F.lane + 256 * j);
                    y[q][j][0] += wv * __builtin_amdgcn_cvt_f32_fp8(w, 0); y[q][j][1] += wv * __builtin_amdgcn_cvt_f32_fp8(w, 1); y[q][j][2] += wv * __builtin_amdgcn_cvt_f32_fp8(w, 2); y[q][j][3] += wv * __builtin_amdgcn_cvt_f32_fp8(w, 3); } }
#pragma unroll
        for (int q = 0; q < 2; ++q) {
            const float* g2 = mod + bsel[q] * 6144 + 5120;
#pragma unroll
            for (int j = 0; j < 4; ++j) { const f32x4 gv = *(const f32x4*)(g2 + 4 * F.lane + 256 * j); v[q][j] = v[q][j] * DN_ALPHA + gv * y[q][j]; }
            row_ln(v[q]); row_affine(v[q], a->in[36] + l * DM, false, a->in[37] + l * DM, F.lane);
            if (!dry) row_store(xr[q], F.lane, v[q]); else asm volatile("" :: "v"(v[q][0]), "v"(v[q][1]), "v"(v[q][2]), "v"(v[q][3]));
            if (l == 0 && !dry) { row_ln(v[q]); const float* mrow = mod + 5 * 6144 + bsel[q] * 6144; row_affine(v[q], mrow + 1024, true, mrow, F.lane); row_store_bf16(H + (size_t)tok[q] * DM, F.lane, v[q]); }
        }
    }
}

constexpr int NPHASE = 22;
__global__ void __launch_bounds__(NTHR, 2) mk_fwd(Args args) {
    extern __shared__ __attribute__((aligned(16))) unsigned char lds_raw[];
    Frame F; F.lds = (LAS unsigned char*)lds_raw; F.tid = threadIdx.x; F.lane = F.tid & 63; F.wave = __builtin_amdgcn_readfirstlane(F.tid >> 6);
    F.G = gridDim.x; F.bid = blockIdx.x; F.gw = F.bid * NWAVES + F.wave; F.NGW = F.G * NWAVES; F.ws = args.ws; F.out = args.out; F.vcu = (F.G % 8 == 0) ? (F.bid % 8) * (F.G / 8) + F.bid / 8 : F.bid;
    for (int u = F.tid; u < (LDS_BYTES - LDS_CTL) / 4; u += NTHR) ((LAS unsigned*)(F.lds + LDS_CTL))[u] = 0u;
    __syncthreads();
    const int lo = args.ph_lo, hi = args.ph_hi;
    CArgsP A4 = (CArgsP)__builtin_amdgcn_kernarg_segment_ptr();
    XcdBarrier bar; bar.bar = (unsigned*)(F.ws + CW_BAR_BYTE); bar.x = 0; bar.st = nullptr;
    if (hi - lo > 1) bar = xcd_barrier_post((unsigned*)(F.ws + CW_BAR_BYTE), (volatile LAS unsigned*)(F.lds + LDS_CTL) + LC_BAR);
#ifndef PHMASK
#define PHMASK 0xfff
#endif
#define PH_EN(k) ((PHMASK >> ((k) < 2 ? (k) : 2 + (((k) - 2) % 10))) & 1)
#define IN(k) (PH_EN(k) && lo <= (k) && (k) < hi)
#define SEAM(k) do { if (IN(k) && IN((k) + 1)) { for (int dd = 0; dd < NDUP(14); ++dd) xcd_barrier(bar); } if (TSMASK != 0 && blockIdx.x == 0 && threadIdx.x == 0) { ((volatile LAS unsigned long long*)(F.lds + LDS_CTL + 2048))[(k) + 1] = __builtin_amdgcn_s_memrealtime(); } FRESH(); } while (0)
#define FRESH() do { int t_ = threadIdx.x, b_ = blockIdx.x; CArgsP p_ = (CArgsP)__builtin_amdgcn_kernarg_segment_ptr(); asm volatile("" : "+v"(t_)); asm volatile("" : "+s"(b_), "+s"(p_)); A4 = p_; unsigned char* w_ = p_->ws; float* o_ = p_->out; \
    F.tid = t_; F.lane = t_ & 63; F.wave = __builtin_amdgcn_readfirstlane(t_ >> 6); F.bid = b_; F.gw = b_ * NWAVES + F.wave; F.ws = w_; F.out = o_; F.vcu = (F.G % 8 == 0) ? (b_ % 8) * (F.G / 8) + b_ / 8 : b_; } while (0)
    if (TSMASK != 0 && blockIdx.x == 0 && threadIdx.x == 0) ((volatile LAS unsigned long long*)(F.lds + LDS_CTL + 2048))[0] = __builtin_amdgcn_s_memrealtime();
    if (IN(0)) { for (int dd = 0; dd < NDUP(0); ++dd) phase_prologue(F, A4); } SEAM(0);
    if (IN(1)) { for (int dd = 0; dd < NDUP(1); ++dd) phase_rows0(F, A4); } SEAM(1);
#pragma unroll 1
    for (int l = 0; l < 2; ++l) {
        const int pb = 2 + 10 * l; const bool lat = (l == 1);
        if (IN(pb + 0)) {
            SchedPlain S{(const char*)(F.ws + WS_H), (const char*)(F.ws + WS_WIN) + (size_t)l * INC * 1024 * 2, 1024, 68, 26, F.G, F.bid, false};
            EpiInproj E{F.ws, A4->in[7] + l * INC, (const float*)(F.ws + WS_ROPE)};
            for (int dd = 0; dd < NDUP(2); ++dd) pg8::gemm_phase(F.lds, 1024, S, E);
        } SEAM(pb + 0);
        if (IN(pb + 1)) {
            for (int dd = 0; dd < NDUP(3); ++dd) lru_phase(F, A4, l, 0, false);
            for (int dd = 0; dd < NDUP(4); ++dd)
            for (int it = F.bid; it < 136 * 4; it += F.G) { const int chunk = it >> 2; if (lat && (chunk % 34) < 2) continue; sg_item(F, A4, l, chunk, it & 3); }
        } SEAM(pb + 1);
        if (IN(pb + 2)) { for (int dd = 0; dd < NDUP(5); ++dd) phase_carry(F); } SEAM(pb + 2);
        if (IN(pb + 3)) { phase_attn(F, A4, l); } SEAM(pb + 3);
        if (IN(pb + 4)) {
            for (int dd = 0; dd < NDUP(8); ++dd) {
                SchedMerge S{(const char*)(F.ws + OV_OA), (const char*)(F.ws + WS_WBR) + (size_t)(l * 3) * 1024 * 512 * 2, F.G, F.bid};
                EpiMerge E{(bf16_t*)(F.ws + OV_MG), (const bf16_t*)(F.ws + OV_G)};
                pg8::gemm_phase(F.lds, 512, S, E);
            }
            if (!lat) mini_merge_ctx(F, l);
        } SEAM(pb + 4);
        if (IN(pb + 5)) {
            SchedPlain S{(const char*)(F.ws + OV_MG), (const char*)(F.ws + WS_WOUT) + (size_t)l * 1048576 * 2, 1024, 64, 4, F.G, F.bid, true};
            EpiWout E{F.out, (float*)(F.ws + WS_XC), (const float*)(F.ws + WS_MOD) + l * 5 * 6144, false};
            pg8::gemm_phase(F.lds, 1024, S, E);
            if (NDUP(11) > 1) { EpiWout E2{F.out, (float*)(F.ws + WS_XC), (const float*)(F.ws + WS_MOD) + l * 5 * 6144, true}; pg8::gemm_phase(F.lds, 1024, S, E2); }
            if (!lat) mini_wout_ctx(F, l);
        } SEAM(pb + 5);
        if (IN(pb + 6)) { phase_router(F, A4, l, false); if (NDUP(12) > 1) phase_router(F, A4, l, F.G != 12345); } SEAM(pb + 6);
        if (IN(pb + 7)) {
            build_tables(F, l);
            SchedMoe S{(const char*)(F.ws + WS_H), (const char*)(F.ws + WS_H), (const char*)(F.ws + WS_WM1), (const char*)(F.ws + WS_WSH1) + (size_t)l * 524288 * 2,
                       (const int*)(F.ws + WS_LIST), (const LAS int*)(F.lds + LDS_CTL), 1024, 2, F.G, F.vcu, lat ? 64 : 68, lat, true, (size_t)524288 * 2};
            EpiMoe1 E{(bf16_t*)(F.ws + OV_ACT), (bf16_t*)(F.ws + OV_ACTSH)};
            for (int dd = 0; dd < NDUP(9); ++dd) pg8::gemm_phase(F.lds, 1024, S, E);
        } SEAM(pb + 7);
        if (IN(pb + 8)) {
            build_tables(F, l);
            SchedMoe S{(const char*)(F.ws + OV_ACT), (const char*)(F.ws + OV_ACTSH), (const char*)(F.ws + WS_WM2), (const char*)(F.ws + WS_WSH2) + (size_t)l * 262144 * 2,
                       (const int*)(F.ws + WS_LIST), (const LAS int*)(F.lds + LDS_CTL), 256, 4, F.G, F.vcu, lat ? 64 : 68, lat, false, (size_t)262144 * 2};
            EpiMoe2 E{(unsigned char*)(F.ws + OV_YS), (bf16_t*)(F.ws + WS_H)};
            for (int dd = 0; dd < NDUP(10); ++dd) pg8::gemm_phase(F.lds, 256, S, E);
        } SEAM(pb + 8);
        if (IN(pb + 9)) {
            build_tables(F, l);
            phase_combine(F, A4, l, false);
            if (NDUP(13) > 1) phase_combine(F, A4, l, F.G != 12345);
            if (l == 0) for (int dd = 0; dd < NDUP(15); ++dd) conv_moe_layer(F, A4, 1);
        } SEAM(pb + 9);
    }
    if (TSMASK != 0 && hi - lo == NPHASE) { __syncthreads(); asm volatile("s_waitcnt vmcnt(0)" ::: "memory");
        if (blockIdx.x == 0 && threadIdx.x == 0) { volatile LAS unsigned long long* ts = (volatile LAS unsigned long long*)(F.lds + LDS_CTL + 2048);
            unsigned long long sel = 0; for (int k = 0; k < NPHASE; ++k) if ((TSMASK >> k) & 1) sel += ts[k + 1] - ts[k];
            const float frac = (float)sel / (float)(ts[NPHASE] - ts[0]); args.out[0] += 1.0f + floorf(90.0f * frac + 0.5f); } }
#undef IN
#undef SEAM
}

extern "C" void kernel_launch(void* const* d_in, const int* in_sizes, int n_in, void* d_out, int out_size, void* d_ws, size_t ws_size, hipStream_t stream) {
    static int grid = 0;
    if (grid == 0) {
        if (n_in != 38 || out_size != NBATCH * SEQ * DM || ws_size < WS_END) { fprintf(stderr, "kernel_launch: unexpected shapes (n_in %d out %d ws %zu need %zu)\n", n_in, out_size, ws_size, (size_t)WS_END); grid = -1; return; }
        int dev = 0, cus = 0;
        if (hipGetDevice(&dev) != hipSuccess || hipDeviceGetAttribute(&cus, hipDeviceAttributeMultiprocessorCount, dev) != hipSuccess) { grid = -1; return; }
        if (hipFuncSetAttribute((const void*)mk_fwd, hipFuncAttributeMaxDynamicSharedMemorySize, LDS_BYTES) != hipSuccess) { fprintf(stderr, "kernel_launch: hipFuncSetAttribute failed\n"); grid = -1; return; }
        int per_cu = 0;
        if (hipOccupancyMaxActiveBlocksPerMultiprocessor(&per_cu, (const void*)mk_fwd, NTHR, LDS_BYTES) != hipSuccess || per_cu < 1) fprintf(stderr, "kernel_launch: occupancy query says %d\n", per_cu);
        (void)hipGetLastError();
        grid = cus;
    }
    if (grid < 0) return;
    (void)hipMemsetAsync((char*)d_ws + WS_CTL, 0, CTL_ZERO_BYTES, stream);
    Args a{};
    for (int i = 0; i < 38; ++i) a.in[i] = (const float*)d_in[i];
    a.out = (float*)d_out; a.ws = (unsigned char*)d_ws;
#if MK_MULTI
    for (int p = 0; p < NPHASE; ++p) { a.ph_lo = p; a.ph_hi = p + 1; hipLaunchKernelGGL(mk_fwd, dim3(grid), dim3(NTHR), LDS_BYTES, stream, a); }
#else
    a.ph_lo = 0; a.ph_hi = NPHASE; hipLaunchKernelGGL(mk_fwd, dim3(grid), dim3(NTHR), LDS_BYTES, stream, a);
#endif
}
```

```cpp
#include <hip/hip_runtime.h>
#include <cstdio>
#include <cstdint>
#include <cmath>

#ifndef MK_MULTI
#define MK_MULTI 0
#endif
#ifndef DUPMASK
#define DUPMASK 0
#endif
#define NDUP(c) (1 + ((DUPMASK >> (c)) & 1))
#ifndef TSMASK
#define TSMASK 0
#endif
#ifndef NAIVE_GEMM
#define NAIVE_GEMM 0
#endif

#define LAS __attribute__((address_space(3)))
#define GAS __attribute__((address_space(1)))
typedef unsigned short bf16_t;
typedef short bf16x8 __attribute__((ext_vector_type(8)));
typedef short s16x4 __attribute__((ext_vector_type(4)));
typedef float f32x4 __attribute__((ext_vector_type(4)));
typedef float f32x16 __attribute__((ext_vector_type(16)));
typedef unsigned u32x4 __attribute__((ext_vector_type(4)));
typedef unsigned u32x2 __attribute__((ext_vector_type(2)));

constexpr int DM = 1024, NBATCH = 4, SEQ = 4096, CTX = 256, TPB = SEQ + CTX  , T = NBATCH * TPB  ;
constexpr int INC = 6656, NEXP = 64;
constexpr float DN_ALPHA = 1.41421356237309515f;
constexpr float LN_EPS = 1e-6f, RMS_EPS = 1e-5f;
constexpr int NWAVES = 8, NTHR = 512;

constexpr size_t MiB = 1u << 20;
constexpr size_t WS_CTL = 0, CTL_ZERO_BYTES = 1 * MiB;
constexpr size_t CW_BAR_BYTE = 16384;
constexpr size_t WS_CNT = 65536;
constexpr size_t WS_MOD = 131072;
constexpr size_t WS_ROPE = 1 * MiB;
constexpr size_t WS_LAM = 1 * MiB + 8192;
constexpr size_t WS_SUM = 1 * MiB + 65536;
constexpr size_t WS_HIN = WS_SUM + 2304 * 1024;
constexpr size_t WS_TOKE = 5 * MiB, WS_TOKP = 6 * MiB, WS_TOKW = 7 * MiB;
constexpr size_t WS_LIST = 8 * MiB;
constexpr size_t WS_XC = 13 * MiB;
constexpr size_t WS_WLRU = 17 * MiB;
constexpr size_t WS_WSG = 17 * MiB + 512 * 1024;
constexpr size_t WS_WRT = 17 * MiB + 768 * 1024;
constexpr size_t WS_WSH1 = 18 * MiB;
constexpr size_t WS_WSH2 = 20 * MiB;
constexpr size_t WS_WOUT = 21 * MiB;
constexpr size_t WS_WBR = 25 * MiB;
constexpr size_t WS_WIN = 31 * MiB;
constexpr size_t WS_WM1 = 57 * MiB;
constexpr size_t WS_WM2 = 121 * MiB;
constexpr size_t WS_H = 153 * MiB;
constexpr size_t WS_OV = 187 * MiB;
constexpr size_t OV_Q = WS_OV, OV_K = WS_OV + 17 * MiB, OV_V = WS_OV + 34 * MiB, OV_U = WS_OV + 51 * MiB, OV_S = WS_OV + 68 * MiB,
                 OV_X = WS_OV + 85 * MiB, OV_Y = WS_OV + 102 * MiB, OV_G = WS_OV + 119 * MiB, OV_OA = WS_OV + 221 * MiB,
                 OV_OB = WS_OV + 238 * MiB, OV_OC = WS_OV + 255 * MiB, OV_MG = WS_OV + 272 * MiB;
constexpr size_t OV_ACT = WS_OV, OV_ACTSH = WS_OV + 69 * MiB, OV_YS = WS_OV + 78 * MiB;
constexpr size_t WS_END = WS_OV + 350 * MiB;

constexpr int LDS_SCRATCH = 147456;
constexpr int LDS_CTL = LDS_SCRATCH;
constexpr int LDS_BYTES = LDS_SCRATCH + 4096;
constexpr int LC_BAR = 0;
constexpr int LC_TCNT = 64, LC_TBASE = 64 + 80, LC_SBASE = 64 + 160;

struct Args { const float* in[38]; float* out; unsigned char* ws; int ph_lo, ph_hi; };
typedef const Args __attribute__((address_space(4)))* CArgsP;

__device__ __forceinline__ unsigned f2bf(float f) { unsigned u = __builtin_bit_cast(unsigned, f); return (u + 0x7fffu + ((u >> 16) & 1u)) >> 16; }
typedef float f32x2 __attribute__((ext_vector_type(2))); typedef __bf16 bf16x2_t __attribute__((ext_vector_type(2)));
__device__ __forceinline__ unsigned pk2(float lo, float hi) { const f32x2 v = {lo, hi}; const bf16x2_t b = __builtin_convertvector(v, bf16x2_t); return __builtin_bit_cast(unsigned, b); }
__device__ __forceinline__ float bflo(unsigned w) { return __builtin_bit_cast(float, w << 16); }
__device__ __forceinline__ float bfhi(unsigned w) { return __builtin_bit_cast(float, w & 0xffff0000u); }
__device__ __forceinline__ float bf2f(bf16_t b) { return __builtin_bit_cast(float, (unsigned)b << 16); }
#define WS_DPP(v, ctrl, rmask, bc) __builtin_bit_cast(float, __builtin_amdgcn_update_dpp(0, __builtin_bit_cast(int, v), ctrl, rmask, 0xF, bc))
__device__ __forceinline__ float wave_sum(float v) {
    v += WS_DPP(v, 0xB1, 0xF, true); v += WS_DPP(v, 0x4E, 0xF, true); v += WS_DPP(v, 0x141, 0xF, true); v += WS_DPP(v, 0x140, 0xF, true);
    v += WS_DPP(v, 0x142, 0xA, false); v += WS_DPP(v, 0x143, 0xC, false);
    return __builtin_bit_cast(float, __builtin_amdgcn_readlane(__builtin_bit_cast(int, v), 63));
}
__device__ __forceinline__ float sigmoidf_(float x) { return __builtin_amdgcn_rcpf(1.f + __builtin_amdgcn_exp2f(-1.4426950408889634f * x)); }
__device__ __forceinline__ float gelu_tanh(float x) { const float u = x * (0.7978845608028654f + 0.035677408136300125f * x * x); return x * __builtin_amdgcn_rcpf(1.f + __builtin_amdgcn_exp2f(-2.885390081777927f * u)); }
__device__ __forceinline__ float silu_(float x) { return x * __builtin_amdgcn_rcpf(1.f + __builtin_amdgcn_exp2f(-1.4426950408889634f * x)); }
__device__ __forceinline__ float expm1_fast(float x) {
    if (x > -0.5f && x < 0.5f) { float p = 1.0f + x * (1.0f / 8.0f); p = 1.0f + x * (1.0f / 7.0f) * p; p = 1.0f + x * (1.0f / 6.0f) * p; p = 1.0f + x * 0.2f * p; p = 1.0f + x * 0.25f * p; p = 1.0f + x * (1.0f / 3.0f) * p; p = 1.0f + x * 0.5f * p; return x * p; }
    return expm1f(x);
}
#define LDS_WAIT() asm volatile("s_waitcnt lgkmcnt(0)" ::: "memory")
#define VM_WAIT() asm volatile("s_waitcnt vmcnt(0)" ::: "memory")

#define XB_TMO      128
#define XB_XCNT(j)  (256  + 64 * (j))
#define XB_XSUB(j)  (1280 + 64 * (j))
#define XB_XGEN(j)  (2304 + 64 * (j))
#define XB_TOP      3328
#define XB_TOPGEN   3392
#define XCD_BAR_WORDS 3456
#define XB_SPIN_CAP (1u << 22)
__device__ __forceinline__ unsigned xb_ld(unsigned* p)              { return __hip_atomic_load(p, __ATOMIC_RELAXED, __HIP_MEMORY_SCOPE_AGENT); }
__device__ __forceinline__ unsigned xb_add(unsigned* p, unsigned v) { return __hip_atomic_fetch_add(p, v, __ATOMIC_RELAXED, __HIP_MEMORY_SCOPE_AGENT); }
__device__ __forceinline__ unsigned xb_xcc_id() { return (unsigned)__builtin_amdgcn_s_getreg((3 << 11) | 20) & 0xFu; }
#define XB_SPIN(cond, bar) do { unsigned _sp = 0; while (cond) { __builtin_amdgcn_s_sleep(1); \
    if ((++_sp & 255u) == 0u) { if (xb_ld(&(bar)[XB_TMO])) break; if (_sp > XB_SPIN_CAP) { atomicAdd(&(bar)[XB_TMO], 1u); break; } } } } while (0)
struct XcdBarrier { unsigned* bar; unsigned x; volatile LAS unsigned* st; };
__device__ __forceinline__ XcdBarrier xcd_barrier_post(unsigned* bar, volatile LAS unsigned* st) {
    XcdBarrier b; b.bar = bar; b.x = xb_xcc_id(); b.st = st;
    if (threadIdx.x == 0) (void)xb_add(&bar[XB_XCNT(b.x)], 1u);
    return b;
}
__device__ __forceinline__ void xcd_barrier_complete(unsigned* bar, unsigned x, unsigned& nloc, unsigned& nx) {
    const unsigned G = gridDim.x * gridDim.y * gridDim.z;
    unsigned sum, cnt, mine, sp = 0u;
    for (;;) {
        sum = 0u; cnt = 0u; mine = 0u;
#pragma unroll
        for (unsigned j = 0; j < 16; ++j) { const unsigned c = xb_ld(&bar[XB_XCNT(j)]); sum += c; cnt += (c > 0u) ? 1u : 0u; mine = (j == x) ? c : mine; }
        if (sum == G) break;
        __builtin_amdgcn_s_sleep(1);
        if ((++sp & 255u) == 0u) { if (xb_ld(&bar[XB_TMO])) break; if (sp > XB_SPIN_CAP) { atomicAdd(&bar[XB_TMO], 1u); break; } }
    }
    nloc = mine > 0u ? mine : 1u; nx = cnt > 0u ? cnt : 1u;
}
__device__ __forceinline__ void xcd_barrier(const XcdBarrier& b) {
    asm volatile("s_waitcnt vmcnt(0)" ::: "memory");
    __syncthreads();
    if (threadIdx.x == 0) {
        unsigned* bar = b.bar; asm volatile("" : "+s"(bar));
        __builtin_amdgcn_s_waitcnt(0);
        unsigned nloc = b.st[0], nx = b.st[1];
        if (nloc == 0u) { xcd_barrier_complete(bar, b.x, nloc, nx); b.st[0] = nloc; b.st[1] = nx; }
        const unsigned old = xb_add(&bar[XB_XSUB(b.x)], 1u);
        const unsigned gen = old / nloc;
        if (old + 1u == (gen + 1u) * nloc) {
            __builtin_amdgcn_fence(__ATOMIC_RELEASE, "agent");
            asm volatile("s_waitcnt vmcnt(0)" ::: "memory");
            const unsigned og = xb_add(&bar[XB_TOP], 1u);
            const unsigned tg = og / nx;
            if (og + 1u == (tg + 1u) * nx) xb_add(&bar[XB_TOPGEN], 1u);
            else XB_SPIN(xb_ld(&bar[XB_TOPGEN]) == tg, bar);
            __builtin_amdgcn_fence(__ATOMIC_ACQUIRE, "agent");
            xb_add(&bar[XB_XGEN(b.x)], 1u);
            asm volatile("s_waitcnt vmcnt(0)" ::: "memory");
        } else {
            XB_SPIN(xb_ld(&bar[XB_XGEN(b.x)]) == gen, bar);
            __builtin_amdgcn_fence(__ATOMIC_ACQUIRE, "agent");
            asm volatile("s_waitcnt vmcnt(0)" ::: "memory");
        }
    }
    __syncthreads();
}

namespace pg8 {
constexpr int BM = 256, BK = 64, HALF = 128, HTB = HALF * BK * 2, STAGE_BYTES = 8 * HTB, NXCD = 8, WGM = 8;
__host__ __device__ __forceinline__ int lds_byte(int r, int c) { const int st = (r >> 4) * 2 + (c >> 5), rr = r & 15, cc = c & 31, ob = rr * 64 + cc * 2; return st * 1024 + (ob ^ (((ob >> 9) & 1) << 5)); }
__host__ __device__ __forceinline__ void stage_rc(int b, int& R, int& C) { const int st = b / 1024, sb = b % 1024, swz = sb ^ (((sb >> 9) & 1) << 5); R = (st >> 1) * 16 + swz / 64; C = (st & 1) * 32 + (swz % 64) / 2; }
__host__ __device__ __forceinline__ int perm32(int rho) { const int n = rho >> 4, i = rho & 15; return 8 * (i >> 2) + 4 * n + (i & 3); }
struct Unit { int pm, pn, e, ti, nrows, row0; };
typedef f32x4 Acc[2][2][4][2];

template <class Epi, class Sched>
__device__ __forceinline__ void gemm_phase(LAS unsigned char* lds, const int K, const Sched& S, const Epi& E) {
    int tid_ = threadIdx.x; asm volatile("" : "+v"(tid_));
    const int tid = tid_, wid = __builtin_amdgcn_readfirstlane(tid >> 6), lane = tid & 63, wr = wid >> 2, wc = wid & 3, fr = lane & 15, fq = lane >> 4;
    (void)fr; (void)fq; (void)wc;
    Unit cur, nxt; int ui = 0;
    if (!S.next(0, cur)) return;
    Acc acc;
#pragma unroll
    for (int a = 0; a < 2; ++a)
#pragma unroll
        for (int b = 0; b < 2; ++b)
#pragma unroll
            for (int m = 0; m < 4; ++m)
#pragma unroll
                for (int n = 0; n < 2; ++n) acc[a][b][m][n] = (f32x4){0.f, 0.f, 0.f, 0.f};
#if NAIVE_GEMM
    for (;;) {
        const char* Ab = S.a_base(); const char* Bb = S.b_ptr(cur);
#pragma unroll 1
        for (int ai = 0; ai < 2; ++ai)
#pragma unroll 1
            for (int m = 0; m < 4; ++m) {
                const int rr = ai * 128 + wr * 64 + m * 16 + fr;
                const bf16_t* ap = (const bf16_t*)(Ab + S.a_off(cur, rr));
#pragma unroll
                for (int bj = 0; bj < 2; ++bj)
#pragma unroll
                    for (int n = 0; n < 2; ++n)
#pragma unroll
                        for (int j = 0; j < 4; ++j) {
                            const int cc = Epi::PERM ? bj * 128 + wc * 32 + fq * 8 + n * 4 + j : bj * 128 + wc * 32 + n * 16 + fq * 4 + j;
                            const bf16_t* bp = (const bf16_t*)(Bb + (size_t)cc * K * 2);
                            float s = 0.f;
                            for (int k = 0; k < K; k += 8) {
                                const u32x4 av = *(const u32x4*)(ap + k), bv = *(const u32x4*)(bp + k);
                                s += bflo(av.x) * bflo(bv.x) + bfhi(av.x) * bfhi(bv.x) + bflo(av.y) * bflo(bv.y) + bfhi(av.y) * bfhi(bv.y)
                                   + bflo(av.z) * bflo(bv.z) + bfhi(av.z) * bfhi(bv.z) + bflo(av.w) * bflo(bv.w) + bfhi(av.w) * bfhi(bv.w);
                            }
                            acc[ai][bj][m][n][j] = s;
                        }
            }
        E(acc, cur, wr, wc, fr, fq);
        ++ui;
        if (!S.next(ui, cur)) break;
    }
    return;
#else
    const int nt = K / BK;
    unsigned voffB[2];
    { int Rr[2], Cc[2];
#pragma unroll
      for (int i = 0; i < 2; ++i) { stage_rc(tid * 16 + i * 8192, Rr[i], Cc[i]); const int Rb = Epi::PERM ? ((Rr[i] & ~31) + perm32(Rr[i] & 31)) : Rr[i]; voffB[i] = (unsigned)(Rb * K + Cc[i]) * 2u; } }
#define PG8_AOFFS(U, o00, o01, o10, o11) do { int t3_ = threadIdx.x; asm volatile("" : "+v"(t3_)); int R0_, C0_, R1_, C1_; stage_rc(t3_ * 16, R0_, C0_); stage_rc(t3_ * 16 + 8192, R1_, C1_); \
        o00 = S.a_off(U, R0_) + (unsigned)C0_ * 2u; o01 = S.a_off(U, R1_) + (unsigned)C1_ * 2u; o10 = S.a_off(U, HALF + R0_) + (unsigned)C0_ * 2u; o11 = S.a_off(U, HALF + R1_) + (unsigned)C1_ * 2u; } while (0)
    const size_t kstep = (size_t)(BK * 2);
    const size_t hstep = (size_t)HALF * K * 2;
    const unsigned ldsw = (unsigned)wid * 1024u;
    const int aoff = lds_byte(wr * 64 + fr, fq * 8), boff = lds_byte(wc * 32 + fr, fq * 8);
#define PG8_SA(b, h) (((b) * 2 + (h)) * HTB)
#define PG8_SB(b, h) ((4 + (b) * 2 + (h)) * HTB)
#define PG8_STAGE(bufoff, gbase, v0, v1) do { \
        __builtin_amdgcn_global_load_lds((const unsigned*)((const char*)(gbase) + (v0)), (LAS unsigned*)(lds + (bufoff) + ldsw), 16, 0, 0); \
        __builtin_amdgcn_global_load_lds((const unsigned*)((const char*)(gbase) + (v1)), (LAS unsigned*)(lds + (bufoff) + ldsw + 8192), 16, 0, 0); } while (0)
#define PG8_LDA(dst, b, h) do { _Pragma("unroll") for (int m = 0; m < 4; ++m) _Pragma("unroll") for (int k = 0; k < 2; ++k) dst[m][k] = *(const LAS bf16x8*)(lds + PG8_SA(b, h) + aoff + m * 2048 + k * 1024); } while (0)
#define PG8_LDB(dst, b, h) do { _Pragma("unroll") for (int n = 0; n < 2; ++n) _Pragma("unroll") for (int k = 0; k < 2; ++k) dst[n][k] = *(const LAS bf16x8*)(lds + PG8_SB(b, h) + boff + n * 2048 + k * 1024); } while (0)
#define PG8_MMA(ai, bj, At, Bt) do { __builtin_amdgcn_s_setprio(1); _Pragma("unroll") for (int m = 0; m < 4; ++m) _Pragma("unroll") for (int n = 0; n < 2; ++n) _Pragma("unroll") for (int k = 0; k < 2; ++k) \
        acc[ai][bj][m][n] = __builtin_amdgcn_mfma_f32_16x16x32_bf16(Bt[n][k], At[m][k], acc[ai][bj][m][n], 0, 0, 0); __builtin_amdgcn_s_setprio(0); } while (0)
#define PG8_WAIT_V(n) asm volatile("s_waitcnt vmcnt(" #n ")" ::: "memory")
#define PG8_WAIT_L(n) asm volatile("s_waitcnt lgkmcnt(" #n ")" ::: "memory")
#define PG8_BAR __builtin_amdgcn_s_barrier()
#define PG8_SCHED __builtin_amdgcn_sched_barrier(0)
    bf16x8 At[4][2], B0[2][2], B1[2][2];
    const char* const Ab = S.a_base();
    unsigned vA00, vA01, vA10, vA11;
    PG8_AOFFS(cur, vA00, vA01, vA10, vA11);
    const char* cB = S.b_ptr(cur);
    PG8_STAGE(PG8_SB(0, 0), cB, voffB[0], voffB[1]); PG8_STAGE(PG8_SB(0, 1), cB + hstep, voffB[0], voffB[1]); PG8_STAGE(PG8_SA(0, 0), Ab, vA00, vA01); PG8_STAGE(PG8_SA(0, 1), Ab, vA10, vA11);
    if (wr == 1) PG8_BAR;
    PG8_WAIT_V(2); PG8_BAR;
    PG8_STAGE(PG8_SB(1, 0), cB + kstep, voffB[0], voffB[1]); PG8_STAGE(PG8_SA(1, 0), Ab + kstep, vA00, vA01); PG8_STAGE(PG8_SB(1, 1), cB + hstep + kstep, voffB[0], voffB[1]);
    PG8_WAIT_V(6); PG8_BAR;
    for (;;) {
        const bool has_next = S.next(ui + 1, nxt);
        unsigned vN00 = vA00, vN01 = vA01, vN10 = vA10, vN11 = vA11; const char* nB = cB;
        if (has_next) { PG8_AOFFS(nxt, vN00, vN01, vN10, vN11); nB = S.b_ptr(nxt); }
        for (int t = 0; t < nt; t += 2) {
            const bool last = (t == nt - 2);
            const char* a1 = Ab + (size_t)(t + 1) * kstep;
            const char* a2 = last ? Ab : Ab + (size_t)(t + 2) * kstep; const char* b2 = last ? nB : cB + (size_t)(t + 2) * kstep;
            const char* a3 = a2 + kstep; const char* b3 = b2 + kstep;
            const unsigned w00 = last ? vN00 : vA00, w01 = last ? vN01 : vA01, w10 = last ? vN10 : vA10, w11 = last ? vN11 : vA11;
            PG8_LDB(B0, 0, 0); PG8_LDB(B1, 0, 1); PG8_SCHED; PG8_LDA(At, 0, 0); PG8_STAGE(PG8_SA(1, 1), a1, vA10, vA11);
            PG8_WAIT_V(8); PG8_WAIT_L(0); PG8_BAR; PG8_MMA(0, 0, At, B0); PG8_MMA(0, 1, At, B1); PG8_BAR; PG8_SCHED;
            PG8_LDA(At, 0, 1); PG8_STAGE(PG8_SB(0, 0), b2, voffB[0], voffB[1]); PG8_STAGE(PG8_SB(0, 1), b2 + hstep, voffB[0], voffB[1]); PG8_STAGE(PG8_SA(0, 0), a2, w00, w01);
            PG8_WAIT_V(8); PG8_WAIT_L(0); PG8_BAR; PG8_MMA(1, 0, At, B0); PG8_MMA(1, 1, At, B1); PG8_BAR; PG8_SCHED;
            PG8_LDB(B0, 1, 0); PG8_LDB(B1, 1, 1); PG8_SCHED; PG8_LDA(At, 1, 0); PG8_STAGE(PG8_SA(0, 1), a2, w10, w11);
            PG8_WAIT_V(8); PG8_WAIT_L(0); PG8_BAR; PG8_MMA(0, 0, At, B0); PG8_MMA(0, 1, At, B1); PG8_BAR; PG8_SCHED;
            PG8_LDA(At, 1, 1); PG8_STAGE(PG8_SB(1, 0), b3, voffB[0], voffB[1]); PG8_STAGE(PG8_SB(1, 1), b3 + hstep, voffB[0], voffB[1]); PG8_STAGE(PG8_SA(1, 0), a3, w00, w01);
            PG8_WAIT_V(8); PG8_WAIT_L(0); PG8_BAR; PG8_MMA(1, 0, At, B0); PG8_MMA(1, 1, At, B1); PG8_BAR; PG8_SCHED;
        }
        if (wr == 0) PG8_BAR;
        { int t2_ = threadIdx.x; asm volatile("" : "+v"(t2_)); const int l2_ = t2_ & 63; E(acc, cur, wr, wc, l2_ & 15, l2_ >> 4); }
        if (!has_next) break;
#pragma unroll
        for (int a = 0; a < 2; ++a)
#pragma unroll
            for (int b = 0; b < 2; ++b)
#pragma unroll
                for (int m = 0; m < 4; ++m)
#pragma unroll
                    for (int n = 0; n < 2; ++n) acc[a][b][m][n] = (f32x4){0.f, 0.f, 0.f, 0.f};
        cur = nxt; vA00 = vN00; vA01 = vN01; vA10 = vN10; vA11 = vN11; cB = nB; ++ui;
        if (wr == 1) PG8_BAR;
    }
    PG8_WAIT_V(0);
    PG8_BAR;
#undef PG8_SA
#undef PG8_AOFFS
#undef PG8_SB
#undef PG8_STAGE
#undef PG8_LDA
#undef PG8_LDB
#undef PG8_MMA
#undef PG8_WAIT_V
#undef PG8_WAIT_L
#undef PG8_BAR
#undef PG8_SCHED
#endif
}
}
using pg8::Unit;
using pg8::Acc;

__device__ __forceinline__ float* resid_row(float* out, float* xc, int tok) {
    const int b = tok / TPB, j = tok - b * TPB;
    return j < CTX ? xc + ((size_t)(b * CTX + j)) * DM : out + ((size_t)(b * SEQ + j - CTX)) * DM;
}
__device__ __forceinline__ int tile_to_pm(int i, bool latent_only) { return latent_only ? (i >> 4) * 17 + 1 + (i & 15) : i; }

__device__ __forceinline__ bool static_order(int i, int G, int c, int nM, int nN, int& pm, int& pn) {
    const int nwg = nM * nN; const long L = (long)i * G + c; if (L >= nwg) return false;
    int wgid = (int)L; { const int q = nwg / 8, r = nwg % 8, xcd = wgid % 8, off = wgid / 8; wgid = (xcd < r ? xcd * (q + 1) : r * (q + 1) + (xcd - r) * q) + off; }
    const int nig = 8 * nN, gid = wgid / nig, fm = gid * 8, gsz = (nM - fm) < 8 ? (nM - fm) : 8;
    pm = fm + ((wgid % nig) % gsz); pn = (wgid % nig) / gsz; return true;
}

struct SchedPlain {
    const char* A; const char* Bt; int K, nM, nN, G, c; bool lat;
    __device__ __forceinline__ bool next(int i, Unit& u) const {
        int pm, pn; if (!static_order(i, G, c, nM, nN, pm, pn)) return false;
        u.pm = tile_to_pm(pm, lat); u.pn = pn; u.e = 0; u.ti = 0; u.nrows = 256; u.row0 = u.pm * 256; return true;
    }
    __device__ __forceinline__ const char* a_base() const { return A; }
    __device__ __forceinline__ unsigned a_off(const Unit& u, int rr) const { return (unsigned)(u.row0 + rr) * (unsigned)(K * 2); }
    __device__ __forceinline__ const char* b_ptr(const Unit& u) const { return Bt + (size_t)u.pn * 256 * K * 2; }
};

struct SchedMerge {
    const char* A0; const char* Bt0; int G, c;
    __device__ __forceinline__ bool next(int i, Unit& u) const {
        const int ti = i / 3, r = i - 3 * ti; int pm, pn; if (!static_order(ti, G, c, 64, 4, pm, pn)) return false;
        u.pm = tile_to_pm(pm, true); u.pn = pn; u.e = r; u.ti = 0; u.nrows = 256; u.row0 = u.pm * 256; return true;
    }
    __device__ __forceinline__ const char* a_base() const { return A0; }
    __device__ __forceinline__ unsigned a_off(const Unit& u, int rr) const { return (unsigned)u.e * (unsigned)(17 * MiB) + (unsigned)(u.row0 + rr) * 1024u; }
    __device__ __forceinline__ const char* b_ptr(const Unit& u) const { return Bt0 + ((size_t)u.e * 1024 * 512 + (size_t)u.pn * 256 * 512) * 2; }
};

struct SchedMoe {
    const char* A;
    const char* Ash;
    const char* Bt; const char* Btsh; const int* list;
    const LAS int* tb;
    int K, nN, G, c, nsh; bool lat, gather; size_t bstride;
    __device__ __forceinline__ bool next(int i, Unit& u) const {
        const int nrt = tb[LC_TBASE + 64], L = i * G + c, tot = (nrt + nsh) * nN;
        if (L >= tot) return false;
        const int rt = L / nN; u.pn = L - rt * nN;
        if (rt < nrt) {
            int e = 0;
#pragma unroll 1
            for (int s = 32; s > 0; s >>= 1) if (e + s < 64 && tb[LC_TBASE + e + s] <= rt) e += s;
            u.e = e; u.ti = rt - tb[LC_TBASE + e]; const int cnt = tb[LC_TCNT + e]; const int rem = cnt - u.ti * 256;
            u.nrows = rem < 256 ? rem : 256; u.row0 = tb[LC_SBASE + e] + u.ti * 256; u.pm = 0;
        } else { u.e = 64; u.ti = rt - nrt; u.pm = tile_to_pm(u.ti, lat); u.nrows = 256; u.row0 = u.pm * 256; }
        return true;
    }
    __device__ __forceinline__ const char* a_base() const { return A; }
    __device__ __forceinline__ unsigned a_off(const Unit& u, int rr) const {
        if (u.e == 64) return (unsigned)(Ash - A) + (unsigned)(u.row0 + rr) * (unsigned)(K * 2);
        if (gather) { const int r2 = rr < u.nrows ? rr : u.nrows - 1; const int tok = list[(size_t)u.e * T + u.ti * 256 + r2]; return (unsigned)tok * (unsigned)(K * 2); }
        return (unsigned)(u.row0 + rr) * (unsigned)(K * 2);
    }
    __device__ __forceinline__ const char* b_ptr(const Unit& u) const { return (u.e == 64 ? Btsh : Bt + (size_t)u.e * bstride) + (size_t)u.pn * 256 * K * 2; }
};

#define EPI_FOR_ROWS  _Pragma("unroll") for (int ai = 0; ai < 2; ++ai) _Pragma("unroll") for (int m = 0; m < 4; ++m)
#define EPI_FOR_COLS  _Pragma("unroll") for (int bj = 0; bj < 2; ++bj) _Pragma("unroll") for (int n = 0; n < 2; ++n)

struct EpiInproj {
    static constexpr bool PERM = false;
    unsigned char* ws; const float* bias; const float* rope;
    __device__ __forceinline__ void operator()(const Acc& acc, const Unit& u, int wr, int wc, int fr, int fq) const {
        const int pn = u.pn; const bool isg = pn >= 14; const int seg = pn >> 1;
        bf16_t* base = (bf16_t*)(ws + (isg ? OV_G : OV_Q + (size_t)seg * 17 * MiB));
        const int ld = isg ? 3072 : 512, coff = isg ? (pn - 14) * 256 : (pn & 1) * 256;
        const bool latent = (u.pm % 17) != 0;
        f32x4 bv[2][2];
        EPI_FOR_COLS bv[bj][n] = *(const f32x4*)(bias + pn * 256 + bj * 128 + wc * 32 + n * 16 + fq * 4);
        EPI_FOR_ROWS {
            const int row = u.row0 + ai * 128 + wr * 64 + m * 16 + fr;
            bf16_t* rp = base + (size_t)row * ld + coff + wc * 32 + fq * 4;
            f32x4 v[2][2];
            EPI_FOR_COLS v[bj][n] = acc[ai][bj][m][n] + bv[bj][n];
            if (seg < 2 && !isg) {
                if (latent) {
                    const int pos = (row % TPB) - CTX; const int pa = (wc & 1) ? (pos & 63) : (pos >> 6);
                    const f32x4 c0 = *(const f32x4*)(rope + (pa * 16 + fq * 4) * 2), c1 = *(const f32x4*)(rope + (pa * 16 + fq * 4) * 2 + 4);
                    const float cs[4] = {c0[0], c0[2], c1[0], c1[2]}, sn[4] = {c0[1], c0[3], c1[1], c1[3]};
#pragma unroll
                    for (int bj = 0; bj < 2; ++bj)
#pragma unroll
                        for (int j = 0; j < 4; ++j) { const float a = v[bj][0][j], b = v[bj][1][j]; v[bj][0][j] = a * cs[j] - b * sn[j]; v[bj][1][j] = b * cs[j] + a * sn[j]; }
                }
            } else if (isg) {
                EPI_FOR_COLS {
#pragma unroll
                    for (int j = 0; j < 4; ++j) v[bj][n][j] = sigmoidf_(v[bj][n][j]); }
            } else if (seg == 3 || seg == 4 || seg == 6) {
                EPI_FOR_COLS {
#pragma unroll
                    for (int j = 0; j < 4; ++j) v[bj][n][j] = gelu_tanh(v[bj][n][j]); }
            }
            EPI_FOR_COLS { u32x2 w; w.x = pk2(v[bj][n][0], v[bj][n][1]); w.y = pk2(v[bj][n][2], v[bj][n][3]); *(u32x2*)(rp + bj * 128 + n * 16) = w; }
        }
    }
};

struct EpiMerge {
    static constexpr bool PERM = true;
    bf16_t* mg; const bf16_t* gate;
    __device__ __forceinline__ void operator()(const Acc& acc, const Unit& u, int wr, int wc, int fr, int fq) const {
        const int r = u.e;
#pragma unroll
        for (int ai = 0; ai < 2; ++ai) {
            const size_t rbase = (size_t)(u.row0 + ai * 128 + wr * 64 + fr); const int col = u.pn * 256 + wc * 32 + fq * 8;
            u32x4 g[4][2], o[4][2];
#pragma unroll
            for (int m = 0; m < 4; ++m)
#pragma unroll
                for (int bj = 0; bj < 2; ++bj) { g[m][bj] = *(const u32x4*)(gate + (rbase + m * 16) * 3072 + r * 1024 + col + bj * 128);
                    if (r > 0) o[m][bj] = *(const u32x4*)(mg + (rbase + m * 16) * DM + col + bj * 128); else o[m][bj] = (u32x4){0u, 0u, 0u, 0u}; }
#pragma unroll
            for (int m = 0; m < 4; ++m)
#pragma unroll
                for (int bj = 0; bj < 2; ++bj) { const u32x4 gg = g[m][bj], oo = o[m][bj]; const f32x4 v0 = acc[ai][bj][m][0], v1 = acc[ai][bj][m][1];
                    u32x4 w; w.x = pk2(v0[0] * bflo(gg.x) + bflo(oo.x), v0[1] * bfhi(gg.x) + bfhi(oo.x)); w.y = pk2(v0[2] * bflo(gg.y) + bflo(oo.y), v0[3] * bfhi(gg.y) + bfhi(oo.y));
                    w.z = pk2(v1[0] * bflo(gg.z) + bflo(oo.z), v1[1] * bfhi(gg.z) + bfhi(oo.z)); w.w = pk2(v1[2] * bflo(gg.w) + bflo(oo.w), v1[3] * bfhi(gg.w) + bfhi(oo.w));
                    *(u32x4*)(mg + (rbase + m * 16) * DM + col + bj * 128) = w; }
        }
    }
};

struct EpiWout {
    static constexpr bool PERM = true;
    float* out; float* xc; const float* modl; bool dry;
    __device__ __forceinline__ void operator()(const Acc& acc, const Unit& u, int wr, int wc, int fr, int fq) const {
        const int b = u.pm / 17; const int bsel = (u.pm % 17) == 0 ? 4 : b;
        const float* g1 = modl + bsel * 6144 + 2048;
        f32x4 gv[2][2];
        EPI_FOR_COLS gv[bj][n] = *(const f32x4*)(g1 + u.pn * 256 + bj * 128 + wc * 32 + fq * 8 + n * 4);
#pragma unroll
        for (int ai = 0; ai < 2; ++ai)
#pragma unroll
            for (int mp = 0; mp < 4; mp += 2) {
                float* rp[2]; f32x4 x[2][2][2];
#pragma unroll
                for (int q = 0; q < 2; ++q) { rp[q] = resid_row(out, xc, u.row0 + ai * 128 + wr * 64 + (mp + q) * 16 + fr) + u.pn * 256 + wc * 32 + fq * 8;
                    EPI_FOR_COLS x[q][bj][n] = *(const f32x4*)(rp[q] + bj * 128 + n * 4); }
#pragma unroll
                for (int q = 0; q < 2; ++q)
                    EPI_FOR_COLS { const f32x4 y = x[q][bj][n] * DN_ALPHA + gv[bj][n] * acc[ai][bj][mp + q][n]; if (!dry) *(f32x4*)(rp[q] + bj * 128 + n * 4) = y; else asm volatile("" :: "v"(y)); }
            }
    }
};

struct EpiMoe1 {
    static constexpr bool PERM = true;
    bf16_t* act; bf16_t* actsh;
    __device__ __forceinline__ void operator()(const Acc& acc, const Unit& u, int wr, int wc, int fr, int fq) const {
        bf16_t* base = u.e == 64 ? actsh : act;
        EPI_FOR_ROWS {
            const int rl = ai * 128 + wr * 64 + m * 16 + fr;
            if (rl < u.nrows) {
                const f32x4 g0 = acc[ai][0][m][0], g1 = acc[ai][0][m][1], p0 = acc[ai][1][m][0], p1 = acc[ai][1][m][1];
                u32x4 w; w.x = pk2(silu_(g0[0]) * p0[0], silu_(g0[1]) * p0[1]); w.y = pk2(silu_(g0[2]) * p0[2], silu_(g0[3]) * p0[3]);
                w.z = pk2(silu_(g1[0]) * p1[0], silu_(g1[1]) * p1[1]); w.w = pk2(silu_(g1[2]) * p1[2], silu_(g1[3]) * p1[3]);
                *(u32x4*)(base + (size_t)(u.row0 + rl) * 256 + u.pn * 128 + wc * 32 + fq * 8) = w;
            }
        }
    }
};

struct EpiMoe2 {
    static constexpr bool PERM = true;
    unsigned char* ys; bf16_t* sho;
    __device__ __forceinline__ void operator()(const Acc& acc, const Unit& u, int wr, int wc, int fr, int fq) const {
        EPI_FOR_ROWS {
            const int rl = ai * 128 + wr * 64 + m * 16 + fr;
            if (rl < u.nrows) {
                if (u.e == 64) {
                    bf16_t* rp = sho + (size_t)(u.row0 + rl) * DM + u.pn * 256 + wc * 32 + fq * 8;
#pragma unroll
                    for (int bj = 0; bj < 2; ++bj) { const f32x4 v0 = acc[ai][bj][m][0], v1 = acc[ai][bj][m][1];
                        u32x4 w; w.x = pk2(v0[0], v0[1]); w.y = pk2(v0[2], v0[3]); w.z = pk2(v1[0], v1[1]); w.w = pk2(v1[2], v1[3]); *(u32x4*)(rp + bj * 128) = w; }
                } else {
                    unsigned char* rp = ys + (size_t)(u.row0 + rl) * DM + u.pn * 256 + wc * 32 + fq * 8;
#pragma unroll
                    for (int bj = 0; bj < 2; ++bj) { const f32x4 v0 = acc[ai][bj][m][0] * 16.0f, v1 = acc[ai][bj][m][1] * 16.0f;
                        int w0 = 0, w1 = 0;
                        w0 = __builtin_amdgcn_cvt_pk_fp8_f32(v0[0], v0[1], w0, false); w0 = __builtin_amdgcn_cvt_pk_fp8_f32(v0[2], v0[3], w0, true);
                        w1 = __builtin_amdgcn_cvt_pk_fp8_f32(v1[0], v1[1], w1, false); w1 = __builtin_amdgcn_cvt_pk_fp8_f32(v1[2], v1[3], w1, true);
                        *(u32x2*)(rp + bj * 128) = (u32x2){(unsigned)w0, (unsigned)w1}; }
                }
            }
        }
    }
};

struct Frame {
    LAS unsigned char* lds; int tid, lane, wave, G, bid, gw, NGW, vcu;
    unsigned char* ws; float* out;
};

__device__ __forceinline__ void transpose_item(const float* W, int ldw, int k0, int n0, bf16_t* WT, int ldt, int drow0, LAS float* scr, int lane) {
    const int lk = lane >> 4, n4 = (lane & 15) * 4;
#pragma unroll 8
    for (int i = 0; i < 16; ++i) { const int k = 4 * i + lk; const f32x4 v = *(const f32x4*)(W + (size_t)(k0 + k) * ldw + n0 + n4);
        *(LAS f32x4*)(scr + k * 64 + (n4 ^ (((k >> 3) & 7) << 2))) = v; }
    LDS_WAIT(); asm volatile("" ::: "memory");
    const int c = lane & 7;
#pragma unroll
    for (int j = 0; j < 8; ++j) { const int n = (lane >> 3) + 8 * j; const LAS float* sp = scr + (8 * c) * 64 + (n ^ (c << 2));
        u32x4 o; o.x = pk2(sp[0 * 64], sp[1 * 64]); o.y = pk2(sp[2 * 64], sp[3 * 64]); o.z = pk2(sp[4 * 64], sp[5 * 64]); o.w = pk2(sp[6 * 64], sp[7 * 64]);
        *(u32x4*)(WT + (size_t)(drow0 + n) * ldt + k0 + 8 * c) = o; }
    LDS_WAIT(); asm volatile("" ::: "memory");
}
__device__ __forceinline__ void conv_expert_item(const float* wg, const float* wu, const float* wd, bf16_t* t1, bf16_t* t2, int which, int rr, LAS float* scr, int lane) {
    if (which < 2) { const int kb = rr >> 2, nb = rr & 3, n0 = 64 * nb;
        transpose_item(which == 0 ? wg : wu, 256, 64 * kb, n0, t1, 1024, (n0 >> 7) * 256 + (n0 & 127) + which * 128, scr, lane);
    } else { const int kb = rr >> 4, nb = rr & 15; transpose_item(wd, 1024, 64 * kb, 64 * nb, t2, 256, 64 * nb, scr, lane); }
}
__device__ __forceinline__ void conv_moe_layer(const Frame& F, CArgsP a, int l) {
    LAS float* scr = (LAS float*)(F.lds + F.wave * 16384);
    for (int it = F.gw; it < 64 * 3 * 64; it += F.NGW) {
        const int idx = it >> 6, e = idx / 3, which = idx - e * 3, rr = it & 63; const size_t eo = (size_t)(l * 64 + e) * 262144;
        conv_expert_item(a->in[30] + eo, a->in[31] + eo, a->in[32] + eo, (bf16_t*)(F.ws + WS_WM1) + (size_t)e * 524288, (bf16_t*)(F.ws + WS_WM2) + (size_t)e * 262144, which, rr, scr, F.lane);
    }
}

__device__ __forceinline__ void phase_prologue(const Frame& F, CArgsP a) {
    LAS float* scr = (LAS float*)(F.lds + F.wave * 16384);
    constexpr int I_IN = 2 * 1664, I_BR = 6 * 128, I_OUT = 2 * 256, I_SH = 6 * 64;
    for (int it0 = F.gw; it0 < I_IN + I_BR + I_OUT + I_SH; it0 += F.NGW) {
        int it = it0;
        if (it < I_IN) { const int l = it / 1664, r = it - l * 1664, kb = r / 104, nb = r - kb * 104;
            transpose_item(a->in[6] + (size_t)l * 1024 * INC, INC, 64 * kb, 64 * nb, (bf16_t*)(F.ws + WS_WIN) + (size_t)l * INC * 1024, 1024, 64 * nb, scr, F.lane); continue; }
        it -= I_IN;
        if (it < I_BR) { const int idx = it >> 7, rr = it & 127, kb = rr >> 4, nb = rr & 15;
            transpose_item(a->in[24] + (size_t)idx * 512 * 1024, 1024, 64 * kb, 64 * nb, (bf16_t*)(F.ws + WS_WBR) + (size_t)idx * 1024 * 512, 512, 64 * nb, scr, F.lane); continue; }
        it -= I_BR;
        if (it < I_OUT) { const int l = it >> 8, rr = it & 255, kb = rr >> 4, nb = rr & 15;
            transpose_item(a->in[25] + (size_t)l * 1048576, 1024, 64 * kb, 64 * nb, (bf16_t*)(F.ws + WS_WOUT) + (size_t)l * 1048576, 1024, 64 * nb, scr, F.lane); continue; }
        it -= I_OUT;
        { const int idx = it >> 6, l = idx / 3, which = idx - l * 3, rr = it & 63; const size_t lo = (size_t)l * 262144;
          conv_expert_item(a->in[33] + lo, a->in[34] + lo, a->in[35] + lo, (bf16_t*)(F.ws + WS_WSH1) + (size_t)l * 524288, (bf16_t*)(F.ws + WS_WSH2) + (size_t)l * 262144, which, rr, scr, F.lane); }
    }
    conv_moe_layer(F, a, 0);
    { const int gt = F.bid * NTHR + F.tid, NG = F.G * NTHR;
      bf16_t* wl = (bf16_t*)(F.ws + WS_WLRU);
      for (int i = gt; i < 2 * 2 * 2 * 8 * 4096; i += NG) {
          const int ii = i & 63, j = (i >> 6) & 63, cb = (i >> 12) & 7, ax = (i >> 15) & 1, d = (i >> 16) & 1, l = i >> 17;
          const float* src = ax == 0 ? a->in[19] : a->in[21];
          wl[i] = (bf16_t)f2bf(src[(size_t)((l * 2 + d) * 8 + cb) * 4096 + ii * 64 + j]); }
      bf16_t* wrt = (bf16_t*)(F.ws + WS_WRT);
      for (int i = gt; i < 2 * 64 * 1024; i += NG) { const int k = i & 1023, e = (i >> 10) & 63, l = i >> 16; wrt[i] = (bf16_t)f2bf(a->in[28][(size_t)(l * 1024 + k) * 64 + e]); }
      bf16_t* wsg = (bf16_t*)(F.ws + WS_WSG);
      for (int i = gt; i < 2 * 4 * 128 * 128; i += NG) wsg[i] = (bf16_t)f2bf(a->in[15][i]);
      if (F.bid == 0) { float* rope = (float*)(F.ws + WS_ROPE);
          for (int t = F.tid; t < 1024; t += NTHR) { const int p = t >> 4, f = t & 15; const float inv = powf(10000.0f, -(float)f / 16.0f); const float ang = (float)p * inv; rope[2 * t] = cosf(ang); rope[2 * t + 1] = sinf(ang); } }
      if (F.bid == (1 % F.G) && F.wave == 0) { float* lam = (float*)(F.ws + WS_LAM);
#pragma unroll
          for (int l = 0; l < 2; ++l) { const float s1 = wave_sum(a->in[8][l * 64 + F.lane] * a->in[9][l * 64 + F.lane]), s2 = wave_sum(a->in[10][l * 64 + F.lane] * a->in[11][l * 64 + F.lane]);
              const float li = 0.8f - 0.6f * expf(-0.3f * (float)l); if (F.lane == 0) lam[l] = expf(s1) - expf(s2) + li; } }
    }
    __syncthreads();
    LAS float* sl = (LAS float*)(F.lds);
    for (int i = F.tid; i < 5 * 1024; i += NTHR) { const int b = i >> 10, k = i & 1023; const float cv = b < 4 ? a->in[1][b * 1024 + k] : a->in[3][k]; sl[i] = silu_(cv); }
    __syncthreads();
    float* mod = (float*)(F.ws + WS_MOD);
    LAS float* part = (LAS float*)(F.lds + 20480);
    for (int c = F.bid; c < 192; c += F.G) {
        const int l = c / 96, cg = c - l * 96, col = F.tid & 63, ks = F.wave, n = cg * 64 + col;
        const float* w = a->in[4] + ((size_t)l * 1024 + ks * 128) * 6144 + n;
        float acc[5] = {0.f, 0.f, 0.f, 0.f, 0.f};
#pragma unroll 8
        for (int k = 0; k < 128; ++k) { const float wv = w[(size_t)k * 6144];
#pragma unroll
            for (int b = 0; b < 5; ++b) acc[b] += sl[b * 1024 + ks * 128 + k] * wv; }
#pragma unroll
        for (int b = 0; b < 5; ++b) part[(ks * 5 + b) * 64 + col] = acc[b];
        __syncthreads();
        if (F.tid < 320) { const int b = F.tid >> 6; float s = a->in[5][l * 6144 + n];
#pragma unroll
            for (int k8 = 0; k8 < 8; ++k8) s += part[(k8 * 5 + b) * 64 + col];
            mod[(l * 5 + b) * 6144 + n] = s; }
        __syncthreads();
    }
}

__device__ __forceinline__ void row_load(const float* p, int lane, f32x4 (&v)[4]) {
#pragma unroll
    for (int j = 0; j < 4; ++j) v[j] = *(const f32x4*)(p + 4 * lane + 256 * j);
}
__device__ __forceinline__ void row_store(float* p, int lane, const f32x4 (&v)[4]) {
#pragma unroll
    for (int j = 0; j < 4; ++j) *(f32x4*)(p + 4 * lane + 256 * j) = v[j];
}
__device__ __forceinline__ void row_ln(f32x4 (&v)[4]) {
    float s = 0.f;
#pragma unroll
    for (int j = 0; j < 4; ++j) s += (v[j][0] + v[j][1]) + (v[j][2] + v[j][3]);
    const float mean = wave_sum(s) * (1.f / DM); float q = 0.f;
#pragma unroll
    for (int j = 0; j < 4; ++j) { v[j] = v[j] - mean; q += (v[j][0] * v[j][0] + v[j][1] * v[j][1]) + (v[j][2] * v[j][2] + v[j][3] * v[j][3]); }
    const float rstd = 1.f / sqrtf(wave_sum(q) * (1.f / DM) + LN_EPS);
#pragma unroll
    for (int j = 0; j < 4; ++j) v[j] = v[j] * rstd;
}
__device__ __forceinline__ void row_affine(f32x4 (&v)[4], const float* scale1p  , bool plus1, const float* shift, int lane) {
#pragma unroll
    for (int j = 0; j < 4; ++j) { const f32x4 sc = *(const f32x4*)(scale1p + 4 * lane + 256 * j), sh = *(const f32x4*)(shift + 4 * lane + 256 * j);
        v[j] = plus1 ? v[j] * (sc + 1.0f) + sh : v[j] * sc + sh; }
}
__device__ __forceinline__ void row_store_bf16(bf16_t* p, int lane, const f32x4 (&v)[4]) {
#pragma unroll
    for (int j = 0; j < 4; ++j) { u32x2 w; w.x = pk2(v[j][0], v[j][1]); w.y = pk2(v[j][2], v[j][3]); *(u32x2*)(p + 4 * lane + 256 * j) = w; }
}

__device__ __forceinline__ void phase_rows0(const Frame& F, CArgsP a) {
    const float* mod = (const float*)(F.ws + WS_MOD); float* xc = (float*)(F.ws + WS_XC); bf16_t* H = (bf16_t*)(F.ws + WS_H);
    for (int tok = F.gw; tok < T; tok += F.NGW) {
        const int b = tok / TPB, j = tok - b * TPB; const bool isc = j < CTX;
        const float* src = isc ? a->in[2] + (size_t)(b * CTX + j) * DM : a->in[0] + (size_t)(b * SEQ + j - CTX) * DM;
        f32x4 v[4]; row_load(src, F.lane, v);
        row_store(resid_row(F.out, xc, tok), F.lane, v);
        row_ln(v);
        const float* mrow = mod + (isc ? 4 : b) * 6144;
        row_affine(v, mrow + 1024, true, mrow, F.lane);
        row_store_bf16(H + (size_t)tok * DM, F.lane, v);
    }
}

__device__ __forceinline__ void sg_item(const Frame& F, CArgsP a, int l, int chunk, int g) {
    LAS bf16_t* vgT = (LAS bf16_t*)F.lds;
    const bf16_t* Sb = (const bf16_t*)(F.ws + OV_S); const bf16_t* Ub = (const bf16_t*)(F.ws + OV_U); bf16_t* OB = (bf16_t*)(F.ws + OV_OB);
    const int tok0 = chunk * 128;
    { const int q = F.tid >> 2, qt = F.tid & 3;
      const bf16_t* sp = Sb + (size_t)(tok0 + q) * 512 + g * 128 + qt * 32;
      float x[32];
#pragma unroll
      for (int i = 0; i < 4; ++i) { const u32x4 w = *(const u32x4*)(sp + 8 * i);
          x[8 * i + 0] = bflo(w.x); x[8 * i + 1] = bfhi(w.x); x[8 * i + 2] = bflo(w.y); x[8 * i + 3] = bfhi(w.y); x[8 * i + 4] = bflo(w.z); x[8 * i + 5] = bfhi(w.z); x[8 * i + 6] = bflo(w.w); x[8 * i + 7] = bfhi(w.w); }
      float s = 0.f;
#pragma unroll
      for (int i = 0; i < 32; ++i) s += x[i];
      s += __shfl_xor(s, 1); s += __shfl_xor(s, 2); const float mean = s * (1.f / 128.f); float qq = 0.f;
#pragma unroll
      for (int i = 0; i < 32; ++i) { x[i] -= mean; qq += x[i] * x[i]; }
      qq += __shfl_xor(qq, 1); qq += __shfl_xor(qq, 2); const float rstd = 1.f / sqrtf(qq * (1.f / 128.f) + LN_EPS);
      const float* lg = a->in[13] + l * 512 + g * 128 + qt * 32; const float* lb = a->in[14] + l * 512 + g * 128 + qt * 32;
#pragma unroll
      for (int i = 0; i < 32; ++i) vgT[(qt * 32 + i) * 136 + q] = (bf16_t)f2bf(x[i] * rstd * lg[i] + lb[i]);
    }
    __syncthreads();
    const int w = F.wave, fr = F.lane & 15, fq = F.lane >> 4;
    bf16x8 af[4];
#pragma unroll
    for (int ks = 0; ks < 4; ++ks) af[ks] = *(const LAS bf16x8*)(vgT + (w * 16 + fr) * 136 + ks * 32 + fq * 8);
    const bf16_t* W = (const bf16_t*)(F.ws + WS_WSG) + (size_t)(l * 4 + g) * 16384;
    const float* bs = a->in[16] + (l * 4 + g) * 128;
#pragma unroll 2
    for (int n = 0; n < 8; ++n) {
        f32x4 d = {0.f, 0.f, 0.f, 0.f};
#pragma unroll
        for (int ks = 0; ks < 4; ++ks) { const bf16x8 bfv = *(const bf16x8*)(W + (n * 16 + fr) * 128 + ks * 32 + fq * 8); d = __builtin_amdgcn_mfma_f32_16x16x32_bf16(af[ks], bfv, d, 0, 0, 0); }
        const int p = n * 16 + fr, c0 = w * 16 + fq * 4; const float bsp = bs[p];
        const size_t off = (size_t)(tok0 + p) * 512 + g * 128 + c0;
        const u32x2 uu = *(const u32x2*)(Ub + off);
        u32x2 o; o.x = pk2(bflo(uu.x) * (d[0] + bsp), bfhi(uu.x) * (d[1] + bsp)); o.y = pk2(bflo(uu.y) * (d[2] + bsp), bfhi(uu.y) * (d[3] + bsp));
        *(u32x2*)(OB + off) = o;
    }
    __syncthreads();
}

template <bool REV>
__device__ __forceinline__ void lru_scan(const f32x4 (&av)[4], const f32x4 (&bv)[4], f32x4 (&hv)[4], int lane, int mode, float hin, float& sumA, float& sumH) {
#define LRU_MI(k) (REV ? 3 - (k) : (k))
    const int fr = lane & 15, fq = lane >> 4, q = REV ? 3 - fq : fq;
    const int s1 = REV ? lane + 16 : lane - 16, s2 = REV ? lane + 32 : lane - 32, st = REV ? fr : 48 + fr;
    float Ea[4], Eh[4], Ta[4], Th[4];
#pragma unroll
    for (int m = 0; m < 4; ++m) {
        float A = 1.f, H = 0.f;
#pragma unroll
        for (int rk = 0; rk < 4; ++rk) { const int r = LRU_MI(rk); H = av[m][r] * H + bv[m][r]; A *= av[m][r]; }
        float pa = __shfl(A, s1), ph = __shfl(H, s1); if (q >= 1) { H = A * ph + H; A *= pa; }
        pa = __shfl(A, s2); ph = __shfl(H, s2); if (q >= 2) { H = A * ph + H; A *= pa; }
        float ea = __shfl(A, s1), eh = __shfl(H, s1); if (q == 0) { ea = 1.f; eh = 0.f; }
        Ea[m] = ea; Eh[m] = eh; Ta[m] = __shfl(A, st); Th[m] = __shfl(H, st);
    }
    if (mode == 0) {
        float A = 1.f, H = 0.f;
#pragma unroll
        for (int mk = 0; mk < 4; ++mk) { const int m = LRU_MI(mk); H = Ta[m] * H + Th[m]; A *= Ta[m]; }
        sumA = A; sumH = H;
    } else {
        float S = hin;
#pragma unroll
        for (int mk = 0; mk < 4; ++mk) { const int m = LRU_MI(mk); float h = Ea[m] * S + Eh[m];
#pragma unroll
            for (int rk = 0; rk < 4; ++rk) { const int r = LRU_MI(rk); h = av[m][r] * h + bv[m][r]; hv[m][r] = h; }
            S = Ta[m] * S + Th[m]; }
    }
#undef LRU_MI
}
struct LruConst { f32x4 cw[4][2]; f32x4 cbias[2]; bf16x8 wa0, wa1, wx0, wx1; float ba, bx, sp; };
struct LruIn { u32x4 x[4]; u32x4 y; float hin; };
__device__ __forceinline__ void lru_load_const(const Frame& F, CArgsP a, int l, int cb, LruConst& c) {
    const int lane = F.lane, fr = lane & 15, fq = lane >> 4, d = F.wave >> 2, nt = F.wave & 3, ch0 = cb * 64, c8 = (F.tid & 7) * 8;
    const bf16_t* Wa = (const bf16_t*)(F.ws + WS_WLRU) + (size_t)((l * 4 + d * 2) * 8 + cb) * 4096 + (nt * 16 + fr) * 64 + fq * 8;
    c.wa0 = *(const bf16x8*)(Wa); c.wa1 = *(const bf16x8*)(Wa + 32); c.wx0 = *(const bf16x8*)(Wa + 8 * 4096); c.wx1 = *(const bf16x8*)(Wa + 8 * 4096 + 32);
    const int pidx = (l * 2 + d) * 512 + ch0 + nt * 16 + fr;
    c.ba = a->in[20][pidx]; c.bx = a->in[22][pidx]; c.sp = log1pf(expf(-a->in[23][pidx]));
#pragma unroll
    for (int jj = 0; jj < 4; ++jj) { c.cw[jj][0] = *(const f32x4*)(a->in[17] + l * 2048 + jj * 512 + ch0 + c8); c.cw[jj][1] = *(const f32x4*)(a->in[17] + l * 2048 + jj * 512 + ch0 + c8 + 4); }
    c.cbias[0] = *(const f32x4*)(a->in[18] + l * 512 + ch0 + c8); c.cbias[1] = *(const f32x4*)(a->in[18] + l * 512 + ch0 + c8 + 4);
}
__device__ __forceinline__ void lru_load_in(const Frame& F, int b, int chunk, int cb, int mode, LruIn& in) {
    const bf16_t* Xb = (const bf16_t*)(F.ws + OV_X); const bf16_t* Yb = (const bf16_t*)(F.ws + OV_Y);
    const int ch0 = cb * 64, ct = F.tid >> 3, c8 = (F.tid & 7) * 8, d = F.wave >> 2, ch = (F.wave & 3) * 16 + (F.lane & 15);
    const int seg_lo = chunk < 4 ? 0 : 256, seg_hi = chunk < 4 ? 256 : TPB, j0 = chunk * 64;
#pragma unroll
    for (int jj = 0; jj < 4; ++jj) { const int j = j0 + ct + jj - 2; in.x[jj] = (u32x4){0u, 0u, 0u, 0u}; if (j >= seg_lo && j < seg_hi) in.x[jj] = *(const u32x4*)(Xb + (size_t)(b * TPB + j) * 512 + ch0 + c8); }
    in.y = (u32x4){0u, 0u, 0u, 0u}; in.hin = 0.f;
    if (mode == 1) { in.y = *(const u32x4*)(Yb + (size_t)(b * TPB + j0 + ct) * 512 + ch0 + c8); in.hin = ((const float*)(F.ws + WS_HIN))[(size_t)((b * 2 + d) * 68 + chunk) * 512 + ch0 + ch]; }
}
__device__ __forceinline__ void lru_compute(const Frame& F, const LruConst& c, const LruIn& in, int b, int chunk, int cb, int mode) {
    LAS float* xs = (LAS float*)F.lds;
    LAS bf16_t* xsb = (LAS bf16_t*)(F.lds + 16384);
    LAS float* hx = (LAS float*)(F.lds + 25600);
    bf16_t* OC = (bf16_t*)(F.ws + OV_OC);
    const int tok0 = b * TPB + chunk * 64, ch0 = cb * 64;
    const int lane = F.lane, fr = lane & 15, fq = lane >> 4, d = F.wave >> 2, nt = F.wave & 3, ch = nt * 16 + fr;
    const int ct = F.tid >> 3, c8 = (F.tid & 7) * 8;
    {
      f32x4 a0 = c.cbias[0], a1 = c.cbias[1];
#pragma unroll
      for (int jj = 0; jj < 4; ++jj) { const u32x4 w = in.x[jj];
          a0 += c.cw[jj][0] * (f32x4){bflo(w.x), bfhi(w.x), bflo(w.y), bfhi(w.y)}; a1 += c.cw[jj][1] * (f32x4){bflo(w.z), bfhi(w.z), bflo(w.w), bfhi(w.w)}; }
      *(LAS f32x4*)(xs + ct * 64 + c8) = a0; *(LAS f32x4*)(xs + ct * 64 + c8 + 4) = a1;
      u32x4 pw; pw.x = pk2(a0[0], a0[1]); pw.y = pk2(a0[2], a0[3]); pw.z = pk2(a1[0], a1[1]); pw.w = pk2(a1[2], a1[3]);
      *(LAS u32x4*)(xsb + ct * 72 + c8) = pw; }
    __syncthreads();
    f32x4 av[4], bv[4], hv[4];
#pragma unroll
    for (int m = 0; m < 4; ++m) {
        const bf16x8 a0 = *(const LAS bf16x8*)(xsb + (m * 16 + fr) * 72 + fq * 8), a1 = *(const LAS bf16x8*)(xsb + (m * 16 + fr) * 72 + 32 + fq * 8);
        f32x4 da = {0.f, 0.f, 0.f, 0.f}, dx = {0.f, 0.f, 0.f, 0.f};
        da = __builtin_amdgcn_mfma_f32_16x16x32_bf16(a0, c.wa0, da, 0, 0, 0); da = __builtin_amdgcn_mfma_f32_16x16x32_bf16(a1, c.wa1, da, 0, 0, 0);
        dx = __builtin_amdgcn_mfma_f32_16x16x32_bf16(a0, c.wx0, dx, 0, 0, 0); dx = __builtin_amdgcn_mfma_f32_16x16x32_bf16(a1, c.wx1, dx, 0, 0, 0);
#pragma unroll
        for (int r = 0; r < 4; ++r) { const float rg = sigmoidf_(da[r] + c.ba), ig = sigmoidf_(dx[r] + c.bx); const float la = -8.0f * rg * c.sp;
            const float e1 = expm1_fast(la);
            av[m][r] = 1.0f + e1; bv[m][r] = __builtin_amdgcn_sqrtf(-e1 * (2.0f + e1)) * (ig * xs[(m * 16 + fq * 4 + r) * 64 + ch]); hv[m][r] = 0.f; }
    }
    float sumA = 1.f, sumH = 0.f;
    if (d == 0) lru_scan<false>(av, bv, hv, lane, mode, in.hin, sumA, sumH); else lru_scan<true>(av, bv, hv, lane, mode, in.hin, sumA, sumH);
    if (mode == 0) {
        if (fq == 0) { float* sum = (float*)(F.ws + WS_SUM) + ((size_t)((b * 2 + d) * 68 + chunk) * 512 + ch0 + ch) * 2; *(float2*)sum = make_float2(sumA, sumH); }
        __syncthreads();
        return;
    }
#pragma unroll
    for (int m = 0; m < 4; ++m)
#pragma unroll
        for (int r = 0; r < 4; ++r) hx[d * 4096 + (m * 16 + fq * 4 + r) * 64 + ch] = hv[m][r];
    __syncthreads();
    { const u32x4 yv = in.y;
      const f32x4 f0 = *(const LAS f32x4*)(hx + ct * 64 + c8), f1 = *(const LAS f32x4*)(hx + ct * 64 + c8 + 4), g0 = *(const LAS f32x4*)(hx + 4096 + ct * 64 + c8), g1 = *(const LAS f32x4*)(hx + 4096 + ct * 64 + c8 + 4);
      u32x4 o; o.x = pk2(bflo(yv.x) * (f0[0] + g0[0]), bfhi(yv.x) * (f0[1] + g0[1])); o.y = pk2(bflo(yv.y) * (f0[2] + g0[2]), bfhi(yv.y) * (f0[3] + g0[3]));
      o.z = pk2(bflo(yv.z) * (f1[0] + g1[0]), bfhi(yv.z) * (f1[1] + g1[1])); o.w = pk2(bflo(yv.w) * (f1[2] + g1[2]), bfhi(yv.w) * (f1[3] + g1[3]));
      *(u32x4*)(OC + (size_t)(tok0 + ct) * 512 + ch0 + c8) = o; }
}
__device__ __forceinline__ void lru_phase(const Frame& F, CArgsP a, int l, int mode, bool skip_ctx) {
    constexpr int NIT = 4 * 68 * 8;
    int it = F.bid;
    while (it < NIT && skip_ctx && ((it >> 3) % 68) < 4) it += F.G;
    if (it >= NIT) return;
    LruConst c; LruIn cur, nxt;
    int cb = it & 7; lru_load_const(F, a, l, cb, c);
    lru_load_in(F, (it >> 3) / 68, (it >> 3) % 68, cb, mode, cur);
    for (;;) {
        int nit = it + F.G;
        while (nit < NIT && skip_ctx && ((nit >> 3) % 68) < 4) nit += F.G;
        const bool has = nit < NIT;
        if (has) lru_load_in(F, (nit >> 3) / 68, (nit >> 3) % 68, nit & 7, mode, nxt);
        lru_compute(F, c, cur, (it >> 3) / 68, (it >> 3) % 68, cb, mode);
        if (!has) break;
        if ((nit & 7) != cb) { cb = nit & 7; lru_load_const(F, a, l, cb, c); }
        it = nit; cur = nxt;
    }
}

__device__ __forceinline__ void phase_carry(const Frame& F) {
    const int gt = F.bid * NTHR + F.tid; if (gt >= 4 * 2 * 512) return;
    const int c = gt & 511, d = (gt >> 9) & 1, b = gt >> 10;
    const float* sum = (const float*)(F.ws + WS_SUM) + (size_t)((b * 2 + d) * 68) * 1024 + c * 2;
    float* hin = (float*)(F.ws + WS_HIN) + (size_t)((b * 2 + d) * 68) * 512 + c;
    float h = 0.f;
#pragma unroll 1
    for (int g0 = 0; g0 < 68; g0 += 17) {
        float A[17], Hh[17];
#pragma unroll
        for (int i = 0; i < 17; ++i) { const int o = g0 + i; const int ck = d == 0 ? o : (o < 4 ? 3 - o : 71 - o); const float2 v = *(const float2*)(sum + (size_t)ck * 1024); A[i] = v.x; Hh[i] = v.y; }
#pragma unroll
        for (int i = 0; i < 17; ++i) { const int o = g0 + i; const int ck = d == 0 ? o : (o < 4 ? 3 - o : 71 - o); hin[(size_t)ck * 512] = h; h = A[i] * h + Hh[i]; }
    }
}

constexpr int AT_KST = 272, AT_VST = 320;
constexpr int AT_KOFF = 0, AT_VOFF = 2 * 64 * AT_KST, AT_XOFF = AT_VOFF + 2 * 64 * AT_VST;
#define AT_SBAR() __builtin_amdgcn_sched_barrier(0)
struct AttnState { f32x16 o[4]; bf16x8 pfp[4]; float mrun, lrun; };
#define AT_PIN1(x) asm volatile("" : "+v"(x))
__device__ __forceinline__ float at_max3(float a, float b, float c) { float r; asm("v_max3_f32 %0, %1, %2, %3" : "=v"(r) : "v"(a), "v"(b), "v"(c)); return r; }
__device__ __forceinline__ bf16x8 at_vfrag(const LAS unsigned char* vp) {
    const s16x4 lo = __builtin_bit_cast(s16x4, __builtin_amdgcn_ds_read_tr16_b64_v4i16((LAS s16x4*)(vp)));
    const s16x4 hh = __builtin_bit_cast(s16x4, __builtin_amdgcn_ds_read_tr16_b64_v4i16((LAS s16x4*)(vp + 8 * AT_VST)));
    return (bf16x8){lo[0], lo[1], lo[2], lo[3], hh[0], hh[1], hh[2], hh[3]};
}
__device__ __forceinline__ float attn_stage1(const f32x16& p0, const f32x16& p1, f32x16& n0, f32x16& n1, const bf16x8 (&qr)[4], const LAS unsigned char* kf) {
    float mx = at_max3(p0[0], p0[1], at_max3(p1[0], p1[1], p1[1]));
    bf16x8 a0 = *(const LAS bf16x8*)(kf), a1 = *(const LAS bf16x8*)(kf + 32 * AT_KST);
    AT_SBAR();
#pragma unroll
    for (int ks = 0; ks < 4; ++ks) {
        bf16x8 b0 = a0, b1 = a1;
        if (ks < 3) { b0 = *(const LAS bf16x8*)(kf + (ks + 1) * 32); b1 = *(const LAS bf16x8*)(kf + 32 * AT_KST + (ks + 1) * 32); }
        if (ks == 0) n0 = __builtin_amdgcn_mfma_f32_32x32x16_bf16(a0, qr[0], (f32x16){0.f, 0.f, 0.f, 0.f, 0.f, 0.f, 0.f, 0.f, 0.f, 0.f, 0.f, 0.f, 0.f, 0.f, 0.f, 0.f}, 0, 0, 0);
        else n0 = __builtin_amdgcn_mfma_f32_32x32x16_bf16(a0, qr[ks], n0, 0, 0, 0);
        mx = at_max3(at_max3(mx, p0[4 * ks + 2], p0[4 * ks + 3]), p1[4 * ks + 2], p1[4 * ks + 3]); AT_PIN1(mx); AT_SBAR();
        if (ks == 0) n1 = __builtin_amdgcn_mfma_f32_32x32x16_bf16(a1, qr[0], (f32x16){0.f, 0.f, 0.f, 0.f, 0.f, 0.f, 0.f, 0.f, 0.f, 0.f, 0.f, 0.f, 0.f, 0.f, 0.f, 0.f}, 0, 0, 0);
        else n1 = __builtin_amdgcn_mfma_f32_32x32x16_bf16(a1, qr[ks], n1, 0, 0, 0);
        if (ks < 3) { mx = at_max3(at_max3(mx, p0[4 * ks + 4], p0[4 * ks + 5]), p1[4 * ks + 4], p1[4 * ks + 5]); AT_PIN1(mx); } AT_SBAR();
        a0 = b0; a1 = b1;
    }
    return mx;
}
template <bool FIRST>
__device__ __forceinline__ void attn_stage2(AttnState& st, const f32x16& p0, const f32x16& p1, float mx, const LAS unsigned char* vf) {
    constexpr float SC = 0.125f * 1.4426950408889634f, THR = 8.0f;
    bf16x8 vcur; if (!FIRST) vcur = at_vfrag(vf);
    float tm; { auto rr = __builtin_amdgcn_permlane32_swap(__float_as_uint(mx), __float_as_uint(mx), false, false); tm = fmaxf(__uint_as_float(rr[0]), __uint_as_float(rr[1])) * SC; }
    if (__any(tm > st.mrun + THR)) {
        const float mn = fmaxf(st.mrun, tm); const float al = __builtin_amdgcn_exp2f(fmaxf(st.mrun - mn, -126.f));
#pragma unroll
        for (int db = 0; db < 4; ++db)
#pragma unroll
            for (int r = 0; r < 16; ++r) st.o[db][r] *= al;
        if (!FIRST) {
#pragma unroll
            for (int kk = 0; kk < 4; ++kk) { u32x4 w = __builtin_bit_cast(u32x4, st.pfp[kk]);
                w.x = pk2(bflo(w.x) * al, bfhi(w.x) * al); w.y = pk2(bflo(w.y) * al, bfhi(w.y) * al); w.z = pk2(bflo(w.z) * al, bfhi(w.z) * al); w.w = pk2(bflo(w.w) * al, bfhi(w.w) * al);
                st.pfp[kk] = __builtin_bit_cast(bf16x8, w); }
        }
        st.lrun *= al; st.mrun = mn;
    }
    const float nm = -st.mrun; float ls = 0.f;
    AT_SBAR();
#pragma unroll
    for (int kk = 0; kk < 4; ++kk) {
        unsigned pw0 = 0, pw1 = 0, pw2 = 0, pw3 = 0;
#pragma unroll
        for (int db = 0; db < 4; ++db) {
            const int g = kk * 4 + db;
            if (!FIRST) {
                bf16x8 vnext = vcur;
                if (g < 15) { const int g2 = g + 1; vnext = at_vfrag(vf + ((g2 >> 2) * 16) * AT_VST + (g2 & 3) * 64); }
                st.o[db] = __builtin_amdgcn_mfma_f32_32x32x16_bf16(vcur, st.pfp[kk], st.o[db], 0, 0, 0);
                vcur = vnext;
            }
            const float x0 = g < 8 ? p0[2 * g] : p1[2 * g - 16], x1 = g < 8 ? p0[2 * g + 1] : p1[2 * g - 15];
            const float e0 = __builtin_amdgcn_exp2f(__builtin_fmaf(x0, SC, nm)), e1 = __builtin_amdgcn_exp2f(__builtin_fmaf(x1, SC, nm));
            ls += e0 + e1; unsigned w = pk2(e0, e1); AT_PIN1(ls); AT_PIN1(w);
            if (db == 0) pw0 = w; else if (db == 1) pw1 = w; else if (db == 2) pw2 = w; else pw3 = w;
            AT_SBAR();
        }
        st.pfp[kk] = __builtin_bit_cast(bf16x8, (u32x4){pw0, pw1, pw2, pw3});
    }
    st.lrun += ls;
}
__device__ __forceinline__ void attn_unit(const Frame& F, int tokq0, int tokk0, int ntiles, int h, float lam, const float* gain, float oscale) {
    const bf16_t* Q = (const bf16_t*)(F.ws + OV_Q); const char* Kg = (const char*)(F.ws + OV_K); const char* Vg = (const char*)(F.ws + OV_V); bf16_t* OA = (bf16_t*)(F.ws + OV_OA);
    const int lane = F.lane, r32 = lane & 31, hi = lane >> 5, rb = F.wave >> 1, c = F.wave & 1;
    bf16x8 qr[4];
    { const bf16_t* qp = Q + (size_t)(tokq0 + rb * 32 + r32) * 512 + h * 128 + c * 64 + hi * 8;
#pragma unroll
      for (int ks = 0; ks < 4; ++ks) qr[ks] = *(const bf16x8*)(qp + ks * 16); }
    const int srow0 = F.tid >> 4, sch = F.tid & 15;
    const unsigned goff = (unsigned)(((tokk0 + srow0) * 512 + h * 128 + sch * 8) * 2);
    LAS unsigned char* kl = F.lds + AT_KOFF + srow0 * AT_KST + sch * 16;
    LAS unsigned char* vl = F.lds + AT_VOFF + srow0 * AT_VST + sch * 16;
    const LAS unsigned char* kfb = F.lds + AT_KOFF + r32 * AT_KST + (c * 64 + hi * 8) * 2;
    const LAS unsigned char* vfb = F.lds + AT_VOFF + (4 * hi + ((lane & 15) >> 2)) * AT_VST + (((lane >> 4) & 1) * 16 + (lane & 3) * 4) * 2;
    {
      const u32x4 k0 = *(const u32x4*)(Kg + goff), k1 = *(const u32x4*)(Kg + goff + 32 * 1024), k2 = *(const u32x4*)(Kg + goff + 64 * 1024), k3 = *(const u32x4*)(Kg + goff + 96 * 1024);
      *(LAS u32x4*)(kl) = k0; *(LAS u32x4*)(kl + 32 * AT_KST) = k1; *(LAS u32x4*)(kl + 64 * AT_KST) = k2; *(LAS u32x4*)(kl + 96 * AT_KST) = k3; }
    __syncthreads();
    AttnState st; st.mrun = -1e30f; st.lrun = 0.f;
#pragma unroll
    for (int db = 0; db < 4; ++db)
#pragma unroll
        for (int r = 0; r < 16; ++r) st.o[db][r] = 0.f;
    f32x16 pa0, pa1, pb0, pb1;
#pragma unroll
    for (int r = 0; r < 16; ++r) { pa0[r] = 0.f; pa1[r] = 0.f; }
#pragma unroll
    for (int ks = 0; ks < 4; ++ks) {
        const bf16x8 a0 = *(const LAS bf16x8*)(kfb + ks * 32), a1 = *(const LAS bf16x8*)(kfb + 32 * AT_KST + ks * 32);
        pa0 = __builtin_amdgcn_mfma_f32_32x32x16_bf16(a0, qr[ks], pa0, 0, 0, 0); pa1 = __builtin_amdgcn_mfma_f32_32x32x16_bf16(a1, qr[ks], pa1, 0, 0, 0);
    }
    asm volatile("s_nop 15\n\ts_nop 7" : "+v"(pa0), "+v"(pa1));
    u32x4 sv0 = *(const u32x4*)(Vg + goff), sv1 = *(const u32x4*)(Vg + goff + 32 * 1024);
#define AT_ITER(I, FIRSTF, PC0, PC1, PN0, PN1) do { \
        const int i_ = (I); const bool ldk_ = i_ + 2 < ntiles; const int sl_ = i_ & 1; \
        const float mx_ = attn_stage1(PC0, PC1, PN0, PN1, qr, kfb + ((i_ + 1) & 1) * (64 * AT_KST)); \
        *(LAS u32x4*)(vl + sl_ * (64 * AT_VST)) = sv0; *(LAS u32x4*)(vl + sl_ * (64 * AT_VST) + 32 * AT_VST) = sv1; \
        u32x4 sk0_, sk1_; if (ldk_) { const unsigned go_ = goff + (unsigned)(i_ + 2) * 65536u; sk0_ = *(const u32x4*)(Kg + go_); sk1_ = *(const u32x4*)(Kg + go_ + 32 * 1024); } \
        attn_stage2<FIRSTF>(st, PC0, PC1, mx_, vfb + ((i_ + 1) & 1) * (64 * AT_VST)); \
        if (ldk_) { *(LAS u32x4*)(kl + sl_ * (64 * AT_KST)) = sk0_; *(LAS u32x4*)(kl + sl_ * (64 * AT_KST) + 32 * AT_KST) = sk1_; } \
        if (i_ + 1 < ntiles) { const unsigned gv_ = goff + (unsigned)(i_ + 1) * 65536u; sv0 = *(const u32x4*)(Vg + gv_); sv1 = *(const u32x4*)(Vg + gv_ + 32 * 1024); } \
        __syncthreads(); } while (0)
    AT_ITER(0, true, pa0, pa1, pb0, pb1);
    AT_ITER(1, false, pb0, pb1, pa0, pa1);
#pragma unroll 1
    for (int i = 2; i < ntiles; i += 2) {
        AT_ITER(i, false, pa0, pa1, pb0, pb1);
        AT_ITER(i + 1, false, pb0, pb1, pa0, pa1);
    }
#undef AT_ITER
    {
      const LAS unsigned char* vf = vfb + ((ntiles - 1) & 1) * (64 * AT_VST);
#pragma unroll
      for (int db = 0; db < 4; ++db)
#pragma unroll
          for (int kk = 0; kk < 4; ++kk) {
              const LAS unsigned char* vp = vf + (kk * 16) * AT_VST + db * 64;
              const s16x4 lo = __builtin_bit_cast(s16x4, __builtin_amdgcn_ds_read_tr16_b64_v4i16((LAS s16x4*)(vp)));
              const s16x4 hh = __builtin_bit_cast(s16x4, __builtin_amdgcn_ds_read_tr16_b64_v4i16((LAS s16x4*)(vp + 8 * AT_VST)));
              const bf16x8 vfr = {lo[0], lo[1], lo[2], lo[3], hh[0], hh[1], hh[2], hh[3]};
              st.o[db] = __builtin_amdgcn_mfma_f32_32x32x16_bf16(vfr, st.pfp[kk], st.o[db], 0, 0, 0);
          } }
    float lrun = st.lrun; lrun += __shfl_xor(lrun, 32);
    const float il = 1.f / lrun;
    LAS float* ex = (LAS float*)(F.lds + AT_XOFF) + rb * 4096;
    if (c == 1) {
#pragma unroll
        for (int db = 0; db < 4; ++db)
#pragma unroll
            for (int r = 0; r < 16; ++r) ex[(db * 16 + r) * 64 + lane] = st.o[db][r] * il;
    }
    __syncthreads();
    if (c == 0) {
        float ss = 0.f;
#pragma unroll
        for (int db = 0; db < 4; ++db)
#pragma unroll
            for (int r = 0; r < 16; ++r) { const float dv = st.o[db][r] * il - lam * ex[(db * 16 + r) * 64 + lane]; st.o[db][r] = dv; ss += dv * dv; }
        ss += __shfl_xor(ss, 32);
        const float rinv = oscale / sqrtf(ss * (1.f / 128.f) + RMS_EPS);
        bf16_t* op = OA + (size_t)(tokq0 + rb * 32 + r32) * 512 + h * 128;
#pragma unroll
        for (int db = 0; db < 4; ++db)
#pragma unroll
            for (int r4 = 0; r4 < 4; ++r4) { const int dv0 = db * 32 + 8 * r4 + 4 * hi; const f32x4 gv = *(const f32x4*)(gain + dv0);
                u32x2 w; w.x = pk2(st.o[db][4 * r4] * rinv * gv[0], st.o[db][4 * r4 + 1] * rinv * gv[1]); w.y = pk2(st.o[db][4 * r4 + 2] * rinv * gv[2], st.o[db][4 * r4 + 3] * rinv * gv[3]);
                *(u32x2*)(op + dv0) = w; }
    }
    __syncthreads();
}

__device__ __forceinline__ void phase_attn(const Frame& F, CArgsP a, int l) {
    const float lam = ((const float*)(F.ws + WS_LAM))[l]; const float li = 0.8f - 0.6f * expf(-0.3f * (float)l);
    for (int dd = 0; dd < NDUP(6); ++dd) lru_phase(F, a, l, 1, l == 1);
    __syncthreads();
    const int nlat = 4 * 4 * 32, nctx = (l == 0) ? 4 * 4 * 2 : 0;
    for (int dd = 0; dd < NDUP(7); ++dd)
    for (int it = F.vcu; it < nlat + nctx; it += F.G) {
        int b, h, qb, tq0, nt;
        if (it < nlat) { qb = it & 31; h = (it >> 5) & 3; b = it >> 7; tq0 = b * TPB + CTX + qb * 128; nt = 68; }
        else { const int i2 = it - nlat; qb = i2 & 1; h = (i2 >> 1) & 3; b = i2 >> 3; tq0 = b * TPB + qb * 128; nt = 4; }
        attn_unit(F, tq0, b * TPB, nt, h, lam, a->in[12] + (l * 4 + h) * 128, 1.0f - li);
    }
}

__device__ __forceinline__ void mini_tile(const bf16_t* A, int lda, const bf16_t* Bt, int K, int lane, int wave, f32x4 (&acc)[2]) {
    const int fr = lane & 15, fq = lane >> 4;
    const bf16_t* ap = A + (size_t)((wave >> 1) * 16 + fr) * lda + fq * 8;
    const bf16_t* bp0 = Bt + (size_t)((wave & 1) * 32 + fr) * K + fq * 8; const bf16_t* bp1 = bp0 + (size_t)16 * K;
    acc[0] = (f32x4){0.f, 0.f, 0.f, 0.f}; acc[1] = (f32x4){0.f, 0.f, 0.f, 0.f};
#pragma unroll 8
    for (int k = 0; k < K; k += 32) {
        const bf16x8 av = *(const bf16x8*)(ap + k), b0 = *(const bf16x8*)(bp0 + k), b1 = *(const bf16x8*)(bp1 + k);
        acc[0] = __builtin_amdgcn_mfma_f32_16x16x32_bf16(b0, av, acc[0], 0, 0, 0); acc[1] = __builtin_amdgcn_mfma_f32_16x16x32_bf16(b1, av, acc[1], 0, 0, 0);
    }
}
__device__ __forceinline__ void mini_merge_ctx(const Frame& F, int l) {
    const int fr = F.lane & 15, fq = F.lane >> 4;
    for (int t = F.bid; t < 256; t += F.G) {
        const int rb = t >> 4, cbk = t & 15, cr = rb * 64, tok0 = (cr >> 8) * TPB + (cr & 255), col0 = cbk * 64;
        const int row = tok0 + (F.wave >> 1) * 16 + fr, colw = col0 + (F.wave & 1) * 32 + fq * 4;
        f32x4 mg[2] = {{0.f, 0.f, 0.f, 0.f}, {0.f, 0.f, 0.f, 0.f}};
#pragma unroll 1
        for (int r = 0; r < 3; ++r) {
            f32x4 acc[2];
            mini_tile((const bf16_t*)(F.ws + OV_OA + (size_t)r * 17 * MiB) + (size_t)tok0 * 512, 512, (const bf16_t*)(F.ws + WS_WBR) + (size_t)(l * 3 + r) * 1024 * 512 + (size_t)col0 * 512, 512, F.lane, F.wave, acc);
#pragma unroll
            for (int n = 0; n < 2; ++n) { const u32x2 g = *(const u32x2*)((const bf16_t*)(F.ws + OV_G) + (size_t)row * 3072 + r * 1024 + colw + n * 16);
                mg[n][0] += bflo(g.x) * acc[n][0]; mg[n][1] += bfhi(g.x) * acc[n][1]; mg[n][2] += bflo(g.y) * acc[n][2]; mg[n][3] += bfhi(g.y) * acc[n][3]; }
        }
#pragma unroll
        for (int n = 0; n < 2; ++n) { u32x2 w; w.x = pk2(mg[n][0], mg[n][1]); w.y = pk2(mg[n][2], mg[n][3]); *(u32x2*)((bf16_t*)(F.ws + OV_MG) + (size_t)row * DM + colw + n * 16) = w; }
    }
}
__device__ __forceinline__ void mini_wout_ctx(const Frame& F, int l) {
    const int fr = F.lane & 15, fq = F.lane >> 4;
    const float* g1 = (const float*)(F.ws + WS_MOD) + (l * 5 + 4) * 6144 + 2048;
    for (int t = F.bid; t < 256; t += F.G) {
        const int rb = t >> 4, cbk = t & 15, cr = rb * 64, tok0 = (cr >> 8) * TPB + (cr & 255), col0 = cbk * 64;
        const int crow = cr + (F.wave >> 1) * 16 + fr, colw = col0 + (F.wave & 1) * 32 + fq * 4;
        f32x4 acc[2];
        mini_tile((const bf16_t*)(F.ws + OV_MG) + (size_t)tok0 * DM, DM, (const bf16_t*)(F.ws + WS_WOUT) + (size_t)l * 1048576 + (size_t)col0 * 1024, 1024, F.lane, F.wave, acc);
#pragma unroll
        for (int n = 0; n < 2; ++n) { f32x4* p = (f32x4*)((float*)(F.ws + WS_XC) + (size_t)crow * DM + colw + n * 16); const f32x4 gv = *(const f32x4*)(g1 + colw + n * 16); const f32x4 x = *p; *p = x * DN_ALPHA + gv * acc[n]; }
    }
}

constexpr int RT_AST = 1032;
__device__ __forceinline__ void phase_router(const Frame& F, CArgsP a, int l, bool dry) {
    const float* mod = (const float*)(F.ws + WS_MOD) + l * 5 * 6144; float* xc = (float*)(F.ws + WS_XC); bf16_t* H = (bf16_t*)(F.ws + WS_H);
    LAS bf16_t* AT = (LAS bf16_t*)F.lds;
    LAS float* LG = (LAS float*)(F.lds + 32 * RT_AST * 2);
    LAS unsigned* LC = (LAS unsigned*)(F.lds + 32 * RT_AST * 2 + 8192);
    const bf16_t* Wt = (const bf16_t*)(F.ws + WS_WRT) + (size_t)l * 65536; const float rb_ = a->in[29][l * 64 + F.lane];
    unsigned* cnt = (unsigned*)(F.ws + WS_CNT) + l * 4096; int* list = (int*)(F.ws + WS_LIST);
    int* toke = (int*)(F.ws + WS_TOKE); int* tokp = (int*)(F.ws + WS_TOKP); float* tokw = (float*)(F.ws + WS_TOKW);
    const int nrows = l == 0 ? T : NBATCH * SEQ, nbatch = nrows / 32;
    const int fr = F.lane & 15, fq = F.lane >> 4, mt = F.wave & 1, nt = F.wave >> 1;
    if (F.tid < 64) LC[F.tid] = 0u;
    bf16x8 bfr[32];
    { const bf16_t* bp = Wt + (size_t)(nt * 16 + fr) * 1024 + fq * 8;
#pragma unroll
      for (int ks = 0; ks < 32; ++ks) bfr[ks] = *(const bf16x8*)(bp + ks * 32); }
    for (int bt = F.bid; bt < nbatch; bt += F.G) {
        int toks[4];
#pragma unroll
        for (int r = 0; r < 4; ++r) { const int ridx = bt * 32 + F.wave * 4 + r; toks[r] = l == 0 ? ridx : (ridx >> 12) * TPB + CTX + (ridx & 4095); }
#pragma unroll
        for (int rp = 0; rp < 4; rp += 2) {
        f32x4 vv[2][4];
        row_load(resid_row(F.out, xc, toks[rp]), F.lane, vv[0]); row_load(resid_row(F.out, xc, toks[rp + 1]), F.lane, vv[1]);
#pragma unroll
        for (int r2 = 0; r2 < 2; ++r2) { const int r = rp + r2; const int tok = toks[r];
            const int b = tok / TPB; const int bsel = (tok - b * TPB) < CTX ? 4 : b;
            float* xr = resid_row(F.out, xc, tok);
            f32x4 (&v)[4] = vv[r2]; row_ln(v); row_affine(v, a->in[26] + l * DM, false, a->in[27] + l * DM, F.lane);
            row_ln(v); const float* mrow = mod + bsel * 6144; row_affine(v, mrow + 4096, true, mrow + 3072, F.lane);
#pragma unroll
            for (int j = 0; j < 4; ++j) { u32x2 w; w.x = pk2(v[j][0], v[j][1]); w.y = pk2(v[j][2], v[j][3]);
                if (!dry) *(u32x2*)(H + (size_t)tok * DM + 4 * F.lane + 256 * j) = w; *(LAS u32x2*)(AT + (F.wave * 4 + r) * RT_AST + 4 * F.lane + 256 * j) = w; }
        }
        }
        __syncthreads();
        { f32x4 d = {0.f, 0.f, 0.f, 0.f};
          const LAS bf16_t* ap = AT + (mt * 16 + fr) * RT_AST + fq * 8;
#pragma unroll
          for (int ks = 0; ks < 32; ++ks) { const bf16x8 av = *(const LAS bf16x8*)(ap + ks * 32); d = __builtin_amdgcn_mfma_f32_16x16x32_bf16(av, bfr[ks], d, 0, 0, 0); }
#pragma unroll
          for (int r = 0; r < 4; ++r) LG[(mt * 16 + fq * 4 + r) * 64 + nt * 16 + fr] = d[r]; }
        __syncthreads();
        bool selr[4]; int rkr[4], lpr[4]; float wr_[4];
#pragma unroll
        for (int r = 0; r < 4; ++r) {
            const float lg = LG[(F.wave * 4 + r) * 64 + F.lane];
            const float s = sigmoidf_(lg); const float bsc = s + rb_;
            float m1 = bsc; m1 = fmaxf(m1, WS_DPP(m1, 0xB1, 0xF, true)); m1 = fmaxf(m1, WS_DPP(m1, 0x4E, 0xF, true)); m1 = fmaxf(m1, WS_DPP(m1, 0x141, 0xF, true));
            const unsigned long long eq = __ballot(bsc == m1); const unsigned gm = (unsigned)(eq >> (F.lane & ~7)) & 0xffu; const int first = __ffs(gm) - 1;
            float m2 = ((F.lane & 7) == first) ? -INFINITY : bsc; m2 = fmaxf(m2, WS_DPP(m2, 0xB1, 0xF, true)); m2 = fmaxf(m2, WS_DPP(m2, 0x4E, 0xF, true)); m2 = fmaxf(m2, WS_DPP(m2, 0x141, 0xF, true));
            const float gs = m1 + m2; const int myg = F.lane >> 3; int grank = 0;
#pragma unroll
            for (int g = 0; g < 8; ++g) { const float og = __builtin_bit_cast(float, __builtin_amdgcn_readlane(__builtin_bit_cast(int, gs), g * 8)); grank += (int)(og > gs) + (int)((og == gs) & (g < myg)); }
            const bool gsel = grank < 4; const float mk = gsel ? bsc : -INFINITY; int rk = 0;
#pragma unroll
            for (int j = 0; j < 64; ++j) { const float vj = __builtin_bit_cast(float, __builtin_amdgcn_readlane(__builtin_bit_cast(int, mk), j)); rk += (int)(vj > mk) + (int)((vj == mk) & (j < F.lane)); }
            const bool sel = gsel && rk < 8 && !dry;
            const float ssum = wave_sum((gsel && rk < 8) ? s : 0.f);
            selr[r] = sel; rkr[r] = rk; wr_[r] = s / ssum * 2.5f; lpr[r] = 0;
            if (sel) lpr[r] = (int)__hip_atomic_fetch_add((LAS unsigned*)(LC + F.lane), 1u, __ATOMIC_RELAXED, __HIP_MEMORY_SCOPE_WORKGROUP);
        }
        __syncthreads();
        if (F.tid < 64) { const unsigned n = LC[F.tid]; unsigned base = 0; if (n) base = atomicAdd(cnt + F.tid * 64, n); LC[64 + F.tid] = base; LC[F.tid] = 0u; }
        __syncthreads();
#pragma unroll
        for (int r = 0; r < 4; ++r)
            if (selr[r]) { const int tok = toks[r]; const int pos = (int)LC[64 + F.lane] + lpr[r];
                list[(size_t)F.lane * T + pos] = tok; toke[tok * 8 + rkr[r]] = F.lane; tokp[tok * 8 + rkr[r]] = pos; tokw[tok * 8 + rkr[r]] = wr_[r]; }
        __syncthreads();
    }
}

__device__ __forceinline__ void build_tables(const Frame& F, int l) {
    LAS int* tb = (LAS int*)(F.lds + LDS_CTL);
    __syncthreads();
    if (F.tid < 64) tb[LC_TCNT + F.tid] = (int)__hip_atomic_load((unsigned*)(F.ws + WS_CNT) + l * 4096 + F.tid * 64, __ATOMIC_RELAXED, __HIP_MEMORY_SCOPE_AGENT);
    __syncthreads();
    if (F.tid == 0) { int tbs = 0, sbs = 0;
        for (int e = 0; e < 64; ++e) { const int c = tb[LC_TCNT + e]; tb[LC_TBASE + e] = tbs; tb[LC_SBASE + e] = sbs; tbs += (c + 255) >> 8; sbs += c; }
        tb[LC_TBASE + 64] = tbs; tb[LC_SBASE + 64] = sbs; }
    __syncthreads();
}

__device__ __forceinline__ void phase_combine(const Frame& F, CArgsP a, int l, bool dry) {
    const float* mod = (const float*)(F.ws + WS_MOD) + l * 5 * 6144; float* xc = (float*)(F.ws + WS_XC); bf16_t* H = (bf16_t*)(F.ws + WS_H);
    const unsigned char* YS = (const unsigned char*)(F.ws + OV_YS); const LAS int* tb = (const LAS int*)(F.lds + LDS_CTL);
    const int* toke = (const int*)(F.ws + WS_TOKE); const int* tokp = (const int*)(F.ws + WS_TOKP); const float* tokw = (const float*)(F.ws + WS_TOKW);
    const int nrows = l == 0 ? T : NBATCH * SEQ;
    for (int rp = F.gw * 2; rp < nrows; rp += F.NGW * 2) {
        int tok[2], bsel[2]; float* xr[2]; f32x4 y[2][4], v[2][4]; int me, mp; float mw;
#pragma unroll
        for (int q = 0; q < 2; ++q) { const int ridx = rp + q; tok[q] = l == 0 ? ridx : (ridx >> 12) * TPB + CTX + (ridx & 4095);
            const int b = tok[q] / TPB; bsel[q] = (tok[q] - b * TPB) < CTX ? 4 : b; xr[q] = resid_row(F.out, xc, tok[q]); }
        { const int q = (F.lane >> 3) & 1, k = F.lane & 7; me = toke[tok[q] * 8 + k]; mp = tokp[tok[q] * 8 + k]; mw = tokw[tok[q] * 8 + k]; }
#pragma unroll
        for (int q = 0; q < 2; ++q) { const bf16_t* sp = H + (size_t)tok[q] * DM;
#pragma unroll
            for (int j = 0; j < 4; ++j) { const u32x2 w = *(const u32x2*)(sp + 4 * F.lane + 256 * j); y[q][j] = (f32x4){bflo(w.x), bfhi(w.x), bflo(w.y), bfhi(w.y)}; }
            row_load(xr[q], F.lane, v[q]); }
#pragma unroll
        for (int q = 0; q < 2; ++q) { row_ln(v[q]); row_affine(v[q], a->in[26] + l * DM, false, a->in[27] + l * DM, F.lane); }
#pragma unroll
        for (int q = 0; q < 2; ++q)
#pragma unroll
            for (int k = 0; k < 8; ++k) { const int e = __shfl(me, q * 8 + k), p = __shfl(mp, q * 8 + k); const float wv = __shfl(mw, q * 8 + k) * 0.0625f;
                const unsigned char* yp = YS + (size_t)(tb[LC_SBASE + e] + p) * DM;
#pragma unroll
                for (int j = 0; j < 4; ++j) { const int w = (int)*(const unsigned*)(yp + 4 * F.lane + 256 * j);
                    y[q][j][0] += wv * __builtin_amdgcn_cvt_f32_fp8(w, 0); y[q][j][1] += wv * __builtin_amdgcn_cvt_f32_fp8(w, 1); y[q][j][2] += wv * __builtin_amdgcn_cvt_f32_fp8(w, 2); y[q][j][3] += wv * __builtin_amdgcn_cvt_f32_fp8(w, 3); } }
#pragma unroll
        for (int q = 0; q < 2; ++q) {
            const float* g2 = mod + bsel[q] * 6144 + 5120;
#pragma unroll
            for (int j = 0; j < 4; ++j) { const f32x4 gv = *(const f32x4*)(g2 + 4 * F.lane + 256 * j); v[q][j] = v[q][j] * DN_ALPHA + gv * y[q][j]; }
            row_ln(v[q]); row_affine(v[q], a->in[36] + l * DM, false, a->in[37] + l * DM, F.lane);
            if (!dry) row_store(xr[q], F.lane, v[q]); else asm volatile("" :: "v"(v[q][0]), "v"(v[q][1]), "v"(v[q][2]), "v"(v[q][3]));
            if (l == 0 && !dry) { row_ln(v[q]); const float* mrow = mod + 5 * 6144 + bsel[q] * 6144; row_affine(v[q], mrow + 1024, true, mrow, F.lane); row_store_bf16(H + (size_t)tok[q] * DM, F.lane, v[q]); }
        }
    }
}

constexpr int NPHASE = 22;
__global__ void __launch_bounds__(NTHR, 2) mk_fwd(Args args) {
    extern __shared__ __attribute__((aligned(16))) unsigned char lds_raw[];
    Frame F; F.lds = (LAS unsigned char*)lds_raw; F.tid = threadIdx.x; F.lane = F.tid & 63; F.wave = __builtin_amdgcn_readfirstlane(F.tid >> 6);
    F.G = gridDim.x; F.bid = blockIdx.x; F.gw = F.bid * NWAVES + F.wave; F.NGW = F.G * NWAVES; F.ws = args.ws; F.out = args.out; F.vcu = (F.G % 8 == 0) ? (F.bid % 8) * (F.G / 8) + F.bid / 8 : F.bid;
    for (int u = F.tid; u < (LDS_BYTES - LDS_CTL) / 4; u += NTHR) ((LAS unsigned*)(F.lds + LDS_CTL))[u] = 0u;
    __syncthreads();
    const int lo = args.ph_lo, hi = args.ph_hi;
    CArgsP A4 = (CArgsP)__builtin_amdgcn_kernarg_segment_ptr();
    XcdBarrier bar; bar.bar = (unsigned*)(F.ws + CW_BAR_BYTE); bar.x = 0; bar.st = nullptr;
    if (hi - lo > 1) bar = xcd_barrier_post((unsigned*)(F.ws + CW_BAR_BYTE), (volatile LAS unsigned*)(F.lds + LDS_CTL) + LC_BAR);
#ifndef PHMASK
#define PHMASK 0xfff
#endif
#define PH_EN(k) ((PHMASK >> ((k) < 2 ? (k) : 2 + (((k) - 2) % 10))) & 1)
#define IN(k) (PH_EN(k) && lo <= (k) && (k) < hi)
#define SEAM(k) do { if (IN(k) && IN((k) + 1)) { for (int dd = 0; dd < NDUP(14); ++dd) xcd_barrier(bar); } if (TSMASK != 0 && blockIdx.x == 0 && threadIdx.x == 0) { ((volatile LAS unsigned long long*)(F.lds + LDS_CTL + 2048))[(k) + 1] = __builtin_amdgcn_s_memrealtime(); } FRESH(); } while (0)
#define FRESH() do { int t_ = threadIdx.x, b_ = blockIdx.x; CArgsP p_ = (CArgsP)__builtin_amdgcn_kernarg_segment_ptr(); asm volatile("" : "+v"(t_)); asm volatile("" : "+s"(b_), "+s"(p_)); A4 = p_; unsigned char* w_ = p_->ws; float* o_ = p_->out; \
    F.tid = t_; F.lane = t_ & 63; F.wave = __builtin_amdgcn_readfirstlane(t_ >> 6); F.bid = b_; F.gw = b_ * NWAVES + F.wave; F.ws = w_; F.out = o_; F.vcu = (F.G % 8 == 0) ? (b_ % 8) * (F.G / 8) + b_ / 8 : b_; } while (0)
    if (TSMASK != 0 && blockIdx.x == 0 && threadIdx.x == 0) ((volatile LAS unsigned long long*)(F.lds + LDS_CTL + 2048))[0] = __builtin_amdgcn_s_memrealtime();
    if (IN(0)) { for (int dd = 0; dd < NDUP(0); ++dd) phase_prologue(F, A4); } SEAM(0);
    if (IN(1)) { for (int dd = 0; dd < NDUP(1); ++dd) phase_rows0(F, A4); } SEAM(1);
#pragma unroll 1
    for (int l = 0; l < 2; ++l) {
        const int pb = 2 + 10 * l; const bool lat = (l == 1);
        if (IN(pb + 0)) {
            SchedPlain S{(const char*)(F.ws + WS_H), (const char*)(F.ws + WS_WIN) + (size_t)l * INC * 1024 * 2, 1024, 68, 26, F.G, F.bid, false};
            EpiInproj E{F.ws, A4->in[7] + l * INC, (const float*)(F.ws + WS_ROPE)};
            for (int dd = 0; dd < NDUP(2); ++dd) pg8::gemm_phase(F.lds, 1024, S, E);
        } SEAM(pb + 0);
        if (IN(pb + 1)) {
            for (int dd = 0; dd < NDUP(3); ++dd) lru_phase(F, A4, l, 0, false);
            for (int dd = 0; dd < NDUP(4); ++dd)
            for (int it = F.bid; it < 136 * 4; it += F.G) { const int chunk = it >> 2; if (lat && (chunk % 34) < 2) continue; sg_item(F, A4, l, chunk, it & 3); }
        } SEAM(pb + 1);
        if (IN(pb + 2)) { for (int dd = 0; dd < NDUP(5); ++dd) phase_carry(F); } SEAM(pb + 2);
        if (IN(pb + 3)) { phase_attn(F, A4, l); } SEAM(pb + 3);
        if (IN(pb + 4)) {
            for (int dd = 0; dd < NDUP(8); ++dd) {
                SchedMerge S{(const char*)(F.ws + OV_OA), (const char*)(F.ws + WS_WBR) + (size_t)(l * 3) * 1024 * 512 * 2, F.G, F.bid};
                EpiMerge E{(bf16_t*)(F.ws + OV_MG), (const bf16_t*)(F.ws + OV_G)};
                pg8::gemm_phase(F.lds, 512, S, E);
            }
            if (!lat) mini_merge_ctx(F, l);
        } SEAM(pb + 4);
        if (IN(pb + 5)) {
            SchedPlain S{(const char*)(F.ws + OV_MG), (const char*)(F.ws + WS_WOUT) + (size_t)l * 1048576 * 2, 1024, 64, 4, F.G, F.bid, true};
            EpiWout E{F.out, (float*)(F.ws + WS_XC), (const float*)(F.ws + WS_MOD) + l * 5 * 6144, false};
            pg8::gemm_phase(F.lds, 1024, S, E);
            if (NDUP(11) > 1) { EpiWout E2{F.out, (float*)(F.ws + WS_XC), (const float*)(F.ws + WS_MOD) + l * 5 * 6144, true}; pg8::gemm_phase(F.lds, 1024, S, E2); }
            if (!lat) mini_wout_ctx(F, l);
        } SEAM(pb + 5);
        if (IN(pb + 6)) { phase_router(F, A4, l, false); if (NDUP(12) > 1) phase_router(F, A4, l, F.G != 12345); } SEAM(pb + 6);
        if (IN(pb + 7)) {
            build_tables(F, l);
            SchedMoe S{(const char*)(F.ws + WS_H), (const char*)(F.ws + WS_H), (const char*)(F.ws + WS_WM1), (const char*)(F.ws + WS_WSH1) + (size_t)l * 524288 * 2,
                       (const int*)(F.ws + WS_LIST), (const LAS int*)(F.lds + LDS_CTL), 1024, 2, F.G, F.vcu, lat ? 64 : 68, lat, true, (size_t)524288 * 2};
            EpiMoe1 E{(bf16_t*)(F.ws + OV_ACT), (bf16_t*)(F.ws + OV_ACTSH)};
            for (int dd = 0; dd < NDUP(9); ++dd) pg8::gemm_phase(F.lds, 1024, S, E);
        } SEAM(pb + 7);
        if (IN(pb + 8)) {
            build_tables(F, l);
            SchedMoe S{(const char*)(F.ws + OV_ACT), (const char*)(F.ws + OV_ACTSH), (const char*)(F.ws + WS_WM2), (const char*)(F.ws + WS_WSH2) + (size_t)l * 262144 * 2,
                       (const int*)(F.ws + WS_LIST), (const LAS int*)(F.lds + LDS_CTL), 256, 4, F.G, F.vcu, lat ? 64 : 68, lat, false, (size_t)262144 * 2};
            EpiMoe2 E{(unsigned char*)(F.ws + OV_YS), (bf16_t*)(F.ws + WS_H)};
            for (int dd = 0; dd < NDUP(10); ++dd) pg8::gemm_phase(F.lds, 256, S, E);
        } SEAM(pb + 8);
        if (IN(pb + 9)) {
            build_tables(F, l);
            phase_combine(F, A4, l, false);
            if (NDUP(13) > 1) phase_combine(F, A4, l, F.G != 12345);
            if (l == 0) for (int dd = 0; dd < NDUP(15); ++dd) conv_moe_layer(F, A4, 1);
        } SEAM(pb + 9);
    }
    if (TSMASK != 0 && hi - lo == NPHASE) { __syncthreads(); asm volatile("s_waitcnt vmcnt(0)" ::: "memory");
        if (blockIdx.x == 0 && threadIdx.x == 0) { volatile LAS unsigned long long* ts = (volatile LAS unsigned long long*)(F.lds + LDS_CTL + 2048);
            unsigned long long sel = 0; for (int k = 0; k < NPHASE; ++k) if ((TSMASK >> k) & 1) sel += ts[k + 1] - ts[k];
            const float frac = (float)sel / (float)(ts[NPHASE] - ts[0]); args.out[0] += 1.0f + floorf(90.0f * frac + 0.5f); } }
#undef IN
#undef SEAM
}

extern "C" void kernel_launch(void* const* d_in, const int* in_sizes, int n_in, void* d_out, int out_size, void* d_ws, size_t ws_size, hipStream_t stream) {
    static int grid = 0;
    if (grid == 0) {
        if (n_in != 38 || out_size != NBATCH * SEQ * DM || ws_size < WS_END) { fprintf(stderr, "kernel_launch: unexpected shapes (n_in %d out %d ws %zu need %zu)\n", n_in, out_size, ws_size, (size_t)WS_END); grid = -1; return; }
        int dev = 0, cus = 0;
        if (hipGetDevice(&dev) != hipSuccess || hipDeviceGetAttribute(&cus, hipDeviceAttributeMultiprocessorCount, dev) != hipSuccess) { grid = -1; return; }
        if (hipFuncSetAttribute((const void*)mk_fwd, hipFuncAttributeMaxDynamicSharedMemorySize, LDS_BYTES) != hipSuccess) { fprintf(stderr, "kernel_launch: hipFuncSetAttribute failed\n"); grid = -1; return; }
        int per_cu = 0;
        if (hipOccupancyMaxActiveBlocksPerMultiprocessor(&per_cu, (const void*)mk_fwd, NTHR, LDS_BYTES) != hipSuccess || per_cu < 1) fprintf(stderr, "kernel_launch: occupancy query says %d\n", per_cu);
        (void)hipGetLastError();
        grid = cus;
    }
    if (grid < 0) return;
    (void)hipMemsetAsync((char*)d_ws + WS_CTL, 0, CTL_ZERO_BYTES, stream);
    Args a{};
    for (int i = 0; i < 38; ++i) a.in[i] = (const float*)d_in[i];
    a.out = (float*)d_out; a.ws = (unsigned char*)d_ws;
#if MK_MULTI
    for (int p = 0; p < NPHASE; ++p) { a.ph_lo = p; a.ph_hi = p + 1; hipLaunchKernelGGL(mk_fwd, dim3(grid), dim3(NTHR), LDS_BYTES, stream, a); }
#else
    a.ph_lo = 0; a.ph_hi = NPHASE; hipLaunchKernelGGL(mk_fwd, dim3(grid), dim3(NTHR), LDS_BYTES, stream, a);
#endif
}
```

```cpp
#include <hip/hip_runtime.h>
#include <cstdio>
#include <cstdint>
#include <cmath>

#ifndef MK_MULTI
#define MK_MULTI 0
#endif
#ifndef DUPMASK
#define DUPMASK 0
#endif
#define NDUP(c) (1 + ((DUPMASK >> (c)) & 1))
#ifndef TSMASK
#define TSMASK 0
#endif
#ifndef NAIVE_GEMM
#define NAIVE_GEMM 0
#endif

#define LAS __attribute__((address_space(3)))
#define GAS __attribute__((address_space(1)))
typedef unsigned short bf16_t;
typedef short bf16x8 __attribute__((ext_vector_type(8)));
typedef short s16x4 __attribute__((ext_vector_type(4)));
typedef float f32x4 __attribute__((ext_vector_type(4)));
typedef float f32x16 __attribute__((ext_vector_type(16)));
typedef unsigned u32x4 __attribute__((ext_vector_type(4)));
typedef unsigned u32x2 __attribute__((ext_vector_type(2)));

constexpr int DM = 1024, NBATCH = 4, SEQ = 4096, CTX = 256, TPB = SEQ + CTX  , T = NBATCH * TPB  ;
constexpr int INC = 6656, NEXP = 64;
constexpr float DN_ALPHA = 1.41421356237309515f;
constexpr float LN_EPS = 1e-6f, RMS_EPS = 1e-5f;
constexpr int NWAVES = 8, NTHR = 512;

constexpr size_t MiB = 1u << 20;
constexpr size_t WS_CTL = 0, CTL_ZERO_BYTES = 1 * MiB;
constexpr size_t CW_BAR_BYTE = 16384;
constexpr size_t WS_CNT = 65536;
constexpr size_t WS_MOD = 131072;
constexpr size_t WS_ROPE = 1 * MiB;
constexpr size_t WS_LAM = 1 * MiB + 8192;
constexpr size_t WS_SUM = 1 * MiB + 65536;
constexpr size_t WS_HIN = WS_SUM + 2304 * 1024;
constexpr size_t WS_TOKE = 5 * MiB, WS_TOKP = 6 * MiB, WS_TOKW = 7 * MiB;
constexpr size_t WS_LIST = 8 * MiB;
constexpr size_t WS_XC = 13 * MiB;
constexpr size_t WS_WLRU = 17 * MiB;
constexpr size_t WS_WSG = 17 * MiB + 512 * 1024;
constexpr size_t WS_WRT = 17 * MiB + 768 * 1024;
constexpr size_t WS_WSH1 = 18 * MiB;
constexpr size_t WS_WSH2 = 20 * MiB;
constexpr size_t WS_WOUT = 21 * MiB;
constexpr size_t WS_WBR = 25 * MiB;
constexpr size_t WS_WIN = 31 * MiB;
constexpr size_t WS_WM1 = 57 * MiB;
constexpr size_t WS_WM2 = 121 * MiB;
constexpr size_t WS_H = 153 * MiB;
constexpr size_t WS_OV = 187 * MiB;
constexpr size_t OV_Q = WS_OV, OV_K = WS_OV + 17 * MiB, OV_V = WS_OV + 34 * MiB, OV_U = WS_OV + 51 * MiB, OV_S = WS_OV + 68 * MiB,
                 OV_X = WS_OV + 85 * MiB, OV_Y = WS_OV + 102 * MiB, OV_G = WS_OV + 119 * MiB, OV_OA = WS_OV + 221 * MiB,
                 OV_OB = WS_OV + 238 * MiB, OV_OC = WS_OV + 255 * MiB, OV_MG = WS_OV + 272 * MiB;
constexpr size_t OV_ACT = WS_OV, OV_ACTSH = WS_OV + 69 * MiB, OV_YS = WS_OV + 78 * MiB;
constexpr size_t WS_END = WS_OV + 350 * MiB;

constexpr int LDS_SCRATCH = 147456;
constexpr int LDS_CTL = LDS_SCRATCH;
constexpr int LDS_BYTES = LDS_SCRATCH + 4096;
constexpr int LC_BAR = 0;
constexpr int LC_TCNT = 64, LC_TBASE = 64 + 80, LC_SBASE = 64 + 160;

struct Args { const float* in[38]; float* out; unsigned char* ws; int ph_lo, ph_hi; };
typedef const Args __attribute__((address_space(4)))* CArgsP;

__device__ __forceinline__ unsigned f2bf(float f) { unsigned u = __builtin_bit_cast(unsigned, f); return (u + 0x7fffu + ((u >> 16) & 1u)) >> 16; }
typedef float f32x2 __attribute__((ext_vector_type(2))); typedef __bf16 bf16x2_t __attribute__((ext_vector_type(2)));
__device__ __forceinline__ unsigned pk2(float lo, float hi) { const f32x2 v = {lo, hi}; const bf16x2_t b = __builtin_convertvector(v, bf16x2_t); return __builtin_bit_cast(unsigned, b); }
__device__ __forceinline__ float bflo(unsigned w) { return __builtin_bit_cast(float, w << 16); }
__device__ __forceinline__ float bfhi(unsigned w) { return __builtin_bit_cast(float, w & 0xffff0000u); }
__device__ __forceinline__ float bf2f(bf16_t b) { return __builtin_bit_cast(float, (unsigned)b << 16); }
#define WS_DPP(v, ctrl, rmask, bc) __builtin_bit_cast(float, __builtin_amdgcn_update_dpp(0, __builtin_bit_cast(int, v), ctrl, rmask, 0xF, bc))
__device__ __forceinline__ float wave_sum(float v) {
    v += WS_DPP(v, 0xB1, 0xF, true); v += WS_DPP(v, 0x4E, 0xF, true); v += WS_DPP(v, 0x141, 0xF, true); v += WS_DPP(v, 0x140, 0xF, true);
    v += WS_DPP(v, 0x142, 0xA, false); v += WS_DPP(v, 0x143, 0xC, false);
    return __builtin_bit_cast(float, __builtin_amdgcn_readlane(__builtin_bit_cast(int, v), 63));
}
__device__ __forceinline__ float sigmoidf_(float x) { return __builtin_amdgcn_rcpf(1.f + __builtin_amdgcn_exp2f(-1.4426950408889634f * x)); }
__device__ __forceinline__ float gelu_tanh(float x) { const float u = x * (0.7978845608028654f + 0.035677408136300125f * x * x); return x * __builtin_amdgcn_rcpf(1.f + __builtin_amdgcn_exp2f(-2.885390081777927f * u)); }
__device__ __forceinline__ float silu_(float x) { return x * __builtin_amdgcn_rcpf(1.f + __builtin_amdgcn_exp2f(-1.4426950408889634f * x)); }
__device__ __forceinline__ float expm1_fast(float x) {
    if (x > -0.5f && x < 0.5f) { float p = 1.0f + x * (1.0f / 8.0f); p = 1.0f + x * (1.0f / 7.0f) * p; p = 1.0f + x * (1.0f / 6.0f) * p; p = 1.0f + x * 0.2f * p; p = 1.0f + x * 0.25f * p; p = 1.0f + x * (1.0f / 3.0f) * p; p = 1.0f + x * 0.5f * p; return x * p; }
    return expm1f(x);
}
#define LDS_WAIT() asm volatile("s_waitcnt lgkmcnt(0)" ::: "memory")
#define VM_WAIT() asm volatile("s_waitcnt vmcnt(0)" ::: "memory")

#define XB_TMO      128
#define XB_XCNT(j)  (256  + 64 * (j))
#define XB_XSUB(j)  (1280 + 64 * (j))
#define XB_XGEN(j)  (2304 + 64 * (j))
#define XB_TOP      3328
#define XB_TOPGEN   3392
#define XCD_BAR_WORDS 3456
#define XB_SPIN_CAP (1u << 22)
__device__ __forceinline__ unsigned xb_ld(unsigned* p)              { return __hip_atomic_load(p, __ATOMIC_RELAXED, __HIP_MEMORY_SCOPE_AGENT); }
__device__ __forceinline__ unsigned xb_add(unsigned* p, unsigned v) { return __hip_atomic_fetch_add(p, v, __ATOMIC_RELAXED, __HIP_MEMORY_SCOPE_AGENT); }
__device__ __forceinline__ unsigned xb_xcc_id() { return (unsigned)__builtin_amdgcn_s_getreg((3 << 11) | 20) & 0xFu; }
#define XB_SPIN(cond, bar) do { unsigned _sp = 0; while (cond) { __builtin_amdgcn_s_sleep(1); \
    if ((++_sp & 255u) == 0u) { if (xb_ld(&(bar)[XB_TMO])) break; if (_sp > XB_SPIN_CAP) { atomicAdd(&(bar)[XB_TMO], 1u); break; } } } } while (0)
struct XcdBarrier { unsigned* bar; unsigned x; volatile LAS unsigned* st; };
__device__ __forceinline__ XcdBarrier xcd_barrier_post(unsigned* bar, volatile LAS unsigned* st) {
    XcdBarrier b; b.bar = bar; b.x = xb_xcc_id(); b.st = st;
    if (threadIdx.x == 0) (void)xb_add(&bar[XB_XCNT(b.x)], 1u);
    return b;
}
__device__ __forceinline__ void xcd_barrier_complete(unsigned* bar, unsigned x, unsigned& nloc, unsigned& nx) {
    const unsigned G = gridDim.x * gridDim.y * gridDim.z;
    unsigned sum, cnt, mine, sp = 0u;
    for (;;) {
        sum = 0u; cnt = 0u; mine = 0u;
#pragma unroll
        for (unsigned j = 0; j < 16; ++j) { const unsigned c = xb_ld(&bar[XB_XCNT(j)]); sum += c; cnt += (c > 0u) ? 1u : 0u; mine = (j == x) ? c : mine; }
        if (sum == G) break;
        __builtin_amdgcn_s_sleep(1);
        if ((++sp & 255u) == 0u) { if (xb_ld(&bar[XB_TMO])) break; if (sp > XB_SPIN_CAP) { atomicAdd(&bar[XB_TMO], 1u); break; } }
    }
    nloc = mine > 0u ? mine : 1u; nx = cnt > 0u ? cnt : 1u;
}
__device__ __forceinline__ void xcd_barrier(const XcdBarrier& b) {
    asm volatile("s_waitcnt vmcnt(0)" ::: "memory");
    __syncthreads();
    if (threadIdx.x == 0) {
        unsigned* bar = b.bar; asm volatile("" : "+s"(bar));
        __builtin_amdgcn_s_waitcnt(0);
        unsigned nloc = b.st[0], nx = b.st[1];
        if (nloc == 0u) { xcd_barrier_complete(bar, b.x, nloc, nx); b.st[0] = nloc; b.st[1] = nx; }
        const unsigned old = xb_add(&bar[XB_XSUB(b.x)], 1u);
        const unsigned gen = old / nloc;
        if (old + 1u == (gen + 1u) * nloc) {
            __builtin_amdgcn_fence(__ATOMIC_RELEASE, "agent");
            asm volatile("s_waitcnt vmcnt(0)" ::: "memory");
            const unsigned og = xb_add(&bar[XB_TOP], 1u);
            const unsigned tg = og / nx;
            if (og + 1u == (tg + 1u) * nx) xb_add(&bar[XB_TOPGEN], 1u);
            else XB_SPIN(xb_ld(&bar[XB_TOPGEN]) == tg, bar);
            __builtin_amdgcn_fence(__ATOMIC_ACQUIRE, "agent");
            xb_add(&bar[XB_XGEN(b.x)], 1u);
            asm volatile("s_waitcnt vmcnt(0)" ::: "memory");
        } else {
            XB_SPIN(xb_ld(&bar[XB_XGEN(b.x)]) == gen, bar);
            __builtin_amdgcn_fence(__ATOMIC_ACQUIRE, "agent");
            asm volatile("s_waitcnt vmcnt(0)" ::: "memory");
        }
    }
    __syncthreads();
}

namespace pg8 {
constexpr int BM = 256, BK = 64, HALF = 128, HTB = HALF * BK * 2, STAGE_BYTES = 8 * HTB, NXCD = 8, WGM = 8;
__host__ __device__ __forceinline__ int lds_byte(int r, int c) { const int st = (r >> 4) * 2 + (c >> 5), rr = r & 15, cc = c & 31, ob = rr * 64 + cc * 2; return st * 1024 + (ob ^ (((ob >> 9) & 1) << 5)); }
__host__ __device__ __forceinline__ void stage_rc(int b, int& R, int& C) { const int st = b / 1024, sb = b % 1024, swz = sb ^ (((sb >> 9) & 1) << 5); R = (st >> 1) * 16 + swz / 64; C = (st & 1) * 32 + (swz % 64) / 2; }
__host__ __device__ __forceinline__ int perm32(int rho) { const int n = rho >> 4, i = rho & 15; return 8 * (i >> 2) + 4 * n + (i & 3); }
struct Unit { int pm, pn, e, ti, nrows, row0; };
typedef f32x4 Acc[2][2][4][2];

template <class Epi, class Sched>
__device__ __forceinline__ void gemm_phase(LAS unsigned char* lds, const int K, const Sched& S, const Epi& E) {
    int tid_ = threadIdx.x; asm volatile("" : "+v"(tid_));
    const int tid = tid_, wid = __builtin_amdgcn_readfirstlane(tid >> 6), lane = tid & 63, wr = wid >> 2, wc = wid & 3, fr = lane & 15, fq = lane >> 4;
    (void)fr; (void)fq; (void)wc;
    Unit cur, nxt; int ui = 0;
    if (!S.next(0, cur)) return;
    Acc acc;
#pragma unroll
    for (int a = 0; a < 2; ++a)
#pragma unroll
        for (int b = 0; b < 2; ++b)
#pragma unroll
            for (int m = 0; m < 4; ++m)
#pragma unroll
                for (int n = 0; n < 2; ++n) acc[a][b][m][n] = (f32x4){0.f, 0.f, 0.f, 0.f};
#if NAIVE_GEMM
    for (;;) {
        const char* Ab = S.a_base(); const char* Bb = S.b_ptr(cur);
#pragma unroll 1
        for (int ai = 0; ai < 2; ++ai)
#pragma unroll 1
            for (int m = 0; m < 4; ++m) {
                const int rr = ai * 128 + wr * 64 + m * 16 + fr;
                const bf16_t* ap = (const bf16_t*)(Ab + S.a_off(cur, rr));
#pragma unroll
                for (int bj = 0; bj < 2; ++bj)
#pragma unroll
                    for (int n = 0; n < 2; ++n)
#pragma unroll
                        for (int j = 0; j < 4; ++j) {
                            const int cc = Epi::PERM ? bj * 128 + wc * 32 + fq * 8 + n * 4 + j : bj * 128 + wc * 32 + n * 16 + fq * 4 + j;
                            const bf16_t* bp = (const bf16_t*)(Bb + (size_t)cc * K * 2);
                            float s = 0.f;
                            for (int k = 0; k < K; k += 8) {
                                const u32x4 av = *(const u32x4*)(ap + k), bv = *(const u32x4*)(bp + k);
                                s += bflo(av.x) * bflo(bv.x) + bfhi(av.x) * bfhi(bv.x) + bflo(av.y) * bflo(bv.y) + bfhi(av.y) * bfhi(bv.y)
                                   + bflo(av.z) * bflo(bv.z) + bfhi(av.z) * bfhi(bv.z) + bflo(av.w) * bflo(bv.w) + bfhi(av.w) * bfhi(bv.w);
                            }
                            acc[ai][bj][m][n][j] = s;
                        }
            }
        E(acc, cur, wr, wc, fr, fq);
        ++ui;
        if (!S.next(ui, cur)) break;
    }
    return;
#else
    const int nt = K / BK;
    unsigned voffB[2];
    { int Rr[2], Cc[2];
#pragma unroll
      for (int i = 0; i < 2; ++i) { stage_rc(tid * 16 + i * 8192, Rr[i], Cc[i]); const int Rb = Epi::PERM ? ((Rr[i] & ~31) + perm32(Rr[i] & 31)) : Rr[i]; voffB[i] = (unsigned)(Rb * K + Cc[i]) * 2u; } }
#define PG8_AOFFS(U, o00, o01, o10, o11) do { int t3_ = threadIdx.x; asm volatile("" : "+v"(t3_)); int R0_, C0_, R1_, C1_; stage_rc(t3_ * 16, R0_, C0_); stage_rc(t3_ * 16 + 8192, R1_, C1_); \
        o00 = S.a_off(U, R0_) + (unsigned)C0_ * 2u; o01 = S.a_off(U, R1_) + (unsigned)C1_ * 2u; o10 = S.a_off(U, HALF + R0_) + (unsigned)C0_ * 2u; o11 = S.a_off(U, HALF + R1_) + (unsigned)C1_ * 2u; } while (0)
    const size_t kstep = (size_t)(BK * 2);
    const size_t hstep = (size_t)HALF * K * 2;
    const unsigned ldsw = (unsigned)wid * 1024u;
    const int aoff = lds_byte(wr * 64 + fr, fq * 8), boff = lds_byte(wc * 32 + fr, fq * 8);
#define PG8_SA(b, h) (((b) * 2 + (h)) * HTB)
#define PG8_SB(b, h) ((4 + (b) * 2 + (h)) * HTB)
#define PG8_STAGE(bufoff, gbase, v0, v1) do { \
        __builtin_amdgcn_global_load_lds((const unsigned*)((const char*)(gbase) + (v0)), (LAS unsigned*)(lds + (bufoff) + ldsw), 16, 0, 0); \
        __builtin_amdgcn_global_load_lds((const unsigned*)((const char*)(gbase) + (v1)), (LAS unsigned*)(lds + (bufoff) + ldsw + 8192), 16, 0, 0); } while (0)
#define PG8_LDA(dst, b, h) do { _Pragma("unroll") for (int m = 0; m < 4; ++m) _Pragma("unroll") for (int k = 0; k < 2; ++k) dst[m][k] = *(const LAS bf16x8*)(lds + PG8_SA(b, h) + aoff + m * 2048 + k * 1024); } while (0)
#define PG8_LDB(dst, b, h) do { _Pragma("unroll") for (int n = 0; n < 2; ++n) _Pragma("unroll") for (int k = 0; k < 2; ++k) dst[n][k] = *(const LAS bf16x8*)(lds + PG8_SB(b, h) + boff + n * 2048 + k * 1024); } while (0)
#define PG8_MMA(ai, bj, At, Bt) do { __builtin_amdgcn_s_setprio(1); _Pragma("unroll") for (int m = 0; m < 4; ++m) _Pragma("unroll") for (int n = 0; n < 2; ++n) _Pragma("unroll") for (int k = 0; k < 2; ++k) \
        acc[ai][bj][m][n] = __builtin_amdgcn_mfma_f32_16x16x32_bf16(Bt[n][k], At[m][k], acc[ai][bj][m][n], 0, 0, 0); __builtin_amdgcn_s_setprio(0); } while (0)
#define PG8_WAIT_V(n) asm volatile("s_waitcnt vmcnt(" #n ")" ::: "memory")
#define PG8_WAIT_L(n) asm volatile("s_waitcnt lgkmcnt(" #n ")" ::: "memory")
#define PG8_BAR __builtin_amdgcn_s_barrier()
#define PG8_SCHED __builtin_amdgcn_sched_barrier(0)
    bf16x8 At[4][2], B0[2][2], B1[2][2];
    const char* const Ab = S.a_base();
    unsigned vA00, vA01, vA10, vA11;
    PG8_AOFFS(cur, vA00, vA01, vA10, vA11);
    const char* cB = S.b_ptr(cur);
    PG8_STAGE(PG8_SB(0, 0), cB, voffB[0], voffB[1]); PG8_STAGE(PG8_SB(0, 1), cB + hstep, voffB[0], voffB[1]); PG8_STAGE(PG8_SA(0, 0), Ab, vA00, vA01); PG8_STAGE(PG8_SA(0, 1), Ab, vA10, vA11);
    if (wr == 1) PG8_BAR;
    PG8_WAIT_V(2); PG8_BAR;
    PG8_STAGE(PG8_SB(1, 0), cB + kstep, voffB[0], voffB[1]); PG8_STAGE(PG8_SA(1, 0), Ab + kstep, vA00, vA01); PG8_STAGE(PG8_SB(1, 1), cB + hstep + kstep, voffB[0], voffB[1]);
    PG8_WAIT_V(6); PG8_BAR;
    for (;;) {
        const bool has_next = S.next(ui + 1, nxt);
        unsigned vN00 = vA00, vN01 = vA01, vN10 = vA10, vN11 = vA11; const char* nB = cB;
        if (has_next) { PG8_AOFFS(nxt, vN00, vN01, vN10, vN11); nB = S.b_ptr(nxt); }
        for (int t = 0; t < nt; t += 2) {
            const bool last = (t == nt - 2);
            const char* a1 = Ab + (size_t)(t + 1) * kstep;
            const char* a2 = last ? Ab : Ab + (size_t)(t + 2) * kstep; const char* b2 = last ? nB : cB + (size_t)(t + 2) * kstep;
            const char* a3 = a2 + kstep; const char* b3 = b2 + kstep;
            const unsigned w00 = last ? vN00 : vA00, w01 = last ? vN01 : vA01, w10 = last ? vN10 : vA10, w11 = last ? vN11 : vA11;
            PG8_LDB(B0, 0, 0); PG8_LDB(B1, 0, 1); PG8_SCHED; PG8_LDA(At, 0, 0); PG8_STAGE(PG8_SA(1, 1), a1, vA10, vA11);
            PG8_WAIT_V(8); PG8_WAIT_L(0); PG8_BAR; PG8_MMA(0, 0, At, B0); PG8_MMA(0, 1, At, B1); PG8_BAR; PG8_SCHED;
            PG8_LDA(At, 0, 1); PG8_STAGE(PG8_SB(0, 0), b2, voffB[0], voffB[1]); PG8_STAGE(PG8_SB(0, 1), b2 + hstep, voffB[0], voffB[1]); PG8_STAGE(PG8_SA(0, 0), a2, w00, w01);
            PG8_WAIT_V(8); PG8_WAIT_L(0); PG8_BAR; PG8_MMA(1, 0, At, B0); PG8_MMA(1, 1, At, B1); PG8_BAR; PG8_SCHED;
            PG8_LDB(B0, 1, 0); PG8_LDB(B1, 1, 1); PG8_SCHED; PG8_LDA(At, 1, 0); PG8_STAGE(PG8_SA(0, 1), a2, w10, w11);
            PG8_WAIT_V(8); PG8_WAIT_L(0); PG8_BAR; PG8_MMA(0, 0, At, B0); PG8_MMA(0, 1, At, B1); PG8_BAR; PG8_SCHED;
            PG8_LDA(At, 1, 1); PG8_STAGE(PG8_SB(1, 0), b3, voffB[0], voffB[1]); PG8_STAGE(PG8_SB(1, 1), b3 + hstep, voffB[0], voffB[1]); PG8_STAGE(PG8_SA(1, 0), a3, w00, w01);
            PG8_WAIT_V(8); PG8_WAIT_L(0); PG8_BAR; PG8_MMA(1, 0, At, B0); PG8_MMA(1, 1, At, B1); PG8_BAR; PG8_SCHED;
        }
        if (wr == 0) PG8_BAR;
        { int t2_ = threadIdx.x; asm volatile("" : "+v"(t2_)); const int l2_ = t2_ & 63; E(acc, cur, wr, wc, l2_ & 15, l2_ >> 4); }
        if (!has_next) break;
#pragma unroll
        for (int a = 0; a < 2; ++a)
#pragma unroll
            for (int b = 0; b < 2; ++b)
#pragma unroll
                for (int m = 0; m < 4; ++m)
#pragma unroll
                    for (int n = 0; n < 2; ++n) acc[a][b][m][n] = (f32x4){0.f, 0.f, 0.f, 0.f};
        cur = nxt; vA00 = vN00; vA01 = vN01; vA10 = vN10; vA11 = vN11; cB = nB; ++ui;
        if (wr == 1) PG8_BAR;
    }
    PG8_WAIT_V(0);
    PG8_BAR;
#undef PG8_SA
#undef PG8_AOFFS
#undef PG8_SB
#undef PG8_STAGE
#undef PG8_LDA
#undef PG8_LDB
#undef PG8_MMA
#undef PG8_WAIT_V
#undef PG8_WAIT_L
#undef PG8_BAR
#undef PG8_SCHED
#endif
}
}
using pg8::Unit;
using pg8::Acc;

__device__ __forceinline__ float* resid_row(float* out, float* xc, int tok) {
    const int b = tok / TPB, j = tok - b * TPB;
    return j < CTX ? xc + ((size_t)(b * CTX + j)) * DM : out + ((size_t)(b * SEQ + j - CTX)) * DM;
}
__device__ __forceinline__ int tile_to_pm(int i, bool latent_only) { return latent_only ? (i >> 4) * 17 + 1 + (i & 15) : i; }

__device__ __forceinline__ bool static_order(int i, int G, int c, int nM, int nN, int& pm, int& pn) {
    const int nwg = nM * nN; const long L = (long)i * G + c; if (L >= nwg) return false;
    int wgid = (int)L; { const int q = nwg / 8, r = nwg % 8, xcd = wgid % 8, off = wgid / 8; wgid = (xcd < r ? xcd * (q + 1) : r * (q + 1) + (xcd - r) * q) + off; }
    const int nig = 8 * nN, gid = wgid / nig, fm = gid * 8, gsz = (nM - fm) < 8 ? (nM - fm) : 8;
    pm = fm + ((wgid % nig) % gsz); pn = (wgid % nig) / gsz; return true;
}

struct SchedPlain {
    const char* A; const char* Bt; int K, nM, nN, G, c; bool lat;
    __device__ __forceinline__ bool next(int i, Unit& u) const {
        int pm, pn; if (!static_order(i, G, c, nM, nN, pm, pn)) return false;
        u.pm = tile_to_pm(pm, lat); u.pn = pn; u.e = 0; u.ti = 0; u.nrows = 256; u.row0 = u.pm * 256; return true;
    }
    __device__ __forceinline__ const char* a_base() const { return A; }
    __device__ __forceinline__ unsigned a_off(const Unit& u, int rr) const { return (unsigned)(u.row0 + rr) * (unsigned)(K * 2); }
    __device__ __forceinline__ const char* b_ptr(const Unit& u) const { return Bt + (size_t)u.pn * 256 * K * 2; }
};

struct SchedMerge {
    const char* A0; const char* Bt0; int G, c;
    __device__ __forceinline__ bool next(int i, Unit& u) const {
        const int ti = i / 3, r = i - 3 * ti; int pm, pn; if (!static_order(ti, G, c, 64, 4, pm, pn)) return false;
        u.pm = tile_to_pm(pm, true); u.pn = pn; u.e = r; u.ti = 0; u.nrows = 256; u.row0 = u.pm * 256; return true;
    }
    __device__ __forceinline__ const char* a_base() const { return A0; }
    __device__ __forceinline__ unsigned a_off(const Unit& u, int rr) const { return (unsigned)u.e * (unsigned)(17 * MiB) + (unsigned)(u.row0 + rr) * 1024u; }
    __device__ __forceinline__ const char* b_ptr(const Unit& u) const { return Bt0 + ((size_t)u.e * 1024 * 512 + (size_t)u.pn * 256 * 512) * 2; }
};

struct SchedMoe {
    const char* A;
    const char* Ash;
    const char* Bt; const char* Btsh; const int* list;
    const LAS int* tb;
    int K, nN, G, c, nsh; bool lat, gather; size_t bstride;
    __device__ __forceinline__ bool next(int i, Unit& u) const {
        const int nrt = tb[LC_TBASE + 64], L = i * G + c, tot = (nrt + nsh) * nN;
        if (L >= tot) return false;
        const int rt = L / nN; u.pn = L - rt * nN;
        if (rt < nrt) {
            int e = 0;
#pragma unroll 1
            for (int s = 32; s > 0; s >>= 1) if (e + s < 64 && tb[LC_TBASE + e + s] <= rt) e += s;
            u.e = e; u.ti = rt - tb[LC_TBASE + e]; const int cnt = tb[LC_TCNT + e]; const int rem = cnt - u.ti * 256;
            u.nrows = rem < 256 ? rem : 256; u.row0 = tb[LC_SBASE + e] + u.ti * 256; u.pm = 0;
        } else { u.e = 64; u.ti = rt - nrt; u.pm = tile_to_pm(u.ti, lat); u.nrows = 256; u.row0 = u.pm * 256; }
        return true;
    }
    __device__ __forceinline__ const char* a_base() const { return A; }
    __device__ __forceinline__ unsigned a_off(const Unit& u, int rr) const {
        if (u.e == 64) return (unsigned)(Ash - A) + (unsigned)(u.row0 + rr) * (unsigned)(K * 2);
        if (gather) { const int r2 = rr < u.nrows ? rr : u.nrows - 1; const int tok = list[(size_t)u.e * T + u.ti * 256 + r2]; return (unsigned)tok * (unsigned)(K * 2); }
        return (unsigned)(u.row0 + rr) * (unsigned)(K * 2);
    }
    __device__ __forceinline__ const char* b_ptr(const Unit& u) const { return (u.e == 64 ? Btsh : Bt + (size_t)u.e * bstride) + (size_t)u.pn * 256 * K * 2; }
};

#define EPI_FOR_ROWS  _Pragma("unroll") for (int ai = 0; ai < 2; ++ai) _Pragma("unroll") for (int m = 0; m < 4; ++m)
#define EPI_FOR_COLS  _Pragma("unroll") for (int bj = 0; bj < 2; ++bj) _Pragma("unroll") for (int n = 0; n < 2; ++n)

struct EpiInproj {
    static constexpr bool PERM = false;
    unsigned char* ws; const float* bias; const float* rope;
    __device__ __forceinline__ void operator()(const Acc& acc, const Unit& u, int wr, int wc, int fr, int fq) const {
        const int pn = u.pn; const bool isg = pn >= 14; const int seg = pn >> 1;
        bf16_t* base = (bf16_t*)(ws + (isg ? OV_G : OV_Q + (size_t)seg * 17 * MiB));
        const int ld = isg ? 3072 : 512, coff = isg ? (pn - 14) * 256 : (pn & 1) * 256;
        const bool latent = (u.pm % 17) != 0;
        f32x4 bv[2][2];
        EPI_FOR_COLS bv[bj][n] = *(const f32x4*)(bias + pn * 256 + bj * 128 + wc * 32 + n * 16 + fq * 4);
        EPI_FOR_ROWS {
            const int row = u.row0 + ai * 128 + wr * 64 + m * 16 + fr;
            bf16_t* rp = base + (size_t)row * ld + coff + wc * 32 + fq * 4;
            f32x4 v[2][2];
            EPI_FOR_COLS v[bj][n] = acc[ai][bj][m][n] + bv[bj][n];
            if (seg < 2 && !isg) {
                if (latent) {
                    const int pos = (row % TPB) - CTX; const int pa = (wc & 1) ? (pos & 63) : (pos >> 6);
                    const f32x4 c0 = *(const f32x4*)(rope + (pa * 16 + fq * 4) * 2), c1 = *(const f32x4*)(rope + (pa * 16 + fq * 4) * 2 + 4);
                    const float cs[4] = {c0[0], c0[2], c1[0], c1[2]}, sn[4] = {c0[1], c0[3], c1[1], c1[3]};
#pragma unroll
                    for (int bj = 0; bj < 2; ++bj)
#pragma unroll
                        for (int j = 0; j < 4; ++j) { const float a = v[bj][0][j], b = v[bj][1][j]; v[bj][0][j] = a * cs[j] - b * sn[j]; v[bj][1][j] = b * cs[j] + a * sn[j]; }
                }
                if (seg == 0) { EPI_FOR_COLS v[bj][n] = v[bj][n] * (0.125f * 1.4426950408889634f); }
            } else if (isg) {
                EPI_FOR_COLS {
#pragma unroll
                    for (int j = 0; j < 4; ++j) v[bj][n][j] = sigmoidf_(v[bj][n][j]); }
            } else if (seg == 3 || seg == 4 || seg == 6) {
                EPI_FOR_COLS {
#pragma unroll
                    for (int j = 0; j < 4; ++j) v[bj][n][j] = gelu_tanh(v[bj][n][j]); }
            }
            EPI_FOR_COLS { u32x2 w; w.x = pk2(v[bj][n][0], v[bj][n][1]); w.y = pk2(v[bj][n][2], v[bj][n][3]); *(u32x2*)(rp + bj * 128 + n * 16) = w; }
        }
    }
};

struct EpiMerge {
    static constexpr bool PERM = true;
    bf16_t* mg; const bf16_t* gate;
    __device__ __forceinline__ void operator()(const Acc& acc, const Unit& u, int wr, int wc, int fr, int fq) const {
        const int r = u.e;
#pragma unroll
        for (int ai = 0; ai < 2; ++ai) {
            const size_t rbase = (size_t)(u.row0 + ai * 128 + wr * 64 + fr); const int col = u.pn * 256 + wc * 32 + fq * 8;
            u32x4 g[4][2], o[4][2];
#pragma unroll
            for (int m = 0; m < 4; ++m)
#pragma unroll
                for (int bj = 0; bj < 2; ++bj) { g[m][bj] = *(const u32x4*)(gate + (rbase + m * 16) * 3072 + r * 1024 + col + bj * 128);
                    if (r > 0) o[m][bj] = *(const u32x4*)(mg + (rbase + m * 16) * DM + col + bj * 128); else o[m][bj] = (u32x4){0u, 0u, 0u, 0u}; }
#pragma unroll
            for (int m = 0; m < 4; ++m)
#pragma unroll
                for (int bj = 0; bj < 2; ++bj) { const u32x4 gg = g[m][bj], oo = o[m][bj]; const f32x4 v0 = acc[ai][bj][m][0], v1 = acc[ai][bj][m][1];
                    u32x4 w; w.x = pk2(v0[0] * bflo(gg.x) + bflo(oo.x), v0[1] * bfhi(gg.x) + bfhi(oo.x)); w.y = pk2(v0[2] * bflo(gg.y) + bflo(oo.y), v0[3] * bfhi(gg.y) + bfhi(oo.y));
                    w.z = pk2(v1[0] * bflo(gg.z) + bflo(oo.z), v1[1] * bfhi(gg.z) + bfhi(oo.z)); w.w = pk2(v1[2] * bflo(gg.w) + bflo(oo.w), v1[3] * bfhi(gg.w) + bfhi(oo.w));
                    *(u32x4*)(mg + (rbase + m * 16) * DM + col + bj * 128) = w; }
        }
    }
};

struct EpiWout {
    static constexpr bool PERM = true;
    float* out; float* xc; const float* modl; bool dry;
    __device__ __forceinline__ void operator()(const Acc& acc, const Unit& u, int wr, int wc, int fr, int fq) const {
        const int b = u.pm / 17; const int bsel = (u.pm % 17) == 0 ? 4 : b;
        const float* g1 = modl + bsel * 6144 + 2048;
        f32x4 gv[2][2];
        EPI_FOR_COLS gv[bj][n] = *(const f32x4*)(g1 + u.pn * 256 + bj * 128 + wc * 32 + fq * 8 + n * 4);
#pragma unroll
        for (int ai = 0; ai < 2; ++ai) {
            bf16_t* rp[4]; u32x4 x[4][2];
#pragma unroll
            for (int m = 0; m < 4; ++m) { rp[m] = (bf16_t*)resid_row(out, xc, u.row0 + ai * 128 + wr * 64 + m * 16 + fr) + u.pn * 256 + wc * 32 + fq * 8;
#pragma unroll
                for (int bj = 0; bj < 2; ++bj) x[m][bj] = *(const u32x4*)(rp[m] + bj * 128); }
#pragma unroll
            for (int m = 0; m < 4; ++m)
#pragma unroll
                for (int bj = 0; bj < 2; ++bj) { const u32x4 xx = x[m][bj]; const f32x4 a0 = acc[ai][bj][m][0] * gv[bj][0], a1 = acc[ai][bj][m][1] * gv[bj][1];
                    u32x4 w; w.x = pk2(bflo(xx.x) * DN_ALPHA + a0[0], bfhi(xx.x) * DN_ALPHA + a0[1]); w.y = pk2(bflo(xx.y) * DN_ALPHA + a0[2], bfhi(xx.y) * DN_ALPHA + a0[3]);
                    w.z = pk2(bflo(xx.z) * DN_ALPHA + a1[0], bfhi(xx.z) * DN_ALPHA + a1[1]); w.w = pk2(bflo(xx.w) * DN_ALPHA + a1[2], bfhi(xx.w) * DN_ALPHA + a1[3]);
                    if (!dry) *(u32x4*)(rp[m] + bj * 128) = w; else asm volatile("" :: "v"(w)); }
        }
    }
};

struct EpiMoe1 {
    static constexpr bool PERM = true;
    bf16_t* act; bf16_t* actsh;
    __device__ __forceinline__ void operator()(const Acc& acc, const Unit& u, int wr, int wc, int fr, int fq) const {
        bf16_t* base = u.e == 64 ? actsh : act;
        EPI_FOR_ROWS {
            const int rl = ai * 128 + wr * 64 + m * 16 + fr;
            if (rl < u.nrows) {
                const f32x4 g0 = acc[ai][0][m][0], g1 = acc[ai][0][m][1], p0 = acc[ai][1][m][0], p1 = acc[ai][1][m][1];
                u32x4 w; w.x = pk2(silu_(g0[0]) * p0[0], silu_(g0[1]) * p0[1]); w.y = pk2(silu_(g0[2]) * p0[2], silu_(g0[3]) * p0[3]);
                w.z = pk2(silu_(g1[0]) * p1[0], silu_(g1[1]) * p1[1]); w.w = pk2(silu_(g1[2]) * p1[2], silu_(g1[3]) * p1[3]);
                *(u32x4*)(base + (size_t)(u.row0 + rl) * 256 + u.pn * 128 + wc * 32 + fq * 8) = w;
            }
        }
    }
};

struct EpiMoe2 {
    static constexpr bool PERM = true;
    unsigned char* ys; bf16_t* sho;
    __device__ __forceinline__ void operator()(const Acc& acc, const Unit& u, int wr, int wc, int fr, int fq) const {
        EPI_FOR_ROWS {
            const int rl = ai * 128 + wr * 64 + m * 16 + fr;
            if (rl < u.nrows) {
                if (u.e == 64) {
                    bf16_t* rp = sho + (size_t)(u.row0 + rl) * DM + u.pn * 256 + wc * 32 + fq * 8;
#pragma unroll
                    for (int bj = 0; bj < 2; ++bj) { const f32x4 v0 = acc[ai][bj][m][0], v1 = acc[ai][bj][m][1];
                        u32x4 w; w.x = pk2(v0[0], v0[1]); w.y = pk2(v0[2], v0[3]); w.z = pk2(v1[0], v1[1]); w.w = pk2(v1[2], v1[3]); *(u32x4*)(rp + bj * 128) = w; }
                } else {
                    unsigned char* rp = ys + (size_t)(u.row0 + rl) * DM + u.pn * 256 + wc * 32 + fq * 8;
#pragma unroll
                    for (int bj = 0; bj < 2; ++bj) { const f32x4 v0 = acc[ai][bj][m][0] * 16.0f, v1 = acc[ai][bj][m][1] * 16.0f;
                        int w0 = 0, w1 = 0;
                        w0 = __builtin_amdgcn_cvt_pk_fp8_f32(v0[0], v0[1], w0, false); w0 = __builtin_amdgcn_cvt_pk_fp8_f32(v0[2], v0[3], w0, true);
                        w1 = __builtin_amdgcn_cvt_pk_fp8_f32(v1[0], v1[1], w1, false); w1 = __builtin_amdgcn_cvt_pk_fp8_f32(v1[2], v1[3], w1, true);
                        *(u32x2*)(rp + bj * 128) = (u32x2){(unsigned)w0, (unsigned)w1}; }
                }
            }
        }
    }
};

struct Frame {
    LAS unsigned char* lds; int tid, lane, wave, G, bid, gw, NGW, vcu;
    unsigned char* ws; float* out;
};

__device__ __forceinline__ void transpose_item(const float* W, int ldw, int k0, int n0, bf16_t* WT, int ldt, int drow0, LAS float* scr, int lane) {
    const int lk = lane >> 4, n4 = (lane & 15) * 4;
#pragma unroll 8
    for (int i = 0; i < 16; ++i) { const int k = 4 * i + lk; const f32x4 v = *(const f32x4*)(W + (size_t)(k0 + k) * ldw + n0 + n4);
        *(LAS f32x4*)(scr + k * 64 + (n4 ^ (((k >> 3) & 7) << 2))) = v; }
    LDS_WAIT(); asm volatile("" ::: "memory");
    const int c = lane & 7;
#pragma unroll
    for (int j = 0; j < 8; ++j) { const int n = (lane >> 3) + 8 * j; const LAS float* sp = scr + (8 * c) * 64 + (n ^ (c << 2));
        u32x4 o; o.x = pk2(sp[0 * 64], sp[1 * 64]); o.y = pk2(sp[2 * 64], sp[3 * 64]); o.z = pk2(sp[4 * 64], sp[5 * 64]); o.w = pk2(sp[6 * 64], sp[7 * 64]);
        *(u32x4*)(WT + (size_t)(drow0 + n) * ldt + k0 + 8 * c) = o; }
    LDS_WAIT(); asm volatile("" ::: "memory");
}
__device__ __forceinline__ void conv_expert_item(const float* wg, const float* wu, const float* wd, bf16_t* t1, bf16_t* t2, int which, int rr, LAS float* scr, int lane) {
    if (which < 2) { const int kb = rr >> 2, nb = rr & 3, n0 = 64 * nb;
        transpose_item(which == 0 ? wg : wu, 256, 64 * kb, n0, t1, 1024, (n0 >> 7) * 256 + (n0 & 127) + which * 128, scr, lane);
    } else { const int kb = rr >> 4, nb = rr & 15; transpose_item(wd, 1024, 64 * kb, 64 * nb, t2, 256, 64 * nb, scr, lane); }
}
__device__ __forceinline__ void conv_moe_layer(const Frame& F, CArgsP a, int l) {
    LAS float* scr = (LAS float*)(F.lds + F.wave * 16384);
    for (int it = F.gw; it < 64 * 3 * 64; it += F.NGW) {
        const int idx = it >> 6, e = idx / 3, which = idx - e * 3, rr = it & 63; const size_t eo = (size_t)(l * 64 + e) * 262144;
        conv_expert_item(a->in[30] + eo, a->in[31] + eo, a->in[32] + eo, (bf16_t*)(F.ws + WS_WM1) + (size_t)e * 524288, (bf16_t*)(F.ws + WS_WM2) + (size_t)e * 262144, which, rr, scr, F.lane);
    }
}

__device__ __forceinline__ void phase_prologue(const Frame& F, CArgsP a) {
    LAS float* scr = (LAS float*)(F.lds + F.wave * 16384);
    constexpr int I_IN = 2 * 1664, I_BR = 6 * 128, I_OUT = 2 * 256, I_SH = 6 * 64;
    for (int it0 = F.gw; it0 < I_IN + I_BR + I_OUT + I_SH; it0 += F.NGW) {
        int it = it0;
        if (it < I_IN) { const int l = it / 1664, r = it - l * 1664, kb = r / 104, nb = r - kb * 104;
            transpose_item(a->in[6] + (size_t)l * 1024 * INC, INC, 64 * kb, 64 * nb, (bf16_t*)(F.ws + WS_WIN) + (size_t)l * INC * 1024, 1024, 64 * nb, scr, F.lane); continue; }
        it -= I_IN;
        if (it < I_BR) { const int idx = it >> 7, rr = it & 127, kb = rr >> 4, nb = rr & 15;
            transpose_item(a->in[24] + (size_t)idx * 512 * 1024, 1024, 64 * kb, 64 * nb, (bf16_t*)(F.ws + WS_WBR) + (size_t)idx * 1024 * 512, 512, 64 * nb, scr, F.lane); continue; }
        it -= I_BR;
        if (it < I_OUT) { const int l = it >> 8, rr = it & 255, kb = rr >> 4, nb = rr & 15;
            transpose_item(a->in[25] + (size_t)l * 1048576, 1024, 64 * kb, 64 * nb, (bf16_t*)(F.ws + WS_WOUT) + (size_t)l * 1048576, 1024, 64 * nb, scr, F.lane); continue; }
        it -= I_OUT;
        { const int idx = it >> 6, l = idx / 3, which = idx - l * 3, rr = it & 63; const size_t lo = (size_t)l * 262144;
          conv_expert_item(a->in[33] + lo, a->in[34] + lo, a->in[35] + lo, (bf16_t*)(F.ws + WS_WSH1) + (size_t)l * 524288, (bf16_t*)(F.ws + WS_WSH2) + (size_t)l * 262144, which, rr, scr, F.lane); }
    }
    conv_moe_layer(F, a, 0);
    { const int gt = F.bid * NTHR + F.tid, NG = F.G * NTHR;
      bf16_t* wl = (bf16_t*)(F.ws + WS_WLRU);
      for (int i = gt; i < 2 * 2 * 2 * 8 * 4096; i += NG) {
          const int ii = i & 63, j = (i >> 6) & 63, cb = (i >> 12) & 7, ax = (i >> 15) & 1, d = (i >> 16) & 1, l = i >> 17;
          const float* src = ax == 0 ? a->in[19] : a->in[21];
          wl[i] = (bf16_t)f2bf(src[(size_t)((l * 2 + d) * 8 + cb) * 4096 + ii * 64 + j]); }
      bf16_t* wrt = (bf16_t*)(F.ws + WS_WRT);
      for (int i = gt; i < 2 * 64 * 1024; i += NG) { const int k = i & 1023, e = (i >> 10) & 63, l = i >> 16; wrt[i] = (bf16_t)f2bf(a->in[28][(size_t)(l * 1024 + k) * 64 + e]); }
      bf16_t* wsg = (bf16_t*)(F.ws + WS_WSG);
      for (int i = gt; i < 2 * 4 * 128 * 128; i += NG) wsg[i] = (bf16_t)f2bf(a->in[15][i]);
      if (F.bid == 0) { float* rope = (float*)(F.ws + WS_ROPE);
          for (int t = F.tid; t < 1024; t += NTHR) { const int p = t >> 4, f = t & 15; const float inv = powf(10000.0f, -(float)f / 16.0f); const float ang = (float)p * inv; rope[2 * t] = cosf(ang); rope[2 * t + 1] = sinf(ang); } }
      if (F.bid == (1 % F.G) && F.wave == 0) { float* lam = (float*)(F.ws + WS_LAM);
#pragma unroll
          for (int l = 0; l < 2; ++l) { const float s1 = wave_sum(a->in[8][l * 64 + F.lane] * a->in[9][l * 64 + F.lane]), s2 = wave_sum(a->in[10][l * 64 + F.lane] * a->in[11][l * 64 + F.lane]);
              const float li = 0.8f - 0.6f * expf(-0.3f * (float)l); if (F.lane == 0) lam[l] = expf(s1) - expf(s2) + li; } }
    }
    __syncthreads();
    LAS float* sl = (LAS float*)(F.lds);
    for (int i = F.tid; i < 5 * 1024; i += NTHR) { const int b = i >> 10, k = i & 1023; const float cv = b < 4 ? a->in[1][b * 1024 + k] : a->in[3][k]; sl[i] = silu_(cv); }
    __syncthreads();
    float* mod = (float*)(F.ws + WS_MOD);
    LAS float* part = (LAS float*)(F.lds + 20480);
    for (int c = F.bid; c < 192; c += F.G) {
        const int l = c / 96, cg = c - l * 96, col = F.tid & 63, ks = F.wave, n = cg * 64 + col;
        const float* w = a->in[4] + ((size_t)l * 1024 + ks * 128) * 6144 + n;
        float acc[5] = {0.f, 0.f, 0.f, 0.f, 0.f};
#pragma unroll 8
        for (int k = 0; k < 128; ++k) { const float wv = w[(size_t)k * 6144];
#pragma unroll
            for (int b = 0; b < 5; ++b) acc[b] += sl[b * 1024 + ks * 128 + k] * wv; }
#pragma unroll
        for (int b = 0; b < 5; ++b) part[(ks * 5 + b) * 64 + col] = acc[b];
        __syncthreads();
        if (F.tid < 320) { const int b = F.tid >> 6; float s = a->in[5][l * 6144 + n];
#pragma unroll
            for (int k8 = 0; k8 < 8; ++k8) s += part[(k8 * 5 + b) * 64 + col];
            mod[(l * 5 + b) * 6144 + n] = s; }
        __syncthreads();
    }
}

__device__ __forceinline__ void row_load(const float* p, int lane, f32x4 (&v)[4]) {
#pragma unroll
    for (int j = 0; j < 4; ++j) v[j] = *(const f32x4*)(p + 4 * lane + 256 * j);
}
__device__ __forceinline__ void row_load_bf16(const float* p, int lane, f32x4 (&v)[4]) {
#pragma unroll
    for (int j = 0; j < 4; ++j) { const u32x2 w = *(const u32x2*)((const bf16_t*)p + 4 * lane + 256 * j); v[j] = (f32x4){bflo(w.x), bfhi(w.x), bflo(w.y), bfhi(w.y)}; }
}
__device__ __forceinline__ void row_store(float* p, int lane, const f32x4 (&v)[4]) {
#pragma unroll
    for (int j = 0; j < 4; ++j) *(f32x4*)(p + 4 * lane + 256 * j) = v[j];
}
__device__ __forceinline__ void row_ln(f32x4 (&v)[4]) {
    float s = 0.f;
#pragma unroll
    for (int j = 0; j < 4; ++j) s += (v[j][0] + v[j][1]) + (v[j][2] + v[j][3]);
    const float mean = wave_sum(s) * (1.f / DM); float q = 0.f;
#pragma unroll
    for (int j = 0; j < 4; ++j) { v[j] = v[j] - mean; q += (v[j][0] * v[j][0] + v[j][1] * v[j][1]) + (v[j][2] * v[j][2] + v[j][3] * v[j][3]); }
    const float rstd = __builtin_amdgcn_rsqf(wave_sum(q) * (1.f / DM) + LN_EPS);
#pragma unroll
    for (int j = 0; j < 4; ++j) v[j] = v[j] * rstd;
}
__device__ __forceinline__ void row_affine(f32x4 (&v)[4], const float* scale1p  , bool plus1, const float* shift, int lane) {
#pragma unroll
    for (int j = 0; j < 4; ++j) { const f32x4 sc = *(const f32x4*)(scale1p + 4 * lane + 256 * j), sh = *(const f32x4*)(shift + 4 * lane + 256 * j);
        v[j] = plus1 ? v[j] * (sc + 1.0f) + sh : v[j] * sc + sh; }
}
__device__ __forceinline__ void row_store_bf16(bf16_t* p, int lane, const f32x4 (&v)[4]) {
#pragma unroll
    for (int j = 0; j < 4; ++j) { u32x2 w; w.x = pk2(v[j][0], v[j][1]); w.y = pk2(v[j][2], v[j][3]); *(u32x2*)(p + 4 * lane + 256 * j) = w; }
}

__device__ __forceinline__ void phase_rows0(const Frame& F, CArgsP a) {
    const float* mod = (const float*)(F.ws + WS_MOD); float* xc = (float*)(F.ws + WS_XC); bf16_t* H = (bf16_t*)(F.ws + WS_H);
    for (int tok = F.gw; tok < T; tok += F.NGW) {
        const int b = tok / TPB, j = tok - b * TPB; const bool isc = j < CTX;
        const float* src = isc ? a->in[2] + (size_t)(b * CTX + j) * DM : a->in[0] + (size_t)(b * SEQ + j - CTX) * DM;
        f32x4 v[4]; row_load(src, F.lane, v);
        row_store_bf16((bf16_t*)resid_row(F.out, xc, tok), F.lane, v);
        row_ln(v);
        const float* mrow = mod + (isc ? 4 : b) * 6144;
        row_affine(v, mrow + 1024, true, mrow, F.lane);
        row_store_bf16(H + (size_t)tok * DM, F.lane, v);
    }
}

__device__ __forceinline__ void sg_item(const Frame& F, CArgsP a, int l, int chunk, int g) {
    LAS bf16_t* vgT = (LAS bf16_t*)F.lds;
    const bf16_t* Sb = (const bf16_t*)(F.ws + OV_S); const bf16_t* Ub = (const bf16_t*)(F.ws + OV_U); bf16_t* OB = (bf16_t*)(F.ws + OV_OB);
    const int tok0 = chunk * 128;
    { const int q = F.tid >> 2, qt = F.tid & 3;
      const bf16_t* sp = Sb + (size_t)(tok0 + q) * 512 + g * 128 + qt * 32;
      float x[32];
#pragma unroll
      for (int i = 0; i < 4; ++i) { const u32x4 w = *(const u32x4*)(sp + 8 * i);
          x[8 * i + 0] = bflo(w.x); x[8 * i + 1] = bfhi(w.x); x[8 * i + 2] = bflo(w.y); x[8 * i + 3] = bfhi(w.y); x[8 * i + 4] = bflo(w.z); x[8 * i + 5] = bfhi(w.z); x[8 * i + 6] = bflo(w.w); x[8 * i + 7] = bfhi(w.w); }
      float s = 0.f;
#pragma unroll
      for (int i = 0; i < 32; ++i) s += x[i];
      s += __shfl_xor(s, 1); s += __shfl_xor(s, 2); const float mean = s * (1.f / 128.f); float qq = 0.f;
#pragma unroll
      for (int i = 0; i < 32; ++i) { x[i] -= mean; qq += x[i] * x[i]; }
      qq += __shfl_xor(qq, 1); qq += __shfl_xor(qq, 2); const float rstd = 1.f / sqrtf(qq * (1.f / 128.f) + LN_EPS);
      const float* lg = a->in[13] + l * 512 + g * 128 + qt * 32; const float* lb = a->in[14] + l * 512 + g * 128 + qt * 32;
#pragma unroll
      for (int i = 0; i < 32; ++i) vgT[(qt * 32 + i) * 136 + q] = (bf16_t)f2bf(x[i] * rstd * lg[i] + lb[i]);
    }
    __syncthreads();
    const int w = F.wave, fr = F.lane & 15, fq = F.lane >> 4;
    bf16x8 af[4];
#pragma unroll
    for (int ks = 0; ks < 4; ++ks) af[ks] = *(const LAS bf16x8*)(vgT + (w * 16 + fr) * 136 + ks * 32 + fq * 8);
    const bf16_t* W = (const bf16_t*)(F.ws + WS_WSG) + (size_t)(l * 4 + g) * 16384;
    const float* bs = a->in[16] + (l * 4 + g) * 128;
#pragma unroll 2
    for (int n = 0; n < 8; ++n) {
        f32x4 d = {0.f, 0.f, 0.f, 0.f};
#pragma unroll
        for (int ks = 0; ks < 4; ++ks) { const bf16x8 bfv = *(const bf16x8*)(W + (n * 16 + fr) * 128 + ks * 32 + fq * 8); d = __builtin_amdgcn_mfma_f32_16x16x32_bf16(af[ks], bfv, d, 0, 0, 0); }
        const int p = n * 16 + fr, c0 = w * 16 + fq * 4; const float bsp = bs[p];
        const size_t off = (size_t)(tok0 + p) * 512 + g * 128 + c0;
        const u32x2 uu = *(const u32x2*)(Ub + off);
        u32x2 o; o.x = pk2(bflo(uu.x) * (d[0] + bsp), bfhi(uu.x) * (d[1] + bsp)); o.y = pk2(bflo(uu.y) * (d[2] + bsp), bfhi(uu.y) * (d[3] + bsp));
        *(u32x2*)(OB + off) = o;
    }
    __syncthreads();
}

template <bool REV>
__device__ __forceinline__ void lru_scan(const f32x4 (&av)[4], const f32x4 (&bv)[4], f32x4 (&hv)[4], int lane, int mode, float hin, float& sumA, float& sumH) {
#define LRU_MI(k) (REV ? 3 - (k) : (k))
    const int fr = lane & 15, fq = lane >> 4, q = REV ? 3 - fq : fq;
    const int s1 = REV ? lane + 16 : lane - 16, s2 = REV ? lane + 32 : lane - 32, st = REV ? fr : 48 + fr;
    float Ea[4], Eh[4], Ta[4], Th[4];
#pragma unroll
    for (int m = 0; m < 4; ++m) {
        float A = 1.f, H = 0.f;
#pragma unroll
        for (int rk = 0; rk < 4; ++rk) { const int r = LRU_MI(rk); H = av[m][r] * H + bv[m][r]; A *= av[m][r]; }
        float pa = __shfl(A, s1), ph = __shfl(H, s1); if (q >= 1) { H = A * ph + H; A *= pa; }
        pa = __shfl(A, s2); ph = __shfl(H, s2); if (q >= 2) { H = A * ph + H; A *= pa; }
        float ea = __shfl(A, s1), eh = __shfl(H, s1); if (q == 0) { ea = 1.f; eh = 0.f; }
        Ea[m] = ea; Eh[m] = eh; Ta[m] = __shfl(A, st); Th[m] = __shfl(H, st);
    }
    if (mode == 0) {
        float A = 1.f, H = 0.f;
#pragma unroll
        for (int mk = 0; mk < 4; ++mk) { const int m = LRU_MI(mk); H = Ta[m] * H + Th[m]; A *= Ta[m]; }
        sumA = A; sumH = H;
    } else {
        float S = hin;
#pragma unroll
        for (int mk = 0; mk < 4; ++mk) { const int m = LRU_MI(mk); float h = Ea[m] * S + Eh[m];
#pragma unroll
            for (int rk = 0; rk < 4; ++rk) { const int r = LRU_MI(rk); h = av[m][r] * h + bv[m][r]; hv[m][r] = h; }
            S = Ta[m] * S + Th[m]; }
    }
#undef LRU_MI
}
struct LruConst { f32x4 cw[4][2]; f32x4 cbias[2]; bf16x8 wa0, wa1, wx0, wx1; float ba, bx, sp; };
struct LruIn { u32x4 x[4]; u32x4 y; float hin; };
__device__ __forceinline__ void lru_load_const(const Frame& F, CArgsP a, int l, int cb, LruConst& c) {
    const int lane = F.lane, fr = lane & 15, fq = lane >> 4, d = F.wave >> 2, nt = F.wave & 3, ch0 = cb * 64, c8 = (F.tid & 7) * 8;
    const bf16_t* Wa = (const bf16_t*)(F.ws + WS_WLRU) + (size_t)((l * 4 + d * 2) * 8 + cb) * 4096 + (nt * 16 + fr) * 64 + fq * 8;
    c.wa0 = *(const bf16x8*)(Wa); c.wa1 = *(const bf16x8*)(Wa + 32); c.wx0 = *(const bf16x8*)(Wa + 8 * 4096); c.wx1 = *(const bf16x8*)(Wa + 8 * 4096 + 32);
    const int pidx = (l * 2 + d) * 512 + ch0 + nt * 16 + fr;
    c.ba = a->in[20][pidx]; c.bx = a->in[22][pidx]; c.sp = log1pf(expf(-a->in[23][pidx]));
#pragma unroll
    for (int jj = 0; jj < 4; ++jj) { c.cw[jj][0] = *(const f32x4*)(a->in[17] + l * 2048 + jj * 512 + ch0 + c8); c.cw[jj][1] = *(const f32x4*)(a->in[17] + l * 2048 + jj * 512 + ch0 + c8 + 4); }
    c.cbias[0] = *(const f32x4*)(a->in[18] + l * 512 + ch0 + c8); c.cbias[1] = *(const f32x4*)(a->in[18] + l * 512 + ch0 + c8 + 4);
}
__device__ __forceinline__ void lru_load_in(const Frame& F, int b, int chunk, int cb, int mode, LruIn& in) {
    const bf16_t* Xb = (const bf16_t*)(F.ws + OV_X); const bf16_t* Yb = (const bf16_t*)(F.ws + OV_Y);
    const int ch0 = cb * 64, ct = F.tid >> 3, c8 = (F.tid & 7) * 8, d = F.wave >> 2, ch = (F.wave & 3) * 16 + (F.lane & 15);
    const int seg_lo = chunk < 4 ? 0 : 256, seg_hi = chunk < 4 ? 256 : TPB, j0 = chunk * 64;
#pragma unroll
    for (int jj = 0; jj < 4; ++jj) { const int j = j0 + ct + jj - 2; in.x[jj] = (u32x4){0u, 0u, 0u, 0u}; if (j >= seg_lo && j < seg_hi) in.x[jj] = *(const u32x4*)(Xb + (size_t)(b * TPB + j) * 512 + ch0 + c8); }
    in.y = (u32x4){0u, 0u, 0u, 0u}; in.hin = 0.f;
    if (mode == 1) { in.y = *(const u32x4*)(Yb + (size_t)(b * TPB + j0 + ct) * 512 + ch0 + c8); in.hin = ((const float*)(F.ws + WS_HIN))[(size_t)((b * 2 + d) * 68 + chunk) * 512 + ch0 + ch]; }
}
__device__ __forceinline__ void lru_compute(const Frame& F, const LruConst& c, const LruIn& in, int b, int chunk, int cb, int mode) {
    LAS float* xs = (LAS float*)F.lds;
    LAS bf16_t* xsb = (LAS bf16_t*)(F.lds + 16384);
    LAS float* hx = (LAS float*)(F.lds + 25600);
    bf16_t* OC = (bf16_t*)(F.ws + OV_OC);
    const int tok0 = b * TPB + chunk * 64, ch0 = cb * 64;
    const int lane = F.lane, fr = lane & 15, fq = lane >> 4, d = F.wave >> 2, nt = F.wave & 3, ch = nt * 16 + fr;
    const int ct = F.tid >> 3, c8 = (F.tid & 7) * 8;
    {
      f32x4 a0 = c.cbias[0], a1 = c.cbias[1];
#pragma unroll
      for (int jj = 0; jj < 4; ++jj) { const u32x4 w = in.x[jj];
          a0 += c.cw[jj][0] * (f32x4){bflo(w.x), bfhi(w.x), bflo(w.y), bfhi(w.y)}; a1 += c.cw[jj][1] * (f32x4){bflo(w.z), bfhi(w.z), bflo(w.w), bfhi(w.w)}; }
      *(LAS f32x4*)(xs + ct * 64 + c8) = a0; *(LAS f32x4*)(xs + ct * 64 + c8 + 4) = a1;
      u32x4 pw; pw.x = pk2(a0[0], a0[1]); pw.y = pk2(a0[2], a0[3]); pw.z = pk2(a1[0], a1[1]); pw.w = pk2(a1[2], a1[3]);
      *(LAS u32x4*)(xsb + ct * 72 + c8) = pw; }
    __syncthreads();
    f32x4 av[4], bv[4], hv[4];
#pragma unroll
    for (int m = 0; m < 4; ++m) {
        const bf16x8 a0 = *(const LAS bf16x8*)(xsb + (m * 16 + fr) * 72 + fq * 8), a1 = *(const LAS bf16x8*)(xsb + (m * 16 + fr) * 72 + 32 + fq * 8);
        f32x4 da = {0.f, 0.f, 0.f, 0.f}, dx = {0.f, 0.f, 0.f, 0.f};
        da = __builtin_amdgcn_mfma_f32_16x16x32_bf16(a0, c.wa0, da, 0, 0, 0); da = __builtin_amdgcn_mfma_f32_16x16x32_bf16(a1, c.wa1, da, 0, 0, 0);
        dx = __builtin_amdgcn_mfma_f32_16x16x32_bf16(a0, c.wx0, dx, 0, 0, 0); dx = __builtin_amdgcn_mfma_f32_16x16x32_bf16(a1, c.wx1, dx, 0, 0, 0);
#pragma unroll
        for (int r = 0; r < 4; ++r) { const float rg = sigmoidf_(da[r] + c.ba), ig = sigmoidf_(dx[r] + c.bx); const float la = -8.0f * rg * c.sp;
            const float e1 = expm1_fast(la);
            av[m][r] = 1.0f + e1; bv[m][r] = __builtin_amdgcn_sqrtf(-e1 * (2.0f + e1)) * (ig * xs[(m * 16 + fq * 4 + r) * 64 + ch]); hv[m][r] = 0.f; }
    }
    float sumA = 1.f, sumH = 0.f;
    if (d == 0) lru_scan<false>(av, bv, hv, lane, mode, in.hin, sumA, sumH); else lru_scan<true>(av, bv, hv, lane, mode, in.hin, sumA, sumH);
    if (mode == 0) {
        if (fq == 0) { float* sum = (float*)(F.ws + WS_SUM) + ((size_t)((b * 2 + d) * 68 + chunk) * 512 + ch0 + ch) * 2; *(float2*)sum = make_float2(sumA, sumH); }
        __syncthreads();
        return;
    }
#pragma unroll
    for (int m = 0; m < 4; ++m)
#pragma unroll
        for (int r = 0; r < 4; ++r) hx[d * 4096 + (m * 16 + fq * 4 + r) * 64 + ch] = hv[m][r];
    __syncthreads();
    { const u32x4 yv = in.y;
      const f32x4 f0 = *(const LAS f32x4*)(hx + ct * 64 + c8), f1 = *(const LAS f32x4*)(hx + ct * 64 + c8 + 4), g0 = *(const LAS f32x4*)(hx + 4096 + ct * 64 + c8), g1 = *(const LAS f32x4*)(hx + 4096 + ct * 64 + c8 + 4);
      u32x4 o; o.x = pk2(bflo(yv.x) * (f0[0] + g0[0]), bfhi(yv.x) * (f0[1] + g0[1])); o.y = pk2(bflo(yv.y) * (f0[2] + g0[2]), bfhi(yv.y) * (f0[3] + g0[3]));
      o.z = pk2(bflo(yv.z) * (f1[0] + g1[0]), bfhi(yv.z) * (f1[1] + g1[1])); o.w = pk2(bflo(yv.w) * (f1[2] + g1[2]), bfhi(yv.w) * (f1[3] + g1[3]));
      *(u32x4*)(OC + (size_t)(tok0 + ct) * 512 + ch0 + c8) = o; }
}
__device__ __forceinline__ void lru_phase(const Frame& F, CArgsP a, int l, int mode, bool skip_ctx) {
    constexpr int NIT = 4 * 68 * 8;
    int it = F.bid;
    while (it < NIT && skip_ctx && ((it >> 3) % 68) < 4) it += F.G;
    if (it >= NIT) return;
    LruConst c; LruIn cur, nxt;
    int cb = it & 7; lru_load_const(F, a, l, cb, c);
    lru_load_in(F, (it >> 3) / 68, (it >> 3) % 68, cb, mode, cur);
    for (;;) {
        int nit = it + F.G;
        while (nit < NIT && skip_ctx && ((nit >> 3) % 68) < 4) nit += F.G;
        const bool has = nit < NIT;
        if (has) lru_load_in(F, (nit >> 3) / 68, (nit >> 3) % 68, nit & 7, mode, nxt);
        lru_compute(F, c, cur, (it >> 3) / 68, (it >> 3) % 68, cb, mode);
        if (!has) break;
        if ((nit & 7) != cb) { cb = nit & 7; lru_load_const(F, a, l, cb, c); }
        it = nit; cur = nxt;
    }
}

__device__ __forceinline__ void phase_carry(const Frame& F) {
    const int gt = F.bid * NTHR + F.tid; if (gt >= 4 * 2 * 512) return;
    const int c = gt & 511, d = (gt >> 9) & 1, b = gt >> 10;
    const float* sum = (const float*)(F.ws + WS_SUM) + (size_t)((b * 2 + d) * 68) * 1024 + c * 2;
    float* hin = (float*)(F.ws + WS_HIN) + (size_t)((b * 2 + d) * 68) * 512 + c;
    float h = 0.f;
#pragma unroll 1
    for (int g0 = 0; g0 < 68; g0 += 17) {
        float A[17], Hh[17];
#pragma unroll
        for (int i = 0; i < 17; ++i) { const int o = g0 + i; const int ck = d == 0 ? o : (o < 4 ? 3 - o : 71 - o); const float2 v = *(const float2*)(sum + (size_t)ck * 1024); A[i] = v.x; Hh[i] = v.y; }
#pragma unroll
        for (int i = 0; i < 17; ++i) { const int o = g0 + i; const int ck = d == 0 ? o : (o < 4 ? 3 - o : 71 - o); hin[(size_t)ck * 512] = h; h = A[i] * h + Hh[i]; }
    }
}

constexpr int AT_KST = 272, AT_VST = 320;
constexpr int AT_KOFF = 0, AT_VOFF = 2 * 64 * AT_KST, AT_XOFF = AT_VOFF + 2 * 64 * AT_VST;
#define AT_SBAR() __builtin_amdgcn_sched_barrier(0)
struct AttnState { f32x16 o[4]; f32x16 negm; bf16x8 pfp[4]; float lrun; };
#define AT_PIN1(x) asm volatile("" : "+v"(x))
__device__ __forceinline__ float at_max3(float a, float b, float c) { float r; asm("v_max3_f32 %0, %1, %2, %3" : "=v"(r) : "v"(a), "v"(b), "v"(c)); return r; }
__device__ __forceinline__ bf16x8 at_vfrag(const LAS unsigned char* vp) {
    const s16x4 lo = __builtin_bit_cast(s16x4, __builtin_amdgcn_ds_read_tr16_b64_v4i16((LAS s16x4*)(vp)));
    const s16x4 hh = __builtin_bit_cast(s16x4, __builtin_amdgcn_ds_read_tr16_b64_v4i16((LAS s16x4*)(vp + 8 * AT_VST)));
    return (bf16x8){lo[0], lo[1], lo[2], lo[3], hh[0], hh[1], hh[2], hh[3]};
}
__device__ __forceinline__ float attn_stage1(const AttnState& st, const f32x16& p0, const f32x16& p1, f32x16& n0, f32x16& n1, const LAS unsigned char* ql, const LAS unsigned char* kf) {
    float mx = at_max3(p0[0], p0[1], at_max3(p1[0], p1[1], p1[1]));
    bf16x8 a0 = *(const LAS bf16x8*)(kf), a1 = *(const LAS bf16x8*)(kf + 32 * AT_KST), q = *(const LAS bf16x8*)(ql);
    AT_SBAR();
#pragma unroll
    for (int ks = 0; ks < 4; ++ks) {
        bf16x8 b0 = a0, b1 = a1, qn = q;
        if (ks < 3) { b0 = *(const LAS bf16x8*)(kf + (ks + 1) * 32); b1 = *(const LAS bf16x8*)(kf + 32 * AT_KST + (ks + 1) * 32); qn = *(const LAS bf16x8*)(ql + (ks + 1) * 1024); }
        if (ks == 0) n0 = __builtin_amdgcn_mfma_f32_32x32x16_bf16(a0, q, st.negm, 0, 0, 0);
        else n0 = __builtin_amdgcn_mfma_f32_32x32x16_bf16(a0, q, n0, 0, 0, 0);
        mx = at_max3(at_max3(mx, p0[4 * ks + 2], p0[4 * ks + 3]), p1[4 * ks + 2], p1[4 * ks + 3]); AT_PIN1(mx); AT_SBAR();
        if (ks == 0) n1 = __builtin_amdgcn_mfma_f32_32x32x16_bf16(a1, q, st.negm, 0, 0, 0);
        else n1 = __builtin_amdgcn_mfma_f32_32x32x16_bf16(a1, q, n1, 0, 0, 0);
        if (ks < 3) { mx = at_max3(at_max3(mx, p0[4 * ks + 4], p0[4 * ks + 5]), p1[4 * ks + 4], p1[4 * ks + 5]); AT_PIN1(mx); } AT_SBAR();
        a0 = b0; a1 = b1; q = qn;
    }
    return mx;
}
template <bool FIRST>
__device__ __forceinline__ void attn_stage2(AttnState& st, f32x16& p0, f32x16& p1, f32x16& n0, f32x16& n1, float mx, const LAS unsigned char* vf) {
    constexpr float THR = 8.0f;
    bf16x8 vcur; if (!FIRST) vcur = at_vfrag(vf);
    float tm; { auto rr = __builtin_amdgcn_permlane32_swap(__float_as_uint(mx), __float_as_uint(mx), false, false); tm = fmaxf(__uint_as_float(rr[0]), __uint_as_float(rr[1])); }
    if (FIRST || __any(tm > THR)) {
        const float dl = FIRST ? tm : fmaxf(tm, 0.f);
#pragma unroll
        for (int r = 0; r < 16; ++r) { p0[r] -= dl; p1[r] -= dl; n0[r] -= dl; n1[r] -= dl; st.negm[r] -= dl; }
        if (!FIRST) {
            const float al = __builtin_amdgcn_exp2f(-dl);
#pragma unroll
            for (int db = 0; db < 4; ++db)
#pragma unroll
                for (int r = 0; r < 16; ++r) st.o[db][r] *= al;
#pragma unroll
            for (int kk = 0; kk < 4; ++kk) { u32x4 w = __builtin_bit_cast(u32x4, st.pfp[kk]);
                w.x = pk2(bflo(w.x) * al, bfhi(w.x) * al); w.y = pk2(bflo(w.y) * al, bfhi(w.y) * al); w.z = pk2(bflo(w.z) * al, bfhi(w.z) * al); w.w = pk2(bflo(w.w) * al, bfhi(w.w) * al);
                st.pfp[kk] = __builtin_bit_cast(bf16x8, w); }
            st.lrun *= al;
        }
    }
    float ls = 0.f;
    AT_SBAR();
#pragma unroll
    for (int kk = 0; kk < 4; ++kk) {
        unsigned pw0 = 0, pw1 = 0, pw2 = 0, pw3 = 0;
#pragma unroll
        for (int db = 0; db < 4; ++db) {
            const int g = kk * 4 + db;
            if (!FIRST) {
                bf16x8 vnext = vcur;
                if (g < 15) { const int g2 = g + 1; vnext = at_vfrag(vf + ((g2 >> 2) * 16) * AT_VST + (g2 & 3) * 64); }
                st.o[db] = __builtin_amdgcn_mfma_f32_32x32x16_bf16(vcur, st.pfp[kk], st.o[db], 0, 0, 0);
                vcur = vnext;
            }
            const float x0 = g < 8 ? p0[2 * g] : p1[2 * g - 16], x1 = g < 8 ? p0[2 * g + 1] : p1[2 * g - 15];
            const float e0 = __builtin_amdgcn_exp2f(x0), e1 = __builtin_amdgcn_exp2f(x1);
            ls += e0 + e1; unsigned w = pk2(e0, e1); AT_PIN1(ls); AT_PIN1(w);
            if (db == 0) pw0 = w; else if (db == 1) pw1 = w; else if (db == 2) pw2 = w; else pw3 = w;
            AT_SBAR();
        }
        st.pfp[kk] = __builtin_bit_cast(bf16x8, (u32x4){pw0, pw1, pw2, pw3});
    }
    st.lrun += ls;
}
__device__ __forceinline__ void attn_unit(const Frame& F, int tokq0, int tokk0, int ntiles, int h, float lam, const float* gain, float oscale) {
    const bf16_t* Q = (const bf16_t*)(F.ws + OV_Q); const char* Kg = (const char*)(F.ws + OV_K); const char* Vg = (const char*)(F.ws + OV_V); bf16_t* OA = (bf16_t*)(F.ws + OV_OA);
    const int lane = F.lane, r32 = lane & 31, hi = lane >> 5, rb = F.wave >> 1, c = F.wave & 1;
    LAS unsigned char* ql = F.lds + AT_XOFF + F.wave * 4096 + lane * 16;
    { const bf16_t* qp = Q + (size_t)(tokq0 + rb * 32 + r32) * 512 + h * 128 + c * 64 + hi * 8;
#pragma unroll
      for (int ks = 0; ks < 4; ++ks) *(LAS bf16x8*)(ql + ks * 1024) = *(const bf16x8*)(qp + ks * 16); }
    const int srow0 = F.tid >> 4, sch = F.tid & 15;
    const unsigned goff = (unsigned)(((tokk0 + srow0) * 512 + h * 128 + sch * 8) * 2);
    LAS unsigned char* kl = F.lds + AT_KOFF + srow0 * AT_KST + sch * 16;
    LAS unsigned char* vl = F.lds + AT_VOFF + srow0 * AT_VST + sch * 16;
    const LAS unsigned char* kfb = F.lds + AT_KOFF + r32 * AT_KST + (c * 64 + hi * 8) * 2;
    const LAS unsigned char* vfb = F.lds + AT_VOFF + (4 * hi + ((lane & 15) >> 2)) * AT_VST + (((lane >> 4) & 1) * 16 + (lane & 3) * 4) * 2;
    {
      const u32x4 k0 = *(const u32x4*)(Kg + goff), k1 = *(const u32x4*)(Kg + goff + 32 * 1024), k2 = *(const u32x4*)(Kg + goff + 64 * 1024), k3 = *(const u32x4*)(Kg + goff + 96 * 1024);
      *(LAS u32x4*)(kl) = k0; *(LAS u32x4*)(kl + 32 * AT_KST) = k1; *(LAS u32x4*)(kl + 64 * AT_KST) = k2; *(LAS u32x4*)(kl + 96 * AT_KST) = k3; }
    __syncthreads();
    AttnState st; st.lrun = 0.f;
#pragma unroll
    for (int r = 0; r < 16; ++r) st.negm[r] = 0.f;
#pragma unroll
    for (int db = 0; db < 4; ++db)
#pragma unroll
        for (int r = 0; r < 16; ++r) st.o[db][r] = 0.f;
    f32x16 pa0, pa1, pb0, pb1;
#pragma unroll
    for (int r = 0; r < 16; ++r) { pa0[r] = 0.f; pa1[r] = 0.f; }
#pragma unroll
    for (int ks = 0; ks < 4; ++ks) {
        const bf16x8 a0 = *(const LAS bf16x8*)(kfb + ks * 32), a1 = *(const LAS bf16x8*)(kfb + 32 * AT_KST + ks * 32);
        const bf16x8 q = *(const LAS bf16x8*)(ql + ks * 1024);
        pa0 = __builtin_amdgcn_mfma_f32_32x32x16_bf16(a0, q, pa0, 0, 0, 0); pa1 = __builtin_amdgcn_mfma_f32_32x32x16_bf16(a1, q, pa1, 0, 0, 0);
    }
    asm volatile("s_nop 15\n\ts_nop 7" : "+v"(pa0), "+v"(pa1));
    u32x4 sv0 = *(const u32x4*)(Vg + goff), sv1 = *(const u32x4*)(Vg + goff + 32 * 1024);
#define AT_ITER(I, FIRSTF, PC0, PC1, PN0, PN1) do { \
        const int i_ = (I); const bool ldk_ = i_ + 2 < ntiles; const int sl_ = i_ & 1; \
        const float mx_ = attn_stage1(st, PC0, PC1, PN0, PN1, ql, kfb + ((i_ + 1) & 1) * (64 * AT_KST)); \
        *(LAS u32x4*)(vl + sl_ * (64 * AT_VST)) = sv0; *(LAS u32x4*)(vl + sl_ * (64 * AT_VST) + 32 * AT_VST) = sv1; \
        u32x4 sk0_, sk1_; if (ldk_) { const unsigned go_ = goff + (unsigned)(i_ + 2) * 65536u; sk0_ = *(const u32x4*)(Kg + go_); sk1_ = *(const u32x4*)(Kg + go_ + 32 * 1024); } \
        attn_stage2<FIRSTF>(st, PC0, PC1, PN0, PN1, mx_, vfb + ((i_ + 1) & 1) * (64 * AT_VST)); \
        if (ldk_) { *(LAS u32x4*)(kl + sl_ * (64 * AT_KST)) = sk0_; *(LAS u32x4*)(kl + sl_ * (64 * AT_KST) + 32 * AT_KST) = sk1_; } \
        if (i_ + 1 < ntiles) { const unsigned gv_ = goff + (unsigned)(i_ + 1) * 65536u; sv0 = *(const u32x4*)(Vg + gv_); sv1 = *(const u32x4*)(Vg + gv_ + 32 * 1024); } \
        __syncthreads(); } while (0)
    AT_ITER(0, true, pa0, pa1, pb0, pb1);
    AT_ITER(1, false, pb0, pb1, pa0, pa1);
#pragma unroll 1
    for (int i = 2; i < ntiles; i += 2) {
        AT_ITER(i, false, pa0, pa1, pb0, pb1);
        AT_ITER(i + 1, false, pb0, pb1, pa0, pa1);
    }
#undef AT_ITER
    {
      const LAS unsigned char* vf = vfb + ((ntiles - 1) & 1) * (64 * AT_VST);
#pragma unroll
      for (int db = 0; db < 4; ++db)
#pragma unroll
          for (int kk = 0; kk < 4; ++kk) {
              const LAS unsigned char* vp = vf + (kk * 16) * AT_VST + db * 64;
              const s16x4 lo = __builtin_bit_cast(s16x4, __builtin_amdgcn_ds_read_tr16_b64_v4i16((LAS s16x4*)(vp)));
              const s16x4 hh = __builtin_bit_cast(s16x4, __builtin_amdgcn_ds_read_tr16_b64_v4i16((LAS s16x4*)(vp + 8 * AT_VST)));
              const bf16x8 vfr = {lo[0], lo[1], lo[2], lo[3], hh[0], hh[1], hh[2], hh[3]};
              st.o[db] = __builtin_amdgcn_mfma_f32_32x32x16_bf16(vfr, st.pfp[kk], st.o[db], 0, 0, 0);
          } }
    float lrun = st.lrun; lrun += __shfl_xor(lrun, 32);
    const float il = 1.f / lrun;
    LAS float* ex = (LAS float*)(F.lds + AT_XOFF) + rb * 4096;
    if (c == 1) {
#pragma unroll
        for (int db = 0; db < 4; ++db)
#pragma unroll
            for (int r = 0; r < 16; ++r) ex[(db * 16 + r) * 64 + lane] = st.o[db][r] * il;
    }
    __syncthreads();
    if (c == 0) {
        float ss = 0.f;
#pragma unroll
        for (int db = 0; db < 4; ++db)
#pragma unroll
            for (int r = 0; r < 16; ++r) { const float dv = st.o[db][r] * il - lam * ex[(db * 16 + r) * 64 + lane]; st.o[db][r] = dv; ss += dv * dv; }
        ss += __shfl_xor(ss, 32);
        const float rinv = oscale / sqrtf(ss * (1.f / 128.f) + RMS_EPS);
        bf16_t* op = OA + (size_t)(tokq0 + rb * 32 + r32) * 512 + h * 128;
#pragma unroll
        for (int db = 0; db < 4; ++db)
#pragma unroll
            for (int r4 = 0; r4 < 4; ++r4) { const int dv0 = db * 32 + 8 * r4 + 4 * hi; const f32x4 gv = *(const f32x4*)(gain + dv0);
                u32x2 w; w.x = pk2(st.o[db][4 * r4] * rinv * gv[0], st.o[db][4 * r4 + 1] * rinv * gv[1]); w.y = pk2(st.o[db][4 * r4 + 2] * rinv * gv[2], st.o[db][4 * r4 + 3] * rinv * gv[3]);
                *(u32x2*)(op + dv0) = w; }
    }
    __syncthreads();
}

__device__ __forceinline__ void phase_attn(const Frame& F, CArgsP a, int l) {
    const float lam = ((const float*)(F.ws + WS_LAM))[l]; const float li = 0.8f - 0.6f * expf(-0.3f * (float)l);
    for (int dd = 0; dd < NDUP(6); ++dd) lru_phase(F, a, l, 1, l == 1);
    __syncthreads();
    const int nlat = 4 * 4 * 32, nctx = (l == 0) ? 4 * 4 * 2 : 0;
    for (int dd = 0; dd < NDUP(7); ++dd)
    for (int it = F.vcu; it < nlat + nctx; it += F.G) {
        int b, h, qb, tq0, nt;
        if (it < nlat) { qb = it & 31; h = (it >> 5) & 3; b = it >> 7; tq0 = b * TPB + CTX + qb * 128; nt = 68; }
        else { const int i2 = it - nlat; qb = i2 & 1; h = (i2 >> 1) & 3; b = i2 >> 3; tq0 = b * TPB + qb * 128; nt = 4; }
        attn_unit(F, tq0, b * TPB, nt, h, lam, a->in[12] + (l * 4 + h) * 128, 1.0f - li);
    }
}

__device__ __forceinline__ void mini_tile(const bf16_t* A, int lda, const bf16_t* Bt, int K, int lane, int wave, f32x4 (&acc)[2]) {
    const int fr = lane & 15, fq = lane >> 4;
    const bf16_t* ap = A + (size_t)((wave >> 1) * 16 + fr) * lda + fq * 8;
    const bf16_t* bp0 = Bt + (size_t)((wave & 1) * 32 + fr) * K + fq * 8; const bf16_t* bp1 = bp0 + (size_t)16 * K;
    acc[0] = (f32x4){0.f, 0.f, 0.f, 0.f}; acc[1] = (f32x4){0.f, 0.f, 0.f, 0.f};
#pragma unroll 8
    for (int k = 0; k < K; k += 32) {
        const bf16x8 av = *(const bf16x8*)(ap + k), b0 = *(const bf16x8*)(bp0 + k), b1 = *(const bf16x8*)(bp1 + k);
        acc[0] = __builtin_amdgcn_mfma_f32_16x16x32_bf16(b0, av, acc[0], 0, 0, 0); acc[1] = __builtin_amdgcn_mfma_f32_16x16x32_bf16(b1, av, acc[1], 0, 0, 0);
    }
}
__device__ __forceinline__ void mini_merge_ctx(const Frame& F, int l) {
    const int fr = F.lane & 15, fq = F.lane >> 4;
    for (int t = F.bid; t < 256; t += F.G) {
        const int rb = t >> 4, cbk = t & 15, cr = rb * 64, tok0 = (cr >> 8) * TPB + (cr & 255), col0 = cbk * 64;
        const int row = tok0 + (F.wave >> 1) * 16 + fr, colw = col0 + (F.wave & 1) * 32 + fq * 4;
        f32x4 mg[2] = {{0.f, 0.f, 0.f, 0.f}, {0.f, 0.f, 0.f, 0.f}};
#pragma unroll 1
        for (int r = 0; r < 3; ++r) {
            f32x4 acc[2];
            mini_tile((const bf16_t*)(F.ws + OV_OA + (size_t)r * 17 * MiB) + (size_t)tok0 * 512, 512, (const bf16_t*)(F.ws + WS_WBR) + (size_t)(l * 3 + r) * 1024 * 512 + (size_t)col0 * 512, 512, F.lane, F.wave, acc);
#pragma unroll
            for (int n = 0; n < 2; ++n) { const u32x2 g = *(const u32x2*)((const bf16_t*)(F.ws + OV_G) + (size_t)row * 3072 + r * 1024 + colw + n * 16);
                mg[n][0] += bflo(g.x) * acc[n][0]; mg[n][1] += bfhi(g.x) * acc[n][1]; mg[n][2] += bflo(g.y) * acc[n][2]; mg[n][3] += bfhi(g.y) * acc[n][3]; }
        }
#pragma unroll
        for (int n = 0; n < 2; ++n) { u32x2 w; w.x = pk2(mg[n][0], mg[n][1]); w.y = pk2(mg[n][2], mg[n][3]); *(u32x2*)((bf16_t*)(F.ws + OV_MG) + (size_t)row * DM + colw + n * 16) = w; }
    }
}
__device__ __forceinline__ void mini_wout_ctx(const Frame& F, int l) {
    const int fr = F.lane & 15, fq = F.lane >> 4;
    const float* g1 = (const float*)(F.ws + WS_MOD) + (l * 5 + 4) * 6144 + 2048;
    for (int t = F.bid; t < 256; t += F.G) {
        const int rb = t >> 4, cbk = t & 15, cr = rb * 64, tok0 = (cr >> 8) * TPB + (cr & 255), col0 = cbk * 64;
        const int crow = cr + (F.wave >> 1) * 16 + fr, colw = col0 + (F.wave & 1) * 32 + fq * 4;
        f32x4 acc[2];
        mini_tile((const bf16_t*)(F.ws + OV_MG) + (size_t)tok0 * DM, DM, (const bf16_t*)(F.ws + WS_WOUT) + (size_t)l * 1048576 + (size_t)col0 * 1024, 1024, F.lane, F.wave, acc);
#pragma unroll
        for (int n = 0; n < 2; ++n) { u32x2* p = (u32x2*)((bf16_t*)((float*)(F.ws + WS_XC) + (size_t)crow * DM) + colw + n * 16); const f32x4 gv = *(const f32x4*)(g1 + colw + n * 16); const u32x2 x = *p;
            u32x2 w; w.x = pk2(bflo(x.x) * DN_ALPHA + gv[0] * acc[n][0], bfhi(x.x) * DN_ALPHA + gv[1] * acc[n][1]); w.y = pk2(bflo(x.y) * DN_ALPHA + gv[2] * acc[n][2], bfhi(x.y) * DN_ALPHA + gv[3] * acc[n][3]); *p = w; }
    }
}

constexpr int RT_AST = 1032;
__device__ __forceinline__ void phase_router(const Frame& F, CArgsP a, int l, bool dry) {
    const float* mod = (const float*)(F.ws + WS_MOD) + l * 5 * 6144; float* xc = (float*)(F.ws + WS_XC); bf16_t* H = (bf16_t*)(F.ws + WS_H);
    LAS bf16_t* AT = (LAS bf16_t*)F.lds;
    LAS float* LG = (LAS float*)(F.lds + 32 * RT_AST * 2);
    LAS unsigned* LC = (LAS unsigned*)(F.lds + 32 * RT_AST * 2 + 8192);
    const bf16_t* Wt = (const bf16_t*)(F.ws + WS_WRT) + (size_t)l * 65536; const float rb_ = a->in[29][l * 64 + F.lane];
    unsigned* cnt = (unsigned*)(F.ws + WS_CNT) + l * 4096; int* list = (int*)(F.ws + WS_LIST);
    int* toke = (int*)(F.ws + WS_TOKE); int* tokp = (int*)(F.ws + WS_TOKP); float* tokw = (float*)(F.ws + WS_TOKW);
    const int nrows = l == 0 ? T : NBATCH * SEQ, nbatch = nrows / 32;
    const int fr = F.lane & 15, fq = F.lane >> 4, mt = F.wave & 1, nt = F.wave >> 1;
    if (F.tid < 64) LC[F.tid] = 0u;
    bf16x8 bfr[32];
    { const bf16_t* bp = Wt + (size_t)(nt * 16 + fr) * 1024 + fq * 8;
#pragma unroll
      for (int ks = 0; ks < 32; ++ks) bfr[ks] = *(const bf16x8*)(bp + ks * 32); }
    for (int bt = F.bid; bt < nbatch; bt += F.G) {
        int toks[4];
#pragma unroll
        for (int r = 0; r < 4; ++r) { const int ridx = bt * 32 + F.wave * 4 + r; toks[r] = l == 0 ? ridx : (ridx >> 12) * TPB + CTX + (ridx & 4095); }
#pragma unroll
        for (int rp = 0; rp < 4; rp += 2) {
        f32x4 vv[2][4];
        row_load_bf16(resid_row(F.out, xc, toks[rp]), F.lane, vv[0]); row_load_bf16(resid_row(F.out, xc, toks[rp + 1]), F.lane, vv[1]);
#pragma unroll
        for (int r2 = 0; r2 < 2; ++r2) { const int r = rp + r2; const int tok = toks[r];
            const int b = tok / TPB; const int bsel = (tok - b * TPB) < CTX ? 4 : b;
            float* xr = resid_row(F.out, xc, tok);
            f32x4 (&v)[4] = vv[r2]; row_ln(v); row_affine(v, a->in[26] + l * DM, false, a->in[27] + l * DM, F.lane);
            row_ln(v); const float* mrow = mod + bsel * 6144; row_affine(v, mrow + 4096, true, mrow + 3072, F.lane);
#pragma unroll
            for (int j = 0; j < 4; ++j) { u32x2 w; w.x = pk2(v[j][0], v[j][1]); w.y = pk2(v[j][2], v[j][3]);
                if (!dry) *(u32x2*)(H + (size_t)tok * DM + 4 * F.lane + 256 * j) = w; *(LAS u32x2*)(AT + (F.wave * 4 + r) * RT_AST + 4 * F.lane + 256 * j) = w; }
        }
        }
        __syncthreads();
        { f32x4 d = {0.f, 0.f, 0.f, 0.f};
          const LAS bf16_t* ap = AT + (mt * 16 + fr) * RT_AST + fq * 8;
#pragma unroll
          for (int ks = 0; ks < 32; ++ks) { const bf16x8 av = *(const LAS bf16x8*)(ap + ks * 32); d = __builtin_amdgcn_mfma_f32_16x16x32_bf16(av, bfr[ks], d, 0, 0, 0); }
#pragma unroll
          for (int r = 0; r < 4; ++r) LG[(mt * 16 + fq * 4 + r) * 64 + nt * 16 + fr] = d[r]; }
        __syncthreads();
        bool selr[4]; int rkr[4], lpr[4]; float wr_[4];
#pragma unroll
        for (int r = 0; r < 4; ++r) {
            const float lg = LG[(F.wave * 4 + r) * 64 + F.lane];
            const float s = sigmoidf_(lg); const float bsc = s + rb_;
            float m1 = bsc; m1 = fmaxf(m1, WS_DPP(m1, 0xB1, 0xF, true)); m1 = fmaxf(m1, WS_DPP(m1, 0x4E, 0xF, true)); m1 = fmaxf(m1, WS_DPP(m1, 0x141, 0xF, true));
            const unsigned long long eq = __ballot(bsc == m1); const unsigned gm = (unsigned)(eq >> (F.lane & ~7)) & 0xffu; const int first = __ffs(gm) - 1;
            float m2 = ((F.lane & 7) == first) ? -INFINITY : bsc; m2 = fmaxf(m2, WS_DPP(m2, 0xB1, 0xF, true)); m2 = fmaxf(m2, WS_DPP(m2, 0x4E, 0xF, true)); m2 = fmaxf(m2, WS_DPP(m2, 0x141, 0xF, true));
            const float gs = m1 + m2; const int myg = F.lane >> 3; int grank = 0;
#pragma unroll
            for (int g = 0; g < 8; ++g) { const float og = __builtin_bit_cast(float, __builtin_amdgcn_readlane(__builtin_bit_cast(int, gs), g * 8)); grank += (int)(og > gs) + (int)((og == gs) & (g < myg)); }
            const bool gsel = grank < 4; const float mk = gsel ? bsc : -INFINITY; int rk = 0;
#pragma unroll
            for (int j = 0; j < 64; ++j) { const float vj = __builtin_bit_cast(float, __builtin_amdgcn_readlane(__builtin_bit_cast(int, mk), j)); rk += (int)(vj > mk) + (int)((vj == mk) & (j < F.lane)); }
            const bool sel = gsel && rk < 8 && !dry;
            const float ssum = wave_sum((gsel && rk < 8) ? s : 0.f);
            selr[r] = sel; rkr[r] = rk; wr_[r] = s / ssum * 2.5f; lpr[r] = 0;
            if (sel) lpr[r] = (int)__hip_atomic_fetch_add((LAS unsigned*)(LC + F.lane), 1u, __ATOMIC_RELAXED, __HIP_MEMORY_SCOPE_WORKGROUP);
        }
        __syncthreads();
        if (F.tid < 64) { const unsigned n = LC[F.tid]; unsigned base = 0; if (n) base = atomicAdd(cnt + F.tid * 64, n); LC[64 + F.tid] = base; LC[F.tid] = 0u; }
        __syncthreads();
#pragma unroll
        for (int r = 0; r < 4; ++r)
            if (selr[r]) { const int tok = toks[r]; const int pos = (int)LC[64 + F.lane] + lpr[r];
                list[(size_t)F.lane * T + pos] = tok; toke[tok * 8 + rkr[r]] = F.lane; tokp[tok * 8 + rkr[r]] = pos; tokw[tok * 8 + rkr[r]] = wr_[r]; }
        __syncthreads();
    }
}

__device__ __forceinline__ void build_tables(const Frame& F, int l) {
    LAS int* tb = (LAS int*)(F.lds + LDS_CTL);
    __syncthreads();
    if (F.tid < 64) tb[LC_TCNT + F.tid] = (int)__hip_atomic_load((unsigned*)(F.ws + WS_CNT) + l * 4096 + F.tid * 64, __ATOMIC_RELAXED, __HIP_MEMORY_SCOPE_AGENT);
    __syncthreads();
    if (F.tid == 0) { int tbs = 0, sbs = 0;
        for (int e = 0; e < 64; ++e) { const int c = tb[LC_TCNT + e]; tb[LC_TBASE + e] = tbs; tb[LC_SBASE + e] = sbs; tbs += (c + 255) >> 8; sbs += c; }
        tb[LC_TBASE + 64] = tbs; tb[LC_SBASE + 64] = sbs; }
    __syncthreads();
}

__device__ __forceinline__ void phase_combine(const Frame& F, CArgsP a, int l, bool dry) {
    const float* mod = (const float*)(F.ws + WS_MOD) + l * 5 * 6144; float* xc = (float*)(F.ws + WS_XC); bf16_t* H = (bf16_t*)(F.ws + WS_H);
    const unsigned char* YS = (const unsigned char*)(F.ws + OV_YS); const LAS int* tb = (const LAS int*)(F.lds + LDS_CTL);
    const int* toke = (const int*)(F.ws + WS_TOKE); const int* tokp = (const int*)(F.ws + WS_TOKP); const float* tokw = (const float*)(F.ws + WS_TOKW);
    const int nrows = l == 0 ? T : NBATCH * SEQ;
    for (int rp = F.gw * 2; rp < nrows; rp += F.NGW * 2) {
        int tok[2], bsel[2]; float* xr[2]; f32x4 y[2][4], v[2][4]; int me, mp; float mw;
#pragma unroll
        for (int q = 0; q < 2; ++q) { const int ridx = rp + q; tok[q] = l == 0 ? ridx : (ridx >> 12) * TPB + CTX + (ridx & 4095);
            const int b = tok[q] / TPB; bsel[q] = (tok[q] - b * TPB) < CTX ? 4 : b; xr[q] = resid_row(F.out, xc, tok[q]); }
        { const int q = (F.lane >> 3) & 1, k = F.lane & 7; me = toke[tok[q] * 8 + k]; mp = tokp[tok[q] * 8 + k]; mw = tokw[tok[q] * 8 + k]; }
#pragma unroll
        for (int q = 0; q < 2; ++q) { const bf16_t* sp = H + (size_t)tok[q] * DM;
#pragma unroll
            for (int j = 0; j < 4; ++j) { const u32x2 w = *(const u32x2*)(sp + 4 * F.lane + 256 * j); y[q][j] = (f32x4){bflo(w.x), bfhi(w.x), bflo(w.y), bfhi(w.y)}; }
            row_load_bf16(xr[q], F.lane, v[q]); }
#pragma unroll
        for (int q = 0; q < 2; ++q) { row_ln(v[q]); row_affine(v[q], a->in[26] + l * DM, false, a->in[27] + l * DM, F.lane); }
#pragma unroll
        for (int q = 0; q < 2; ++q)
#pragma unroll
            for (int k = 0; k < 8; ++k) { const int e = __shfl(me, q * 8 + k), p = __shfl(mp, q * 8 + k); const float wv = __shfl(mw, q * 8 + k) * 0.0625f;
                const unsigned char* yp = YS + (size_t)(tb[LC_SBASE + e] + p) * DM;
#pragma unroll
                for (int j = 0; j < 4; ++j) { const int w = (int)*(const unsigned*)(yp + 4 * F.lane + 256 * j);
                    y[q][j][0] += wv * __builtin_amdgcn_cvt_f32_fp8(w, 0); y[q][j][1] += wv * __builtin_amdgcn_cvt_f32_fp8(w, 1); y[q][j][2] += wv * __builtin_amdgcn_cvt_f32_fp8(w, 2); y[q][j][3] += wv * __builtin_amdgcn_cvt_f32_fp8(w, 3); } }
#pragma unroll
        for (int q = 0; q < 2; ++q) {
            const float* g2 = mod + bsel[q] * 6144 + 5120;
#pragma unroll
            for (int j = 0; j < 4; ++j) { const f32x4 gv = *(const f32x4*)(g2 + 4 * F.lane + 256 * j); v[q][j] = v[q][j] * DN_ALPHA + gv * y[q][j]; }
            row_ln(v[q]); row_affine(v[q], a->in[36] + l * DM, false, a->in[37] + l * DM, F.lane);
            if (!dry) { if (l == 0) row_store_bf16((bf16_t*)xr[q], F.lane, v[q]); else row_store(xr[q], F.lane, v[q]); } else asm volatile("" :: "v"(v[q][0]), "v"(v[q][1]), "v"(v[q][2]), "v"(v[q][3]));
            if (l == 0 && !dry) { row_ln(v[q]); const float* mrow = mod + 5 * 6144 + bsel[q] * 6144; row_affine(v[q], mrow + 1024, true, mrow, F.lane); row_store_bf16(H + (size_t)tok[q] * DM, F.lane, v[q]); }
        }
    }
}

constexpr int NPHASE = 22;
__global__ void __launch_bounds__(NTHR, 2) mk_fwd(Args args) {
    extern __shared__ __attribute__((aligned(16))) unsigned char lds_raw[];
    Frame F; F.lds = (LAS unsigned char*)lds_raw; F.tid = threadIdx.x; F.lane = F.tid & 63; F.wave = __builtin_amdgcn_readfirstlane(F.tid >> 6);
    F.G = gridDim.x; F.bid = blockIdx.x; F.gw = F.bid * NWAVES + F.wave; F.NGW = F.G * NWAVES; F.ws = args.ws; F.out = args.out; F.vcu = (F.G % 8 == 0) ? (F.bid % 8) * (F.G / 8) + F.bid / 8 : F.bid;
    for (int u = F.tid; u < (LDS_BYTES - LDS_CTL) / 4; u += NTHR) ((LAS unsigned*)(F.lds + LDS_CTL))[u] = 0u;
    __syncthreads();
    const int lo = args.ph_lo, hi = args.ph_hi;
    CArgsP A4 = (CArgsP)__builtin_amdgcn_kernarg_segment_ptr();
    XcdBarrier bar; bar.bar = (unsigned*)(F.ws + CW_BAR_BYTE); bar.x = 0; bar.st = nullptr;
    if (hi - lo > 1) bar = xcd_barrier_post((unsigned*)(F.ws + CW_BAR_BYTE), (volatile LAS unsigned*)(F.lds + LDS_CTL) + LC_BAR);
#ifndef PHMASK
#define PHMASK 0xfff
#endif
#define PH_EN(k) ((PHMASK >> ((k) < 2 ? (k) : 2 + (((k) - 2) % 10))) & 1)
#define IN(k) (PH_EN(k) && lo <= (k) && (k) < hi)
#define SEAM(k) do { if (IN(k) && IN((k) + 1)) { for (int dd = 0; dd < NDUP(14); ++dd) xcd_barrier(bar); } if (TSMASK != 0 && blockIdx.x == 0 && threadIdx.x == 0) { ((volatile LAS unsigned long long*)(F.lds + LDS_CTL + 2048))[(k) + 1] = __builtin_amdgcn_s_memrealtime(); } FRESH(); } while (0)
#define FRESH() do { int t_ = threadIdx.x, b_ = blockIdx.x; CArgsP p_ = (CArgsP)__builtin_amdgcn_kernarg_segment_ptr(); asm volatile("" : "+v"(t_)); asm volatile("" : "+s"(b_), "+s"(p_)); A4 = p_; unsigned char* w_ = p_->ws; float* o_ = p_->out; \
    F.tid = t_; F.lane = t_ & 63; F.wave = __builtin_amdgcn_readfirstlane(t_ >> 6); F.bid = b_; F.gw = b_ * NWAVES + F.wave; F.ws = w_; F.out = o_; F.vcu = (F.G % 8 == 0) ? (b_ % 8) * (F.G / 8) + b_ / 8 : b_; } while (0)
    if (TSMASK != 0 && blockIdx.x == 0 && threadIdx.x == 0) ((volatile LAS unsigned long long*)(F.lds + LDS_CTL + 2048))[0] = __builtin_amdgcn_s_memrealtime();
    if (IN(0)) { for (int dd = 0; dd < NDUP(0); ++dd) phase_prologue(F, A4); } SEAM(0);
    if (IN(1)) { for (int dd = 0; dd < NDUP(1); ++dd) phase_rows0(F, A4); } SEAM(1);
#pragma unroll 1
    for (int l = 0; l < 2; ++l) {
        const int pb = 2 + 10 * l; const bool lat = (l == 1);
        if (IN(pb + 0)) {
            SchedPlain S{(const char*)(F.ws + WS_H), (const char*)(F.ws + WS_WIN) + (size_t)l * INC * 1024 * 2, 1024, 68, 26, F.G, F.bid, false};
            EpiInproj E{F.ws, A4->in[7] + l * INC, (const float*)(F.ws + WS_ROPE)};
            for (int dd = 0; dd < NDUP(2); ++dd) pg8::gemm_phase(F.lds, 1024, S, E);
        } SEAM(pb + 0);
        if (IN(pb + 1)) {
            for (int dd = 0; dd < NDUP(3); ++dd) lru_phase(F, A4, l, 0, false);
            for (int dd = 0; dd < NDUP(4); ++dd)
            for (int it = F.bid; it < 136 * 4; it += F.G) { const int chunk = it >> 2; if (lat && (chunk % 34) < 2) continue; sg_item(F, A4, l, chunk, it & 3); }
        } SEAM(pb + 1);
        if (IN(pb + 2)) { for (int dd = 0; dd < NDUP(5); ++dd) phase_carry(F); } SEAM(pb + 2);
        if (IN(pb + 3)) { phase_attn(F, A4, l); } SEAM(pb + 3);
        if (IN(pb + 4)) {
            for (int dd = 0; dd < NDUP(8); ++dd) {
                SchedMerge S{(const char*)(F.ws + OV_OA), (const char*)(F.ws + WS_WBR) + (size_t)(l * 3) * 1024 * 512 * 2, F.G, F.bid};
                EpiMerge E{(bf16_t*)(F.ws + OV_MG), (const bf16_t*)(F.ws + OV_G)};
                pg8::gemm_phase(F.lds, 512, S, E);
            }
            if (!lat) mini_merge_ctx(F, l);
        } SEAM(pb + 4);
        if (IN(pb + 5)) {
            SchedPlain S{(const char*)(F.ws + OV_MG), (const char*)(F.ws + WS_WOUT) + (size_t)l * 1048576 * 2, 1024, 64, 4, F.G, F.bid, true};
            EpiWout E{F.out, (float*)(F.ws + WS_XC), (const float*)(F.ws + WS_MOD) + l * 5 * 6144, false};
            pg8::gemm_phase(F.lds, 1024, S, E);
            if (NDUP(11) > 1) { EpiWout E2{F.out, (float*)(F.ws + WS_XC), (const float*)(F.ws + WS_MOD) + l * 5 * 6144, true}; pg8::gemm_phase(F.lds, 1024, S, E2); }
            if (!lat) mini_wout_ctx(F, l);
        } SEAM(pb + 5);
        if (IN(pb + 6)) { phase_router(F, A4, l, false); if (NDUP(12) > 1) phase_router(F, A4, l, F.G != 12345); } SEAM(pb + 6);
        if (IN(pb + 7)) {
            build_tables(F, l);
            SchedMoe S{(const char*)(F.ws + WS_H), (const char*)(F.ws + WS_H), (const char*)(F.ws + WS_WM1), (const char*)(F.ws + WS_WSH1) + (size_t)l * 524288 * 2,
                       (const int*)(F.ws + WS_LIST), (const LAS int*)(F.lds + LDS_CTL), 1024, 2, F.G, F.vcu, lat ? 64 : 68, lat, true, (size_t)524288 * 2};
            EpiMoe1 E{(bf16_t*)(F.ws + OV_ACT), (bf16_t*)(F.ws + OV_ACTSH)};
            for (int dd = 0; dd < NDUP(9); ++dd) pg8::gemm_phase(F.lds, 1024, S, E);
        } SEAM(pb + 7);
        if (IN(pb + 8)) {
            build_tables(F, l);
            SchedMoe S{(const char*)(F.ws + OV_ACT), (const char*)(F.ws + OV_ACTSH), (const char*)(F.ws + WS_WM2), (const char*)(F.ws + WS_WSH2) + (size_t)l * 262144 * 2,
                       (const int*)(F.ws + WS_LIST), (const LAS int*)(F.lds + LDS_CTL), 256, 4, F.G, F.vcu, lat ? 64 : 68, lat, false, (size_t)262144 * 2};
            EpiMoe2 E{(unsigned char*)(F.ws + OV_YS), (bf16_t*)(F.ws + WS_H)};
            for (int dd = 0; dd < NDUP(10); ++dd) pg8::gemm_phase(F.lds, 256, S, E);
        } SEAM(pb + 8);
        if (IN(pb + 9)) {
            build_tables(F, l);
            phase_combine(F, A4, l, false);
            if (NDUP(13) > 1) phase_combine(F, A4, l, F.G != 12345);
            if (l == 0) for (int dd = 0; dd < NDUP(15); ++dd) conv_moe_layer(F, A4, 1);
        } SEAM(pb + 9);
    }
    if (TSMASK != 0 && hi - lo == NPHASE) { __syncthreads(); asm volatile("s_waitcnt vmcnt(0)" ::: "memory");
        if (blockIdx.x == 0 && threadIdx.x == 0) { volatile LAS unsigned long long* ts = (volatile LAS unsigned long long*)(F.lds + LDS_CTL + 2048);
            unsigned long long sel = 0; for (int k = 0; k < NPHASE; ++k) if ((TSMASK >> k) & 1) sel += ts[k + 1] - ts[k];
            const float frac = (float)sel / (float)(ts[NPHASE] - ts[0]); args.out[0] += 1.0f + floorf(90.0f * frac + 0.5f); } }
#undef IN
#undef SEAM
}

extern "C" void kernel_launch(void* const* d_in, const int* in_sizes, int n_in, void* d_out, int out_size, void* d_ws, size_t ws_size, hipStream_t stream) {
    static int grid = 0;
    if (grid == 0) {
        if (n_in != 38 || out_size != NBATCH * SEQ * DM || ws_size < WS_END) { fprintf(stderr, "kernel_launch: unexpected shapes (n_in %d out %d ws %zu need %zu)\n", n_in, out_size, ws_size, (size_t)WS_END); grid = -1; return; }
        int dev = 0, cus = 0;
        if (hipGetDevice(&dev) != hipSuccess || hipDeviceGetAttribute(&cus, hipDeviceAttributeMultiprocessorCount, dev) != hipSuccess) { grid = -1; return; }
        if (hipFuncSetAttribute((const void*)mk_fwd, hipFuncAttributeMaxDynamicSharedMemorySize, LDS_BYTES) != hipSuccess) { fprintf(stderr, "kernel_launch: hipFuncSetAttribute failed\n"); grid = -1; return; }
        int per_cu = 0;
        if (hipOccupancyMaxActiveBlocksPerMultiprocessor(&per_cu, (const void*)mk_fwd, NTHR, LDS_BYTES) != hipSuccess || per_cu < 1) fprintf(stderr, "kernel_launch: occupancy query says %d\n", per_cu);
        (void)hipGetLastError();
        grid = cus;
    }
    if (grid < 0) return;
    (void)hipMemsetAsync((char*)d_ws + WS_CTL, 0, CTL_ZERO_BYTES, stream);
    Args a{};
    for (int i = 0; i < 38; ++i) a.in[i] = (const float*)d_in[i];
    a.out = (float*)d_out; a.ws = (unsigned char*)d_ws;
#if MK_MULTI
    for (int p = 0; p < NPHASE; ++p) { a.ph_lo = p; a.ph_hi = p + 1; hipLaunchKernelGGL(mk_fwd, dim3(grid), dim3(NTHR), LDS_BYTES, stream, a); }
#else
    a.ph_lo = 0; a.ph_hi = NPHASE; hipLaunchKernelGGL(mk_fwd, dim3(grid), dim3(NTHR), LDS_BYTES, stream, a);
#endif
}
```

```cpp
#include <hip/hip_runtime.h>
#include <cstdio>
#include <cstdint>
#include <cmath>

#ifndef MK_MULTI
#define MK_MULTI 0
#endif
#ifndef DUPMASK
#define DUPMASK 0
#endif
#define NDUP(c) (1 + ((DUPMASK >> (c)) & 1))
#ifndef TSMASK
#define TSMASK 0
#endif
#ifndef NAIVE_GEMM
#define NAIVE_GEMM 0
#endif

#define LAS __attribute__((address_space(3)))
#define GAS __attribute__((address_space(1)))
typedef unsigned short bf16_t;
typedef short bf16x8 __attribute__((ext_vector_type(8)));
typedef short s16x4 __attribute__((ext_vector_type(4)));
typedef float f32x4 __attribute__((ext_vector_type(4)));
typedef float f32x16 __attribute__((ext_vector_type(16)));
typedef unsigned u32x4 __attribute__((ext_vector_type(4)));
typedef unsigned u32x2 __attribute__((ext_vector_type(2)));

constexpr int DM = 1024, NBATCH = 4, SEQ = 4096, CTX = 256, TPB = SEQ + CTX  , T = NBATCH * TPB  ;
constexpr int INC = 6656, NEXP = 64;
constexpr float DN_ALPHA = 1.41421356237309515f;
constexpr float LN_EPS = 1e-6f, RMS_EPS = 1e-5f;
constexpr int NWAVES = 8, NTHR = 512;

constexpr size_t MiB = 1u << 20;
constexpr size_t WS_CTL = 0, CTL_ZERO_BYTES = 1 * MiB;
constexpr size_t CW_BAR_BYTE = 16384;
constexpr size_t WS_CNT = 65536;
constexpr size_t WS_MOD = 131072;
constexpr size_t WS_ROPE = 1 * MiB;
constexpr size_t WS_LAM = 1 * MiB + 8192;
constexpr size_t WS_SUM = 1 * MiB + 65536;
constexpr size_t WS_HIN = WS_SUM + 2304 * 1024;
constexpr size_t WS_TOKE = 5 * MiB, WS_TOKP = 6 * MiB, WS_TOKW = 7 * MiB;
constexpr size_t WS_LIST = 8 * MiB;
constexpr size_t WS_XC = 13 * MiB;
constexpr size_t WS_WLRU = 17 * MiB;
constexpr size_t WS_WSG = 17 * MiB + 512 * 1024;
constexpr size_t WS_WRT = 17 * MiB + 768 * 1024;
constexpr size_t WS_WSH1 = 18 * MiB;
constexpr size_t WS_WSH2 = 20 * MiB;
constexpr size_t WS_WOUT = 21 * MiB;
constexpr size_t WS_WBR = 25 * MiB;
constexpr size_t WS_WIN = 31 * MiB;
constexpr size_t WS_WM1 = 57 * MiB;
constexpr size_t WS_WM2 = 121 * MiB;
constexpr size_t WS_H = 153 * MiB;
constexpr size_t WS_OV = 187 * MiB;
constexpr size_t OV_Q = WS_OV, OV_K = WS_OV + 17 * MiB, OV_V = WS_OV + 34 * MiB, OV_U = WS_OV + 51 * MiB, OV_S = WS_OV + 68 * MiB,
                 OV_X = WS_OV + 85 * MiB, OV_Y = WS_OV + 102 * MiB, OV_G = WS_OV + 119 * MiB, OV_OA = WS_OV + 221 * MiB,
                 OV_OB = WS_OV + 238 * MiB, OV_OC = WS_OV + 255 * MiB, OV_MG = WS_OV + 272 * MiB;
constexpr size_t OV_ACT = WS_OV, OV_ACTSH = WS_OV + 69 * MiB, OV_YS = WS_OV + 78 * MiB;
constexpr size_t WS_END = WS_OV + 350 * MiB;

constexpr int LDS_SCRATCH = 147456;
constexpr int LDS_CTL = LDS_SCRATCH;
constexpr int LDS_BYTES = LDS_SCRATCH + 4096;
constexpr int LC_BAR = 0;
constexpr int LC_TCNT = 64, LC_TBASE = 64 + 80, LC_SBASE = 64 + 160;

struct Args { const float* in[38]; float* out; unsigned char* ws; int ph_lo, ph_hi; };
typedef const Args __attribute__((address_space(4)))* CArgsP;

__device__ __forceinline__ unsigned f2bf(float f) { unsigned u = __builtin_bit_cast(unsigned, f); return (u + 0x7fffu + ((u >> 16) & 1u)) >> 16; }
typedef float f32x2 __attribute__((ext_vector_type(2))); typedef __bf16 bf16x2_t __attribute__((ext_vector_type(2)));
__device__ __forceinline__ unsigned pk2(float lo, float hi) { const f32x2 v = {lo, hi}; const bf16x2_t b = __builtin_convertvector(v, bf16x2_t); return __builtin_bit_cast(unsigned, b); }
__device__ __forceinline__ float bflo(unsigned w) { return __builtin_bit_cast(float, w << 16); }
__device__ __forceinline__ float bfhi(unsigned w) { return __builtin_bit_cast(float, w & 0xffff0000u); }
__device__ __forceinline__ float bf2f(bf16_t b) { return __builtin_bit_cast(float, (unsigned)b << 16); }
#define WS_DPP(v, ctrl, rmask, bc) __builtin_bit_cast(float, __builtin_amdgcn_update_dpp(0, __builtin_bit_cast(int, v), ctrl, rmask, 0xF, bc))
__device__ __forceinline__ float wave_sum(float v) {
    v += WS_DPP(v, 0xB1, 0xF, true); v += WS_DPP(v, 0x4E, 0xF, true); v += WS_DPP(v, 0x141, 0xF, true); v += WS_DPP(v, 0x140, 0xF, true);
    v += WS_DPP(v, 0x142, 0xA, false); v += WS_DPP(v, 0x143, 0xC, false);
    return __builtin_bit_cast(float, __builtin_amdgcn_readlane(__builtin_bit_cast(int, v), 63));
}
__device__ __forceinline__ float sigmoidf_(float x) { return __builtin_amdgcn_rcpf(1.f + __builtin_amdgcn_exp2f(-1.4426950408889634f * x)); }
__device__ __forceinline__ float gelu_tanh(float x) { const float u = x * (0.7978845608028654f + 0.035677408136300125f * x * x); return x * __builtin_amdgcn_rcpf(1.f + __builtin_amdgcn_exp2f(-2.885390081777927f * u)); }
__device__ __forceinline__ float silu_(float x) { return x * __builtin_amdgcn_rcpf(1.f + __builtin_amdgcn_exp2f(-1.4426950408889634f * x)); }
__device__ __forceinline__ float expm1_fast(float x) {
    if (x > -0.5f && x < 0.5f) { float p = 1.0f + x * (1.0f / 8.0f); p = 1.0f + x * (1.0f / 7.0f) * p; p = 1.0f + x * (1.0f / 6.0f) * p; p = 1.0f + x * 0.2f * p; p = 1.0f + x * 0.25f * p; p = 1.0f + x * (1.0f / 3.0f) * p; p = 1.0f + x * 0.5f * p; return x * p; }
    return expm1f(x);
}
#define LDS_WAIT() asm volatile("s_waitcnt lgkmcnt(0)" ::: "memory")
#define VM_WAIT() asm volatile("s_waitcnt vmcnt(0)" ::: "memory")

#define XB_TMO      128
#define XB_XCNT(j)  (256  + 64 * (j))
#define XB_XSUB(j)  (1280 + 64 * (j))
#define XB_XGEN(j)  (2304 + 64 * (j))
#define XB_TOP      3328
#define XB_TOPGEN   3392
#define XCD_BAR_WORDS 3456
#define XB_SPIN_CAP (1u << 22)
__device__ __forceinline__ unsigned xb_ld(unsigned* p)              { return __hip_atomic_load(p, __ATOMIC_RELAXED, __HIP_MEMORY_SCOPE_AGENT); }
__device__ __forceinline__ unsigned xb_add(unsigned* p, unsigned v) { return __hip_atomic_fetch_add(p, v, __ATOMIC_RELAXED, __HIP_MEMORY_SCOPE_AGENT); }
__device__ __forceinline__ unsigned xb_xcc_id() { return (unsigned)__builtin_amdgcn_s_getreg((3 << 11) | 20) & 0xFu; }
#define XB_SPIN(cond, bar) do { unsigned _sp = 0; while (cond) { __builtin_amdgcn_s_sleep(1); \
    if ((++_sp & 255u) == 0u) { if (xb_ld(&(bar)[XB_TMO])) break; if (_sp > XB_SPIN_CAP) { atomicAdd(&(bar)[XB_TMO], 1u); break; } } } } while (0)
struct XcdBarrier { unsigned* bar; unsigned x; volatile LAS unsigned* st; };
__device__ __forceinline__ XcdBarrier xcd_barrier_post(unsigned* bar, volatile LAS unsigned* st) {
    XcdBarrier b; b.bar = bar; b.x = xb_xcc_id(); b.st = st;
    if (threadIdx.x == 0) (void)xb_add(&bar[XB_XCNT(b.x)], 1u);
    return b;
}
__device__ __forceinline__ void xcd_barrier_complete(unsigned* bar, unsigned x, unsigned& nloc, unsigned& nx) {
    const unsigned G = gridDim.x * gridDim.y * gridDim.z;
    unsigned sum, cnt, mine, sp = 0u;
    for (;;) {
        sum = 0u; cnt = 0u; mine = 0u;
#pragma unroll
        for (unsigned j = 0; j < 16; ++j) { const unsigned c = xb_ld(&bar[XB_XCNT(j)]); sum += c; cnt += (c > 0u) ? 1u : 0u; mine = (j == x) ? c : mine; }
        if (sum == G) break;
        __builtin_amdgcn_s_sleep(1);
        if ((++sp & 255u) == 0u) { if (xb_ld(&bar[XB_TMO])) break; if (sp > XB_SPIN_CAP) { atomicAdd(&bar[XB_TMO], 1u); break; } }
    }
    nloc = mine > 0u ? mine : 1u; nx = cnt > 0u ? cnt : 1u;
}
__device__ __forceinline__ void xcd_barrier(const XcdBarrier& b) {
    asm volatile("s_waitcnt vmcnt(0)" ::: "memory");
    __syncthreads();
    if (threadIdx.x == 0) {
        unsigned* bar = b.bar; asm volatile("" : "+s"(bar));
        __builtin_amdgcn_s_waitcnt(0);
        unsigned nloc = b.st[0], nx = b.st[1];
        if (nloc == 0u) { xcd_barrier_complete(bar, b.x, nloc, nx); b.st[0] = nloc; b.st[1] = nx; }
        const unsigned old = xb_add(&bar[XB_XSUB(b.x)], 1u);
        const unsigned gen = old / nloc;
        if (old + 1u == (gen + 1u) * nloc) {
            __builtin_amdgcn_fence(__ATOMIC_RELEASE, "agent");
            asm volatile("s_waitcnt vmcnt(0)" ::: "memory");
            const unsigned og = xb_add(&bar[XB_TOP], 1u);
            const unsigned tg = og / nx;
            if (og + 1u == (tg + 1u) * nx) xb_add(&bar[XB_TOPGEN], 1u);
            else XB_SPIN(xb_ld(&bar[XB_TOPGEN]) == tg, bar);
            __builtin_amdgcn_fence(__ATOMIC_ACQUIRE, "agent");
            xb_add(&bar[XB_XGEN(b.x)], 1u);
            asm volatile("s_waitcnt vmcnt(0)" ::: "memory");
        } else {
            XB_SPIN(xb_ld(&bar[XB_XGEN(b.x)]) == gen, bar);
            __builtin_amdgcn_fence(__ATOMIC_ACQUIRE, "agent");
            asm volatile("s_waitcnt vmcnt(0)" ::: "memory");
        }
    }
    __syncthreads();
}

namespace pg8 {
constexpr int BM = 256, BK = 64, HALF = 128, HTB = HALF * BK * 2, STAGE_BYTES = 8 * HTB, NXCD = 8, WGM = 8;
__host__ __device__ __forceinline__ int lds_byte(int r, int c) { const int st = (r >> 4) * 2 + (c >> 5), rr = r & 15, cc = c & 31, ob = rr * 64 + cc * 2; return st * 1024 + (ob ^ (((ob >> 9) & 1) << 5)); }
__host__ __device__ __forceinline__ void stage_rc(int b, int& R, int& C) { const int st = b / 1024, sb = b % 1024, swz = sb ^ (((sb >> 9) & 1) << 5); R = (st >> 1) * 16 + swz / 64; C = (st & 1) * 32 + (swz % 64) / 2; }
__host__ __device__ __forceinline__ int perm32(int rho) { const int n = rho >> 4, i = rho & 15; return 8 * (i >> 2) + 4 * n + (i & 3); }
struct Unit { int pm, pn, e, ti, nrows, row0; };
typedef f32x4 Acc[2][2][4][2];

template <class Epi, class Sched>
__device__ __forceinline__ void gemm_phase(LAS unsigned char* lds, const int K, const Sched& S, const Epi& E) {
    int tid_ = threadIdx.x; asm volatile("" : "+v"(tid_));
    const int tid = tid_, wid = __builtin_amdgcn_readfirstlane(tid >> 6), lane = tid & 63, wr = wid >> 2, wc = wid & 3, fr = lane & 15, fq = lane >> 4;
    (void)fr; (void)fq; (void)wc;
    Unit cur, nxt; int ui = 0;
    if (!S.next(0, cur)) return;
    Acc acc;
#pragma unroll
    for (int a = 0; a < 2; ++a)
#pragma unroll
        for (int b = 0; b < 2; ++b)
#pragma unroll
            for (int m = 0; m < 4; ++m)
#pragma unroll
                for (int n = 0; n < 2; ++n) acc[a][b][m][n] = (f32x4){0.f, 0.f, 0.f, 0.f};
#if NAIVE_GEMM
    for (;;) {
        const char* Ab = S.a_base(); const char* Bb = S.b_ptr(cur);
#pragma unroll 1
        for (int ai = 0; ai < 2; ++ai)
#pragma unroll 1
            for (int m = 0; m < 4; ++m) {
                const int rr = ai * 128 + wr * 64 + m * 16 + fr;
                const bf16_t* ap = (const bf16_t*)(Ab + S.a_off(cur, rr));
#pragma unroll
                for (int bj = 0; bj < 2; ++bj)
#pragma unroll
                    for (int n = 0; n < 2; ++n)
#pragma unroll
                        for (int j = 0; j < 4; ++j) {
                            const int cc = Epi::PERM ? bj * 128 + wc * 32 + fq * 8 + n * 4 + j : bj * 128 + wc * 32 + n * 16 + fq * 4 + j;
                            const bf16_t* bp = (const bf16_t*)(Bb + (size_t)cc * K * 2);
                            float s = 0.f;
                            for (int k = 0; k < K; k += 8) {
                                const u32x4 av = *(const u32x4*)(ap + k), bv = *(const u32x4*)(bp + k);
                                s += bflo(av.x) * bflo(bv.x) + bfhi(av.x) * bfhi(bv.x) + bflo(av.y) * bflo(bv.y) + bfhi(av.y) * bfhi(bv.y)
                                   + bflo(av.z) * bflo(bv.z) + bfhi(av.z) * bfhi(bv.z) + bflo(av.w) * bflo(bv.w) + bfhi(av.w) * bfhi(bv.w);
                            }
                            acc[ai][bj][m][n][j] = s;
                        }
            }
        E(acc, cur, wr, wc, fr, fq);
        ++ui;
        if (!S.next(ui, cur)) break;
    }
    return;
#else
    const int nt = K / BK;
    unsigned voffB[2];
    { int Rr[2], Cc[2];
#pragma unroll
      for (int i = 0; i < 2; ++i) { stage_rc(tid * 16 + i * 8192, Rr[i], Cc[i]); const int Rb = Epi::PERM ? ((Rr[i] & ~31) + perm32(Rr[i] & 31)) : Rr[i]; voffB[i] = (unsigned)(Rb * K + Cc[i]) * 2u; } }
#define PG8_AOFFS(U, o00, o01, o10, o11) do { int t3_ = threadIdx.x; asm volatile("" : "+v"(t3_)); int R0_, C0_, R1_, C1_; stage_rc(t3_ * 16, R0_, C0_); stage_rc(t3_ * 16 + 8192, R1_, C1_); \
        o00 = S.a_off(U, R0_) + (unsigned)C0_ * 2u; o01 = S.a_off(U, R1_) + (unsigned)C1_ * 2u; o10 = S.a_off(U, HALF + R0_) + (unsigned)C0_ * 2u; o11 = S.a_off(U, HALF + R1_) + (unsigned)C1_ * 2u; } while (0)
    const size_t kstep = (size_t)(BK * 2);
    const size_t hstep = (size_t)HALF * K * 2;
    const unsigned ldsw = (unsigned)wid * 1024u;
    const int aoff = lds_byte(wr * 64 + fr, fq * 8), boff = lds_byte(wc * 32 + fr, fq * 8);
#define PG8_SA(b, h) (((b) * 2 + (h)) * HTB)
#define PG8_SB(b, h) ((4 + (b) * 2 + (h)) * HTB)
#define PG8_STAGE(bufoff, gbase, v0, v1) do { \
        __builtin_amdgcn_global_load_lds((const unsigned*)((const char*)(gbase) + (v0)), (LAS unsigned*)(lds + (bufoff) + ldsw), 16, 0, 0); \
        __builtin_amdgcn_global_load_lds((const unsigned*)((const char*)(gbase) + (v1)), (LAS unsigned*)(lds + (bufoff) + ldsw + 8192), 16, 0, 0); } while (0)
#define PG8_LDA(dst, b, h) do { _Pragma("unroll") for (int m = 0; m < 4; ++m) _Pragma("unroll") for (int k = 0; k < 2; ++k) dst[m][k] = *(const LAS bf16x8*)(lds + PG8_SA(b, h) + aoff + m * 2048 + k * 1024); } while (0)
#define PG8_LDB(dst, b, h) do { _Pragma("unroll") for (int n = 0; n < 2; ++n) _Pragma("unroll") for (int k = 0; k < 2; ++k) dst[n][k] = *(const LAS bf16x8*)(lds + PG8_SB(b, h) + boff + n * 2048 + k * 1024); } while (0)
#define PG8_MMA(ai, bj, At, Bt) do { __builtin_amdgcn_s_setprio(1); _Pragma("unroll") for (int m = 0; m < 4; ++m) _Pragma("unroll") for (int n = 0; n < 2; ++n) _Pragma("unroll") for (int k = 0; k < 2; ++k) \
        acc[ai][bj][m][n] = __builtin_amdgcn_mfma_f32_16x16x32_bf16(Bt[n][k], At[m][k], acc[ai][bj][m][n], 0, 0, 0); __builtin_amdgcn_s_setprio(0); } while (0)
#define PG8_WAIT_V(n) asm volatile("s_waitcnt vmcnt(" #n ")" ::: "memory")
#define PG8_WAIT_L(n) asm volatile("s_waitcnt lgkmcnt(" #n ")" ::: "memory")
#define PG8_BAR __builtin_amdgcn_s_barrier()
#define PG8_SCHED __builtin_amdgcn_sched_barrier(0)
    bf16x8 At[4][2], B0[2][2], B1[2][2];
    const char* const Ab = S.a_base();
    unsigned vA00, vA01, vA10, vA11;
    PG8_AOFFS(cur, vA00, vA01, vA10, vA11);
    const char* cB = S.b_ptr(cur);
    PG8_STAGE(PG8_SB(0, 0), cB, voffB[0], voffB[1]); PG8_STAGE(PG8_SB(0, 1), cB + hstep, voffB[0], voffB[1]); PG8_STAGE(PG8_SA(0, 0), Ab, vA00, vA01); PG8_STAGE(PG8_SA(0, 1), Ab, vA10, vA11);
    if (wr == 1) PG8_BAR;
    PG8_WAIT_V(2); PG8_BAR;
    PG8_STAGE(PG8_SB(1, 0), cB + kstep, voffB[0], voffB[1]); PG8_STAGE(PG8_SA(1, 0), Ab + kstep, vA00, vA01); PG8_STAGE(PG8_SB(1, 1), cB + hstep + kstep, voffB[0], voffB[1]);
    PG8_WAIT_V(6); PG8_BAR;
    for (;;) {
        const bool has_next = S.next(ui + 1, nxt);
        unsigned vN00 = vA00, vN01 = vA01, vN10 = vA10, vN11 = vA11; const char* nB = cB;
        if (has_next) { PG8_AOFFS(nxt, vN00, vN01, vN10, vN11); nB = S.b_ptr(nxt); }
        for (int t = 0; t < nt; t += 2) {
            const bool last = (t == nt - 2);
            const char* a1 = Ab + (size_t)(t + 1) * kstep;
            const char* a2 = last ? Ab : Ab + (size_t)(t + 2) * kstep; const char* b2 = last ? nB : cB + (size_t)(t + 2) * kstep;
            const char* a3 = a2 + kstep; const char* b3 = b2 + kstep;
            const unsigned w00 = last ? vN00 : vA00, w01 = last ? vN01 : vA01, w10 = last ? vN10 : vA10, w11 = last ? vN11 : vA11;
            PG8_LDB(B0, 0, 0); PG8_LDB(B1, 0, 1); PG8_SCHED; PG8_LDA(At, 0, 0); PG8_STAGE(PG8_SA(1, 1), a1, vA10, vA11);
            PG8_WAIT_V(8); PG8_WAIT_L(0); PG8_BAR; PG8_MMA(0, 0, At, B0); PG8_MMA(0, 1, At, B1); PG8_BAR; PG8_SCHED;
            PG8_LDA(At, 0, 1); PG8_STAGE(PG8_SB(0, 0), b2, voffB[0], voffB[1]); PG8_STAGE(PG8_SB(0, 1), b2 + hstep, voffB[0], voffB[1]); PG8_STAGE(PG8_SA(0, 0), a2, w00, w01);
            PG8_WAIT_V(8); PG8_WAIT_L(0); PG8_BAR; PG8_MMA(1, 0, At, B0); PG8_MMA(1, 1, At, B1); PG8_BAR; PG8_SCHED;
            PG8_LDB(B0, 1, 0); PG8_LDB(B1, 1, 1); PG8_SCHED; PG8_LDA(At, 1, 0); PG8_STAGE(PG8_SA(0, 1), a2, w10, w11);
            PG8_WAIT_V(8); PG8_WAIT_L(0); PG8_BAR; PG8_MMA(0, 0, At, B0); PG8_MMA(0, 1, At, B1); PG8_BAR; PG8_SCHED;
            PG8_LDA(At, 1, 1); PG8_STAGE(PG8_SB(1, 0), b3, voffB[0], voffB[1]); PG8_STAGE(PG8_SB(1, 1), b3 + hstep, voffB[0], voffB[1]); PG8_STAGE(PG8_SA(1, 0), a3, w00, w01);
            PG8_WAIT_V(8); PG8_WAIT_L(0); PG8_BAR; PG8_MMA(1, 0, At, B0); PG8_MMA(1, 1, At, B1); PG8_BAR; PG8_SCHED;
        }
        if (wr == 0) PG8_BAR;
        { int t2_ = threadIdx.x; asm volatile("" : "+v"(t2_)); const int l2_ = t2_ & 63; E(acc, cur, wr, wc, l2_ & 15, l2_ >> 4); }
        if (!has_next) break;
#pragma unroll
        for (int a = 0; a < 2; ++a)
#pragma unroll
            for (int b = 0; b < 2; ++b)
#pragma unroll
                for (int m = 0; m < 4; ++m)
#pragma unroll
                    for (int n = 0; n < 2; ++n) acc[a][b][m][n] = (f32x4){0.f, 0.f, 0.f, 0.f};
        cur = nxt; vA00 = vN00; vA01 = vN01; vA10 = vN10; vA11 = vN11; cB = nB; ++ui;
        if (wr == 1) PG8_BAR;
    }
    PG8_WAIT_V(0);
    PG8_BAR;
#undef PG8_SA
#undef PG8_AOFFS
#undef PG8_SB
#undef PG8_STAGE
#undef PG8_LDA
#undef PG8_LDB
#undef PG8_MMA
#undef PG8_WAIT_V
#undef PG8_WAIT_L
#undef PG8_BAR
#undef PG8_SCHED
#endif
}
}
using pg8::Unit;
using pg8::Acc;

__device__ __forceinline__ float* resid_row(float* out, float* xc, int tok) {
    const int b = tok / TPB, j = tok - b * TPB;
    return j < CTX ? xc + ((size_t)(b * CTX + j)) * DM : out + ((size_t)(b * SEQ + j - CTX)) * DM;
}
__device__ __forceinline__ int tile_to_pm(int i, bool latent_only) { return latent_only ? (i >> 4) * 17 + 1 + (i & 15) : i; }

__device__ __forceinline__ bool static_order(int i, int G, int c, int nM, int nN, int& pm, int& pn) {
    const int nwg = nM * nN; const long L = (long)i * G + c; if (L >= nwg) return false;
    int wgid = (int)L; { const int q = nwg / 8, r = nwg % 8, xcd = wgid % 8, off = wgid / 8; wgid = (xcd < r ? xcd * (q + 1) : r * (q + 1) + (xcd - r) * q) + off; }
    const int nig = 8 * nN, gid = wgid / nig, fm = gid * 8, gsz = (nM - fm) < 8 ? (nM - fm) : 8;
    pm = fm + ((wgid % nig) % gsz); pn = (wgid % nig) / gsz; return true;
}

struct SchedPlain {
    const char* A; const char* Bt; int K, nM, nN, G, c; bool lat;
    __device__ __forceinline__ bool next(int i, Unit& u) const {
        int pm, pn; if (!static_order(i, G, c, nM, nN, pm, pn)) return false;
        u.pm = tile_to_pm(pm, lat); u.pn = pn; u.e = 0; u.ti = 0; u.nrows = 256; u.row0 = u.pm * 256; return true;
    }
    __device__ __forceinline__ const char* a_base() const { return A; }
    __device__ __forceinline__ unsigned a_off(const Unit& u, int rr) const { return (unsigned)(u.row0 + rr) * (unsigned)(K * 2); }
    __device__ __forceinline__ const char* b_ptr(const Unit& u) const { return Bt + (size_t)u.pn * 256 * K * 2; }
};

struct SchedMerge {
    const char* A0; const char* Bt0; int G, c;
    __device__ __forceinline__ bool next(int i, Unit& u) const {
        const int ti = i / 3, r = i - 3 * ti; int pm, pn; if (!static_order(ti, G, c, 64, 4, pm, pn)) return false;
        u.pm = tile_to_pm(pm, true); u.pn = pn; u.e = r; u.ti = 0; u.nrows = 256; u.row0 = u.pm * 256; return true;
    }
    __device__ __forceinline__ const char* a_base() const { return A0; }
    __device__ __forceinline__ unsigned a_off(const Unit& u, int rr) const { return (unsigned)u.e * (unsigned)(17 * MiB) + (unsigned)(u.row0 + rr) * 1024u; }
    __device__ __forceinline__ const char* b_ptr(const Unit& u) const { return Bt0 + ((size_t)u.e * 1024 * 512 + (size_t)u.pn * 256 * 512) * 2; }
};

struct SchedMoe {
    const char* A;
    const char* Ash;
    const char* Bt; const char* Btsh; const int* list;
    const LAS int* tb;
    int K, nN, G, c, nsh; bool lat, gather; size_t bstride;
    __device__ __forceinline__ bool next(int i, Unit& u) const {
        const int nrt = tb[LC_TBASE + 64], L = i * G + c, tot = (nrt + nsh) * nN;
        if (L >= tot) return false;
        const int rt = L / nN; u.pn = L - rt * nN;
        if (rt < nrt) {
            int e = 0;
#pragma unroll 1
            for (int s = 32; s > 0; s >>= 1) if (e + s < 64 && tb[LC_TBASE + e + s] <= rt) e += s;
            u.e = e; u.ti = rt - tb[LC_TBASE + e]; const int cnt = tb[LC_TCNT + e]; const int rem = cnt - u.ti * 256;
            u.nrows = rem < 256 ? rem : 256; u.row0 = tb[LC_SBASE + e] + u.ti * 256; u.pm = 0;
        } else { u.e = 64; u.ti = rt - nrt; u.pm = tile_to_pm(u.ti, lat); u.nrows = 256; u.row0 = u.pm * 256; }
        return true;
    }
    __device__ __forceinline__ const char* a_base() const { return A; }
    __device__ __forceinline__ unsigned a_off(const Unit& u, int rr) const {
        if (u.e == 64) return (unsigned)(Ash - A) + (unsigned)(u.row0 + rr) * (unsigned)(K * 2);
        if (gather) { const int r2 = rr < u.nrows ? rr : u.nrows - 1; const int tok = list[(size_t)u.e * T + u.ti * 256 + r2]; return (unsigned)tok * (unsigned)(K * 2); }
        return (unsigned)(u.row0 + rr) * (unsigned)(K * 2);
    }
    __device__ __forceinline__ const char* b_ptr(const Unit& u) const { return (u.e == 64 ? Btsh : Bt + (size_t)u.e * bstride) + (size_t)u.pn * 256 * K * 2; }
};

#define EPI_FOR_ROWS  _Pragma("unroll") for (int ai = 0; ai < 2; ++ai) _Pragma("unroll") for (int m = 0; m < 4; ++m)
#define EPI_FOR_COLS  _Pragma("unroll") for (int bj = 0; bj < 2; ++bj) _Pragma("unroll") for (int n = 0; n < 2; ++n)

struct EpiInproj {
    static constexpr bool PERM = false;
    unsigned char* ws; const float* bias; const float* rope;
    __device__ __forceinline__ void operator()(const Acc& acc, const Unit& u, int wr, int wc, int fr, int fq) const {
        const int pn = u.pn; const bool isg = pn >= 14; const int seg = pn >> 1;
        bf16_t* base = (bf16_t*)(ws + (isg ? OV_G : OV_Q + (size_t)seg * 17 * MiB));
        const int ld = isg ? 3072 : 512, coff = isg ? (pn - 14) * 256 : (pn & 1) * 256;
        const bool latent = (u.pm % 17) != 0;
        f32x4 bv[2][2];
        EPI_FOR_COLS bv[bj][n] = *(const f32x4*)(bias + pn * 256 + bj * 128 + wc * 32 + n * 16 + fq * 4);
        EPI_FOR_ROWS {
            const int row = u.row0 + ai * 128 + wr * 64 + m * 16 + fr;
            bf16_t* rp = base + (size_t)row * ld + coff + wc * 32 + fq * 4;
            f32x4 v[2][2];
            EPI_FOR_COLS v[bj][n] = acc[ai][bj][m][n] + bv[bj][n];
            if (seg < 2 && !isg) {
                if (latent) {
                    const int pos = (row % TPB) - CTX; const int pa = (wc & 1) ? (pos & 63) : (pos >> 6);
                    const f32x4 c0 = *(const f32x4*)(rope + (pa * 16 + fq * 4) * 2), c1 = *(const f32x4*)(rope + (pa * 16 + fq * 4) * 2 + 4);
                    const float cs[4] = {c0[0], c0[2], c1[0], c1[2]}, sn[4] = {c0[1], c0[3], c1[1], c1[3]};
#pragma unroll
                    for (int bj = 0; bj < 2; ++bj)
#pragma unroll
                        for (int j = 0; j < 4; ++j) { const float a = v[bj][0][j], b = v[bj][1][j]; v[bj][0][j] = a * cs[j] - b * sn[j]; v[bj][1][j] = b * cs[j] + a * sn[j]; }
                }
                if (seg == 0) { EPI_FOR_COLS v[bj][n] = v[bj][n] * (0.125f * 1.4426950408889634f); }
            } else if (isg) {
                EPI_FOR_COLS {
#pragma unroll
                    for (int j = 0; j < 4; ++j) v[bj][n][j] = sigmoidf_(v[bj][n][j]); }
            } else if (seg == 3 || seg == 4 || seg == 6) {
                EPI_FOR_COLS {
#pragma unroll
                    for (int j = 0; j < 4; ++j) v[bj][n][j] = gelu_tanh(v[bj][n][j]); }
            }
            EPI_FOR_COLS { u32x2 w; w.x = pk2(v[bj][n][0], v[bj][n][1]); w.y = pk2(v[bj][n][2], v[bj][n][3]); *(u32x2*)(rp + bj * 128 + n * 16) = w; }
        }
    }
};

struct EpiMerge {
    static constexpr bool PERM = true;
    bf16_t* mg; const bf16_t* gate;
    __device__ __forceinline__ void operator()(const Acc& acc, const Unit& u, int wr, int wc, int fr, int fq) const {
        const int r = u.e;
#pragma unroll
        for (int ai = 0; ai < 2; ++ai) {
            const size_t rbase = (size_t)(u.row0 + ai * 128 + wr * 64 + fr); const int col = u.pn * 256 + wc * 32 + fq * 8;
            u32x4 g[4][2], o[4][2];
#pragma unroll
            for (int m = 0; m < 4; ++m)
#pragma unroll
                for (int bj = 0; bj < 2; ++bj) { g[m][bj] = *(const u32x4*)(gate + (rbase + m * 16) * 3072 + r * 1024 + col + bj * 128);
                    if (r > 0) o[m][bj] = *(const u32x4*)(mg + (rbase + m * 16) * DM + col + bj * 128); else o[m][bj] = (u32x4){0u, 0u, 0u, 0u}; }
#pragma unroll
            for (int m = 0; m < 4; ++m)
#pragma unroll
                for (int bj = 0; bj < 2; ++bj) { const u32x4 gg = g[m][bj], oo = o[m][bj]; const f32x4 v0 = acc[ai][bj][m][0], v1 = acc[ai][bj][m][1];
                    u32x4 w; w.x = pk2(v0[0] * bflo(gg.x) + bflo(oo.x), v0[1] * bfhi(gg.x) + bfhi(oo.x)); w.y = pk2(v0[2] * bflo(gg.y) + bflo(oo.y), v0[3] * bfhi(gg.y) + bfhi(oo.y));
                    w.z = pk2(v1[0] * bflo(gg.z) + bflo(oo.z), v1[1] * bfhi(gg.z) + bfhi(oo.z)); w.w = pk2(v1[2] * bflo(gg.w) + bflo(oo.w), v1[3] * bfhi(gg.w) + bfhi(oo.w));
                    *(u32x4*)(mg + (rbase + m * 16) * DM + col + bj * 128) = w; }
        }
    }
};

struct EpiWout {
    static constexpr bool PERM = true;
    float* out; float* xc; const float* modl; bool dry;
    __device__ __forceinline__ void operator()(const Acc& acc, const Unit& u, int wr, int wc, int fr, int fq) const {
        const int b = u.pm / 17; const int bsel = (u.pm % 17) == 0 ? 4 : b;
        const float* g1 = modl + bsel * 6144 + 2048;
        f32x4 gv[2][2];
        EPI_FOR_COLS gv[bj][n] = *(const f32x4*)(g1 + u.pn * 256 + bj * 128 + wc * 32 + fq * 8 + n * 4);
#pragma unroll
        for (int ai = 0; ai < 2; ++ai) {
            bf16_t* rp[4]; u32x4 x[4][2];
#pragma unroll
            for (int m = 0; m < 4; ++m) { rp[m] = (bf16_t*)resid_row(out, xc, u.row0 + ai * 128 + wr * 64 + m * 16 + fr) + u.pn * 256 + wc * 32 + fq * 8;
#pragma unroll
                for (int bj = 0; bj < 2; ++bj) x[m][bj] = *(const u32x4*)(rp[m] + bj * 128); }
#pragma unroll
            for (int m = 0; m < 4; ++m)
#pragma unroll
                for (int bj = 0; bj < 2; ++bj) { const u32x4 xx = x[m][bj]; const f32x4 a0 = acc[ai][bj][m][0] * gv[bj][0], a1 = acc[ai][bj][m][1] * gv[bj][1];
                    u32x4 w; w.x = pk2(bflo(xx.x) * DN_ALPHA + a0[0], bfhi(xx.x) * DN_ALPHA + a0[1]); w.y = pk2(bflo(xx.y) * DN_ALPHA + a0[2], bfhi(xx.y) * DN_ALPHA + a0[3]);
                    w.z = pk2(bflo(xx.z) * DN_ALPHA + a1[0], bfhi(xx.z) * DN_ALPHA + a1[1]); w.w = pk2(bflo(xx.w) * DN_ALPHA + a1[2], bfhi(xx.w) * DN_ALPHA + a1[3]);
                    if (!dry) *(u32x4*)(rp[m] + bj * 128) = w; else asm volatile("" :: "v"(w)); }
        }
    }
};

struct EpiMoe1 {
    static constexpr bool PERM = true;
    bf16_t* act; bf16_t* actsh;
    __device__ __forceinline__ void operator()(const Acc& acc, const Unit& u, int wr, int wc, int fr, int fq) const {
        bf16_t* base = u.e == 64 ? actsh : act;
        EPI_FOR_ROWS {
            const int rl = ai * 128 + wr * 64 + m * 16 + fr;
            if (rl < u.nrows) {
                const f32x4 g0 = acc[ai][0][m][0], g1 = acc[ai][0][m][1], p0 = acc[ai][1][m][0], p1 = acc[ai][1][m][1];
                u32x4 w; w.x = pk2(silu_(g0[0]) * p0[0], silu_(g0[1]) * p0[1]); w.y = pk2(silu_(g0[2]) * p0[2], silu_(g0[3]) * p0[3]);
                w.z = pk2(silu_(g1[0]) * p1[0], silu_(g1[1]) * p1[1]); w.w = pk2(silu_(g1[2]) * p1[2], silu_(g1[3]) * p1[3]);
                *(u32x4*)(base + (size_t)(u.row0 + rl) * 256 + u.pn * 128 + wc * 32 + fq * 8) = w;
            }
        }
    }
};

struct EpiMoe2 {
    static constexpr bool PERM = true;
    unsigned char* ys; bf16_t* sho;
    __device__ __forceinline__ void operator()(const Acc& acc, const Unit& u, int wr, int wc, int fr, int fq) const {
        EPI_FOR_ROWS {
            const int rl = ai * 128 + wr * 64 + m * 16 + fr;
            if (rl < u.nrows) {
                if (u.e == 64) {
                    bf16_t* rp = sho + (size_t)(u.row0 + rl) * DM + u.pn * 256 + wc * 32 + fq * 8;
#pragma unroll
                    for (int bj = 0; bj < 2; ++bj) { const f32x4 v0 = acc[ai][bj][m][0], v1 = acc[ai][bj][m][1];
                        u32x4 w; w.x = pk2(v0[0], v0[1]); w.y = pk2(v0[2], v0[3]); w.z = pk2(v1[0], v1[1]); w.w = pk2(v1[2], v1[3]); *(u32x4*)(rp + bj * 128) = w; }
                } else {
                    unsigned char* rp = ys + (size_t)(u.row0 + rl) * DM + u.pn * 256 + wc * 32 + fq * 8;
#pragma unroll
                    for (int bj = 0; bj < 2; ++bj) { const f32x4 v0 = acc[ai][bj][m][0] * 16.0f, v1 = acc[ai][bj][m][1] * 16.0f;
                        int w0 = 0, w1 = 0;
                        w0 = __builtin_amdgcn_cvt_pk_fp8_f32(v0[0], v0[1], w0, false); w0 = __builtin_amdgcn_cvt_pk_fp8_f32(v0[2], v0[3], w0, true);
                        w1 = __builtin_amdgcn_cvt_pk_fp8_f32(v1[0], v1[1], w1, false); w1 = __builtin_amdgcn_cvt_pk_fp8_f32(v1[2], v1[3], w1, true);
                        *(u32x2*)(rp + bj * 128) = (u32x2){(unsigned)w0, (unsigned)w1}; }
                }
            }
        }
    }
};

struct Frame {
    LAS unsigned char* lds; int tid, lane, wave, G, bid, gw, NGW, vcu;
    unsigned char* ws; float* out;
};

__device__ __forceinline__ void transpose_item(const float* W, int ldw, int k0, int n0, bf16_t* WT, int ldt, int drow0, LAS float* scr, int lane) {
    const int lk = lane >> 4, n4 = (lane & 15) * 4;
#pragma unroll 8
    for (int i = 0; i < 16; ++i) { const int k = 4 * i + lk; const f32x4 v = *(const f32x4*)(W + (size_t)(k0 + k) * ldw + n0 + n4);
        *(LAS f32x4*)(scr + k * 64 + (n4 ^ (((k >> 3) & 7) << 2))) = v; }
    LDS_WAIT(); asm volatile("" ::: "memory");
    const int c = lane & 7;
#pragma unroll
    for (int j = 0; j < 8; ++j) { const int n = (lane >> 3) + 8 * j; const LAS float* sp = scr + (8 * c) * 64 + (n ^ (c << 2));
        u32x4 o; o.x = pk2(sp[0 * 64], sp[1 * 64]); o.y = pk2(sp[2 * 64], sp[3 * 64]); o.z = pk2(sp[4 * 64], sp[5 * 64]); o.w = pk2(sp[6 * 64], sp[7 * 64]);
        *(u32x4*)(WT + (size_t)(drow0 + n) * ldt + k0 + 8 * c) = o; }
    LDS_WAIT(); asm volatile("" ::: "memory");
}
__device__ __forceinline__ void conv_expert_item(const float* wg, const float* wu, const float* wd, bf16_t* t1, bf16_t* t2, int which, int rr, LAS float* scr, int lane) {
    if (which < 2) { const int kb = rr >> 2, nb = rr & 3, n0 = 64 * nb;
        transpose_item(which == 0 ? wg : wu, 256, 64 * kb, n0, t1, 1024, (n0 >> 7) * 256 + (n0 & 127) + which * 128, scr, lane);
    } else { const int kb = rr >> 4, nb = rr & 15; transpose_item(wd, 1024, 64 * kb, 64 * nb, t2, 256, 64 * nb, scr, lane); }
}
__device__ __forceinline__ void conv_moe_layer(const Frame& F, CArgsP a, int l) {
    LAS float* scr = (LAS float*)(F.lds + F.wave * 16384);
    for (int it = F.gw; it < 64 * 3 * 64; it += F.NGW) {
        const int idx = it >> 6, e = idx / 3, which = idx - e * 3, rr = it & 63; const size_t eo = (size_t)(l * 64 + e) * 262144;
        conv_expert_item(a->in[30] + eo, a->in[31] + eo, a->in[32] + eo, (bf16_t*)(F.ws + WS_WM1) + (size_t)e * 524288, (bf16_t*)(F.ws + WS_WM2) + (size_t)e * 262144, which, rr, scr, F.lane);
    }
}

__device__ __forceinline__ void phase_prologue(const Frame& F, CArgsP a) {
    LAS float* scr = (LAS float*)(F.lds + F.wave * 16384);
    constexpr int I_IN = 2 * 1664, I_BR = 6 * 128, I_OUT = 2 * 256, I_SH = 6 * 64;
    for (int it0 = F.gw; it0 < I_IN + I_BR + I_OUT + I_SH; it0 += F.NGW) {
        int it = it0;
        if (it < I_IN) { const int l = it / 1664, r = it - l * 1664, kb = r / 104, nb = r - kb * 104;
            transpose_item(a->in[6] + (size_t)l * 1024 * INC, INC, 64 * kb, 64 * nb, (bf16_t*)(F.ws + WS_WIN) + (size_t)l * INC * 1024, 1024, 64 * nb, scr, F.lane); continue; }
        it -= I_IN;
        if (it < I_BR) { const int idx = it >> 7, rr = it & 127, kb = rr >> 4, nb = rr & 15;
            transpose_item(a->in[24] + (size_t)idx * 512 * 1024, 1024, 64 * kb, 64 * nb, (bf16_t*)(F.ws + WS_WBR) + (size_t)idx * 1024 * 512, 512, 64 * nb, scr, F.lane); continue; }
        it -= I_BR;
        if (it < I_OUT) { const int l = it >> 8, rr = it & 255, kb = rr >> 4, nb = rr & 15;
            transpose_item(a->in[25] + (size_t)l * 1048576, 1024, 64 * kb, 64 * nb, (bf16_t*)(F.ws + WS_WOUT) + (size_t)l * 1048576, 1024, 64 * nb, scr, F.lane); continue; }
        it -= I_OUT;
        { const int idx = it >> 6, l = idx / 3, which = idx - l * 3, rr = it & 63; const size_t lo = (size_t)l * 262144;
          conv_expert_item(a->in[33] + lo, a->in[34] + lo, a->in[35] + lo, (bf16_t*)(F.ws + WS_WSH1) + (size_t)l * 524288, (bf16_t*)(F.ws + WS_WSH2) + (size_t)l * 262144, which, rr, scr, F.lane); }
    }
    conv_moe_layer(F, a, 0);
    { const int gt = F.bid * NTHR + F.tid, NG = F.G * NTHR;
      bf16_t* wl = (bf16_t*)(F.ws + WS_WLRU);
      for (int i = gt; i < 2 * 2 * 2 * 8 * 4096; i += NG) {
          const int ii = i & 63, j = (i >> 6) & 63, cb = (i >> 12) & 7, ax = (i >> 15) & 1, d = (i >> 16) & 1, l = i >> 17;
          const float* src = ax == 0 ? a->in[19] : a->in[21];
          wl[i] = (bf16_t)f2bf(src[(size_t)((l * 2 + d) * 8 + cb) * 4096 + ii * 64 + j]); }
      bf16_t* wrt = (bf16_t*)(F.ws + WS_WRT);
      for (int i = gt; i < 2 * 64 * 1024; i += NG) { const int k = i & 1023, e = (i >> 10) & 63, l = i >> 16; wrt[i] = (bf16_t)f2bf(a->in[28][(size_t)(l * 1024 + k) * 64 + e]); }
      bf16_t* wsg = (bf16_t*)(F.ws + WS_WSG);
      for (int i = gt; i < 2 * 4 * 128 * 128; i += NG) wsg[i] = (bf16_t)f2bf(a->in[15][i]);
      if (F.bid == 0) { float* rope = (float*)(F.ws + WS_ROPE);
          for (int t = F.tid; t < 1024; t += NTHR) { const int p = t >> 4, f = t & 15; const float inv = powf(10000.0f, -(float)f / 16.0f); const float ang = (float)p * inv; rope[2 * t] = cosf(ang); rope[2 * t + 1] = sinf(ang); } }
      if (F.bid == (1 % F.G) && F.wave == 0) { float* lam = (float*)(F.ws + WS_LAM);
#pragma unroll
          for (int l = 0; l < 2; ++l) { const float s1 = wave_sum(a->in[8][l * 64 + F.lane] * a->in[9][l * 64 + F.lane]), s2 = wave_sum(a->in[10][l * 64 + F.lane] * a->in[11][l * 64 + F.lane]);
              const float li = 0.8f - 0.6f * expf(-0.3f * (float)l); if (F.lane == 0) lam[l] = expf(s1) - expf(s2) + li; } }
    }
    __syncthreads();
    LAS float* sl = (LAS float*)(F.lds);
    for (int i = F.tid; i < 5 * 1024; i += NTHR) { const int b = i >> 10, k = i & 1023; const float cv = b < 4 ? a->in[1][b * 1024 + k] : a->in[3][k]; sl[i] = silu_(cv); }
    __syncthreads();
    float* mod = (float*)(F.ws + WS_MOD);
    LAS float* part = (LAS float*)(F.lds + 20480);
    for (int c = F.bid; c < 192; c += F.G) {
        const int l = c / 96, cg = c - l * 96, col = F.tid & 63, ks = F.wave, n = cg * 64 + col;
        const float* w = a->in[4] + ((size_t)l * 1024 + ks * 128) * 6144 + n;
        float acc[5] = {0.f, 0.f, 0.f, 0.f, 0.f};
#pragma unroll 8
        for (int k = 0; k < 128; ++k) { const float wv = w[(size_t)k * 6144];
#pragma unroll
            for (int b = 0; b < 5; ++b) acc[b] += sl[b * 1024 + ks * 128 + k] * wv; }
#pragma unroll
        for (int b = 0; b < 5; ++b) part[(ks * 5 + b) * 64 + col] = acc[b];
        __syncthreads();
        if (F.tid < 320) { const int b = F.tid >> 6; float s = a->in[5][l * 6144 + n];
#pragma unroll
            for (int k8 = 0; k8 < 8; ++k8) s += part[(k8 * 5 + b) * 64 + col];
            mod[(l * 5 + b) * 6144 + n] = s; }
        __syncthreads();
    }
}

__device__ __forceinline__ void row_load(const float* p, int lane, f32x4 (&v)[4]) {
#pragma unroll
    for (int j = 0; j < 4; ++j) v[j] = *(const f32x4*)(p + 4 * lane + 256 * j);
}
__device__ __forceinline__ void row_load_bf16(const float* p, int lane, f32x4 (&v)[4]) {
#pragma unroll
    for (int j = 0; j < 4; ++j) { const u32x2 w = *(const u32x2*)((const bf16_t*)p + 4 * lane + 256 * j); v[j] = (f32x4){bflo(w.x), bfhi(w.x), bflo(w.y), bfhi(w.y)}; }
}
__device__ __forceinline__ void row_store(float* p, int lane, const f32x4 (&v)[4]) {
#pragma unroll
    for (int j = 0; j < 4; ++j) *(f32x4*)(p + 4 * lane + 256 * j) = v[j];
}
__device__ __forceinline__ void row_ln(f32x4 (&v)[4]) {
    float s = 0.f;
#pragma unroll
    for (int j = 0; j < 4; ++j) s += (v[j][0] + v[j][1]) + (v[j][2] + v[j][3]);
    const float mean = wave_sum(s) * (1.f / DM); float q = 0.f;
#pragma unroll
    for (int j = 0; j < 4; ++j) { v[j] = v[j] - mean; q += (v[j][0] * v[j][0] + v[j][1] * v[j][1]) + (v[j][2] * v[j][2] + v[j][3] * v[j][3]); }
    const float rstd = __builtin_amdgcn_rsqf(wave_sum(q) * (1.f / DM) + LN_EPS);
#pragma unroll
    for (int j = 0; j < 4; ++j) v[j] = v[j] * rstd;
}
__device__ __forceinline__ void row_affine(f32x4 (&v)[4], const float* scale1p  , bool plus1, const float* shift, int lane) {
#pragma unroll
    for (int j = 0; j < 4; ++j) { const f32x4 sc = *(const f32x4*)(scale1p + 4 * lane + 256 * j), sh = *(const f32x4*)(shift + 4 * lane + 256 * j);
        v[j] = plus1 ? v[j] * (sc + 1.0f) + sh : v[j] * sc + sh; }
}
__device__ __forceinline__ void row_store_bf16(bf16_t* p, int lane, const f32x4 (&v)[4]) {
#pragma unroll
    for (int j = 0; j < 4; ++j) { u32x2 w; w.x = pk2(v[j][0], v[j][1]); w.y = pk2(v[j][2], v[j][3]); *(u32x2*)(p + 4 * lane + 256 * j) = w; }
}

__device__ __forceinline__ void phase_rows0(const Frame& F, CArgsP a) {
    const float* mod = (const float*)(F.ws + WS_MOD); float* xc = (float*)(F.ws + WS_XC); bf16_t* H = (bf16_t*)(F.ws + WS_H);
    for (int tok = F.gw; tok < T; tok += F.NGW) {
        const int b = tok / TPB, j = tok - b * TPB; const bool isc = j < CTX;
        const float* src = isc ? a->in[2] + (size_t)(b * CTX + j) * DM : a->in[0] + (size_t)(b * SEQ + j - CTX) * DM;
        f32x4 v[4]; row_load(src, F.lane, v);
        row_store_bf16((bf16_t*)resid_row(F.out, xc, tok), F.lane, v);
        row_ln(v);
        const float* mrow = mod + (isc ? 4 : b) * 6144;
        row_affine(v, mrow + 1024, true, mrow, F.lane);
        row_store_bf16(H + (size_t)tok * DM, F.lane, v);
    }
}

__device__ __forceinline__ void sg_item(const Frame& F, CArgsP a, int l, int chunk, int g) {
    LAS bf16_t* vgT = (LAS bf16_t*)F.lds;
    const bf16_t* Sb = (const bf16_t*)(F.ws + OV_S); const bf16_t* Ub = (const bf16_t*)(F.ws + OV_U); bf16_t* OB = (bf16_t*)(F.ws + OV_OB);
    const int tok0 = chunk * 128;
    { const int q = F.tid >> 2, qt = F.tid & 3;
      const bf16_t* sp = Sb + (size_t)(tok0 + q) * 512 + g * 128 + qt * 32;
      float x[32];
#pragma unroll
      for (int i = 0; i < 4; ++i) { const u32x4 w = *(const u32x4*)(sp + 8 * i);
          x[8 * i + 0] = bflo(w.x); x[8 * i + 1] = bfhi(w.x); x[8 * i + 2] = bflo(w.y); x[8 * i + 3] = bfhi(w.y); x[8 * i + 4] = bflo(w.z); x[8 * i + 5] = bfhi(w.z); x[8 * i + 6] = bflo(w.w); x[8 * i + 7] = bfhi(w.w); }
      float s = 0.f;
#pragma unroll
      for (int i = 0; i < 32; ++i) s += x[i];
      s += __shfl_xor(s, 1); s += __shfl_xor(s, 2); const float mean = s * (1.f / 128.f); float qq = 0.f;
#pragma unroll
      for (int i = 0; i < 32; ++i) { x[i] -= mean; qq += x[i] * x[i]; }
      qq += __shfl_xor(qq, 1); qq += __shfl_xor(qq, 2); const float rstd = 1.f / sqrtf(qq * (1.f / 128.f) + LN_EPS);
      const float* lg = a->in[13] + l * 512 + g * 128 + qt * 32; const float* lb = a->in[14] + l * 512 + g * 128 + qt * 32;
#pragma unroll
      for (int i = 0; i < 32; ++i) vgT[(qt * 32 + i) * 136 + q] = (bf16_t)f2bf(x[i] * rstd * lg[i] + lb[i]);
    }
    __syncthreads();
    const int w = F.wave, fr = F.lane & 15, fq = F.lane >> 4;
    bf16x8 af[4];
#pragma unroll
    for (int ks = 0; ks < 4; ++ks) af[ks] = *(const LAS bf16x8*)(vgT + (w * 16 + fr) * 136 + ks * 32 + fq * 8);
    const bf16_t* W = (const bf16_t*)(F.ws + WS_WSG) + (size_t)(l * 4 + g) * 16384;
    const float* bs = a->in[16] + (l * 4 + g) * 128;
#pragma unroll 2
    for (int n = 0; n < 8; ++n) {
        f32x4 d = {0.f, 0.f, 0.f, 0.f};
#pragma unroll
        for (int ks = 0; ks < 4; ++ks) { const bf16x8 bfv = *(const bf16x8*)(W + (n * 16 + fr) * 128 + ks * 32 + fq * 8); d = __builtin_amdgcn_mfma_f32_16x16x32_bf16(af[ks], bfv, d, 0, 0, 0); }
        const int p = n * 16 + fr, c0 = w * 16 + fq * 4; const float bsp = bs[p];
        const size_t off = (size_t)(tok0 + p) * 512 + g * 128 + c0;
        const u32x2 uu = *(const u32x2*)(Ub + off);
        u32x2 o; o.x = pk2(bflo(uu.x) * (d[0] + bsp), bfhi(uu.x) * (d[1] + bsp)); o.y = pk2(bflo(uu.y) * (d[2] + bsp), bfhi(uu.y) * (d[3] + bsp));
        *(u32x2*)(OB + off) = o;
    }
    __syncthreads();
}

template <bool REV>
__device__ __forceinline__ void lru_scan(const f32x4 (&av)[4], const f32x4 (&bv)[4], f32x4 (&hv)[4], int lane, int mode, float hin, float& sumA, float& sumH) {
#define LRU_MI(k) (REV ? 3 - (k) : (k))
    const int fr = lane & 15, fq = lane >> 4, q = REV ? 3 - fq : fq;
    const int s1 = REV ? lane + 16 : lane - 16, s2 = REV ? lane + 32 : lane - 32, st = REV ? fr : 48 + fr;
    float Ea[4], Eh[4], Ta[4], Th[4];
#pragma unroll
    for (int m = 0; m < 4; ++m) {
        float A = 1.f, H = 0.f;
#pragma unroll
        for (int rk = 0; rk < 4; ++rk) { const int r = LRU_MI(rk); H = av[m][r] * H + bv[m][r]; A *= av[m][r]; }
        float pa = __shfl(A, s1), ph = __shfl(H, s1); if (q >= 1) { H = A * ph + H; A *= pa; }
        pa = __shfl(A, s2); ph = __shfl(H, s2); if (q >= 2) { H = A * ph + H; A *= pa; }
        float ea = __shfl(A, s1), eh = __shfl(H, s1); if (q == 0) { ea = 1.f; eh = 0.f; }
        Ea[m] = ea; Eh[m] = eh; Ta[m] = __shfl(A, st); Th[m] = __shfl(H, st);
    }
    if (mode == 0) {
        float A = 1.f, H = 0.f;
#pragma unroll
        for (int mk = 0; mk < 4; ++mk) { const int m = LRU_MI(mk); H = Ta[m] * H + Th[m]; A *= Ta[m]; }
        sumA = A; sumH = H;
    } else {
        float S = hin;
#pragma unroll
        for (int mk = 0; mk < 4; ++mk) { const int m = LRU_MI(mk); float h = Ea[m] * S + Eh[m];
#pragma unroll
            for (int rk = 0; rk < 4; ++rk) { const int r = LRU_MI(rk); h = av[m][r] * h + bv[m][r]; hv[m][r] = h; }
            S = Ta[m] * S + Th[m]; }
    }
#undef LRU_MI
}
struct LruConst { f32x4 cw[4][2]; f32x4 cbias[2]; bf16x8 wa0, wa1, wx0, wx1; float ba, bx, sp; };
struct LruIn { u32x4 x[4]; u32x4 y; float hin; };
__device__ __forceinline__ void lru_load_const(const Frame& F, CArgsP a, int l, int cb, LruConst& c) {
    const int lane = F.lane, fr = lane & 15, fq = lane >> 4, d = F.wave >> 2, nt = F.wave & 3, ch0 = cb * 64, c8 = (F.tid & 7) * 8;
    const bf16_t* Wa = (const bf16_t*)(F.ws + WS_WLRU) + (size_t)((l * 4 + d * 2) * 8 + cb) * 4096 + (nt * 16 + fr) * 64 + fq * 8;
    c.wa0 = *(const bf16x8*)(Wa); c.wa1 = *(const bf16x8*)(Wa + 32); c.wx0 = *(const bf16x8*)(Wa + 8 * 4096); c.wx1 = *(const bf16x8*)(Wa + 8 * 4096 + 32);
    const int pidx = (l * 2 + d) * 512 + ch0 + nt * 16 + fr;
    c.ba = a->in[20][pidx]; c.bx = a->in[22][pidx]; c.sp = log1pf(expf(-a->in[23][pidx]));
#pragma unroll
    for (int jj = 0; jj < 4; ++jj) { c.cw[jj][0] = *(const f32x4*)(a->in[17] + l * 2048 + jj * 512 + ch0 + c8); c.cw[jj][1] = *(const f32x4*)(a->in[17] + l * 2048 + jj * 512 + ch0 + c8 + 4); }
    c.cbias[0] = *(const f32x4*)(a->in[18] + l * 512 + ch0 + c8); c.cbias[1] = *(const f32x4*)(a->in[18] + l * 512 + ch0 + c8 + 4);
}
__device__ __forceinline__ void lru_load_in(const Frame& F, int b, int chunk, int cb, int mode, LruIn& in) {
    const bf16_t* Xb = (const bf16_t*)(F.ws + OV_X); const bf16_t* Yb = (const bf16_t*)(F.ws + OV_Y);
    const int ch0 = cb * 64, ct = F.tid >> 3, c8 = (F.tid & 7) * 8, d = F.wave >> 2, ch = (F.wave & 3) * 16 + (F.lane & 15);
    const int seg_lo = chunk < 4 ? 0 : 256, seg_hi = chunk < 4 ? 256 : TPB, j0 = chunk * 64;
#pragma unroll
    for (int jj = 0; jj < 4; ++jj) { const int j = j0 + ct + jj - 2; in.x[jj] = (u32x4){0u, 0u, 0u, 0u}; if (j >= seg_lo && j < seg_hi) in.x[jj] = *(const u32x4*)(Xb + (size_t)(b * TPB + j) * 512 + ch0 + c8); }
    in.y = (u32x4){0u, 0u, 0u, 0u}; in.hin = 0.f;
    if (mode == 1) { in.y = *(const u32x4*)(Yb + (size_t)(b * TPB + j0 + ct) * 512 + ch0 + c8); in.hin = ((const float*)(F.ws + WS_HIN))[(size_t)((b * 2 + d) * 68 + chunk) * 512 + ch0 + ch]; }
}
__device__ __forceinline__ void lru_compute(const Frame& F, const LruConst& c, const LruIn& in, int b, int chunk, int cb, int mode) {
    LAS float* xs = (LAS float*)F.lds;
    LAS bf16_t* xsb = (LAS bf16_t*)(F.lds + 16384);
    LAS float* hx = (LAS float*)(F.lds + 25600);
    bf16_t* OC = (bf16_t*)(F.ws + OV_OC);
    const int tok0 = b * TPB + chunk * 64, ch0 = cb * 64;
    const int lane = F.lane, fr = lane & 15, fq = lane >> 4, d = F.wave >> 2, nt = F.wave & 3, ch = nt * 16 + fr;
    const int ct = F.tid >> 3, c8 = (F.tid & 7) * 8;
    {
      f32x4 a0 = c.cbias[0], a1 = c.cbias[1];
#pragma unroll
      for (int jj = 0; jj < 4; ++jj) { const u32x4 w = in.x[jj];
          a0 += c.cw[jj][0] * (f32x4){bflo(w.x), bfhi(w.x), bflo(w.y), bfhi(w.y)}; a1 += c.cw[jj][1] * (f32x4){bflo(w.z), bfhi(w.z), bflo(w.w), bfhi(w.w)}; }
      *(LAS f32x4*)(xs + ct * 64 + c8) = a0; *(LAS f32x4*)(xs + ct * 64 + c8 + 4) = a1;
      u32x4 pw; pw.x = pk2(a0[0], a0[1]); pw.y = pk2(a0[2], a0[3]); pw.z = pk2(a1[0], a1[1]); pw.w = pk2(a1[2], a1[3]);
      *(LAS u32x4*)(xsb + ct * 72 + c8) = pw; }
    __syncthreads();
    f32x4 av[4], bv[4], hv[4];
#pragma unroll
    for (int m = 0; m < 4; ++m) {
        const bf16x8 a0 = *(const LAS bf16x8*)(xsb + (m * 16 + fr) * 72 + fq * 8), a1 = *(const LAS bf16x8*)(xsb + (m * 16 + fr) * 72 + 32 + fq * 8);
        f32x4 da = {0.f, 0.f, 0.f, 0.f}, dx = {0.f, 0.f, 0.f, 0.f};
        da = __builtin_amdgcn_mfma_f32_16x16x32_bf16(a0, c.wa0, da, 0, 0, 0); da = __builtin_amdgcn_mfma_f32_16x16x32_bf16(a1, c.wa1, da, 0, 0, 0);
        dx = __builtin_amdgcn_mfma_f32_16x16x32_bf16(a0, c.wx0, dx, 0, 0, 0); dx = __builtin_amdgcn_mfma_f32_16x16x32_bf16(a1, c.wx1, dx, 0, 0, 0);
#pragma unroll
        for (int r = 0; r < 4; ++r) { const float rg = sigmoidf_(da[r] + c.ba), ig = sigmoidf_(dx[r] + c.bx); const float la = -8.0f * rg * c.sp;
            const float e1 = expm1_fast(la);
            av[m][r] = 1.0f + e1; bv[m][r] = __builtin_amdgcn_sqrtf(-e1 * (2.0f + e1)) * (ig * xs[(m * 16 + fq * 4 + r) * 64 + ch]); hv[m][r] = 0.f; }
    }
    float sumA = 1.f, sumH = 0.f;
    if (d == 0) lru_scan<false>(av, bv, hv, lane, mode, in.hin, sumA, sumH); else lru_scan<true>(av, bv, hv, lane, mode, in.hin, sumA, sumH);
    if (mode == 0) {
        if (fq == 0) { float* sum = (float*)(F.ws + WS_SUM) + ((size_t)((b * 2 + d) * 68 + chunk) * 512 + ch0 + ch) * 2; *(float2*)sum = make_float2(sumA, sumH); }
        __syncthreads();
        return;
    }
#pragma unroll
    for (int m = 0; m < 4; ++m)
#pragma unroll
        for (int r = 0; r < 4; ++r) hx[d * 4096 + (m * 16 + fq * 4 + r) * 64 + ch] = hv[m][r];
    __syncthreads();
    { const u32x4 yv = in.y;
      const f32x4 f0 = *(const LAS f32x4*)(hx + ct * 64 + c8), f1 = *(const LAS f32x4*)(hx + ct * 64 + c8 + 4), g0 = *(const LAS f32x4*)(hx + 4096 + ct * 64 + c8), g1 = *(const LAS f32x4*)(hx + 4096 + ct * 64 + c8 + 4);
      u32x4 o; o.x = pk2(bflo(yv.x) * (f0[0] + g0[0]), bfhi(yv.x) * (f0[1] + g0[1])); o.y = pk2(bflo(yv.y) * (f0[2] + g0[2]), bfhi(yv.y) * (f0[3] + g0[3]));
      o.z = pk2(bflo(yv.z) * (f1[0] + g1[0]), bfhi(yv.z) * (f1[1] + g1[1])); o.w = pk2(bflo(yv.w) * (f1[2] + g1[2]), bfhi(yv.w) * (f1[3] + g1[3]));
      *(u32x4*)(OC + (size_t)(tok0 + ct) * 512 + ch0 + c8) = o; }
}
__device__ __forceinline__ void lru_phase(const Frame& F, CArgsP a, int l, int mode, bool skip_ctx) {
    constexpr int NIT = 4 * 68 * 8;
    int it = F.bid;
    while (it < NIT && skip_ctx && ((it >> 3) % 68) < 4) it += F.G;
    if (it >= NIT) return;
    LruConst c; LruIn cur, nxt;
    int cb = it & 7; lru_load_const(F, a, l, cb, c);
    lru_load_in(F, (it >> 3) / 68, (it >> 3) % 68, cb, mode, cur);
    for (;;) {
        int nit = it + F.G;
        while (nit < NIT && skip_ctx && ((nit >> 3) % 68) < 4) nit += F.G;
        const bool has = nit < NIT;
        if (has) lru_load_in(F, (nit >> 3) / 68, (nit >> 3) % 68, nit & 7, mode, nxt);
        lru_compute(F, c, cur, (it >> 3) / 68, (it >> 3) % 68, cb, mode);
        if (!has) break;
        if ((nit & 7) != cb) { cb = nit & 7; lru_load_const(F, a, l, cb, c); }
        it = nit; cur = nxt;
    }
}

__device__ __forceinline__ void phase_carry(const Frame& F) {
    const int gt = F.bid * NTHR + F.tid; if (gt >= 4 * 2 * 512) return;
    const int c = gt & 511, d = (gt >> 9) & 1, b = gt >> 10;
    const float* sum = (const float*)(F.ws + WS_SUM) + (size_t)((b * 2 + d) * 68) * 1024 + c * 2;
    float* hin = (float*)(F.ws + WS_HIN) + (size_t)((b * 2 + d) * 68) * 512 + c;
    float h = 0.f;
#pragma unroll 1
    for (int g0 = 0; g0 < 68; g0 += 17) {
        float A[17], Hh[17];
#pragma unroll
        for (int i = 0; i < 17; ++i) { const int o = g0 + i; const int ck = d == 0 ? o : (o < 4 ? 3 - o : 71 - o); const float2 v = *(const float2*)(sum + (size_t)ck * 1024); A[i] = v.x; Hh[i] = v.y; }
#pragma unroll
        for (int i = 0; i < 17; ++i) { const int o = g0 + i; const int ck = d == 0 ? o : (o < 4 ? 3 - o : 71 - o); hin[(size_t)ck * 512] = h; h = A[i] * h + Hh[i]; }
    }
}

constexpr int AT_KST = 272, AT_VST = 320;
constexpr int AT_KOFF = 0, AT_VOFF = 2 * 64 * AT_KST, AT_XOFF = AT_VOFF + 2 * 64 * AT_VST;
#define AT_SBAR() __builtin_amdgcn_sched_barrier(0)
struct AttnState { f32x16 o[4]; f32x16 negm; bf16x8 pfp[4]; float lrun; };
#define AT_PIN1(x) asm volatile("" : "+v"(x))
__device__ __forceinline__ float at_max3(float a, float b, float c) { float r; asm("v_max3_f32 %0, %1, %2, %3" : "=v"(r) : "v"(a), "v"(b), "v"(c)); return r; }
__device__ __forceinline__ bf16x8 at_vfrag(const LAS unsigned char* vp) {
    const s16x4 lo = __builtin_bit_cast(s16x4, __builtin_amdgcn_ds_read_tr16_b64_v4i16((LAS s16x4*)(vp)));
    const s16x4 hh = __builtin_bit_cast(s16x4, __builtin_amdgcn_ds_read_tr16_b64_v4i16((LAS s16x4*)(vp + 8 * AT_VST)));
    return (bf16x8){lo[0], lo[1], lo[2], lo[3], hh[0], hh[1], hh[2], hh[3]};
}
__device__ __forceinline__ float attn_stage1(const AttnState& st, const f32x16& p0, const f32x16& p1, f32x16& n0, f32x16& n1, const LAS unsigned char* ql, const LAS unsigned char* kf) {
    float mx = at_max3(p0[0], p0[1], at_max3(p1[0], p1[1], p1[1]));
    bf16x8 a0 = *(const LAS bf16x8*)(kf), a1 = *(const LAS bf16x8*)(kf + 32 * AT_KST), q = *(const LAS bf16x8*)(ql);
    AT_SBAR();
#pragma unroll
    for (int ks = 0; ks < 4; ++ks) {
        bf16x8 b0 = a0, b1 = a1, qn = q;
        if (ks < 3) { b0 = *(const LAS bf16x8*)(kf + (ks + 1) * 32); b1 = *(const LAS bf16x8*)(kf + 32 * AT_KST + (ks + 1) * 32); qn = *(const LAS bf16x8*)(ql + (ks + 1) * 1024); }
        if (ks == 0) n0 = __builtin_amdgcn_mfma_f32_32x32x16_bf16(a0, q, st.negm, 0, 0, 0);
        else n0 = __builtin_amdgcn_mfma_f32_32x32x16_bf16(a0, q, n0, 0, 0, 0);
        mx = at_max3(at_max3(mx, p0[4 * ks + 2], p0[4 * ks + 3]), p1[4 * ks + 2], p1[4 * ks + 3]); AT_PIN1(mx); AT_SBAR();
        if (ks == 0) n1 = __builtin_amdgcn_mfma_f32_32x32x16_bf16(a1, q, st.negm, 0, 0, 0);
        else n1 = __builtin_amdgcn_mfma_f32_32x32x16_bf16(a1, q, n1, 0, 0, 0);
        if (ks < 3) { mx = at_max3(at_max3(mx, p0[4 * ks + 4], p0[4 * ks + 5]), p1[4 * ks + 4], p1[4 * ks + 5]); AT_PIN1(mx); } AT_SBAR();
        a0 = b0; a1 = b1; q = qn;
    }
    return mx;
}
template <bool FIRST>
__device__ __forceinline__ void attn_stage2(AttnState& st, f32x16& p0, f32x16& p1, f32x16& n0, f32x16& n1, float mx, const LAS unsigned char* vf) {
    constexpr float THR = 8.0f;
    bf16x8 vcur, vnx; if (!FIRST) { vcur = at_vfrag(vf); vnx = at_vfrag(vf + 64); }
    float tm; { auto rr = __builtin_amdgcn_permlane32_swap(__float_as_uint(mx), __float_as_uint(mx), false, false); tm = fmaxf(__uint_as_float(rr[0]), __uint_as_float(rr[1])); }
    if (FIRST || __any(tm > THR)) {
        const float dl = FIRST ? tm : fmaxf(tm, 0.f);
#pragma unroll
        for (int r = 0; r < 16; ++r) { p0[r] -= dl; p1[r] -= dl; n0[r] -= dl; n1[r] -= dl; st.negm[r] -= dl; }
        if (!FIRST) {
            const float al = __builtin_amdgcn_exp2f(-dl);
#pragma unroll
            for (int db = 0; db < 4; ++db)
#pragma unroll
                for (int r = 0; r < 16; ++r) st.o[db][r] *= al;
#pragma unroll
            for (int kk = 0; kk < 4; ++kk) { u32x4 w = __builtin_bit_cast(u32x4, st.pfp[kk]);
                w.x = pk2(bflo(w.x) * al, bfhi(w.x) * al); w.y = pk2(bflo(w.y) * al, bfhi(w.y) * al); w.z = pk2(bflo(w.z) * al, bfhi(w.z) * al); w.w = pk2(bflo(w.w) * al, bfhi(w.w) * al);
                st.pfp[kk] = __builtin_bit_cast(bf16x8, w); }
            st.lrun *= al;
        }
    }
    float ls = 0.f;
    AT_SBAR();
#pragma unroll
    for (int kk = 0; kk < 4; ++kk) {
        unsigned pw0 = 0, pw1 = 0, pw2 = 0, pw3 = 0;
#pragma unroll
        for (int db = 0; db < 4; ++db) {
            const int g = kk * 4 + db;
            if (!FIRST) {
                bf16x8 vn2 = vnx;
                if (g < 14) { const int g2 = g + 2; vn2 = at_vfrag(vf + ((g2 >> 2) * 16) * AT_VST + (g2 & 3) * 64); }
                st.o[db] = __builtin_amdgcn_mfma_f32_32x32x16_bf16(vcur, st.pfp[kk], st.o[db], 0, 0, 0);
                vcur = vnx; vnx = vn2;
            }
            const float x0 = g < 8 ? p0[2 * g] : p1[2 * g - 16], x1 = g < 8 ? p0[2 * g + 1] : p1[2 * g - 15];
            const float e0 = __builtin_amdgcn_exp2f(x0), e1 = __builtin_amdgcn_exp2f(x1);
            ls += e0 + e1; unsigned w = pk2(e0, e1); AT_PIN1(ls); AT_PIN1(w);
            if (db == 0) pw0 = w; else if (db == 1) pw1 = w; else if (db == 2) pw2 = w; else pw3 = w;
            AT_SBAR();
        }
        st.pfp[kk] = __builtin_bit_cast(bf16x8, (u32x4){pw0, pw1, pw2, pw3});
    }
    st.lrun += ls;
}
__device__ __forceinline__ void attn_unit(const Frame& F, int tokq0, int tokk0, int ntiles, int h, float lam, const float* gain, float oscale) {
    const bf16_t* Q = (const bf16_t*)(F.ws + OV_Q); const char* Kg = (const char*)(F.ws + OV_K); const char* Vg = (const char*)(F.ws + OV_V); bf16_t* OA = (bf16_t*)(F.ws + OV_OA);
    const int lane = F.lane, r32 = lane & 31, hi = lane >> 5, rb = F.wave >> 1, c = F.wave & 1;
    LAS unsigned char* ql = F.lds + AT_XOFF + F.wave * 4096 + lane * 16;
    { const bf16_t* qp = Q + (size_t)(tokq0 + rb * 32 + r32) * 512 + h * 128 + c * 64 + hi * 8;
#pragma unroll
      for (int ks = 0; ks < 4; ++ks) *(LAS bf16x8*)(ql + ks * 1024) = *(const bf16x8*)(qp + ks * 16); }
    const int srow0 = F.tid >> 4, sch = F.tid & 15;
    const unsigned goff = (unsigned)(((tokk0 + srow0) * 512 + h * 128 + sch * 8) * 2);
    LAS unsigned char* kl = F.lds + AT_KOFF + srow0 * AT_KST + sch * 16;
    LAS unsigned char* vl = F.lds + AT_VOFF + srow0 * AT_VST + sch * 16;
    const LAS unsigned char* kfb = F.lds + AT_KOFF + r32 * AT_KST + (c * 64 + hi * 8) * 2;
    const LAS unsigned char* vfb = F.lds + AT_VOFF + (4 * hi + ((lane & 15) >> 2)) * AT_VST + (((lane >> 4) & 1) * 16 + (lane & 3) * 4) * 2;
    {
      const u32x4 k0 = *(const u32x4*)(Kg + goff), k1 = *(const u32x4*)(Kg + goff + 32 * 1024), k2 = *(const u32x4*)(Kg + goff + 64 * 1024), k3 = *(const u32x4*)(Kg + goff + 96 * 1024);
      *(LAS u32x4*)(kl) = k0; *(LAS u32x4*)(kl + 32 * AT_KST) = k1; *(LAS u32x4*)(kl + 64 * AT_KST) = k2; *(LAS u32x4*)(kl + 96 * AT_KST) = k3; }
    __syncthreads();
    AttnState st; st.lrun = 0.f;
#pragma unroll
    for (int r = 0; r < 16; ++r) st.negm[r] = 0.f;
#pragma unroll
    for (int db = 0; db < 4; ++db)
#pragma unroll
        for (int r = 0; r < 16; ++r) st.o[db][r] = 0.f;
    f32x16 pa0, pa1, pb0, pb1;
#pragma unroll
    for (int r = 0; r < 16; ++r) { pa0[r] = 0.f; pa1[r] = 0.f; }
#pragma unroll
    for (int ks = 0; ks < 4; ++ks) {
        const bf16x8 a0 = *(const LAS bf16x8*)(kfb + ks * 32), a1 = *(const LAS bf16x8*)(kfb + 32 * AT_KST + ks * 32);
        const bf16x8 q = *(const LAS bf16x8*)(ql + ks * 1024);
        pa0 = __builtin_amdgcn_mfma_f32_32x32x16_bf16(a0, q, pa0, 0, 0, 0); pa1 = __builtin_amdgcn_mfma_f32_32x32x16_bf16(a1, q, pa1, 0, 0, 0);
    }
    asm volatile("s_nop 15\n\ts_nop 7" : "+v"(pa0), "+v"(pa1));
    u32x4 sv0 = *(const u32x4*)(Vg + goff), sv1 = *(const u32x4*)(Vg + goff + 32 * 1024);
#define AT_ITER(I, FIRSTF, PC0, PC1, PN0, PN1) do { \
        const int i_ = (I); const bool ldk_ = i_ + 2 < ntiles; const int sl_ = i_ & 1; \
        const float mx_ = attn_stage1(st, PC0, PC1, PN0, PN1, ql, kfb + ((i_ + 1) & 1) * (64 * AT_KST)); \
        *(LAS u32x4*)(vl + sl_ * (64 * AT_VST)) = sv0; *(LAS u32x4*)(vl + sl_ * (64 * AT_VST) + 32 * AT_VST) = sv1; \
        u32x4 sk0_, sk1_; if (ldk_) { const unsigned go_ = goff + (unsigned)(i_ + 2) * 65536u; sk0_ = *(const u32x4*)(Kg + go_); sk1_ = *(const u32x4*)(Kg + go_ + 32 * 1024); } \
        attn_stage2<FIRSTF>(st, PC0, PC1, PN0, PN1, mx_, vfb + ((i_ + 1) & 1) * (64 * AT_VST)); \
        if (ldk_) { *(LAS u32x4*)(kl + sl_ * (64 * AT_KST)) = sk0_; *(LAS u32x4*)(kl + sl_ * (64 * AT_KST) + 32 * AT_KST) = sk1_; } \
        if (i_ + 1 < ntiles) { const unsigned gv_ = goff + (unsigned)(i_ + 1) * 65536u; sv0 = *(const u32x4*)(Vg + gv_); sv1 = *(const u32x4*)(Vg + gv_ + 32 * 1024); } \
        __syncthreads(); } while (0)
    AT_ITER(0, true, pa0, pa1, pb0, pb1);
    AT_ITER(1, false, pb0, pb1, pa0, pa1);
#pragma unroll 1
    for (int i = 2; i < ntiles; i += 2) {
        AT_ITER(i, false, pa0, pa1, pb0, pb1);
        AT_ITER(i + 1, false, pb0, pb1, pa0, pa1);
    }
#undef AT_ITER
    {
      const LAS unsigned char* vf = vfb + ((ntiles - 1) & 1) * (64 * AT_VST);
#pragma unroll
      for (int db = 0; db < 4; ++db)
#pragma unroll
          for (int kk = 0; kk < 4; ++kk) {
              const LAS unsigned char* vp = vf + (kk * 16) * AT_VST + db * 64;
              const s16x4 lo = __builtin_bit_cast(s16x4, __builtin_amdgcn_ds_read_tr16_b64_v4i16((LAS s16x4*)(vp)));
              const s16x4 hh = __builtin_bit_cast(s16x4, __builtin_amdgcn_ds_read_tr16_b64_v4i16((LAS s16x4*)(vp + 8 * AT_VST)));
              const bf16x8 vfr = {lo[0], lo[1], lo[2], lo[3], hh[0], hh[1], hh[2], hh[3]};
              st.o[db] = __builtin_amdgcn_mfma_f32_32x32x16_bf16(vfr, st.pfp[kk], st.o[db], 0, 0, 0);
          } }
    float lrun = st.lrun; lrun += __shfl_xor(lrun, 32);
    const float il = 1.f / lrun;
    LAS float* ex = (LAS float*)(F.lds + AT_XOFF) + rb * 4096;
    if (c == 1) {
#pragma unroll
        for (int db = 0; db < 4; ++db)
#pragma unroll
            for (int r = 0; r < 16; ++r) ex[(db * 16 + r) * 64 + lane] = st.o[db][r] * il;
    }
    __syncthreads();
    if (c == 0) {
        float ss = 0.f;
#pragma unroll
        for (int db = 0; db < 4; ++db)
#pragma unroll
            for (int r = 0; r < 16; ++r) { const float dv = st.o[db][r] * il - lam * ex[(db * 16 + r) * 64 + lane]; st.o[db][r] = dv; ss += dv * dv; }
        ss += __shfl_xor(ss, 32);
        const float rinv = oscale / sqrtf(ss * (1.f / 128.f) + RMS_EPS);
        bf16_t* op = OA + (size_t)(tokq0 + rb * 32 + r32) * 512 + h * 128;
#pragma unroll
        for (int db = 0; db < 4; ++db)
#pragma unroll
            for (int r4 = 0; r4 < 4; ++r4) { const int dv0 = db * 32 + 8 * r4 + 4 * hi; const f32x4 gv = *(const f32x4*)(gain + dv0);
                u32x2 w; w.x = pk2(st.o[db][4 * r4] * rinv * gv[0], st.o[db][4 * r4 + 1] * rinv * gv[1]); w.y = pk2(st.o[db][4 * r4 + 2] * rinv * gv[2], st.o[db][4 * r4 + 3] * rinv * gv[3]);
                *(u32x2*)(op + dv0) = w; }
    }
    __syncthreads();
}

__device__ __forceinline__ void phase_attn(const Frame& F, CArgsP a, int l) {
    const float lam = ((const float*)(F.ws + WS_LAM))[l]; const float li = 0.8f - 0.6f * expf(-0.3f * (float)l);
    for (int dd = 0; dd < NDUP(6); ++dd) lru_phase(F, a, l, 1, l == 1);
    __syncthreads();
    const int nlat = 4 * 4 * 32, nctx = (l == 0) ? 4 * 4 * 2 : 0;
    for (int dd = 0; dd < NDUP(7); ++dd)
    for (int it = F.vcu; it < nlat + nctx; it += F.G) {
        int b, h, qb, tq0, nt;
        if (it < nlat) { qb = it & 31; h = (it >> 5) & 3; b = it >> 7; tq0 = b * TPB + CTX + qb * 128; nt = 68; }
        else { const int i2 = it - nlat; qb = i2 & 1; h = (i2 >> 1) & 3; b = i2 >> 3; tq0 = b * TPB + qb * 128; nt = 4; }
        attn_unit(F, tq0, b * TPB, nt, h, lam, a->in[12] + (l * 4 + h) * 128, 1.0f - li);
    }
}

__device__ __forceinline__ void mini_tile(const bf16_t* A, int lda, const bf16_t* Bt, int K, int lane, int wave, f32x4 (&acc)[2]) {
    const int fr = lane & 15, fq = lane >> 4;
    const bf16_t* ap = A + (size_t)((wave >> 1) * 16 + fr) * lda + fq * 8;
    const bf16_t* bp0 = Bt + (size_t)((wave & 1) * 32 + fr) * K + fq * 8; const bf16_t* bp1 = bp0 + (size_t)16 * K;
    acc[0] = (f32x4){0.f, 0.f, 0.f, 0.f}; acc[1] = (f32x4){0.f, 0.f, 0.f, 0.f};
#pragma unroll 8
    for (int k = 0; k < K; k += 32) {
        const bf16x8 av = *(const bf16x8*)(ap + k), b0 = *(const bf16x8*)(bp0 + k), b1 = *(const bf16x8*)(bp1 + k);
        acc[0] = __builtin_amdgcn_mfma_f32_16x16x32_bf16(b0, av, acc[0], 0, 0, 0); acc[1] = __builtin_amdgcn_mfma_f32_16x16x32_bf16(b1, av, acc[1], 0, 0, 0);
    }
}
__device__ __forceinline__ void mini_merge_ctx(const Frame& F, int l) {
    const int fr = F.lane & 15, fq = F.lane >> 4;
    for (int t = F.bid; t < 256; t += F.G) {
        const int rb = t >> 4, cbk = t & 15, cr = rb * 64, tok0 = (cr >> 8) * TPB + (cr & 255), col0 = cbk * 64;
        const int row = tok0 + (F.wave >> 1) * 16 + fr, colw = col0 + (F.wave & 1) * 32 + fq * 4;
        f32x4 mg[2] = {{0.f, 0.f, 0.f, 0.f}, {0.f, 0.f, 0.f, 0.f}};
#pragma unroll 1
        for (int r = 0; r < 3; ++r) {
            f32x4 acc[2];
            mini_tile((const bf16_t*)(F.ws + OV_OA + (size_t)r * 17 * MiB) + (size_t)tok0 * 512, 512, (const bf16_t*)(F.ws + WS_WBR) + (size_t)(l * 3 + r) * 1024 * 512 + (size_t)col0 * 512, 512, F.lane, F.wave, acc);
#pragma unroll
            for (int n = 0; n < 2; ++n) { const u32x2 g = *(const u32x2*)((const bf16_t*)(F.ws + OV_G) + (size_t)row * 3072 + r * 1024 + colw + n * 16);
                mg[n][0] += bflo(g.x) * acc[n][0]; mg[n][1] += bfhi(g.x) * acc[n][1]; mg[n][2] += bflo(g.y) * acc[n][2]; mg[n][3] += bfhi(g.y) * acc[n][3]; }
        }
#pragma unroll
        for (int n = 0; n < 2; ++n) { u32x2 w; w.x = pk2(mg[n][0], mg[n][1]); w.y = pk2(mg[n][2], mg[n][3]); *(u32x2*)((bf16_t*)(F.ws + OV_MG) + (size_t)row * DM + colw + n * 16) = w; }
    }
}
__device__ __forceinline__ void mini_wout_ctx(const Frame& F, int l) {
    const int fr = F.lane & 15, fq = F.lane >> 4;
    const float* g1 = (const float*)(F.ws + WS_MOD) + (l * 5 + 4) * 6144 + 2048;
    for (int t = F.bid; t < 256; t += F.G) {
        const int rb = t >> 4, cbk = t & 15, cr = rb * 64, tok0 = (cr >> 8) * TPB + (cr & 255), col0 = cbk * 64;
        const int crow = cr + (F.wave >> 1) * 16 + fr, colw = col0 + (F.wave & 1) * 32 + fq * 4;
        f32x4 acc[2];
        mini_tile((const bf16_t*)(F.ws + OV_MG) + (size_t)tok0 * DM, DM, (const bf16_t*)(F.ws + WS_WOUT) + (size_t)l * 1048576 + (size_t)col0 * 1024, 1024, F.lane, F.wave, acc);
#pragma unroll
        for (int n = 0; n < 2; ++n) { u32x2* p = (u32x2*)((bf16_t*)((float*)(F.ws + WS_XC) + (size_t)crow * DM) + colw + n * 16); const f32x4 gv = *(const f32x4*)(g1 + colw + n * 16); const u32x2 x = *p;
            u32x2 w; w.x = pk2(bflo(x.x) * DN_ALPHA + gv[0] * acc[n][0], bfhi(x.x) * DN_ALPHA + gv[1] * acc[n][1]); w.y = pk2(bflo(x.y) * DN_ALPHA + gv[2] * acc[n][2], bfhi(x.y) * DN_ALPHA + gv[3] * acc[n][3]); *p = w; }
    }
}

constexpr int RT_AST = 1032;
__device__ __forceinline__ void phase_router(const Frame& F, CArgsP a, int l, bool dry) {
    const float* mod = (const float*)(F.ws + WS_MOD) + l * 5 * 6144; float* xc = (float*)(F.ws + WS_XC); bf16_t* H = (bf16_t*)(F.ws + WS_H);
    LAS bf16_t* AT = (LAS bf16_t*)F.lds;
    LAS float* LG = (LAS float*)(F.lds + 32 * RT_AST * 2);
    LAS unsigned* LC = (LAS unsigned*)(F.lds + 32 * RT_AST * 2 + 8192);
    const bf16_t* Wt = (const bf16_t*)(F.ws + WS_WRT) + (size_t)l * 65536; const float rb_ = a->in[29][l * 64 + F.lane];
    unsigned* cnt = (unsigned*)(F.ws + WS_CNT) + l * 4096; int* list = (int*)(F.ws + WS_LIST);
    int* toke = (int*)(F.ws + WS_TOKE); int* tokp = (int*)(F.ws + WS_TOKP); float* tokw = (float*)(F.ws + WS_TOKW);
    const int nrows = l == 0 ? T : NBATCH * SEQ, nbatch = nrows / 32;
    const int fr = F.lane & 15, fq = F.lane >> 4, mt = F.wave & 1, nt = F.wave >> 1;
    if (F.tid < 64) LC[F.tid] = 0u;
    bf16x8 bfr[32];
    { const bf16_t* bp = Wt + (size_t)(nt * 16 + fr) * 1024 + fq * 8;
#pragma unroll
      for (int ks = 0; ks < 32; ++ks) bfr[ks] = *(const bf16x8*)(bp + ks * 32); }
    for (int bt = F.bid; bt < nbatch; bt += F.G) {
        int toks[4];
#pragma unroll
        for (int r = 0; r < 4; ++r) { const int ridx = bt * 32 + F.wave * 4 + r; toks[r] = l == 0 ? ridx : (ridx >> 12) * TPB + CTX + (ridx & 4095); }
#pragma unroll
        for (int rp = 0; rp < 4; rp += 2) {
        f32x4 vv[2][4];
        row_load_bf16(resid_row(F.out, xc, toks[rp]), F.lane, vv[0]); row_load_bf16(resid_row(F.out, xc, toks[rp + 1]), F.lane, vv[1]);
#pragma unroll
        for (int r2 = 0; r2 < 2; ++r2) { const int r = rp + r2; const int tok = toks[r];
            const int b = tok / TPB; const int bsel = (tok - b * TPB) < CTX ? 4 : b;
            float* xr = resid_row(F.out, xc, tok);
            f32x4 (&v)[4] = vv[r2]; row_ln(v); row_affine(v, a->in[26] + l * DM, false, a->in[27] + l * DM, F.lane);
            row_ln(v); const float* mrow = mod + bsel * 6144; row_affine(v, mrow + 4096, true, mrow + 3072, F.lane);
#pragma unroll
            for (int j = 0; j < 4; ++j) { u32x2 w; w.x = pk2(v[j][0], v[j][1]); w.y = pk2(v[j][2], v[j][3]);
                if (!dry) *(u32x2*)(H + (size_t)tok * DM + 4 * F.lane + 256 * j) = w; *(LAS u32x2*)(AT + (F.wave * 4 + r) * RT_AST + 4 * F.lane + 256 * j) = w; }
        }
        }
        __syncthreads();
        { f32x4 d = {0.f, 0.f, 0.f, 0.f};
          const LAS bf16_t* ap = AT + (mt * 16 + fr) * RT_AST + fq * 8;
#pragma unroll
          for (int ks = 0; ks < 32; ++ks) { const bf16x8 av = *(const LAS bf16x8*)(ap + ks * 32); d = __builtin_amdgcn_mfma_f32_16x16x32_bf16(av, bfr[ks], d, 0, 0, 0); }
#pragma unroll
          for (int r = 0; r < 4; ++r) LG[(mt * 16 + fq * 4 + r) * 64 + nt * 16 + fr] = d[r]; }
        __syncthreads();
        bool selr[4]; int rkr[4], lpr[4]; float wr_[4];
#pragma unroll
        for (int r = 0; r < 4; ++r) {
            const float lg = LG[(F.wave * 4 + r) * 64 + F.lane];
            const float s = sigmoidf_(lg); const float bsc = s + rb_;
            float m1 = bsc; m1 = fmaxf(m1, WS_DPP(m1, 0xB1, 0xF, true)); m1 = fmaxf(m1, WS_DPP(m1, 0x4E, 0xF, true)); m1 = fmaxf(m1, WS_DPP(m1, 0x141, 0xF, true));
            const unsigned long long eq = __ballot(bsc == m1); const unsigned gm = (unsigned)(eq >> (F.lane & ~7)) & 0xffu; const int first = __ffs(gm) - 1;
            float m2 = ((F.lane & 7) == first) ? -INFINITY : bsc; m2 = fmaxf(m2, WS_DPP(m2, 0xB1, 0xF, true)); m2 = fmaxf(m2, WS_DPP(m2, 0x4E, 0xF, true)); m2 = fmaxf(m2, WS_DPP(m2, 0x141, 0xF, true));
            const float gs = m1 + m2; const int myg = F.lane >> 3; int grank = 0;
#pragma unroll
            for (int g = 0; g < 8; ++g) { const float og = __builtin_bit_cast(float, __builtin_amdgcn_readlane(__builtin_bit_cast(int, gs), g * 8)); grank += (int)(og > gs) + (int)((og == gs) & (g < myg)); }
            const bool gsel = grank < 4; const float mk = gsel ? bsc : -INFINITY; int rk = 64;
            { float vv_ = mk;
#pragma unroll
              for (int k = 0; k < 8; ++k) {
                  float m = vv_; m = fmaxf(m, WS_DPP(m, 0xB1, 0xF, true)); m = fmaxf(m, WS_DPP(m, 0x4E, 0xF, true)); m = fmaxf(m, WS_DPP(m, 0x141, 0xF, true)); m = fmaxf(m, WS_DPP(m, 0x140, 0xF, true));
                  const float r1 = __builtin_bit_cast(float, __builtin_amdgcn_readlane(__builtin_bit_cast(int, m), 15)), r2 = __builtin_bit_cast(float, __builtin_amdgcn_readlane(__builtin_bit_cast(int, m), 31)),
                              r3 = __builtin_bit_cast(float, __builtin_amdgcn_readlane(__builtin_bit_cast(int, m), 47)), r4 = __builtin_bit_cast(float, __builtin_amdgcn_readlane(__builtin_bit_cast(int, m), 63));
                  const float wm = fmaxf(fmaxf(r1, r2), fmaxf(r3, r4));
                  const unsigned long long bal = __ballot(vv_ == wm); const int win = __ffsll((long long)bal) - 1;
                  if (F.lane == win) { rk = k; vv_ = -INFINITY; }
              } }
            const bool sel = gsel && rk < 8 && !dry;
            const float ssum = wave_sum((gsel && rk < 8) ? s : 0.f);
            selr[r] = sel; rkr[r] = rk; wr_[r] = s / ssum * 2.5f; lpr[r] = 0;
            if (sel) lpr[r] = (int)__hip_atomic_fetch_add((LAS unsigned*)(LC + F.lane), 1u, __ATOMIC_RELAXED, __HIP_MEMORY_SCOPE_WORKGROUP);
        }
        __syncthreads();
        if (F.tid < 64) { const unsigned n = LC[F.tid]; unsigned base = 0; if (n) base = atomicAdd(cnt + F.tid * 64, n); LC[64 + F.tid] = base; LC[F.tid] = 0u; }
        __syncthreads();
#pragma unroll
        for (int r = 0; r < 4; ++r)
            if (selr[r]) { const int tok = toks[r]; const int pos = (int)LC[64 + F.lane] + lpr[r];
                list[(size_t)F.lane * T + pos] = tok; toke[tok * 8 + rkr[r]] = F.lane; tokp[tok * 8 + rkr[r]] = pos; tokw[tok * 8 + rkr[r]] = wr_[r]; }
        __syncthreads();
    }
}

__device__ __forceinline__ void build_tables(const Frame& F, int l) {
    LAS int* tb = (LAS int*)(F.lds + LDS_CTL);
    __syncthreads();
    if (F.tid < 64) tb[LC_TCNT + F.tid] = (int)__hip_atomic_load((unsigned*)(F.ws + WS_CNT) + l * 4096 + F.tid * 64, __ATOMIC_RELAXED, __HIP_MEMORY_SCOPE_AGENT);
    __syncthreads();
    if (F.tid == 0) { int tbs = 0, sbs = 0;
        for (int e = 0; e < 64; ++e) { const int c = tb[LC_TCNT + e]; tb[LC_TBASE + e] = tbs; tb[LC_SBASE + e] = sbs; tbs += (c + 255) >> 8; sbs += c; }
        tb[LC_TBASE + 64] = tbs; tb[LC_SBASE + 64] = sbs; }
    __syncthreads();
}

__device__ __forceinline__ void phase_combine(const Frame& F, CArgsP a, int l, bool dry) {
    const float* mod = (const float*)(F.ws + WS_MOD) + l * 5 * 6144; float* xc = (float*)(F.ws + WS_XC); bf16_t* H = (bf16_t*)(F.ws + WS_H);
    const unsigned char* YS = (const unsigned char*)(F.ws + OV_YS); const LAS int* tb = (const LAS int*)(F.lds + LDS_CTL);
    const int* toke = (const int*)(F.ws + WS_TOKE); const int* tokp = (const int*)(F.ws + WS_TOKP); const float* tokw = (const float*)(F.ws + WS_TOKW);
    const int nrows = l == 0 ? T : NBATCH * SEQ;
    for (int rp = F.gw * 2; rp < nrows; rp += F.NGW * 2) {
        int tok[2], bsel[2]; float* xr[2]; f32x4 y[2][4], v[2][4]; int me, mp; float mw;
#pragma unroll
        for (int q = 0; q < 2; ++q) { const int ridx = rp + q; tok[q] = l == 0 ? ridx : (ridx >> 12) * TPB + CTX + (ridx & 4095);
            const int b = tok[q] / TPB; bsel[q] = (tok[q] - b * TPB) < CTX ? 4 : b; xr[q] = resid_row(F.out, xc, tok[q]); }
        { const int q = (F.lane >> 3) & 1, k = F.lane & 7; me = toke[tok[q] * 8 + k]; mp = tokp[tok[q] * 8 + k]; mw = tokw[tok[q] * 8 + k]; }
#pragma unroll
        for (int q = 0; q < 2; ++q) { const bf16_t* sp = H + (size_t)tok[q] * DM;
#pragma unroll
            for (int j = 0; j < 4; ++j) { const u32x2 w = *(const u32x2*)(sp + 4 * F.lane + 256 * j); y[q][j] = (f32x4){bflo(w.x), bfhi(w.x), bflo(w.y), bfhi(w.y)}; }
            row_load_bf16(xr[q], F.lane, v[q]); }
#pragma unroll
        for (int q = 0; q < 2; ++q) { row_ln(v[q]); row_affine(v[q], a->in[26] + l * DM, false, a->in[27] + l * DM, F.lane); }
#pragma unroll
        for (int q = 0; q < 2; ++q)
#pragma unroll
            for (int k = 0; k < 8; ++k) { const int e = __shfl(me, q * 8 + k), p = __shfl(mp, q * 8 + k); const float wv = __shfl(mw, q * 8 + k) * 0.0625f;
                const unsigned char* yp = YS + (size_t)(tb[LC_SBASE + e] + p) * DM;
#pragma unroll
                for (int j = 0; j < 4; ++j) { const int w = (int)*(const unsigned*)(yp + 4 * F.lane + 256 * j);
                    y[q][j][0] += wv * __builtin_amdgcn_cvt_f32_fp8(w, 0); y[q][j][1] += wv * __builtin_amdgcn_cvt_f32_fp8(w, 1); y[q][j][2] += wv * __builtin_amdgcn_cvt_f32_fp8(w, 2); y[q][j][3] += wv * __builtin_amdgcn_cvt_f32_fp8(w, 3); } }
#pragma unroll
        for (int q = 0; q < 2; ++q) {
            const float* g2 = mod + bsel[q] * 6144 + 5120;
#pragma unroll
            for (int j = 0; j < 4; ++j) { const f32x4 gv = *(const f32x4*)(g2 + 4 * F.lane + 256 * j); v[q][j] = v[q][j] * DN_ALPHA + gv * y[q][j]; }
            row_ln(v[q]); row_affine(v[q], a->in[36] + l * DM, false, a->in[37] + l * DM, F.lane);
            if (!dry) { if (l == 0) row_store_bf16((bf16_t*)xr[q], F.lane, v[q]); else row_store(xr[q], F.lane, v[q]); } else asm volatile("" :: "v"(v[q][0]), "v"(v[q][1]), "v"(v[q][2]), "v"(v[q][3]));
            if (l == 0 && !dry) { row_ln(v[q]); const float* mrow = mod + 5 * 6144 + bsel[q] * 6144; row_affine(v[q], mrow + 1024, true, mrow, F.lane); row_store_bf16(H + (size_t)tok[q] * DM, F.lane, v[q]); }
        }
    }
}

constexpr int NPHASE = 22;
__global__ void __launch_bounds__(NTHR, 2) mk_fwd(Args args) {
    extern __shared__ __attribute__((aligned(16))) unsigned char lds_raw[];
    Frame F; F.lds = (LAS unsigned char*)lds_raw; F.tid = threadIdx.x; F.lane = F.tid & 63; F.wave = __builtin_amdgcn_readfirstlane(F.tid >> 6);
    F.G = gridDim.x; F.bid = blockIdx.x; F.gw = F.bid * NWAVES + F.wave; F.NGW = F.G * NWAVES; F.ws = args.ws; F.out = args.out; F.vcu = (F.G % 8 == 0) ? (F.bid % 8) * (F.G / 8) + F.bid / 8 : F.bid;
    for (int u = F.tid; u < (LDS_BYTES - LDS_CTL) / 4; u += NTHR) ((LAS unsigned*)(F.lds + LDS_CTL))[u] = 0u;
    __syncthreads();
    const int lo = args.ph_lo, hi = args.ph_hi;
    CArgsP A4 = (CArgsP)__builtin_amdgcn_kernarg_segment_ptr();
    XcdBarrier bar; bar.bar = (unsigned*)(F.ws + CW_BAR_BYTE); bar.x = 0; bar.st = nullptr;
    if (hi - lo > 1) bar = xcd_barrier_post((unsigned*)(F.ws + CW_BAR_BYTE), (volatile LAS unsigned*)(F.lds + LDS_CTL) + LC_BAR);
#ifndef PHMASK
#define PHMASK 0xfff
#endif
#define PH_EN(k) ((PHMASK >> ((k) < 2 ? (k) : 2 + (((k) - 2) % 10))) & 1)
#define IN(k) (PH_EN(k) && lo <= (k) && (k) < hi)
#define SEAM(k) do { if (IN(k) && IN((k) + 1)) { for (int dd = 0; dd < NDUP(14); ++dd) xcd_barrier(bar); } if (TSMASK != 0 && blockIdx.x == 0 && threadIdx.x == 0) { ((volatile LAS unsigned long long*)(F.lds + LDS_CTL + 2048))[(k) + 1] = __builtin_amdgcn_s_memrealtime(); } FRESH(); } while (0)
#define FRESH() do { int t_ = threadIdx.x, b_ = blockIdx.x; CArgsP p_ = (CArgsP)__builtin_amdgcn_kernarg_segment_ptr(); asm volatile("" : "+v"(t_)); asm volatile("" : "+s"(b_), "+s"(p_)); A4 = p_; unsigned char* w_ = p_->ws; float* o_ = p_->out; \
    F.tid = t_; F.lane = t_ & 63; F.wave = __builtin_amdgcn_readfirstlane(t_ >> 6); F.bid = b_; F.gw = b_ * NWAVES + F.wave; F.ws = w_; F.out = o_; F.vcu = (F.G % 8 == 0) ? (b_ % 8) * (F.G / 8) + b_ / 8 : b_; } while (0)
    if (TSMASK != 0 && blockIdx.x == 0 && threadIdx.x == 0) ((volatile LAS unsigned long long*)(F.lds + LDS_CTL + 2048))[0] = __builtin_amdgcn_s_memrealtime();
    if (IN(0)) { for (int dd = 0; dd < NDUP(0); ++dd) phase_prologue(F, A4); } SEAM(0);
    if (IN(1)) { for (int dd = 0; dd < NDUP(1); ++dd) phase_rows0(F, A4); } SEAM(1);
#pragma unroll 1
    for (int l = 0; l < 2; ++l) {
        const int pb = 2 + 10 * l; const bool lat = (l == 1);
        if (IN(pb + 0)) {
            SchedPlain S{(const char*)(F.ws + WS_H), (const char*)(F.ws + WS_WIN) + (size_t)l * INC * 1024 * 2, 1024, 68, 26, F.G, F.bid, false};
            EpiInproj E{F.ws, A4->in[7] + l * INC, (const float*)(F.ws + WS_ROPE)};
            for (int dd = 0; dd < NDUP(2); ++dd) pg8::gemm_phase(F.lds, 1024, S, E);
        } SEAM(pb + 0);
        if (IN(pb + 1)) {
            for (int dd = 0; dd < NDUP(3); ++dd) lru_phase(F, A4, l, 0, false);
            for (int dd = 0; dd < NDUP(4); ++dd)
            for (int it = F.bid; it < 136 * 4; it += F.G) { const int chunk = it >> 2; if (lat && (chunk % 34) < 2) continue; sg_item(F, A4, l, chunk, it & 3); }
        } SEAM(pb + 1);
        if (IN(pb + 2)) { for (int dd = 0; dd < NDUP(5); ++dd) phase_carry(F); } SEAM(pb + 2);
        if (IN(pb + 3)) { phase_attn(F, A4, l); } SEAM(pb + 3);
        if (IN(pb + 4)) {
            for (int dd = 0; dd < NDUP(8); ++dd) {
                SchedMerge S{(const char*)(F.ws + OV_OA), (const char*)(F.ws + WS_WBR) + (size_t)(l * 3) * 1024 * 512 * 2, F.G, F.bid};
                EpiMerge E{(bf16_t*)(F.ws + OV_MG), (const bf16_t*)(F.ws + OV_G)};
                pg8::gemm_phase(F.lds, 512, S, E);
            }
            if (!lat) mini_merge_ctx(F, l);
        } SEAM(pb + 4);
        if (IN(pb + 5)) {
            SchedPlain S{(const char*)(F.ws + OV_MG), (const char*)(F.ws + WS_WOUT) + (size_t)l * 1048576 * 2, 1024, 64, 4, F.G, F.bid, true};
            EpiWout E{F.out, (float*)(F.ws + WS_XC), (const float*)(F.ws + WS_MOD) + l * 5 * 6144, false};
            pg8::gemm_phase(F.lds, 1024, S, E);
            if (NDUP(11) > 1) { EpiWout E2{F.out, (float*)(F.ws + WS_XC), (const float*)(F.ws + WS_MOD) + l * 5 * 6144, true}; pg8::gemm_phase(F.lds, 1024, S, E2); }
            if (!lat) mini_wout_ctx(F, l);
        } SEAM(pb + 5);
        if (IN(pb + 6)) { phase_router(F, A4, l, false); if (NDUP(12) > 1) phase_router(F, A4, l, F.G != 12345); } SEAM(pb + 6);
        if (IN(pb + 7)) {
            build_tables(F, l);
            SchedMoe S{(const char*)(F.ws + WS_H), (const char*)(F.ws + WS_H), (const char*)(F.ws + WS_WM1), (const char*)(F.ws + WS_WSH1) + (size_t)l * 524288 * 2,
                       (const int*)(F.ws + WS_LIST), (const LAS int*)(F.lds + LDS_CTL), 1024, 2, F.G, F.vcu, lat ? 64 : 68, lat, true, (size_t)524288 * 2};
            EpiMoe1 E{(bf16_t*)(F.ws + OV_ACT), (bf16_t*)(F.ws + OV_ACTSH)};
            for (int dd = 0; dd < NDUP(9); ++dd) pg8::gemm_phase(F.lds, 1024, S, E);
        } SEAM(pb + 7);
        if (IN(pb + 8)) {
            build_tables(F, l);
            SchedMoe S{(const char*)(F.ws + OV_ACT), (const char*)(F.ws + OV_ACTSH), (const char*)(F.ws + WS_WM2), (const char*)(F.ws + WS_WSH2) + (size_t)l * 262144 * 2,
                       (const int*)(F.ws + WS_LIST), (const LAS int*)(F.lds + LDS_CTL), 256, 4, F.G, F.vcu, lat ? 64 : 68, lat, false, (size_t)262144 * 2};
            EpiMoe2 E{(unsigned char*)(F.ws + OV_YS), (bf16_t*)(F.ws + WS_H)};
            for (int dd = 0; dd < NDUP(10); ++dd) pg8::gemm_phase(F.lds, 256, S, E);
        } SEAM(pb + 8);
        if (IN(pb + 9)) {
            build_tables(F, l);
            phase_combine(F, A4, l, false);
            if (NDUP(13) > 1) phase_combine(F, A4, l, F.G != 12345);
            if (l == 0) for (int dd = 0; dd < NDUP(15); ++dd) conv_moe_layer(F, A4, 1);
        } SEAM(pb + 9);
    }
    if (TSMASK != 0 && hi - lo == NPHASE) { __syncthreads(); asm volatile("s_waitcnt vmcnt(0)" ::: "memory");
        if (blockIdx.x == 0 && threadIdx.x == 0) { volatile LAS unsigned long long* ts = (volatile LAS unsigned long long*)(F.lds + LDS_CTL + 2048);
            unsigned long long sel = 0; for (int k = 0; k < NPHASE; ++k) if ((TSMASK >> k) & 1) sel += ts[k + 1] - ts[k];
            const float frac = (float)sel / (float)(ts[NPHASE] - ts[0]); args.out[0] += 1.0f + floorf(90.0f * frac + 0.5f); } }
#undef IN
#undef SEAM
}

extern "C" void kernel_launch(void* const* d_in, const int* in_sizes, int n_in, void* d_out, int out_size, void* d_ws, size_t ws_size, hipStream_t stream) {
    static int grid = 0;
    if (grid == 0) {
        if (n_in != 38 || out_size != NBATCH * SEQ * DM || ws_size < WS_END) { fprintf(stderr, "kernel_launch: unexpected shapes (n_in %d out %d ws %zu need %zu)\n", n_in, out_size, ws_size, (size_t)WS_END); grid = -1; return; }
        int dev = 0, cus = 0;
        if (hipGetDevice(&dev) != hipSuccess || hipDeviceGetAttribute(&cus, hipDeviceAttributeMultiprocessorCount, dev) != hipSuccess) { grid = -1; return; }
        if (hipFuncSetAttribute((const void*)mk_fwd, hipFuncAttributeMaxDynamicSharedMemorySize, LDS_BYTES) != hipSuccess) { fprintf(stderr, "kernel_launch: hipFuncSetAttribute failed\n"); grid = -1; return; }
        int per_cu = 0;
        if (hipOccupancyMaxActiveBlocksPerMultiprocessor(&per_cu, (const void*)mk_fwd, NTHR, LDS_BYTES) != hipSuccess || per_cu < 1) fprintf(stderr, "kernel_launch: occupancy query says %d\n", per_cu);
        (void)hipGetLastError();
        grid = cus;
    }
    if (grid < 0) return;
    (void)hipMemsetAsync((char*)d_ws + WS_CTL, 0, CTL_ZERO_BYTES, stream);
    Args a{};
    for (int i = 0; i < 38; ++i) a.in[i] = (const float*)d_in[i];
    a.out = (float*)d_out; a.ws = (unsigned char*)d_ws;
#if MK_MULTI
    for (int p = 0; p < NPHASE; ++p) { a.ph_lo = p; a.ph_hi = p + 1; hipLaunchKernelGGL(mk_fwd, dim3(grid), dim3(NTHR), LDS_BYTES, stream, a); }
#else
    a.ph_lo = 0; a.ph_hi = NPHASE; hipLaunchKernelGGL(mk_fwd, dim3(grid), dim3(NTHR), LDS_BYTES, stream, a);
#endif
}
```

```cpp
#include <hip/hip_runtime.h>
#include <cstdio>
#include <cstdint>
#include <cmath>

#ifndef MK_MULTI
#define MK_MULTI 0
#endif
#ifndef DUPMASK
#define DUPMASK 0
#endif
#define NDUP(c) (1 + ((DUPMASK >> (c)) & 1))
#ifndef TSMASK
#define TSMASK 0
#endif
#ifndef NAIVE_GEMM
#define NAIVE_GEMM 0
#endif

#define LAS __attribute__((address_space(3)))
#define GAS __attribute__((address_space(1)))
typedef unsigned short bf16_t;
typedef short bf16x8 __attribute__((ext_vector_type(8)));
typedef short s16x4 __attribute__((ext_vector_type(4)));
typedef float f32x4 __attribute__((ext_vector_type(4)));
typedef float f32x16 __attribute__((ext_vector_type(16)));
typedef unsigned u32x4 __attribute__((ext_vector_type(4)));
typedef unsigned u32x2 __attribute__((ext_vector_type(2)));

constexpr int DM = 1024, NBATCH = 4, SEQ = 4096, CTX = 256, TPB = SEQ + CTX  , T = NBATCH * TPB  ;
constexpr int INC = 6656, NEXP = 64;
constexpr float DN_ALPHA = 1.41421356237309515f;
constexpr float LN_EPS = 1e-6f, RMS_EPS = 1e-5f;
constexpr int NWAVES = 8, NTHR = 512;

constexpr size_t MiB = 1u << 20;
constexpr size_t WS_CTL = 0, CTL_ZERO_BYTES = 1 * MiB;
constexpr size_t CW_BAR_BYTE = 16384;
constexpr size_t WS_CNT = 65536;
constexpr size_t WS_MOD = 131072;
constexpr size_t WS_ROPE = 1 * MiB;
constexpr size_t WS_LAM = 1 * MiB + 8192;
constexpr size_t WS_SUM = 1 * MiB + 65536;
constexpr size_t WS_HIN = WS_SUM + 2304 * 1024;
constexpr size_t WS_TOKE = 5 * MiB, WS_TOKP = 6 * MiB, WS_TOKW = 7 * MiB;
constexpr size_t WS_LIST = 8 * MiB;
constexpr size_t WS_XC = 13 * MiB;
constexpr size_t WS_WLRU = 17 * MiB;
constexpr size_t WS_WSG = 17 * MiB + 512 * 1024;
constexpr size_t WS_WRT = 17 * MiB + 768 * 1024;
constexpr size_t WS_WSH1 = 18 * MiB;
constexpr size_t WS_WSH2 = 20 * MiB;
constexpr size_t WS_WOUT = 21 * MiB;
constexpr size_t WS_WBR = 25 * MiB;
constexpr size_t WS_WIN = 31 * MiB;
constexpr size_t WS_WM1 = 57 * MiB;
constexpr size_t WS_WM2 = 121 * MiB;
constexpr size_t WS_H = 153 * MiB;
constexpr size_t WS_OV = 187 * MiB;
constexpr size_t OV_Q = WS_OV, OV_K = WS_OV + 17 * MiB, OV_V = WS_OV + 34 * MiB, OV_U = WS_OV + 51 * MiB, OV_S = WS_OV + 68 * MiB,
                 OV_X = WS_OV + 85 * MiB, OV_Y = WS_OV + 102 * MiB, OV_G = WS_OV + 119 * MiB, OV_OA = WS_OV + 221 * MiB,
                 OV_OB = WS_OV + 238 * MiB, OV_OC = WS_OV + 255 * MiB, OV_MG = WS_OV + 272 * MiB;
constexpr size_t OV_ACT = WS_OV, OV_ACTSH = WS_OV + 69 * MiB, OV_YS = WS_OV + 78 * MiB;
constexpr size_t WS_END = WS_OV + 350 * MiB;

constexpr int LDS_SCRATCH = 147456;
constexpr int LDS_CTL = LDS_SCRATCH;
constexpr int LDS_BYTES = LDS_SCRATCH + 4096;
constexpr int LC_BAR = 0;
constexpr int LC_TCNT = 64, LC_TBASE = 64 + 80, LC_SBASE = 64 + 160;

struct Args { const float* in[38]; float* out; unsigned char* ws; int ph_lo, ph_hi; };
typedef const Args __attribute__((address_space(4)))* CArgsP;

__device__ __forceinline__ unsigned f2bf(float f) { unsigned u = __builtin_bit_cast(unsigned, f); return (u + 0x7fffu + ((u >> 16) & 1u)) >> 16; }
typedef float f32x2 __attribute__((ext_vector_type(2))); typedef __bf16 bf16x2_t __attribute__((ext_vector_type(2)));
__device__ __forceinline__ unsigned pk2(float lo, float hi) { const f32x2 v = {lo, hi}; const bf16x2_t b = __builtin_convertvector(v, bf16x2_t); return __builtin_bit_cast(unsigned, b); }
__device__ __forceinline__ float bflo(unsigned w) { return __builtin_bit_cast(float, w << 16); }
__device__ __forceinline__ float bfhi(unsigned w) { return __builtin_bit_cast(float, w & 0xffff0000u); }
__device__ __forceinline__ float bf2f(bf16_t b) { return __builtin_bit_cast(float, (unsigned)b << 16); }
#define WS_DPP(v, ctrl, rmask, bc) __builtin_bit_cast(float, __builtin_amdgcn_update_dpp(0, __builtin_bit_cast(int, v), ctrl, rmask, 0xF, bc))
__device__ __forceinline__ float wave_sum(float v) {
    v += WS_DPP(v, 0xB1, 0xF, true); v += WS_DPP(v, 0x4E, 0xF, true); v += WS_DPP(v, 0x141, 0xF, true); v += WS_DPP(v, 0x140, 0xF, true);
    v += WS_DPP(v, 0x142, 0xA, false); v += WS_DPP(v, 0x143, 0xC, false);
    return __builtin_bit_cast(float, __builtin_amdgcn_readlane(__builtin_bit_cast(int, v), 63));
}
__device__ __forceinline__ float sigmoidf_(float x) { return __builtin_amdgcn_rcpf(1.f + __builtin_amdgcn_exp2f(-1.4426950408889634f * x)); }
__device__ __forceinline__ float gelu_tanh(float x) { const float u = x * (0.7978845608028654f + 0.035677408136300125f * x * x); return x * __builtin_amdgcn_rcpf(1.f + __builtin_amdgcn_exp2f(-2.885390081777927f * u)); }
__device__ __forceinline__ float silu_(float x) { return x * __builtin_amdgcn_rcpf(1.f + __builtin_amdgcn_exp2f(-1.4426950408889634f * x)); }
__device__ __forceinline__ float expm1_fast(float x) {
    if (x > -0.5f && x < 0.5f) { float p = 1.0f + x * (1.0f / 8.0f); p = 1.0f + x * (1.0f / 7.0f) * p; p = 1.0f + x * (1.0f / 6.0f) * p; p = 1.0f + x * 0.2f * p; p = 1.0f + x * 0.25f * p; p = 1.0f + x * (1.0f / 3.0f) * p; p = 1.0f + x * 0.5f * p; return x * p; }
    return expm1f(x);
}
#define LDS_WAIT() asm volatile("s_waitcnt lgkmcnt(0)" ::: "memory")
#define VM_WAIT() asm volatile("s_waitcnt vmcnt(0)" ::: "memory")

#define XB_TMO      128
#define XB_XCNT(j)  (256  + 64 * (j))
#define XB_XSUB(j)  (1280 + 64 * (j))
#define XB_XGEN(j)  (2304 + 64 * (j))
#define XB_TOP      3328
#define XB_TOPGEN   3392
#define XCD_BAR_WORDS 3456
#define XB_SPIN_CAP (1u << 22)
__device__ __forceinline__ unsigned xb_ld(unsigned* p)              { return __hip_atomic_load(p, __ATOMIC_RELAXED, __HIP_MEMORY_SCOPE_AGENT); }
__device__ __forceinline__ unsigned xb_add(unsigned* p, unsigned v) { return __hip_atomic_fetch_add(p, v, __ATOMIC_RELAXED, __HIP_MEMORY_SCOPE_AGENT); }
__device__ __forceinline__ unsigned xb_xcc_id() { return (unsigned)__builtin_amdgcn_s_getreg((3 << 11) | 20) & 0xFu; }
#define XB_SPIN(cond, bar) do { unsigned _sp = 0; while (cond) { __builtin_amdgcn_s_sleep(1); \
    if ((++_sp & 255u) == 0u) { if (xb_ld(&(bar)[XB_TMO])) break; if (_sp > XB_SPIN_CAP) { atomicAdd(&(bar)[XB_TMO], 1u); break; } } } } while (0)
struct XcdBarrier { unsigned* bar; unsigned x; volatile LAS unsigned* st; };
__device__ __forceinline__ XcdBarrier xcd_barrier_post(unsigned* bar, volatile LAS unsigned* st) {
    XcdBarrier b; b.bar = bar; b.x = xb_xcc_id(); b.st = st;
    if (threadIdx.x == 0) (void)xb_add(&bar[XB_XCNT(b.x)], 1u);
    return b;
}
__device__ __forceinline__ void xcd_barrier_complete(unsigned* bar, unsigned x, unsigned& nloc, unsigned& nx) {
    const unsigned G = gridDim.x * gridDim.y * gridDim.z;
    unsigned sum, cnt, mine, sp = 0u;
    for (;;) {
        sum = 0u; cnt = 0u; mine = 0u;
#pragma unroll
        for (unsigned j = 0; j < 16; ++j) { const unsigned c = xb_ld(&bar[XB_XCNT(j)]); sum += c; cnt += (c > 0u) ? 1u : 0u; mine = (j == x) ? c : mine; }
        if (sum == G) break;
        __builtin_amdgcn_s_sleep(1);
        if ((++sp & 255u) == 0u) { if (xb_ld(&bar[XB_TMO])) break; if (sp > XB_SPIN_CAP) { atomicAdd(&bar[XB_TMO], 1u); break; } }
    }
    nloc = mine > 0u ? mine : 1u; nx = cnt > 0u ? cnt : 1u;
}
__device__ __forceinline__ void xcd_barrier(const XcdBarrier& b) {
    asm volatile("s_waitcnt vmcnt(0)" ::: "memory");
    __syncthreads();
    if (threadIdx.x == 0) {
        unsigned* bar = b.bar; asm volatile("" : "+s"(bar));
        __builtin_amdgcn_s_waitcnt(0);
        unsigned nloc = b.st[0], nx = b.st[1];
        if (nloc == 0u) { xcd_barrier_complete(bar, b.x, nloc, nx); b.st[0] = nloc; b.st[1] = nx; }
        const unsigned old = xb_add(&bar[XB_XSUB(b.x)], 1u);
        const unsigned gen = old / nloc;
        if (old + 1u == (gen + 1u) * nloc) {
            __builtin_amdgcn_fence(__ATOMIC_RELEASE, "agent");
            asm volatile("s_waitcnt vmcnt(0)" ::: "memory");
            const unsigned og = xb_add(&bar[XB_TOP], 1u);
            const unsigned tg = og / nx;
            if (og + 1u == (tg + 1u) * nx) xb_add(&bar[XB_TOPGEN], 1u);
            else XB_SPIN(xb_ld(&bar[XB_TOPGEN]) == tg, bar);
            __builtin_amdgcn_fence(__ATOMIC_ACQUIRE, "agent");
            xb_add(&bar[XB_XGEN(b.x)], 1u);
            asm volatile("s_waitcnt vmcnt(0)" ::: "memory");
        } else {
            XB_SPIN(xb_ld(&bar[XB_XGEN(b.x)]) == gen, bar);
            __builtin_amdgcn_fence(__ATOMIC_ACQUIRE, "agent");
            asm volatile("s_waitcnt vmcnt(0)" ::: "memory");
        }
    }
    __syncthreads();
}

namespace pg8 {
constexpr int BM = 256, BK = 64, HALF = 128, HTB = HALF * BK * 2, STAGE_BYTES = 8 * HTB, NXCD = 8, WGM = 8;
__host__ __device__ __forceinline__ int lds_byte(int r, int c) { const int st = (r >> 4) * 2 + (c >> 5), rr = r & 15, cc = c & 31, ob = rr * 64 + cc * 2; return st * 1024 + (ob ^ (((ob >> 9) & 1) << 5)); }
__host__ __device__ __forceinline__ void stage_rc(int b, int& R, int& C) { const int st = b / 1024, sb = b % 1024, swz = sb ^ (((sb >> 9) & 1) << 5); R = (st >> 1) * 16 + swz / 64; C = (st & 1) * 32 + (swz % 64) / 2; }
__host__ __device__ __forceinline__ int perm32(int rho) { const int n = rho >> 4, i = rho & 15; return 8 * (i >> 2) + 4 * n + (i & 3); }
struct Unit { int pm, pn, e, ti, nrows, row0; };
typedef f32x4 Acc[2][2][4][2];

template <class Epi, class Sched>
__device__ __forceinline__ void gemm_phase(LAS unsigned char* lds, const int K, const Sched& S, const Epi& E) {
    int tid_ = threadIdx.x; asm volatile("" : "+v"(tid_));
    const int tid = tid_, wid = __builtin_amdgcn_readfirstlane(tid >> 6), lane = tid & 63, wr = wid >> 2, wc = wid & 3, fr = lane & 15, fq = lane >> 4;
    (void)fr; (void)fq; (void)wc;
    Unit cur, nxt; int ui = 0;
    if (!S.next(0, cur)) return;
    Acc acc;
#pragma unroll
    for (int a = 0; a < 2; ++a)
#pragma unroll
        for (int b = 0; b < 2; ++b)
#pragma unroll
            for (int m = 0; m < 4; ++m)
#pragma unroll
                for (int n = 0; n < 2; ++n) acc[a][b][m][n] = (f32x4){0.f, 0.f, 0.f, 0.f};
#if NAIVE_GEMM
    for (;;) {
        const char* Ab = S.a_base(); const char* Bb = S.b_ptr(cur);
#pragma unroll 1
        for (int ai = 0; ai < 2; ++ai)
#pragma unroll 1
            for (int m = 0; m < 4; ++m) {
                const int rr = ai * 128 + wr * 64 + m * 16 + fr;
                const bf16_t* ap = (const bf16_t*)(Ab + S.a_off(cur, rr));
#pragma unroll
                for (int bj = 0; bj < 2; ++bj)
#pragma unroll
                    for (int n = 0; n < 2; ++n)
#pragma unroll
                        for (int j = 0; j < 4; ++j) {
                            const int cc = Epi::PERM ? bj * 128 + wc * 32 + fq * 8 + n * 4 + j : bj * 128 + wc * 32 + n * 16 + fq * 4 + j;
                            const bf16_t* bp = (const bf16_t*)(Bb + (size_t)cc * K * 2);
                            float s = 0.f;
                            for (int k = 0; k < K; k += 8) {
                                const u32x4 av = *(const u32x4*)(ap + k), bv = *(const u32x4*)(bp + k);
                                s += bflo(av.x) * bflo(bv.x) + bfhi(av.x) * bfhi(bv.x) + bflo(av.y) * bflo(bv.y) + bfhi(av.y) * bfhi(bv.y)
                                   + bflo(av.z) * bflo(bv.z) + bfhi(av.z) * bfhi(bv.z) + bflo(av.w) * bflo(bv.w) + bfhi(av.w) * bfhi(bv.w);
                            }
                            acc[ai][bj][m][n][j] = s;
                        }
            }
        E(acc, cur, wr, wc, fr, fq);
        ++ui;
        if (!S.next(ui, cur)) break;
    }
    return;
#else
    const int nt = K / BK;
    unsigned voffB[2];
    { int Rr[2], Cc[2];
#pragma unroll
      for (int i = 0; i < 2; ++i) { stage_rc(tid * 16 + i * 8192, Rr[i], Cc[i]); const int Rb = Epi::PERM ? ((Rr[i] & ~31) + perm32(Rr[i] & 31)) : Rr[i]; voffB[i] = (unsigned)(Rb * K + Cc[i]) * 2u; } }
#define PG8_AOFFS(U, o00, o01, o10, o11) do { int t3_ = threadIdx.x; asm volatile("" : "+v"(t3_)); int R0_, C0_, R1_, C1_; stage_rc(t3_ * 16, R0_, C0_); stage_rc(t3_ * 16 + 8192, R1_, C1_); \
        o00 = S.a_off(U, R0_) + (unsigned)C0_ * 2u; o01 = S.a_off(U, R1_) + (unsigned)C1_ * 2u; o10 = S.a_off(U, HALF + R0_) + (unsigned)C0_ * 2u; o11 = S.a_off(U, HALF + R1_) + (unsigned)C1_ * 2u; } while (0)
    const size_t kstep = (size_t)(BK * 2);
    const size_t hstep = (size_t)HALF * K * 2;
    const unsigned ldsw = (unsigned)wid * 1024u;
    const int aoff = lds_byte(wr * 64 + fr, fq * 8), boff = lds_byte(wc * 32 + fr, fq * 8);
#define PG8_SA(b, h) (((b) * 2 + (h)) * HTB)
#define PG8_SB(b, h) ((4 + (b) * 2 + (h)) * HTB)
#define PG8_STAGE(bufoff, gbase, v0, v1) do { \
        __builtin_amdgcn_global_load_lds((const unsigned*)((const char*)(gbase) + (v0)), (LAS unsigned*)(lds + (bufoff) + ldsw), 16, 0, 0); \
        __builtin_amdgcn_global_load_lds((const unsigned*)((const char*)(gbase) + (v1)), (LAS unsigned*)(lds + (bufoff) + ldsw + 8192), 16, 0, 0); } while (0)
#define PG8_LDA(dst, b, h) do { _Pragma("unroll") for (int m = 0; m < 4; ++m) _Pragma("unroll") for (int k = 0; k < 2; ++k) dst[m][k] = *(const LAS bf16x8*)(lds + PG8_SA(b, h) + aoff + m * 2048 + k * 1024); } while (0)
#define PG8_LDB(dst, b, h) do { _Pragma("unroll") for (int n = 0; n < 2; ++n) _Pragma("unroll") for (int k = 0; k < 2; ++k) dst[n][k] = *(const LAS bf16x8*)(lds + PG8_SB(b, h) + boff + n * 2048 + k * 1024); } while (0)
#define PG8_MMA(ai, bj, At, Bt) do { __builtin_amdgcn_s_setprio(1); _Pragma("unroll") for (int m = 0; m < 4; ++m) _Pragma("unroll") for (int n = 0; n < 2; ++n) _Pragma("unroll") for (int k = 0; k < 2; ++k) \
        acc[ai][bj][m][n] = __builtin_amdgcn_mfma_f32_16x16x32_bf16(Bt[n][k], At[m][k], acc[ai][bj][m][n], 0, 0, 0); __builtin_amdgcn_s_setprio(0); } while (0)
#define PG8_WAIT_V(n) asm volatile("s_waitcnt vmcnt(" #n ")" ::: "memory")
#define PG8_WAIT_L(n) asm volatile("s_waitcnt lgkmcnt(" #n ")" ::: "memory")
#define PG8_BAR __builtin_amdgcn_s_barrier()
#define PG8_SCHED __builtin_amdgcn_sched_barrier(0)
    bf16x8 At[4][2], B0[2][2], B1[2][2];
    const char* const Ab = S.a_base();
    unsigned vA00, vA01, vA10, vA11;
    PG8_AOFFS(cur, vA00, vA01, vA10, vA11);
    const char* cB = S.b_ptr(cur);
    PG8_STAGE(PG8_SB(0, 0), cB, voffB[0], voffB[1]); PG8_STAGE(PG8_SB(0, 1), cB + hstep, voffB[0], voffB[1]); PG8_STAGE(PG8_SA(0, 0), Ab, vA00, vA01); PG8_STAGE(PG8_SA(0, 1), Ab, vA10, vA11);
    if (wr == 1) PG8_BAR;
    PG8_WAIT_V(2); PG8_BAR;
    PG8_STAGE(PG8_SB(1, 0), cB + kstep, voffB[0], voffB[1]); PG8_STAGE(PG8_SA(1, 0), Ab + kstep, vA00, vA01); PG8_STAGE(PG8_SB(1, 1), cB + hstep + kstep, voffB[0], voffB[1]);
    PG8_WAIT_V(6); PG8_BAR;
    for (;;) {
        const bool has_next = S.next(ui + 1, nxt);
        unsigned vN00 = vA00, vN01 = vA01, vN10 = vA10, vN11 = vA11; const char* nB = cB;
        if (has_next) { PG8_AOFFS(nxt, vN00, vN01, vN10, vN11); nB = S.b_ptr(nxt); }
        for (int t = 0; t < nt; t += 2) {
            const bool last = (t == nt - 2);
            const char* a1 = Ab + (size_t)(t + 1) * kstep;
            const char* a2 = last ? Ab : Ab + (size_t)(t + 2) * kstep; const char* b2 = last ? nB : cB + (size_t)(t + 2) * kstep;
            const char* a3 = a2 + kstep; const char* b3 = b2 + kstep;
            const unsigned w00 = last ? vN00 : vA00, w01 = last ? vN01 : vA01, w10 = last ? vN10 : vA10, w11 = last ? vN11 : vA11;
            PG8_LDB(B0, 0, 0); PG8_LDB(B1, 0, 1); PG8_SCHED; PG8_LDA(At, 0, 0); PG8_STAGE(PG8_SA(1, 1), a1, vA10, vA11);
            PG8_WAIT_V(8); PG8_WAIT_L(0); PG8_BAR; PG8_MMA(0, 0, At, B0); PG8_MMA(0, 1, At, B1); PG8_BAR; PG8_SCHED;
            PG8_LDA(At, 0, 1); PG8_STAGE(PG8_SB(0, 0), b2, voffB[0], voffB[1]); PG8_STAGE(PG8_SB(0, 1), b2 + hstep, voffB[0], voffB[1]); PG8_STAGE(PG8_SA(0, 0), a2, w00, w01);
            PG8_WAIT_V(8); PG8_WAIT_L(0); PG8_BAR; PG8_MMA(1, 0, At, B0); PG8_MMA(1, 1, At, B1); PG8_BAR; PG8_SCHED;
            PG8_LDB(B0, 1, 0); PG8_LDB(B1, 1, 1); PG8_SCHED; PG8_LDA(At, 1, 0); PG8_STAGE(PG8_SA(0, 1), a2, w10, w11);
            PG8_WAIT_V(8); PG8_WAIT_L(0); PG8_BAR; PG8_MMA(0, 0, At, B0); PG8_MMA(0, 1, At, B1); PG8_BAR; PG8_SCHED;
            PG8_LDA(At, 1, 1); PG8_STAGE(PG8_SB(1, 0), b3, voffB[0], voffB[1]); PG8_STAGE(PG8_SB(1, 1), b3 + hstep, voffB[0], voffB[1]); PG8_STAGE(PG8_SA(1, 0), a3, w00, w01);
            PG8_WAIT_V(8); PG8_WAIT_L(0); PG8_BAR; PG8_MMA(1, 0, At, B0); PG8_MMA(1, 1, At, B1); PG8_BAR; PG8_SCHED;
        }
        if (wr == 0) PG8_BAR;
        { int t2_ = threadIdx.x; asm volatile("" : "+v"(t2_)); const int l2_ = t2_ & 63; E(acc, cur, wr, wc, l2_ & 15, l2_ >> 4); }
        if (!has_next) break;
#pragma unroll
        for (int a = 0; a < 2; ++a)
#pragma unroll
            for (int b = 0; b < 2; ++b)
#pragma unroll
                for (int m = 0; m < 4; ++m)
#pragma unroll
                    for (int n = 0; n < 2; ++n) acc[a][b][m][n] = (f32x4){0.f, 0.f, 0.f, 0.f};
        cur = nxt; vA00 = vN00; vA01 = vN01; vA10 = vN10; vA11 = vN11; cB = nB; ++ui;
        if (wr == 1) PG8_BAR;
    }
    PG8_WAIT_V(0);
    PG8_BAR;
#undef PG8_SA
#undef PG8_AOFFS
#undef PG8_SB
#undef PG8_STAGE
#undef PG8_LDA
#undef PG8_LDB
#undef PG8_MMA
#undef PG8_WAIT_V
#undef PG8_WAIT_L
#undef PG8_BAR
#undef PG8_SCHED
#endif
}
}
using pg8::Unit;
using pg8::Acc;

__device__ __forceinline__ float* resid_row(float* out, float* xc, int tok) {
    const int b = tok / TPB, j = tok - b * TPB;
    return j < CTX ? xc + ((size_t)(b * CTX + j)) * DM : out + ((size_t)(b * SEQ + j - CTX)) * DM;
}
__device__ __forceinline__ int tile_to_pm(int i, bool latent_only) { return latent_only ? (i >> 4) * 17 + 1 + (i & 15) : i; }

__device__ __forceinline__ bool static_order(int i, int G, int c, int nM, int nN, int& pm, int& pn) {
    const int nwg = nM * nN; const long L = (long)i * G + c; if (L >= nwg) return false;
    int wgid = (int)L; { const int q = nwg / 8, r = nwg % 8, xcd = wgid % 8, off = wgid / 8; wgid = (xcd < r ? xcd * (q + 1) : r * (q + 1) + (xcd - r) * q) + off; }
    const int nig = 8 * nN, gid = wgid / nig, fm = gid * 8, gsz = (nM - fm) < 8 ? (nM - fm) : 8;
    pm = fm + ((wgid % nig) % gsz); pn = (wgid % nig) / gsz; return true;
}

struct SchedPlain {
    const char* A; const char* Bt; int K, nM, nN, G, c; bool lat;
    __device__ __forceinline__ bool next(int i, Unit& u) const {
        int pm, pn; if (!static_order(i, G, c, nM, nN, pm, pn)) return false;
        u.pm = tile_to_pm(pm, lat); u.pn = pn; u.e = 0; u.ti = 0; u.nrows = 256; u.row0 = u.pm * 256; return true;
    }
    __device__ __forceinline__ const char* a_base() const { return A; }
    __device__ __forceinline__ unsigned a_off(const Unit& u, int rr) const { return (unsigned)(u.row0 + rr) * (unsigned)(K * 2); }
    __device__ __forceinline__ const char* b_ptr(const Unit& u) const { return Bt + (size_t)u.pn * 256 * K * 2; }
};

struct SchedMerge {
    const char* A0; const char* Bt0; int G, c;
    __device__ __forceinline__ bool next(int i, Unit& u) const {
        const int ti = i / 3, r = i - 3 * ti; int pm, pn; if (!static_order(ti, G, c, 64, 4, pm, pn)) return false;
        u.pm = tile_to_pm(pm, true); u.pn = pn; u.e = r; u.ti = 0; u.nrows = 256; u.row0 = u.pm * 256; return true;
    }
    __device__ __forceinline__ const char* a_base() const { return A0; }
    __device__ __forceinline__ unsigned a_off(const Unit& u, int rr) const { return (unsigned)u.e * (unsigned)(17 * MiB) + (unsigned)(u.row0 + rr) * 1024u; }
    __device__ __forceinline__ const char* b_ptr(const Unit& u) const { return Bt0 + ((size_t)u.e * 1024 * 512 + (size_t)u.pn * 256 * 512) * 2; }
};

struct SchedMoe {
    const char* A;
    const char* Ash;
    const char* Bt; const char* Btsh; const int* list;
    const LAS int* tb;
    int K, nN, G, c, nsh; bool lat, gather; size_t bstride;
    __device__ __forceinline__ bool next(int i, Unit& u) const {
        const int nrt = tb[LC_TBASE + 64], L = i * G + c, tot = (nrt + nsh) * nN;
        if (L >= tot) return false;
        const int rt = L / nN; u.pn = L - rt * nN;
        if (rt < nrt) {
            int e = 0;
#pragma unroll 1
            for (int s = 32; s > 0; s >>= 1) if (e + s < 64 && tb[LC_TBASE + e + s] <= rt) e += s;
            u.e = e; u.ti = rt - tb[LC_TBASE + e]; const int cnt = tb[LC_TCNT + e]; const int rem = cnt - u.ti * 256;
            u.nrows = rem < 256 ? rem : 256; u.row0 = tb[LC_SBASE + e] + u.ti * 256; u.pm = 0;
        } else { u.e = 64; u.ti = rt - nrt; u.pm = tile_to_pm(u.ti, lat); u.nrows = 256; u.row0 = u.pm * 256; }
        return true;
    }
    __device__ __forceinline__ const char* a_base() const { return A; }
    __device__ __forceinline__ unsigned a_off(const Unit& u, int rr) const {
        if (u.e == 64) return (unsigned)(Ash - A) + (unsigned)(u.row0 + rr) * (unsigned)(K * 2);
        if (gather) { const int r2 = rr < u.nrows ? rr : u.nrows - 1; const int tok = list[(size_t)u.e * T + u.ti * 256 + r2]; return (unsigned)tok * (unsigned)(K * 2); }
        return (unsigned)(u.row0 + rr) * (unsigned)(K * 2);
    }
    __device__ __forceinline__ const char* b_ptr(const Unit& u) const { return (u.e == 64 ? Btsh : Bt + (size_t)u.e * bstride) + (size_t)u.pn * 256 * K * 2; }
};

#define EPI_FOR_ROWS  _Pragma("unroll") for (int ai = 0; ai < 2; ++ai) _Pragma("unroll") for (int m = 0; m < 4; ++m)
#define EPI_FOR_COLS  _Pragma("unroll") for (int bj = 0; bj < 2; ++bj) _Pragma("unroll") for (int n = 0; n < 2; ++n)

struct EpiInproj {
    static constexpr bool PERM = false;
    unsigned char* ws; const float* bias; const float* rope;
    __device__ __forceinline__ void operator()(const Acc& acc, const Unit& u, int wr, int wc, int fr, int fq) const {
        const int pn = u.pn; const bool isg = pn >= 14; const int seg = pn >> 1;
        bf16_t* base = (bf16_t*)(ws + (isg ? OV_G : OV_Q + (size_t)seg * 17 * MiB));
        const int ld = isg ? 3072 : 512, coff = isg ? (pn - 14) * 256 : (pn & 1) * 256;
        const bool latent = (u.pm % 17) != 0;
        f32x4 bv[2][2];
        EPI_FOR_COLS bv[bj][n] = *(const f32x4*)(bias + pn * 256 + bj * 128 + wc * 32 + n * 16 + fq * 4);
        EPI_FOR_ROWS {
            const int row = u.row0 + ai * 128 + wr * 64 + m * 16 + fr;
            bf16_t* rp = base + (size_t)row * ld + coff + wc * 32 + fq * 4;
            f32x4 v[2][2];
            EPI_FOR_COLS v[bj][n] = acc[ai][bj][m][n] + bv[bj][n];
            if (seg < 2 && !isg) {
                if (latent) {
                    const int pos = (row % TPB) - CTX; const int pa = (wc & 1) ? (pos & 63) : (pos >> 6);
                    const f32x4 c0 = *(const f32x4*)(rope + (pa * 16 + fq * 4) * 2), c1 = *(const f32x4*)(rope + (pa * 16 + fq * 4) * 2 + 4);
                    const float cs[4] = {c0[0], c0[2], c1[0], c1[2]}, sn[4] = {c0[1], c0[3], c1[1], c1[3]};
#pragma unroll
                    for (int bj = 0; bj < 2; ++bj)
#pragma unroll
                        for (int j = 0; j < 4; ++j) { const float a = v[bj][0][j], b = v[bj][1][j]; v[bj][0][j] = a * cs[j] - b * sn[j]; v[bj][1][j] = b * cs[j] + a * sn[j]; }
                }
                if (seg == 0) { EPI_FOR_COLS v[bj][n] = v[bj][n] * (0.125f * 1.4426950408889634f); }
            }
            EPI_FOR_COLS { u32x2 w; w.x = pk2(v[bj][n][0], v[bj][n][1]); w.y = pk2(v[bj][n][2], v[bj][n][3]); *(u32x2*)(rp + bj * 128 + n * 16) = w; }
        }
    }
};

struct EpiMerge {
    static constexpr bool PERM = true;
    bf16_t* mg; const bf16_t* gate;
    __device__ __forceinline__ void operator()(const Acc& acc, const Unit& u, int wr, int wc, int fr, int fq) const {
        const int r = u.e;
#pragma unroll
        for (int ai = 0; ai < 2; ++ai) {
            const size_t rbase = (size_t)(u.row0 + ai * 128 + wr * 64 + fr); const int col = u.pn * 256 + wc * 32 + fq * 8;
            u32x4 g[4][2], o[4][2];
#pragma unroll
            for (int m = 0; m < 4; ++m)
#pragma unroll
                for (int bj = 0; bj < 2; ++bj) { g[m][bj] = *(const u32x4*)(gate + (rbase + m * 16) * 3072 + r * 1024 + col + bj * 128);
                    if (r > 0) o[m][bj] = *(const u32x4*)(mg + (rbase + m * 16) * DM + col + bj * 128); else o[m][bj] = (u32x4){0u, 0u, 0u, 0u}; }
#pragma unroll
            for (int m = 0; m < 4; ++m)
#pragma unroll
                for (int bj = 0; bj < 2; ++bj) { const u32x4 gg = g[m][bj], oo = o[m][bj]; const f32x4 v0 = acc[ai][bj][m][0], v1 = acc[ai][bj][m][1];
                    u32x4 w; w.x = pk2(v0[0] * sigmoidf_(bflo(gg.x)) + bflo(oo.x), v0[1] * sigmoidf_(bfhi(gg.x)) + bfhi(oo.x)); w.y = pk2(v0[2] * sigmoidf_(bflo(gg.y)) + bflo(oo.y), v0[3] * sigmoidf_(bfhi(gg.y)) + bfhi(oo.y));
                    w.z = pk2(v1[0] * sigmoidf_(bflo(gg.z)) + bflo(oo.z), v1[1] * sigmoidf_(bfhi(gg.z)) + bfhi(oo.z)); w.w = pk2(v1[2] * sigmoidf_(bflo(gg.w)) + bflo(oo.w), v1[3] * sigmoidf_(bfhi(gg.w)) + bfhi(oo.w));
                    *(u32x4*)(mg + (rbase + m * 16) * DM + col + bj * 128) = w; }
        }
    }
};

struct EpiWout {
    static constexpr bool PERM = true;
    float* out; float* xc; const float* modl; bool dry;
    __device__ __forceinline__ void operator()(const Acc& acc, const Unit& u, int wr, int wc, int fr, int fq) const {
        const int b = u.pm / 17; const int bsel = (u.pm % 17) == 0 ? 4 : b;
        const float* g1 = modl + bsel * 6144 + 2048;
        f32x4 gv[2][2];
        EPI_FOR_COLS gv[bj][n] = *(const f32x4*)(g1 + u.pn * 256 + bj * 128 + wc * 32 + fq * 8 + n * 4);
#pragma unroll
        for (int ai = 0; ai < 2; ++ai) {
            bf16_t* rp[4]; u32x4 x[4][2];
#pragma unroll
            for (int m = 0; m < 4; ++m) { rp[m] = (bf16_t*)resid_row(out, xc, u.row0 + ai * 128 + wr * 64 + m * 16 + fr) + u.pn * 256 + wc * 32 + fq * 8;
#pragma unroll
                for (int bj = 0; bj < 2; ++bj) x[m][bj] = *(const u32x4*)(rp[m] + bj * 128); }
#pragma unroll
            for (int m = 0; m < 4; ++m)
#pragma unroll
                for (int bj = 0; bj < 2; ++bj) { const u32x4 xx = x[m][bj]; const f32x4 a0 = acc[ai][bj][m][0] * gv[bj][0], a1 = acc[ai][bj][m][1] * gv[bj][1];
                    u32x4 w; w.x = pk2(bflo(xx.x) * DN_ALPHA + a0[0], bfhi(xx.x) * DN_ALPHA + a0[1]); w.y = pk2(bflo(xx.y) * DN_ALPHA + a0[2], bfhi(xx.y) * DN_ALPHA + a0[3]);
                    w.z = pk2(bflo(xx.z) * DN_ALPHA + a1[0], bfhi(xx.z) * DN_ALPHA + a1[1]); w.w = pk2(bflo(xx.w) * DN_ALPHA + a1[2], bfhi(xx.w) * DN_ALPHA + a1[3]);
                    if (!dry) *(u32x4*)(rp[m] + bj * 128) = w; else asm volatile("" :: "v"(w)); }
        }
    }
};

struct EpiMoe1 {
    static constexpr bool PERM = true;
    bf16_t* act; bf16_t* actsh;
    __device__ __forceinline__ void operator()(const Acc& acc, const Unit& u, int wr, int wc, int fr, int fq) const {
        bf16_t* base = u.e == 64 ? actsh : act;
        EPI_FOR_ROWS {
            const int rl = ai * 128 + wr * 64 + m * 16 + fr;
            if (rl < u.nrows) {
                const f32x4 g0 = acc[ai][0][m][0], g1 = acc[ai][0][m][1], p0 = acc[ai][1][m][0], p1 = acc[ai][1][m][1];
                u32x4 w; w.x = pk2(silu_(g0[0]) * p0[0], silu_(g0[1]) * p0[1]); w.y = pk2(silu_(g0[2]) * p0[2], silu_(g0[3]) * p0[3]);
                w.z = pk2(silu_(g1[0]) * p1[0], silu_(g1[1]) * p1[1]); w.w = pk2(silu_(g1[2]) * p1[2], silu_(g1[3]) * p1[3]);
                *(u32x4*)(base + (size_t)(u.row0 + rl) * 256 + u.pn * 128 + wc * 32 + fq * 8) = w;
            }
        }
    }
};

struct EpiMoe2 {
    static constexpr bool PERM = true;
    unsigned char* ys; bf16_t* sho;
    __device__ __forceinline__ void operator()(const Acc& acc, const Unit& u, int wr, int wc, int fr, int fq) const {
        EPI_FOR_ROWS {
            const int rl = ai * 128 + wr * 64 + m * 16 + fr;
            if (rl < u.nrows) {
                if (u.e == 64) {
                    bf16_t* rp = sho + (size_t)(u.row0 + rl) * DM + u.pn * 256 + wc * 32 + fq * 8;
#pragma unroll
                    for (int bj = 0; bj < 2; ++bj) { const f32x4 v0 = acc[ai][bj][m][0], v1 = acc[ai][bj][m][1];
                        u32x4 w; w.x = pk2(v0[0], v0[1]); w.y = pk2(v0[2], v0[3]); w.z = pk2(v1[0], v1[1]); w.w = pk2(v1[2], v1[3]); *(u32x4*)(rp + bj * 128) = w; }
                } else {
                    unsigned char* rp = ys + (size_t)(u.row0 + rl) * DM + u.pn * 256 + wc * 32 + fq * 8;
#pragma unroll
                    for (int bj = 0; bj < 2; ++bj) { const f32x4 v0 = acc[ai][bj][m][0] * 16.0f, v1 = acc[ai][bj][m][1] * 16.0f;
                        int w0 = 0, w1 = 0;
                        w0 = __builtin_amdgcn_cvt_pk_fp8_f32(v0[0], v0[1], w0, false); w0 = __builtin_amdgcn_cvt_pk_fp8_f32(v0[2], v0[3], w0, true);
                        w1 = __builtin_amdgcn_cvt_pk_fp8_f32(v1[0], v1[1], w1, false); w1 = __builtin_amdgcn_cvt_pk_fp8_f32(v1[2], v1[3], w1, true);
                        *(u32x2*)(rp + bj * 128) = (u32x2){(unsigned)w0, (unsigned)w1}; }
                }
            }
        }
    }
};

struct Frame {
    LAS unsigned char* lds; int tid, lane, wave, G, bid, gw, NGW, vcu;
    unsigned char* ws; float* out;
};

__device__ __forceinline__ void transpose_item(const float* W, int ldw, int k0, int n0, bf16_t* WT, int ldt, int drow0, LAS float* scr, int lane) {
    const int lk = lane >> 4, n4 = (lane & 15) * 4;
#pragma unroll 8
    for (int i = 0; i < 16; ++i) { const int k = 4 * i + lk; const f32x4 v = *(const f32x4*)(W + (size_t)(k0 + k) * ldw + n0 + n4);
        *(LAS f32x4*)(scr + k * 64 + (n4 ^ (((k >> 3) & 7) << 2))) = v; }
    LDS_WAIT(); asm volatile("" ::: "memory");
    const int c = lane & 7;
#pragma unroll
    for (int j = 0; j < 8; ++j) { const int n = (lane >> 3) + 8 * j; const LAS float* sp = scr + (8 * c) * 64 + (n ^ (c << 2));
        u32x4 o; o.x = pk2(sp[0 * 64], sp[1 * 64]); o.y = pk2(sp[2 * 64], sp[3 * 64]); o.z = pk2(sp[4 * 64], sp[5 * 64]); o.w = pk2(sp[6 * 64], sp[7 * 64]);
        *(u32x4*)(WT + (size_t)(drow0 + n) * ldt + k0 + 8 * c) = o; }
    LDS_WAIT(); asm volatile("" ::: "memory");
}
__device__ __forceinline__ void conv_expert_item(const float* wg, const float* wu, const float* wd, bf16_t* t1, bf16_t* t2, int which, int rr, LAS float* scr, int lane) {
    if (which < 2) { const int kb = rr >> 2, nb = rr & 3, n0 = 64 * nb;
        transpose_item(which == 0 ? wg : wu, 256, 64 * kb, n0, t1, 1024, (n0 >> 7) * 256 + (n0 & 127) + which * 128, scr, lane);
    } else { const int kb = rr >> 4, nb = rr & 15; transpose_item(wd, 1024, 64 * kb, 64 * nb, t2, 256, 64 * nb, scr, lane); }
}
__device__ __forceinline__ void conv_moe_layer(const Frame& F, CArgsP a, int l) {
    LAS float* scr = (LAS float*)(F.lds + F.wave * 16384);
    for (int it = F.gw; it < 64 * 3 * 64; it += F.NGW) {
        const int idx = it >> 6, e = idx / 3, which = idx - e * 3, rr = it & 63; const size_t eo = (size_t)(l * 64 + e) * 262144;
        conv_expert_item(a->in[30] + eo, a->in[31] + eo, a->in[32] + eo, (bf16_t*)(F.ws + WS_WM1) + (size_t)e * 524288, (bf16_t*)(F.ws + WS_WM2) + (size_t)e * 262144, which, rr, scr, F.lane);
    }
}

__device__ __forceinline__ void phase_prologue(const Frame& F, CArgsP a) {
    LAS float* scr = (LAS float*)(F.lds + F.wave * 16384);
    constexpr int I_IN = 2 * 1664, I_BR = 6 * 128, I_OUT = 2 * 256, I_SH = 6 * 64;
    for (int it0 = F.gw; it0 < I_IN + I_BR + I_OUT + I_SH; it0 += F.NGW) {
        int it = it0;
        if (it < I_IN) { const int l = it / 1664, r = it - l * 1664, kb = r / 104, nb = r - kb * 104;
            transpose_item(a->in[6] + (size_t)l * 1024 * INC, INC, 64 * kb, 64 * nb, (bf16_t*)(F.ws + WS_WIN) + (size_t)l * INC * 1024, 1024, 64 * nb, scr, F.lane); continue; }
        it -= I_IN;
        if (it < I_BR) { const int idx = it >> 7, rr = it & 127, kb = rr >> 4, nb = rr & 15;
            transpose_item(a->in[24] + (size_t)idx * 512 * 1024, 1024, 64 * kb, 64 * nb, (bf16_t*)(F.ws + WS_WBR) + (size_t)idx * 1024 * 512, 512, 64 * nb, scr, F.lane); continue; }
        it -= I_BR;
        if (it < I_OUT) { const int l = it >> 8, rr = it & 255, kb = rr >> 4, nb = rr & 15;
            transpose_item(a->in[25] + (size_t)l * 1048576, 1024, 64 * kb, 64 * nb, (bf16_t*)(F.ws + WS_WOUT) + (size_t)l * 1048576, 1024, 64 * nb, scr, F.lane); continue; }
        it -= I_OUT;
        { const int idx = it >> 6, l = idx / 3, which = idx - l * 3, rr = it & 63; const size_t lo = (size_t)l * 262144;
          conv_expert_item(a->in[33] + lo, a->in[34] + lo, a->in[35] + lo, (bf16_t*)(F.ws + WS_WSH1) + (size_t)l * 524288, (bf16_t*)(F.ws + WS_WSH2) + (size_t)l * 262144, which, rr, scr, F.lane); }
    }
    conv_moe_layer(F, a, 0);
    { const int gt = F.bid * NTHR + F.tid, NG = F.G * NTHR;
      bf16_t* wl = (bf16_t*)(F.ws + WS_WLRU);
      for (int i = gt; i < 2 * 2 * 2 * 8 * 4096; i += NG) {
          const int ii = i & 63, j = (i >> 6) & 63, cb = (i >> 12) & 7, ax = (i >> 15) & 1, d = (i >> 16) & 1, l = i >> 17;
          const float* src = ax == 0 ? a->in[19] : a->in[21];
          wl[i] = (bf16_t)f2bf(src[(size_t)((l * 2 + d) * 8 + cb) * 4096 + ii * 64 + j]); }
      bf16_t* wrt = (bf16_t*)(F.ws + WS_WRT);
      for (int i = gt; i < 2 * 64 * 1024; i += NG) { const int k = i & 1023, e = (i >> 10) & 63, l = i >> 16; wrt[i] = (bf16_t)f2bf(a->in[28][(size_t)(l * 1024 + k) * 64 + e]); }
      bf16_t* wsg = (bf16_t*)(F.ws + WS_WSG);
      for (int i = gt; i < 2 * 4 * 128 * 128; i += NG) wsg[i] = (bf16_t)f2bf(a->in[15][i]);
      if (F.bid == 0) { float* rope = (float*)(F.ws + WS_ROPE);
          for (int t = F.tid; t < 1024; t += NTHR) { const int p = t >> 4, f = t & 15; const float inv = powf(10000.0f, -(float)f / 16.0f); const float ang = (float)p * inv; rope[2 * t] = cosf(ang); rope[2 * t + 1] = sinf(ang); } }
      if (F.bid == (1 % F.G) && F.wave == 0) { float* lam = (float*)(F.ws + WS_LAM);
#pragma unroll
          for (int l = 0; l < 2; ++l) { const float s1 = wave_sum(a->in[8][l * 64 + F.lane] * a->in[9][l * 64 + F.lane]), s2 = wave_sum(a->in[10][l * 64 + F.lane] * a->in[11][l * 64 + F.lane]);
              const float li = 0.8f - 0.6f * expf(-0.3f * (float)l); if (F.lane == 0) lam[l] = expf(s1) - expf(s2) + li; } }
    }
    __syncthreads();
    LAS float* sl = (LAS float*)(F.lds);
    for (int i = F.tid; i < 5 * 1024; i += NTHR) { const int b = i >> 10, k = i & 1023; const float cv = b < 4 ? a->in[1][b * 1024 + k] : a->in[3][k]; sl[i] = silu_(cv); }
    __syncthreads();
    float* mod = (float*)(F.ws + WS_MOD);
    LAS float* part = (LAS float*)(F.lds + 20480);
    for (int c = F.bid; c < 192; c += F.G) {
        const int l = c / 96, cg = c - l * 96, col = F.tid & 63, ks = F.wave, n = cg * 64 + col;
        const float* w = a->in[4] + ((size_t)l * 1024 + ks * 128) * 6144 + n;
        float acc[5] = {0.f, 0.f, 0.f, 0.f, 0.f};
#pragma unroll 8
        for (int k = 0; k < 128; ++k) { const float wv = w[(size_t)k * 6144];
#pragma unroll
            for (int b = 0; b < 5; ++b) acc[b] += sl[b * 1024 + ks * 128 + k] * wv; }
#pragma unroll
        for (int b = 0; b < 5; ++b) part[(ks * 5 + b) * 64 + col] = acc[b];
        __syncthreads();
        if (F.tid < 320) { const int b = F.tid >> 6; float s = a->in[5][l * 6144 + n];
#pragma unroll
            for (int k8 = 0; k8 < 8; ++k8) s += part[(k8 * 5 + b) * 64 + col];
            mod[(l * 5 + b) * 6144 + n] = s; }
        __syncthreads();
    }
}

__device__ __forceinline__ void row_load(const float* p, int lane, f32x4 (&v)[4]) {
#pragma unroll
    for (int j = 0; j < 4; ++j) v[j] = *(const f32x4*)(p + 4 * lane + 256 * j);
}
__device__ __forceinline__ void row_load_bf16(const float* p, int lane, f32x4 (&v)[4]) {
#pragma unroll
    for (int j = 0; j < 4; ++j) { const u32x2 w = *(const u32x2*)((const bf16_t*)p + 4 * lane + 256 * j); v[j] = (f32x4){bflo(w.x), bfhi(w.x), bflo(w.y), bfhi(w.y)}; }
}
__device__ __forceinline__ void row_store(float* p, int lane, const f32x4 (&v)[4]) {
#pragma unroll
    for (int j = 0; j < 4; ++j) *(f32x4*)(p + 4 * lane + 256 * j) = v[j];
}
__device__ __forceinline__ void row_ln(f32x4 (&v)[4]) {
    float s = 0.f;
#pragma unroll
    for (int j = 0; j < 4; ++j) s += (v[j][0] + v[j][1]) + (v[j][2] + v[j][3]);
    const float mean = wave_sum(s) * (1.f / DM); float q = 0.f;
#pragma unroll
    for (int j = 0; j < 4; ++j) { v[j] = v[j] - mean; q += (v[j][0] * v[j][0] + v[j][1] * v[j][1]) + (v[j][2] * v[j][2] + v[j][3] * v[j][3]); }
    const float rstd = __builtin_amdgcn_rsqf(wave_sum(q) * (1.f / DM) + LN_EPS);
#pragma unroll
    for (int j = 0; j < 4; ++j) v[j] = v[j] * rstd;
}
__device__ __forceinline__ void row_affine(f32x4 (&v)[4], const float* scale1p  , bool plus1, const float* shift, int lane) {
#pragma unroll
    for (int j = 0; j < 4; ++j) { const f32x4 sc = *(const f32x4*)(scale1p + 4 * lane + 256 * j), sh = *(const f32x4*)(shift + 4 * lane + 256 * j);
        v[j] = plus1 ? v[j] * (sc + 1.0f) + sh : v[j] * sc + sh; }
}
__device__ __forceinline__ void row_store_bf16(bf16_t* p, int lane, const f32x4 (&v)[4]) {
#pragma unroll
    for (int j = 0; j < 4; ++j) { u32x2 w; w.x = pk2(v[j][0], v[j][1]); w.y = pk2(v[j][2], v[j][3]); *(u32x2*)(p + 4 * lane + 256 * j) = w; }
}

__device__ __forceinline__ void phase_rows0(const Frame& F, CArgsP a) {
    const float* mod = (const float*)(F.ws + WS_MOD); float* xc = (float*)(F.ws + WS_XC); bf16_t* H = (bf16_t*)(F.ws + WS_H);
    for (int tok = F.gw; tok < T; tok += F.NGW) {
        const int b = tok / TPB, j = tok - b * TPB; const bool isc = j < CTX;
        const float* src = isc ? a->in[2] + (size_t)(b * CTX + j) * DM : a->in[0] + (size_t)(b * SEQ + j - CTX) * DM;
        f32x4 v[4]; row_load(src, F.lane, v);
        row_store_bf16((bf16_t*)resid_row(F.out, xc, tok), F.lane, v);
        row_ln(v);
        const float* mrow = mod + (isc ? 4 : b) * 6144;
        row_affine(v, mrow + 1024, true, mrow, F.lane);
        row_store_bf16(H + (size_t)tok * DM, F.lane, v);
    }
}

__device__ __forceinline__ void sg_item(const Frame& F, CArgsP a, int l, int chunk, int g) {
    LAS bf16_t* vgT = (LAS bf16_t*)F.lds;
    const bf16_t* Sb = (const bf16_t*)(F.ws + OV_S); const bf16_t* Ub = (const bf16_t*)(F.ws + OV_U); bf16_t* OB = (bf16_t*)(F.ws + OV_OB);
    const int tok0 = chunk * 128;
    { const int q = F.tid >> 2, qt = F.tid & 3;
      const bf16_t* sp = Sb + (size_t)(tok0 + q) * 512 + g * 128 + qt * 32;
      float x[32];
#pragma unroll
      for (int i = 0; i < 4; ++i) { const u32x4 w = *(const u32x4*)(sp + 8 * i);
          x[8 * i + 0] = gelu_tanh(bflo(w.x)); x[8 * i + 1] = gelu_tanh(bfhi(w.x)); x[8 * i + 2] = gelu_tanh(bflo(w.y)); x[8 * i + 3] = gelu_tanh(bfhi(w.y)); x[8 * i + 4] = gelu_tanh(bflo(w.z)); x[8 * i + 5] = gelu_tanh(bfhi(w.z)); x[8 * i + 6] = gelu_tanh(bflo(w.w)); x[8 * i + 7] = gelu_tanh(bfhi(w.w)); }
      float s = 0.f;
#pragma unroll
      for (int i = 0; i < 32; ++i) s += x[i];
      s += __shfl_xor(s, 1); s += __shfl_xor(s, 2); const float mean = s * (1.f / 128.f); float qq = 0.f;
#pragma unroll
      for (int i = 0; i < 32; ++i) { x[i] -= mean; qq += x[i] * x[i]; }
      qq += __shfl_xor(qq, 1); qq += __shfl_xor(qq, 2); const float rstd = 1.f / sqrtf(qq * (1.f / 128.f) + LN_EPS);
      const float* lg = a->in[13] + l * 512 + g * 128 + qt * 32; const float* lb = a->in[14] + l * 512 + g * 128 + qt * 32;
#pragma unroll
      for (int i = 0; i < 32; ++i) vgT[(qt * 32 + i) * 136 + q] = (bf16_t)f2bf(x[i] * rstd * lg[i] + lb[i]);
    }
    __syncthreads();
    const int w = F.wave, fr = F.lane & 15, fq = F.lane >> 4;
    bf16x8 af[4];
#pragma unroll
    for (int ks = 0; ks < 4; ++ks) af[ks] = *(const LAS bf16x8*)(vgT + (w * 16 + fr) * 136 + ks * 32 + fq * 8);
    const bf16_t* W = (const bf16_t*)(F.ws + WS_WSG) + (size_t)(l * 4 + g) * 16384;
    const float* bs = a->in[16] + (l * 4 + g) * 128;
#pragma unroll 2
    for (int n = 0; n < 8; ++n) {
        f32x4 d = {0.f, 0.f, 0.f, 0.f};
#pragma unroll
        for (int ks = 0; ks < 4; ++ks) { const bf16x8 bfv = *(const bf16x8*)(W + (n * 16 + fr) * 128 + ks * 32 + fq * 8); d = __builtin_amdgcn_mfma_f32_16x16x32_bf16(af[ks], bfv, d, 0, 0, 0); }
        const int p = n * 16 + fr, c0 = w * 16 + fq * 4; const float bsp = bs[p];
        const size_t off = (size_t)(tok0 + p) * 512 + g * 128 + c0;
        const u32x2 uu = *(const u32x2*)(Ub + off);
        u32x2 o; o.x = pk2(gelu_tanh(bflo(uu.x)) * (d[0] + bsp), gelu_tanh(bfhi(uu.x)) * (d[1] + bsp)); o.y = pk2(gelu_tanh(bflo(uu.y)) * (d[2] + bsp), gelu_tanh(bfhi(uu.y)) * (d[3] + bsp));
        *(u32x2*)(OB + off) = o;
    }
    __syncthreads();
}

template <bool REV>
__device__ __forceinline__ void lru_scan(const f32x4 (&av)[4], const f32x4 (&bv)[4], f32x4 (&hv)[4], int lane, int mode, float hin, float& sumA, float& sumH) {
#define LRU_MI(k) (REV ? 3 - (k) : (k))
    const int fr = lane & 15, fq = lane >> 4, q = REV ? 3 - fq : fq;
    const int s1 = REV ? lane + 16 : lane - 16, s2 = REV ? lane + 32 : lane - 32, st = REV ? fr : 48 + fr;
    float Ea[4], Eh[4], Ta[4], Th[4];
#pragma unroll
    for (int m = 0; m < 4; ++m) {
        float A = 1.f, H = 0.f;
#pragma unroll
        for (int rk = 0; rk < 4; ++rk) { const int r = LRU_MI(rk); H = av[m][r] * H + bv[m][r]; A *= av[m][r]; }
        float pa = __shfl(A, s1), ph = __shfl(H, s1); if (q >= 1) { H = A * ph + H; A *= pa; }
        pa = __shfl(A, s2); ph = __shfl(H, s2); if (q >= 2) { H = A * ph + H; A *= pa; }
        float ea = __shfl(A, s1), eh = __shfl(H, s1); if (q == 0) { ea = 1.f; eh = 0.f; }
        Ea[m] = ea; Eh[m] = eh; Ta[m] = __shfl(A, st); Th[m] = __shfl(H, st);
    }
    if (mode == 0) {
        float A = 1.f, H = 0.f;
#pragma unroll
        for (int mk = 0; mk < 4; ++mk) { const int m = LRU_MI(mk); H = Ta[m] * H + Th[m]; A *= Ta[m]; }
        sumA = A; sumH = H;
    } else {
        float S = hin;
#pragma unroll
        for (int mk = 0; mk < 4; ++mk) { const int m = LRU_MI(mk); float h = Ea[m] * S + Eh[m];
#pragma unroll
            for (int rk = 0; rk < 4; ++rk) { const int r = LRU_MI(rk); h = av[m][r] * h + bv[m][r]; hv[m][r] = h; }
            S = Ta[m] * S + Th[m]; }
    }
#undef LRU_MI
}
struct LruConst { f32x4 cw[4][2]; f32x4 cbias[2]; bf16x8 wa0, wa1, wx0, wx1; float ba, bx, sp; };
struct LruIn { u32x4 x[4]; u32x4 y; float hin; };
__device__ __forceinline__ void lru_load_const(const Frame& F, CArgsP a, int l, int cb, LruConst& c) {
    const int lane = F.lane, fr = lane & 15, fq = lane >> 4, d = F.wave >> 2, nt = F.wave & 3, ch0 = cb * 64, c8 = (F.tid & 7) * 8;
    const bf16_t* Wa = (const bf16_t*)(F.ws + WS_WLRU) + (size_t)((l * 4 + d * 2) * 8 + cb) * 4096 + (nt * 16 + fr) * 64 + fq * 8;
    c.wa0 = *(const bf16x8*)(Wa); c.wa1 = *(const bf16x8*)(Wa + 32); c.wx0 = *(const bf16x8*)(Wa + 8 * 4096); c.wx1 = *(const bf16x8*)(Wa + 8 * 4096 + 32);
    const int pidx = (l * 2 + d) * 512 + ch0 + nt * 16 + fr;
    c.ba = a->in[20][pidx]; c.bx = a->in[22][pidx]; c.sp = log1pf(expf(-a->in[23][pidx]));
#pragma unroll
    for (int jj = 0; jj < 4; ++jj) { c.cw[jj][0] = *(const f32x4*)(a->in[17] + l * 2048 + jj * 512 + ch0 + c8); c.cw[jj][1] = *(const f32x4*)(a->in[17] + l * 2048 + jj * 512 + ch0 + c8 + 4); }
    c.cbias[0] = *(const f32x4*)(a->in[18] + l * 512 + ch0 + c8); c.cbias[1] = *(const f32x4*)(a->in[18] + l * 512 + ch0 + c8 + 4);
}
__device__ __forceinline__ void lru_load_in(const Frame& F, int b, int chunk, int cb, int mode, LruIn& in) {
    const bf16_t* Xb = (const bf16_t*)(F.ws + OV_X); const bf16_t* Yb = (const bf16_t*)(F.ws + OV_Y);
    const int ch0 = cb * 64, ct = F.tid >> 3, c8 = (F.tid & 7) * 8, d = F.wave >> 2, ch = (F.wave & 3) * 16 + (F.lane & 15);
    const int seg_lo = chunk < 4 ? 0 : 256, seg_hi = chunk < 4 ? 256 : TPB, j0 = chunk * 64;
#pragma unroll
    for (int jj = 0; jj < 4; ++jj) { const int j = j0 + ct + jj - 2; in.x[jj] = (u32x4){0u, 0u, 0u, 0u}; if (j >= seg_lo && j < seg_hi) in.x[jj] = *(const u32x4*)(Xb + (size_t)(b * TPB + j) * 512 + ch0 + c8); }
    in.y = (u32x4){0u, 0u, 0u, 0u}; in.hin = 0.f;
    if (mode == 1) { in.y = *(const u32x4*)(Yb + (size_t)(b * TPB + j0 + ct) * 512 + ch0 + c8); in.hin = ((const float*)(F.ws + WS_HIN))[(size_t)((b * 2 + d) * 68 + chunk) * 512 + ch0 + ch]; }
}
__device__ __forceinline__ void lru_compute(const Frame& F, const LruConst& c, const LruIn& in, int b, int chunk, int cb, int mode) {
    LAS float* xs = (LAS float*)F.lds;
    LAS bf16_t* xsb = (LAS bf16_t*)(F.lds + 16384);
    LAS float* hx = (LAS float*)(F.lds + 25600);
    bf16_t* OC = (bf16_t*)(F.ws + OV_OC);
    const int tok0 = b * TPB + chunk * 64, ch0 = cb * 64;
    const int lane = F.lane, fr = lane & 15, fq = lane >> 4, d = F.wave >> 2, nt = F.wave & 3, ch = nt * 16 + fr;
    const int ct = F.tid >> 3, c8 = (F.tid & 7) * 8;
    {
      f32x4 a0 = c.cbias[0], a1 = c.cbias[1];
#pragma unroll
      for (int jj = 0; jj < 4; ++jj) { const u32x4 w = in.x[jj];
          a0 += c.cw[jj][0] * (f32x4){bflo(w.x), bfhi(w.x), bflo(w.y), bfhi(w.y)}; a1 += c.cw[jj][1] * (f32x4){bflo(w.z), bfhi(w.z), bflo(w.w), bfhi(w.w)}; }
      *(LAS f32x4*)(xs + ct * 64 + c8) = a0; *(LAS f32x4*)(xs + ct * 64 + c8 + 4) = a1;
      u32x4 pw; pw.x = pk2(a0[0], a0[1]); pw.y = pk2(a0[2], a0[3]); pw.z = pk2(a1[0], a1[1]); pw.w = pk2(a1[2], a1[3]);
      *(LAS u32x4*)(xsb + ct * 72 + c8) = pw; }
    __syncthreads();
    f32x4 av[4], bv[4], hv[4];
#pragma unroll
    for (int m = 0; m < 4; ++m) {
        const bf16x8 a0 = *(const LAS bf16x8*)(xsb + (m * 16 + fr) * 72 + fq * 8), a1 = *(const LAS bf16x8*)(xsb + (m * 16 + fr) * 72 + 32 + fq * 8);
        f32x4 da = {0.f, 0.f, 0.f, 0.f}, dx = {0.f, 0.f, 0.f, 0.f};
        da = __builtin_amdgcn_mfma_f32_16x16x32_bf16(a0, c.wa0, da, 0, 0, 0); da = __builtin_amdgcn_mfma_f32_16x16x32_bf16(a1, c.wa1, da, 0, 0, 0);
        dx = __builtin_amdgcn_mfma_f32_16x16x32_bf16(a0, c.wx0, dx, 0, 0, 0); dx = __builtin_amdgcn_mfma_f32_16x16x32_bf16(a1, c.wx1, dx, 0, 0, 0);
#pragma unroll
        for (int r = 0; r < 4; ++r) { const float rg = sigmoidf_(da[r] + c.ba), ig = sigmoidf_(dx[r] + c.bx); const float la = -8.0f * rg * c.sp;
            const float e1 = expm1_fast(la);
            av[m][r] = 1.0f + e1; bv[m][r] = __builtin_amdgcn_sqrtf(-e1 * (2.0f + e1)) * (ig * xs[(m * 16 + fq * 4 + r) * 64 + ch]); hv[m][r] = 0.f; }
    }
    float sumA = 1.f, sumH = 0.f;
    if (d == 0) lru_scan<false>(av, bv, hv, lane, mode, in.hin, sumA, sumH); else lru_scan<true>(av, bv, hv, lane, mode, in.hin, sumA, sumH);
    if (mode == 0) {
        if (fq == 0) { float* sum = (float*)(F.ws + WS_SUM) + ((size_t)((b * 2 + d) * 68 + chunk) * 512 + ch0 + ch) * 2; *(float2*)sum = make_float2(sumA, sumH); }
        __syncthreads();
        return;
    }
#pragma unroll
    for (int m = 0; m < 4; ++m)
#pragma unroll
        for (int r = 0; r < 4; ++r) hx[d * 4096 + (m * 16 + fq * 4 + r) * 64 + ch] = hv[m][r];
    __syncthreads();
    { const u32x4 yv = in.y;
      const f32x4 f0 = *(const LAS f32x4*)(hx + ct * 64 + c8), f1 = *(const LAS f32x4*)(hx + ct * 64 + c8 + 4), g0 = *(const LAS f32x4*)(hx + 4096 + ct * 64 + c8), g1 = *(const LAS f32x4*)(hx + 4096 + ct * 64 + c8 + 4);
      u32x4 o; o.x = pk2(gelu_tanh(bflo(yv.x)) * (f0[0] + g0[0]), gelu_tanh(bfhi(yv.x)) * (f0[1] + g0[1])); o.y = pk2(gelu_tanh(bflo(yv.y)) * (f0[2] + g0[2]), gelu_tanh(bfhi(yv.y)) * (f0[3] + g0[3]));
      o.z = pk2(gelu_tanh(bflo(yv.z)) * (f1[0] + g1[0]), gelu_tanh(bfhi(yv.z)) * (f1[1] + g1[1])); o.w = pk2(gelu_tanh(bflo(yv.w)) * (f1[2] + g1[2]), gelu_tanh(bfhi(yv.w)) * (f1[3] + g1[3]));
      *(u32x4*)(OC + (size_t)(tok0 + ct) * 512 + ch0 + c8) = o; }
}
__device__ __forceinline__ void lru_phase(const Frame& F, CArgsP a, int l, int mode, bool skip_ctx) {
    constexpr int NIT = 4 * 68 * 8;
    int it = F.bid;
    while (it < NIT && skip_ctx && ((it >> 3) % 68) < 4) it += F.G;
    if (it >= NIT) return;
    LruConst c; LruIn cur, nxt;
    int cb = it & 7; lru_load_const(F, a, l, cb, c);
    lru_load_in(F, (it >> 3) / 68, (it >> 3) % 68, cb, mode, cur);
    for (;;) {
        int nit = it + F.G;
        while (nit < NIT && skip_ctx && ((nit >> 3) % 68) < 4) nit += F.G;
        const bool has = nit < NIT;
        if (has) lru_load_in(F, (nit >> 3) / 68, (nit >> 3) % 68, nit & 7, mode, nxt);
        lru_compute(F, c, cur, (it >> 3) / 68, (it >> 3) % 68, cb, mode);
        if (!has) break;
        if ((nit & 7) != cb) { cb = nit & 7; lru_load_const(F, a, l, cb, c); }
        it = nit; cur = nxt;
    }
}

__device__ __forceinline__ void phase_carry(const Frame& F) {
    const int gt = F.bid * NTHR + F.tid; if (gt >= 4 * 2 * 512) return;
    const int c = gt & 511, d = (gt >> 9) & 1, b = gt >> 10;
    const float* sum = (const float*)(F.ws + WS_SUM) + (size_t)((b * 2 + d) * 68) * 1024 + c * 2;
    float* hin = (float*)(F.ws + WS_HIN) + (size_t)((b * 2 + d) * 68) * 512 + c;
    float h = 0.f;
#pragma unroll 1
    for (int g0 = 0; g0 < 68; g0 += 17) {
        float A[17], Hh[17];
#pragma unroll
        for (int i = 0; i < 17; ++i) { const int o = g0 + i; const int ck = d == 0 ? o : (o < 4 ? 3 - o : 71 - o); const float2 v = *(const float2*)(sum + (size_t)ck * 1024); A[i] = v.x; Hh[i] = v.y; }
#pragma unroll
        for (int i = 0; i < 17; ++i) { const int o = g0 + i; const int ck = d == 0 ? o : (o < 4 ? 3 - o : 71 - o); hin[(size_t)ck * 512] = h; h = A[i] * h + Hh[i]; }
    }
}

constexpr int AT_KST = 272, AT_VST = 320;
constexpr int AT_KOFF = 0, AT_VOFF = 2 * 64 * AT_KST, AT_XOFF = AT_VOFF + 2 * 64 * AT_VST;
#define AT_SBAR() __builtin_amdgcn_sched_barrier(0)
struct AttnState { f32x16 o[4]; f32x16 negm; bf16x8 pfp[4]; float lrun; };
#define AT_PIN1(x) asm volatile("" : "+v"(x))
__device__ __forceinline__ float at_max3(float a, float b, float c) { float r; asm("v_max3_f32 %0, %1, %2, %3" : "=v"(r) : "v"(a), "v"(b), "v"(c)); return r; }
__device__ __forceinline__ bf16x8 at_vfrag(const LAS unsigned char* vp) {
    const s16x4 lo = __builtin_bit_cast(s16x4, __builtin_amdgcn_ds_read_tr16_b64_v4i16((LAS s16x4*)(vp)));
    const s16x4 hh = __builtin_bit_cast(s16x4, __builtin_amdgcn_ds_read_tr16_b64_v4i16((LAS s16x4*)(vp + 8 * AT_VST)));
    return (bf16x8){lo[0], lo[1], lo[2], lo[3], hh[0], hh[1], hh[2], hh[3]};
}
__device__ __forceinline__ float attn_stage1(const AttnState& st, const f32x16& p0, const f32x16& p1, f32x16& n0, f32x16& n1, const LAS unsigned char* ql, const LAS unsigned char* kf) {
    float mx = at_max3(p0[0], p0[1], at_max3(p1[0], p1[1], p1[1]));
    bf16x8 a0 = *(const LAS bf16x8*)(kf), a1 = *(const LAS bf16x8*)(kf + 32 * AT_KST), q = *(const LAS bf16x8*)(ql);
    AT_SBAR();
#pragma unroll
    for (int ks = 0; ks < 4; ++ks) {
        bf16x8 b0 = a0, b1 = a1, qn = q;
        if (ks < 3) { b0 = *(const LAS bf16x8*)(kf + (ks + 1) * 32); b1 = *(const LAS bf16x8*)(kf + 32 * AT_KST + (ks + 1) * 32); qn = *(const LAS bf16x8*)(ql + (ks + 1) * 1024); }
        if (ks == 0) n0 = __builtin_amdgcn_mfma_f32_32x32x16_bf16(a0, q, st.negm, 0, 0, 0);
        else n0 = __builtin_amdgcn_mfma_f32_32x32x16_bf16(a0, q, n0, 0, 0, 0);
        mx = at_max3(at_max3(mx, p0[4 * ks + 2], p0[4 * ks + 3]), p1[4 * ks + 2], p1[4 * ks + 3]); AT_PIN1(mx); AT_SBAR();
        if (ks == 0) n1 = __builtin_amdgcn_mfma_f32_32x32x16_bf16(a1, q, st.negm, 0, 0, 0);
        else n1 = __builtin_amdgcn_mfma_f32_32x32x16_bf16(a1, q, n1, 0, 0, 0);
        if (ks < 3) { mx = at_max3(at_max3(mx, p0[4 * ks + 4], p0[4 * ks + 5]), p1[4 * ks + 4], p1[4 * ks + 5]); AT_PIN1(mx); } AT_SBAR();
        a0 = b0; a1 = b1; q = qn;
    }
    return mx;
}
template <bool FIRST>
__device__ __forceinline__ void attn_stage2(AttnState& st, f32x16& p0, f32x16& p1, f32x16& n0, f32x16& n1, float mx, const LAS unsigned char* vf) {
    constexpr float THR = 8.0f;
    bf16x8 vcur, vnx; if (!FIRST) { vcur = at_vfrag(vf); vnx = at_vfrag(vf + 64); }
    float tm; { auto rr = __builtin_amdgcn_permlane32_swap(__float_as_uint(mx), __float_as_uint(mx), false, false); tm = fmaxf(__uint_as_float(rr[0]), __uint_as_float(rr[1])); }
    if (FIRST || __any(tm > THR)) {
        const float dl = FIRST ? tm : fmaxf(tm, 0.f);
#pragma unroll
        for (int r = 0; r < 16; ++r) { p0[r] -= dl; p1[r] -= dl; n0[r] -= dl; n1[r] -= dl; st.negm[r] -= dl; }
        if (!FIRST) {
            const float al = __builtin_amdgcn_exp2f(-dl);
#pragma unroll
            for (int db = 0; db < 4; ++db)
#pragma unroll
                for (int r = 0; r < 16; ++r) st.o[db][r] *= al;
#pragma unroll
            for (int kk = 0; kk < 4; ++kk) { u32x4 w = __builtin_bit_cast(u32x4, st.pfp[kk]);
                w.x = pk2(bflo(w.x) * al, bfhi(w.x) * al); w.y = pk2(bflo(w.y) * al, bfhi(w.y) * al); w.z = pk2(bflo(w.z) * al, bfhi(w.z) * al); w.w = pk2(bflo(w.w) * al, bfhi(w.w) * al);
                st.pfp[kk] = __builtin_bit_cast(bf16x8, w); }
            st.lrun *= al;
        }
    }
    float ls = 0.f;
    AT_SBAR();
#pragma unroll
    for (int kk = 0; kk < 4; ++kk) {
        unsigned pw0 = 0, pw1 = 0, pw2 = 0, pw3 = 0;
#pragma unroll
        for (int db = 0; db < 4; ++db) {
            const int g = kk * 4 + db;
            if (!FIRST) {
                bf16x8 vn2 = vnx;
                if (g < 14) { const int g2 = g + 2; vn2 = at_vfrag(vf + ((g2 >> 2) * 16) * AT_VST + (g2 & 3) * 64); }
                st.o[db] = __builtin_amdgcn_mfma_f32_32x32x16_bf16(vcur, st.pfp[kk], st.o[db], 0, 0, 0);
                vcur = vnx; vnx = vn2;
            }
            const float x0 = g < 8 ? p0[2 * g] : p1[2 * g - 16], x1 = g < 8 ? p0[2 * g + 1] : p1[2 * g - 15];
            const float e0 = __builtin_amdgcn_exp2f(x0), e1 = __builtin_amdgcn_exp2f(x1);
            ls += e0 + e1; unsigned w = pk2(e0, e1); AT_PIN1(ls); AT_PIN1(w);
            if (db == 0) pw0 = w; else if (db == 1) pw1 = w; else if (db == 2) pw2 = w; else pw3 = w;
            AT_SBAR();
        }
        st.pfp[kk] = __builtin_bit_cast(bf16x8, (u32x4){pw0, pw1, pw2, pw3});
    }
    st.lrun += ls;
}
__device__ __forceinline__ void attn_unit(const Frame& F, int tokq0, int tokk0, int ntiles, int h, float lam, const float* gain, float oscale) {
    const bf16_t* Q = (const bf16_t*)(F.ws + OV_Q); const char* Kg = (const char*)(F.ws + OV_K); const char* Vg = (const char*)(F.ws + OV_V); bf16_t* OA = (bf16_t*)(F.ws + OV_OA);
    const int lane = F.lane, r32 = lane & 31, hi = lane >> 5, rb = F.wave >> 1, c = F.wave & 1;
    LAS unsigned char* ql = F.lds + AT_XOFF + F.wave * 4096 + lane * 16;
    { const bf16_t* qp = Q + (size_t)(tokq0 + rb * 32 + r32) * 512 + h * 128 + c * 64 + hi * 8;
#pragma unroll
      for (int ks = 0; ks < 4; ++ks) *(LAS bf16x8*)(ql + ks * 1024) = *(const bf16x8*)(qp + ks * 16); }
    const int srow0 = F.tid >> 4, sch = F.tid & 15;
    const unsigned goff = (unsigned)(((tokk0 + srow0) * 512 + h * 128 + sch * 8) * 2);
    LAS unsigned char* kl = F.lds + AT_KOFF + srow0 * AT_KST + sch * 16;
    LAS unsigned char* vl = F.lds + AT_VOFF + srow0 * AT_VST + sch * 16;
    const LAS unsigned char* kfb = F.lds + AT_KOFF + r32 * AT_KST + (c * 64 + hi * 8) * 2;
    const LAS unsigned char* vfb = F.lds + AT_VOFF + (4 * hi + ((lane & 15) >> 2)) * AT_VST + (((lane >> 4) & 1) * 16 + (lane & 3) * 4) * 2;
    {
      const u32x4 k0 = *(const u32x4*)(Kg + goff), k1 = *(const u32x4*)(Kg + goff + 32 * 1024), k2 = *(const u32x4*)(Kg + goff + 64 * 1024), k3 = *(const u32x4*)(Kg + goff + 96 * 1024);
      *(LAS u32x4*)(kl) = k0; *(LAS u32x4*)(kl + 32 * AT_KST) = k1; *(LAS u32x4*)(kl + 64 * AT_KST) = k2; *(LAS u32x4*)(kl + 96 * AT_KST) = k3; }
    __syncthreads();
    AttnState st; st.lrun = 0.f;
#pragma unroll
    for (int r = 0; r < 16; ++r) st.negm[r] = 0.f;
#pragma unroll
    for (int db = 0; db < 4; ++db)
#pragma unroll
        for (int r = 0; r < 16; ++r) st.o[db][r] = 0.f;
    f32x16 pa0, pa1, pb0, pb1;
#pragma unroll
    for (int r = 0; r < 16; ++r) { pa0[r] = 0.f; pa1[r] = 0.f; }
#pragma unroll
    for (int ks = 0; ks < 4; ++ks) {
        const bf16x8 a0 = *(const LAS bf16x8*)(kfb + ks * 32), a1 = *(const LAS bf16x8*)(kfb + 32 * AT_KST + ks * 32);
        const bf16x8 q = *(const LAS bf16x8*)(ql + ks * 1024);
        pa0 = __builtin_amdgcn_mfma_f32_32x32x16_bf16(a0, q, pa0, 0, 0, 0); pa1 = __builtin_amdgcn_mfma_f32_32x32x16_bf16(a1, q, pa1, 0, 0, 0);
    }
    asm volatile("s_nop 15\n\ts_nop 7" : "+v"(pa0), "+v"(pa1));
    u32x4 sv0 = *(const u32x4*)(Vg + goff), sv1 = *(const u32x4*)(Vg + goff + 32 * 1024);
#define AT_ITER(I, FIRSTF, PC0, PC1, PN0, PN1) do { \
        const int i_ = (I); const bool ldk_ = i_ + 2 < ntiles; const int sl_ = i_ & 1; \
        const float mx_ = attn_stage1(st, PC0, PC1, PN0, PN1, ql, kfb + ((i_ + 1) & 1) * (64 * AT_KST)); \
        *(LAS u32x4*)(vl + sl_ * (64 * AT_VST)) = sv0; *(LAS u32x4*)(vl + sl_ * (64 * AT_VST) + 32 * AT_VST) = sv1; \
        u32x4 sk0_, sk1_; if (ldk_) { const unsigned go_ = goff + (unsigned)(i_ + 2) * 65536u; sk0_ = *(const u32x4*)(Kg + go_); sk1_ = *(const u32x4*)(Kg + go_ + 32 * 1024); } \
        attn_stage2<FIRSTF>(st, PC0, PC1, PN0, PN1, mx_, vfb + ((i_ + 1) & 1) * (64 * AT_VST)); \
        if (ldk_) { *(LAS u32x4*)(kl + sl_ * (64 * AT_KST)) = sk0_; *(LAS u32x4*)(kl + sl_ * (64 * AT_KST) + 32 * AT_KST) = sk1_; } \
        if (i_ + 1 < ntiles) { const unsigned gv_ = goff + (unsigned)(i_ + 1) * 65536u; sv0 = *(const u32x4*)(Vg + gv_); sv1 = *(const u32x4*)(Vg + gv_ + 32 * 1024); } \
        __syncthreads(); } while (0)
    AT_ITER(0, true, pa0, pa1, pb0, pb1);
    AT_ITER(1, false, pb0, pb1, pa0, pa1);
#pragma unroll 1
    for (int i = 2; i < ntiles; i += 2) {
        AT_ITER(i, false, pa0, pa1, pb0, pb1);
        AT_ITER(i + 1, false, pb0, pb1, pa0, pa1);
    }
#undef AT_ITER
    {
      const LAS unsigned char* vf = vfb + ((ntiles - 1) & 1) * (64 * AT_VST);
#pragma unroll
      for (int db = 0; db < 4; ++db)
#pragma unroll
          for (int kk = 0; kk < 4; ++kk) {
              const LAS unsigned char* vp = vf + (kk * 16) * AT_VST + db * 64;
              const s16x4 lo = __builtin_bit_cast(s16x4, __builtin_amdgcn_ds_read_tr16_b64_v4i16((LAS s16x4*)(vp)));
              const s16x4 hh = __builtin_bit_cast(s16x4, __builtin_amdgcn_ds_read_tr16_b64_v4i16((LAS s16x4*)(vp + 8 * AT_VST)));
              const bf16x8 vfr = {lo[0], lo[1], lo[2], lo[3], hh[0], hh[1], hh[2], hh[3]};
              st.o[db] = __builtin_amdgcn_mfma_f32_32x32x16_bf16(vfr, st.pfp[kk], st.o[db], 0, 0, 0);
          } }
    float lrun = st.lrun; lrun += __shfl_xor(lrun, 32);
    const float il = 1.f / lrun;
    LAS float* ex = (LAS float*)(F.lds + AT_XOFF) + rb * 4096;
    if (c == 1) {
#pragma unroll
        for (int db = 0; db < 4; ++db)
#pragma unroll
            for (int r = 0; r < 16; ++r) ex[(db * 16 + r) * 64 + lane] = st.o[db][r] * il;
    }
    __syncthreads();
    if (c == 0) {
        float ss = 0.f;
#pragma unroll
        for (int db = 0; db < 4; ++db)
#pragma unroll
            for (int r = 0; r < 16; ++r) { const float dv = st.o[db][r] * il - lam * ex[(db * 16 + r) * 64 + lane]; st.o[db][r] = dv; ss += dv * dv; }
        ss += __shfl_xor(ss, 32);
        const float rinv = oscale / sqrtf(ss * (1.f / 128.f) + RMS_EPS);
        bf16_t* op = OA + (size_t)(tokq0 + rb * 32 + r32) * 512 + h * 128;
#pragma unroll
        for (int db = 0; db < 4; ++db)
#pragma unroll
            for (int r4 = 0; r4 < 4; ++r4) { const int dv0 = db * 32 + 8 * r4 + 4 * hi; const f32x4 gv = *(const f32x4*)(gain + dv0);
                u32x2 w; w.x = pk2(st.o[db][4 * r4] * rinv * gv[0], st.o[db][4 * r4 + 1] * rinv * gv[1]); w.y = pk2(st.o[db][4 * r4 + 2] * rinv * gv[2], st.o[db][4 * r4 + 3] * rinv * gv[3]);
                *(u32x2*)(op + dv0) = w; }
    }
    __syncthreads();
}

__device__ __forceinline__ void phase_attn(const Frame& F, CArgsP a, int l) {
    const float lam = ((const float*)(F.ws + WS_LAM))[l]; const float li = 0.8f - 0.6f * expf(-0.3f * (float)l);
    for (int dd = 0; dd < NDUP(6); ++dd) lru_phase(F, a, l, 1, l == 1);
    __syncthreads();
    const int nlat = 4 * 4 * 32, nctx = (l == 0) ? 4 * 4 * 2 : 0;
    for (int dd = 0; dd < NDUP(7); ++dd)
    for (int it = F.vcu; it < nlat + nctx; it += F.G) {
        int b, h, qb, tq0, nt;
        if (it < nlat) { qb = it & 31; h = (it >> 5) & 3; b = it >> 7; tq0 = b * TPB + CTX + qb * 128; nt = 68; }
        else { const int i2 = it - nlat; qb = i2 & 1; h = (i2 >> 1) & 3; b = i2 >> 3; tq0 = b * TPB + qb * 128; nt = 4; }
        attn_unit(F, tq0, b * TPB, nt, h, lam, a->in[12] + (l * 4 + h) * 128, 1.0f - li);
    }
}

__device__ __forceinline__ void mini_tile(const bf16_t* A, int lda, const bf16_t* Bt, int K, int lane, int wave, f32x4 (&acc)[2]) {
    const int fr = lane & 15, fq = lane >> 4;
    const bf16_t* ap = A + (size_t)((wave >> 1) * 16 + fr) * lda + fq * 8;
    const bf16_t* bp0 = Bt + (size_t)((wave & 1) * 32 + fr) * K + fq * 8; const bf16_t* bp1 = bp0 + (size_t)16 * K;
    acc[0] = (f32x4){0.f, 0.f, 0.f, 0.f}; acc[1] = (f32x4){0.f, 0.f, 0.f, 0.f};
#pragma unroll 8
    for (int k = 0; k < K; k += 32) {
        const bf16x8 av = *(const bf16x8*)(ap + k), b0 = *(const bf16x8*)(bp0 + k), b1 = *(const bf16x8*)(bp1 + k);
        acc[0] = __builtin_amdgcn_mfma_f32_16x16x32_bf16(b0, av, acc[0], 0, 0, 0); acc[1] = __builtin_amdgcn_mfma_f32_16x16x32_bf16(b1, av, acc[1], 0, 0, 0);
    }
}
__device__ __forceinline__ void mini_merge_ctx(const Frame& F, int l) {
    const int fr = F.lane & 15, fq = F.lane >> 4;
    for (int t = F.bid; t < 256; t += F.G) {
        const int rb = t >> 4, cbk = t & 15, cr = rb * 64, tok0 = (cr >> 8) * TPB + (cr & 255), col0 = cbk * 64;
        const int row = tok0 + (F.wave >> 1) * 16 + fr, colw = col0 + (F.wave & 1) * 32 + fq * 4;
        f32x4 mg[2] = {{0.f, 0.f, 0.f, 0.f}, {0.f, 0.f, 0.f, 0.f}};
#pragma unroll 1
        for (int r = 0; r < 3; ++r) {
            f32x4 acc[2];
            mini_tile((const bf16_t*)(F.ws + OV_OA + (size_t)r * 17 * MiB) + (size_t)tok0 * 512, 512, (const bf16_t*)(F.ws + WS_WBR) + (size_t)(l * 3 + r) * 1024 * 512 + (size_t)col0 * 512, 512, F.lane, F.wave, acc);
#pragma unroll
            for (int n = 0; n < 2; ++n) { const u32x2 g = *(const u32x2*)((const bf16_t*)(F.ws + OV_G) + (size_t)row * 3072 + r * 1024 + colw + n * 16);
                mg[n][0] += sigmoidf_(bflo(g.x)) * acc[n][0]; mg[n][1] += sigmoidf_(bfhi(g.x)) * acc[n][1]; mg[n][2] += sigmoidf_(bflo(g.y)) * acc[n][2]; mg[n][3] += sigmoidf_(bfhi(g.y)) * acc[n][3]; }
        }
#pragma unroll
        for (int n = 0; n < 2; ++n) { u32x2 w; w.x = pk2(mg[n][0], mg[n][1]); w.y = pk2(mg[n][2], mg[n][3]); *(u32x2*)((bf16_t*)(F.ws + OV_MG) + (size_t)row * DM + colw + n * 16) = w; }
    }
}
__device__ __forceinline__ void mini_wout_ctx(const Frame& F, int l) {
    const int fr = F.lane & 15, fq = F.lane >> 4;
    const float* g1 = (const float*)(F.ws + WS_MOD) + (l * 5 + 4) * 6144 + 2048;
    for (int t = F.bid; t < 256; t += F.G) {
        const int rb = t >> 4, cbk = t & 15, cr = rb * 64, tok0 = (cr >> 8) * TPB + (cr & 255), col0 = cbk * 64;
        const int crow = cr + (F.wave >> 1) * 16 + fr, colw = col0 + (F.wave & 1) * 32 + fq * 4;
        f32x4 acc[2];
        mini_tile((const bf16_t*)(F.ws + OV_MG) + (size_t)tok0 * DM, DM, (const bf16_t*)(F.ws + WS_WOUT) + (size_t)l * 1048576 + (size_t)col0 * 1024, 1024, F.lane, F.wave, acc);
#pragma unroll
        for (int n = 0; n < 2; ++n) { u32x2* p = (u32x2*)((bf16_t*)((float*)(F.ws + WS_XC) + (size_t)crow * DM) + colw + n * 16); const f32x4 gv = *(const f32x4*)(g1 + colw + n * 16); const u32x2 x = *p;
            u32x2 w; w.x = pk2(bflo(x.x) * DN_ALPHA + gv[0] * acc[n][0], bfhi(x.x) * DN_ALPHA + gv[1] * acc[n][1]); w.y = pk2(bflo(x.y) * DN_ALPHA + gv[2] * acc[n][2], bfhi(x.y) * DN_ALPHA + gv[3] * acc[n][3]); *p = w; }
    }
}

constexpr int RT_AST = 1032;
__device__ __forceinline__ void phase_router(const Frame& F, CArgsP a, int l, bool dry) {
    const float* mod = (const float*)(F.ws + WS_MOD) + l * 5 * 6144; float* xc = (float*)(F.ws + WS_XC); bf16_t* H = (bf16_t*)(F.ws + WS_H);
    LAS bf16_t* AT = (LAS bf16_t*)F.lds;
    LAS float* LG = (LAS float*)(F.lds + 32 * RT_AST * 2);
    LAS unsigned* LC = (LAS unsigned*)(F.lds + 32 * RT_AST * 2 + 8192);
    const bf16_t* Wt = (const bf16_t*)(F.ws + WS_WRT) + (size_t)l * 65536; const float rb_ = a->in[29][l * 64 + F.lane];
    unsigned* cnt = (unsigned*)(F.ws + WS_CNT) + l * 4096; int* list = (int*)(F.ws + WS_LIST);
    int* toke = (int*)(F.ws + WS_TOKE); int* tokp = (int*)(F.ws + WS_TOKP); float* tokw = (float*)(F.ws + WS_TOKW);
    const int nrows = l == 0 ? T : NBATCH * SEQ, nbatch = nrows / 32;
    const int fr = F.lane & 15, fq = F.lane >> 4, mt = F.wave & 1, nt = F.wave >> 1;
    if (F.tid < 64) LC[F.tid] = 0u;
    bf16x8 bfr[32];
    { const bf16_t* bp = Wt + (size_t)(nt * 16 + fr) * 1024 + fq * 8;
#pragma unroll
      for (int ks = 0; ks < 32; ++ks) bfr[ks] = *(const bf16x8*)(bp + ks * 32); }
    for (int bt = F.bid; bt < nbatch; bt += F.G) {
        int toks[4];
#pragma unroll
        for (int r = 0; r < 4; ++r) { const int ridx = bt * 32 + F.wave * 4 + r; toks[r] = l == 0 ? ridx : (ridx >> 12) * TPB + CTX + (ridx & 4095); }
#pragma unroll
        for (int rp = 0; rp < 4; rp += 2) {
        f32x4 vv[2][4];
        row_load_bf16(resid_row(F.out, xc, toks[rp]), F.lane, vv[0]); row_load_bf16(resid_row(F.out, xc, toks[rp + 1]), F.lane, vv[1]);
#pragma unroll
        for (int r2 = 0; r2 < 2; ++r2) { const int r = rp + r2; const int tok = toks[r];
            const int b = tok / TPB; const int bsel = (tok - b * TPB) < CTX ? 4 : b;
            float* xr = resid_row(F.out, xc, tok);
            f32x4 (&v)[4] = vv[r2]; row_ln(v); row_affine(v, a->in[26] + l * DM, false, a->in[27] + l * DM, F.lane);
            row_ln(v); const float* mrow = mod + bsel * 6144; row_affine(v, mrow + 4096, true, mrow + 3072, F.lane);
#pragma unroll
            for (int j = 0; j < 4; ++j) { u32x2 w; w.x = pk2(v[j][0], v[j][1]); w.y = pk2(v[j][2], v[j][3]);
                if (!dry) *(u32x2*)(H + (size_t)tok * DM + 4 * F.lane + 256 * j) = w; *(LAS u32x2*)(AT + (F.wave * 4 + r) * RT_AST + 4 * F.lane + 256 * j) = w; }
        }
        }
        __syncthreads();
        { f32x4 d = {0.f, 0.f, 0.f, 0.f};
          const LAS bf16_t* ap = AT + (mt * 16 + fr) * RT_AST + fq * 8;
#pragma unroll
          for (int ks = 0; ks < 32; ++ks) { const bf16x8 av = *(const LAS bf16x8*)(ap + ks * 32); d = __builtin_amdgcn_mfma_f32_16x16x32_bf16(av, bfr[ks], d, 0, 0, 0); }
#pragma unroll
          for (int r = 0; r < 4; ++r) LG[(mt * 16 + fq * 4 + r) * 64 + nt * 16 + fr] = d[r]; }
        __syncthreads();
        bool selr[4]; int rkr[4], lpr[4]; float wr_[4];
#pragma unroll
        for (int r = 0; r < 4; ++r) {
            const float lg = LG[(F.wave * 4 + r) * 64 + F.lane];
            const float s = sigmoidf_(lg); const float bsc = s + rb_;
            float m1 = bsc; m1 = fmaxf(m1, WS_DPP(m1, 0xB1, 0xF, true)); m1 = fmaxf(m1, WS_DPP(m1, 0x4E, 0xF, true)); m1 = fmaxf(m1, WS_DPP(m1, 0x141, 0xF, true));
            const unsigned long long eq = __ballot(bsc == m1); const unsigned gm = (unsigned)(eq >> (F.lane & ~7)) & 0xffu; const int first = __ffs(gm) - 1;
            float m2 = ((F.lane & 7) == first) ? -INFINITY : bsc; m2 = fmaxf(m2, WS_DPP(m2, 0xB1, 0xF, true)); m2 = fmaxf(m2, WS_DPP(m2, 0x4E, 0xF, true)); m2 = fmaxf(m2, WS_DPP(m2, 0x141, 0xF, true));
            const float gs = m1 + m2; const int myg = F.lane >> 3; int grank = 0;
#pragma unroll
            for (int g = 0; g < 8; ++g) { const float og = __builtin_bit_cast(float, __builtin_amdgcn_readlane(__builtin_bit_cast(int, gs), g * 8)); grank += (int)(og > gs) + (int)((og == gs) & (g < myg)); }
            const bool gsel = grank < 4; const float mk = gsel ? bsc : -INFINITY; int rk = 64;
            { float vv_ = mk;
#pragma unroll
              for (int k = 0; k < 8; ++k) {
                  float m = vv_; m = fmaxf(m, WS_DPP(m, 0xB1, 0xF, true)); m = fmaxf(m, WS_DPP(m, 0x4E, 0xF, true)); m = fmaxf(m, WS_DPP(m, 0x141, 0xF, true)); m = fmaxf(m, WS_DPP(m, 0x140, 0xF, true));
                  const float r1 = __builtin_bit_cast(float, __builtin_amdgcn_readlane(__builtin_bit_cast(int, m), 15)), r2 = __builtin_bit_cast(float, __builtin_amdgcn_readlane(__builtin_bit_cast(int, m), 31)),
                              r3 = __builtin_bit_cast(float, __builtin_amdgcn_readlane(__builtin_bit_cast(int, m), 47)), r4 = __builtin_bit_cast(float, __builtin_amdgcn_readlane(__builtin_bit_cast(int, m), 63));
                  const float wm = fmaxf(fmaxf(r1, r2), fmaxf(r3, r4));
                  const unsigned long long bal = __ballot(vv_ == wm); const int win = __ffsll((long long)bal) - 1;
                  if (F.lane == win) { rk = k; vv_ = -INFINITY; }
              } }
            const bool sel = gsel && rk < 8 && !dry;
            const float ssum = wave_sum((gsel && rk < 8) ? s : 0.f);
            selr[r] = sel; rkr[r] = rk; wr_[r] = s / ssum * 2.5f; lpr[r] = 0;
            if (sel) lpr[r] = (int)__hip_atomic_fetch_add((LAS unsigned*)(LC + F.lane), 1u, __ATOMIC_RELAXED, __HIP_MEMORY_SCOPE_WORKGROUP);
        }
        __syncthreads();
        if (F.tid < 64) { const unsigned n = LC[F.tid]; unsigned base = 0; if (n) base = atomicAdd(cnt + F.tid * 64, n); LC[64 + F.tid] = base; LC[F.tid] = 0u; }
        __syncthreads();
#pragma unroll
        for (int r = 0; r < 4; ++r)
            if (selr[r]) { const int tok = toks[r]; const int pos = (int)LC[64 + F.lane] + lpr[r];
                list[(size_t)F.lane * T + pos] = tok; toke[tok * 8 + rkr[r]] = F.lane; tokp[tok * 8 + rkr[r]] = pos; tokw[tok * 8 + rkr[r]] = wr_[r]; }
        __syncthreads();
    }
}

__device__ __forceinline__ void build_tables(const Frame& F, int l) {
    LAS int* tb = (LAS int*)(F.lds + LDS_CTL);
    __syncthreads();
    if (F.tid < 64) tb[LC_TCNT + F.tid] = (int)__hip_atomic_load((unsigned*)(F.ws + WS_CNT) + l * 4096 + F.tid * 64, __ATOMIC_RELAXED, __HIP_MEMORY_SCOPE_AGENT);
    __syncthreads();
    if (F.tid == 0) { int tbs = 0, sbs = 0;
        for (int e = 0; e < 64; ++e) { const int c = tb[LC_TCNT + e]; tb[LC_TBASE + e] = tbs; tb[LC_SBASE + e] = sbs; tbs += (c + 255) >> 8; sbs += c; }
        tb[LC_TBASE + 64] = tbs; tb[LC_SBASE + 64] = sbs; }
    __syncthreads();
}

__device__ __forceinline__ void phase_combine(const Frame& F, CArgsP a, int l, bool dry) {
    const float* mod = (const float*)(F.ws + WS_MOD) + l * 5 * 6144; float* xc = (float*)(F.ws + WS_XC); bf16_t* H = (bf16_t*)(F.ws + WS_H);
    const unsigned char* YS = (const unsigned char*)(F.ws + OV_YS); const LAS int* tb = (const LAS int*)(F.lds + LDS_CTL);
    const int* toke = (const int*)(F.ws + WS_TOKE); const int* tokp = (const int*)(F.ws + WS_TOKP); const float* tokw = (const float*)(F.ws + WS_TOKW);
    const int nrows = l == 0 ? T : NBATCH * SEQ;
    for (int rp = F.gw * 2; rp < nrows; rp += F.NGW * 2) {
        int tok[2], bsel[2]; float* xr[2]; f32x4 y[2][4], v[2][4]; int me, mp; float mw;
#pragma unroll
        for (int q = 0; q < 2; ++q) { const int ridx = rp + q; tok[q] = l == 0 ? ridx : (ridx >> 12) * TPB + CTX + (ridx & 4095);
            const int b = tok[q] / TPB; bsel[q] = (tok[q] - b * TPB) < CTX ? 4 : b; xr[q] = resid_row(F.out, xc, tok[q]); }
        { const int q = (F.lane >> 3) & 1, k = F.lane & 7; me = toke[tok[q] * 8 + k]; mp = tokp[tok[q] * 8 + k]; mw = tokw[tok[q] * 8 + k]; }
#pragma unroll
        for (int q = 0; q < 2; ++q) { const bf16_t* sp = H + (size_t)tok[q] * DM;
#pragma unroll
            for (int j = 0; j < 4; ++j) { const u32x2 w = *(const u32x2*)(sp + 4 * F.lane + 256 * j); y[q][j] = (f32x4){bflo(w.x), bfhi(w.x), bflo(w.y), bfhi(w.y)}; }
            row_load_bf16(xr[q], F.lane, v[q]); }
#pragma unroll
        for (int q = 0; q < 2; ++q) { row_ln(v[q]); row_affine(v[q], a->in[26] + l * DM, false, a->in[27] + l * DM, F.lane); }
#pragma unroll
        for (int q = 0; q < 2; ++q)
#pragma unroll
            for (int k = 0; k < 8; ++k) { const int e = __shfl(me, q * 8 + k), p = __shfl(mp, q * 8 + k); const float wv = __shfl(mw, q * 8 + k) * 0.0625f;
                const unsigned char* yp = YS + (size_t)(tb[LC_SBASE + e] + p) * DM;
#pragma unroll
                for (int j = 0; j < 4; ++j) { const int w = (int)*(const unsigned*)(yp + 4 * F.lane + 256 * j);
                    y[q][j][0] += wv * __builtin_amdgcn_cvt_f32_fp8(w, 0); y[q][j][1] += wv * __builtin_amdgcn_cvt_f32_fp8(w, 1); y[q][j][2] += wv * __builtin_amdgcn_cvt_f32_fp8(w, 2); y[q][j][3] += wv * __builtin_amdgcn_cvt_f32_fp8(w, 3); } }
#pragma unroll
        for (int q = 0; q < 2; ++q) {
            const float* g2 = mod + bsel[q] * 6144 + 5120;
#pragma unroll
            for (int j = 0; j < 4; ++j) { const f32x4 gv = *(const f32x4*)(g2 + 4 * F.lane + 256 * j); v[q][j] = v[q][j] * DN_ALPHA + gv * y[q][j]; }
            row_ln(v[q]); row_affine(v[q], a->in[36] + l * DM, false, a->in[37] + l * DM, F.lane);
            if (!dry) { if (l == 0) row_store_bf16((bf16_t*)xr[q], F.lane, v[q]); else row_store(xr[q], F.lane, v[q]); } else asm volatile("" :: "v"(v[q][0]), "v"(v[q][1]), "v"(v[q][2]), "v"(v[q][3]));
            if (l == 0 && !dry) { row_ln(v[q]); const float* mrow = mod + 5 * 6144 + bsel[q] * 6144; row_affine(v[q], mrow + 1024, true, mrow, F.lane); row_store_bf16(H + (size_t)tok[q] * DM, F.lane, v[q]); }
        }
    }
}

constexpr int NPHASE = 22;
__global__ void __launch_bounds__(NTHR, 2) mk_fwd(Args args) {
    extern __shared__ __attribute__((aligned(16))) unsigned char lds_raw[];
    Frame F; F.lds = (LAS unsigned char*)lds_raw; F.tid = threadIdx.x; F.lane = F.tid & 63; F.wave = __builtin_amdgcn_readfirstlane(F.tid >> 6);
    F.G = gridDim.x; F.bid = blockIdx.x; F.gw = F.bid * NWAVES + F.wave; F.NGW = F.G * NWAVES; F.ws = args.ws; F.out = args.out; F.vcu = (F.G % 8 == 0) ? (F.bid % 8) * (F.G / 8) + F.bid / 8 : F.bid;
    for (int u = F.tid; u < (LDS_BYTES - LDS_CTL) / 4; u += NTHR) ((LAS unsigned*)(F.lds + LDS_CTL))[u] = 0u;
    __syncthreads();
    const int lo = args.ph_lo, hi = args.ph_hi;
    CArgsP A4 = (CArgsP)__builtin_amdgcn_kernarg_segment_ptr();
    XcdBarrier bar; bar.bar = (unsigned*)(F.ws + CW_BAR_BYTE); bar.x = 0; bar.st = nullptr;
    if (hi - lo > 1) bar = xcd_barrier_post((unsigned*)(F.ws + CW_BAR_BYTE), (volatile LAS unsigned*)(F.lds + LDS_CTL) + LC_BAR);
#ifndef PHMASK
#define PHMASK 0xfff
#endif
#define PH_EN(k) ((PHMASK >> ((k) < 2 ? (k) : 2 + (((k) - 2) % 10))) & 1)
#define IN(k) (PH_EN(k) && lo <= (k) && (k) < hi)
#define SEAM(k) do { if (IN(k) && IN((k) + 1)) { for (int dd = 0; dd < NDUP(14); ++dd) xcd_barrier(bar); } if (TSMASK != 0 && blockIdx.x == 0 && threadIdx.x == 0) { ((volatile LAS unsigned long long*)(F.lds + LDS_CTL + 2048))[(k) + 1] = __builtin_amdgcn_s_memrealtime(); } FRESH(); } while (0)
#define FRESH() do { int t_ = threadIdx.x, b_ = blockIdx.x; CArgsP p_ = (CArgsP)__builtin_amdgcn_kernarg_segment_ptr(); asm volatile("" : "+v"(t_)); asm volatile("" : "+s"(b_), "+s"(p_)); A4 = p_; unsigned char* w_ = p_->ws; float* o_ = p_->out; \
    F.tid = t_; F.lane = t_ & 63; F.wave = __builtin_amdgcn_readfirstlane(t_ >> 6); F.bid = b_; F.gw = b_ * NWAVES + F.wave; F.ws = w_; F.out = o_; F.vcu = (F.G % 8 == 0) ? (b_ % 8) * (F.G / 8) + b_ / 8 : b_; } while (0)
    if (TSMASK != 0 && blockIdx.x == 0 && threadIdx.x == 0) ((volatile LAS unsigned long long*)(F.lds + LDS_CTL + 2048))[0] = __builtin_amdgcn_s_memrealtime();
    if (IN(0)) { for (int dd = 0; dd < NDUP(0); ++dd) phase_prologue(F, A4); } SEAM(0);
    if (IN(1)) { for (int dd = 0; dd < NDUP(1); ++dd) phase_rows0(F, A4); } SEAM(1);
#pragma unroll 1
    for (int l = 0; l < 2; ++l) {
        const int pb = 2 + 10 * l; const bool lat = (l == 1);
        if (IN(pb + 0)) {
            SchedPlain S{(const char*)(F.ws + WS_H), (const char*)(F.ws + WS_WIN) + (size_t)l * INC * 1024 * 2, 1024, 68, 26, F.G, F.bid, false};
            EpiInproj E{F.ws, A4->in[7] + l * INC, (const float*)(F.ws + WS_ROPE)};
            for (int dd = 0; dd < NDUP(2); ++dd) pg8::gemm_phase(F.lds, 1024, S, E);
        } SEAM(pb + 0);
        if (IN(pb + 1)) {
            for (int dd = 0; dd < NDUP(3); ++dd) lru_phase(F, A4, l, 0, false);
            for (int dd = 0; dd < NDUP(4); ++dd)
            for (int it = F.bid; it < 136 * 4; it += F.G) { const int chunk = it >> 2; if (lat && (chunk % 34) < 2) continue; sg_item(F, A4, l, chunk, it & 3); }
        } SEAM(pb + 1);
        if (IN(pb + 2)) { for (int dd = 0; dd < NDUP(5); ++dd) phase_carry(F); } SEAM(pb + 2);
        if (IN(pb + 3)) { phase_attn(F, A4, l); } SEAM(pb + 3);
        if (IN(pb + 4)) {
            for (int dd = 0; dd < NDUP(8); ++dd) {
                SchedMerge S{(const char*)(F.ws + OV_OA), (const char*)(F.ws + WS_WBR) + (size_t)(l * 3) * 1024 * 512 * 2, F.G, F.bid};
                EpiMerge E{(bf16_t*)(F.ws + OV_MG), (const bf16_t*)(F.ws + OV_G)};
                pg8::gemm_phase(F.lds, 512, S, E);
            }
            if (!lat) mini_merge_ctx(F, l);
        } SEAM(pb + 4);
        if (IN(pb + 5)) {
            SchedPlain S{(const char*)(F.ws + OV_MG), (const char*)(F.ws + WS_WOUT) + (size_t)l * 1048576 * 2, 1024, 64, 4, F.G, F.bid, true};
            EpiWout E{F.out, (float*)(F.ws + WS_XC), (const float*)(F.ws + WS_MOD) + l * 5 * 6144, false};
            pg8::gemm_phase(F.lds, 1024, S, E);
            if (NDUP(11) > 1) { EpiWout E2{F.out, (float*)(F.ws + WS_XC), (const float*)(F.ws + WS_MOD) + l * 5 * 6144, true}; pg8::gemm_phase(F.lds, 1024, S, E2); }
            if (!lat) mini_wout_ctx(F, l);
        } SEAM(pb + 5);
        if (IN(pb + 6)) { phase_router(F, A4, l, false); if (NDUP(12) > 1) phase_router(F, A4, l, F.G != 12345); } SEAM(pb + 6);
        if (IN(pb + 7)) {
            build_tables(F, l);
            SchedMoe S{(const char*)(F.ws + WS_H), (const char*)(F.ws + WS_H), (const char*)(F.ws + WS_WM1), (const char*)(F.ws + WS_WSH1) + (size_t)l * 524288 * 2,
                       (const int*)(F.ws + WS_LIST), (const LAS int*)(F.lds + LDS_CTL), 1024, 2, F.G, F.vcu, lat ? 64 : 68, lat, true, (size_t)524288 * 2};
            EpiMoe1 E{(bf16_t*)(F.ws + OV_ACT), (bf16_t*)(F.ws + OV_ACTSH)};
            for (int dd = 0; dd < NDUP(9); ++dd) pg8::gemm_phase(F.lds, 1024, S, E);
        } SEAM(pb + 7);
        if (IN(pb + 8)) {
            build_tables(F, l);
            SchedMoe S{(const char*)(F.ws + OV_ACT), (const char*)(F.ws + OV_ACTSH), (const char*)(F.ws + WS_WM2), (const char*)(F.ws + WS_WSH2) + (size_t)l * 262144 * 2,
                       (const int*)(F.ws + WS_LIST), (const LAS int*)(F.lds + LDS_CTL), 256, 4, F.G, F.vcu, lat ? 64 : 68, lat, false, (size_t)262144 * 2};
            EpiMoe2 E{(unsigned char*)(F.ws + OV_YS), (bf16_t*)(F.ws + WS_H)};
            for (int dd = 0; dd < NDUP(10); ++dd) pg8::gemm_phase(F.lds, 256, S, E);
        } SEAM(pb + 8);
        if (IN(pb + 9)) {
            build_tables(F, l);
            phase_combine(F, A4, l, false);
            if (NDUP(13) > 1) phase_combine(F, A4, l, F.G != 12345);
            if (l == 0) for (int dd = 0; dd < NDUP(15); ++dd) conv_moe_layer(F, A4, 1);
        } SEAM(pb + 9);
    }
    if (TSMASK != 0 && hi - lo == NPHASE) { __syncthreads(); asm volatile("s_waitcnt vmcnt(0)" ::: "memory");
        if (blockIdx.x == 0 && threadIdx.x == 0) { volatile LAS unsigned long long* ts = (volatile LAS unsigned long long*)(F.lds + LDS_CTL + 2048);
            unsigned long long sel = 0; for (int k = 0; k < NPHASE; ++k) if ((TSMASK >> k) & 1) sel += ts[k + 1] - ts[k];
            const float frac = (float)sel / (float)(ts[NPHASE] - ts[0]); args.out[0] += 1.0f + floorf(90.0f * frac + 0.5f); } }
#undef IN
#undef SEAM
}

extern "C" void kernel_launch(void* const* d_in, const int* in_sizes, int n_in, void* d_out, int out_size, void* d_ws, size_t ws_size, hipStream_t stream) {
    static int grid = 0;
    if (grid == 0) {
        if (n_in != 38 || out_size != NBATCH * SEQ * DM || ws_size < WS_END) { fprintf(stderr, "kernel_launch: unexpected shapes (n_in %d out %d ws %zu need %zu)\n", n_in, out_size, ws_size, (size_t)WS_END); grid = -1; return; }
        int dev = 0, cus = 0;
        if (hipGetDevice(&dev) != hipSuccess || hipDeviceGetAttribute(&cus, hipDeviceAttributeMultiprocessorCount, dev) != hipSuccess) { grid = -1; return; }
        if (hipFuncSetAttribute((const void*)mk_fwd, hipFuncAttributeMaxDynamicSharedMemorySize, LDS_BYTES) != hipSuccess) { fprintf(stderr, "kernel_launch: hipFuncSetAttribute failed\n"); grid = -1; return; }
        int per_cu = 0;
        if (hipOccupancyMaxActiveBlocksPerMultiprocessor(&per_cu, (const void*)mk_fwd, NTHR, LDS_BYTES) != hipSuccess || per_cu < 1) fprintf(stderr, "kernel_launch: occupancy query says %d\n", per_cu);
        (void)hipGetLastError();
        grid = cus;
    }
    if (grid < 0) return;
    (void)hipMemsetAsync((char*)d_ws + WS_CTL, 0, CTL_ZERO_BYTES, stream);
    Args a{};
    for (int i = 0; i < 38; ++i) a.in[i] = (const float*)d_in[i];
    a.out = (float*)d_out; a.ws = (unsigned char*)d_ws;
#if MK_MULTI
    for (int p = 0; p < NPHASE; ++p) { a.ph_lo = p; a.ph_hi = p + 1; hipLaunchKernelGGL(mk_fwd, dim3(grid), dim3(NTHR), LDS_BYTES, stream, a); }
#else
    a.ph_lo = 0; a.ph_hi = NPHASE; hipLaunchKernelGGL(mk_fwd, dim3(grid), dim3(NTHR), LDS_BYTES, stream, a);
#endif
}
```

```cpp
#include <hip/hip_runtime.h>
#include <cstdio>
#include <cstdint>
#include <cmath>

#ifndef MK_MULTI
#define MK_MULTI 0
#endif
#ifndef DUPMASK
#define DUPMASK 0
#endif
#define NDUP(c) (1 + ((DUPMASK >> (c)) & 1))
#ifndef TSMASK
#define TSMASK 0
#endif
#ifndef NAIVE_GEMM
#define NAIVE_GEMM 0
#endif

#define LAS __attribute__((address_space(3)))
#define GAS __attribute__((address_space(1)))
typedef unsigned short bf16_t;
typedef short bf16x8 __attribute__((ext_vector_type(8)));
typedef short s16x4 __attribute__((ext_vector_type(4)));
typedef float f32x4 __attribute__((ext_vector_type(4)));
typedef float f32x16 __attribute__((ext_vector_type(16)));
typedef unsigned u32x4 __attribute__((ext_vector_type(4)));
typedef unsigned u32x2 __attribute__((ext_vector_type(2)));

constexpr int DM = 1024, NBATCH = 4, SEQ = 4096, CTX = 256, TPB = SEQ + CTX  , T = NBATCH * TPB  ;
constexpr int INC = 6656, NEXP = 64;
constexpr float DN_ALPHA = 1.41421356237309515f;
constexpr float LN_EPS = 1e-6f, RMS_EPS = 1e-5f;
constexpr int NWAVES = 8, NTHR = 512;

constexpr size_t MiB = 1u << 20;
constexpr size_t WS_CTL = 0, CTL_ZERO_BYTES = 1 * MiB;
constexpr size_t CW_BAR_BYTE = 16384;
constexpr size_t WS_CNT = 65536;
constexpr size_t WS_MOD = 131072;
constexpr size_t WS_ROPE = 1 * MiB;
constexpr size_t WS_LAM = 1 * MiB + 8192;
constexpr size_t WS_SUM = 1 * MiB + 65536;
constexpr size_t WS_HIN = WS_SUM + 2304 * 1024;
constexpr size_t WS_TOKE = 5 * MiB, WS_TOKP = 6 * MiB, WS_TOKW = 7 * MiB;
constexpr size_t WS_LIST = 8 * MiB;
constexpr size_t WS_XC = 13 * MiB;
constexpr size_t WS_WLRU = 17 * MiB;
constexpr size_t WS_WSG = 17 * MiB + 512 * 1024;
constexpr size_t WS_WRT = 17 * MiB + 768 * 1024;
constexpr size_t WS_WSH1 = 18 * MiB;
constexpr size_t WS_WSH2 = 20 * MiB;
constexpr size_t WS_WOUT = 21 * MiB;
constexpr size_t WS_WBR = 25 * MiB;
constexpr size_t WS_WIN = 31 * MiB;
constexpr size_t WS_WM1 = 57 * MiB;
constexpr size_t WS_WM2 = 121 * MiB;
constexpr size_t WS_H = 153 * MiB;
constexpr size_t WS_OV = 187 * MiB;
constexpr size_t OV_Q = WS_OV, OV_K = WS_OV + 17 * MiB, OV_V = WS_OV + 34 * MiB, OV_U = WS_OV + 51 * MiB, OV_S = WS_OV + 68 * MiB,
                 OV_X = WS_OV + 85 * MiB, OV_Y = WS_OV + 102 * MiB, OV_G = WS_OV + 119 * MiB, OV_OA = WS_OV + 221 * MiB,
                 OV_OB = WS_OV + 238 * MiB, OV_OC = WS_OV + 255 * MiB, OV_MG = WS_OV + 272 * MiB;
constexpr size_t OV_ACT = WS_OV, OV_ACTSH = WS_OV + 69 * MiB, OV_YS = WS_OV + 78 * MiB;
constexpr size_t WS_END = WS_OV + 350 * MiB;

constexpr int LDS_SCRATCH = 147456;
constexpr int LDS_CTL = LDS_SCRATCH;
constexpr int LDS_BYTES = LDS_SCRATCH + 4096;
constexpr int LC_BAR = 0;
constexpr int LC_TCNT = 64, LC_TBASE = 64 + 80, LC_SBASE = 64 + 160;

struct Args { const float* in[38]; float* out; unsigned char* ws; int ph_lo, ph_hi; };
typedef const Args __attribute__((address_space(4)))* CArgsP;

__device__ __forceinline__ unsigned f2bf(float f) { unsigned u = __builtin_bit_cast(unsigned, f); return (u + 0x7fffu + ((u >> 16) & 1u)) >> 16; }
typedef float f32x2 __attribute__((ext_vector_type(2))); typedef __bf16 bf16x2_t __attribute__((ext_vector_type(2)));
__device__ __forceinline__ unsigned pk2(float lo, float hi) { const f32x2 v = {lo, hi}; const bf16x2_t b = __builtin_convertvector(v, bf16x2_t); return __builtin_bit_cast(unsigned, b); }
__device__ __forceinline__ float bflo(unsigned w) { return __builtin_bit_cast(float, w << 16); }
__device__ __forceinline__ float bfhi(unsigned w) { return __builtin_bit_cast(float, w & 0xffff0000u); }
__device__ __forceinline__ float bf2f(bf16_t b) { return __builtin_bit_cast(float, (unsigned)b << 16); }
#define WS_DPP(v, ctrl, rmask, bc) __builtin_bit_cast(float, __builtin_amdgcn_update_dpp(0, __builtin_bit_cast(int, v), ctrl, rmask, 0xF, bc))
__device__ __forceinline__ float wave_sum(float v) {
    v += WS_DPP(v, 0xB1, 0xF, true); v += WS_DPP(v, 0x4E, 0xF, true); v += WS_DPP(v, 0x141, 0xF, true); v += WS_DPP(v, 0x140, 0xF, true);
    v += WS_DPP(v, 0x142, 0xA, false); v += WS_DPP(v, 0x143, 0xC, false);
    return __builtin_bit_cast(float, __builtin_amdgcn_readlane(__builtin_bit_cast(int, v), 63));
}
__device__ __forceinline__ float sigmoidf_(float x) { return __builtin_amdgcn_rcpf(1.f + __builtin_amdgcn_exp2f(-1.4426950408889634f * x)); }
__device__ __forceinline__ float gelu_tanh(float x) { const float u = x * (0.7978845608028654f + 0.035677408136300125f * x * x); return x * __builtin_amdgcn_rcpf(1.f + __builtin_amdgcn_exp2f(-2.885390081777927f * u)); }
__device__ __forceinline__ float silu_(float x) { return x * __builtin_amdgcn_rcpf(1.f + __builtin_amdgcn_exp2f(-1.4426950408889634f * x)); }
__device__ __forceinline__ float expm1_fast(float x) {
    if (x > -0.5f && x < 0.5f) { float p = 1.0f + x * (1.0f / 8.0f); p = 1.0f + x * (1.0f / 7.0f) * p; p = 1.0f + x * (1.0f / 6.0f) * p; p = 1.0f + x * 0.2f * p; p = 1.0f + x * 0.25f * p; p = 1.0f + x * (1.0f / 3.0f) * p; p = 1.0f + x * 0.5f * p; return x * p; }
    return expm1f(x);
}
#define LDS_WAIT() asm volatile("s_waitcnt lgkmcnt(0)" ::: "memory")
#define VM_WAIT() asm volatile("s_waitcnt vmcnt(0)" ::: "memory")

#define XB_TMO      128
#define XB_XCNT(j)  (256  + 64 * (j))
#define XB_XSUB(j)  (1280 + 64 * (j))
#define XB_XGEN(j)  (2304 + 64 * (j))
#define XB_TOP      3328
#define XB_TOPGEN   3392
#define XCD_BAR_WORDS 3456
#define XB_SPIN_CAP (1u << 22)
__device__ __forceinline__ unsigned xb_ld(unsigned* p)              { return __hip_atomic_load(p, __ATOMIC_RELAXED, __HIP_MEMORY_SCOPE_AGENT); }
__device__ __forceinline__ unsigned xb_add(unsigned* p, unsigned v) { return __hip_atomic_fetch_add(p, v, __ATOMIC_RELAXED, __HIP_MEMORY_SCOPE_AGENT); }
__device__ __forceinline__ unsigned xb_xcc_id() { return (unsigned)__builtin_amdgcn_s_getreg((3 << 11) | 20) & 0xFu; }
#define XB_SPIN(cond, bar) do { unsigned _sp = 0; while (cond) { __builtin_amdgcn_s_sleep(1); \
    if ((++_sp & 255u) == 0u) { if (xb_ld(&(bar)[XB_TMO])) break; if (_sp > XB_SPIN_CAP) { atomicAdd(&(bar)[XB_TMO], 1u); break; } } } } while (0)
struct XcdBarrier { unsigned* bar; unsigned x; volatile LAS unsigned* st; };
__device__ __forceinline__ XcdBarrier xcd_barrier_post(unsigned* bar, volatile LAS unsigned* st) {
    XcdBarrier b; b.bar = bar; b.x = xb_xcc_id(); b.st = st;
    if (threadIdx.x == 0) (void)xb_add(&bar[XB_XCNT(b.x)], 1u);
    return b;
}
__device__ __forceinline__ void xcd_barrier_complete(unsigned* bar, unsigned x, unsigned& nloc, unsigned& nx) {
    const unsigned G = gridDim.x * gridDim.y * gridDim.z;
    unsigned sum, cnt, mine, sp = 0u;
    for (;;) {
        sum = 0u; cnt = 0u; mine = 0u;
#pragma unroll
        for (unsigned j = 0; j < 16; ++j) { const unsigned c = xb_ld(&bar[XB_XCNT(j)]); sum += c; cnt += (c > 0u) ? 1u : 0u; mine = (j == x) ? c : mine; }
        if (sum == G) break;
        __builtin_amdgcn_s_sleep(1);
        if ((++sp & 255u) == 0u) { if (xb_ld(&bar[XB_TMO])) break; if (sp > XB_SPIN_CAP) { atomicAdd(&bar[XB_TMO], 1u); break; } }
    }
    nloc = mine > 0u ? mine : 1u; nx = cnt > 0u ? cnt : 1u;
}
__device__ __forceinline__ void xcd_barrier(const XcdBarrier& b) {
    asm volatile("s_waitcnt vmcnt(0)" ::: "memory");
    __syncthreads();
    if (threadIdx.x == 0) {
        unsigned* bar = b.bar; asm volatile("" : "+s"(bar));
        __builtin_amdgcn_s_waitcnt(0);
        unsigned nloc = b.st[0], nx = b.st[1];
        if (nloc == 0u) { xcd_barrier_complete(bar, b.x, nloc, nx); b.st[0] = nloc; b.st[1] = nx; }
        const unsigned old = xb_add(&bar[XB_XSUB(b.x)], 1u);
        const unsigned gen = old / nloc;
        if (old + 1u == (gen + 1u) * nloc) {
            __builtin_amdgcn_fence(__ATOMIC_RELEASE, "agent");
            asm volatile("s_waitcnt vmcnt(0)" ::: "memory");
            const unsigned og = xb_add(&bar[XB_TOP], 1u);
            const unsigned tg = og / nx;
            if (og + 1u == (tg + 1u) * nx) xb_add(&bar[XB_TOPGEN], 1u);
            else XB_SPIN(xb_ld(&bar[XB_TOPGEN]) == tg, bar);
            __builtin_amdgcn_fence(__ATOMIC_ACQUIRE, "agent");
            xb_add(&bar[XB_XGEN(b.x)], 1u);
            asm volatile("s_waitcnt vmcnt(0)" ::: "memory");
        } else {
            XB_SPIN(xb_ld(&bar[XB_XGEN(b.x)]) == gen, bar);
            __builtin_amdgcn_fence(__ATOMIC_ACQUIRE, "agent");
            asm volatile("s_waitcnt vmcnt(0)" ::: "memory");
        }
    }
    __syncthreads();
}

namespace pg8 {
constexpr int BM = 256, BK = 64, HALF = 128, HTB = HALF * BK * 2, STAGE_BYTES = 8 * HTB, NXCD = 8, WGM = 8;
__host__ __device__ __forceinline__ int lds_byte(int r, int c) { const int st = (r >> 4) * 2 + (c >> 5), rr = r & 15, cc = c & 31, ob = rr * 64 + cc * 2; return st * 1024 + (ob ^ (((ob >> 9) & 1) << 5)); }
__host__ __device__ __forceinline__ void stage_rc(int b, int& R, int& C) { const int st = b / 1024, sb = b % 1024, swz = sb ^ (((sb >> 9) & 1) << 5); R = (st >> 1) * 16 + swz / 64; C = (st & 1) * 32 + (swz % 64) / 2; }
__host__ __device__ __forceinline__ int perm32(int rho) { const int n = rho >> 4, i = rho & 15; return 8 * (i >> 2) + 4 * n + (i & 3); }
struct Unit { int pm, pn, e, ti, nrows, row0; };
typedef f32x4 Acc[2][2][4][2];

template <class Epi, class Sched>
__device__ __forceinline__ void gemm_phase(LAS unsigned char* lds, const int K, const Sched& S, const Epi& E) {
    int tid_ = threadIdx.x; asm volatile("" : "+v"(tid_));
    const int tid = tid_, wid = __builtin_amdgcn_readfirstlane(tid >> 6), lane = tid & 63, wr = wid >> 2, wc = wid & 3, fr = lane & 15, fq = lane >> 4;
    (void)fr; (void)fq; (void)wc;
    Unit cur, nxt; int ui = 0;
    if (!S.next(0, cur)) return;
    Acc acc;
#pragma unroll
    for (int a = 0; a < 2; ++a)
#pragma unroll
        for (int b = 0; b < 2; ++b)
#pragma unroll
            for (int m = 0; m < 4; ++m)
#pragma unroll
                for (int n = 0; n < 2; ++n) acc[a][b][m][n] = (f32x4){0.f, 0.f, 0.f, 0.f};
#if NAIVE_GEMM
    for (;;) {
        const char* Ab = S.a_base(); const char* Bb = S.b_ptr(cur);
#pragma unroll 1
        for (int ai = 0; ai < 2; ++ai)
#pragma unroll 1
            for (int m = 0; m < 4; ++m) {
                const int rr = ai * 128 + wr * 64 + m * 16 + fr;
                const bf16_t* ap = (const bf16_t*)(Ab + S.a_off(cur, rr));
#pragma unroll
                for (int bj = 0; bj < 2; ++bj)
#pragma unroll
                    for (int n = 0; n < 2; ++n)
#pragma unroll
                        for (int j = 0; j < 4; ++j) {
                            const int cc = Epi::PERM ? bj * 128 + wc * 32 + fq * 8 + n * 4 + j : bj * 128 + wc * 32 + n * 16 + fq * 4 + j;
                            const bf16_t* bp = (const bf16_t*)(Bb + (size_t)cc * K * 2);
                            float s = 0.f;
                            for (int k = 0; k < K; k += 8) {
                                const u32x4 av = *(const u32x4*)(ap + k), bv = *(const u32x4*)(bp + k);
                                s += bflo(av.x) * bflo(bv.x) + bfhi(av.x) * bfhi(bv.x) + bflo(av.y) * bflo(bv.y) + bfhi(av.y) * bfhi(bv.y)
                                   + bflo(av.z) * bflo(bv.z) + bfhi(av.z) * bfhi(bv.z) + bflo(av.w) * bflo(bv.w) + bfhi(av.w) * bfhi(bv.w);
                            }
                            acc[ai][bj][m][n][j] = s;
                        }
            }
        E(acc, cur, wr, wc, fr, fq);
        ++ui;
        if (!S.next(ui, cur)) break;
    }
    return;
#else
    const int nt = K / BK;
    unsigned voffB[2];
    { int Rr[2], Cc[2];
#pragma unroll
      for (int i = 0; i < 2; ++i) { stage_rc(tid * 16 + i * 8192, Rr[i], Cc[i]); const int Rb = Epi::PERM ? ((Rr[i] & ~31) + perm32(Rr[i] & 31)) : Rr[i]; voffB[i] = (unsigned)(Rb * K + Cc[i]) * 2u; } }
#define PG8_AOFFS(U, o00, o01, o10, o11) do { int t3_ = threadIdx.x; asm volatile("" : "+v"(t3_)); int R0_, C0_, R1_, C1_; stage_rc(t3_ * 16, R0_, C0_); stage_rc(t3_ * 16 + 8192, R1_, C1_); \
        o00 = S.a_off(U, R0_) + (unsigned)C0_ * 2u; o01 = S.a_off(U, R1_) + (unsigned)C1_ * 2u; o10 = S.a_off(U, HALF + R0_) + (unsigned)C0_ * 2u; o11 = S.a_off(U, HALF + R1_) + (unsigned)C1_ * 2u; } while (0)
    const size_t kstep = (size_t)(BK * 2);
    const size_t hstep = (size_t)HALF * K * 2;
    const unsigned ldsw = (unsigned)wid * 1024u;
    const int aoff = lds_byte(wr * 64 + fr, fq * 8), boff = lds_byte(wc * 32 + fr, fq * 8);
#define PG8_SA(b, h) (((b) * 2 + (h)) * HTB)
#define PG8_SB(b, h) ((4 + (b) * 2 + (h)) * HTB)
#define PG8_STAGE(bufoff, gbase, v0, v1) do { \
        __builtin_amdgcn_global_load_lds((const unsigned*)((const char*)(gbase) + (v0)), (LAS unsigned*)(lds + (bufoff) + ldsw), 16, 0, 0); \
        __builtin_amdgcn_global_load_lds((const unsigned*)((const char*)(gbase) + (v1)), (LAS unsigned*)(lds + (bufoff) + ldsw + 8192), 16, 0, 0); } while (0)
#define PG8_LDA(dst, b, h) do { _Pragma("unroll") for (int m = 0; m < 4; ++m) _Pragma("unroll") for (int k = 0; k < 2; ++k) dst[m][k] = *(const LAS bf16x8*)(lds + PG8_SA(b, h) + aoff + m * 2048 + k * 1024); } while (0)
#define PG8_LDB(dst, b, h) do { _Pragma("unroll") for (int n = 0; n < 2; ++n) _Pragma("unroll") for (int k = 0; k < 2; ++k) dst[n][k] = *(const LAS bf16x8*)(lds + PG8_SB(b, h) + boff + n * 2048 + k * 1024); } while (0)
#define PG8_MMA(ai, bj, At, Bt) do { __builtin_amdgcn_s_setprio(1); _Pragma("unroll") for (int m = 0; m < 4; ++m) _Pragma("unroll") for (int n = 0; n < 2; ++n) _Pragma("unroll") for (int k = 0; k < 2; ++k) \
        acc[ai][bj][m][n] = __builtin_amdgcn_mfma_f32_16x16x32_bf16(Bt[n][k], At[m][k], acc[ai][bj][m][n], 0, 0, 0); __builtin_amdgcn_s_setprio(0); } while (0)
#define PG8_WAIT_V(n) asm volatile("s_waitcnt vmcnt(" #n ")" ::: "memory")
#define PG8_WAIT_L(n) asm volatile("s_waitcnt lgkmcnt(" #n ")" ::: "memory")
#define PG8_BAR __builtin_amdgcn_s_barrier()
#define PG8_SCHED __builtin_amdgcn_sched_barrier(0)
    bf16x8 At[4][2], B0[2][2], B1[2][2];
    const char* const Ab = S.a_base();
    unsigned vA00, vA01, vA10, vA11;
    PG8_AOFFS(cur, vA00, vA01, vA10, vA11);
    const char* cB = S.b_ptr(cur);
    PG8_STAGE(PG8_SB(0, 0), cB, voffB[0], voffB[1]); PG8_STAGE(PG8_SB(0, 1), cB + hstep, voffB[0], voffB[1]); PG8_STAGE(PG8_SA(0, 0), Ab, vA00, vA01); PG8_STAGE(PG8_SA(0, 1), Ab, vA10, vA11);
    if (wr == 1) PG8_BAR;
    PG8_WAIT_V(2); PG8_BAR;
    PG8_STAGE(PG8_SB(1, 0), cB + kstep, voffB[0], voffB[1]); PG8_STAGE(PG8_SA(1, 0), Ab + kstep, vA00, vA01); PG8_STAGE(PG8_SB(1, 1), cB + hstep + kstep, voffB[0], voffB[1]);
    PG8_WAIT_V(6); PG8_BAR;
    for (;;) {
        const bool has_next = S.next(ui + 1, nxt);
        unsigned vN00 = vA00, vN01 = vA01, vN10 = vA10, vN11 = vA11; const char* nB = cB;
        if (has_next) { PG8_AOFFS(nxt, vN00, vN01, vN10, vN11); nB = S.b_ptr(nxt); }
        for (int t = 0; t < nt; t += 2) {
            const bool last = (t == nt - 2);
            const char* a1 = Ab + (size_t)(t + 1) * kstep;
            const char* a2 = last ? Ab : Ab + (size_t)(t + 2) * kstep; const char* b2 = last ? nB : cB + (size_t)(t + 2) * kstep;
            const char* a3 = a2 + kstep; const char* b3 = b2 + kstep;
            const unsigned w00 = last ? vN00 : vA00, w01 = last ? vN01 : vA01, w10 = last ? vN10 : vA10, w11 = last ? vN11 : vA11;
            PG8_LDB(B0, 0, 0); PG8_LDB(B1, 0, 1); PG8_SCHED; PG8_LDA(At, 0, 0); PG8_STAGE(PG8_SA(1, 1), a1, vA10, vA11);
            PG8_WAIT_V(8); PG8_WAIT_L(0); PG8_BAR; PG8_MMA(0, 0, At, B0); PG8_MMA(0, 1, At, B1); PG8_BAR; PG8_SCHED;
            PG8_LDA(At, 0, 1); PG8_STAGE(PG8_SB(0, 0), b2, voffB[0], voffB[1]); PG8_STAGE(PG8_SB(0, 1), b2 + hstep, voffB[0], voffB[1]); PG8_STAGE(PG8_SA(0, 0), a2, w00, w01);
            PG8_WAIT_V(8); PG8_WAIT_L(0); PG8_BAR; PG8_MMA(1, 0, At, B0); PG8_MMA(1, 1, At, B1); PG8_BAR; PG8_SCHED;
            PG8_LDB(B0, 1, 0); PG8_LDB(B1, 1, 1); PG8_SCHED; PG8_LDA(At, 1, 0); PG8_STAGE(PG8_SA(0, 1), a2, w10, w11);
            PG8_WAIT_V(8); PG8_WAIT_L(0); PG8_BAR; PG8_MMA(0, 0, At, B0); PG8_MMA(0, 1, At, B1); PG8_BAR; PG8_SCHED;
            PG8_LDA(At, 1, 1); PG8_STAGE(PG8_SB(1, 0), b3, voffB[0], voffB[1]); PG8_STAGE(PG8_SB(1, 1), b3 + hstep, voffB[0], voffB[1]); PG8_STAGE(PG8_SA(1, 0), a3, w00, w01);
            PG8_WAIT_V(8); PG8_WAIT_L(0); PG8_BAR; PG8_MMA(1, 0, At, B0); PG8_MMA(1, 1, At, B1); PG8_BAR; PG8_SCHED;
        }
        if (wr == 0) PG8_BAR;
        { int t2_ = threadIdx.x; asm volatile("" : "+v"(t2_)); const int l2_ = t2_ & 63; E(acc, cur, wr, wc, l2_ & 15, l2_ >> 4); }
        if (!has_next) break;
#pragma unroll
        for (int a = 0; a < 2; ++a)
#pragma unroll
            for (int b = 0; b < 2; ++b)
#pragma unroll
                for (int m = 0; m < 4; ++m)
#pragma unroll
                    for (int n = 0; n < 2; ++n) acc[a][b][m][n] = (f32x4){0.f, 0.f, 0.f, 0.f};
        cur = nxt; vA00 = vN00; vA01 = vN01; vA10 = vN10; vA11 = vN11; cB = nB; ++ui;
        if (wr == 1) PG8_BAR;
    }
    PG8_WAIT_V(0);
    PG8_BAR;
#undef PG8_SA
#undef PG8_AOFFS
#undef PG8_SB
#undef PG8_STAGE
#undef PG8_LDA
#undef PG8_LDB
#undef PG8_MMA
#undef PG8_WAIT_V
#undef PG8_WAIT_L
#undef PG8_BAR
#undef PG8_SCHED
#endif
}
}
using pg8::Unit;
using pg8::Acc;

__device__ __forceinline__ float* resid_row(float* out, float* xc, int tok) {
    const int b = tok / TPB, j = tok - b * TPB;
    return j < CTX ? xc + ((size_t)(b * CTX + j)) * DM : out + ((size_t)(b * SEQ + j - CTX)) * DM;
}
__device__ __forceinline__ int tile_to_pm(int i, bool latent_only) { return latent_only ? (i >> 4) * 17 + 1 + (i & 15) : i; }

__device__ __forceinline__ bool static_order(int i, int G, int c, int nM, int nN, int& pm, int& pn) {
    const int nwg = nM * nN; const long L = (long)i * G + c; if (L >= nwg) return false;
    int wgid = (int)L; { const int q = nwg / 8, r = nwg % 8, xcd = wgid % 8, off = wgid / 8; wgid = (xcd < r ? xcd * (q + 1) : r * (q + 1) + (xcd - r) * q) + off; }
    const int nig = 8 * nN, gid = wgid / nig, fm = gid * 8, gsz = (nM - fm) < 8 ? (nM - fm) : 8;
    pm = fm + ((wgid % nig) % gsz); pn = (wgid % nig) / gsz; return true;
}

struct SchedPlain {
    const char* A; const char* Bt; int K, nM, nN, G, c; bool lat;
    __device__ __forceinline__ bool next(int i, Unit& u) const {
        int pm, pn; if (!static_order(i, G, c, nM, nN, pm, pn)) return false;
        u.pm = tile_to_pm(pm, lat); u.pn = pn; u.e = 0; u.ti = 0; u.nrows = 256; u.row0 = u.pm * 256; return true;
    }
    __device__ __forceinline__ const char* a_base() const { return A; }
    __device__ __forceinline__ unsigned a_off(const Unit& u, int rr) const { return (unsigned)(u.row0 + rr) * (unsigned)(K * 2); }
    __device__ __forceinline__ const char* b_ptr(const Unit& u) const { return Bt + (size_t)u.pn * 256 * K * 2; }
};

struct SchedMerge {
    const char* A0; const char* Bt0; int G, c;
    __device__ __forceinline__ bool next(int i, Unit& u) const {
        const int ti = i / 3, r = i - 3 * ti; int pm, pn; if (!static_order(ti, G, c, 64, 4, pm, pn)) return false;
        u.pm = tile_to_pm(pm, true); u.pn = pn; u.e = r; u.ti = 0; u.nrows = 256; u.row0 = u.pm * 256; return true;
    }
    __device__ __forceinline__ const char* a_base() const { return A0; }
    __device__ __forceinline__ unsigned a_off(const Unit& u, int rr) const { return (unsigned)u.e * (unsigned)(17 * MiB) + (unsigned)(u.row0 + rr) * 1024u; }
    __device__ __forceinline__ const char* b_ptr(const Unit& u) const { return Bt0 + ((size_t)u.e * 1024 * 512 + (size_t)u.pn * 256 * 512) * 2; }
};

struct SchedMoe {
    const char* A;
    const char* Ash;
    const char* Bt; const char* Btsh; const int* list;
    const LAS int* tb;
    int K, nN, G, c, nsh; bool lat, gather; size_t bstride;
    __device__ __forceinline__ bool next(int i, Unit& u) const {
        const int nrt = tb[LC_TBASE + 64], L = i * G + c, tot = (nrt + nsh) * nN;
        if (L >= tot) return false;
        const int rt = L / nN; u.pn = L - rt * nN;
        if (rt < nrt) {
            int e = 0;
#pragma unroll 1
            for (int s = 32; s > 0; s >>= 1) if (e + s < 64 && tb[LC_TBASE + e + s] <= rt) e += s;
            u.e = e; u.ti = rt - tb[LC_TBASE + e]; const int cnt = tb[LC_TCNT + e]; const int rem = cnt - u.ti * 256;
            u.nrows = rem < 256 ? rem : 256; u.row0 = tb[LC_SBASE + e] + u.ti * 256; u.pm = 0;
        } else { u.e = 64; u.ti = rt - nrt; u.pm = tile_to_pm(u.ti, lat); u.nrows = 256; u.row0 = u.pm * 256; }
        return true;
    }
    __device__ __forceinline__ const char* a_base() const { return A; }
    __device__ __forceinline__ unsigned a_off(const Unit& u, int rr) const {
        if (u.e == 64) return (unsigned)(Ash - A) + (unsigned)(u.row0 + rr) * (unsigned)(K * 2);
        if (gather) { const int r2 = rr < u.nrows ? rr : u.nrows - 1; const int tok = list[(size_t)u.e * T + u.ti * 256 + r2]; return (unsigned)tok * (unsigned)(K * 2); }
        return (unsigned)(u.row0 + rr) * (unsigned)(K * 2);
    }
    __device__ __forceinline__ const char* b_ptr(const Unit& u) const { return (u.e == 64 ? Btsh : Bt + (size_t)u.e * bstride) + (size_t)u.pn * 256 * K * 2; }
};

#define EPI_FOR_ROWS  _Pragma("unroll") for (int ai = 0; ai < 2; ++ai) _Pragma("unroll") for (int m = 0; m < 4; ++m)
#define EPI_FOR_COLS  _Pragma("unroll") for (int bj = 0; bj < 2; ++bj) _Pragma("unroll") for (int n = 0; n < 2; ++n)

struct EpiInproj {
    static constexpr bool PERM = true;
    unsigned char* ws; const float* bias; const float* rope;
    __device__ __forceinline__ void operator()(const Acc& acc, const Unit& u, int wr, int wc, int fr, int fq) const {
        const int pn = u.pn; const bool isg = pn >= 14; const int seg = pn >> 1;
        bf16_t* base = (bf16_t*)(ws + (isg ? OV_G : OV_Q + (size_t)seg * 17 * MiB));
        const int ld = isg ? 3072 : 512, coff = isg ? (pn - 14) * 256 : (pn & 1) * 256;
        const bool latent = (u.pm % 17) != 0; const bool dorope = seg < 2 && !isg && latent;
        f32x4 bv[2][2];
        EPI_FOR_COLS bv[bj][n] = *(const f32x4*)(bias + pn * 256 + bj * 128 + wc * 32 + fq * 8 + n * 4);
        const float qs = (seg == 0 && !isg) ? 0.125f * 1.4426950408889634f : 1.0f;
        const bool upper = __builtin_amdgcn_mbcnt_hi(~0u, __builtin_amdgcn_mbcnt_lo(~0u, 0u)) >= 32u;
        EPI_FOR_ROWS {
            const int row = u.row0 + ai * 128 + wr * 64 + m * 16 + fr;
            bf16_t* rp = base + (size_t)row * ld + coff + wc * 32 + fq * 8;
            f32x4 v[2][2];
            EPI_FOR_COLS v[bj][n] = acc[ai][bj][m][n] + bv[bj][n];
            if (dorope) {
                const int pos = (row % TPB) - CTX; const int pa = (wc & 1) ? (pos & 63) : (pos >> 6);
                const float* tp = rope + (pa * 16 + (fq & 1) * 8) * 2;
                f32x4 t[4];
#pragma unroll
                for (int i = 0; i < 4; ++i) t[i] = *(const f32x4*)(tp + 4 * i);
#pragma unroll
                for (int bj = 0; bj < 2; ++bj)
#pragma unroll
                    for (int n = 0; n < 2; ++n)
#pragma unroll
                        for (int j = 0; j < 4; ++j) { const float own = v[bj][n][j];
                            const auto rr = __builtin_amdgcn_permlane32_swap(__float_as_uint(own), __float_as_uint(own), false, false);
                            const float oth = upper ? __uint_as_float(rr[0]) : __uint_as_float(rr[1]);
                            const int fi = 4 * n + j; const float cs = t[fi >> 1][(fi & 1) * 2], sn = t[fi >> 1][(fi & 1) * 2 + 1];
                            v[bj][n][j] = own * cs + (upper ? oth : -oth) * sn; }
            }
#pragma unroll
            for (int bj = 0; bj < 2; ++bj) { const f32x4 v0 = v[bj][0] * qs, v1 = v[bj][1] * qs;
                u32x4 w; w.x = pk2(v0[0], v0[1]); w.y = pk2(v0[2], v0[3]); w.z = pk2(v1[0], v1[1]); w.w = pk2(v1[2], v1[3]); *(u32x4*)(rp + bj * 128) = w; }
        }
    }
};

struct EpiMerge {
    static constexpr bool PERM = true;
    bf16_t* mg; const bf16_t* gate;
    __device__ __forceinline__ void operator()(const Acc& acc, const Unit& u, int wr, int wc, int fr, int fq) const {
        const int r = u.e;
#pragma unroll
        for (int ai = 0; ai < 2; ++ai) {
            const size_t rbase = (size_t)(u.row0 + ai * 128 + wr * 64 + fr); const int col = u.pn * 256 + wc * 32 + fq * 8;
            u32x4 g[4][2], o[4][2];
#pragma unroll
            for (int m = 0; m < 4; ++m)
#pragma unroll
                for (int bj = 0; bj < 2; ++bj) { g[m][bj] = *(const u32x4*)(gate + (rbase + m * 16) * 3072 + r * 1024 + col + bj * 128);
                    if (r > 0) o[m][bj] = *(const u32x4*)(mg + (rbase + m * 16) * DM + col + bj * 128); else o[m][bj] = (u32x4){0u, 0u, 0u, 0u}; }
#pragma unroll
            for (int m = 0; m < 4; ++m)
#pragma unroll
                for (int bj = 0; bj < 2; ++bj) { const u32x4 gg = g[m][bj], oo = o[m][bj]; const f32x4 v0 = acc[ai][bj][m][0], v1 = acc[ai][bj][m][1];
                    u32x4 w; w.x = pk2(v0[0] * sigmoidf_(bflo(gg.x)) + bflo(oo.x), v0[1] * sigmoidf_(bfhi(gg.x)) + bfhi(oo.x)); w.y = pk2(v0[2] * sigmoidf_(bflo(gg.y)) + bflo(oo.y), v0[3] * sigmoidf_(bfhi(gg.y)) + bfhi(oo.y));
                    w.z = pk2(v1[0] * sigmoidf_(bflo(gg.z)) + bflo(oo.z), v1[1] * sigmoidf_(bfhi(gg.z)) + bfhi(oo.z)); w.w = pk2(v1[2] * sigmoidf_(bflo(gg.w)) + bflo(oo.w), v1[3] * sigmoidf_(bfhi(gg.w)) + bfhi(oo.w));
                    *(u32x4*)(mg + (rbase + m * 16) * DM + col + bj * 128) = w; }
        }
    }
};

struct EpiWout {
    static constexpr bool PERM = true;
    float* out; float* xc; const float* modl; bool dry;
    __device__ __forceinline__ void operator()(const Acc& acc, const Unit& u, int wr, int wc, int fr, int fq) const {
        const int b = u.pm / 17; const int bsel = (u.pm % 17) == 0 ? 4 : b;
        const float* g1 = modl + bsel * 6144 + 2048;
        f32x4 gv[2][2];
        EPI_FOR_COLS gv[bj][n] = *(const f32x4*)(g1 + u.pn * 256 + bj * 128 + wc * 32 + fq * 8 + n * 4);
#pragma unroll
        for (int ai = 0; ai < 2; ++ai) {
            bf16_t* rp[4]; u32x4 x[4][2];
#pragma unroll
            for (int m = 0; m < 4; ++m) { rp[m] = (bf16_t*)resid_row(out, xc, u.row0 + ai * 128 + wr * 64 + m * 16 + fr) + u.pn * 256 + wc * 32 + fq * 8;
#pragma unroll
                for (int bj = 0; bj < 2; ++bj) x[m][bj] = *(const u32x4*)(rp[m] + bj * 128); }
#pragma unroll
            for (int m = 0; m < 4; ++m)
#pragma unroll
                for (int bj = 0; bj < 2; ++bj) { const u32x4 xx = x[m][bj]; const f32x4 a0 = acc[ai][bj][m][0] * gv[bj][0], a1 = acc[ai][bj][m][1] * gv[bj][1];
                    u32x4 w; w.x = pk2(bflo(xx.x) * DN_ALPHA + a0[0], bfhi(xx.x) * DN_ALPHA + a0[1]); w.y = pk2(bflo(xx.y) * DN_ALPHA + a0[2], bfhi(xx.y) * DN_ALPHA + a0[3]);
                    w.z = pk2(bflo(xx.z) * DN_ALPHA + a1[0], bfhi(xx.z) * DN_ALPHA + a1[1]); w.w = pk2(bflo(xx.w) * DN_ALPHA + a1[2], bfhi(xx.w) * DN_ALPHA + a1[3]);
                    if (!dry) *(u32x4*)(rp[m] + bj * 128) = w; else asm volatile("" :: "v"(w)); }
        }
    }
};

struct EpiMoe1 {
    static constexpr bool PERM = true;
    bf16_t* act; bf16_t* actsh;
    __device__ __forceinline__ void operator()(const Acc& acc, const Unit& u, int wr, int wc, int fr, int fq) const {
        bf16_t* base = u.e == 64 ? actsh : act;
        EPI_FOR_ROWS {
            const int rl = ai * 128 + wr * 64 + m * 16 + fr;
            if (rl < u.nrows) {
                const f32x4 g0 = acc[ai][0][m][0], g1 = acc[ai][0][m][1], p0 = acc[ai][1][m][0], p1 = acc[ai][1][m][1];
                u32x4 w; w.x = pk2(silu_(g0[0]) * p0[0], silu_(g0[1]) * p0[1]); w.y = pk2(silu_(g0[2]) * p0[2], silu_(g0[3]) * p0[3]);
                w.z = pk2(silu_(g1[0]) * p1[0], silu_(g1[1]) * p1[1]); w.w = pk2(silu_(g1[2]) * p1[2], silu_(g1[3]) * p1[3]);
                *(u32x4*)(base + (size_t)(u.row0 + rl) * 256 + u.pn * 128 + wc * 32 + fq * 8) = w;
            }
        }
    }
};

struct EpiMoe2 {
    static constexpr bool PERM = true;
    unsigned char* ys; bf16_t* sho;
    __device__ __forceinline__ void operator()(const Acc& acc, const Unit& u, int wr, int wc, int fr, int fq) const {
        EPI_FOR_ROWS {
            const int rl = ai * 128 + wr * 64 + m * 16 + fr;
            if (rl < u.nrows) {
                if (u.e == 64) {
                    bf16_t* rp = sho + (size_t)(u.row0 + rl) * DM + u.pn * 256 + wc * 32 + fq * 8;
#pragma unroll
                    for (int bj = 0; bj < 2; ++bj) { const f32x4 v0 = acc[ai][bj][m][0], v1 = acc[ai][bj][m][1];
                        u32x4 w; w.x = pk2(v0[0], v0[1]); w.y = pk2(v0[2], v0[3]); w.z = pk2(v1[0], v1[1]); w.w = pk2(v1[2], v1[3]); *(u32x4*)(rp + bj * 128) = w; }
                } else {
                    unsigned char* rp = ys + (size_t)(u.row0 + rl) * DM + u.pn * 256 + wc * 32 + fq * 8;
#pragma unroll
                    for (int bj = 0; bj < 2; ++bj) { const f32x4 v0 = acc[ai][bj][m][0] * 16.0f, v1 = acc[ai][bj][m][1] * 16.0f;
                        int w0 = 0, w1 = 0;
                        w0 = __builtin_amdgcn_cvt_pk_fp8_f32(v0[0], v0[1], w0, false); w0 = __builtin_amdgcn_cvt_pk_fp8_f32(v0[2], v0[3], w0, true);
                        w1 = __builtin_amdgcn_cvt_pk_fp8_f32(v1[0], v1[1], w1, false); w1 = __builtin_amdgcn_cvt_pk_fp8_f32(v1[2], v1[3], w1, true);
                        *(u32x2*)(rp + bj * 128) = (u32x2){(unsigned)w0, (unsigned)w1}; }
                }
            }
        }
    }
};

struct Frame {
    LAS unsigned char* lds; int tid, lane, wave, G, bid, gw, NGW, vcu;
    unsigned char* ws; float* out;
};

__device__ __forceinline__ void transpose_item(const float* W, int ldw, int k0, int n0, bf16_t* WT, int ldt, int drow0, LAS float* scr, int lane) {
    const int lk = lane >> 4, n4 = (lane & 15) * 4;
#pragma unroll 8
    for (int i = 0; i < 16; ++i) { const int k = 4 * i + lk; const f32x4 v = *(const f32x4*)(W + (size_t)(k0 + k) * ldw + n0 + n4);
        *(LAS f32x4*)(scr + k * 64 + (n4 ^ (((k >> 3) & 7) << 2))) = v; }
    LDS_WAIT(); asm volatile("" ::: "memory");
    const int c = lane & 7;
#pragma unroll
    for (int j = 0; j < 8; ++j) { const int n = (lane >> 3) + 8 * j; const LAS float* sp = scr + (8 * c) * 64 + (n ^ (c << 2));
        u32x4 o; o.x = pk2(sp[0 * 64], sp[1 * 64]); o.y = pk2(sp[2 * 64], sp[3 * 64]); o.z = pk2(sp[4 * 64], sp[5 * 64]); o.w = pk2(sp[6 * 64], sp[7 * 64]);
        *(u32x4*)(WT + (size_t)(drow0 + n) * ldt + k0 + 8 * c) = o; }
    LDS_WAIT(); asm volatile("" ::: "memory");
}
__device__ __forceinline__ void conv_expert_item(const float* wg, const float* wu, const float* wd, bf16_t* t1, bf16_t* t2, int which, int rr, LAS float* scr, int lane) {
    if (which < 2) { const int kb = rr >> 2, nb = rr & 3, n0 = 64 * nb;
        transpose_item(which == 0 ? wg : wu, 256, 64 * kb, n0, t1, 1024, (n0 >> 7) * 256 + (n0 & 127) + which * 128, scr, lane);
    } else { const int kb = rr >> 4, nb = rr & 15; transpose_item(wd, 1024, 64 * kb, 64 * nb, t2, 256, 64 * nb, scr, lane); }
}
__device__ __forceinline__ void conv_moe_layer(const Frame& F, CArgsP a, int l) {
    LAS float* scr = (LAS float*)(F.lds + F.wave * 16384);
    for (int it = F.gw; it < 64 * 3 * 64; it += F.NGW) {
        const int idx = it >> 6, e = idx / 3, which = idx - e * 3, rr = it & 63; const size_t eo = (size_t)(l * 64 + e) * 262144;
        conv_expert_item(a->in[30] + eo, a->in[31] + eo, a->in[32] + eo, (bf16_t*)(F.ws + WS_WM1) + (size_t)e * 524288, (bf16_t*)(F.ws + WS_WM2) + (size_t)e * 262144, which, rr, scr, F.lane);
    }
}

__device__ __forceinline__ void phase_prologue(const Frame& F, CArgsP a) {
    LAS float* scr = (LAS float*)(F.lds + F.wave * 16384);
    constexpr int I_IN = 2 * 1664, I_BR = 6 * 128, I_OUT = 2 * 256, I_SH = 6 * 64;
    for (int it0 = F.gw; it0 < I_IN + I_BR + I_OUT + I_SH; it0 += F.NGW) {
        int it = it0;
        if (it < I_IN) { const int l = it / 1664, r = it - l * 1664, kb = r / 104, nb = r - kb * 104;
            transpose_item(a->in[6] + (size_t)l * 1024 * INC, INC, 64 * kb, 64 * nb, (bf16_t*)(F.ws + WS_WIN) + (size_t)l * INC * 1024, 1024, 64 * nb, scr, F.lane); continue; }
        it -= I_IN;
        if (it < I_BR) { const int idx = it >> 7, rr = it & 127, kb = rr >> 4, nb = rr & 15;
            transpose_item(a->in[24] + (size_t)idx * 512 * 1024, 1024, 64 * kb, 64 * nb, (bf16_t*)(F.ws + WS_WBR) + (size_t)idx * 1024 * 512, 512, 64 * nb, scr, F.lane); continue; }
        it -= I_BR;
        if (it < I_OUT) { const int l = it >> 8, rr = it & 255, kb = rr >> 4, nb = rr & 15;
            transpose_item(a->in[25] + (size_t)l * 1048576, 1024, 64 * kb, 64 * nb, (bf16_t*)(F.ws + WS_WOUT) + (size_t)l * 1048576, 1024, 64 * nb, scr, F.lane); continue; }
        it -= I_OUT;
        { const int idx = it >> 6, l = idx / 3, which = idx - l * 3, rr = it & 63; const size_t lo = (size_t)l * 262144;
          conv_expert_item(a->in[33] + lo, a->in[34] + lo, a->in[35] + lo, (bf16_t*)(F.ws + WS_WSH1) + (size_t)l * 524288, (bf16_t*)(F.ws + WS_WSH2) + (size_t)l * 262144, which, rr, scr, F.lane); }
    }
    conv_moe_layer(F, a, 0);
    { const int gt = F.bid * NTHR + F.tid, NG = F.G * NTHR;
      bf16_t* wl = (bf16_t*)(F.ws + WS_WLRU);
      for (int i = gt; i < 2 * 2 * 2 * 8 * 4096; i += NG) {
          const int ii = i & 63, j = (i >> 6) & 63, cb = (i >> 12) & 7, ax = (i >> 15) & 1, d = (i >> 16) & 1, l = i >> 17;
          const float* src = ax == 0 ? a->in[19] : a->in[21];
          wl[i] = (bf16_t)f2bf(src[(size_t)((l * 2 + d) * 8 + cb) * 4096 + ii * 64 + j]); }
      bf16_t* wrt = (bf16_t*)(F.ws + WS_WRT);
      for (int i = gt; i < 2 * 64 * 1024; i += NG) { const int k = i & 1023, e = (i >> 10) & 63, l = i >> 16; wrt[i] = (bf16_t)f2bf(a->in[28][(size_t)(l * 1024 + k) * 64 + e]); }
      bf16_t* wsg = (bf16_t*)(F.ws + WS_WSG);
      for (int i = gt; i < 2 * 4 * 128 * 128; i += NG) wsg[i] = (bf16_t)f2bf(a->in[15][i]);
      if (F.bid == 0) { float* rope = (float*)(F.ws + WS_ROPE);
          for (int t = F.tid; t < 1024; t += NTHR) { const int p = t >> 4, f = t & 15; const float inv = powf(10000.0f, -(float)f / 16.0f); const float ang = (float)p * inv; rope[2 * t] = cosf(ang); rope[2 * t + 1] = sinf(ang); } }
      if (F.bid == (1 % F.G) && F.wave == 0) { float* lam = (float*)(F.ws + WS_LAM);
#pragma unroll
          for (int l = 0; l < 2; ++l) { const float s1 = wave_sum(a->in[8][l * 64 + F.lane] * a->in[9][l * 64 + F.lane]), s2 = wave_sum(a->in[10][l * 64 + F.lane] * a->in[11][l * 64 + F.lane]);
              const float li = 0.8f - 0.6f * expf(-0.3f * (float)l); if (F.lane == 0) lam[l] = expf(s1) - expf(s2) + li; } }
    }
    __syncthreads();
    LAS float* sl = (LAS float*)(F.lds);
    for (int i = F.tid; i < 5 * 1024; i += NTHR) { const int b = i >> 10, k = i & 1023; const float cv = b < 4 ? a->in[1][b * 1024 + k] : a->in[3][k]; sl[i] = silu_(cv); }
    __syncthreads();
    float* mod = (float*)(F.ws + WS_MOD);
    LAS float* part = (LAS float*)(F.lds + 20480);
    for (int c = F.bid; c < 192; c += F.G) {
        const int l = c / 96, cg = c - l * 96, col = F.tid & 63, ks = F.wave, n = cg * 64 + col;
        const float* w = a->in[4] + ((size_t)l * 1024 + ks * 128) * 6144 + n;
        float acc[5] = {0.f, 0.f, 0.f, 0.f, 0.f};
#pragma unroll 8
        for (int k = 0; k < 128; ++k) { const float wv = w[(size_t)k * 6144];
#pragma unroll
            for (int b = 0; b < 5; ++b) acc[b] += sl[b * 1024 + ks * 128 + k] * wv; }
#pragma unroll
        for (int b = 0; b < 5; ++b) part[(ks * 5 + b) * 64 + col] = acc[b];
        __syncthreads();
        if (F.tid < 320) { const int b = F.tid >> 6; float s = a->in[5][l * 6144 + n];
#pragma unroll
            for (int k8 = 0; k8 < 8; ++k8) s += part[(k8 * 5 + b) * 64 + col];
            mod[(l * 5 + b) * 6144 + n] = s; }
        __syncthreads();
    }
}

__device__ __forceinline__ void row_load(const float* p, int lane, f32x4 (&v)[4]) {
#pragma unroll
    for (int j = 0; j < 4; ++j) v[j] = *(const f32x4*)(p + 4 * lane + 256 * j);
}
__device__ __forceinline__ void row_load_bf16(const float* p, int lane, f32x4 (&v)[4]) {
#pragma unroll
    for (int j = 0; j < 4; ++j) { const u32x2 w = *(const u32x2*)((const bf16_t*)p + 4 * lane + 256 * j); v[j] = (f32x4){bflo(w.x), bfhi(w.x), bflo(w.y), bfhi(w.y)}; }
}
__device__ __forceinline__ void row_store(float* p, int lane, const f32x4 (&v)[4]) {
#pragma unroll
    for (int j = 0; j < 4; ++j) *(f32x4*)(p + 4 * lane + 256 * j) = v[j];
}
__device__ __forceinline__ void row_ln(f32x4 (&v)[4]) {
    float s = 0.f;
#pragma unroll
    for (int j = 0; j < 4; ++j) s += (v[j][0] + v[j][1]) + (v[j][2] + v[j][3]);
    const float mean = wave_sum(s) * (1.f / DM); float q = 0.f;
#pragma unroll
    for (int j = 0; j < 4; ++j) { v[j] = v[j] - mean; q += (v[j][0] * v[j][0] + v[j][1] * v[j][1]) + (v[j][2] * v[j][2] + v[j][3] * v[j][3]); }
    const float rstd = __builtin_amdgcn_rsqf(wave_sum(q) * (1.f / DM) + LN_EPS);
#pragma unroll
    for (int j = 0; j < 4; ++j) v[j] = v[j] * rstd;
}
__device__ __forceinline__ void row_affine(f32x4 (&v)[4], const float* scale1p  , bool plus1, const float* shift, int lane) {
#pragma unroll
    for (int j = 0; j < 4; ++j) { const f32x4 sc = *(const f32x4*)(scale1p + 4 * lane + 256 * j), sh = *(const f32x4*)(shift + 4 * lane + 256 * j);
        v[j] = plus1 ? v[j] * (sc + 1.0f) + sh : v[j] * sc + sh; }
}
__device__ __forceinline__ void row_store_bf16(bf16_t* p, int lane, const f32x4 (&v)[4]) {
#pragma unroll
    for (int j = 0; j < 4; ++j) { u32x2 w; w.x = pk2(v[j][0], v[j][1]); w.y = pk2(v[j][2], v[j][3]); *(u32x2*)(p + 4 * lane + 256 * j) = w; }
}

__device__ __forceinline__ void phase_rows0(const Frame& F, CArgsP a) {
    const float* mod = (const float*)(F.ws + WS_MOD); float* xc = (float*)(F.ws + WS_XC); bf16_t* H = (bf16_t*)(F.ws + WS_H);
    for (int tok = F.gw; tok < T; tok += F.NGW) {
        const int b = tok / TPB, j = tok - b * TPB; const bool isc = j < CTX;
        const float* src = isc ? a->in[2] + (size_t)(b * CTX + j) * DM : a->in[0] + (size_t)(b * SEQ + j - CTX) * DM;
        f32x4 v[4]; row_load(src, F.lane, v);
        row_store_bf16((bf16_t*)resid_row(F.out, xc, tok), F.lane, v);
        row_ln(v);
        const float* mrow = mod + (isc ? 4 : b) * 6144;
        row_affine(v, mrow + 1024, true, mrow, F.lane);
        row_store_bf16(H + (size_t)tok * DM, F.lane, v);
    }
}

__device__ __forceinline__ void sg_item(const Frame& F, CArgsP a, int l, int chunk, int g) {
    LAS bf16_t* vgT = (LAS bf16_t*)F.lds;
    const bf16_t* Sb = (const bf16_t*)(F.ws + OV_S); const bf16_t* Ub = (const bf16_t*)(F.ws + OV_U); bf16_t* OB = (bf16_t*)(F.ws + OV_OB);
    const int tok0 = chunk * 128;
    { const int q = F.tid >> 2, qt = F.tid & 3;
      const bf16_t* sp = Sb + (size_t)(tok0 + q) * 512 + g * 128 + qt * 32;
      float x[32];
#pragma unroll
      for (int i = 0; i < 4; ++i) { const u32x4 w = *(const u32x4*)(sp + 8 * i);
          x[8 * i + 0] = gelu_tanh(bflo(w.x)); x[8 * i + 1] = gelu_tanh(bfhi(w.x)); x[8 * i + 2] = gelu_tanh(bflo(w.y)); x[8 * i + 3] = gelu_tanh(bfhi(w.y)); x[8 * i + 4] = gelu_tanh(bflo(w.z)); x[8 * i + 5] = gelu_tanh(bfhi(w.z)); x[8 * i + 6] = gelu_tanh(bflo(w.w)); x[8 * i + 7] = gelu_tanh(bfhi(w.w)); }
      float s = 0.f;
#pragma unroll
      for (int i = 0; i < 32; ++i) s += x[i];
      s += __shfl_xor(s, 1); s += __shfl_xor(s, 2); const float mean = s * (1.f / 128.f); float qq = 0.f;
#pragma unroll
      for (int i = 0; i < 32; ++i) { x[i] -= mean; qq += x[i] * x[i]; }
      qq += __shfl_xor(qq, 1); qq += __shfl_xor(qq, 2); const float rstd = 1.f / sqrtf(qq * (1.f / 128.f) + LN_EPS);
      const float* lg = a->in[13] + l * 512 + g * 128 + qt * 32; const float* lb = a->in[14] + l * 512 + g * 128 + qt * 32;
#pragma unroll
      for (int i = 0; i < 32; ++i) vgT[(qt * 32 + i) * 136 + q] = (bf16_t)f2bf(x[i] * rstd * lg[i] + lb[i]);
    }
    __syncthreads();
    const int w = F.wave, fr = F.lane & 15, fq = F.lane >> 4;
    bf16x8 af[4];
#pragma unroll
    for (int ks = 0; ks < 4; ++ks) af[ks] = *(const LAS bf16x8*)(vgT + (w * 16 + fr) * 136 + ks * 32 + fq * 8);
    const bf16_t* W = (const bf16_t*)(F.ws + WS_WSG) + (size_t)(l * 4 + g) * 16384;
    const float* bs = a->in[16] + (l * 4 + g) * 128;
#pragma unroll 2
    for (int n = 0; n < 8; ++n) {
        f32x4 d = {0.f, 0.f, 0.f, 0.f};
#pragma unroll
        for (int ks = 0; ks < 4; ++ks) { const bf16x8 bfv = *(const bf16x8*)(W + (n * 16 + fr) * 128 + ks * 32 + fq * 8); d = __builtin_amdgcn_mfma_f32_16x16x32_bf16(af[ks], bfv, d, 0, 0, 0); }
        const int p = n * 16 + fr, c0 = w * 16 + fq * 4; const float bsp = bs[p];
        const size_t off = (size_t)(tok0 + p) * 512 + g * 128 + c0;
        const u32x2 uu = *(const u32x2*)(Ub + off);
        u32x2 o; o.x = pk2(gelu_tanh(bflo(uu.x)) * (d[0] + bsp), gelu_tanh(bfhi(uu.x)) * (d[1] + bsp)); o.y = pk2(gelu_tanh(bflo(uu.y)) * (d[2] + bsp), gelu_tanh(bfhi(uu.y)) * (d[3] + bsp));
        *(u32x2*)(OB + off) = o;
    }
    __syncthreads();
}

template <bool REV>
__device__ __forceinline__ void lru_scan(const f32x4 (&av)[4], const f32x4 (&bv)[4], f32x4 (&hv)[4], int lane, int mode, float hin, float& sumA, float& sumH) {
#define LRU_MI(k) (REV ? 3 - (k) : (k))
    const int fr = lane & 15, fq = lane >> 4, q = REV ? 3 - fq : fq;
    const int s1 = REV ? lane + 16 : lane - 16, s2 = REV ? lane + 32 : lane - 32, st = REV ? fr : 48 + fr;
    float Ea[4], Eh[4], Ta[4], Th[4];
#pragma unroll
    for (int m = 0; m < 4; ++m) {
        float A = 1.f, H = 0.f;
#pragma unroll
        for (int rk = 0; rk < 4; ++rk) { const int r = LRU_MI(rk); H = av[m][r] * H + bv[m][r]; A *= av[m][r]; }
        float pa = __shfl(A, s1), ph = __shfl(H, s1); if (q >= 1) { H = A * ph + H; A *= pa; }
        pa = __shfl(A, s2); ph = __shfl(H, s2); if (q >= 2) { H = A * ph + H; A *= pa; }
        float ea = __shfl(A, s1), eh = __shfl(H, s1); if (q == 0) { ea = 1.f; eh = 0.f; }
        Ea[m] = ea; Eh[m] = eh; Ta[m] = __shfl(A, st); Th[m] = __shfl(H, st);
    }
    if (mode == 0) {
        float A = 1.f, H = 0.f;
#pragma unroll
        for (int mk = 0; mk < 4; ++mk) { const int m = LRU_MI(mk); H = Ta[m] * H + Th[m]; A *= Ta[m]; }
        sumA = A; sumH = H;
    } else {
        float S = hin;
#pragma unroll
        for (int mk = 0; mk < 4; ++mk) { const int m = LRU_MI(mk); float h = Ea[m] * S + Eh[m];
#pragma unroll
            for (int rk = 0; rk < 4; ++rk) { const int r = LRU_MI(rk); h = av[m][r] * h + bv[m][r]; hv[m][r] = h; }
            S = Ta[m] * S + Th[m]; }
    }
#undef LRU_MI
}
struct LruConst { f32x4 cw[4][2]; f32x4 cbias[2]; bf16x8 wa0, wa1, wx0, wx1; float ba, bx, sp; };
struct LruIn { u32x4 x[4]; u32x4 y; float hin; };
__device__ __forceinline__ void lru_load_const(const Frame& F, CArgsP a, int l, int cb, LruConst& c) {
    const int lane = F.lane, fr = lane & 15, fq = lane >> 4, d = F.wave >> 2, nt = F.wave & 3, ch0 = cb * 64, c8 = (F.tid & 7) * 8;
    const bf16_t* Wa = (const bf16_t*)(F.ws + WS_WLRU) + (size_t)((l * 4 + d * 2) * 8 + cb) * 4096 + (nt * 16 + fr) * 64 + fq * 8;
    c.wa0 = *(const bf16x8*)(Wa); c.wa1 = *(const bf16x8*)(Wa + 32); c.wx0 = *(const bf16x8*)(Wa + 8 * 4096); c.wx1 = *(const bf16x8*)(Wa + 8 * 4096 + 32);
    const int pidx = (l * 2 + d) * 512 + ch0 + nt * 16 + fr;
    c.ba = a->in[20][pidx]; c.bx = a->in[22][pidx]; c.sp = log1pf(expf(-a->in[23][pidx]));
#pragma unroll
    for (int jj = 0; jj < 4; ++jj) { c.cw[jj][0] = *(const f32x4*)(a->in[17] + l * 2048 + jj * 512 + ch0 + c8); c.cw[jj][1] = *(const f32x4*)(a->in[17] + l * 2048 + jj * 512 + ch0 + c8 + 4); }
    c.cbias[0] = *(const f32x4*)(a->in[18] + l * 512 + ch0 + c8); c.cbias[1] = *(const f32x4*)(a->in[18] + l * 512 + ch0 + c8 + 4);
}
__device__ __forceinline__ void lru_load_in(const Frame& F, int b, int chunk, int cb, int mode, LruIn& in) {
    const bf16_t* Xb = (const bf16_t*)(F.ws + OV_X); const bf16_t* Yb = (const bf16_t*)(F.ws + OV_Y);
    const int ch0 = cb * 64, ct = F.tid >> 3, c8 = (F.tid & 7) * 8, d = F.wave >> 2, ch = (F.wave & 3) * 16 + (F.lane & 15);
    const int seg_lo = chunk < 4 ? 0 : 256, seg_hi = chunk < 4 ? 256 : TPB, j0 = chunk * 64;
#pragma unroll
    for (int jj = 0; jj < 4; ++jj) { const int j = j0 + ct + jj - 2; in.x[jj] = (u32x4){0u, 0u, 0u, 0u}; if (j >= seg_lo && j < seg_hi) in.x[jj] = *(const u32x4*)(Xb + (size_t)(b * TPB + j) * 512 + ch0 + c8); }
    in.y = (u32x4){0u, 0u, 0u, 0u}; in.hin = 0.f;
    if (mode == 1) { in.y = *(const u32x4*)(Yb + (size_t)(b * TPB + j0 + ct) * 512 + ch0 + c8); in.hin = ((const float*)(F.ws + WS_HIN))[(size_t)((b * 2 + d) * 68 + chunk) * 512 + ch0 + ch]; }
}
__device__ __forceinline__ void lru_compute(const Frame& F, const LruConst& c, const LruIn& in, int b, int chunk, int cb, int mode) {
    LAS float* xs = (LAS float*)F.lds;
    LAS bf16_t* xsb = (LAS bf16_t*)(F.lds + 16384);
    LAS float* hx = (LAS float*)(F.lds + 25600);
    bf16_t* OC = (bf16_t*)(F.ws + OV_OC);
    const int tok0 = b * TPB + chunk * 64, ch0 = cb * 64;
    const int lane = F.lane, fr = lane & 15, fq = lane >> 4, d = F.wave >> 2, nt = F.wave & 3, ch = nt * 16 + fr;
    const int ct = F.tid >> 3, c8 = (F.tid & 7) * 8;
    {
      f32x4 a0 = c.cbias[0], a1 = c.cbias[1];
#pragma unroll
      for (int jj = 0; jj < 4; ++jj) { const u32x4 w = in.x[jj];
          a0 += c.cw[jj][0] * (f32x4){bflo(w.x), bfhi(w.x), bflo(w.y), bfhi(w.y)}; a1 += c.cw[jj][1] * (f32x4){bflo(w.z), bfhi(w.z), bflo(w.w), bfhi(w.w)}; }
      *(LAS f32x4*)(xs + ct * 64 + c8) = a0; *(LAS f32x4*)(xs + ct * 64 + c8 + 4) = a1;
      u32x4 pw; pw.x = pk2(a0[0], a0[1]); pw.y = pk2(a0[2], a0[3]); pw.z = pk2(a1[0], a1[1]); pw.w = pk2(a1[2], a1[3]);
      *(LAS u32x4*)(xsb + ct * 72 + c8) = pw; }
    __syncthreads();
    f32x4 av[4], bv[4], hv[4];
#pragma unroll
    for (int m = 0; m < 4; ++m) {
        const bf16x8 a0 = *(const LAS bf16x8*)(xsb + (m * 16 + fr) * 72 + fq * 8), a1 = *(const LAS bf16x8*)(xsb + (m * 16 + fr) * 72 + 32 + fq * 8);
        f32x4 da = {0.f, 0.f, 0.f, 0.f}, dx = {0.f, 0.f, 0.f, 0.f};
        da = __builtin_amdgcn_mfma_f32_16x16x32_bf16(a0, c.wa0, da, 0, 0, 0); da = __builtin_amdgcn_mfma_f32_16x16x32_bf16(a1, c.wa1, da, 0, 0, 0);
        dx = __builtin_amdgcn_mfma_f32_16x16x32_bf16(a0, c.wx0, dx, 0, 0, 0); dx = __builtin_amdgcn_mfma_f32_16x16x32_bf16(a1, c.wx1, dx, 0, 0, 0);
#pragma unroll
        for (int r = 0; r < 4; ++r) { const float rg = sigmoidf_(da[r] + c.ba), ig = sigmoidf_(dx[r] + c.bx); const float la = -8.0f * rg * c.sp;
            const float e1 = expm1_fast(la);
            av[m][r] = 1.0f + e1; bv[m][r] = __builtin_amdgcn_sqrtf(-e1 * (2.0f + e1)) * (ig * xs[(m * 16 + fq * 4 + r) * 64 + ch]); hv[m][r] = 0.f; }
    }
    float sumA = 1.f, sumH = 0.f;
    if (d == 0) lru_scan<false>(av, bv, hv, lane, mode, in.hin, sumA, sumH); else lru_scan<true>(av, bv, hv, lane, mode, in.hin, sumA, sumH);
    if (mode == 0) {
        if (fq == 0) { float* sum = (float*)(F.ws + WS_SUM) + ((size_t)((b * 2 + d) * 68 + chunk) * 512 + ch0 + ch) * 2; *(float2*)sum = make_float2(sumA, sumH); }
        __syncthreads();
        return;
    }
#pragma unroll
    for (int m = 0; m < 4; ++m)
#pragma unroll
        for (int r = 0; r < 4; ++r) hx[d * 4096 + (m * 16 + fq * 4 + r) * 64 + ch] = hv[m][r];
    __syncthreads();
    { const u32x4 yv = in.y;
      const f32x4 f0 = *(const LAS f32x4*)(hx + ct * 64 + c8), f1 = *(const LAS f32x4*)(hx + ct * 64 + c8 + 4), g0 = *(const LAS f32x4*)(hx + 4096 + ct * 64 + c8), g1 = *(const LAS f32x4*)(hx + 4096 + ct * 64 + c8 + 4);
      u32x4 o; o.x = pk2(gelu_tanh(bflo(yv.x)) * (f0[0] + g0[0]), gelu_tanh(bfhi(yv.x)) * (f0[1] + g0[1])); o.y = pk2(gelu_tanh(bflo(yv.y)) * (f0[2] + g0[2]), gelu_tanh(bfhi(yv.y)) * (f0[3] + g0[3]));
      o.z = pk2(gelu_tanh(bflo(yv.z)) * (f1[0] + g1[0]), gelu_tanh(bfhi(yv.z)) * (f1[1] + g1[1])); o.w = pk2(gelu_tanh(bflo(yv.w)) * (f1[2] + g1[2]), gelu_tanh(bfhi(yv.w)) * (f1[3] + g1[3]));
      *(u32x4*)(OC + (size_t)(tok0 + ct) * 512 + ch0 + c8) = o; }
}
__device__ __forceinline__ void lru_phase(const Frame& F, CArgsP a, int l, int mode, bool skip_ctx) {
    constexpr int NIT = 4 * 68 * 8;
    int it = F.bid;
    while (it < NIT && skip_ctx && ((it >> 3) % 68) < 4) it += F.G;
    if (it >= NIT) return;
    LruConst c; LruIn cur, nxt;
    int cb = it & 7; lru_load_const(F, a, l, cb, c);
    lru_load_in(F, (it >> 3) / 68, (it >> 3) % 68, cb, mode, cur);
    for (;;) {
        int nit = it + F.G;
        while (nit < NIT && skip_ctx && ((nit >> 3) % 68) < 4) nit += F.G;
        const bool has = nit < NIT;
        if (has) lru_load_in(F, (nit >> 3) / 68, (nit >> 3) % 68, nit & 7, mode, nxt);
        lru_compute(F, c, cur, (it >> 3) / 68, (it >> 3) % 68, cb, mode);
        if (!has) break;
        if ((nit & 7) != cb) { cb = nit & 7; lru_load_const(F, a, l, cb, c); }
        it = nit; cur = nxt;
    }
}

__device__ __forceinline__ void phase_carry(const Frame& F) {
    const int gt = F.bid * NTHR + F.tid; if (gt >= 4 * 2 * 512) return;
    const int c = gt & 511, d = (gt >> 9) & 1, b = gt >> 10;
    const float* sum = (const float*)(F.ws + WS_SUM) + (size_t)((b * 2 + d) * 68) * 1024 + c * 2;
    float* hin = (float*)(F.ws + WS_HIN) + (size_t)((b * 2 + d) * 68) * 512 + c;
    float h = 0.f;
#pragma unroll 1
    for (int g0 = 0; g0 < 68; g0 += 17) {
        float A[17], Hh[17];
#pragma unroll
        for (int i = 0; i < 17; ++i) { const int o = g0 + i; const int ck = d == 0 ? o : (o < 4 ? 3 - o : 71 - o); const float2 v = *(const float2*)(sum + (size_t)ck * 1024); A[i] = v.x; Hh[i] = v.y; }
#pragma unroll
        for (int i = 0; i < 17; ++i) { const int o = g0 + i; const int ck = d == 0 ? o : (o < 4 ? 3 - o : 71 - o); hin[(size_t)ck * 512] = h; h = A[i] * h + Hh[i]; }
    }
}

constexpr int AT_KST = 272, AT_VST = 320;
constexpr int AT_KOFF = 0, AT_VOFF = 2 * 64 * AT_KST, AT_XOFF = AT_VOFF + 2 * 64 * AT_VST;
#define AT_SBAR() __builtin_amdgcn_sched_barrier(0)
struct AttnState { f32x16 o[4]; f32x16 negm; bf16x8 pfp[4]; float lrun; };
#define AT_PIN1(x) asm volatile("" : "+v"(x))
__device__ __forceinline__ float at_max3(float a, float b, float c) { float r; asm("v_max3_f32 %0, %1, %2, %3" : "=v"(r) : "v"(a), "v"(b), "v"(c)); return r; }
__device__ __forceinline__ bf16x8 at_vfrag(const LAS unsigned char* vp) {
    const s16x4 lo = __builtin_bit_cast(s16x4, __builtin_amdgcn_ds_read_tr16_b64_v4i16((LAS s16x4*)(vp)));
    const s16x4 hh = __builtin_bit_cast(s16x4, __builtin_amdgcn_ds_read_tr16_b64_v4i16((LAS s16x4*)(vp + 8 * AT_VST)));
    return (bf16x8){lo[0], lo[1], lo[2], lo[3], hh[0], hh[1], hh[2], hh[3]};
}
__device__ __forceinline__ float attn_stage1(const AttnState& st, const f32x16& p0, const f32x16& p1, f32x16& n0, f32x16& n1, const LAS unsigned char* ql, const LAS unsigned char* kf) {
    float mx = at_max3(p0[0], p0[1], at_max3(p1[0], p1[1], p1[1]));
    bf16x8 a0 = *(const LAS bf16x8*)(kf), a1 = *(const LAS bf16x8*)(kf + 32 * AT_KST), q = *(const LAS bf16x8*)(ql);
    AT_SBAR();
#pragma unroll
    for (int ks = 0; ks < 4; ++ks) {
        bf16x8 b0 = a0, b1 = a1, qn = q;
        if (ks < 3) { b0 = *(const LAS bf16x8*)(kf + (ks + 1) * 32); b1 = *(const LAS bf16x8*)(kf + 32 * AT_KST + (ks + 1) * 32); qn = *(const LAS bf16x8*)(ql + (ks + 1) * 1024); }
        if (ks == 0) n0 = __builtin_amdgcn_mfma_f32_32x32x16_bf16(a0, q, st.negm, 0, 0, 0);
        else n0 = __builtin_amdgcn_mfma_f32_32x32x16_bf16(a0, q, n0, 0, 0, 0);
        mx = at_max3(at_max3(mx, p0[4 * ks + 2], p0[4 * ks + 3]), p1[4 * ks + 2], p1[4 * ks + 3]); AT_PIN1(mx); AT_SBAR();
        if (ks == 0) n1 = __builtin_amdgcn_mfma_f32_32x32x16_bf16(a1, q, st.negm, 0, 0, 0);
        else n1 = __builtin_amdgcn_mfma_f32_32x32x16_bf16(a1, q, n1, 0, 0, 0);
        if (ks < 3) { mx = at_max3(at_max3(mx, p0[4 * ks + 4], p0[4 * ks + 5]), p1[4 * ks + 4], p1[4 * ks + 5]); AT_PIN1(mx); } AT_SBAR();
        a0 = b0; a1 = b1; q = qn;
    }
    return mx;
}
template <bool FIRST>
__device__ __forceinline__ void attn_stage2(AttnState& st, f32x16& p0, f32x16& p1, f32x16& n0, f32x16& n1, float mx, const LAS unsigned char* vf) {
    constexpr float THR = 8.0f;
    bf16x8 vcur, vnx; if (!FIRST) { vcur = at_vfrag(vf); vnx = at_vfrag(vf + 64); }
    float tm; { auto rr = __builtin_amdgcn_permlane32_swap(__float_as_uint(mx), __float_as_uint(mx), false, false); tm = fmaxf(__uint_as_float(rr[0]), __uint_as_float(rr[1])); }
    if (FIRST || __any(tm > THR)) {
        const float dl = FIRST ? tm : fmaxf(tm, 0.f);
#pragma unroll
        for (int r = 0; r < 16; ++r) { p0[r] -= dl; p1[r] -= dl; n0[r] -= dl; n1[r] -= dl; st.negm[r] -= dl; }
        if (!FIRST) {
            const float al = __builtin_amdgcn_exp2f(-dl);
#pragma unroll
            for (int db = 0; db < 4; ++db)
#pragma unroll
                for (int r = 0; r < 16; ++r) st.o[db][r] *= al;
#pragma unroll
            for (int kk = 0; kk < 4; ++kk) { u32x4 w = __builtin_bit_cast(u32x4, st.pfp[kk]);
                w.x = pk2(bflo(w.x) * al, bfhi(w.x) * al); w.y = pk2(bflo(w.y) * al, bfhi(w.y) * al); w.z = pk2(bflo(w.z) * al, bfhi(w.z) * al); w.w = pk2(bflo(w.w) * al, bfhi(w.w) * al);
                st.pfp[kk] = __builtin_bit_cast(bf16x8, w); }
            st.lrun *= al;
        }
    }
    float ls = 0.f;
    AT_SBAR();
#pragma unroll
    for (int kk = 0; kk < 4; ++kk) {
        unsigned pw0 = 0, pw1 = 0, pw2 = 0, pw3 = 0;
#pragma unroll
        for (int db = 0; db < 4; ++db) {
            const int g = kk * 4 + db;
            if (!FIRST) {
                bf16x8 vn2 = vnx;
                if (g < 14) { const int g2 = g + 2; vn2 = at_vfrag(vf + ((g2 >> 2) * 16) * AT_VST + (g2 & 3) * 64); }
                st.o[db] = __builtin_amdgcn_mfma_f32_32x32x16_bf16(vcur, st.pfp[kk], st.o[db], 0, 0, 0);
                vcur = vnx; vnx = vn2;
            }
            const float x0 = g < 8 ? p0[2 * g] : p1[2 * g - 16], x1 = g < 8 ? p0[2 * g + 1] : p1[2 * g - 15];
            const float e0 = __builtin_amdgcn_exp2f(x0), e1 = __builtin_amdgcn_exp2f(x1);
            ls += e0 + e1; unsigned w = pk2(e0, e1); AT_PIN1(ls); AT_PIN1(w);
            if (db == 0) pw0 = w; else if (db == 1) pw1 = w; else if (db == 2) pw2 = w; else pw3 = w;
            AT_SBAR();
        }
        st.pfp[kk] = __builtin_bit_cast(bf16x8, (u32x4){pw0, pw1, pw2, pw3});
    }
    st.lrun += ls;
}
__device__ __forceinline__ void attn_unit(const Frame& F, int tokq0, int tokk0, int ntiles, int h, float lam, const float* gain, float oscale) {
    const bf16_t* Q = (const bf16_t*)(F.ws + OV_Q); const char* Kg = (const char*)(F.ws + OV_K); const char* Vg = (const char*)(F.ws + OV_V); bf16_t* OA = (bf16_t*)(F.ws + OV_OA);
    const int lane = F.lane, r32 = lane & 31, hi = lane >> 5, rb = F.wave >> 1, c = F.wave & 1;
    LAS unsigned char* ql = F.lds + AT_XOFF + F.wave * 4096 + lane * 16;
    { const bf16_t* qp = Q + (size_t)(tokq0 + rb * 32 + r32) * 512 + h * 128 + c * 64 + hi * 8;
#pragma unroll
      for (int ks = 0; ks < 4; ++ks) *(LAS bf16x8*)(ql + ks * 1024) = *(const bf16x8*)(qp + ks * 16); }
    const int srow0 = F.tid >> 4, sch = F.tid & 15;
    const unsigned goff = (unsigned)(((tokk0 + srow0) * 512 + h * 128 + sch * 8) * 2);
    LAS unsigned char* kl = F.lds + AT_KOFF + srow0 * AT_KST + sch * 16;
    LAS unsigned char* vl = F.lds + AT_VOFF + srow0 * AT_VST + sch * 16;
    const LAS unsigned char* kfb = F.lds + AT_KOFF + r32 * AT_KST + (c * 64 + hi * 8) * 2;
    const LAS unsigned char* vfb = F.lds + AT_VOFF + (4 * hi + ((lane & 15) >> 2)) * AT_VST + (((lane >> 4) & 1) * 16 + (lane & 3) * 4) * 2;
    {
      const u32x4 k0 = *(const u32x4*)(Kg + goff), k1 = *(const u32x4*)(Kg + goff + 32 * 1024), k2 = *(const u32x4*)(Kg + goff + 64 * 1024), k3 = *(const u32x4*)(Kg + goff + 96 * 1024);
      *(LAS u32x4*)(kl) = k0; *(LAS u32x4*)(kl + 32 * AT_KST) = k1; *(LAS u32x4*)(kl + 64 * AT_KST) = k2; *(LAS u32x4*)(kl + 96 * AT_KST) = k3; }
    __syncthreads();
    AttnState st; st.lrun = 0.f;
#pragma unroll
    for (int r = 0; r < 16; ++r) st.negm[r] = 0.f;
#pragma unroll
    for (int db = 0; db < 4; ++db)
#pragma unroll
        for (int r = 0; r < 16; ++r) st.o[db][r] = 0.f;
    f32x16 pa0, pa1, pb0, pb1;
#pragma unroll
    for (int r = 0; r < 16; ++r) { pa0[r] = 0.f; pa1[r] = 0.f; }
#pragma unroll
    for (int ks = 0; ks < 4; ++ks) {
        const bf16x8 a0 = *(const LAS bf16x8*)(kfb + ks * 32), a1 = *(const LAS bf16x8*)(kfb + 32 * AT_KST + ks * 32);
        const bf16x8 q = *(const LAS bf16x8*)(ql + ks * 1024);
        pa0 = __builtin_amdgcn_mfma_f32_32x32x16_bf16(a0, q, pa0, 0, 0, 0); pa1 = __builtin_amdgcn_mfma_f32_32x32x16_bf16(a1, q, pa1, 0, 0, 0);
    }
    asm volatile("s_nop 15\n\ts_nop 7" : "+v"(pa0), "+v"(pa1));
    u32x4 sv0 = *(const u32x4*)(Vg + goff), sv1 = *(const u32x4*)(Vg + goff + 32 * 1024);
#define AT_ITER(I, FIRSTF, PC0, PC1, PN0, PN1) do { \
        const int i_ = (I); const bool ldk_ = i_ + 2 < ntiles; const int sl_ = i_ & 1; \
        const float mx_ = attn_stage1(st, PC0, PC1, PN0, PN1, ql, kfb + ((i_ + 1) & 1) * (64 * AT_KST)); \
        *(LAS u32x4*)(vl + sl_ * (64 * AT_VST)) = sv0; *(LAS u32x4*)(vl + sl_ * (64 * AT_VST) + 32 * AT_VST) = sv1; \
        u32x4 sk0_, sk1_; if (ldk_) { const unsigned go_ = goff + (unsigned)(i_ + 2) * 65536u; sk0_ = *(const u32x4*)(Kg + go_); sk1_ = *(const u32x4*)(Kg + go_ + 32 * 1024); } \
        attn_stage2<FIRSTF>(st, PC0, PC1, PN0, PN1, mx_, vfb + ((i_ + 1) & 1) * (64 * AT_VST)); \
        if (ldk_) { *(LAS u32x4*)(kl + sl_ * (64 * AT_KST)) = sk0_; *(LAS u32x4*)(kl + sl_ * (64 * AT_KST) + 32 * AT_KST) = sk1_; } \
        if (i_ + 1 < ntiles) { const unsigned gv_ = goff + (unsigned)(i_ + 1) * 65536u; sv0 = *(const u32x4*)(Vg + gv_); sv1 = *(const u32x4*)(Vg + gv_ + 32 * 1024); } \
        __syncthreads(); } while (0)
    AT_ITER(0, true, pa0, pa1, pb0, pb1);
    AT_ITER(1, false, pb0, pb1, pa0, pa1);
#pragma unroll 1
    for (int i = 2; i < ntiles; i += 2) {
        AT_ITER(i, false, pa0, pa1, pb0, pb1);
        AT_ITER(i + 1, false, pb0, pb1, pa0, pa1);
    }
#undef AT_ITER
    {
      const LAS unsigned char* vf = vfb + ((ntiles - 1) & 1) * (64 * AT_VST);
#pragma unroll
      for (int db = 0; db < 4; ++db)
#pragma unroll
          for (int kk = 0; kk < 4; ++kk) {
              const LAS unsigned char* vp = vf + (kk * 16) * AT_VST + db * 64;
              const s16x4 lo = __builtin_bit_cast(s16x4, __builtin_amdgcn_ds_read_tr16_b64_v4i16((LAS s16x4*)(vp)));
              const s16x4 hh = __builtin_bit_cast(s16x4, __builtin_amdgcn_ds_read_tr16_b64_v4i16((LAS s16x4*)(vp + 8 * AT_VST)));
              const bf16x8 vfr = {lo[0], lo[1], lo[2], lo[3], hh[0], hh[1], hh[2], hh[3]};
              st.o[db] = __builtin_amdgcn_mfma_f32_32x32x16_bf16(vfr, st.pfp[kk], st.o[db], 0, 0, 0);
          } }
    float lrun = st.lrun; lrun += __shfl_xor(lrun, 32);
    const float il = 1.f / lrun;
    LAS float* ex = (LAS float*)(F.lds + AT_XOFF) + rb * 4096;
    if (c == 1) {
#pragma unroll
        for (int db = 0; db < 4; ++db)
#pragma unroll
            for (int r = 0; r < 16; ++r) ex[(db * 16 + r) * 64 + lane] = st.o[db][r] * il;
    }
    __syncthreads();
    if (c == 0) {
        float ss = 0.f;
#pragma unroll
        for (int db = 0; db < 4; ++db)
#pragma unroll
            for (int r = 0; r < 16; ++r) { const float dv = st.o[db][r] * il - lam * ex[(db * 16 + r) * 64 + lane]; st.o[db][r] = dv; ss += dv * dv; }
        ss += __shfl_xor(ss, 32);
        const float rinv = oscale / sqrtf(ss * (1.f / 128.f) + RMS_EPS);
        bf16_t* op = OA + (size_t)(tokq0 + rb * 32 + r32) * 512 + h * 128;
#pragma unroll
        for (int db = 0; db < 4; ++db)
#pragma unroll
            for (int r4 = 0; r4 < 4; ++r4) { const int dv0 = db * 32 + 8 * r4 + 4 * hi; const f32x4 gv = *(const f32x4*)(gain + dv0);
                u32x2 w; w.x = pk2(st.o[db][4 * r4] * rinv * gv[0], st.o[db][4 * r4 + 1] * rinv * gv[1]); w.y = pk2(st.o[db][4 * r4 + 2] * rinv * gv[2], st.o[db][4 * r4 + 3] * rinv * gv[3]);
                *(u32x2*)(op + dv0) = w; }
    }
    __syncthreads();
}

__device__ __forceinline__ void phase_attn(const Frame& F, CArgsP a, int l) {
    const float lam = ((const float*)(F.ws + WS_LAM))[l]; const float li = 0.8f - 0.6f * expf(-0.3f * (float)l);
    for (int dd = 0; dd < NDUP(6); ++dd) lru_phase(F, a, l, 1, l == 1);
    __syncthreads();
    const int nlat = 4 * 4 * 32, nctx = (l == 0) ? 4 * 4 * 2 : 0;
    for (int dd = 0; dd < NDUP(7); ++dd)
    for (int it = F.vcu; it < nlat + nctx; it += F.G) {
        int b, h, qb, tq0, nt;
        if (it < nlat) { qb = it & 31; h = (it >> 5) & 3; b = it >> 7; tq0 = b * TPB + CTX + qb * 128; nt = 68; }
        else { const int i2 = it - nlat; qb = i2 & 1; h = (i2 >> 1) & 3; b = i2 >> 3; tq0 = b * TPB + qb * 128; nt = 4; }
        attn_unit(F, tq0, b * TPB, nt, h, lam, a->in[12] + (l * 4 + h) * 128, 1.0f - li);
    }
}

__device__ __forceinline__ void mini_tile(const bf16_t* A, int lda, const bf16_t* Bt, int K, int lane, int wave, f32x4 (&acc)[2]) {
    const int fr = lane & 15, fq = lane >> 4;
    const bf16_t* ap = A + (size_t)((wave >> 1) * 16 + fr) * lda + fq * 8;
    const bf16_t* bp0 = Bt + (size_t)((wave & 1) * 32 + fr) * K + fq * 8; const bf16_t* bp1 = bp0 + (size_t)16 * K;
    acc[0] = (f32x4){0.f, 0.f, 0.f, 0.f}; acc[1] = (f32x4){0.f, 0.f, 0.f, 0.f};
#pragma unroll 8
    for (int k = 0; k < K; k += 32) {
        const bf16x8 av = *(const bf16x8*)(ap + k), b0 = *(const bf16x8*)(bp0 + k), b1 = *(const bf16x8*)(bp1 + k);
        acc[0] = __builtin_amdgcn_mfma_f32_16x16x32_bf16(b0, av, acc[0], 0, 0, 0); acc[1] = __builtin_amdgcn_mfma_f32_16x16x32_bf16(b1, av, acc[1], 0, 0, 0);
    }
}
__device__ __forceinline__ void mini_merge_ctx(const Frame& F, int l) {
    const int fr = F.lane & 15, fq = F.lane >> 4;
    for (int t = F.bid; t < 256; t += F.G) {
        const int rb = t >> 4, cbk = t & 15, cr = rb * 64, tok0 = (cr >> 8) * TPB + (cr & 255), col0 = cbk * 64;
        const int row = tok0 + (F.wave >> 1) * 16 + fr, colw = col0 + (F.wave & 1) * 32 + fq * 4;
        f32x4 mg[2] = {{0.f, 0.f, 0.f, 0.f}, {0.f, 0.f, 0.f, 0.f}};
#pragma unroll 1
        for (int r = 0; r < 3; ++r) {
            f32x4 acc[2];
            mini_tile((const bf16_t*)(F.ws + OV_OA + (size_t)r * 17 * MiB) + (size_t)tok0 * 512, 512, (const bf16_t*)(F.ws + WS_WBR) + (size_t)(l * 3 + r) * 1024 * 512 + (size_t)col0 * 512, 512, F.lane, F.wave, acc);
#pragma unroll
            for (int n = 0; n < 2; ++n) { const u32x2 g = *(const u32x2*)((const bf16_t*)(F.ws + OV_G) + (size_t)row * 3072 + r * 1024 + colw + n * 16);
                mg[n][0] += sigmoidf_(bflo(g.x)) * acc[n][0]; mg[n][1] += sigmoidf_(bfhi(g.x)) * acc[n][1]; mg[n][2] += sigmoidf_(bflo(g.y)) * acc[n][2]; mg[n][3] += sigmoidf_(bfhi(g.y)) * acc[n][3]; }
        }
#pragma unroll
        for (int n = 0; n < 2; ++n) { u32x2 w; w.x = pk2(mg[n][0], mg[n][1]); w.y = pk2(mg[n][2], mg[n][3]); *(u32x2*)((bf16_t*)(F.ws + OV_MG) + (size_t)row * DM + colw + n * 16) = w; }
    }
}
__device__ __forceinline__ void mini_wout_ctx(const Frame& F, int l) {
    const int fr = F.lane & 15, fq = F.lane >> 4;
    const float* g1 = (const float*)(F.ws + WS_MOD) + (l * 5 + 4) * 6144 + 2048;
    for (int t = F.bid; t < 256; t += F.G) {
        const int rb = t >> 4, cbk = t & 15, cr = rb * 64, tok0 = (cr >> 8) * TPB + (cr & 255), col0 = cbk * 64;
        const int crow = cr + (F.wave >> 1) * 16 + fr, colw = col0 + (F.wave & 1) * 32 + fq * 4;
        f32x4 acc[2];
        mini_tile((const bf16_t*)(F.ws + OV_MG) + (size_t)tok0 * DM, DM, (const bf16_t*)(F.ws + WS_WOUT) + (size_t)l * 1048576 + (size_t)col0 * 1024, 1024, F.lane, F.wave, acc);
#pragma unroll
        for (int n = 0; n < 2; ++n) { u32x2* p = (u32x2*)((bf16_t*)((float*)(F.ws + WS_XC) + (size_t)crow * DM) + colw + n * 16); const f32x4 gv = *(const f32x4*)(g1 + colw + n * 16); const u32x2 x = *p;
            u32x2 w; w.x = pk2(bflo(x.x) * DN_ALPHA + gv[0] * acc[n][0], bfhi(x.x) * DN_ALPHA + gv[1] * acc[n][1]); w.y = pk2(bflo(x.y) * DN_ALPHA + gv[2] * acc[n][2], bfhi(x.y) * DN_ALPHA + gv[3] * acc[n][3]); *p = w; }
    }
}

constexpr int RT_AST = 1032;
__device__ __forceinline__ void phase_router(const Frame& F, CArgsP a, int l, bool dry) {
    const float* mod = (const float*)(F.ws + WS_MOD) + l * 5 * 6144; float* xc = (float*)(F.ws + WS_XC); bf16_t* H = (bf16_t*)(F.ws + WS_H);
    LAS bf16_t* AT = (LAS bf16_t*)F.lds;
    LAS float* LG = (LAS float*)(F.lds + 32 * RT_AST * 2);
    LAS unsigned* LC = (LAS unsigned*)(F.lds + 32 * RT_AST * 2 + 8192);
    const bf16_t* Wt = (const bf16_t*)(F.ws + WS_WRT) + (size_t)l * 65536; const float rb_ = a->in[29][l * 64 + F.lane];
    unsigned* cnt = (unsigned*)(F.ws + WS_CNT) + l * 4096; int* list = (int*)(F.ws + WS_LIST);
    int* toke = (int*)(F.ws + WS_TOKE); int* tokp = (int*)(F.ws + WS_TOKP); float* tokw = (float*)(F.ws + WS_TOKW);
    const int nrows = l == 0 ? T : NBATCH * SEQ, nbatch = nrows / 32;
    const int fr = F.lane & 15, fq = F.lane >> 4, mt = F.wave & 1, nt = F.wave >> 1;
    if (F.tid < 64) LC[F.tid] = 0u;
    bf16x8 bfr[32];
    { const bf16_t* bp = Wt + (size_t)(nt * 16 + fr) * 1024 + fq * 8;
#pragma unroll
      for (int ks = 0; ks < 32; ++ks) bfr[ks] = *(const bf16x8*)(bp + ks * 32); }
    for (int bt = F.bid; bt < nbatch; bt += F.G) {
        int toks[4];
#pragma unroll
        for (int r = 0; r < 4; ++r) { const int ridx = bt * 32 + F.wave * 4 + r; toks[r] = l == 0 ? ridx : (ridx >> 12) * TPB + CTX + (ridx & 4095); }
#pragma unroll
        for (int rp = 0; rp < 4; rp += 2) {
        f32x4 vv[2][4];
        row_load_bf16(resid_row(F.out, xc, toks[rp]), F.lane, vv[0]); row_load_bf16(resid_row(F.out, xc, toks[rp + 1]), F.lane, vv[1]);
#pragma unroll
        for (int r2 = 0; r2 < 2; ++r2) { const int r = rp + r2; const int tok = toks[r];
            const int b = tok / TPB; const int bsel = (tok - b * TPB) < CTX ? 4 : b;
            float* xr = resid_row(F.out, xc, tok);
            f32x4 (&v)[4] = vv[r2]; row_ln(v); row_affine(v, a->in[26] + l * DM, false, a->in[27] + l * DM, F.lane);
            row_ln(v); const float* mrow = mod + bsel * 6144; row_affine(v, mrow + 4096, true, mrow + 3072, F.lane);
#pragma unroll
            for (int j = 0; j < 4; ++j) { u32x2 w; w.x = pk2(v[j][0], v[j][1]); w.y = pk2(v[j][2], v[j][3]);
                if (!dry) *(u32x2*)(H + (size_t)tok * DM + 4 * F.lane + 256 * j) = w; *(LAS u32x2*)(AT + (F.wave * 4 + r) * RT_AST + 4 * F.lane + 256 * j) = w; }
        }
        }
        __syncthreads();
        { f32x4 d = {0.f, 0.f, 0.f, 0.f};
          const LAS bf16_t* ap = AT + (mt * 16 + fr) * RT_AST + fq * 8;
#pragma unroll
          for (int ks = 0; ks < 32; ++ks) { const bf16x8 av = *(const LAS bf16x8*)(ap + ks * 32); d = __builtin_amdgcn_mfma_f32_16x16x32_bf16(av, bfr[ks], d, 0, 0, 0); }
#pragma unroll
          for (int r = 0; r < 4; ++r) LG[(mt * 16 + fq * 4 + r) * 64 + nt * 16 + fr] = d[r]; }
        __syncthreads();
        bool selr[4]; int rkr[4], lpr[4]; float wr_[4];
#pragma unroll
        for (int r = 0; r < 4; ++r) {
            const float lg = LG[(F.wave * 4 + r) * 64 + F.lane];
            const float s = sigmoidf_(lg); const float bsc = s + rb_;
            float m1 = bsc; m1 = fmaxf(m1, WS_DPP(m1, 0xB1, 0xF, true)); m1 = fmaxf(m1, WS_DPP(m1, 0x4E, 0xF, true)); m1 = fmaxf(m1, WS_DPP(m1, 0x141, 0xF, true));
            const unsigned long long eq = __ballot(bsc == m1); const unsigned gm = (unsigned)(eq >> (F.lane & ~7)) & 0xffu; const int first = __ffs(gm) - 1;
            float m2 = ((F.lane & 7) == first) ? -INFINITY : bsc; m2 = fmaxf(m2, WS_DPP(m2, 0xB1, 0xF, true)); m2 = fmaxf(m2, WS_DPP(m2, 0x4E, 0xF, true)); m2 = fmaxf(m2, WS_DPP(m2, 0x141, 0xF, true));
            const float gs = m1 + m2; const int myg = F.lane >> 3; int grank = 0;
#pragma unroll
            for (int g = 0; g < 8; ++g) { const float og = __builtin_bit_cast(float, __builtin_amdgcn_readlane(__builtin_bit_cast(int, gs), g * 8)); grank += (int)(og > gs) + (int)((og == gs) & (g < myg)); }
            const bool gsel = grank < 4; const float mk = gsel ? bsc : -INFINITY; int rk = 64;
            { float vv_ = mk;
#pragma unroll
              for (int k = 0; k < 8; ++k) {
                  float m = vv_; m = fmaxf(m, WS_DPP(m, 0xB1, 0xF, true)); m = fmaxf(m, WS_DPP(m, 0x4E, 0xF, true)); m = fmaxf(m, WS_DPP(m, 0x141, 0xF, true)); m = fmaxf(m, WS_DPP(m, 0x140, 0xF, true));
                  const float r1 = __builtin_bit_cast(float, __builtin_amdgcn_readlane(__builtin_bit_cast(int, m), 15)), r2 = __builtin_bit_cast(float, __builtin_amdgcn_readlane(__builtin_bit_cast(int, m), 31)),
                              r3 = __builtin_bit_cast(float, __builtin_amdgcn_readlane(__builtin_bit_cast(int, m), 47)), r4 = __builtin_bit_cast(float, __builtin_amdgcn_readlane(__builtin_bit_cast(int, m), 63));
                  const float wm = fmaxf(fmaxf(r1, r2), fmaxf(r3, r4));
                  const unsigned long long bal = __ballot(vv_ == wm); const int win = __ffsll((long long)bal) - 1;
                  if (F.lane == win) { rk = k; vv_ = -INFINITY; }
              } }
            const bool sel = gsel && rk < 8 && !dry;
            const float ssum = wave_sum((gsel && rk < 8) ? s : 0.f);
            selr[r] = sel; rkr[r] = rk; wr_[r] = s / ssum * 2.5f; lpr[r] = 0;
            if (sel) lpr[r] = (int)__hip_atomic_fetch_add((LAS unsigned*)(LC + F.lane), 1u, __ATOMIC_RELAXED, __HIP_MEMORY_SCOPE_WORKGROUP);
        }
        __syncthreads();
        if (F.tid < 64) { const unsigned n = LC[F.tid]; unsigned base = 0; if (n) base = atomicAdd(cnt + F.tid * 64, n); LC[64 + F.tid] = base; LC[F.tid] = 0u; }
        __syncthreads();
#pragma unroll
        for (int r = 0; r < 4; ++r)
            if (selr[r]) { const int tok = toks[r]; const int pos = (int)LC[64 + F.lane] + lpr[r];
                list[(size_t)F.lane * T + pos] = tok; toke[tok * 8 + rkr[r]] = F.lane; tokp[tok * 8 + rkr[r]] = pos; tokw[tok * 8 + rkr[r]] = wr_[r]; }
        __syncthreads();
    }
}

__device__ __forceinline__ void build_tables(const Frame& F, int l) {
    LAS int* tb = (LAS int*)(F.lds + LDS_CTL);
    __syncthreads();
    if (F.tid < 64) tb[LC_TCNT + F.tid] = (int)__hip_atomic_load((unsigned*)(F.ws + WS_CNT) + l * 4096 + F.tid * 64, __ATOMIC_RELAXED, __HIP_MEMORY_SCOPE_AGENT);
    __syncthreads();
    if (F.tid == 0) { int tbs = 0, sbs = 0;
        for (int e = 0; e < 64; ++e) { const int c = tb[LC_TCNT + e]; tb[LC_TBASE + e] = tbs; tb[LC_SBASE + e] = sbs; tbs += (c + 255) >> 8; sbs += c; }
        tb[LC_TBASE + 64] = tbs; tb[LC_SBASE + 64] = sbs; }
    __syncthreads();
}

__device__ __forceinline__ void phase_combine(const Frame& F, CArgsP a, int l, bool dry) {
    const float* mod = (const float*)(F.ws + WS_MOD) + l * 5 * 6144; float* xc = (float*)(F.ws + WS_XC); bf16_t* H = (bf16_t*)(F.ws + WS_H);
    const unsigned char* YS = (const unsigned char*)(F.ws + OV_YS); const LAS int* tb = (const LAS int*)(F.lds + LDS_CTL);
    const int* toke = (const int*)(F.ws + WS_TOKE); const int* tokp = (const int*)(F.ws + WS_TOKP); const float* tokw = (const float*)(F.ws + WS_TOKW);
    const int nrows = l == 0 ? T : NBATCH * SEQ;
    for (int rp = F.gw * 2; rp < nrows; rp += F.NGW * 2) {
        int tok[2], bsel[2]; float* xr[2]; f32x4 y[2][4], v[2][4]; int me, mp; float mw;
#pragma unroll
        for (int q = 0; q < 2; ++q) { const int ridx = rp + q; tok[q] = l == 0 ? ridx : (ridx >> 12) * TPB + CTX + (ridx & 4095);
            const int b = tok[q] / TPB; bsel[q] = (tok[q] - b * TPB) < CTX ? 4 : b; xr[q] = resid_row(F.out, xc, tok[q]); }
        { const int q = (F.lane >> 3) & 1, k = F.lane & 7; me = toke[tok[q] * 8 + k]; mp = tokp[tok[q] * 8 + k]; mw = tokw[tok[q] * 8 + k]; }
#pragma unroll
        for (int q = 0; q < 2; ++q) { const bf16_t* sp = H + (size_t)tok[q] * DM;
#pragma unroll
            for (int j = 0; j < 4; ++j) { const u32x2 w = *(const u32x2*)(sp + 4 * F.lane + 256 * j); y[q][j] = (f32x4){bflo(w.x), bfhi(w.x), bflo(w.y), bfhi(w.y)}; }
            row_load_bf16(xr[q], F.lane, v[q]); }
#pragma unroll
        for (int q = 0; q < 2; ++q) { row_ln(v[q]); row_affine(v[q], a->in[26] + l * DM, false, a->in[27] + l * DM, F.lane); }
#pragma unroll
        for (int q = 0; q < 2; ++q)
#pragma unroll
            for (int k = 0; k < 8; ++k) { const int e = __shfl(me, q * 8 + k), p = __shfl(mp, q * 8 + k); const float wv = __shfl(mw, q * 8 + k) * 0.0625f;
                const unsigned char* yp = YS + (size_t)(tb[LC_SBASE + e] + p) * DM;
#pragma unroll
                for (int j = 0; j < 4; ++j) { const int w = (int)*(const unsigned*)(yp + 4 * F.lane + 256 * j);
                    y[q][j][0] += wv * __builtin_amdgcn_cvt_f32_fp8(w, 0); y[q][j][1] += wv * __builtin_amdgcn_cvt_f32_fp8(w, 1); y[q][j][2] += wv * __builtin_amdgcn_cvt_f32_fp8(w, 2); y[q][j][3] += wv * __builtin_amdgcn_cvt_f32_fp8(w, 3); } }
#pragma unroll
        for (int q = 0; q < 2; ++q) {
            const float* g2 = mod + bsel[q] * 6144 + 5120;
#pragma unroll
            for (int j = 0; j < 4; ++j) { const f32x4 gv = *(const f32x4*)(g2 + 4 * F.lane + 256 * j); v[q][j] = v[q][j] * DN_ALPHA + gv * y[q][j]; }
            row_ln(v[q]); row_affine(v[q], a->in[36] + l * DM, false, a->in[37] + l * DM, F.lane);
            if (!dry) { if (l == 0) row_store_bf16((bf16_t*)xr[q], F.lane, v[q]); else row_store(xr[q], F.lane, v[q]); } else asm volatile("" :: "v"(v[q][0]), "v"(v[q][1]), "v"(v[q][2]), "v"(v[q][3]));
            if (l == 0 && !dry) { row_ln(v[q]); const float* mrow = mod + 5 * 6144 + bsel[q] * 6144; row_affine(v[q], mrow + 1024, true, mrow, F.lane); row_store_bf16(H + (size_t)tok[q] * DM, F.lane, v[q]); }
        }
    }
}

constexpr int NPHASE = 22;
__global__ void __launch_bounds__(NTHR, 2) mk_fwd(Args args) {
    extern __shared__ __attribute__((aligned(16))) unsigned char lds_raw[];
    Frame F; F.lds = (LAS unsigned char*)lds_raw; F.tid = threadIdx.x; F.lane = F.tid & 63; F.wave = __builtin_amdgcn_readfirstlane(F.tid >> 6);
    F.G = gridDim.x; F.bid = blockIdx.x; F.gw = F.bid * NWAVES + F.wave; F.NGW = F.G * NWAVES; F.ws = args.ws; F.out = args.out; F.vcu = (F.G % 8 == 0) ? (F.bid % 8) * (F.G / 8) + F.bid / 8 : F.bid;
    for (int u = F.tid; u < (LDS_BYTES - LDS_CTL) / 4; u += NTHR) ((LAS unsigned*)(F.lds + LDS_CTL))[u] = 0u;
    __syncthreads();
    const int lo = args.ph_lo, hi = args.ph_hi;
    CArgsP A4 = (CArgsP)__builtin_amdgcn_kernarg_segment_ptr();
    XcdBarrier bar; bar.bar = (unsigned*)(F.ws + CW_BAR_BYTE); bar.x = 0; bar.st = nullptr;
    if (hi - lo > 1) bar = xcd_barrier_post((unsigned*)(F.ws + CW_BAR_BYTE), (volatile LAS unsigned*)(F.lds + LDS_CTL) + LC_BAR);
#ifndef PHMASK
#define PHMASK 0xfff
#endif
#define PH_EN(k) ((PHMASK >> ((k) < 2 ? (k) : 2 + (((k) - 2) % 10))) & 1)
#define IN(k) (PH_EN(k) && lo <= (k) && (k) < hi)
#define SEAM(k) do { if (IN(k) && IN((k) + 1)) { for (int dd = 0; dd < NDUP(14); ++dd) xcd_barrier(bar); } if (TSMASK != 0 && blockIdx.x == 0 && threadIdx.x == 0) { ((volatile LAS unsigned long long*)(F.lds + LDS_CTL + 2048))[(k) + 1] = __builtin_amdgcn_s_memrealtime(); } FRESH(); } while (0)
#define FRESH() do { int t_ = threadIdx.x, b_ = blockIdx.x; CArgsP p_ = (CArgsP)__builtin_amdgcn_kernarg_segment_ptr(); asm volatile("" : "+v"(t_)); asm volatile("" : "+s"(b_), "+s"(p_)); A4 = p_; unsigned char* w_ = p_->ws; float* o_ = p_->out; \
    F.tid = t_; F.lane = t_ & 63; F.wave = __builtin_amdgcn_readfirstlane(t_ >> 6); F.bid = b_; F.gw = b_ * NWAVES + F.wave; F.ws = w_; F.out = o_; F.vcu = (F.G % 8 == 0) ? (b_ % 8) * (F.G / 8) + b_ / 8 : b_; } while (0)
    if (TSMASK != 0 && blockIdx.x == 0 && threadIdx.x == 0) ((volatile LAS unsigned long long*)(F.lds + LDS_CTL + 2048))[0] = __builtin_amdgcn_s_memrealtime();
    if (IN(0)) { for (int dd = 0; dd < NDUP(0); ++dd) phase_prologue(F, A4); } SEAM(0);
    if (IN(1)) { for (int dd = 0; dd < NDUP(1); ++dd) phase_rows0(F, A4); } SEAM(1);
#pragma unroll 1
    for (int l = 0; l < 2; ++l) {
        const int pb = 2 + 10 * l; const bool lat = (l == 1);
        if (IN(pb + 0)) {
            SchedPlain S{(const char*)(F.ws + WS_H), (const char*)(F.ws + WS_WIN) + (size_t)l * INC * 1024 * 2, 1024, 68, 26, F.G, F.bid, false};
            EpiInproj E{F.ws, A4->in[7] + l * INC, (const float*)(F.ws + WS_ROPE)};
            for (int dd = 0; dd < NDUP(2); ++dd) pg8::gemm_phase(F.lds, 1024, S, E);
        } SEAM(pb + 0);
        if (IN(pb + 1)) {
            for (int dd = 0; dd < NDUP(3); ++dd) lru_phase(F, A4, l, 0, false);
            for (int dd = 0; dd < NDUP(4); ++dd)
            for (int it = F.bid; it < 136 * 4; it += F.G) { const int chunk = it >> 2; if (lat && (chunk % 34) < 2) continue; sg_item(F, A4, l, chunk, it & 3); }
        } SEAM(pb + 1);
        if (IN(pb + 2)) { for (int dd = 0; dd < NDUP(5); ++dd) phase_carry(F); } SEAM(pb + 2);
        if (IN(pb + 3)) { phase_attn(F, A4, l); } SEAM(pb + 3);
        if (IN(pb + 4)) {
            for (int dd = 0; dd < NDUP(8); ++dd) {
                SchedMerge S{(const char*)(F.ws + OV_OA), (const char*)(F.ws + WS_WBR) + (size_t)(l * 3) * 1024 * 512 * 2, F.G, F.bid};
                EpiMerge E{(bf16_t*)(F.ws + OV_MG), (const bf16_t*)(F.ws + OV_G)};
                pg8::gemm_phase(F.lds, 512, S, E);
            }
            if (!lat) mini_merge_ctx(F, l);
        } SEAM(pb + 4);
        if (IN(pb + 5)) {
            SchedPlain S{(const char*)(F.ws + OV_MG), (const char*)(F.ws + WS_WOUT) + (size_t)l * 1048576 * 2, 1024, 64, 4, F.G, F.bid, true};
            EpiWout E{F.out, (float*)(F.ws + WS_XC), (const float*)(F.ws + WS_MOD) + l * 5 * 6144, false};
            pg8::gemm_phase(F.lds, 1024, S, E);
            if (NDUP(11) > 1) { EpiWout E2{F.out, (float*)(F.ws + WS_XC), (const float*)(F.ws + WS_MOD) + l * 5 * 6144, true}; pg8::gemm_phase(F.lds, 1024, S, E2); }
            if (!lat) mini_wout_ctx(F, l);
        } SEAM(pb + 5);
        if (IN(pb + 6)) { phase_router(F, A4, l, false); if (NDUP(12) > 1) phase_router(F, A4, l, F.G != 12345); } SEAM(pb + 6);
        if (IN(pb + 7)) {
            build_tables(F, l);
            SchedMoe S{(const char*)(F.ws + WS_H), (const char*)(F.ws + WS_H), (const char*)(F.ws + WS_WM1), (const char*)(F.ws + WS_WSH1) + (size_t)l * 524288 * 2,
                       (const int*)(F.ws + WS_LIST), (const LAS int*)(F.lds + LDS_CTL), 1024, 2, F.G, F.vcu, lat ? 64 : 68, lat, true, (size_t)524288 * 2};
            EpiMoe1 E{(bf16_t*)(F.ws + OV_ACT), (bf16_t*)(F.ws + OV_ACTSH)};
            for (int dd = 0; dd < NDUP(9); ++dd) pg8::gemm_phase(F.lds, 1024, S, E);
        } SEAM(pb + 7);
        if (IN(pb + 8)) {
            build_tables(F, l);
            SchedMoe S{(const char*)(F.ws + OV_ACT), (const char*)(F.ws + OV_ACTSH), (const char*)(F.ws + WS_WM2), (const char*)(F.ws + WS_WSH2) + (size_t)l * 262144 * 2,
                       (const int*)(F.ws + WS_LIST), (const LAS int*)(F.lds + LDS_CTL), 256, 4, F.G, F.vcu, lat ? 64 : 68, lat, false, (size_t)262144 * 2};
            EpiMoe2 E{(unsigned char*)(F.ws + OV_YS), (bf16_t*)(F.ws + WS_H)};
            for (int dd = 0; dd < NDUP(10); ++dd) pg8::gemm_phase(F.lds, 256, S, E);
        } SEAM(pb + 8);
        if (IN(pb + 9)) {
            build_tables(F, l);
            phase_combine(F, A4, l, false);
            if (NDUP(13) > 1) phase_combine(F, A4, l, F.G != 12345);
            if (l == 0) for (int dd = 0; dd < NDUP(15); ++dd) conv_moe_layer(F, A4, 1);
        } SEAM(pb + 9);
    }
    if (TSMASK != 0 && hi - lo == NPHASE) { __syncthreads(); asm volatile("s_waitcnt vmcnt(0)" ::: "memory");
        if (blockIdx.x == 0 && threadIdx.x == 0) { volatile LAS unsigned long long* ts = (volatile LAS unsigned long long*)(F.lds + LDS_CTL + 2048);
            unsigned long long sel = 0; for (int k = 0; k < NPHASE; ++k) if ((TSMASK >> k) & 1) sel += ts[k + 1] - ts[k];
            const float frac = (float)sel / (float)(ts[NPHASE] - ts[0]); args.out[0] += 1.0f + floorf(90.0f * frac + 0.5f); } }
#undef IN
#undef SEAM
}

extern "C" void kernel_launch(void* const* d_in, const int* in_sizes, int n_in, void* d_out, int out_size, void* d_ws, size_t ws_size, hipStream_t stream) {
    static int grid = 0;
    if (grid == 0) {
        if (n_in != 38 || out_size != NBATCH * SEQ * DM || ws_size < WS_END) { fprintf(stderr, "kernel_launch: unexpected shapes (n_in %d out %d ws %zu need %zu)\n", n_in, out_size, ws_size, (size_t)WS_END); grid = -1; return; }
        int dev = 0, cus = 0;
        if (hipGetDevice(&dev) != hipSuccess || hipDeviceGetAttribute(&cus, hipDeviceAttributeMultiprocessorCount, dev) != hipSuccess) { grid = -1; return; }
        if (hipFuncSetAttribute((const void*)mk_fwd, hipFuncAttributeMaxDynamicSharedMemorySize, LDS_BYTES) != hipSuccess) { fprintf(stderr, "kernel_launch: hipFuncSetAttribute failed\n"); grid = -1; return; }
        int per_cu = 0;
        if (hipOccupancyMaxActiveBlocksPerMultiprocessor(&per_cu, (const void*)mk_fwd, NTHR, LDS_BYTES) != hipSuccess || per_cu < 1) fprintf(stderr, "kernel_launch: occupancy query says %d\n", per_cu);
        (void)hipGetLastError();
        grid = cus;
    }
    if (grid < 0) return;
    (void)hipMemsetAsync((char*)d_ws + WS_CTL, 0, CTL_ZERO_BYTES, stream);
    Args a{};
    for (int i = 0; i < 38; ++i) a.in[i] = (const float*)d_in[i];
    a.out = (float*)d_out; a.ws = (unsigned char*)d_ws;
#if MK_MULTI
    for (int p = 0; p < NPHASE; ++p) { a.ph_lo = p; a.ph_hi = p + 1; hipLaunchKernelGGL(mk_fwd, dim3(grid), dim3(NTHR), LDS_BYTES, stream, a); }
#else
    a.ph_lo = 0; a.ph_hi = NPHASE; hipLaunchKernelGGL(mk_fwd, dim3(grid), dim3(NTHR), LDS_BYTES, stream, a);
#endif
}
```

```cpp
#include <hip/hip_runtime.h>
#include <cstdio>
#include <cstdint>
#include <cmath>

#ifndef MK_MULTI
#define MK_MULTI 0
#endif
#ifndef DUPMASK
#define DUPMASK 0
#endif
#define NDUP(c) (1 + ((DUPMASK >> (c)) & 1))
#ifndef TSMASK
#define TSMASK 0
#endif
#ifndef NAIVE_GEMM
#define NAIVE_GEMM 0
#endif

#define LAS __attribute__((address_space(3)))
#define GAS __attribute__((address_space(1)))
typedef unsigned short bf16_t;
typedef short bf16x8 __attribute__((ext_vector_type(8)));
typedef short s16x4 __attribute__((ext_vector_type(4)));
typedef float f32x4 __attribute__((ext_vector_type(4)));
typedef float f32x16 __attribute__((ext_vector_type(16)));
typedef unsigned u32x4 __attribute__((ext_vector_type(4)));
typedef unsigned u32x2 __attribute__((ext_vector_type(2)));

constexpr int DM = 1024, NBATCH = 4, SEQ = 4096, CTX = 256, TPB = SEQ + CTX  , T = NBATCH * TPB  ;
constexpr int INC = 6656, NEXP = 64;
constexpr float DN_ALPHA = 1.41421356237309515f;
constexpr float LN_EPS = 1e-6f, RMS_EPS = 1e-5f;
constexpr int NWAVES = 8, NTHR = 512;

constexpr size_t MiB = 1u << 20;
constexpr size_t WS_CTL = 0, CTL_ZERO_BYTES = 1 * MiB;
constexpr size_t CW_BAR_BYTE = 16384;
constexpr size_t WS_CNT = 65536;
constexpr size_t WS_MOD = 131072;
constexpr size_t WS_ROPE = 1 * MiB;
constexpr size_t WS_LAM = 1 * MiB + 8192;
constexpr size_t WS_SUM = 1 * MiB + 65536;
constexpr size_t WS_HIN = WS_SUM + 2304 * 1024;
constexpr size_t WS_TOKE = 5 * MiB, WS_TOKP = 6 * MiB, WS_TOKW = 7 * MiB;
constexpr size_t WS_LIST = 8 * MiB;
constexpr size_t WS_XC = 13 * MiB;
constexpr size_t WS_WLRU = 17 * MiB;
constexpr size_t WS_WSG = 17 * MiB + 512 * 1024;
constexpr size_t WS_WRT = 17 * MiB + 768 * 1024;
constexpr size_t WS_WSH1 = 18 * MiB;
constexpr size_t WS_WSH2 = 20 * MiB;
constexpr size_t WS_WOUT = 21 * MiB;
constexpr size_t WS_WBR = 25 * MiB;
constexpr size_t WS_WIN = 31 * MiB;
constexpr size_t WS_WM1 = 57 * MiB;
constexpr size_t WS_WM2 = 121 * MiB;
constexpr size_t WS_H = 153 * MiB;
constexpr size_t WS_OV = 187 * MiB;
constexpr size_t OV_Q = WS_OV, OV_K = WS_OV + 17 * MiB, OV_V = WS_OV + 34 * MiB, OV_U = WS_OV + 51 * MiB, OV_S = WS_OV + 68 * MiB,
                 OV_X = WS_OV + 85 * MiB, OV_Y = WS_OV + 102 * MiB, OV_G = WS_OV + 119 * MiB, OV_OA = WS_OV + 221 * MiB,
                 OV_OB = WS_OV + 238 * MiB, OV_OC = WS_OV + 255 * MiB, OV_MG = WS_OV + 272 * MiB;
constexpr size_t OV_ACT = WS_OV, OV_ACTSH = WS_OV + 69 * MiB, OV_YS = WS_OV + 78 * MiB;
constexpr size_t WS_END = WS_OV + 350 * MiB;

constexpr int LDS_SCRATCH = 147456;
constexpr int LDS_CTL = LDS_SCRATCH;
constexpr int LDS_BYTES = LDS_SCRATCH + 4096;
constexpr int LC_BAR = 0;
constexpr int LC_TCNT = 64, LC_TBASE = 64 + 80, LC_SBASE = 64 + 160;

struct Args { const float* in[38]; float* out; unsigned char* ws; int ph_lo, ph_hi; };
typedef const Args __attribute__((address_space(4)))* CArgsP;

__device__ __forceinline__ unsigned f2bf(float f) { unsigned u = __builtin_bit_cast(unsigned, f); return (u + 0x7fffu + ((u >> 16) & 1u)) >> 16; }
typedef float f32x2 __attribute__((ext_vector_type(2))); typedef __bf16 bf16x2_t __attribute__((ext_vector_type(2)));
__device__ __forceinline__ unsigned pk2(float lo, float hi) { const f32x2 v = {lo, hi}; const bf16x2_t b = __builtin_convertvector(v, bf16x2_t); return __builtin_bit_cast(unsigned, b); }
__device__ __forceinline__ float bflo(unsigned w) { return __builtin_bit_cast(float, w << 16); }
__device__ __forceinline__ float bfhi(unsigned w) { return __builtin_bit_cast(float, w & 0xffff0000u); }
__device__ __forceinline__ float bf2f(bf16_t b) { return __builtin_bit_cast(float, (unsigned)b << 16); }
#define WS_DPP(v, ctrl, rmask, bc) __builtin_bit_cast(float, __builtin_amdgcn_update_dpp(0, __builtin_bit_cast(int, v), ctrl, rmask, 0xF, bc))
__device__ __forceinline__ float wave_sum(float v) {
    v += WS_DPP(v, 0xB1, 0xF, true); v += WS_DPP(v, 0x4E, 0xF, true); v += WS_DPP(v, 0x141, 0xF, true); v += WS_DPP(v, 0x140, 0xF, true);
    v += WS_DPP(v, 0x142, 0xA, false); v += WS_DPP(v, 0x143, 0xC, false);
    return __builtin_bit_cast(float, __builtin_amdgcn_readlane(__builtin_bit_cast(int, v), 63));
}
__device__ __forceinline__ float sigmoidf_(float x) { return __builtin_amdgcn_rcpf(1.f + __builtin_amdgcn_exp2f(-1.4426950408889634f * x)); }
__device__ __forceinline__ float gelu_tanh(float x) { const float u = x * (0.7978845608028654f + 0.035677408136300125f * x * x); return x * __builtin_amdgcn_rcpf(1.f + __builtin_amdgcn_exp2f(-2.885390081777927f * u)); }
__device__ __forceinline__ float silu_(float x) { return x * __builtin_amdgcn_rcpf(1.f + __builtin_amdgcn_exp2f(-1.4426950408889634f * x)); }
__device__ __forceinline__ float expm1_fast(float x) {
    if (x > -0.5f && x < 0.5f) { float p = 1.0f + x * (1.0f / 8.0f); p = 1.0f + x * (1.0f / 7.0f) * p; p = 1.0f + x * (1.0f / 6.0f) * p; p = 1.0f + x * 0.2f * p; p = 1.0f + x * 0.25f * p; p = 1.0f + x * (1.0f / 3.0f) * p; p = 1.0f + x * 0.5f * p; return x * p; }
    return expm1f(x);
}
#define LDS_WAIT() asm volatile("s_waitcnt lgkmcnt(0)" ::: "memory")
#define VM_WAIT() asm volatile("s_waitcnt vmcnt(0)" ::: "memory")

#define XB_TMO      128
#define XB_XCNT(j)  (256  + 64 * (j))
#define XB_XSUB(j)  (1280 + 64 * (j))
#define XB_XGEN(j)  (2304 + 64 * (j))
#define XB_TOP      3328
#define XB_TOPGEN   3392
#define XCD_BAR_WORDS 3456
#define XB_SPIN_CAP (1u << 22)
__device__ __forceinline__ unsigned xb_ld(unsigned* p)              { return __hip_atomic_load(p, __ATOMIC_RELAXED, __HIP_MEMORY_SCOPE_AGENT); }
__device__ __forceinline__ unsigned xb_add(unsigned* p, unsigned v) { return __hip_atomic_fetch_add(p, v, __ATOMIC_RELAXED, __HIP_MEMORY_SCOPE_AGENT); }
__device__ __forceinline__ unsigned xb_xcc_id() { return (unsigned)__builtin_amdgcn_s_getreg((3 << 11) | 20) & 0xFu; }
#define XB_SPIN(cond, bar) do { unsigned _sp = 0; while (cond) { __builtin_amdgcn_s_sleep(1); \
    if ((++_sp & 255u) == 0u) { if (xb_ld(&(bar)[XB_TMO])) break; if (_sp > XB_SPIN_CAP) { atomicAdd(&(bar)[XB_TMO], 1u); break; } } } } while (0)
struct XcdBarrier { unsigned* bar; unsigned x; volatile LAS unsigned* st; };
__device__ __forceinline__ XcdBarrier xcd_barrier_post(unsigned* bar, volatile LAS unsigned* st) {
    XcdBarrier b; b.bar = bar; b.x = xb_xcc_id(); b.st = st;
    if (threadIdx.x == 0) (void)xb_add(&bar[XB_XCNT(b.x)], 1u);
    return b;
}
__device__ __forceinline__ void xcd_barrier_complete(unsigned* bar, unsigned x, unsigned& nloc, unsigned& nx) {
    const unsigned G = gridDim.x * gridDim.y * gridDim.z;
    unsigned sum, cnt, mine, sp = 0u;
    for (;;) {
        sum = 0u; cnt = 0u; mine = 0u;
#pragma unroll
        for (unsigned j = 0; j < 16; ++j) { const unsigned c = xb_ld(&bar[XB_XCNT(j)]); sum += c; cnt += (c > 0u) ? 1u : 0u; mine = (j == x) ? c : mine; }
        if (sum == G) break;
        __builtin_amdgcn_s_sleep(1);
        if ((++sp & 255u) == 0u) { if (xb_ld(&bar[XB_TMO])) break; if (sp > XB_SPIN_CAP) { atomicAdd(&bar[XB_TMO], 1u); break; } }
    }
    nloc = mine > 0u ? mine : 1u; nx = cnt > 0u ? cnt : 1u;
}
__device__ __forceinline__ void xcd_barrier(const XcdBarrier& b) {
    asm volatile("s_waitcnt vmcnt(0)" ::: "memory");
    __syncthreads();
    if (threadIdx.x == 0) {
        unsigned* bar = b.bar; asm volatile("" : "+s"(bar));
        __builtin_amdgcn_s_waitcnt(0);
        unsigned nloc = b.st[0], nx = b.st[1];
        if (nloc == 0u) { xcd_barrier_complete(bar, b.x, nloc, nx); b.st[0] = nloc; b.st[1] = nx; }
        const unsigned old = xb_add(&bar[XB_XSUB(b.x)], 1u);
        const unsigned gen = old / nloc;
        if (old + 1u == (gen + 1u) * nloc) {
            __builtin_amdgcn_fence(__ATOMIC_RELEASE, "agent");
            asm volatile("s_waitcnt vmcnt(0)" ::: "memory");
            const unsigned og = xb_add(&bar[XB_TOP], 1u);
            const unsigned tg = og / nx;
            if (og + 1u == (tg + 1u) * nx) xb_add(&bar[XB_TOPGEN], 1u);
            else XB_SPIN(xb_ld(&bar[XB_TOPGEN]) == tg, bar);
            __builtin_amdgcn_fence(__ATOMIC_ACQUIRE, "agent");
            xb_add(&bar[XB_XGEN(b.x)], 1u);
            asm volatile("s_waitcnt vmcnt(0)" ::: "memory");
        } else {
            XB_SPIN(xb_ld(&bar[XB_XGEN(b.x)]) == gen, bar);
            __builtin_amdgcn_fence(__ATOMIC_ACQUIRE, "agent");
            asm volatile("s_waitcnt vmcnt(0)" ::: "memory");
        }
    }
    __syncthreads();
}

namespace pg8 {
constexpr int BM = 256, BK = 64, HALF = 128, HTB = HALF * BK * 2, STAGE_BYTES = 8 * HTB, NXCD = 8, WGM = 8;
__host__ __device__ __forceinline__ int lds_byte(int r, int c) { const int st = (r >> 4) * 2 + (c >> 5), rr = r & 15, cc = c & 31, ob = rr * 64 + cc * 2; return st * 1024 + (ob ^ (((ob >> 9) & 1) << 5)); }
__host__ __device__ __forceinline__ void stage_rc(int b, int& R, int& C) { const int st = b / 1024, sb = b % 1024, swz = sb ^ (((sb >> 9) & 1) << 5); R = (st >> 1) * 16 + swz / 64; C = (st & 1) * 32 + (swz % 64) / 2; }
__host__ __device__ __forceinline__ int perm32(int rho) { const int n = rho >> 4, i = rho & 15; return 8 * (i >> 2) + 4 * n + (i & 3); }
struct Unit { int pm, pn, e, ti, nrows, row0; };
typedef f32x4 Acc[2][2][4][2];

template <class Epi, class Sched>
__device__ __forceinline__ void gemm_phase(LAS unsigned char* lds, const int K, const Sched& S, const Epi& E) {
    int tid_ = threadIdx.x; asm volatile("" : "+v"(tid_));
    const int tid = tid_, wid = __builtin_amdgcn_readfirstlane(tid >> 6), lane = tid & 63, wr = wid >> 2, wc = wid & 3, fr = lane & 15, fq = lane >> 4;
    (void)fr; (void)fq; (void)wc;
    Unit cur, nxt; int ui = 0;
    if (!S.next(0, cur)) return;
    Acc acc;
#pragma unroll
    for (int a = 0; a < 2; ++a)
#pragma unroll
        for (int b = 0; b < 2; ++b)
#pragma unroll
            for (int m = 0; m < 4; ++m)
#pragma unroll
                for (int n = 0; n < 2; ++n) acc[a][b][m][n] = (f32x4){0.f, 0.f, 0.f, 0.f};
#if NAIVE_GEMM
    for (;;) {
        const char* Ab = S.a_base(); const char* Bb = S.b_ptr(cur);
#pragma unroll 1
        for (int ai = 0; ai < 2; ++ai)
#pragma unroll 1
            for (int m = 0; m < 4; ++m) {
                const int rr = ai * 128 + wr * 64 + m * 16 + fr;
                const bf16_t* ap = (const bf16_t*)(Ab + S.a_off(cur, rr));
#pragma unroll
                for (int bj = 0; bj < 2; ++bj)
#pragma unroll
                    for (int n = 0; n < 2; ++n)
#pragma unroll
                        for (int j = 0; j < 4; ++j) {
                            const int cc = Epi::PERM ? bj * 128 + wc * 32 + fq * 8 + n * 4 + j : bj * 128 + wc * 32 + n * 16 + fq * 4 + j;
                            const bf16_t* bp = (const bf16_t*)(Bb + (size_t)cc * K * 2);
                            float s = 0.f;
                            for (int k = 0; k < K; k += 8) {
                                const u32x4 av = *(const u32x4*)(ap + k), bv = *(const u32x4*)(bp + k);
                                s += bflo(av.x) * bflo(bv.x) + bfhi(av.x) * bfhi(bv.x) + bflo(av.y) * bflo(bv.y) + bfhi(av.y) * bfhi(bv.y)
                                   + bflo(av.z) * bflo(bv.z) + bfhi(av.z) * bfhi(bv.z) + bflo(av.w) * bflo(bv.w) + bfhi(av.w) * bfhi(bv.w);
                            }
                            acc[ai][bj][m][n][j] = s;
                        }
            }
        E(acc, cur, wr, wc, fr, fq);
        ++ui;
        if (!S.next(ui, cur)) break;
    }
    return;
#else
    const int nt = K / BK;
    unsigned voffB[2];
    { int Rr[2], Cc[2];
#pragma unroll
      for (int i = 0; i < 2; ++i) { stage_rc(tid * 16 + i * 8192, Rr[i], Cc[i]); const int Rb = Epi::PERM ? ((Rr[i] & ~31) + perm32(Rr[i] & 31)) : Rr[i]; voffB[i] = (unsigned)(Rb * K + Cc[i]) * 2u; } }
#define PG8_AOFFS(U, o00, o01, o10, o11) do { int t3_ = threadIdx.x; asm volatile("" : "+v"(t3_)); int R0_, C0_, R1_, C1_; stage_rc(t3_ * 16, R0_, C0_); stage_rc(t3_ * 16 + 8192, R1_, C1_); \
        o00 = S.a_off(U, R0_) + (unsigned)C0_ * 2u; o01 = S.a_off(U, R1_) + (unsigned)C1_ * 2u; o10 = S.a_off(U, HALF + R0_) + (unsigned)C0_ * 2u; o11 = S.a_off(U, HALF + R1_) + (unsigned)C1_ * 2u; } while (0)
    const size_t kstep = (size_t)(BK * 2);
    const size_t hstep = (size_t)HALF * K * 2;
    const unsigned ldsw = (unsigned)wid * 1024u;
    const int aoff = lds_byte(wr * 64 + fr, fq * 8), boff = lds_byte(wc * 32 + fr, fq * 8);
#define PG8_SA(b, h) (((b) * 2 + (h)) * HTB)
#define PG8_SB(b, h) ((4 + (b) * 2 + (h)) * HTB)
#define PG8_STAGE(bufoff, gbase, v0, v1) do { \
        __builtin_amdgcn_global_load_lds((const unsigned*)((const char*)(gbase) + (v0)), (LAS unsigned*)(lds + (bufoff) + ldsw), 16, 0, 0); \
        __builtin_amdgcn_global_load_lds((const unsigned*)((const char*)(gbase) + (v1)), (LAS unsigned*)(lds + (bufoff) + ldsw + 8192), 16, 0, 0); } while (0)
#define PG8_LDA(dst, b, h) do { _Pragma("unroll") for (int m = 0; m < 4; ++m) _Pragma("unroll") for (int k = 0; k < 2; ++k) dst[m][k] = *(const LAS bf16x8*)(lds + PG8_SA(b, h) + aoff + m * 2048 + k * 1024); } while (0)
#define PG8_LDB(dst, b, h) do { _Pragma("unroll") for (int n = 0; n < 2; ++n) _Pragma("unroll") for (int k = 0; k < 2; ++k) dst[n][k] = *(const LAS bf16x8*)(lds + PG8_SB(b, h) + boff + n * 2048 + k * 1024); } while (0)
#define PG8_MMA(ai, bj, At, Bt) do { __builtin_amdgcn_s_setprio(1); _Pragma("unroll") for (int m = 0; m < 4; ++m) _Pragma("unroll") for (int n = 0; n < 2; ++n) _Pragma("unroll") for (int k = 0; k < 2; ++k) \
        acc[ai][bj][m][n] = __builtin_amdgcn_mfma_f32_16x16x32_bf16(Bt[n][k], At[m][k], acc[ai][bj][m][n], 0, 0, 0); __builtin_amdgcn_s_setprio(0); } while (0)
#define PG8_WAIT_V(n) asm volatile("s_waitcnt vmcnt(" #n ")" ::: "memory")
#define PG8_WAIT_L(n) asm volatile("s_waitcnt lgkmcnt(" #n ")" ::: "memory")
#define PG8_BAR __builtin_amdgcn_s_barrier()
#define PG8_SCHED __builtin_amdgcn_sched_barrier(0)
    bf16x8 At[4][2], B0[2][2], B1[2][2];
    const char* const Ab = S.a_base();
    unsigned vA00, vA01, vA10, vA11;
    PG8_AOFFS(cur, vA00, vA01, vA10, vA11);
    const char* cB = S.b_ptr(cur);
    PG8_STAGE(PG8_SB(0, 0), cB, voffB[0], voffB[1]); PG8_STAGE(PG8_SB(0, 1), cB + hstep, voffB[0], voffB[1]); PG8_STAGE(PG8_SA(0, 0), Ab, vA00, vA01); PG8_STAGE(PG8_SA(0, 1), Ab, vA10, vA11);
    if (wr == 1) PG8_BAR;
    PG8_WAIT_V(2); PG8_BAR;
    PG8_STAGE(PG8_SB(1, 0), cB + kstep, voffB[0], voffB[1]); PG8_STAGE(PG8_SA(1, 0), Ab + kstep, vA00, vA01); PG8_STAGE(PG8_SB(1, 1), cB + hstep + kstep, voffB[0], voffB[1]);
    PG8_WAIT_V(6); PG8_BAR;
    for (;;) {
        const bool has_next = S.next(ui + 1, nxt);
        unsigned vN00 = vA00, vN01 = vA01, vN10 = vA10, vN11 = vA11; const char* nB = cB;
        if (has_next) { PG8_AOFFS(nxt, vN00, vN01, vN10, vN11); nB = S.b_ptr(nxt); }
        for (int t = 0; t < nt; t += 2) {
            const bool last = (t == nt - 2);
            const char* a1 = Ab + (size_t)(t + 1) * kstep;
            const char* a2 = last ? Ab : Ab + (size_t)(t + 2) * kstep; const char* b2 = last ? nB : cB + (size_t)(t + 2) * kstep;
            const char* a3 = a2 + kstep; const char* b3 = b2 + kstep;
            const unsigned w00 = last ? vN00 : vA00, w01 = last ? vN01 : vA01, w10 = last ? vN10 : vA10, w11 = last ? vN11 : vA11;
            PG8_LDB(B0, 0, 0); PG8_LDB(B1, 0, 1); PG8_SCHED; PG8_LDA(At, 0, 0); PG8_STAGE(PG8_SA(1, 1), a1, vA10, vA11);
            PG8_WAIT_V(8); PG8_WAIT_L(0); PG8_BAR; PG8_MMA(0, 0, At, B0); PG8_MMA(0, 1, At, B1); PG8_BAR; PG8_SCHED;
            PG8_LDA(At, 0, 1); PG8_STAGE(PG8_SB(0, 0), b2, voffB[0], voffB[1]); PG8_STAGE(PG8_SB(0, 1), b2 + hstep, voffB[0], voffB[1]); PG8_STAGE(PG8_SA(0, 0), a2, w00, w01);
            PG8_WAIT_V(8); PG8_WAIT_L(0); PG8_BAR; PG8_MMA(1, 0, At, B0); PG8_MMA(1, 1, At, B1); PG8_BAR; PG8_SCHED;
            PG8_LDB(B0, 1, 0); PG8_LDB(B1, 1, 1); PG8_SCHED; PG8_LDA(At, 1, 0); PG8_STAGE(PG8_SA(0, 1), a2, w10, w11);
            PG8_WAIT_V(8); PG8_WAIT_L(0); PG8_BAR; PG8_MMA(0, 0, At, B0); PG8_MMA(0, 1, At, B1); PG8_BAR; PG8_SCHED;
            PG8_LDA(At, 1, 1); PG8_STAGE(PG8_SB(1, 0), b3, voffB[0], voffB[1]); PG8_STAGE(PG8_SB(1, 1), b3 + hstep, voffB[0], voffB[1]); PG8_STAGE(PG8_SA(1, 0), a3, w00, w01);
            PG8_WAIT_V(8); PG8_WAIT_L(0); PG8_BAR; PG8_MMA(1, 0, At, B0); PG8_MMA(1, 1, At, B1); PG8_BAR; PG8_SCHED;
        }
        if (wr == 0) PG8_BAR;
        { int t2_ = threadIdx.x; asm volatile("" : "+v"(t2_)); const int l2_ = t2_ & 63; E(acc, cur, wr, wc, l2_ & 15, l2_ >> 4); }
        if (!has_next) break;
#pragma unroll
        for (int a = 0; a < 2; ++a)
#pragma unroll
            for (int b = 0; b < 2; ++b)
#pragma unroll
                for (int m = 0; m < 4; ++m)
#pragma unroll
                    for (int n = 0; n < 2; ++n) acc[a][b][m][n] = (f32x4){0.f, 0.f, 0.f, 0.f};
        cur = nxt; vA00 = vN00; vA01 = vN01; vA10 = vN10; vA11 = vN11; cB = nB; ++ui;
        if (wr == 1) PG8_BAR;
    }
    PG8_WAIT_V(0);
    PG8_BAR;
#undef PG8_SA
#undef PG8_AOFFS
#undef PG8_SB
#undef PG8_STAGE
#undef PG8_LDA
#undef PG8_LDB
#undef PG8_MMA
#undef PG8_WAIT_V
#undef PG8_WAIT_L
#undef PG8_BAR
#undef PG8_SCHED
#endif
}
}
using pg8::Unit;
using pg8::Acc;

__device__ __forceinline__ float* resid_row(float* out, float* xc, int tok) {
    const int b = tok / TPB, j = tok - b * TPB;
    return j < CTX ? xc + ((size_t)(b * CTX + j)) * DM : out + ((size_t)(b * SEQ + j - CTX)) * DM;
}
__device__ __forceinline__ int tile_to_pm(int i, bool latent_only) { return latent_only ? (i >> 4) * 17 + 1 + (i & 15) : i; }

__device__ __forceinline__ bool static_order(int i, int G, int c, int nM, int nN, int& pm, int& pn) {
    const int nwg = nM * nN; const long L = (long)i * G + c; if (L >= nwg) return false;
    int wgid = (int)L; { const int q = nwg / 8, r = nwg % 8, xcd = wgid % 8, off = wgid / 8; wgid = (xcd < r ? xcd * (q + 1) : r * (q + 1) + (xcd - r) * q) + off; }
    const int nig = 8 * nN, gid = wgid / nig, fm = gid * 8, gsz = (nM - fm) < 8 ? (nM - fm) : 8;
    pm = fm + ((wgid % nig) % gsz); pn = (wgid % nig) / gsz; return true;
}

struct SchedPlain {
    const char* A; const char* Bt; int K, nM, nN, G, c; bool lat;
    __device__ __forceinline__ bool next(int i, Unit& u) const {
        int pm, pn; if (!static_order(i, G, c, nM, nN, pm, pn)) return false;
        u.pm = tile_to_pm(pm, lat); u.pn = pn; u.e = 0; u.ti = 0; u.nrows = 256; u.row0 = u.pm * 256; return true;
    }
    __device__ __forceinline__ const char* a_base() const { return A; }
    __device__ __forceinline__ unsigned a_off(const Unit& u, int rr) const { return (unsigned)(u.row0 + rr) * (unsigned)(K * 2); }
    __device__ __forceinline__ const char* b_ptr(const Unit& u) const { return Bt + (size_t)u.pn * 256 * K * 2; }
};

struct SchedMerge {
    const char* A0; const char* Bt0; int G, c;
    __device__ __forceinline__ bool next(int i, Unit& u) const {
        const int ti = i / 3, r = i - 3 * ti; int pm, pn; if (!static_order(ti, G, c, 64, 4, pm, pn)) return false;
        u.pm = tile_to_pm(pm, true); u.pn = pn; u.e = r; u.ti = 0; u.nrows = 256; u.row0 = u.pm * 256; return true;
    }
    __device__ __forceinline__ const char* a_base() const { return A0; }
    __device__ __forceinline__ unsigned a_off(const Unit& u, int rr) const { return (unsigned)u.e * (unsigned)(17 * MiB) + (unsigned)(u.row0 + rr) * 1024u; }
    __device__ __forceinline__ const char* b_ptr(const Unit& u) const { return Bt0 + ((size_t)u.e * 1024 * 512 + (size_t)u.pn * 256 * 512) * 2; }
};

struct SchedMoe {
    const char* A;
    const char* Ash;
    const char* Bt; const char* Btsh; const int* list;
    const LAS int* tb;
    int K, nN, G, c, nsh; bool lat, gather; size_t bstride;
    __device__ __forceinline__ bool next(int i, Unit& u) const {
        const int nrt = tb[LC_TBASE + 64], L = i * G + c, tot = (nrt + nsh) * nN;
        if (L >= tot) return false;
        const int rt = L / nN; u.pn = L - rt * nN;
        if (rt < nrt) {
            int e = 0;
#pragma unroll 1
            for (int s = 32; s > 0; s >>= 1) if (e + s < 64 && tb[LC_TBASE + e + s] <= rt) e += s;
            u.e = e; u.ti = rt - tb[LC_TBASE + e]; const int cnt = tb[LC_TCNT + e]; const int rem = cnt - u.ti * 256;
            u.nrows = rem < 256 ? rem : 256; u.row0 = tb[LC_SBASE + e] + u.ti * 256; u.pm = 0;
        } else { u.e = 64; u.ti = rt - nrt; u.pm = tile_to_pm(u.ti, lat); u.nrows = 256; u.row0 = u.pm * 256; }
        return true;
    }
    __device__ __forceinline__ const char* a_base() const { return A; }
    __device__ __forceinline__ unsigned a_off(const Unit& u, int rr) const {
        if (u.e == 64) return (unsigned)(Ash - A) + (unsigned)(u.row0 + rr) * (unsigned)(K * 2);
        if (gather) { const int r2 = rr < u.nrows ? rr : u.nrows - 1; const int tok = list[(size_t)u.e * T + u.ti * 256 + r2]; return (unsigned)tok * (unsigned)(K * 2); }
        return (unsigned)(u.row0 + rr) * (unsigned)(K * 2);
    }
    __device__ __forceinline__ const char* b_ptr(const Unit& u) const { return (u.e == 64 ? Btsh : Bt + (size_t)u.e * bstride) + (size_t)u.pn * 256 * K * 2; }
};

#define EPI_FOR_ROWS  _Pragma("unroll") for (int ai = 0; ai < 2; ++ai) _Pragma("unroll") for (int m = 0; m < 4; ++m)
#define EPI_FOR_COLS  _Pragma("unroll") for (int bj = 0; bj < 2; ++bj) _Pragma("unroll") for (int n = 0; n < 2; ++n)

struct EpiInproj {
    static constexpr bool PERM = true;
    unsigned char* ws; const float* bias; const float* rope;
    __device__ __forceinline__ void operator()(const Acc& acc, const Unit& u, int wr, int wc, int fr, int fq) const {
        const int pn = u.pn; const bool isg = pn >= 14; const int seg = pn >> 1;
        bf16_t* base = (bf16_t*)(ws + (isg ? OV_G : OV_Q + (size_t)seg * 17 * MiB));
        const int ld = isg ? 3072 : 512, coff = isg ? (pn - 14) * 256 : (pn & 1) * 256;
        const bool latent = (u.pm % 17) != 0; const bool dorope = seg < 2 && !isg && latent;
        f32x4 bv[2][2];
        EPI_FOR_COLS bv[bj][n] = *(const f32x4*)(bias + pn * 256 + bj * 128 + wc * 32 + fq * 8 + n * 4);
        const float qs = (seg == 0 && !isg) ? 0.125f * 1.4426950408889634f : 1.0f;
        const bool upper = __builtin_amdgcn_mbcnt_hi(~0u, __builtin_amdgcn_mbcnt_lo(~0u, 0u)) >= 32u;
        EPI_FOR_ROWS {
            const int row = u.row0 + ai * 128 + wr * 64 + m * 16 + fr;
            bf16_t* rp = base + (size_t)row * ld + coff + wc * 32 + fq * 8;
            f32x4 v[2][2];
            EPI_FOR_COLS v[bj][n] = acc[ai][bj][m][n] + bv[bj][n];
            if (dorope) {
                const int pos = (row % TPB) - CTX; const int pa = (wc & 1) ? (pos & 63) : (pos >> 6);
                const float* tp = rope + (pa * 16 + (fq & 1) * 8) * 2;
                f32x4 t[4];
#pragma unroll
                for (int i = 0; i < 4; ++i) t[i] = *(const f32x4*)(tp + 4 * i);
#pragma unroll
                for (int bj = 0; bj < 2; ++bj)
#pragma unroll
                    for (int n = 0; n < 2; ++n)
#pragma unroll
                        for (int j = 0; j < 4; ++j) { const float own = v[bj][n][j];
                            const auto rr = __builtin_amdgcn_permlane32_swap(__float_as_uint(own), __float_as_uint(own), false, false);
                            const float oth = upper ? __uint_as_float(rr[0]) : __uint_as_float(rr[1]);
                            const int fi = 4 * n + j; const float cs = t[fi >> 1][(fi & 1) * 2], sn = t[fi >> 1][(fi & 1) * 2 + 1];
                            v[bj][n][j] = own * cs + (upper ? oth : -oth) * sn; }
            }
#pragma unroll
            for (int bj = 0; bj < 2; ++bj) { const f32x4 v0 = v[bj][0] * qs, v1 = v[bj][1] * qs;
                u32x4 w; w.x = pk2(v0[0], v0[1]); w.y = pk2(v0[2], v0[3]); w.z = pk2(v1[0], v1[1]); w.w = pk2(v1[2], v1[3]); *(u32x4*)(rp + bj * 128) = w; }
        }
    }
};

struct EpiMerge {
    static constexpr bool PERM = true;
    bf16_t* mg; const bf16_t* gate;
    __device__ __forceinline__ void operator()(const Acc& acc, const Unit& u, int wr, int wc, int fr, int fq) const {
        const int r = u.e;
#pragma unroll
        for (int ai = 0; ai < 2; ++ai) {
            const size_t rbase = (size_t)(u.row0 + ai * 128 + wr * 64 + fr); const int col = u.pn * 256 + wc * 32 + fq * 8;
            u32x4 g[4][2], o[4][2];
#pragma unroll
            for (int m = 0; m < 4; ++m)
#pragma unroll
                for (int bj = 0; bj < 2; ++bj) { g[m][bj] = *(const u32x4*)(gate + (rbase + m * 16) * 3072 + r * 1024 + col + bj * 128);
                    if (r > 0) o[m][bj] = *(const u32x4*)(mg + (rbase + m * 16) * DM + col + bj * 128); else o[m][bj] = (u32x4){0u, 0u, 0u, 0u}; }
#pragma unroll
            for (int m = 0; m < 4; ++m)
#pragma unroll
                for (int bj = 0; bj < 2; ++bj) { const u32x4 gg = g[m][bj], oo = o[m][bj]; const f32x4 v0 = acc[ai][bj][m][0], v1 = acc[ai][bj][m][1];
                    u32x4 w; w.x = pk2(v0[0] * sigmoidf_(bflo(gg.x)) + bflo(oo.x), v0[1] * sigmoidf_(bfhi(gg.x)) + bfhi(oo.x)); w.y = pk2(v0[2] * sigmoidf_(bflo(gg.y)) + bflo(oo.y), v0[3] * sigmoidf_(bfhi(gg.y)) + bfhi(oo.y));
                    w.z = pk2(v1[0] * sigmoidf_(bflo(gg.z)) + bflo(oo.z), v1[1] * sigmoidf_(bfhi(gg.z)) + bfhi(oo.z)); w.w = pk2(v1[2] * sigmoidf_(bflo(gg.w)) + bflo(oo.w), v1[3] * sigmoidf_(bfhi(gg.w)) + bfhi(oo.w));
                    *(u32x4*)(mg + (rbase + m * 16) * DM + col + bj * 128) = w; }
        }
    }
};

struct EpiWout {
    static constexpr bool PERM = true;
    float* out; float* xc; const float* modl; bool dry;
    __device__ __forceinline__ void operator()(const Acc& acc, const Unit& u, int wr, int wc, int fr, int fq) const {
        const int b = u.pm / 17; const int bsel = (u.pm % 17) == 0 ? 4 : b;
        const float* g1 = modl + bsel * 6144 + 2048;
        f32x4 gv[2][2];
        EPI_FOR_COLS gv[bj][n] = *(const f32x4*)(g1 + u.pn * 256 + bj * 128 + wc * 32 + fq * 8 + n * 4);
#pragma unroll
        for (int ai = 0; ai < 2; ++ai) {
            bf16_t* rp[4]; u32x4 x[4][2];
#pragma unroll
            for (int m = 0; m < 4; ++m) { rp[m] = (bf16_t*)resid_row(out, xc, u.row0 + ai * 128 + wr * 64 + m * 16 + fr) + u.pn * 256 + wc * 32 + fq * 8;
#pragma unroll
                for (int bj = 0; bj < 2; ++bj) x[m][bj] = *(const u32x4*)(rp[m] + bj * 128); }
#pragma unroll
            for (int m = 0; m < 4; ++m)
#pragma unroll
                for (int bj = 0; bj < 2; ++bj) { const u32x4 xx = x[m][bj]; const f32x4 a0 = acc[ai][bj][m][0] * gv[bj][0], a1 = acc[ai][bj][m][1] * gv[bj][1];
                    u32x4 w; w.x = pk2(bflo(xx.x) * DN_ALPHA + a0[0], bfhi(xx.x) * DN_ALPHA + a0[1]); w.y = pk2(bflo(xx.y) * DN_ALPHA + a0[2], bfhi(xx.y) * DN_ALPHA + a0[3]);
                    w.z = pk2(bflo(xx.z) * DN_ALPHA + a1[0], bfhi(xx.z) * DN_ALPHA + a1[1]); w.w = pk2(bflo(xx.w) * DN_ALPHA + a1[2], bfhi(xx.w) * DN_ALPHA + a1[3]);
                    if (!dry) *(u32x4*)(rp[m] + bj * 128) = w; else asm volatile("" :: "v"(w)); }
        }
    }
};

struct EpiMoe1 {
    static constexpr bool PERM = true;
    bf16_t* act; bf16_t* actsh;
    __device__ __forceinline__ void operator()(const Acc& acc, const Unit& u, int wr, int wc, int fr, int fq) const {
        bf16_t* base = u.e == 64 ? actsh : act;
        EPI_FOR_ROWS {
            const int rl = ai * 128 + wr * 64 + m * 16 + fr;
            if (rl < u.nrows) {
                const f32x4 g0 = acc[ai][0][m][0], g1 = acc[ai][0][m][1], p0 = acc[ai][1][m][0], p1 = acc[ai][1][m][1];
                u32x4 w; w.x = pk2(silu_(g0[0]) * p0[0], silu_(g0[1]) * p0[1]); w.y = pk2(silu_(g0[2]) * p0[2], silu_(g0[3]) * p0[3]);
                w.z = pk2(silu_(g1[0]) * p1[0], silu_(g1[1]) * p1[1]); w.w = pk2(silu_(g1[2]) * p1[2], silu_(g1[3]) * p1[3]);
                *(u32x4*)(base + (size_t)(u.row0 + rl) * 256 + u.pn * 128 + wc * 32 + fq * 8) = w;
            }
        }
    }
};

struct EpiMoe2 {
    static constexpr bool PERM = true;
    unsigned char* ys; bf16_t* sho;
    __device__ __forceinline__ void operator()(const Acc& acc, const Unit& u, int wr, int wc, int fr, int fq) const {
        EPI_FOR_ROWS {
            const int rl = ai * 128 + wr * 64 + m * 16 + fr;
            if (rl < u.nrows) {
                if (u.e == 64) {
                    bf16_t* rp = sho + (size_t)(u.row0 + rl) * DM + u.pn * 256 + wc * 32 + fq * 8;
#pragma unroll
                    for (int bj = 0; bj < 2; ++bj) { const f32x4 v0 = acc[ai][bj][m][0], v1 = acc[ai][bj][m][1];
                        u32x4 w; w.x = pk2(v0[0], v0[1]); w.y = pk2(v0[2], v0[3]); w.z = pk2(v1[0], v1[1]); w.w = pk2(v1[2], v1[3]); *(u32x4*)(rp + bj * 128) = w; }
                } else {
                    unsigned char* rp = ys + (size_t)(u.row0 + rl) * DM + u.pn * 256 + wc * 32 + fq * 8;
#pragma unroll
                    for (int bj = 0; bj < 2; ++bj) { const f32x4 v0 = acc[ai][bj][m][0] * 16.0f, v1 = acc[ai][bj][m][1] * 16.0f;
                        int w0 = 0, w1 = 0;
                        w0 = __builtin_amdgcn_cvt_pk_fp8_f32(v0[0], v0[1], w0, false); w0 = __builtin_amdgcn_cvt_pk_fp8_f32(v0[2], v0[3], w0, true);
                        w1 = __builtin_amdgcn_cvt_pk_fp8_f32(v1[0], v1[1], w1, false); w1 = __builtin_amdgcn_cvt_pk_fp8_f32(v1[2], v1[3], w1, true);
                        *(u32x2*)(rp + bj * 128) = (u32x2){(unsigned)w0, (unsigned)w1}; }
                }
            }
        }
    }
};

struct Frame {
    LAS unsigned char* lds; int tid, lane, wave, G, bid, gw, NGW, vcu;
    unsigned char* ws; float* out;
};

__device__ __forceinline__ void transpose_item(const float* W, int ldw, int k0, int n0, bf16_t* WT, int ldt, int drow0, LAS float* scr, int lane) {
    const int lk = lane >> 4, n4 = (lane & 15) * 4;
#pragma unroll 8
    for (int i = 0; i < 16; ++i) { const int k = 4 * i + lk; const f32x4 v = *(const f32x4*)(W + (size_t)(k0 + k) * ldw + n0 + n4);
        *(LAS f32x4*)(scr + k * 64 + (n4 ^ (((k >> 3) & 7) << 2))) = v; }
    LDS_WAIT(); asm volatile("" ::: "memory");
    const int c = lane & 7;
#pragma unroll
    for (int j = 0; j < 8; ++j) { const int n = (lane >> 3) + 8 * j; const LAS float* sp = scr + (8 * c) * 64 + (n ^ (c << 2));
        u32x4 o; o.x = pk2(sp[0 * 64], sp[1 * 64]); o.y = pk2(sp[2 * 64], sp[3 * 64]); o.z = pk2(sp[4 * 64], sp[5 * 64]); o.w = pk2(sp[6 * 64], sp[7 * 64]);
        *(u32x4*)(WT + (size_t)(drow0 + n) * ldt + k0 + 8 * c) = o; }
    LDS_WAIT(); asm volatile("" ::: "memory");
}
__device__ __forceinline__ void conv_expert_item(const float* wg, const float* wu, const float* wd, bf16_t* t1, bf16_t* t2, int which, int rr, LAS float* scr, int lane) {
    if (which < 2) { const int kb = rr >> 2, nb = rr & 3, n0 = 64 * nb;
        transpose_item(which == 0 ? wg : wu, 256, 64 * kb, n0, t1, 1024, (n0 >> 7) * 256 + (n0 & 127) + which * 128, scr, lane);
    } else { const int kb = rr >> 4, nb = rr & 15; transpose_item(wd, 1024, 64 * kb, 64 * nb, t2, 256, 64 * nb, scr, lane); }
}
__device__ __forceinline__ void conv_moe_layer(const Frame& F, CArgsP a, int l) {
    LAS float* scr = (LAS float*)(F.lds + F.wave * 16384);
    for (int it = F.gw; it < 64 * 3 * 64; it += F.NGW) {
        const int idx = it >> 6, e = idx / 3, which = idx - e * 3, rr = it & 63; const size_t eo = (size_t)(l * 64 + e) * 262144;
        conv_expert_item(a->in[30] + eo, a->in[31] + eo, a->in[32] + eo, (bf16_t*)(F.ws + WS_WM1) + (size_t)e * 524288, (bf16_t*)(F.ws + WS_WM2) + (size_t)e * 262144, which, rr, scr, F.lane);
    }
}

__device__ __forceinline__ void phase_prologue(const Frame& F, CArgsP a) {
    LAS float* scr = (LAS float*)(F.lds + F.wave * 16384);
    constexpr int I_IN = 2 * 1664, I_BR = 6 * 128, I_OUT = 2 * 256, I_SH = 6 * 64;
    for (int it0 = F.gw; it0 < I_IN + I_BR + I_OUT + I_SH; it0 += F.NGW) {
        int it = it0;
        if (it < I_IN) { const int l = it / 1664, r = it - l * 1664, kb = r / 104, nb = r - kb * 104;
            transpose_item(a->in[6] + (size_t)l * 1024 * INC, INC, 64 * kb, 64 * nb, (bf16_t*)(F.ws + WS_WIN) + (size_t)l * INC * 1024, 1024, 64 * nb, scr, F.lane); continue; }
        it -= I_IN;
        if (it < I_BR) { const int idx = it >> 7, rr = it & 127, kb = rr >> 4, nb = rr & 15;
            transpose_item(a->in[24] + (size_t)idx * 512 * 1024, 1024, 64 * kb, 64 * nb, (bf16_t*)(F.ws + WS_WBR) + (size_t)idx * 1024 * 512, 512, 64 * nb, scr, F.lane); continue; }
        it -= I_BR;
        if (it < I_OUT) { const int l = it >> 8, rr = it & 255, kb = rr >> 4, nb = rr & 15;
            transpose_item(a->in[25] + (size_t)l * 1048576, 1024, 64 * kb, 64 * nb, (bf16_t*)(F.ws + WS_WOUT) + (size_t)l * 1048576, 1024, 64 * nb, scr, F.lane); continue; }
        it -= I_OUT;
        { const int idx = it >> 6, l = idx / 3, which = idx - l * 3, rr = it & 63; const size_t lo = (size_t)l * 262144;
          conv_expert_item(a->in[33] + lo, a->in[34] + lo, a->in[35] + lo, (bf16_t*)(F.ws + WS_WSH1) + (size_t)l * 524288, (bf16_t*)(F.ws + WS_WSH2) + (size_t)l * 262144, which, rr, scr, F.lane); }
    }
    conv_moe_layer(F, a, 0);
    { const int gt = F.bid * NTHR + F.tid, NG = F.G * NTHR;
      bf16_t* wl = (bf16_t*)(F.ws + WS_WLRU);
      for (int i = gt; i < 2 * 2 * 2 * 8 * 4096; i += NG) {
          const int ii = i & 63, j = (i >> 6) & 63, cb = (i >> 12) & 7, ax = (i >> 15) & 1, d = (i >> 16) & 1, l = i >> 17;
          const float* src = ax == 0 ? a->in[19] : a->in[21];
          wl[i] = (bf16_t)f2bf(src[(size_t)((l * 2 + d) * 8 + cb) * 4096 + ii * 64 + j]); }
      bf16_t* wrt = (bf16_t*)(F.ws + WS_WRT);
      for (int i = gt; i < 2 * 64 * 1024; i += NG) { const int k = i & 1023, e = (i >> 10) & 63, l = i >> 16; wrt[i] = (bf16_t)f2bf(a->in[28][(size_t)(l * 1024 + k) * 64 + e]); }
      bf16_t* wsg = (bf16_t*)(F.ws + WS_WSG);
      for (int i = gt; i < 2 * 4 * 128 * 128; i += NG) wsg[i] = (bf16_t)f2bf(a->in[15][i]);
      if (F.bid == 0) { float* rope = (float*)(F.ws + WS_ROPE);
          for (int t = F.tid; t < 1024; t += NTHR) { const int p = t >> 4, f = t & 15; const float inv = powf(10000.0f, -(float)f / 16.0f); const float ang = (float)p * inv; rope[2 * t] = cosf(ang); rope[2 * t + 1] = sinf(ang); } }
      if (F.bid == (1 % F.G) && F.wave == 0) { float* lam = (float*)(F.ws + WS_LAM);
#pragma unroll
          for (int l = 0; l < 2; ++l) { const float s1 = wave_sum(a->in[8][l * 64 + F.lane] * a->in[9][l * 64 + F.lane]), s2 = wave_sum(a->in[10][l * 64 + F.lane] * a->in[11][l * 64 + F.lane]);
              const float li = 0.8f - 0.6f * expf(-0.3f * (float)l); if (F.lane == 0) lam[l] = expf(s1) - expf(s2) + li; } }
    }
    __syncthreads();
    LAS float* sl = (LAS float*)(F.lds);
    for (int i = F.tid; i < 5 * 1024; i += NTHR) { const int b = i >> 10, k = i & 1023; const float cv = b < 4 ? a->in[1][b * 1024 + k] : a->in[3][k]; sl[i] = silu_(cv); }
    __syncthreads();
    float* mod = (float*)(F.ws + WS_MOD);
    LAS float* part = (LAS float*)(F.lds + 20480);
    for (int c = F.bid; c < 192; c += F.G) {
        const int l = c / 96, cg = c - l * 96, col = F.tid & 63, ks = F.wave, n = cg * 64 + col;
        const float* w = a->in[4] + ((size_t)l * 1024 + ks * 128) * 6144 + n;
        float acc[5] = {0.f, 0.f, 0.f, 0.f, 0.f};
#pragma unroll 8
        for (int k = 0; k < 128; ++k) { const float wv = w[(size_t)k * 6144];
#pragma unroll
            for (int b = 0; b < 5; ++b) acc[b] += sl[b * 1024 + ks * 128 + k] * wv; }
#pragma unroll
        for (int b = 0; b < 5; ++b) part[(ks * 5 + b) * 64 + col] = acc[b];
        __syncthreads();
        if (F.tid < 320) { const int b = F.tid >> 6; float s = a->in[5][l * 6144 + n];
#pragma unroll
            for (int k8 = 0; k8 < 8; ++k8) s += part[(k8 * 5 + b) * 64 + col];
            mod[(l * 5 + b) * 6144 + n] = s; }
        __syncthreads();
    }
}

__device__ __forceinline__ void row_load(const float* p, int lane, f32x4 (&v)[4]) {
#pragma unroll
    for (int j = 0; j < 4; ++j) v[j] = *(const f32x4*)(p + 4 * lane + 256 * j);
}
__device__ __forceinline__ void row_load_bf16(const float* p, int lane, f32x4 (&v)[4]) {
#pragma unroll
    for (int j = 0; j < 4; ++j) { const u32x2 w = *(const u32x2*)((const bf16_t*)p + 4 * lane + 256 * j); v[j] = (f32x4){bflo(w.x), bfhi(w.x), bflo(w.y), bfhi(w.y)}; }
}
__device__ __forceinline__ void row_store(float* p, int lane, const f32x4 (&v)[4]) {
#pragma unroll
    for (int j = 0; j < 4; ++j) *(f32x4*)(p + 4 * lane + 256 * j) = v[j];
}
__device__ __forceinline__ void row_ln(f32x4 (&v)[4]) {
    float s = 0.f;
#pragma unroll
    for (int j = 0; j < 4; ++j) s += (v[j][0] + v[j][1]) + (v[j][2] + v[j][3]);
    const float mean = wave_sum(s) * (1.f / DM); float q = 0.f;
#pragma unroll
    for (int j = 0; j < 4; ++j) { v[j] = v[j] - mean; q += (v[j][0] * v[j][0] + v[j][1] * v[j][1]) + (v[j][2] * v[j][2] + v[j][3] * v[j][3]); }
    const float rstd = __builtin_amdgcn_rsqf(wave_sum(q) * (1.f / DM) + LN_EPS);
#pragma unroll
    for (int j = 0; j < 4; ++j) v[j] = v[j] * rstd;
}
__device__ __forceinline__ void row_affine(f32x4 (&v)[4], const float* scale1p  , bool plus1, const float* shift, int lane) {
#pragma unroll
    for (int j = 0; j < 4; ++j) { const f32x4 sc = *(const f32x4*)(scale1p + 4 * lane + 256 * j), sh = *(const f32x4*)(shift + 4 * lane + 256 * j);
        v[j] = plus1 ? v[j] * (sc + 1.0f) + sh : v[j] * sc + sh; }
}
__device__ __forceinline__ void row_store_bf16(bf16_t* p, int lane, const f32x4 (&v)[4]) {
#pragma unroll
    for (int j = 0; j < 4; ++j) { u32x2 w; w.x = pk2(v[j][0], v[j][1]); w.y = pk2(v[j][2], v[j][3]); *(u32x2*)(p + 4 * lane + 256 * j) = w; }
}

__device__ __forceinline__ void phase_rows0(const Frame& F, CArgsP a) {
    const float* mod = (const float*)(F.ws + WS_MOD); float* xc = (float*)(F.ws + WS_XC); bf16_t* H = (bf16_t*)(F.ws + WS_H);
    for (int tok = F.gw; tok < T; tok += F.NGW) {
        const int b = tok / TPB, j = tok - b * TPB; const bool isc = j < CTX;
        const float* src = isc ? a->in[2] + (size_t)(b * CTX + j) * DM : a->in[0] + (size_t)(b * SEQ + j - CTX) * DM;
        f32x4 v[4]; row_load(src, F.lane, v);
        row_store_bf16((bf16_t*)resid_row(F.out, xc, tok), F.lane, v);
        row_ln(v);
        const float* mrow = mod + (isc ? 4 : b) * 6144;
        row_affine(v, mrow + 1024, true, mrow, F.lane);
        row_store_bf16(H + (size_t)tok * DM, F.lane, v);
    }
}

__device__ __forceinline__ void sg_item(const Frame& F, CArgsP a, int l, int chunk, int g) {
    LAS bf16_t* vgT = (LAS bf16_t*)F.lds;
    const bf16_t* Sb = (const bf16_t*)(F.ws + OV_S); const bf16_t* Ub = (const bf16_t*)(F.ws + OV_U); bf16_t* OB = (bf16_t*)(F.ws + OV_OB);
    const int tok0 = chunk * 128;
    { const int q = F.tid >> 2, qt = F.tid & 3;
      const bf16_t* sp = Sb + (size_t)(tok0 + q) * 512 + g * 128 + qt * 32;
      float x[32];
#pragma unroll
      for (int i = 0; i < 4; ++i) { const u32x4 w = *(const u32x4*)(sp + 8 * i);
          x[8 * i + 0] = gelu_tanh(bflo(w.x)); x[8 * i + 1] = gelu_tanh(bfhi(w.x)); x[8 * i + 2] = gelu_tanh(bflo(w.y)); x[8 * i + 3] = gelu_tanh(bfhi(w.y)); x[8 * i + 4] = gelu_tanh(bflo(w.z)); x[8 * i + 5] = gelu_tanh(bfhi(w.z)); x[8 * i + 6] = gelu_tanh(bflo(w.w)); x[8 * i + 7] = gelu_tanh(bfhi(w.w)); }
      float s = 0.f;
#pragma unroll
      for (int i = 0; i < 32; ++i) s += x[i];
      s += __shfl_xor(s, 1); s += __shfl_xor(s, 2); const float mean = s * (1.f / 128.f); float qq = 0.f;
#pragma unroll
      for (int i = 0; i < 32; ++i) { x[i] -= mean; qq += x[i] * x[i]; }
      qq += __shfl_xor(qq, 1); qq += __shfl_xor(qq, 2); const float rstd = 1.f / sqrtf(qq * (1.f / 128.f) + LN_EPS);
      const float* lg = a->in[13] + l * 512 + g * 128 + qt * 32; const float* lb = a->in[14] + l * 512 + g * 128 + qt * 32;
#pragma unroll
      for (int i = 0; i < 32; ++i) vgT[(qt * 32 + i) * 136 + q] = (bf16_t)f2bf(x[i] * rstd * lg[i] + lb[i]);
    }
    __syncthreads();
    const int w = F.wave, fr = F.lane & 15, fq = F.lane >> 4;
    bf16x8 af[4];
#pragma unroll
    for (int ks = 0; ks < 4; ++ks) af[ks] = *(const LAS bf16x8*)(vgT + (w * 16 + fr) * 136 + ks * 32 + fq * 8);
    const bf16_t* W = (const bf16_t*)(F.ws + WS_WSG) + (size_t)(l * 4 + g) * 16384;
    const float* bs = a->in[16] + (l * 4 + g) * 128;
#pragma unroll 2
    for (int n = 0; n < 8; ++n) {
        f32x4 d = {0.f, 0.f, 0.f, 0.f};
#pragma unroll
        for (int ks = 0; ks < 4; ++ks) { const bf16x8 bfv = *(const bf16x8*)(W + (n * 16 + fr) * 128 + ks * 32 + fq * 8); d = __builtin_amdgcn_mfma_f32_16x16x32_bf16(af[ks], bfv, d, 0, 0, 0); }
        const int p = n * 16 + fr, c0 = w * 16 + fq * 4; const float bsp = bs[p];
        const size_t off = (size_t)(tok0 + p) * 512 + g * 128 + c0;
        const u32x2 uu = *(const u32x2*)(Ub + off);
        u32x2 o; o.x = pk2(gelu_tanh(bflo(uu.x)) * (d[0] + bsp), gelu_tanh(bfhi(uu.x)) * (d[1] + bsp)); o.y = pk2(gelu_tanh(bflo(uu.y)) * (d[2] + bsp), gelu_tanh(bfhi(uu.y)) * (d[3] + bsp));
        *(u32x2*)(OB + off) = o;
    }
    __syncthreads();
}

template <bool REV>
__device__ __forceinline__ void lru_scan(const f32x4 (&av)[4], const f32x4 (&bv)[4], f32x4 (&hv)[4], int lane, int mode, float hin, float& sumA, float& sumH) {
#define LRU_MI(k) (REV ? 3 - (k) : (k))
    const int fr = lane & 15, fq = lane >> 4, q = REV ? 3 - fq : fq;
    const int s1 = REV ? lane + 16 : lane - 16, s2 = REV ? lane + 32 : lane - 32, st = REV ? fr : 48 + fr;
    float Ea[4], Eh[4], Ta[4], Th[4];
#pragma unroll
    for (int m = 0; m < 4; ++m) {
        float A = 1.f, H = 0.f;
#pragma unroll
        for (int rk = 0; rk < 4; ++rk) { const int r = LRU_MI(rk); H = av[m][r] * H + bv[m][r]; A *= av[m][r]; }
        float pa = __shfl(A, s1), ph = __shfl(H, s1); if (q >= 1) { H = A * ph + H; A *= pa; }
        pa = __shfl(A, s2); ph = __shfl(H, s2); if (q >= 2) { H = A * ph + H; A *= pa; }
        float ea = __shfl(A, s1), eh = __shfl(H, s1); if (q == 0) { ea = 1.f; eh = 0.f; }
        Ea[m] = ea; Eh[m] = eh; Ta[m] = __shfl(A, st); Th[m] = __shfl(H, st);
    }
    if (mode == 0) {
        float A = 1.f, H = 0.f;
#pragma unroll
        for (int mk = 0; mk < 4; ++mk) { const int m = LRU_MI(mk); H = Ta[m] * H + Th[m]; A *= Ta[m]; }
        sumA = A; sumH = H;
    } else {
        float S = hin;
#pragma unroll
        for (int mk = 0; mk < 4; ++mk) { const int m = LRU_MI(mk); float h = Ea[m] * S + Eh[m];
#pragma unroll
            for (int rk = 0; rk < 4; ++rk) { const int r = LRU_MI(rk); h = av[m][r] * h + bv[m][r]; hv[m][r] = h; }
            S = Ta[m] * S + Th[m]; }
    }
#undef LRU_MI
}
struct LruConst { f32x4 cw[4][2]; f32x4 cbias[2]; bf16x8 wa0, wa1, wx0, wx1; float ba, bx, sp; };
struct LruIn { u32x4 x[4]; u32x4 y; float hin; };
__device__ __forceinline__ void lru_load_const(const Frame& F, CArgsP a, int l, int cb, LruConst& c) {
    const int lane = F.lane, fr = lane & 15, fq = lane >> 4, d = F.wave >> 2, nt = F.wave & 3, ch0 = cb * 64, c8 = (F.tid & 7) * 8;
    const bf16_t* Wa = (const bf16_t*)(F.ws + WS_WLRU) + (size_t)((l * 4 + d * 2) * 8 + cb) * 4096 + (nt * 16 + fr) * 64 + fq * 8;
    c.wa0 = *(const bf16x8*)(Wa); c.wa1 = *(const bf16x8*)(Wa + 32); c.wx0 = *(const bf16x8*)(Wa + 8 * 4096); c.wx1 = *(const bf16x8*)(Wa + 8 * 4096 + 32);
    const int pidx = (l * 2 + d) * 512 + ch0 + nt * 16 + fr;
    c.ba = a->in[20][pidx]; c.bx = a->in[22][pidx]; c.sp = log1pf(expf(-a->in[23][pidx]));
#pragma unroll
    for (int jj = 0; jj < 4; ++jj) { c.cw[jj][0] = *(const f32x4*)(a->in[17] + l * 2048 + jj * 512 + ch0 + c8); c.cw[jj][1] = *(const f32x4*)(a->in[17] + l * 2048 + jj * 512 + ch0 + c8 + 4); }
    c.cbias[0] = *(const f32x4*)(a->in[18] + l * 512 + ch0 + c8); c.cbias[1] = *(const f32x4*)(a->in[18] + l * 512 + ch0 + c8 + 4);
}
__device__ __forceinline__ void lru_load_in(const Frame& F, int b, int chunk, int cb, int mode, LruIn& in) {
    const bf16_t* Xb = (const bf16_t*)(F.ws + OV_X); const bf16_t* Yb = (const bf16_t*)(F.ws + OV_Y);
    const int ch0 = cb * 64, ct = F.tid >> 3, c8 = (F.tid & 7) * 8, d = F.wave >> 2, ch = (F.wave & 3) * 16 + (F.lane & 15);
    const int seg_lo = chunk < 4 ? 0 : 256, seg_hi = chunk < 4 ? 256 : TPB, j0 = chunk * 64;
#pragma unroll
    for (int jj = 0; jj < 4; ++jj) { const int j = j0 + ct + jj - 2; in.x[jj] = (u32x4){0u, 0u, 0u, 0u}; if (j >= seg_lo && j < seg_hi) in.x[jj] = *(const u32x4*)(Xb + (size_t)(b * TPB + j) * 512 + ch0 + c8); }
    in.y = (u32x4){0u, 0u, 0u, 0u}; in.hin = 0.f;
    if (mode == 1) { in.y = *(const u32x4*)(Yb + (size_t)(b * TPB + j0 + ct) * 512 + ch0 + c8); in.hin = ((const float*)(F.ws + WS_HIN))[(size_t)((b * 2 + d) * 68 + chunk) * 512 + ch0 + ch]; }
}
__device__ __forceinline__ void lru_compute(const Frame& F, const LruConst& c, const LruIn& in, int b, int chunk, int cb, int mode) {
    LAS float* xs = (LAS float*)F.lds;
    LAS bf16_t* xsb = (LAS bf16_t*)(F.lds + 16384);
    LAS float* hx = (LAS float*)(F.lds + 25600);
    bf16_t* OC = (bf16_t*)(F.ws + OV_OC);
    const int tok0 = b * TPB + chunk * 64, ch0 = cb * 64;
    const int lane = F.lane, fr = lane & 15, fq = lane >> 4, d = F.wave >> 2, nt = F.wave & 3, ch = nt * 16 + fr;
    const int ct = F.tid >> 3, c8 = (F.tid & 7) * 8;
    {
      f32x4 a0 = c.cbias[0], a1 = c.cbias[1];
#pragma unroll
      for (int jj = 0; jj < 4; ++jj) { const u32x4 w = in.x[jj];
          a0 += c.cw[jj][0] * (f32x4){bflo(w.x), bfhi(w.x), bflo(w.y), bfhi(w.y)}; a1 += c.cw[jj][1] * (f32x4){bflo(w.z), bfhi(w.z), bflo(w.w), bfhi(w.w)}; }
      *(LAS f32x4*)(xs + ct * 64 + c8) = a0; *(LAS f32x4*)(xs + ct * 64 + c8 + 4) = a1;
      u32x4 pw; pw.x = pk2(a0[0], a0[1]); pw.y = pk2(a0[2], a0[3]); pw.z = pk2(a1[0], a1[1]); pw.w = pk2(a1[2], a1[3]);
      *(LAS u32x4*)(xsb + ct * 72 + c8) = pw; }
    __syncthreads();
    f32x4 av[4], bv[4], hv[4];
#pragma unroll
    for (int m = 0; m < 4; ++m) {
        const bf16x8 a0 = *(const LAS bf16x8*)(xsb + (m * 16 + fr) * 72 + fq * 8), a1 = *(const LAS bf16x8*)(xsb + (m * 16 + fr) * 72 + 32 + fq * 8);
        f32x4 da = {0.f, 0.f, 0.f, 0.f}, dx = {0.f, 0.f, 0.f, 0.f};
        da = __builtin_amdgcn_mfma_f32_16x16x32_bf16(a0, c.wa0, da, 0, 0, 0); da = __builtin_amdgcn_mfma_f32_16x16x32_bf16(a1, c.wa1, da, 0, 0, 0);
        dx = __builtin_amdgcn_mfma_f32_16x16x32_bf16(a0, c.wx0, dx, 0, 0, 0); dx = __builtin_amdgcn_mfma_f32_16x16x32_bf16(a1, c.wx1, dx, 0, 0, 0);
#pragma unroll
        for (int r = 0; r < 4; ++r) { const float rg = sigmoidf_(da[r] + c.ba), ig = sigmoidf_(dx[r] + c.bx); const float la = -8.0f * rg * c.sp;
            const float e1 = expm1_fast(la);
            av[m][r] = 1.0f + e1; bv[m][r] = __builtin_amdgcn_sqrtf(-e1 * (2.0f + e1)) * (ig * xs[(m * 16 + fq * 4 + r) * 64 + ch]); hv[m][r] = 0.f; }
    }
    float sumA = 1.f, sumH = 0.f;
    if (d == 0) lru_scan<false>(av, bv, hv, lane, mode, in.hin, sumA, sumH); else lru_scan<true>(av, bv, hv, lane, mode, in.hin, sumA, sumH);
    if (mode == 0) {
        if (fq == 0) { float* sum = (float*)(F.ws + WS_SUM) + ((size_t)((b * 2 + d) * 68 + chunk) * 512 + ch0 + ch) * 2; *(float2*)sum = make_float2(sumA, sumH); }
        __syncthreads();
        return;
    }
#pragma unroll
    for (int m = 0; m < 4; ++m)
#pragma unroll
        for (int r = 0; r < 4; ++r) hx[d * 4096 + (m * 16 + fq * 4 + r) * 64 + ch] = hv[m][r];
    __syncthreads();
    { const u32x4 yv = in.y;
      const f32x4 f0 = *(const LAS f32x4*)(hx + ct * 64 + c8), f1 = *(const LAS f32x4*)(hx + ct * 64 + c8 + 4), g0 = *(const LAS f32x4*)(hx + 4096 + ct * 64 + c8), g1 = *(const LAS f32x4*)(hx + 4096 + ct * 64 + c8 + 4);
      u32x4 o; o.x = pk2(gelu_tanh(bflo(yv.x)) * (f0[0] + g0[0]), gelu_tanh(bfhi(yv.x)) * (f0[1] + g0[1])); o.y = pk2(gelu_tanh(bflo(yv.y)) * (f0[2] + g0[2]), gelu_tanh(bfhi(yv.y)) * (f0[3] + g0[3]));
      o.z = pk2(gelu_tanh(bflo(yv.z)) * (f1[0] + g1[0]), gelu_tanh(bfhi(yv.z)) * (f1[1] + g1[1])); o.w = pk2(gelu_tanh(bflo(yv.w)) * (f1[2] + g1[2]), gelu_tanh(bfhi(yv.w)) * (f1[3] + g1[3]));
      *(u32x4*)(OC + (size_t)(tok0 + ct) * 512 + ch0 + c8) = o; }
}
__device__ __forceinline__ void lru_phase(const Frame& F, CArgsP a, int l, int mode, bool skip_ctx) {
    constexpr int NIT = 4 * 68 * 8;
    int it = F.bid;
    while (it < NIT && skip_ctx && ((it >> 3) % 68) < 4) it += F.G;
    if (it >= NIT) return;
    LruConst c; LruIn cur, nxt;
    int cb = it & 7; lru_load_const(F, a, l, cb, c);
    lru_load_in(F, (it >> 3) / 68, (it >> 3) % 68, cb, mode, cur);
    for (;;) {
        int nit = it + F.G;
        while (nit < NIT && skip_ctx && ((nit >> 3) % 68) < 4) nit += F.G;
        const bool has = nit < NIT;
        if (has) lru_load_in(F, (nit >> 3) / 68, (nit >> 3) % 68, nit & 7, mode, nxt);
        lru_compute(F, c, cur, (it >> 3) / 68, (it >> 3) % 68, cb, mode);
        if (!has) break;
        if ((nit & 7) != cb) { cb = nit & 7; lru_load_const(F, a, l, cb, c); }
        it = nit; cur = nxt;
    }
}

__device__ __forceinline__ void phase_carry(const Frame& F) {
    const int gt = F.bid * NTHR + F.tid; if (gt >= 4 * 2 * 512) return;
    const int c = gt & 511, d = (gt >> 9) & 1, b = gt >> 10;
    const float* sum = (const float*)(F.ws + WS_SUM) + (size_t)((b * 2 + d) * 68) * 1024 + c * 2;
    float* hin = (float*)(F.ws + WS_HIN) + (size_t)((b * 2 + d) * 68) * 512 + c;
    float h = 0.f;
#pragma unroll 1
    for (int g0 = 0; g0 < 68; g0 += 17) {
        float A[17], Hh[17];
#pragma unroll
        for (int i = 0; i < 17; ++i) { const int o = g0 + i; const int ck = d == 0 ? o : (o < 4 ? 3 - o : 71 - o); const float2 v = *(const float2*)(sum + (size_t)ck * 1024); A[i] = v.x; Hh[i] = v.y; }
#pragma unroll
        for (int i = 0; i < 17; ++i) { const int o = g0 + i; const int ck = d == 0 ? o : (o < 4 ? 3 - o : 71 - o); hin[(size_t)ck * 512] = h; h = A[i] * h + Hh[i]; }
    }
}

constexpr int AT_KST = 272, AT_VST = 320;
constexpr int AT_KOFF = 0, AT_VOFF = 2 * 64 * AT_KST, AT_XOFF = AT_VOFF + 2 * 64 * AT_VST;
#define AT_SBAR() __builtin_amdgcn_sched_barrier(0)
struct AttnState { f32x16 o[4]; f32x16 negm; bf16x8 pfp[4]; float lrun; };
#define AT_PIN1(x) asm volatile("" : "+v"(x))
__device__ __forceinline__ float at_max3(float a, float b, float c) { float r; asm("v_max3_f32 %0, %1, %2, %3" : "=v"(r) : "v"(a), "v"(b), "v"(c)); return r; }
__device__ __forceinline__ bf16x8 at_vfrag(const LAS unsigned char* vp) {
    const s16x4 lo = __builtin_bit_cast(s16x4, __builtin_amdgcn_ds_read_tr16_b64_v4i16((LAS s16x4*)(vp)));
    const s16x4 hh = __builtin_bit_cast(s16x4, __builtin_amdgcn_ds_read_tr16_b64_v4i16((LAS s16x4*)(vp + 8 * AT_VST)));
    return (bf16x8){lo[0], lo[1], lo[2], lo[3], hh[0], hh[1], hh[2], hh[3]};
}
__device__ __forceinline__ float attn_stage1(const AttnState& st, const f32x16& p0, const f32x16& p1, f32x16& n0, f32x16& n1, const LAS unsigned char* ql, const LAS unsigned char* kf) {
    bf16x8 a0 = *(const LAS bf16x8*)(kf), a1 = *(const LAS bf16x8*)(kf + 32 * AT_KST), q = *(const LAS bf16x8*)(ql);
    AT_SBAR();
    float mx = at_max3(p0[0], p0[1], at_max3(p1[0], p1[1], p1[1]));
    mx = at_max3(at_max3(mx, p0[2], p0[3]), p1[2], p1[3]); mx = at_max3(at_max3(mx, p0[4], p0[5]), p1[4], p1[5]); AT_PIN1(mx);
    AT_SBAR();
#pragma unroll
    for (int ks = 0; ks < 4; ++ks) {
        bf16x8 b0 = a0, b1 = a1, qn = q;
        if (ks < 3) { b0 = *(const LAS bf16x8*)(kf + (ks + 1) * 32); b1 = *(const LAS bf16x8*)(kf + 32 * AT_KST + (ks + 1) * 32); qn = *(const LAS bf16x8*)(ql + (ks + 1) * 1024); }
        if (ks == 0) n0 = __builtin_amdgcn_mfma_f32_32x32x16_bf16(a0, q, st.negm, 0, 0, 0);
        else n0 = __builtin_amdgcn_mfma_f32_32x32x16_bf16(a0, q, n0, 0, 0, 0);
        if (ks < 3) { mx = at_max3(at_max3(mx, p0[4 * ks + 6], p0[4 * ks + 7]), p1[4 * ks + 6], p1[4 * ks + 7]); AT_PIN1(mx); } AT_SBAR();
        if (ks == 0) n1 = __builtin_amdgcn_mfma_f32_32x32x16_bf16(a1, q, st.negm, 0, 0, 0);
        else n1 = __builtin_amdgcn_mfma_f32_32x32x16_bf16(a1, q, n1, 0, 0, 0);
        if (ks < 2) { mx = at_max3(at_max3(mx, p0[4 * ks + 8], p0[4 * ks + 9]), p1[4 * ks + 8], p1[4 * ks + 9]); AT_PIN1(mx); } AT_SBAR();
        a0 = b0; a1 = b1; q = qn;
    }
    return mx;
}
template <bool FIRST>
__device__ __forceinline__ void attn_stage2(AttnState& st, f32x16& p0, f32x16& p1, f32x16& n0, f32x16& n1, float mx, const LAS unsigned char* vf) {
    constexpr float THR = 8.0f;
    bf16x8 vcur, vnx; if (!FIRST) { vcur = at_vfrag(vf); vnx = at_vfrag(vf + 64); }
    float tm; { auto rr = __builtin_amdgcn_permlane32_swap(__float_as_uint(mx), __float_as_uint(mx), false, false); tm = fmaxf(__uint_as_float(rr[0]), __uint_as_float(rr[1])); }
    if (FIRST || __any(tm > THR)) {
        const float dl = FIRST ? tm : fmaxf(tm, 0.f);
#pragma unroll
        for (int r = 0; r < 16; ++r) { p0[r] -= dl; p1[r] -= dl; n0[r] -= dl; n1[r] -= dl; st.negm[r] -= dl; }
        if (!FIRST) {
            const float al = __builtin_amdgcn_exp2f(-dl);
#pragma unroll
            for (int db = 0; db < 4; ++db)
#pragma unroll
                for (int r = 0; r < 16; ++r) st.o[db][r] *= al;
#pragma unroll
            for (int kk = 0; kk < 4; ++kk) { u32x4 w = __builtin_bit_cast(u32x4, st.pfp[kk]);
                w.x = pk2(bflo(w.x) * al, bfhi(w.x) * al); w.y = pk2(bflo(w.y) * al, bfhi(w.y) * al); w.z = pk2(bflo(w.z) * al, bfhi(w.z) * al); w.w = pk2(bflo(w.w) * al, bfhi(w.w) * al);
                st.pfp[kk] = __builtin_bit_cast(bf16x8, w); }
            st.lrun *= al;
        }
    }
    float ls = 0.f;
    AT_SBAR();
#pragma unroll
    for (int kk = 0; kk < 4; ++kk) {
        unsigned pw0 = 0, pw1 = 0, pw2 = 0, pw3 = 0;
#pragma unroll
        for (int db = 0; db < 4; ++db) {
            const int g = kk * 4 + db;
            if (!FIRST) {
                bf16x8 vn2 = vnx;
                if (g < 14) { const int g2 = g + 2; vn2 = at_vfrag(vf + ((g2 >> 2) * 16) * AT_VST + (g2 & 3) * 64); }
                st.o[db] = __builtin_amdgcn_mfma_f32_32x32x16_bf16(vcur, st.pfp[kk], st.o[db], 0, 0, 0);
                vcur = vnx; vnx = vn2;
            }
            const float x0 = g < 8 ? p0[2 * g] : p1[2 * g - 16], x1 = g < 8 ? p0[2 * g + 1] : p1[2 * g - 15];
            const float e0 = __builtin_amdgcn_exp2f(x0), e1 = __builtin_amdgcn_exp2f(x1);
            ls += e0 + e1; unsigned w = pk2(e0, e1); AT_PIN1(ls); AT_PIN1(w);
            if (db == 0) pw0 = w; else if (db == 1) pw1 = w; else if (db == 2) pw2 = w; else pw3 = w;
            AT_SBAR();
        }
        st.pfp[kk] = __builtin_bit_cast(bf16x8, (u32x4){pw0, pw1, pw2, pw3});
    }
    st.lrun += ls;
}
__device__ __forceinline__ void attn_unit(const Frame& F, int tokq0, int tokk0, int ntiles, int h, float lam, const float* gain, float oscale) {
    const bf16_t* Q = (const bf16_t*)(F.ws + OV_Q); const char* Kg = (const char*)(F.ws + OV_K); const char* Vg = (const char*)(F.ws + OV_V); bf16_t* OA = (bf16_t*)(F.ws + OV_OA);
    const int lane = F.lane, r32 = lane & 31, hi = lane >> 5, rb = F.wave >> 1, c = F.wave & 1;
    LAS unsigned char* ql = F.lds + AT_XOFF + F.wave * 4096 + lane * 16;
    { const bf16_t* qp = Q + (size_t)(tokq0 + rb * 32 + r32) * 512 + h * 128 + c * 64 + hi * 8;
#pragma unroll
      for (int ks = 0; ks < 4; ++ks) *(LAS bf16x8*)(ql + ks * 1024) = *(const bf16x8*)(qp + ks * 16); }
    const int srow0 = F.tid >> 4, sch = F.tid & 15;
    const unsigned goff = (unsigned)(((tokk0 + srow0) * 512 + h * 128 + sch * 8) * 2);
    LAS unsigned char* kl = F.lds + AT_KOFF + srow0 * AT_KST + sch * 16;
    LAS unsigned char* vl = F.lds + AT_VOFF + srow0 * AT_VST + sch * 16;
    const LAS unsigned char* kfb = F.lds + AT_KOFF + r32 * AT_KST + (c * 64 + hi * 8) * 2;
    const LAS unsigned char* vfb = F.lds + AT_VOFF + (4 * hi + ((lane & 15) >> 2)) * AT_VST + (((lane >> 4) & 1) * 16 + (lane & 3) * 4) * 2;
    {
      const u32x4 k0 = *(const u32x4*)(Kg + goff), k1 = *(const u32x4*)(Kg + goff + 32 * 1024), k2 = *(const u32x4*)(Kg + goff + 64 * 1024), k3 = *(const u32x4*)(Kg + goff + 96 * 1024);
      *(LAS u32x4*)(kl) = k0; *(LAS u32x4*)(kl + 32 * AT_KST) = k1; *(LAS u32x4*)(kl + 64 * AT_KST) = k2; *(LAS u32x4*)(kl + 96 * AT_KST) = k3; }
    __syncthreads();
    AttnState st; st.lrun = 0.f;
#pragma unroll
    for (int r = 0; r < 16; ++r) st.negm[r] = 0.f;
#pragma unroll
    for (int db = 0; db < 4; ++db)
#pragma unroll
        for (int r = 0; r < 16; ++r) st.o[db][r] = 0.f;
    f32x16 pa0, pa1, pb0, pb1;
#pragma unroll
    for (int r = 0; r < 16; ++r) { pa0[r] = 0.f; pa1[r] = 0.f; }
#pragma unroll
    for (int ks = 0; ks < 4; ++ks) {
        const bf16x8 a0 = *(const LAS bf16x8*)(kfb + ks * 32), a1 = *(const LAS bf16x8*)(kfb + 32 * AT_KST + ks * 32);
        const bf16x8 q = *(const LAS bf16x8*)(ql + ks * 1024);
        pa0 = __builtin_amdgcn_mfma_f32_32x32x16_bf16(a0, q, pa0, 0, 0, 0); pa1 = __builtin_amdgcn_mfma_f32_32x32x16_bf16(a1, q, pa1, 0, 0, 0);
    }
    asm volatile("s_nop 15\n\ts_nop 7" : "+v"(pa0), "+v"(pa1));
    u32x4 sv0 = *(const u32x4*)(Vg + goff), sv1 = *(const u32x4*)(Vg + goff + 32 * 1024);
#define AT_ITER(I, FIRSTF, PC0, PC1, PN0, PN1) do { \
        const int i_ = (I); const bool ldk_ = i_ + 2 < ntiles; const int sl_ = i_ & 1; \
        const float mx_ = attn_stage1(st, PC0, PC1, PN0, PN1, ql, kfb + ((i_ + 1) & 1) * (64 * AT_KST)); \
        *(LAS u32x4*)(vl + sl_ * (64 * AT_VST)) = sv0; *(LAS u32x4*)(vl + sl_ * (64 * AT_VST) + 32 * AT_VST) = sv1; \
        u32x4 sk0_, sk1_; if (ldk_) { const unsigned go_ = goff + (unsigned)(i_ + 2) * 65536u; sk0_ = *(const u32x4*)(Kg + go_); sk1_ = *(const u32x4*)(Kg + go_ + 32 * 1024); } \
        attn_stage2<FIRSTF>(st, PC0, PC1, PN0, PN1, mx_, vfb + ((i_ + 1) & 1) * (64 * AT_VST)); \
        if (ldk_) { *(LAS u32x4*)(kl + sl_ * (64 * AT_KST)) = sk0_; *(LAS u32x4*)(kl + sl_ * (64 * AT_KST) + 32 * AT_KST) = sk1_; } \
        if (i_ + 1 < ntiles) { const unsigned gv_ = goff + (unsigned)(i_ + 1) * 65536u; sv0 = *(const u32x4*)(Vg + gv_); sv1 = *(const u32x4*)(Vg + gv_ + 32 * 1024); } \
        __syncthreads(); } while (0)
    AT_ITER(0, true, pa0, pa1, pb0, pb1);
    AT_ITER(1, false, pb0, pb1, pa0, pa1);
#pragma unroll 1
    for (int i = 2; i < ntiles; i += 2) {
        AT_ITER(i, false, pa0, pa1, pb0, pb1);
        AT_ITER(i + 1, false, pb0, pb1, pa0, pa1);
    }
#undef AT_ITER
    {
      const LAS unsigned char* vf = vfb + ((ntiles - 1) & 1) * (64 * AT_VST);
#pragma unroll
      for (int db = 0; db < 4; ++db)
#pragma unroll
          for (int kk = 0; kk < 4; ++kk) {
              const LAS unsigned char* vp = vf + (kk * 16) * AT_VST + db * 64;
              const s16x4 lo = __builtin_bit_cast(s16x4, __builtin_amdgcn_ds_read_tr16_b64_v4i16((LAS s16x4*)(vp)));
              const s16x4 hh = __builtin_bit_cast(s16x4, __builtin_amdgcn_ds_read_tr16_b64_v4i16((LAS s16x4*)(vp + 8 * AT_VST)));
              const bf16x8 vfr = {lo[0], lo[1], lo[2], lo[3], hh[0], hh[1], hh[2], hh[3]};
              st.o[db] = __builtin_amdgcn_mfma_f32_32x32x16_bf16(vfr, st.pfp[kk], st.o[db], 0, 0, 0);
          } }
    float lrun = st.lrun; lrun += __shfl_xor(lrun, 32);
    const float il = 1.f / lrun;
    LAS float* ex = (LAS float*)(F.lds + AT_XOFF) + rb * 4096;
    if (c == 1) {
#pragma unroll
        for (int db = 0; db < 4; ++db)
#pragma unroll
            for (int r = 0; r < 16; ++r) ex[(db * 16 + r) * 64 + lane] = st.o[db][r] * il;
    }
    __syncthreads();
    if (c == 0) {
        float ss = 0.f;
#pragma unroll
        for (int db = 0; db < 4; ++db)
#pragma unroll
            for (int r = 0; r < 16; ++r) { const float dv = st.o[db][r] * il - lam * ex[(db * 16 + r) * 64 + lane]; st.o[db][r] = dv; ss += dv * dv; }
        ss += __shfl_xor(ss, 32);
        const float rinv = oscale / sqrtf(ss * (1.f / 128.f) + RMS_EPS);
        bf16_t* op = OA + (size_t)(tokq0 + rb * 32 + r32) * 512 + h * 128;
#pragma unroll
        for (int db = 0; db < 4; ++db)
#pragma unroll
            for (int r4 = 0; r4 < 4; ++r4) { const int dv0 = db * 32 + 8 * r4 + 4 * hi; const f32x4 gv = *(const f32x4*)(gain + dv0);
                u32x2 w; w.x = pk2(st.o[db][4 * r4] * rinv * gv[0], st.o[db][4 * r4 + 1] * rinv * gv[1]); w.y = pk2(st.o[db][4 * r4 + 2] * rinv * gv[2], st.o[db][4 * r4 + 3] * rinv * gv[3]);
                *(u32x2*)(op + dv0) = w; }
    }
    __syncthreads();
}

__device__ __forceinline__ void phase_attn(const Frame& F, CArgsP a, int l) {
    const float lam = ((const float*)(F.ws + WS_LAM))[l]; const float li = 0.8f - 0.6f * expf(-0.3f * (float)l);
    for (int dd = 0; dd < NDUP(6); ++dd) lru_phase(F, a, l, 1, l == 1);
    __syncthreads();
    const int nlat = 4 * 4 * 32, nctx = (l == 0) ? 4 * 4 * 2 : 0;
    for (int dd = 0; dd < NDUP(7); ++dd)
    for (int it = F.vcu; it < nlat + nctx; it += F.G) {
        int b, h, qb, tq0, nt;
        if (it < nlat) { qb = it & 31; h = (it >> 5) & 3; b = it >> 7; tq0 = b * TPB + CTX + qb * 128; nt = 68; }
        else { const int i2 = it - nlat; qb = i2 & 1; h = (i2 >> 1) & 3; b = i2 >> 3; tq0 = b * TPB + qb * 128; nt = 4; }
        attn_unit(F, tq0, b * TPB, nt, h, lam, a->in[12] + (l * 4 + h) * 128, 1.0f - li);
    }
}

__device__ __forceinline__ void mini_tile(const bf16_t* A, int lda, const bf16_t* Bt, int K, int lane, int wave, f32x4 (&acc)[2]) {
    const int fr = lane & 15, fq = lane >> 4;
    const bf16_t* ap = A + (size_t)((wave >> 1) * 16 + fr) * lda + fq * 8;
    const bf16_t* bp0 = Bt + (size_t)((wave & 1) * 32 + fr) * K + fq * 8; const bf16_t* bp1 = bp0 + (size_t)16 * K;
    acc[0] = (f32x4){0.f, 0.f, 0.f, 0.f}; acc[1] = (f32x4){0.f, 0.f, 0.f, 0.f};
#pragma unroll 8
    for (int k = 0; k < K; k += 32) {
        const bf16x8 av = *(const bf16x8*)(ap + k), b0 = *(const bf16x8*)(bp0 + k), b1 = *(const bf16x8*)(bp1 + k);
        acc[0] = __builtin_amdgcn_mfma_f32_16x16x32_bf16(b0, av, acc[0], 0, 0, 0); acc[1] = __builtin_amdgcn_mfma_f32_16x16x32_bf16(b1, av, acc[1], 0, 0, 0);
    }
}
__device__ __forceinline__ void mini_merge_ctx(const Frame& F, int l) {
    const int fr = F.lane & 15, fq = F.lane >> 4;
    for (int t = F.bid; t < 256; t += F.G) {
        const int rb = t >> 4, cbk = t & 15, cr = rb * 64, tok0 = (cr >> 8) * TPB + (cr & 255), col0 = cbk * 64;
        const int row = tok0 + (F.wave >> 1) * 16 + fr, colw = col0 + (F.wave & 1) * 32 + fq * 4;
        f32x4 mg[2] = {{0.f, 0.f, 0.f, 0.f}, {0.f, 0.f, 0.f, 0.f}};
#pragma unroll 1
        for (int r = 0; r < 3; ++r) {
            f32x4 acc[2];
            mini_tile((const bf16_t*)(F.ws + OV_OA + (size_t)r * 17 * MiB) + (size_t)tok0 * 512, 512, (const bf16_t*)(F.ws + WS_WBR) + (size_t)(l * 3 + r) * 1024 * 512 + (size_t)col0 * 512, 512, F.lane, F.wave, acc);
#pragma unroll
            for (int n = 0; n < 2; ++n) { const u32x2 g = *(const u32x2*)((const bf16_t*)(F.ws + OV_G) + (size_t)row * 3072 + r * 1024 + colw + n * 16);
                mg[n][0] += sigmoidf_(bflo(g.x)) * acc[n][0]; mg[n][1] += sigmoidf_(bfhi(g.x)) * acc[n][1]; mg[n][2] += sigmoidf_(bflo(g.y)) * acc[n][2]; mg[n][3] += sigmoidf_(bfhi(g.y)) * acc[n][3]; }
        }
#pragma unroll
        for (int n = 0; n < 2; ++n) { u32x2 w; w.x = pk2(mg[n][0], mg[n][1]); w.y = pk2(mg[n][2], mg[n][3]); *(u32x2*)((bf16_t*)(F.ws + OV_MG) + (size_t)row * DM + colw + n * 16) = w; }
    }
}
__device__ __forceinline__ void mini_wout_ctx(const Frame& F, int l) {
    const int fr = F.lane & 15, fq = F.lane >> 4;
    const float* g1 = (const float*)(F.ws + WS_MOD) + (l * 5 + 4) * 6144 + 2048;
    for (int t = F.bid; t < 256; t += F.G) {
        const int rb = t >> 4, cbk = t & 15, cr = rb * 64, tok0 = (cr >> 8) * TPB + (cr & 255), col0 = cbk * 64;
        const int crow = cr + (F.wave >> 1) * 16 + fr, colw = col0 + (F.wave & 1) * 32 + fq * 4;
        f32x4 acc[2];
        mini_tile((const bf16_t*)(F.ws + OV_MG) + (size_t)tok0 * DM, DM, (const bf16_t*)(F.ws + WS_WOUT) + (size_t)l * 1048576 + (size_t)col0 * 1024, 1024, F.lane, F.wave, acc);
#pragma unroll
        for (int n = 0; n < 2; ++n) { u32x2* p = (u32x2*)((bf16_t*)((float*)(F.ws + WS_XC) + (size_t)crow * DM) + colw + n * 16); const f32x4 gv = *(const f32x4*)(g1 + colw + n * 16); const u32x2 x = *p;
            u32x2 w; w.x = pk2(bflo(x.x) * DN_ALPHA + gv[0] * acc[n][0], bfhi(x.x) * DN_ALPHA + gv[1] * acc[n][1]); w.y = pk2(bflo(x.y) * DN_ALPHA + gv[2] * acc[n][2], bfhi(x.y) * DN_ALPHA + gv[3] * acc[n][3]); *p = w; }
    }
}

constexpr int RT_AST = 1032;
__device__ __forceinline__ void phase_router(const Frame& F, CArgsP a, int l, bool dry) {
    const float* mod = (const float*)(F.ws + WS_MOD) + l * 5 * 6144; float* xc = (float*)(F.ws + WS_XC); bf16_t* H = (bf16_t*)(F.ws + WS_H);
    LAS bf16_t* AT = (LAS bf16_t*)F.lds;
    LAS float* LG = (LAS float*)(F.lds + 32 * RT_AST * 2);
    LAS unsigned* LC = (LAS unsigned*)(F.lds + 32 * RT_AST * 2 + 8192);
    const bf16_t* Wt = (const bf16_t*)(F.ws + WS_WRT) + (size_t)l * 65536; const float rb_ = a->in[29][l * 64 + F.lane];
    unsigned* cnt = (unsigned*)(F.ws + WS_CNT) + l * 4096; int* list = (int*)(F.ws + WS_LIST);
    int* toke = (int*)(F.ws + WS_TOKE); int* tokp = (int*)(F.ws + WS_TOKP); float* tokw = (float*)(F.ws + WS_TOKW);
    const int nrows = l == 0 ? T : NBATCH * SEQ, nbatch = nrows / 32;
    const int fr = F.lane & 15, fq = F.lane >> 4, mt = F.wave & 1, nt = F.wave >> 1;
    if (F.tid < 64) LC[F.tid] = 0u;
    bf16x8 bfr[32];
    { const bf16_t* bp = Wt + (size_t)(nt * 16 + fr) * 1024 + fq * 8;
#pragma unroll
      for (int ks = 0; ks < 32; ++ks) bfr[ks] = *(const bf16x8*)(bp + ks * 32); }
    for (int bt = F.bid; bt < nbatch; bt += F.G) {
        int toks[4];
#pragma unroll
        for (int r = 0; r < 4; ++r) { const int ridx = bt * 32 + F.wave * 4 + r; toks[r] = l == 0 ? ridx : (ridx >> 12) * TPB + CTX + (ridx & 4095); }
#pragma unroll
        for (int rp = 0; rp < 4; rp += 2) {
        f32x4 vv[2][4];
        row_load_bf16(resid_row(F.out, xc, toks[rp]), F.lane, vv[0]); row_load_bf16(resid_row(F.out, xc, toks[rp + 1]), F.lane, vv[1]);
#pragma unroll
        for (int r2 = 0; r2 < 2; ++r2) { const int r = rp + r2; const int tok = toks[r];
            const int b = tok / TPB; const int bsel = (tok - b * TPB) < CTX ? 4 : b;
            float* xr = resid_row(F.out, xc, tok);
            f32x4 (&v)[4] = vv[r2]; row_ln(v); row_affine(v, a->in[26] + l * DM, false, a->in[27] + l * DM, F.lane);
            row_ln(v); const float* mrow = mod + bsel * 6144; row_affine(v, mrow + 4096, true, mrow + 3072, F.lane);
#pragma unroll
            for (int j = 0; j < 4; ++j) { u32x2 w; w.x = pk2(v[j][0], v[j][1]); w.y = pk2(v[j][2], v[j][3]);
                if (!dry) *(u32x2*)(H + (size_t)tok * DM + 4 * F.lane + 256 * j) = w; *(LAS u32x2*)(AT + (F.wave * 4 + r) * RT_AST + 4 * F.lane + 256 * j) = w; }
        }
        }
        __syncthreads();
        { f32x4 d = {0.f, 0.f, 0.f, 0.f};
          const LAS bf16_t* ap = AT + (mt * 16 + fr) * RT_AST + fq * 8;
#pragma unroll
          for (int ks = 0; ks < 32; ++ks) { const bf16x8 av = *(const LAS bf16x8*)(ap + ks * 32); d = __builtin_amdgcn_mfma_f32_16x16x32_bf16(av, bfr[ks], d, 0, 0, 0); }
#pragma unroll
          for (int r = 0; r < 4; ++r) LG[(mt * 16 + fq * 4 + r) * 64 + nt * 16 + fr] = d[r]; }
        __syncthreads();
        bool selr[4]; int rkr[4], lpr[4]; float wr_[4];
#pragma unroll
        for (int r = 0; r < 4; ++r) {
            const float lg = LG[(F.wave * 4 + r) * 64 + F.lane];
            const float s = sigmoidf_(lg); const float bsc = s + rb_;
            float m1 = bsc; m1 = fmaxf(m1, WS_DPP(m1, 0xB1, 0xF, true)); m1 = fmaxf(m1, WS_DPP(m1, 0x4E, 0xF, true)); m1 = fmaxf(m1, WS_DPP(m1, 0x141, 0xF, true));
            const unsigned long long eq = __ballot(bsc == m1); const unsigned gm = (unsigned)(eq >> (F.lane & ~7)) & 0xffu; const int first = __ffs(gm) - 1;
            float m2 = ((F.lane & 7) == first) ? -INFINITY : bsc; m2 = fmaxf(m2, WS_DPP(m2, 0xB1, 0xF, true)); m2 = fmaxf(m2, WS_DPP(m2, 0x4E, 0xF, true)); m2 = fmaxf(m2, WS_DPP(m2, 0x141, 0xF, true));
            const float gs = m1 + m2; const int myg = F.lane >> 3; int grank = 0;
#pragma unroll
            for (int g = 0; g < 8; ++g) { const float og = __builtin_bit_cast(float, __builtin_amdgcn_readlane(__builtin_bit_cast(int, gs), g * 8)); grank += (int)(og > gs) + (int)((og == gs) & (g < myg)); }
            const bool gsel = grank < 4; const float mk = gsel ? bsc : -INFINITY; int rk = 64;
            { float vv_ = mk;
#pragma unroll
              for (int k = 0; k < 8; ++k) {
                  float m = vv_; m = fmaxf(m, WS_DPP(m, 0xB1, 0xF, true)); m = fmaxf(m, WS_DPP(m, 0x4E, 0xF, true)); m = fmaxf(m, WS_DPP(m, 0x141, 0xF, true)); m = fmaxf(m, WS_DPP(m, 0x140, 0xF, true));
                  const float r1 = __builtin_bit_cast(float, __builtin_amdgcn_readlane(__builtin_bit_cast(int, m), 15)), r2 = __builtin_bit_cast(float, __builtin_amdgcn_readlane(__builtin_bit_cast(int, m), 31)),
                              r3 = __builtin_bit_cast(float, __builtin_amdgcn_readlane(__builtin_bit_cast(int, m), 47)), r4 = __builtin_bit_cast(float, __builtin_amdgcn_readlane(__builtin_bit_cast(int, m), 63));
                  const float wm = fmaxf(fmaxf(r1, r2), fmaxf(r3, r4));
                  const unsigned long long bal = __ballot(vv_ == wm); const int win = __ffsll((long long)bal) - 1;
                  if (F.lane == win) { rk = k; vv_ = -INFINITY; }
              } }
            const bool sel = gsel && rk < 8 && !dry;
            const float ssum = wave_sum((gsel && rk < 8) ? s : 0.f);
            selr[r] = sel; rkr[r] = rk; wr_[r] = s / ssum * 2.5f; lpr[r] = 0;
            if (sel) lpr[r] = (int)__hip_atomic_fetch_add((LAS unsigned*)(LC + F.lane), 1u, __ATOMIC_RELAXED, __HIP_MEMORY_SCOPE_WORKGROUP);
        }
        __syncthreads();
        if (F.tid < 64) { const unsigned n = LC[F.tid]; unsigned base = 0; if (n) base = atomicAdd(cnt + F.tid * 64, n); LC[64 + F.tid] = base; LC[F.tid] = 0u; }
        __syncthreads();
#pragma unroll
        for (int r = 0; r < 4; ++r)
            if (selr[r]) { const int tok = toks[r]; const int pos = (int)LC[64 + F.lane] + lpr[r];
                list[(size_t)F.lane * T + pos] = tok; toke[tok * 8 + rkr[r]] = F.lane; tokp[tok * 8 + rkr[r]] = pos; tokw[tok * 8 + rkr[r]] = wr_[r]; }
        __syncthreads();
    }
}

__device__ __forceinline__ void build_tables(const Frame& F, int l) {
    LAS int* tb = (LAS int*)(F.lds + LDS_CTL);
    __syncthreads();
    if (F.tid < 64) tb[LC_TCNT + F.tid] = (int)__hip_atomic_load((unsigned*)(F.ws + WS_CNT) + l * 4096 + F.tid * 64, __ATOMIC_RELAXED, __HIP_MEMORY_SCOPE_AGENT);
    __syncthreads();
    if (F.tid == 0) { int tbs = 0, sbs = 0;
        for (int e = 0; e < 64; ++e) { const int c = tb[LC_TCNT + e]; tb[LC_TBASE + e] = tbs; tb[LC_SBASE + e] = sbs; tbs += (c + 255) >> 8; sbs += c; }
        tb[LC_TBASE + 64] = tbs; tb[LC_SBASE + 64] = sbs; }
    __syncthreads();
}

__device__ __forceinline__ void phase_combine(const Frame& F, CArgsP a, int l, bool dry) {
    const float* mod = (const float*)(F.ws + WS_MOD) + l * 5 * 6144; float* xc = (float*)(F.ws + WS_XC); bf16_t* H = (bf16_t*)(F.ws + WS_H);
    const unsigned char* YS = (const unsigned char*)(F.ws + OV_YS); const LAS int* tb = (const LAS int*)(F.lds + LDS_CTL);
    const int* toke = (const int*)(F.ws + WS_TOKE); const int* tokp = (const int*)(F.ws + WS_TOKP); const float* tokw = (const float*)(F.ws + WS_TOKW);
    const int nrows = l == 0 ? T : NBATCH * SEQ;
    for (int rp = F.gw * 2; rp < nrows; rp += F.NGW * 2) {
        int tok[2], bsel[2]; float* xr[2]; f32x4 y[2][4], v[2][4]; int me, mp; float mw;
#pragma unroll
        for (int q = 0; q < 2; ++q) { const int ridx = rp + q; tok[q] = l == 0 ? ridx : (ridx >> 12) * TPB + CTX + (ridx & 4095);
            const int b = tok[q] / TPB; bsel[q] = (tok[q] - b * TPB) < CTX ? 4 : b; xr[q] = resid_row(F.out, xc, tok[q]); }
        { const int q = (F.lane >> 3) & 1, k = F.lane & 7; me = toke[tok[q] * 8 + k]; mp = tokp[tok[q] * 8 + k]; mw = tokw[tok[q] * 8 + k]; }
#pragma unroll
        for (int q = 0; q < 2; ++q) { const bf16_t* sp = H + (size_t)tok[q] * DM;
#pragma unroll
            for (int j = 0; j < 4; ++j) { const u32x2 w = *(const u32x2*)(sp + 4 * F.lane + 256 * j); y[q][j] = (f32x4){bflo(w.x), bfhi(w.x), bflo(w.y), bfhi(w.y)}; }
            row_load_bf16(xr[q], F.lane, v[q]); }
#pragma unroll
        for (int q = 0; q < 2; ++q) { row_ln(v[q]); row_affine(v[q], a->in[26] + l * DM, false, a->in[27] + l * DM, F.lane); }
#pragma unroll
        for (int q = 0; q < 2; ++q)
#pragma unroll
            for (int k = 0; k < 8; ++k) { const int e = __shfl(me, q * 8 + k), p = __shfl(mp, q * 8 + k); const float wv = __shfl(mw, q * 8 + k) * 0.0625f;
                const unsigned char* yp = YS + (size_t)(tb[LC_SBASE + e] + p) * DM;
#pragma unroll
                for (int j = 0; j < 4; ++j) { const int w = (int)*(const unsigned*)(yp + 4 * F.lane + 256 * j);
                    y[q][j][0] += wv * __builtin_amdgcn_cvt_f32_fp8(w, 0); y[q][j][1] += wv * __builtin_amdgcn_cvt_f32_fp8(w, 1); y[q][j][2] += wv * __builtin_amdgcn_cvt_f32_fp8(w, 2); y[q][j][3] += wv * __builtin_amdgcn_cvt_f32_fp8(w, 3); } }
#pragma unroll
        for (int q = 0; q < 2; ++q) {
            const float* g2 = mod + bsel[q] * 6144 + 5120;
#pragma unroll
            for (int j = 0; j < 4; ++j) { const f32x4 gv = *(const f32x4*)(g2 + 4 * F.lane + 256 * j); v[q][j] = v[q][j] * DN_ALPHA + gv * y[q][j]; }
            row_ln(v[q]); row_affine(v[q], a->in[36] + l * DM, false, a->in[37] + l * DM, F.lane);
            if (!dry) { if (l == 0) row_store_bf16((bf16_t*)xr[q], F.lane, v[q]); else row_store(xr[q], F.lane, v[q]); } else asm volatile("" :: "v"(v[q][0]), "v"(v[q][1]), "v"(v[q][2]), "v"(v[q][3]));
            if (l == 0 && !dry) { row_ln(v[q]); const float* mrow = mod + 5 * 6144 + bsel[q] * 6144; row_affine(v[q], mrow + 1024, true, mrow, F.lane); row_store_bf16(H + (size_t)tok[q] * DM, F.lane, v[q]); }
        }
    }
}

constexpr int NPHASE = 22;
__global__ void __launch_bounds__(NTHR, 2) mk_fwd(Args args) {
    extern __shared__ __attribute__((aligned(16))) unsigned char lds_raw[];
    Frame F; F.lds = (LAS unsigned char*)lds_raw; F.tid = threadIdx.x; F.lane = F.tid & 63; F.wave = __builtin_amdgcn_readfirstlane(F.tid >> 6);
    F.G = gridDim.x; F.bid = blockIdx.x; F.gw = F.bid * NWAVES + F.wave; F.NGW = F.G * NWAVES; F.ws = args.ws; F.out = args.out; F.vcu = (F.G % 8 == 0) ? (F.bid % 8) * (F.G / 8) + F.bid / 8 : F.bid;
    for (int u = F.tid; u < (LDS_BYTES - LDS_CTL) / 4; u += NTHR) ((LAS unsigned*)(F.lds + LDS_CTL))[u] = 0u;
    __syncthreads();
    const int lo = args.ph_lo, hi = args.ph_hi;
    CArgsP A4 = (CArgsP)__builtin_amdgcn_kernarg_segment_ptr();
    XcdBarrier bar; bar.bar = (unsigned*)(F.ws + CW_BAR_BYTE); bar.x = 0; bar.st = nullptr;
    if (hi - lo > 1) bar = xcd_barrier_post((unsigned*)(F.ws + CW_BAR_BYTE), (volatile LAS unsigned*)(F.lds + LDS_CTL) + LC_BAR);
#ifndef PHMASK
#define PHMASK 0xfff
#endif
#define PH_EN(k) ((PHMASK >> ((k) < 2 ? (k) : 2 + (((k) - 2) % 10))) & 1)
#define IN(k) (PH_EN(k) && lo <= (k) && (k) < hi)
#define SEAM(k) do { if (IN(k) && IN((k) + 1)) { for (int dd = 0; dd < NDUP(14); ++dd) xcd_barrier(bar); } if (TSMASK != 0 && blockIdx.x == 0 && threadIdx.x == 0) { ((volatile LAS unsigned long long*)(F.lds + LDS_CTL + 2048))[(k) + 1] = __builtin_amdgcn_s_memrealtime(); } FRESH(); } while (0)
#define FRESH() do { int t_ = threadIdx.x, b_ = blockIdx.x; CArgsP p_ = (CArgsP)__builtin_amdgcn_kernarg_segment_ptr(); asm volatile("" : "+v"(t_)); asm volatile("" : "+s"(b_), "+s"(p_)); A4 = p_; unsigned char* w_ = p_->ws; float* o_ = p_->out; \
    F.tid = t_; F.lane = t_ & 63; F.wave = __builtin_amdgcn_readfirstlane(t_ >> 6); F.bid = b_; F.gw = b_ * NWAVES + F.wave; F.ws = w_; F.out = o_; F.vcu = (F.G % 8 == 0) ? (b_ % 8) * (F.G / 8) + b_ / 8 : b_; } while (0)
    if (TSMASK != 0 && blockIdx.x == 0 && threadIdx.x == 0) ((volatile LAS unsigned long long*)(F.lds + LDS_CTL + 2048))[0] = __builtin_amdgcn_s_memrealtime();
    if (IN(0)) { for (int dd = 0; dd < NDUP(0); ++dd) phase_prologue(F, A4); } SEAM(0);
    if (IN(1)) { for (int dd = 0; dd < NDUP(1); ++dd) phase_rows0(F, A4); } SEAM(1);
#pragma unroll 1
    for (int l = 0; l < 2; ++l) {
        const int pb = 2 + 10 * l; const bool lat = (l == 1);
        if (IN(pb + 0)) {
            SchedPlain S{(const char*)(F.ws + WS_H), (const char*)(F.ws + WS_WIN) + (size_t)l * INC * 1024 * 2, 1024, 68, 26, F.G, F.bid, false};
            EpiInproj E{F.ws, A4->in[7] + l * INC, (const float*)(F.ws + WS_ROPE)};
            for (int dd = 0; dd < NDUP(2); ++dd) pg8::gemm_phase(F.lds, 1024, S, E);
        } SEAM(pb + 0);
        if (IN(pb + 1)) {
            for (int dd = 0; dd < NDUP(3); ++dd) lru_phase(F, A4, l, 0, false);
            for (int dd = 0; dd < NDUP(4); ++dd)
            for (int it = F.bid; it < 136 * 4; it += F.G) { const int chunk = it >> 2; if (lat && (chunk % 34) < 2) continue; sg_item(F, A4, l, chunk, it & 3); }
        } SEAM(pb + 1);
        if (IN(pb + 2)) { for (int dd = 0; dd < NDUP(5); ++dd) phase_carry(F); } SEAM(pb + 2);
        if (IN(pb + 3)) { phase_attn(F, A4, l); } SEAM(pb + 3);
        if (IN(pb + 4)) {
            for (int dd = 0; dd < NDUP(8); ++dd) {
                SchedMerge S{(const char*)(F.ws + OV_OA), (const char*)(F.ws + WS_WBR) + (size_t)(l * 3) * 1024 * 512 * 2, F.G, F.bid};
                EpiMerge E{(bf16_t*)(F.ws + OV_MG), (const bf16_t*)(F.ws + OV_G)};
                pg8::gemm_phase(F.lds, 512, S, E);
            }
            if (!lat) mini_merge_ctx(F, l);
        } SEAM(pb + 4);
        if (IN(pb + 5)) {
            SchedPlain S{(const char*)(F.ws + OV_MG), (const char*)(F.ws + WS_WOUT) + (size_t)l * 1048576 * 2, 1024, 64, 4, F.G, F.bid, true};
            EpiWout E{F.out, (float*)(F.ws + WS_XC), (const float*)(F.ws + WS_MOD) + l * 5 * 6144, false};
            pg8::gemm_phase(F.lds, 1024, S, E);
            if (NDUP(11) > 1) { EpiWout E2{F.out, (float*)(F.ws + WS_XC), (const float*)(F.ws + WS_MOD) + l * 5 * 6144, true}; pg8::gemm_phase(F.lds, 1024, S, E2); }
            if (!lat) mini_wout_ctx(F, l);
        } SEAM(pb + 5);
        if (IN(pb + 6)) { phase_router(F, A4, l, false); if (NDUP(12) > 1) phase_router(F, A4, l, F.G != 12345); } SEAM(pb + 6);
        if (IN(pb + 7)) {
            build_tables(F, l);
            SchedMoe S{(const char*)(F.ws + WS_H), (const char*)(F.ws + WS_H), (const char*)(F.ws + WS_WM1), (const char*)(F.ws + WS_WSH1) + (size_t)l * 524288 * 2,
                       (const int*)(F.ws + WS_LIST), (const LAS int*)(F.lds + LDS_CTL), 1024, 2, F.G, F.vcu, lat ? 64 : 68, lat, true, (size_t)524288 * 2};
            EpiMoe1 E{(bf16_t*)(F.ws + OV_ACT), (bf16_t*)(F.ws + OV_ACTSH)};
            for (int dd = 0; dd < NDUP(9); ++dd) pg8::gemm_phase(F.lds, 1024, S, E);
        } SEAM(pb + 7);
        if (IN(pb + 8)) {
            build_tables(F, l);
            SchedMoe S{(const char*)(F.ws + OV_ACT), (const char*)(F.ws + OV_ACTSH), (const char*)(F.ws + WS_WM2), (const char*)(F.ws + WS_WSH2) + (size_t)l * 262144 * 2,
                       (const int*)(F.ws + WS_LIST), (const LAS int*)(F.lds + LDS_CTL), 256, 4, F.G, F.vcu, lat ? 64 : 68, lat, false, (size_t)262144 * 2};
            EpiMoe2 E{(unsigned char*)(F.ws + OV_YS), (bf16_t*)(F.ws + WS_H)};
            for (int dd = 0; dd < NDUP(10); ++dd) pg8::gemm_phase(F.lds, 256, S, E);
        } SEAM(pb + 8);
        if (IN(pb + 9)) {
            build_tables(F, l);
            phase_combine(F, A4, l, false);
            if (NDUP(13) > 1) phase_combine(F, A4, l, F.G != 12345);
            if (l == 0) for (int dd = 0; dd < NDUP(15); ++dd) conv_moe_layer(F, A4, 1);
        } SEAM(pb + 9);
    }
    if (TSMASK != 0 && hi - lo == NPHASE) { __syncthreads(); asm volatile("s_waitcnt vmcnt(0)" ::: "memory");
        if (blockIdx.x == 0 && threadIdx.x == 0) { volatile LAS unsigned long long* ts = (volatile LAS unsigned long long*)(F.lds + LDS_CTL + 2048);
            unsigned long long sel = 0; for (int k = 0; k < NPHASE; ++k) if ((TSMASK >> k) & 1) sel += ts[k + 1] - ts[k];
            const float frac = (float)sel / (float)(ts[NPHASE] - ts[0]); args.out[0] += 1.0f + floorf(90.0f * frac + 0.5f); } }
#undef IN
#undef SEAM
}

extern "C" void kernel_launch(void* const* d_in, const int* in_sizes, int n_in, void* d_out, int out_size, void* d_ws, size_t ws_size, hipStream_t stream) {
    static int grid = 0;
    if (grid == 0) {
        if (n_in != 38 || out_size != NBATCH * SEQ * DM || ws_size < WS_END) { fprintf(stderr, "kernel_launch: unexpected shapes (n_in %d out %d ws %zu need %zu)\n", n_in, out_size, ws_size, (size_t)WS_END); grid = -1; return; }
        int dev = 0, cus = 0;
        if (hipGetDevice(&dev) != hipSuccess || hipDeviceGetAttribute(&cus, hipDeviceAttributeMultiprocessorCount, dev) != hipSuccess) { grid = -1; return; }
        if (hipFuncSetAttribute((const void*)mk_fwd, hipFuncAttributeMaxDynamicSharedMemorySize, LDS_BYTES) != hipSuccess) { fprintf(stderr, "kernel_launch: hipFuncSetAttribute failed\n"); grid = -1; return; }
        int per_cu = 0;
        if (hipOccupancyMaxActiveBlocksPerMultiprocessor(&per_cu, (const void*)mk_fwd, NTHR, LDS_BYTES) != hipSuccess || per_cu < 1) fprintf(stderr, "kernel_launch: occupancy query says %d\n", per_cu);
        (void)hipGetLastError();
        grid = cus;
    }
    if (grid < 0) return;
    (void)hipMemsetAsync((char*)d_ws + WS_CTL, 0, CTL_ZERO_BYTES, stream);
    Args a{};
    for (int i = 0; i < 38; ++i) a.in[i] = (const float*)d_in[i];
    a.out = (float*)d_out; a.ws = (unsigned char*)d_ws;
#if MK_MULTI
    for (int p = 0; p < NPHASE; ++p) { a.ph_lo = p; a.ph_hi = p + 1; hipLaunchKernelGGL(mk_fwd, dim3(grid), dim3(NTHR), LDS_BYTES, stream, a); }
#else
    a.ph_lo = 0; a.ph_hi = NPHASE; hipLaunchKernelGGL(mk_fwd, dim3(grid), dim3(NTHR), LDS_BYTES, stream, a);
#endif
}
```

```cpp
#include <hip/hip_runtime.h>
#include <cstdio>
#include <cstdint>
#include <cmath>

#ifndef MK_MULTI
#define MK_MULTI 0
#endif
#ifndef DUPMASK
#define DUPMASK 0
#endif
#define NDUP(c) (1 + ((DUPMASK >> (c)) & 1))
#ifndef TSMASK
#define TSMASK 0
#endif
#ifndef NAIVE_GEMM
#define NAIVE_GEMM 0
#endif

#define LAS __attribute__((address_space(3)))
#define GAS __attribute__((address_space(1)))
typedef unsigned short bf16_t;
typedef short bf16x8 __attribute__((ext_vector_type(8)));
typedef short s16x4 __attribute__((ext_vector_type(4)));
typedef float f32x4 __attribute__((ext_vector_type(4)));
typedef float f32x16 __attribute__((ext_vector_type(16)));
typedef unsigned u32x4 __attribute__((ext_vector_type(4)));
typedef unsigned u32x2 __attribute__((ext_vector_type(2)));

constexpr int DM = 1024, NBATCH = 4, SEQ = 4096, CTX = 256, TPB = SEQ + CTX  , T = NBATCH * TPB  ;
constexpr int INC = 6656, NEXP = 64;
constexpr float DN_ALPHA = 1.41421356237309515f;
constexpr float LN_EPS = 1e-6f, RMS_EPS = 1e-5f;
constexpr int NWAVES = 8, NTHR = 512;

constexpr size_t MiB = 1u << 20;
constexpr size_t WS_CTL = 0, CTL_ZERO_BYTES = 1 * MiB;
constexpr size_t CW_BAR_BYTE = 16384;
constexpr size_t WS_CNT = 65536;
constexpr size_t WS_MOD = 131072;
constexpr size_t WS_ROPE = 1 * MiB;
constexpr size_t WS_LAM = 1 * MiB + 8192;
constexpr size_t WS_SUM = 1 * MiB + 65536;
constexpr size_t WS_HIN = WS_SUM + 2304 * 1024;
constexpr size_t WS_TOKE = 5 * MiB, WS_TOKP = 6 * MiB, WS_TOKW = 7 * MiB;
constexpr size_t WS_LIST = 8 * MiB;
constexpr size_t WS_XC = 13 * MiB;
constexpr size_t WS_WLRU = 17 * MiB;
constexpr size_t WS_WSG = 17 * MiB + 512 * 1024;
constexpr size_t WS_WRT = 17 * MiB + 768 * 1024;
constexpr size_t WS_WSH1 = 18 * MiB;
constexpr size_t WS_WSH2 = 20 * MiB;
constexpr size_t WS_WOUT = 21 * MiB;
constexpr size_t WS_WBR = 25 * MiB;
constexpr size_t WS_WIN = 31 * MiB;
constexpr size_t WS_WM1 = 57 * MiB;
constexpr size_t WS_WM2 = 121 * MiB;
constexpr size_t WS_H = 153 * MiB;
constexpr size_t WS_OV = 187 * MiB;
constexpr size_t OV_Q = WS_OV, OV_K = WS_OV + 17 * MiB, OV_V = WS_OV + 34 * MiB, OV_U = WS_OV + 51 * MiB, OV_S = WS_OV + 68 * MiB,
                 OV_X = WS_OV + 85 * MiB, OV_Y = WS_OV + 102 * MiB, OV_G = WS_OV + 119 * MiB, OV_OA = WS_OV + 221 * MiB,
                 OV_OB = WS_OV + 238 * MiB, OV_OC = WS_OV + 255 * MiB, OV_MG = WS_OV + 272 * MiB;
constexpr size_t OV_ACT = WS_OV, OV_ACTSH = WS_OV + 69 * MiB, OV_YS = WS_OV + 78 * MiB;
constexpr size_t WS_END = WS_OV + 350 * MiB;

constexpr int LDS_SCRATCH = 147456;
constexpr int LDS_CTL = LDS_SCRATCH;
constexpr int LDS_BYTES = LDS_SCRATCH + 4096;
constexpr int LC_BAR = 0;
constexpr int LC_TCNT = 64, LC_TBASE = 64 + 80, LC_SBASE = 64 + 160;

struct Args { const float* in[38]; float* out; unsigned char* ws; int ph_lo, ph_hi; };
typedef const Args __attribute__((address_space(4)))* CArgsP;

__device__ __forceinline__ unsigned f2bf(float f) { unsigned u = __builtin_bit_cast(unsigned, f); return (u + 0x7fffu + ((u >> 16) & 1u)) >> 16; }
typedef float f32x2 __attribute__((ext_vector_type(2))); typedef __bf16 bf16x2_t __attribute__((ext_vector_type(2)));
__device__ __forceinline__ unsigned pk2(float lo, float hi) { const f32x2 v = {lo, hi}; const bf16x2_t b = __builtin_convertvector(v, bf16x2_t); return __builtin_bit_cast(unsigned, b); }
__device__ __forceinline__ float bflo(unsigned w) { return __builtin_bit_cast(float, w << 16); }
__device__ __forceinline__ float bfhi(unsigned w) { return __builtin_bit_cast(float, w & 0xffff0000u); }
__device__ __forceinline__ float bf2f(bf16_t b) { return __builtin_bit_cast(float, (unsigned)b << 16); }
#define WS_DPP(v, ctrl, rmask, bc) __builtin_bit_cast(float, __builtin_amdgcn_update_dpp(0, __builtin_bit_cast(int, v), ctrl, rmask, 0xF, bc))
__device__ __forceinline__ float wave_sum(float v) {
    v += WS_DPP(v, 0xB1, 0xF, true); v += WS_DPP(v, 0x4E, 0xF, true); v += WS_DPP(v, 0x141, 0xF, true); v += WS_DPP(v, 0x140, 0xF, true);
    v += WS_DPP(v, 0x142, 0xA, false); v += WS_DPP(v, 0x143, 0xC, false);
    return __builtin_bit_cast(float, __builtin_amdgcn_readlane(__builtin_bit_cast(int, v), 63));
}
__device__ __forceinline__ float sigmoidf_(float x) { return __builtin_amdgcn_rcpf(1.f + __builtin_amdgcn_exp2f(-1.4426950408889634f * x)); }
__device__ __forceinline__ float gelu_tanh(float x) { const float u = x * (0.7978845608028654f + 0.035677408136300125f * x * x); return x * __builtin_amdgcn_rcpf(1.f + __builtin_amdgcn_exp2f(-2.885390081777927f * u)); }
__device__ __forceinline__ float silu_(float x) { return x * __builtin_amdgcn_rcpf(1.f + __builtin_amdgcn_exp2f(-1.4426950408889634f * x)); }
__device__ __forceinline__ float expm1_fast(float x) {
    if (x > -0.5f && x < 0.5f) { float p = 1.0f + x * (1.0f / 8.0f); p = 1.0f + x * (1.0f / 7.0f) * p; p = 1.0f + x * (1.0f / 6.0f) * p; p = 1.0f + x * 0.2f * p; p = 1.0f + x * 0.25f * p; p = 1.0f + x * (1.0f / 3.0f) * p; p = 1.0f + x * 0.5f * p; return x * p; }
    return expm1f(x);
}
#define LDS_WAIT() asm volatile("s_waitcnt lgkmcnt(0)" ::: "memory")
#define VM_WAIT() asm volatile("s_waitcnt vmcnt(0)" ::: "memory")

#define XB_TMO      128
#define XB_XCNT(j)  (256  + 64 * (j))
#define XB_XSUB(j)  (1280 + 64 * (j))
#define XB_XGEN(j)  (2304 + 64 * (j))
#define XB_TOP      3328
#define XB_TOPGEN   3392
#define XCD_BAR_WORDS 3456
#define XB_SPIN_CAP (1u << 22)
__device__ __forceinline__ unsigned xb_ld(unsigned* p)              { return __hip_atomic_load(p, __ATOMIC_RELAXED, __HIP_MEMORY_SCOPE_AGENT); }
__device__ __forceinline__ unsigned xb_add(unsigned* p, unsigned v) { return __hip_atomic_fetch_add(p, v, __ATOMIC_RELAXED, __HIP_MEMORY_SCOPE_AGENT); }
__device__ __forceinline__ unsigned xb_xcc_id() { return (unsigned)__builtin_amdgcn_s_getreg((3 << 11) | 20) & 0xFu; }
#define XB_SPIN(cond, bar) do { unsigned _sp = 0; while (cond) { __builtin_amdgcn_s_sleep(1); \
    if ((++_sp & 255u) == 0u) { if (xb_ld(&(bar)[XB_TMO])) break; if (_sp > XB_SPIN_CAP) { atomicAdd(&(bar)[XB_TMO], 1u); break; } } } } while (0)
struct XcdBarrier { unsigned* bar; unsigned x; volatile LAS unsigned* st; };
__device__ __forceinline__ XcdBarrier xcd_barrier_post(unsigned* bar, volatile LAS unsigned* st) {
    XcdBarrier b; b.bar = bar; b.x = xb_xcc_id(); b.st = st;
    if (threadIdx.x == 0) (void)xb_add(&bar[XB_XCNT(b.x)], 1u);
    return b;
}
__device__ __forceinline__ void xcd_barrier_complete(unsigned* bar, unsigned x, unsigned& nloc, unsigned& nx) {
    const unsigned G = gridDim.x * gridDim.y * gridDim.z;
    unsigned sum, cnt, mine, sp = 0u;
    for (;;) {
        sum = 0u; cnt = 0u; mine = 0u;
#pragma unroll
        for (unsigned j = 0; j < 16; ++j) { const unsigned c = xb_ld(&bar[XB_XCNT(j)]); sum += c; cnt += (c > 0u) ? 1u : 0u; mine = (j == x) ? c : mine; }
        if (sum == G) break;
        __builtin_amdgcn_s_sleep(1);
        if ((++sp & 255u) == 0u) { if (xb_ld(&bar[XB_TMO])) break; if (sp > XB_SPIN_CAP) { atomicAdd(&bar[XB_TMO], 1u); break; } }
    }
    nloc = mine > 0u ? mine : 1u; nx = cnt > 0u ? cnt : 1u;
}
__device__ __forceinline__ void xcd_barrier(const XcdBarrier& b) {
    asm volatile("s_waitcnt vmcnt(0)" ::: "memory");
    __syncthreads();
    if (threadIdx.x == 0) {
        unsigned* bar = b.bar; asm volatile("" : "+s"(bar));
        __builtin_amdgcn_s_waitcnt(0);
        unsigned nloc = b.st[0], nx = b.st[1];
        if (nloc == 0u) { xcd_barrier_complete(bar, b.x, nloc, nx); b.st[0] = nloc; b.st[1] = nx; }
        const unsigned old = xb_add(&bar[XB_XSUB(b.x)], 1u);
        const unsigned gen = old / nloc;
        if (old + 1u == (gen + 1u) * nloc) {
            __builtin_amdgcn_fence(__ATOMIC_RELEASE, "agent");
            asm volatile("s_waitcnt vmcnt(0)" ::: "memory");
            const unsigned og = xb_add(&bar[XB_TOP], 1u);
            const unsigned tg = og / nx;
            if (og + 1u == (tg + 1u) * nx) xb_add(&bar[XB_TOPGEN], 1u);
            else XB_SPIN(xb_ld(&bar[XB_TOPGEN]) == tg, bar);
            __builtin_amdgcn_fence(__ATOMIC_ACQUIRE, "agent");
            xb_add(&bar[XB_XGEN(b.x)], 1u);
            asm volatile("s_waitcnt vmcnt(0)" ::: "memory");
        } else {
            XB_SPIN(xb_ld(&bar[XB_XGEN(b.x)]) == gen, bar);
            __builtin_amdgcn_fence(__ATOMIC_ACQUIRE, "agent");
            asm volatile("s_waitcnt vmcnt(0)" ::: "memory");
        }
    }
    __syncthreads();
}

namespace pg8 {
constexpr int BM = 256, BK = 64, HALF = 128, HTB = HALF * BK * 2, STAGE_BYTES = 8 * HTB, NXCD = 8, WGM = 8;
__host__ __device__ __forceinline__ int lds_byte(int r, int c) { const int st = (r >> 4) * 2 + (c >> 5), rr = r & 15, cc = c & 31, ob = rr * 64 + cc * 2; return st * 1024 + (ob ^ (((ob >> 9) & 1) << 5)); }
__host__ __device__ __forceinline__ void stage_rc(int b, int& R, int& C) { const int st = b / 1024, sb = b % 1024, swz = sb ^ (((sb >> 9) & 1) << 5); R = (st >> 1) * 16 + swz / 64; C = (st & 1) * 32 + (swz % 64) / 2; }
__host__ __device__ __forceinline__ int perm32(int rho) { const int n = rho >> 4, i = rho & 15; return 8 * (i >> 2) + 4 * n + (i & 3); }
struct Unit { int pm, pn, e, ti, nrows, row0; };
typedef f32x4 Acc[2][2][4][2];

template <class Epi, class Sched>
__device__ __forceinline__ void gemm_phase(LAS unsigned char* lds, const int K, const Sched& S, const Epi& E) {
    int tid_ = threadIdx.x; asm volatile("" : "+v"(tid_));
    const int tid = tid_, wid = __builtin_amdgcn_readfirstlane(tid >> 6), lane = tid & 63, wr = wid >> 2, wc = wid & 3, fr = lane & 15, fq = lane >> 4;
    (void)fr; (void)fq; (void)wc;
    Unit cur, nxt; int ui = 0;
    if (!S.next(0, cur)) return;
    Acc acc;
#pragma unroll
    for (int a = 0; a < 2; ++a)
#pragma unroll
        for (int b = 0; b < 2; ++b)
#pragma unroll
            for (int m = 0; m < 4; ++m)
#pragma unroll
                for (int n = 0; n < 2; ++n) acc[a][b][m][n] = (f32x4){0.f, 0.f, 0.f, 0.f};
#if NAIVE_GEMM
    for (;;) {
        const char* Ab = S.a_base(); const char* Bb = S.b_ptr(cur);
#pragma unroll 1
        for (int ai = 0; ai < 2; ++ai)
#pragma unroll 1
            for (int m = 0; m < 4; ++m) {
                const int rr = ai * 128 + wr * 64 + m * 16 + fr;
                const bf16_t* ap = (const bf16_t*)(Ab + S.a_off(cur, rr));
#pragma unroll
                for (int bj = 0; bj < 2; ++bj)
#pragma unroll
                    for (int n = 0; n < 2; ++n)
#pragma unroll
                        for (int j = 0; j < 4; ++j) {
                            const int cc = Epi::PERM ? bj * 128 + wc * 32 + fq * 8 + n * 4 + j : bj * 128 + wc * 32 + n * 16 + fq * 4 + j;
                            const bf16_t* bp = (const bf16_t*)(Bb + (size_t)cc * K * 2);
                            float s = 0.f;
                            for (int k = 0; k < K; k += 8) {
                                const u32x4 av = *(const u32x4*)(ap + k), bv = *(const u32x4*)(bp + k);
                                s += bflo(av.x) * bflo(bv.x) + bfhi(av.x) * bfhi(bv.x) + bflo(av.y) * bflo(bv.y) + bfhi(av.y) * bfhi(bv.y)
                                   + bflo(av.z) * bflo(bv.z) + bfhi(av.z) * bfhi(bv.z) + bflo(av.w) * bflo(bv.w) + bfhi(av.w) * bfhi(bv.w);
                            }
                            acc[ai][bj][m][n][j] = s;
                        }
            }
        E(acc, cur, wr, wc, fr, fq);
        ++ui;
        if (!S.next(ui, cur)) break;
    }
    return;
#else
    const int nt = K / BK;
    unsigned voffB[2];
    { int Rr[2], Cc[2];
#pragma unroll
      for (int i = 0; i < 2; ++i) { stage_rc(tid * 16 + i * 8192, Rr[i], Cc[i]); const int Rb = Epi::PERM ? ((Rr[i] & ~31) + perm32(Rr[i] & 31)) : Rr[i]; voffB[i] = (unsigned)(Rb * K + Cc[i]) * 2u; } }
#define PG8_AOFFS(U, o00, o01, o10, o11) do { int t3_ = threadIdx.x; asm volatile("" : "+v"(t3_)); int R0_, C0_, R1_, C1_; stage_rc(t3_ * 16, R0_, C0_); stage_rc(t3_ * 16 + 8192, R1_, C1_); \
        o00 = S.a_off(U, R0_) + (unsigned)C0_ * 2u; o01 = S.a_off(U, R1_) + (unsigned)C1_ * 2u; o10 = S.a_off(U, HALF + R0_) + (unsigned)C0_ * 2u; o11 = S.a_off(U, HALF + R1_) + (unsigned)C1_ * 2u; } while (0)
    const size_t kstep = (size_t)(BK * 2);
    const size_t hstep = (size_t)HALF * K * 2;
    const unsigned ldsw = (unsigned)wid * 1024u;
    const int aoff = lds_byte(wr * 64 + fr, fq * 8), boff = lds_byte(wc * 32 + fr, fq * 8);
#define PG8_SA(b, h) (((b) * 2 + (h)) * HTB)
#define PG8_SB(b, h) ((4 + (b) * 2 + (h)) * HTB)
#define PG8_STAGE(bufoff, gbase, v0, v1) do { \
        __builtin_amdgcn_global_load_lds((const unsigned*)((const char*)(gbase) + (v0)), (LAS unsigned*)(lds + (bufoff) + ldsw), 16, 0, 0); \
        __builtin_amdgcn_global_load_lds((const unsigned*)((const char*)(gbase) + (v1)), (LAS unsigned*)(lds + (bufoff) + ldsw + 8192), 16, 0, 0); } while (0)
#define PG8_LDA(dst, b, h) do { _Pragma("unroll") for (int m = 0; m < 4; ++m) _Pragma("unroll") for (int k = 0; k < 2; ++k) dst[m][k] = *(const LAS bf16x8*)(lds + PG8_SA(b, h) + aoff + m * 2048 + k * 1024); } while (0)
#define PG8_LDB(dst, b, h) do { _Pragma("unroll") for (int n = 0; n < 2; ++n) _Pragma("unroll") for (int k = 0; k < 2; ++k) dst[n][k] = *(const LAS bf16x8*)(lds + PG8_SB(b, h) + boff + n * 2048 + k * 1024); } while (0)
#define PG8_MMA(ai, bj, At, Bt) do { __builtin_amdgcn_s_setprio(1); _Pragma("unroll") for (int m = 0; m < 4; ++m) _Pragma("unroll") for (int n = 0; n < 2; ++n) _Pragma("unroll") for (int k = 0; k < 2; ++k) \
        acc[ai][bj][m][n] = __builtin_amdgcn_mfma_f32_16x16x32_bf16(Bt[n][k], At[m][k], acc[ai][bj][m][n], 0, 0, 0); __builtin_amdgcn_s_setprio(0); } while (0)
#define PG8_WAIT_V(n) asm volatile("s_waitcnt vmcnt(" #n ")" ::: "memory")
#define PG8_WAIT_L(n) asm volatile("s_waitcnt lgkmcnt(" #n ")" ::: "memory")
#define PG8_BAR __builtin_amdgcn_s_barrier()
#define PG8_SCHED __builtin_amdgcn_sched_barrier(0)
    bf16x8 At[4][2], B0[2][2], B1[2][2];
    const char* const Ab = S.a_base();
    unsigned vA00, vA01, vA10, vA11;
    PG8_AOFFS(cur, vA00, vA01, vA10, vA11);
    const char* cB = S.b_ptr(cur);
    PG8_STAGE(PG8_SB(0, 0), cB, voffB[0], voffB[1]); PG8_STAGE(PG8_SB(0, 1), cB + hstep, voffB[0], voffB[1]); PG8_STAGE(PG8_SA(0, 0), Ab, vA00, vA01); PG8_STAGE(PG8_SA(0, 1), Ab, vA10, vA11);
    if (wr == 1) PG8_BAR;
    PG8_WAIT_V(2); PG8_BAR;
    PG8_STAGE(PG8_SB(1, 0), cB + kstep, voffB[0], voffB[1]); PG8_STAGE(PG8_SA(1, 0), Ab + kstep, vA00, vA01); PG8_STAGE(PG8_SB(1, 1), cB + hstep + kstep, voffB[0], voffB[1]);
    PG8_WAIT_V(6); PG8_BAR;
    for (;;) {
        const bool has_next = S.next(ui + 1, nxt);
        unsigned vN00 = vA00, vN01 = vA01, vN10 = vA10, vN11 = vA11; const char* nB = cB;
        if (has_next) { PG8_AOFFS(nxt, vN00, vN01, vN10, vN11); nB = S.b_ptr(nxt); }
        for (int t = 0; t < nt; t += 2) {
            const bool last = (t == nt - 2);
            const char* a1 = Ab + (size_t)(t + 1) * kstep;
            const char* a2 = last ? Ab : Ab + (size_t)(t + 2) * kstep; const char* b2 = last ? nB : cB + (size_t)(t + 2) * kstep;
            const char* a3 = a2 + kstep; const char* b3 = b2 + kstep;
            const unsigned w00 = last ? vN00 : vA00, w01 = last ? vN01 : vA01, w10 = last ? vN10 : vA10, w11 = last ? vN11 : vA11;
            PG8_LDB(B0, 0, 0); PG8_LDB(B1, 0, 1); PG8_SCHED; PG8_LDA(At, 0, 0); PG8_STAGE(PG8_SA(1, 1), a1, vA10, vA11);
            PG8_WAIT_V(8); PG8_WAIT_L(0); PG8_BAR; PG8_MMA(0, 0, At, B0); PG8_MMA(0, 1, At, B1); PG8_BAR; PG8_SCHED;
            PG8_LDA(At, 0, 1); PG8_STAGE(PG8_SB(0, 0), b2, voffB[0], voffB[1]); PG8_STAGE(PG8_SB(0, 1), b2 + hstep, voffB[0], voffB[1]); PG8_STAGE(PG8_SA(0, 0), a2, w00, w01);
            PG8_WAIT_V(8); PG8_WAIT_L(0); PG8_BAR; PG8_MMA(1, 0, At, B0); PG8_MMA(1, 1, At, B1); PG8_BAR; PG8_SCHED;
            PG8_LDB(B0, 1, 0); PG8_LDB(B1, 1, 1); PG8_SCHED; PG8_LDA(At, 1, 0); PG8_STAGE(PG8_SA(0, 1), a2, w10, w11);
            PG8_WAIT_V(8); PG8_WAIT_L(0); PG8_BAR; PG8_MMA(0, 0, At, B0); PG8_MMA(0, 1, At, B1); PG8_BAR; PG8_SCHED;
            PG8_LDA(At, 1, 1); PG8_STAGE(PG8_SB(1, 0), b3, voffB[0], voffB[1]); PG8_STAGE(PG8_SB(1, 1), b3 + hstep, voffB[0], voffB[1]); PG8_STAGE(PG8_SA(1, 0), a3, w00, w01);
            PG8_WAIT_V(8); PG8_WAIT_L(0); PG8_BAR; PG8_MMA(1, 0, At, B0); PG8_MMA(1, 1, At, B1); PG8_BAR; PG8_SCHED;
        }
        if (wr == 0) PG8_BAR;
        { int t2_ = threadIdx.x; asm volatile("" : "+v"(t2_)); const int l2_ = t2_ & 63; E(acc, cur, wr, wc, l2_ & 15, l2_ >> 4); }
        if (!has_next) break;
#pragma unroll
        for (int a = 0; a < 2; ++a)
#pragma unroll
            for (int b = 0; b < 2; ++b)
#pragma unroll
                for (int m = 0; m < 4; ++m)
#pragma unroll
                    for (int n = 0; n < 2; ++n) acc[a][b][m][n] = (f32x4){0.f, 0.f, 0.f, 0.f};
        cur = nxt; vA00 = vN00; vA01 = vN01; vA10 = vN10; vA11 = vN11; cB = nB; ++ui;
        if (wr == 1) PG8_BAR;
    }
    PG8_WAIT_V(0);
    PG8_BAR;
#undef PG8_SA
#undef PG8_AOFFS
#undef PG8_SB
#undef PG8_STAGE
#undef PG8_LDA
#undef PG8_LDB
#undef PG8_MMA
#undef PG8_WAIT_V
#undef PG8_WAIT_L
#undef PG8_BAR
#undef PG8_SCHED
#endif
}
}
using pg8::Unit;
using pg8::Acc;

__device__ __forceinline__ float* resid_row(float* out, float* xc, int tok) {
    const int b = tok / TPB, j = tok - b * TPB;
    return j < CTX ? xc + ((size_t)(b * CTX + j)) * DM : out + ((size_t)(b * SEQ + j - CTX)) * DM;
}
__device__ __forceinline__ int tile_to_pm(int i, bool latent_only) { return latent_only ? (i >> 4) * 17 + 1 + (i & 15) : i; }

__device__ __forceinline__ bool static_order(int i, int G, int c, int nM, int nN, int& pm, int& pn) {
    const int nwg = nM * nN; const long L = (long)i * G + c; if (L >= nwg) return false;
    int wgid = (int)L; { const int q = nwg / 8, r = nwg % 8, xcd = wgid % 8, off = wgid / 8; wgid = (xcd < r ? xcd * (q + 1) : r * (q + 1) + (xcd - r) * q) + off; }
    const int nig = 8 * nN, gid = wgid / nig, fm = gid * 8, gsz = (nM - fm) < 8 ? (nM - fm) : 8;
    pm = fm + ((wgid % nig) % gsz); pn = (wgid % nig) / gsz; return true;
}

struct SchedPlain {
    const char* A; const char* Bt; int K, nM, nN, G, c; bool lat;
    __device__ __forceinline__ bool next(int i, Unit& u) const {
        int pm, pn; if (!static_order(i, G, c, nM, nN, pm, pn)) return false;
        u.pm = tile_to_pm(pm, lat); u.pn = pn; u.e = 0; u.ti = 0; u.nrows = 256; u.row0 = u.pm * 256; return true;
    }
    __device__ __forceinline__ const char* a_base() const { return A; }
    __device__ __forceinline__ unsigned a_off(const Unit& u, int rr) const { return (unsigned)(u.row0 + rr) * (unsigned)(K * 2); }
    __device__ __forceinline__ const char* b_ptr(const Unit& u) const { return Bt + (size_t)u.pn * 256 * K * 2; }
};

struct SchedMerge {
    const char* A0; const char* Bt0; int G, c;
    __device__ __forceinline__ bool next(int i, Unit& u) const {
        const int ti = i / 3, r = i - 3 * ti; int pm, pn; if (!static_order(ti, G, c, 64, 4, pm, pn)) return false;
        u.pm = tile_to_pm(pm, true); u.pn = pn; u.e = r; u.ti = 0; u.nrows = 256; u.row0 = u.pm * 256; return true;
    }
    __device__ __forceinline__ const char* a_base() const { return A0; }
    __device__ __forceinline__ unsigned a_off(const Unit& u, int rr) const { return (unsigned)u.e * (unsigned)(17 * MiB) + (unsigned)(u.row0 + rr) * 1024u; }
    __device__ __forceinline__ const char* b_ptr(const Unit& u) const { return Bt0 + ((size_t)u.e * 1024 * 512 + (size_t)u.pn * 256 * 512) * 2; }
};

struct SchedMoe {
    const char* A;
    const char* Ash;
    const char* Bt; const char* Btsh; const int* list;
    const LAS int* tb;
    int K, nN, G, c, nsh; bool lat, gather; size_t bstride;
    __device__ __forceinline__ bool next(int i, Unit& u) const {
        const int nrt = tb[LC_TBASE + 64], L = i * G + c, tot = (nrt + nsh) * nN;
        if (L >= tot) return false;
        const int rt = L / nN; u.pn = L - rt * nN;
        if (rt < nrt) {
            int e = 0;
#pragma unroll 1
            for (int s = 32; s > 0; s >>= 1) if (e + s < 64 && tb[LC_TBASE + e + s] <= rt) e += s;
            u.e = e; u.ti = rt - tb[LC_TBASE + e]; const int cnt = tb[LC_TCNT + e]; const int rem = cnt - u.ti * 256;
            u.nrows = rem < 256 ? rem : 256; u.row0 = tb[LC_SBASE + e] + u.ti * 256; u.pm = 0;
        } else { u.e = 64; u.ti = rt - nrt; u.pm = tile_to_pm(u.ti, lat); u.nrows = 256; u.row0 = u.pm * 256; }
        return true;
    }
    __device__ __forceinline__ const char* a_base() const { return A; }
    __device__ __forceinline__ unsigned a_off(const Unit& u, int rr) const {
        if (u.e == 64) return (unsigned)(Ash - A) + (unsigned)(u.row0 + rr) * (unsigned)(K * 2);
        if (gather) { const int r2 = rr < u.nrows ? rr : u.nrows - 1; const int tok = list[(size_t)u.e * T + u.ti * 256 + r2]; return (unsigned)tok * (unsigned)(K * 2); }
        return (unsigned)(u.row0 + rr) * (unsigned)(K * 2);
    }
    __device__ __forceinline__ const char* b_ptr(const Unit& u) const { return (u.e == 64 ? Btsh : Bt + (size_t)u.e * bstride) + (size_t)u.pn * 256 * K * 2; }
};

#define EPI_FOR_ROWS  _Pragma("unroll") for (int ai = 0; ai < 2; ++ai) _Pragma("unroll") for (int m = 0; m < 4; ++m)
#define EPI_FOR_COLS  _Pragma("unroll") for (int bj = 0; bj < 2; ++bj) _Pragma("unroll") for (int n = 0; n < 2; ++n)

struct EpiInproj {
    static constexpr bool PERM = true;
    unsigned char* ws; const float* bias; const float* rope;
    __device__ __forceinline__ void operator()(const Acc& acc, const Unit& u, int wr, int wc, int fr, int fq) const {
        const int pn = u.pn; const bool isg = pn >= 14; const int seg = pn >> 1;
        bf16_t* base = (bf16_t*)(ws + (isg ? OV_G : OV_Q + (size_t)seg * 17 * MiB));
        const int ld = isg ? 3072 : 512, coff = isg ? (pn - 14) * 256 : (pn & 1) * 256;
        const bool latent = (u.pm % 17) != 0; const bool dorope = seg < 2 && !isg && latent;
        f32x4 bv[2][2];
        EPI_FOR_COLS bv[bj][n] = *(const f32x4*)(bias + pn * 256 + bj * 128 + wc * 32 + fq * 8 + n * 4);
        const float qs = (seg == 0 && !isg) ? 0.125f * 1.4426950408889634f : 1.0f;
        const bool upper = __builtin_amdgcn_mbcnt_hi(~0u, __builtin_amdgcn_mbcnt_lo(~0u, 0u)) >= 32u;
        EPI_FOR_ROWS {
            const int row = u.row0 + ai * 128 + wr * 64 + m * 16 + fr;
            bf16_t* rp = base + (size_t)row * ld + coff + wc * 32 + fq * 8;
            f32x4 v[2][2];
            EPI_FOR_COLS v[bj][n] = acc[ai][bj][m][n] + bv[bj][n];
            if (dorope) {
                const int pos = (row % TPB) - CTX; const int pa = (wc & 1) ? (pos & 63) : (pos >> 6);
                const float* tp = rope + (pa * 16 + (fq & 1) * 8) * 2;
                f32x4 t[4];
#pragma unroll
                for (int i = 0; i < 4; ++i) t[i] = *(const f32x4*)(tp + 4 * i);
#pragma unroll
                for (int bj = 0; bj < 2; ++bj)
#pragma unroll
                    for (int n = 0; n < 2; ++n)
#pragma unroll
                        for (int j = 0; j < 4; ++j) { const float own = v[bj][n][j];
                            const auto rr = __builtin_amdgcn_permlane32_swap(__float_as_uint(own), __float_as_uint(own), false, false);
                            const float oth = upper ? __uint_as_float(rr[0]) : __uint_as_float(rr[1]);
                            const int fi = 4 * n + j; const float cs = t[fi >> 1][(fi & 1) * 2], sn = t[fi >> 1][(fi & 1) * 2 + 1];
                            v[bj][n][j] = own * cs + (upper ? oth : -oth) * sn; }
            }
#pragma unroll
            for (int bj = 0; bj < 2; ++bj) { const f32x4 v0 = v[bj][0] * qs, v1 = v[bj][1] * qs;
                u32x4 w; w.x = pk2(v0[0], v0[1]); w.y = pk2(v0[2], v0[3]); w.z = pk2(v1[0], v1[1]); w.w = pk2(v1[2], v1[3]); *(u32x4*)(rp + bj * 128) = w; }
        }
    }
};

struct EpiMerge {
    static constexpr bool PERM = true;
    bf16_t* mg; const bf16_t* gate;
    __device__ __forceinline__ void operator()(const Acc& acc, const Unit& u, int wr, int wc, int fr, int fq) const {
        const int r = u.e;
#pragma unroll
        for (int ai = 0; ai < 2; ++ai) {
            const size_t rbase = (size_t)(u.row0 + ai * 128 + wr * 64 + fr); const int col = u.pn * 256 + wc * 32 + fq * 8;
            u32x4 g[4][2], o[4][2];
#pragma unroll
            for (int m = 0; m < 4; ++m)
#pragma unroll
                for (int bj = 0; bj < 2; ++bj) { g[m][bj] = *(const u32x4*)(gate + (rbase + m * 16) * 3072 + r * 1024 + col + bj * 128);
                    if (r > 0) o[m][bj] = *(const u32x4*)(mg + (rbase + m * 16) * DM + col + bj * 128); else o[m][bj] = (u32x4){0u, 0u, 0u, 0u}; }
#pragma unroll
            for (int m = 0; m < 4; ++m)
#pragma unroll
                for (int bj = 0; bj < 2; ++bj) { const u32x4 gg = g[m][bj], oo = o[m][bj]; const f32x4 v0 = acc[ai][bj][m][0], v1 = acc[ai][bj][m][1];
                    u32x4 w; w.x = pk2(v0[0] * sigmoidf_(bflo(gg.x)) + bflo(oo.x), v0[1] * sigmoidf_(bfhi(gg.x)) + bfhi(oo.x)); w.y = pk2(v0[2] * sigmoidf_(bflo(gg.y)) + bflo(oo.y), v0[3] * sigmoidf_(bfhi(gg.y)) + bfhi(oo.y));
                    w.z = pk2(v1[0] * sigmoidf_(bflo(gg.z)) + bflo(oo.z), v1[1] * sigmoidf_(bfhi(gg.z)) + bfhi(oo.z)); w.w = pk2(v1[2] * sigmoidf_(bflo(gg.w)) + bflo(oo.w), v1[3] * sigmoidf_(bfhi(gg.w)) + bfhi(oo.w));
                    *(u32x4*)(mg + (rbase + m * 16) * DM + col + bj * 128) = w; }
        }
    }
};

struct EpiWout {
    static constexpr bool PERM = true;
    float* out; float* xc; const float* modl; bool dry;
    __device__ __forceinline__ void operator()(const Acc& acc, const Unit& u, int wr, int wc, int fr, int fq) const {
        const int b = u.pm / 17; const int bsel = (u.pm % 17) == 0 ? 4 : b;
        const float* g1 = modl + bsel * 6144 + 2048;
        f32x4 gv[2][2];
        EPI_FOR_COLS gv[bj][n] = *(const f32x4*)(g1 + u.pn * 256 + bj * 128 + wc * 32 + fq * 8 + n * 4);
#pragma unroll
        for (int ai = 0; ai < 2; ++ai) {
            bf16_t* rp[4]; u32x4 x[4][2];
#pragma unroll
            for (int m = 0; m < 4; ++m) { rp[m] = (bf16_t*)resid_row(out, xc, u.row0 + ai * 128 + wr * 64 + m * 16 + fr) + u.pn * 256 + wc * 32 + fq * 8;
#pragma unroll
                for (int bj = 0; bj < 2; ++bj) x[m][bj] = *(const u32x4*)(rp[m] + bj * 128); }
#pragma unroll
            for (int m = 0; m < 4; ++m)
#pragma unroll
                for (int bj = 0; bj < 2; ++bj) { const u32x4 xx = x[m][bj]; const f32x4 a0 = acc[ai][bj][m][0] * gv[bj][0], a1 = acc[ai][bj][m][1] * gv[bj][1];
                    u32x4 w; w.x = pk2(bflo(xx.x) * DN_ALPHA + a0[0], bfhi(xx.x) * DN_ALPHA + a0[1]); w.y = pk2(bflo(xx.y) * DN_ALPHA + a0[2], bfhi(xx.y) * DN_ALPHA + a0[3]);
                    w.z = pk2(bflo(xx.z) * DN_ALPHA + a1[0], bfhi(xx.z) * DN_ALPHA + a1[1]); w.w = pk2(bflo(xx.w) * DN_ALPHA + a1[2], bfhi(xx.w) * DN_ALPHA + a1[3]);
                    if (!dry) *(u32x4*)(rp[m] + bj * 128) = w; else asm volatile("" :: "v"(w)); }
        }
    }
};

struct EpiMoe1 {
    static constexpr bool PERM = true;
    bf16_t* act; bf16_t* actsh;
    __device__ __forceinline__ void operator()(const Acc& acc, const Unit& u, int wr, int wc, int fr, int fq) const {
        bf16_t* base = u.e == 64 ? actsh : act;
        EPI_FOR_ROWS {
            const int rl = ai * 128 + wr * 64 + m * 16 + fr;
            if (rl < u.nrows) {
                const f32x4 g0 = acc[ai][0][m][0], g1 = acc[ai][0][m][1], p0 = acc[ai][1][m][0], p1 = acc[ai][1][m][1];
                u32x4 w; w.x = pk2(silu_(g0[0]) * p0[0], silu_(g0[1]) * p0[1]); w.y = pk2(silu_(g0[2]) * p0[2], silu_(g0[3]) * p0[3]);
                w.z = pk2(silu_(g1[0]) * p1[0], silu_(g1[1]) * p1[1]); w.w = pk2(silu_(g1[2]) * p1[2], silu_(g1[3]) * p1[3]);
                *(u32x4*)(base + (size_t)(u.row0 + rl) * 256 + u.pn * 128 + wc * 32 + fq * 8) = w;
            }
        }
    }
};

struct EpiMoe2 {
    static constexpr bool PERM = true;
    unsigned char* ys; bf16_t* sho;
    __device__ __forceinline__ void operator()(const Acc& acc, const Unit& u, int wr, int wc, int fr, int fq) const {
        EPI_FOR_ROWS {
            const int rl = ai * 128 + wr * 64 + m * 16 + fr;
            if (rl < u.nrows) {
                if (u.e == 64) {
                    bf16_t* rp = sho + (size_t)(u.row0 + rl) * DM + u.pn * 256 + wc * 32 + fq * 8;
#pragma unroll
                    for (int bj = 0; bj < 2; ++bj) { const f32x4 v0 = acc[ai][bj][m][0], v1 = acc[ai][bj][m][1];
                        u32x4 w; w.x = pk2(v0[0], v0[1]); w.y = pk2(v0[2], v0[3]); w.z = pk2(v1[0], v1[1]); w.w = pk2(v1[2], v1[3]); *(u32x4*)(rp + bj * 128) = w; }
                } else {
                    unsigned char* rp = ys + (size_t)(u.row0 + rl) * DM + u.pn * 256 + wc * 32 + fq * 8;
#pragma unroll
                    for (int bj = 0; bj < 2; ++bj) { const f32x4 v0 = acc[ai][bj][m][0] * 16.0f, v1 = acc[ai][bj][m][1] * 16.0f;
                        int w0 = 0, w1 = 0;
                        w0 = __builtin_amdgcn_cvt_pk_fp8_f32(v0[0], v0[1], w0, false); w0 = __builtin_amdgcn_cvt_pk_fp8_f32(v0[2], v0[3], w0, true);
                        w1 = __builtin_amdgcn_cvt_pk_fp8_f32(v1[0], v1[1], w1, false); w1 = __builtin_amdgcn_cvt_pk_fp8_f32(v1[2], v1[3], w1, true);
                        *(u32x2*)(rp + bj * 128) = (u32x2){(unsigned)w0, (unsigned)w1}; }
                }
            }
        }
    }
};

struct Frame {
    LAS unsigned char* lds; int tid, lane, wave, G, bid, gw, NGW, vcu;
    unsigned char* ws; float* out;
};

__device__ __forceinline__ void transpose_item(const float* W, int ldw, int k0, int n0, bf16_t* WT, int ldt, int drow0, LAS float* scr, int lane) {
    const int lk = lane >> 4, n4 = (lane & 15) * 4;
#pragma unroll 8
    for (int i = 0; i < 16; ++i) { const int k = 4 * i + lk; const f32x4 v = *(const f32x4*)(W + (size_t)(k0 + k) * ldw + n0 + n4);
        *(LAS f32x4*)(scr + k * 64 + (n4 ^ (((k >> 3) & 7) << 2))) = v; }
    LDS_WAIT(); asm volatile("" ::: "memory");
    const int c = lane & 7;
#pragma unroll
    for (int j = 0; j < 8; ++j) { const int n = (lane >> 3) + 8 * j; const LAS float* sp = scr + (8 * c) * 64 + (n ^ (c << 2));
        u32x4 o; o.x = pk2(sp[0 * 64], sp[1 * 64]); o.y = pk2(sp[2 * 64], sp[3 * 64]); o.z = pk2(sp[4 * 64], sp[5 * 64]); o.w = pk2(sp[6 * 64], sp[7 * 64]);
        *(u32x4*)(WT + (size_t)(drow0 + n) * ldt + k0 + 8 * c) = o; }
    LDS_WAIT(); asm volatile("" ::: "memory");
}
__device__ __forceinline__ void conv_expert_item(const float* wg, const float* wu, const float* wd, bf16_t* t1, bf16_t* t2, int which, int rr, LAS float* scr, int lane) {
    if (which < 2) { const int kb = rr >> 2, nb = rr & 3, n0 = 64 * nb;
        transpose_item(which == 0 ? wg : wu, 256, 64 * kb, n0, t1, 1024, (n0 >> 7) * 256 + (n0 & 127) + which * 128, scr, lane);
    } else { const int kb = rr >> 4, nb = rr & 15; transpose_item(wd, 1024, 64 * kb, 64 * nb, t2, 256, 64 * nb, scr, lane); }
}
__device__ __forceinline__ void conv_moe_layer(const Frame& F, CArgsP a, int l) {
    LAS float* scr = (LAS float*)(F.lds + F.wave * 16384);
    for (int it = F.gw; it < 64 * 3 * 64; it += F.NGW) {
        const int idx = it >> 6, e = idx / 3, which = idx - e * 3, rr = it & 63; const size_t eo = (size_t)(l * 64 + e) * 262144;
        conv_expert_item(a->in[30] + eo, a->in[31] + eo, a->in[32] + eo, (bf16_t*)(F.ws + WS_WM1) + (size_t)e * 524288, (bf16_t*)(F.ws + WS_WM2) + (size_t)e * 262144, which, rr, scr, F.lane);
    }
}

__device__ __forceinline__ void phase_prologue(const Frame& F, CArgsP a) {
    LAS float* scr = (LAS float*)(F.lds + F.wave * 16384);
    constexpr int I_IN = 2 * 1664, I_BR = 6 * 128, I_OUT = 2 * 256, I_SH = 6 * 64;
    for (int it0 = F.gw; it0 < I_IN + I_BR + I_OUT + I_SH; it0 += F.NGW) {
        int it = it0;
        if (it < I_IN) { const int l = it / 1664, r = it - l * 1664, kb = r / 104, nb = r - kb * 104;
            transpose_item(a->in[6] + (size_t)l * 1024 * INC, INC, 64 * kb, 64 * nb, (bf16_t*)(F.ws + WS_WIN) + (size_t)l * INC * 1024, 1024, 64 * nb, scr, F.lane); continue; }
        it -= I_IN;
        if (it < I_BR) { const int idx = it >> 7, rr = it & 127, kb = rr >> 4, nb = rr & 15;
            transpose_item(a->in[24] + (size_t)idx * 512 * 1024, 1024, 64 * kb, 64 * nb, (bf16_t*)(F.ws + WS_WBR) + (size_t)idx * 1024 * 512, 512, 64 * nb, scr, F.lane); continue; }
        it -= I_BR;
        if (it < I_OUT) { const int l = it >> 8, rr = it & 255, kb = rr >> 4, nb = rr & 15;
            transpose_item(a->in[25] + (size_t)l * 1048576, 1024, 64 * kb, 64 * nb, (bf16_t*)(F.ws + WS_WOUT) + (size_t)l * 1048576, 1024, 64 * nb, scr, F.lane); continue; }
        it -= I_OUT;
        { const int idx = it >> 6, l = idx / 3, which = idx - l * 3, rr = it & 63; const size_t lo = (size_t)l * 262144;
          conv_expert_item(a->in[33] + lo, a->in[34] + lo, a->in[35] + lo, (bf16_t*)(F.ws + WS_WSH1) + (size_t)l * 524288, (bf16_t*)(F.ws + WS_WSH2) + (size_t)l * 262144, which, rr, scr, F.lane); }
    }
    conv_moe_layer(F, a, 0);
    { const int gt = F.bid * NTHR + F.tid, NG = F.G * NTHR;
      bf16_t* wl = (bf16_t*)(F.ws + WS_WLRU);
      for (int i = gt; i < 2 * 2 * 2 * 8 * 4096; i += NG) {
          const int ii = i & 63, j = (i >> 6) & 63, cb = (i >> 12) & 7, ax = (i >> 15) & 1, d = (i >> 16) & 1, l = i >> 17;
          const float* src = ax == 0 ? a->in[19] : a->in[21];
          wl[i] = (bf16_t)f2bf(src[(size_t)((l * 2 + d) * 8 + cb) * 4096 + ii * 64 + j]); }
      bf16_t* wrt = (bf16_t*)(F.ws + WS_WRT);
      for (int i = gt; i < 2 * 64 * 1024; i += NG) { const int k = i & 1023, e = (i >> 10) & 63, l = i >> 16; wrt[i] = (bf16_t)f2bf(a->in[28][(size_t)(l * 1024 + k) * 64 + e]); }
      bf16_t* wsg = (bf16_t*)(F.ws + WS_WSG);
      for (int i = gt; i < 2 * 4 * 128 * 128; i += NG) wsg[i] = (bf16_t)f2bf(a->in[15][i]);
      if (F.bid == 0) { float* rope = (float*)(F.ws + WS_ROPE);
          for (int t = F.tid; t < 1024; t += NTHR) { const int p = t >> 4, f = t & 15; const float inv = powf(10000.0f, -(float)f / 16.0f); const float ang = (float)p * inv; rope[2 * t] = cosf(ang); rope[2 * t + 1] = sinf(ang); } }
      if (F.bid == (1 % F.G) && F.wave == 0) { float* lam = (float*)(F.ws + WS_LAM);
#pragma unroll
          for (int l = 0; l < 2; ++l) { const float s1 = wave_sum(a->in[8][l * 64 + F.lane] * a->in[9][l * 64 + F.lane]), s2 = wave_sum(a->in[10][l * 64 + F.lane] * a->in[11][l * 64 + F.lane]);
              const float li = 0.8f - 0.6f * expf(-0.3f * (float)l); if (F.lane == 0) lam[l] = expf(s1) - expf(s2) + li; } }
    }
    __syncthreads();
    LAS float* sl = (LAS float*)(F.lds);
    for (int i = F.tid; i < 5 * 1024; i += NTHR) { const int b = i >> 10, k = i & 1023; const float cv = b < 4 ? a->in[1][b * 1024 + k] : a->in[3][k]; sl[i] = silu_(cv); }
    __syncthreads();
    float* mod = (float*)(F.ws + WS_MOD);
    LAS float* part = (LAS float*)(F.lds + 20480);
    for (int c = F.bid; c < 192; c += F.G) {
        const int l = c / 96, cg = c - l * 96, col = F.tid & 63, ks = F.wave, n = cg * 64 + col;
        const float* w = a->in[4] + ((size_t)l * 1024 + ks * 128) * 6144 + n;
        float acc[5] = {0.f, 0.f, 0.f, 0.f, 0.f};
#pragma unroll 8
        for (int k = 0; k < 128; ++k) { const float wv = w[(size_t)k * 6144];
#pragma unroll
            for (int b = 0; b < 5; ++b) acc[b] += sl[b * 1024 + ks * 128 + k] * wv; }
#pragma unroll
        for (int b = 0; b < 5; ++b) part[(ks * 5 + b) * 64 + col] = acc[b];
        __syncthreads();
        if (F.tid < 320) { const int b = F.tid >> 6; float s = a->in[5][l * 6144 + n];
#pragma unroll
            for (int k8 = 0; k8 < 8; ++k8) s += part[(k8 * 5 + b) * 64 + col];
            mod[(l * 5 + b) * 6144 + n] = s; }
        __syncthreads();
    }
}

__device__ __forceinline__ void row_load(const float* p, int lane, f32x4 (&v)[4]) {
#pragma unroll
    for (int j = 0; j < 4; ++j) v[j] = *(const f32x4*)(p + 4 * lane + 256 * j);
}
__device__ __forceinline__ void row_load_bf16(const float* p, int lane, f32x4 (&v)[4]) {
#pragma unroll
    for (int j = 0; j < 4; ++j) { const u32x2 w = *(const u32x2*)((const bf16_t*)p + 4 * lane + 256 * j); v[j] = (f32x4){bflo(w.x), bfhi(w.x), bflo(w.y), bfhi(w.y)}; }
}
__device__ __forceinline__ void row_store(float* p, int lane, const f32x4 (&v)[4]) {
#pragma unroll
    for (int j = 0; j < 4; ++j) *(f32x4*)(p + 4 * lane + 256 * j) = v[j];
}
__device__ __forceinline__ void row_ln(f32x4 (&v)[4]) {
    float s = 0.f;
#pragma unroll
    for (int j = 0; j < 4; ++j) s += (v[j][0] + v[j][1]) + (v[j][2] + v[j][3]);
    const float mean = wave_sum(s) * (1.f / DM); float q = 0.f;
#pragma unroll
    for (int j = 0; j < 4; ++j) { v[j] = v[j] - mean; q += (v[j][0] * v[j][0] + v[j][1] * v[j][1]) + (v[j][2] * v[j][2] + v[j][3] * v[j][3]); }
    const float rstd = __builtin_amdgcn_rsqf(wave_sum(q) * (1.f / DM) + LN_EPS);
#pragma unroll
    for (int j = 0; j < 4; ++j) v[j] = v[j] * rstd;
}
__device__ __forceinline__ void row_affine(f32x4 (&v)[4], const float* scale1p  , bool plus1, const float* shift, int lane) {
#pragma unroll
    for (int j = 0; j < 4; ++j) { const f32x4 sc = *(const f32x4*)(scale1p + 4 * lane + 256 * j), sh = *(const f32x4*)(shift + 4 * lane + 256 * j);
        v[j] = plus1 ? v[j] * (sc + 1.0f) + sh : v[j] * sc + sh; }
}
__device__ __forceinline__ void row_store_bf16(bf16_t* p, int lane, const f32x4 (&v)[4]) {
#pragma unroll
    for (int j = 0; j < 4; ++j) { u32x2 w; w.x = pk2(v[j][0], v[j][1]); w.y = pk2(v[j][2], v[j][3]); *(u32x2*)(p + 4 * lane + 256 * j) = w; }
}

__device__ __forceinline__ void phase_rows0(const Frame& F, CArgsP a) {
    const float* mod = (const float*)(F.ws + WS_MOD); float* xc = (float*)(F.ws + WS_XC); bf16_t* H = (bf16_t*)(F.ws + WS_H);
    for (int tok = F.gw; tok < T; tok += F.NGW) {
        const int b = tok / TPB, j = tok - b * TPB; const bool isc = j < CTX;
        const float* src = isc ? a->in[2] + (size_t)(b * CTX + j) * DM : a->in[0] + (size_t)(b * SEQ + j - CTX) * DM;
        f32x4 v[4]; row_load(src, F.lane, v);
        row_store_bf16((bf16_t*)resid_row(F.out, xc, tok), F.lane, v);
        row_ln(v);
        const float* mrow = mod + (isc ? 4 : b) * 6144;
        row_affine(v, mrow + 1024, true, mrow, F.lane);
        row_store_bf16(H + (size_t)tok * DM, F.lane, v);
    }
}

__device__ __forceinline__ void sg_item(const Frame& F, CArgsP a, int l, int chunk, int g) {
    LAS bf16_t* vgT = (LAS bf16_t*)F.lds;
    const bf16_t* Sb = (const bf16_t*)(F.ws + OV_S); const bf16_t* Ub = (const bf16_t*)(F.ws + OV_U); bf16_t* OB = (bf16_t*)(F.ws + OV_OB);
    const int tok0 = chunk * 128;
    { const int q = F.tid >> 2, qt = F.tid & 3;
      const bf16_t* sp = Sb + (size_t)(tok0 + q) * 512 + g * 128 + qt * 32;
      float x[32];
#pragma unroll
      for (int i = 0; i < 4; ++i) { const u32x4 w = *(const u32x4*)(sp + 8 * i);
          x[8 * i + 0] = gelu_tanh(bflo(w.x)); x[8 * i + 1] = gelu_tanh(bfhi(w.x)); x[8 * i + 2] = gelu_tanh(bflo(w.y)); x[8 * i + 3] = gelu_tanh(bfhi(w.y)); x[8 * i + 4] = gelu_tanh(bflo(w.z)); x[8 * i + 5] = gelu_tanh(bfhi(w.z)); x[8 * i + 6] = gelu_tanh(bflo(w.w)); x[8 * i + 7] = gelu_tanh(bfhi(w.w)); }
      float s = 0.f;
#pragma unroll
      for (int i = 0; i < 32; ++i) s += x[i];
      s += __shfl_xor(s, 1); s += __shfl_xor(s, 2); const float mean = s * (1.f / 128.f); float qq = 0.f;
#pragma unroll
      for (int i = 0; i < 32; ++i) { x[i] -= mean; qq += x[i] * x[i]; }
      qq += __shfl_xor(qq, 1); qq += __shfl_xor(qq, 2); const float rstd = 1.f / sqrtf(qq * (1.f / 128.f) + LN_EPS);
      const float* lg = a->in[13] + l * 512 + g * 128 + qt * 32; const float* lb = a->in[14] + l * 512 + g * 128 + qt * 32;
#pragma unroll
      for (int i = 0; i < 32; ++i) vgT[(qt * 32 + i) * 136 + q] = (bf16_t)f2bf(x[i] * rstd * lg[i] + lb[i]);
    }
    __syncthreads();
    const int w = F.wave, fr = F.lane & 15, fq = F.lane >> 4;
    bf16x8 af[4];
#pragma unroll
    for (int ks = 0; ks < 4; ++ks) af[ks] = *(const LAS bf16x8*)(vgT + (w * 16 + fr) * 136 + ks * 32 + fq * 8);
    const bf16_t* W = (const bf16_t*)(F.ws + WS_WSG) + (size_t)(l * 4 + g) * 16384;
    const float* bs = a->in[16] + (l * 4 + g) * 128;
#pragma unroll 2
    for (int n = 0; n < 8; ++n) {
        f32x4 d = {0.f, 0.f, 0.f, 0.f};
#pragma unroll
        for (int ks = 0; ks < 4; ++ks) { const bf16x8 bfv = *(const bf16x8*)(W + (n * 16 + fr) * 128 + ks * 32 + fq * 8); d = __builtin_amdgcn_mfma_f32_16x16x32_bf16(af[ks], bfv, d, 0, 0, 0); }
        const int p = n * 16 + fr, c0 = w * 16 + fq * 4; const float bsp = bs[p];
        const size_t off = (size_t)(tok0 + p) * 512 + g * 128 + c0;
        const u32x2 uu = *(const u32x2*)(Ub + off);
        u32x2 o; o.x = pk2(gelu_tanh(bflo(uu.x)) * (d[0] + bsp), gelu_tanh(bfhi(uu.x)) * (d[1] + bsp)); o.y = pk2(gelu_tanh(bflo(uu.y)) * (d[2] + bsp), gelu_tanh(bfhi(uu.y)) * (d[3] + bsp));
        *(u32x2*)(OB + off) = o;
    }
    __syncthreads();
}

constexpr int SG_WOFF = 0, SG_VOFF = 34816;
__device__ __forceinline__ void sg_loads(const Frame& F, int chunk, int g, u32x4 (&sv)[4], u32x2 (&uu)[8]) {
    const bf16_t* Sb = (const bf16_t*)(F.ws + OV_S); const bf16_t* Ub = (const bf16_t*)(F.ws + OV_U);
    const int tok0 = chunk * 128, q = F.tid >> 2, qt = F.tid & 3;
    const bf16_t* sp = Sb + (size_t)(tok0 + q) * 512 + g * 128 + qt * 32;
#pragma unroll
    for (int i = 0; i < 4; ++i) sv[i] = *(const u32x4*)(sp + 8 * i);
    const int fr = F.lane & 15, fq = F.lane >> 4;
#pragma unroll
    for (int n = 0; n < 8; ++n) uu[n] = *(const u32x2*)(Ub + (size_t)(tok0 + n * 16 + fr) * 512 + g * 128 + F.wave * 16 + fq * 4);
}
__device__ __forceinline__ void sg_stage1(const Frame& F, CArgsP a, int l, int g, const u32x4 (&sv)[4], LAS bf16_t* vgT) {
    const int q = F.tid >> 2, qt = F.tid & 3;
    float x[32];
#pragma unroll
    for (int i = 0; i < 4; ++i) { const u32x4 w = sv[i];
        x[8 * i + 0] = gelu_tanh(bflo(w.x)); x[8 * i + 1] = gelu_tanh(bfhi(w.x)); x[8 * i + 2] = gelu_tanh(bflo(w.y)); x[8 * i + 3] = gelu_tanh(bfhi(w.y)); x[8 * i + 4] = gelu_tanh(bflo(w.z)); x[8 * i + 5] = gelu_tanh(bfhi(w.z)); x[8 * i + 6] = gelu_tanh(bflo(w.w)); x[8 * i + 7] = gelu_tanh(bfhi(w.w)); }
    float s = 0.f;
#pragma unroll
    for (int i = 0; i < 32; ++i) s += x[i];
    s += __shfl_xor(s, 1); s += __shfl_xor(s, 2); const float mean = s * (1.f / 128.f); float qq = 0.f;
#pragma unroll
    for (int i = 0; i < 32; ++i) { x[i] -= mean; qq += x[i] * x[i]; }
    qq += __shfl_xor(qq, 1); qq += __shfl_xor(qq, 2); const float rstd = __builtin_amdgcn_rsqf(qq * (1.f / 128.f) + LN_EPS);
    const float* lg = a->in[13] + l * 512 + g * 128 + qt * 32; const float* lb = a->in[14] + l * 512 + g * 128 + qt * 32;
    const int qs = q ^ (qt << 4);
#pragma unroll
    for (int i = 0; i < 32; ++i) vgT[(qt * 32 + i) * 136 + qs] = (bf16_t)f2bf(x[i] * rstd * lg[i] + lb[i]);
}
__device__ __forceinline__ void sg_stage2(const Frame& F, CArgsP a, int l, int chunk, int g, const u32x2 (&uu)[8], const LAS bf16_t* vgT, const LAS bf16_t* Wl) {
    bf16_t* OB = (bf16_t*)(F.ws + OV_OB);
    const int w = F.wave, fr = F.lane & 15, fq = F.lane >> 4, tok0 = chunk * 128;
    bf16x8 af[4];
#pragma unroll
    for (int ks = 0; ks < 4; ++ks) af[ks] = *(const LAS bf16x8*)(vgT + (w * 16 + fr) * 136 + ((ks * 32 + fq * 8) ^ ((w >> 1) << 4)));
    const float* bs = a->in[16] + (l * 4 + g) * 128;
#pragma unroll
    for (int n = 0; n < 8; ++n) {
        f32x4 d = {0.f, 0.f, 0.f, 0.f};
#pragma unroll
        for (int ks = 0; ks < 4; ++ks) { const bf16x8 bfv = *(const LAS bf16x8*)(Wl + (n * 16 + fr) * 136 + ks * 32 + fq * 8); d = __builtin_amdgcn_mfma_f32_16x16x32_bf16(af[ks], bfv, d, 0, 0, 0); }
        const int p = n * 16 + fr, c0 = w * 16 + fq * 4; const float bsp = bs[p];
        const u32x2 u2 = uu[n];
        u32x2 o; o.x = pk2(gelu_tanh(bflo(u2.x)) * (d[0] + bsp), gelu_tanh(bfhi(u2.x)) * (d[1] + bsp)); o.y = pk2(gelu_tanh(bflo(u2.y)) * (d[2] + bsp), gelu_tanh(bfhi(u2.y)) * (d[3] + bsp));
        *(u32x2*)(OB + (size_t)(tok0 + p) * 512 + g * 128 + c0) = o;
    }
}
__device__ __forceinline__ int sg_next(int& it, int G, bool lat) { while (it < 136 * 4) { const int ch = it >> 2; it += G; if (!(lat && (ch % 34) < 2)) return ch; } return -1; }
__device__ __forceinline__ void sg_phase(const Frame& F, CArgsP a, int l, bool lat) {
    if (F.G % 4 != 0) { for (int it = F.bid; it < 136 * 4; it += F.G) { const int chunk = it >> 2; if (lat && (chunk % 34) < 2) continue; sg_item(F, a, l, chunk, it & 3); } return; }
    const int g = F.bid & 3; int it = F.bid;
    int c0 = sg_next(it, F.G, lat); if (c0 < 0) return;
    LAS bf16_t* Wl = (LAS bf16_t*)(F.lds + SG_WOFF); LAS bf16_t* v0 = (LAS bf16_t*)(F.lds + SG_VOFF); LAS bf16_t* v1 = v0 + 128 * 136;
    { const bf16_t* W = (const bf16_t*)(F.ws + WS_WSG) + (size_t)(l * 4 + g) * 16384; const int p = F.tid >> 2, part = F.tid & 3;
      u32x4 wv[4];
#pragma unroll
      for (int i = 0; i < 4; ++i) wv[i] = *(const u32x4*)(W + p * 128 + part * 32 + 8 * i);
#pragma unroll
      for (int i = 0; i < 4; ++i) *(LAS u32x4*)(Wl + p * 136 + part * 32 + 8 * i) = wv[i]; }
    for (;;) {
        const int c1 = sg_next(it, F.G, lat);
        u32x4 s0[4], s1[4]; u32x2 u0[8], u1[8];
        sg_loads(F, c0, g, s0, u0);
        if (c1 >= 0) sg_loads(F, c1, g, s1, u1);
        sg_stage1(F, a, l, g, s0, v0);
        if (c1 >= 0) sg_stage1(F, a, l, g, s1, v1);
        __syncthreads();
        sg_stage2(F, a, l, c0, g, u0, v0, Wl);
        if (c1 >= 0) sg_stage2(F, a, l, c1, g, u1, v1, Wl);
        if (c1 < 0) break;
        c0 = sg_next(it, F.G, lat); if (c0 < 0) break;
        __syncthreads();
    }
    __syncthreads();
}

template <bool REV>
__device__ __forceinline__ void lru_scan(const f32x4 (&av)[4], const f32x4 (&bv)[4], f32x4 (&hv)[4], int lane, int mode, float hin, float& sumA, float& sumH) {
#define LRU_MI(k) (REV ? 3 - (k) : (k))
    const int fr = lane & 15, fq = lane >> 4, q = REV ? 3 - fq : fq;
    const int s1 = REV ? lane + 16 : lane - 16, s2 = REV ? lane + 32 : lane - 32, st = REV ? fr : 48 + fr;
    float Ea[4], Eh[4], Ta[4], Th[4];
#pragma unroll
    for (int m = 0; m < 4; ++m) {
        float A = 1.f, H = 0.f;
#pragma unroll
        for (int rk = 0; rk < 4; ++rk) { const int r = LRU_MI(rk); H = av[m][r] * H + bv[m][r]; A *= av[m][r]; }
        float pa = __shfl(A, s1), ph = __shfl(H, s1); if (q >= 1) { H = A * ph + H; A *= pa; }
        pa = __shfl(A, s2); ph = __shfl(H, s2); if (q >= 2) { H = A * ph + H; A *= pa; }
        float ea = __shfl(A, s1), eh = __shfl(H, s1); if (q == 0) { ea = 1.f; eh = 0.f; }
        Ea[m] = ea; Eh[m] = eh; Ta[m] = __shfl(A, st); Th[m] = __shfl(H, st);
    }
    if (mode == 0) {
        float A = 1.f, H = 0.f;
#pragma unroll
        for (int mk = 0; mk < 4; ++mk) { const int m = LRU_MI(mk); H = Ta[m] * H + Th[m]; A *= Ta[m]; }
        sumA = A; sumH = H;
    } else {
        float S = hin;
#pragma unroll
        for (int mk = 0; mk < 4; ++mk) { const int m = LRU_MI(mk); float h = Ea[m] * S + Eh[m];
#pragma unroll
            for (int rk = 0; rk < 4; ++rk) { const int r = LRU_MI(rk); h = av[m][r] * h + bv[m][r]; hv[m][r] = h; }
            S = Ta[m] * S + Th[m]; }
    }
#undef LRU_MI
}
struct LruConst { f32x4 cw[4][2]; f32x4 cbias[2]; bf16x8 wa0, wa1, wx0, wx1; float ba, bx, sp; };
struct LruIn { u32x4 x[4]; u32x4 y; float hin; };
__device__ __forceinline__ void lru_load_const(const Frame& F, CArgsP a, int l, int cb, LruConst& c) {
    const int lane = F.lane, fr = lane & 15, fq = lane >> 4, d = F.wave >> 2, nt = F.wave & 3, ch0 = cb * 64, c8 = (F.tid & 7) * 8;
    const bf16_t* Wa = (const bf16_t*)(F.ws + WS_WLRU) + (size_t)((l * 4 + d * 2) * 8 + cb) * 4096 + (nt * 16 + fr) * 64 + fq * 8;
    c.wa0 = *(const bf16x8*)(Wa); c.wa1 = *(const bf16x8*)(Wa + 32); c.wx0 = *(const bf16x8*)(Wa + 8 * 4096); c.wx1 = *(const bf16x8*)(Wa + 8 * 4096 + 32);
    const int pidx = (l * 2 + d) * 512 + ch0 + nt * 16 + fr;
    c.ba = a->in[20][pidx]; c.bx = a->in[22][pidx]; c.sp = log1pf(expf(-a->in[23][pidx]));
#pragma unroll
    for (int jj = 0; jj < 4; ++jj) { c.cw[jj][0] = *(const f32x4*)(a->in[17] + l * 2048 + jj * 512 + ch0 + c8); c.cw[jj][1] = *(const f32x4*)(a->in[17] + l * 2048 + jj * 512 + ch0 + c8 + 4); }
    c.cbias[0] = *(const f32x4*)(a->in[18] + l * 512 + ch0 + c8); c.cbias[1] = *(const f32x4*)(a->in[18] + l * 512 + ch0 + c8 + 4);
}
__device__ __forceinline__ void lru_load_in(const Frame& F, int b, int chunk, int cb, int mode, LruIn& in) {
    const bf16_t* Xb = (const bf16_t*)(F.ws + OV_X); const bf16_t* Yb = (const bf16_t*)(F.ws + OV_Y);
    const int ch0 = cb * 64, ct = F.tid >> 3, c8 = (F.tid & 7) * 8, d = F.wave >> 2, ch = (F.wave & 3) * 16 + (F.lane & 15);
    const int seg_lo = chunk < 4 ? 0 : 256, seg_hi = chunk < 4 ? 256 : TPB, j0 = chunk * 64;
#pragma unroll
    for (int jj = 0; jj < 4; ++jj) { const int j = j0 + ct + jj - 2; in.x[jj] = (u32x4){0u, 0u, 0u, 0u}; if (j >= seg_lo && j < seg_hi) in.x[jj] = *(const u32x4*)(Xb + (size_t)(b * TPB + j) * 512 + ch0 + c8); }
    in.y = (u32x4){0u, 0u, 0u, 0u}; in.hin = 0.f;
    if (mode == 1) { in.y = *(const u32x4*)(Yb + (size_t)(b * TPB + j0 + ct) * 512 + ch0 + c8); in.hin = ((const float*)(F.ws + WS_HIN))[(size_t)((b * 2 + d) * 68 + chunk) * 512 + ch0 + ch]; }
}
__device__ __forceinline__ void lru_compute(const Frame& F, const LruConst& c, const LruIn& in, int b, int chunk, int cb, int mode) {
    LAS float* xs = (LAS float*)F.lds;
    LAS bf16_t* xsb = (LAS bf16_t*)(F.lds + 16384);
    LAS float* hx = (LAS float*)(F.lds + 25600);
    bf16_t* OC = (bf16_t*)(F.ws + OV_OC);
    const int tok0 = b * TPB + chunk * 64, ch0 = cb * 64;
    const int lane = F.lane, fr = lane & 15, fq = lane >> 4, d = F.wave >> 2, nt = F.wave & 3, ch = nt * 16 + fr;
    const int ct = F.tid >> 3, c8 = (F.tid & 7) * 8;
    {
      f32x4 a0 = c.cbias[0], a1 = c.cbias[1];
#pragma unroll
      for (int jj = 0; jj < 4; ++jj) { const u32x4 w = in.x[jj];
          a0 += c.cw[jj][0] * (f32x4){bflo(w.x), bfhi(w.x), bflo(w.y), bfhi(w.y)}; a1 += c.cw[jj][1] * (f32x4){bflo(w.z), bfhi(w.z), bflo(w.w), bfhi(w.w)}; }
      *(LAS f32x4*)(xs + ct * 64 + c8) = a0; *(LAS f32x4*)(xs + ct * 64 + c8 + 4) = a1;
      u32x4 pw; pw.x = pk2(a0[0], a0[1]); pw.y = pk2(a0[2], a0[3]); pw.z = pk2(a1[0], a1[1]); pw.w = pk2(a1[2], a1[3]);
      *(LAS u32x4*)(xsb + ct * 72 + c8) = pw; }
    __syncthreads();
    f32x4 av[4], bv[4], hv[4];
#pragma unroll
    for (int m = 0; m < 4; ++m) {
        const bf16x8 a0 = *(const LAS bf16x8*)(xsb + (m * 16 + fr) * 72 + fq * 8), a1 = *(const LAS bf16x8*)(xsb + (m * 16 + fr) * 72 + 32 + fq * 8);
        f32x4 da = {0.f, 0.f, 0.f, 0.f}, dx = {0.f, 0.f, 0.f, 0.f};
        da = __builtin_amdgcn_mfma_f32_16x16x32_bf16(a0, c.wa0, da, 0, 0, 0); da = __builtin_amdgcn_mfma_f32_16x16x32_bf16(a1, c.wa1, da, 0, 0, 0);
        dx = __builtin_amdgcn_mfma_f32_16x16x32_bf16(a0, c.wx0, dx, 0, 0, 0); dx = __builtin_amdgcn_mfma_f32_16x16x32_bf16(a1, c.wx1, dx, 0, 0, 0);
#pragma unroll
        for (int r = 0; r < 4; ++r) { const float rg = sigmoidf_(da[r] + c.ba), ig = sigmoidf_(dx[r] + c.bx); const float la = -8.0f * rg * c.sp;
            const float e1 = expm1_fast(la);
            av[m][r] = 1.0f + e1; bv[m][r] = __builtin_amdgcn_sqrtf(-e1 * (2.0f + e1)) * (ig * xs[(m * 16 + fq * 4 + r) * 64 + ch]); hv[m][r] = 0.f; }
    }
    float sumA = 1.f, sumH = 0.f;
    if (d == 0) lru_scan<false>(av, bv, hv, lane, mode, in.hin, sumA, sumH); else lru_scan<true>(av, bv, hv, lane, mode, in.hin, sumA, sumH);
    if (mode == 0) {
        if (fq == 0) { float* sum = (float*)(F.ws + WS_SUM) + ((size_t)((b * 2 + d) * 68 + chunk) * 512 + ch0 + ch) * 2; *(float2*)sum = make_float2(sumA, sumH); }
        __syncthreads();
        return;
    }
#pragma unroll
    for (int m = 0; m < 4; ++m)
#pragma unroll
        for (int r = 0; r < 4; ++r) hx[d * 4096 + (m * 16 + fq * 4 + r) * 64 + ch] = hv[m][r];
    __syncthreads();
    { const u32x4 yv = in.y;
      const f32x4 f0 = *(const LAS f32x4*)(hx + ct * 64 + c8), f1 = *(const LAS f32x4*)(hx + ct * 64 + c8 + 4), g0 = *(const LAS f32x4*)(hx + 4096 + ct * 64 + c8), g1 = *(const LAS f32x4*)(hx + 4096 + ct * 64 + c8 + 4);
      u32x4 o; o.x = pk2(gelu_tanh(bflo(yv.x)) * (f0[0] + g0[0]), gelu_tanh(bfhi(yv.x)) * (f0[1] + g0[1])); o.y = pk2(gelu_tanh(bflo(yv.y)) * (f0[2] + g0[2]), gelu_tanh(bfhi(yv.y)) * (f0[3] + g0[3]));
      o.z = pk2(gelu_tanh(bflo(yv.z)) * (f1[0] + g1[0]), gelu_tanh(bfhi(yv.z)) * (f1[1] + g1[1])); o.w = pk2(gelu_tanh(bflo(yv.w)) * (f1[2] + g1[2]), gelu_tanh(bfhi(yv.w)) * (f1[3] + g1[3]));
      *(u32x4*)(OC + (size_t)(tok0 + ct) * 512 + ch0 + c8) = o; }
}
__device__ __forceinline__ void lru_phase(const Frame& F, CArgsP a, int l, int mode, bool skip_ctx) {
    constexpr int NIT = 4 * 68 * 8;
    int it = F.bid;
    while (it < NIT && skip_ctx && ((it >> 3) % 68) < 4) it += F.G;
    if (it >= NIT) return;
    LruConst c; LruIn cur, nxt;
    int cb = it & 7; lru_load_const(F, a, l, cb, c);
    lru_load_in(F, (it >> 3) / 68, (it >> 3) % 68, cb, mode, cur);
    for (;;) {
        int nit = it + F.G;
        while (nit < NIT && skip_ctx && ((nit >> 3) % 68) < 4) nit += F.G;
        const bool has = nit < NIT;
        if (has) lru_load_in(F, (nit >> 3) / 68, (nit >> 3) % 68, nit & 7, mode, nxt);
        lru_compute(F, c, cur, (it >> 3) / 68, (it >> 3) % 68, cb, mode);
        if (!has) break;
        if ((nit & 7) != cb) { cb = nit & 7; lru_load_const(F, a, l, cb, c); }
        it = nit; cur = nxt;
    }
}

__device__ __forceinline__ void phase_carry(const Frame& F) {
    const int gt = F.bid * NTHR + F.tid; if (gt >= 4 * 2 * 512) return;
    const int c = gt & 511, d = (gt >> 9) & 1, b = gt >> 10;
    const float* sum = (const float*)(F.ws + WS_SUM) + (size_t)((b * 2 + d) * 68) * 1024 + c * 2;
    float* hin = (float*)(F.ws + WS_HIN) + (size_t)((b * 2 + d) * 68) * 512 + c;
    float h = 0.f;
#pragma unroll 1
    for (int g0 = 0; g0 < 68; g0 += 17) {
        float A[17], Hh[17];
#pragma unroll
        for (int i = 0; i < 17; ++i) { const int o = g0 + i; const int ck = d == 0 ? o : (o < 4 ? 3 - o : 71 - o); const float2 v = *(const float2*)(sum + (size_t)ck * 1024); A[i] = v.x; Hh[i] = v.y; }
#pragma unroll
        for (int i = 0; i < 17; ++i) { const int o = g0 + i; const int ck = d == 0 ? o : (o < 4 ? 3 - o : 71 - o); hin[(size_t)ck * 512] = h; h = A[i] * h + Hh[i]; }
    }
}

constexpr int AT_KST = 272, AT_VST = 320;
constexpr int AT_KOFF = 0, AT_VOFF = 2 * 64 * AT_KST, AT_XOFF = AT_VOFF + 2 * 64 * AT_VST;
#define AT_SBAR() __builtin_amdgcn_sched_barrier(0)
struct AttnState { f32x16 o[4]; f32x16 negm; bf16x8 pfp[4]; float lrun; };
#define AT_PIN1(x) asm volatile("" : "+v"(x))
__device__ __forceinline__ float at_max3(float a, float b, float c) { float r; asm("v_max3_f32 %0, %1, %2, %3" : "=v"(r) : "v"(a), "v"(b), "v"(c)); return r; }
__device__ __forceinline__ bf16x8 at_vfrag(const LAS unsigned char* vp) {
    const s16x4 lo = __builtin_bit_cast(s16x4, __builtin_amdgcn_ds_read_tr16_b64_v4i16((LAS s16x4*)(vp)));
    const s16x4 hh = __builtin_bit_cast(s16x4, __builtin_amdgcn_ds_read_tr16_b64_v4i16((LAS s16x4*)(vp + 8 * AT_VST)));
    return (bf16x8){lo[0], lo[1], lo[2], lo[3], hh[0], hh[1], hh[2], hh[3]};
}
__device__ __forceinline__ float attn_stage1(const AttnState& st, const f32x16& p0, const f32x16& p1, f32x16& n0, f32x16& n1, const LAS unsigned char* ql, const LAS unsigned char* kf) {
    bf16x8 a0 = *(const LAS bf16x8*)(kf), a1 = *(const LAS bf16x8*)(kf + 32 * AT_KST), q = *(const LAS bf16x8*)(ql);
    AT_SBAR();
    float mx = at_max3(p0[0], p0[1], at_max3(p1[0], p1[1], p1[1]));
    mx = at_max3(at_max3(mx, p0[2], p0[3]), p1[2], p1[3]); mx = at_max3(at_max3(mx, p0[4], p0[5]), p1[4], p1[5]); AT_PIN1(mx);
    AT_SBAR();
#pragma unroll
    for (int ks = 0; ks < 4; ++ks) {
        bf16x8 b0 = a0, b1 = a1, qn = q;
        if (ks < 3) { b0 = *(const LAS bf16x8*)(kf + (ks + 1) * 32); b1 = *(const LAS bf16x8*)(kf + 32 * AT_KST + (ks + 1) * 32); qn = *(const LAS bf16x8*)(ql + (ks + 1) * 1024); }
        if (ks == 0) n0 = __builtin_amdgcn_mfma_f32_32x32x16_bf16(a0, q, st.negm, 0, 0, 0);
        else n0 = __builtin_amdgcn_mfma_f32_32x32x16_bf16(a0, q, n0, 0, 0, 0);
        if (ks < 3) { mx = at_max3(at_max3(mx, p0[4 * ks + 6], p0[4 * ks + 7]), p1[4 * ks + 6], p1[4 * ks + 7]); AT_PIN1(mx); } AT_SBAR();
        if (ks == 0) n1 = __builtin_amdgcn_mfma_f32_32x32x16_bf16(a1, q, st.negm, 0, 0, 0);
        else n1 = __builtin_amdgcn_mfma_f32_32x32x16_bf16(a1, q, n1, 0, 0, 0);
        if (ks < 2) { mx = at_max3(at_max3(mx, p0[4 * ks + 8], p0[4 * ks + 9]), p1[4 * ks + 8], p1[4 * ks + 9]); AT_PIN1(mx); } AT_SBAR();
        a0 = b0; a1 = b1; q = qn;
    }
    return mx;
}
template <bool FIRST>
__device__ __forceinline__ void attn_stage2(AttnState& st, f32x16& p0, f32x16& p1, f32x16& n0, f32x16& n1, float mx, const LAS unsigned char* vf) {
    constexpr float THR = 8.0f;
    bf16x8 vcur, vnx; if (!FIRST) { vcur = at_vfrag(vf); vnx = at_vfrag(vf + 64); }
    float tm; { auto rr = __builtin_amdgcn_permlane32_swap(__float_as_uint(mx), __float_as_uint(mx), false, false); tm = fmaxf(__uint_as_float(rr[0]), __uint_as_float(rr[1])); }
    if (FIRST || __any(tm > THR)) {
        const float dl = FIRST ? tm : fmaxf(tm, 0.f);
#pragma unroll
        for (int r = 0; r < 16; ++r) { p0[r] -= dl; p1[r] -= dl; n0[r] -= dl; n1[r] -= dl; st.negm[r] -= dl; }
        if (!FIRST) {
            const float al = __builtin_amdgcn_exp2f(-dl);
#pragma unroll
            for (int db = 0; db < 4; ++db)
#pragma unroll
                for (int r = 0; r < 16; ++r) st.o[db][r] *= al;
#pragma unroll
            for (int kk = 0; kk < 4; ++kk) { u32x4 w = __builtin_bit_cast(u32x4, st.pfp[kk]);
                w.x = pk2(bflo(w.x) * al, bfhi(w.x) * al); w.y = pk2(bflo(w.y) * al, bfhi(w.y) * al); w.z = pk2(bflo(w.z) * al, bfhi(w.z) * al); w.w = pk2(bflo(w.w) * al, bfhi(w.w) * al);
                st.pfp[kk] = __builtin_bit_cast(bf16x8, w); }
            st.lrun *= al;
        }
    }
    float ls = 0.f;
    AT_SBAR();
#pragma unroll
    for (int kk = 0; kk < 4; ++kk) {
        unsigned pw0 = 0, pw1 = 0, pw2 = 0, pw3 = 0;
#pragma unroll
        for (int db = 0; db < 4; ++db) {
            const int g = kk * 4 + db;
            if (!FIRST) {
                bf16x8 vn2 = vnx;
                if (g < 14) { const int g2 = g + 2; vn2 = at_vfrag(vf + ((g2 >> 2) * 16) * AT_VST + (g2 & 3) * 64); }
                st.o[db] = __builtin_amdgcn_mfma_f32_32x32x16_bf16(vcur, st.pfp[kk], st.o[db], 0, 0, 0);
                vcur = vnx; vnx = vn2;
            }
            const float x0 = g < 8 ? p0[2 * g] : p1[2 * g - 16], x1 = g < 8 ? p0[2 * g + 1] : p1[2 * g - 15];
            const float e0 = __builtin_amdgcn_exp2f(x0), e1 = __builtin_amdgcn_exp2f(x1);
            ls += e0 + e1; unsigned w = pk2(e0, e1); AT_PIN1(ls); AT_PIN1(w);
            if (db == 0) pw0 = w; else if (db == 1) pw1 = w; else if (db == 2) pw2 = w; else pw3 = w;
            AT_SBAR();
        }
        st.pfp[kk] = __builtin_bit_cast(bf16x8, (u32x4){pw0, pw1, pw2, pw3});
    }
    st.lrun += ls;
}
__device__ __forceinline__ void attn_unit(const Frame& F, int tokq0, int tokk0, int ntiles, int h, float lam, const float* gain, float oscale) {
    const bf16_t* Q = (const bf16_t*)(F.ws + OV_Q); const char* Kg = (const char*)(F.ws + OV_K); const char* Vg = (const char*)(F.ws + OV_V); bf16_t* OA = (bf16_t*)(F.ws + OV_OA);
    const int lane = F.lane, r32 = lane & 31, hi = lane >> 5, rb = F.wave >> 1, c = F.wave & 1;
    LAS unsigned char* ql = F.lds + AT_XOFF + F.wave * 4096 + lane * 16;
    { const bf16_t* qp = Q + (size_t)(tokq0 + rb * 32 + r32) * 512 + h * 128 + c * 64 + hi * 8;
#pragma unroll
      for (int ks = 0; ks < 4; ++ks) *(LAS bf16x8*)(ql + ks * 1024) = *(const bf16x8*)(qp + ks * 16); }
    const int srow0 = F.tid >> 4, sch = F.tid & 15;
    const unsigned goff = (unsigned)(((tokk0 + srow0) * 512 + h * 128 + sch * 8) * 2);
    LAS unsigned char* kl = F.lds + AT_KOFF + srow0 * AT_KST + sch * 16;
    LAS unsigned char* vl = F.lds + AT_VOFF + srow0 * AT_VST + sch * 16;
    const LAS unsigned char* kfb = F.lds + AT_KOFF + r32 * AT_KST + (c * 64 + hi * 8) * 2;
    const LAS unsigned char* vfb = F.lds + AT_VOFF + (4 * hi + ((lane & 15) >> 2)) * AT_VST + (((lane >> 4) & 1) * 16 + (lane & 3) * 4) * 2;
    {
      const u32x4 k0 = *(const u32x4*)(Kg + goff), k1 = *(const u32x4*)(Kg + goff + 32 * 1024), k2 = *(const u32x4*)(Kg + goff + 64 * 1024), k3 = *(const u32x4*)(Kg + goff + 96 * 1024);
      *(LAS u32x4*)(kl) = k0; *(LAS u32x4*)(kl + 32 * AT_KST) = k1; *(LAS u32x4*)(kl + 64 * AT_KST) = k2; *(LAS u32x4*)(kl + 96 * AT_KST) = k3; }
    __syncthreads();
    AttnState st; st.lrun = 0.f;
#pragma unroll
    for (int r = 0; r < 16; ++r) st.negm[r] = 0.f;
#pragma unroll
    for (int db = 0; db < 4; ++db)
#pragma unroll
        for (int r = 0; r < 16; ++r) st.o[db][r] = 0.f;
    f32x16 pa0, pa1, pb0, pb1;
#pragma unroll
    for (int r = 0; r < 16; ++r) { pa0[r] = 0.f; pa1[r] = 0.f; }
#pragma unroll
    for (int ks = 0; ks < 4; ++ks) {
        const bf16x8 a0 = *(const LAS bf16x8*)(kfb + ks * 32), a1 = *(const LAS bf16x8*)(kfb + 32 * AT_KST + ks * 32);
        const bf16x8 q = *(const LAS bf16x8*)(ql + ks * 1024);
        pa0 = __builtin_amdgcn_mfma_f32_32x32x16_bf16(a0, q, pa0, 0, 0, 0); pa1 = __builtin_amdgcn_mfma_f32_32x32x16_bf16(a1, q, pa1, 0, 0, 0);
    }
    asm volatile("s_nop 15\n\ts_nop 7" : "+v"(pa0), "+v"(pa1));
    u32x4 sv0 = *(const u32x4*)(Vg + goff), sv1 = *(const u32x4*)(Vg + goff + 32 * 1024);
#define AT_ITER(I, FIRSTF, PC0, PC1, PN0, PN1) do { \
        const int i_ = (I); const bool ldk_ = i_ + 2 < ntiles; const int sl_ = i_ & 1; \
        const float mx_ = attn_stage1(st, PC0, PC1, PN0, PN1, ql, kfb + ((i_ + 1) & 1) * (64 * AT_KST)); \
        *(LAS u32x4*)(vl + sl_ * (64 * AT_VST)) = sv0; *(LAS u32x4*)(vl + sl_ * (64 * AT_VST) + 32 * AT_VST) = sv1; \
        u32x4 sk0_, sk1_; if (ldk_) { const unsigned go_ = goff + (unsigned)(i_ + 2) * 65536u; sk0_ = *(const u32x4*)(Kg + go_); sk1_ = *(const u32x4*)(Kg + go_ + 32 * 1024); } \
        attn_stage2<FIRSTF>(st, PC0, PC1, PN0, PN1, mx_, vfb + ((i_ + 1) & 1) * (64 * AT_VST)); \
        if (ldk_) { *(LAS u32x4*)(kl + sl_ * (64 * AT_KST)) = sk0_; *(LAS u32x4*)(kl + sl_ * (64 * AT_KST) + 32 * AT_KST) = sk1_; } \
        if (i_ + 1 < ntiles) { const unsigned gv_ = goff + (unsigned)(i_ + 1) * 65536u; sv0 = *(const u32x4*)(Vg + gv_); sv1 = *(const u32x4*)(Vg + gv_ + 32 * 1024); } \
        __syncthreads(); } while (0)
    AT_ITER(0, true, pa0, pa1, pb0, pb1);
    AT_ITER(1, false, pb0, pb1, pa0, pa1);
#pragma unroll 1
    for (int i = 2; i < ntiles; i += 2) {
        AT_ITER(i, false, pa0, pa1, pb0, pb1);
        AT_ITER(i + 1, false, pb0, pb1, pa0, pa1);
    }
#undef AT_ITER
    {
      const LAS unsigned char* vf = vfb + ((ntiles - 1) & 1) * (64 * AT_VST);
#pragma unroll
      for (int db = 0; db < 4; ++db)
#pragma unroll
          for (int kk = 0; kk < 4; ++kk) {
              const LAS unsigned char* vp = vf + (kk * 16) * AT_VST + db * 64;
              const s16x4 lo = __builtin_bit_cast(s16x4, __builtin_amdgcn_ds_read_tr16_b64_v4i16((LAS s16x4*)(vp)));
              const s16x4 hh = __builtin_bit_cast(s16x4, __builtin_amdgcn_ds_read_tr16_b64_v4i16((LAS s16x4*)(vp + 8 * AT_VST)));
              const bf16x8 vfr = {lo[0], lo[1], lo[2], lo[3], hh[0], hh[1], hh[2], hh[3]};
              st.o[db] = __builtin_amdgcn_mfma_f32_32x32x16_bf16(vfr, st.pfp[kk], st.o[db], 0, 0, 0);
          } }
    float lrun = st.lrun; lrun += __shfl_xor(lrun, 32);
    const float il = 1.f / lrun;
    LAS float* ex = (LAS float*)(F.lds + AT_XOFF) + rb * 4096;
    if (c == 1) {
#pragma unroll
        for (int db = 0; db < 4; ++db)
#pragma unroll
            for (int r = 0; r < 16; ++r) ex[(db * 16 + r) * 64 + lane] = st.o[db][r] * il;
    }
    __syncthreads();
    if (c == 0) {
        float ss = 0.f;
#pragma unroll
        for (int db = 0; db < 4; ++db)
#pragma unroll
            for (int r = 0; r < 16; ++r) { const float dv = st.o[db][r] * il - lam * ex[(db * 16 + r) * 64 + lane]; st.o[db][r] = dv; ss += dv * dv; }
        ss += __shfl_xor(ss, 32);
        const float rinv = oscale / sqrtf(ss * (1.f / 128.f) + RMS_EPS);
        bf16_t* op = OA + (size_t)(tokq0 + rb * 32 + r32) * 512 + h * 128;
#pragma unroll
        for (int db = 0; db < 4; ++db)
#pragma unroll
            for (int r4 = 0; r4 < 4; ++r4) { const int dv0 = db * 32 + 8 * r4 + 4 * hi; const f32x4 gv = *(const f32x4*)(gain + dv0);
                u32x2 w; w.x = pk2(st.o[db][4 * r4] * rinv * gv[0], st.o[db][4 * r4 + 1] * rinv * gv[1]); w.y = pk2(st.o[db][4 * r4 + 2] * rinv * gv[2], st.o[db][4 * r4 + 3] * rinv * gv[3]);
                *(u32x2*)(op + dv0) = w; }
    }
    __syncthreads();
}

__device__ __forceinline__ void phase_attn(const Frame& F, CArgsP a, int l) {
    const float lam = ((const float*)(F.ws + WS_LAM))[l]; const float li = 0.8f - 0.6f * expf(-0.3f * (float)l);
    for (int dd = 0; dd < NDUP(6); ++dd) lru_phase(F, a, l, 1, l == 1);
    __syncthreads();
    const int nlat = 4 * 4 * 32, nctx = (l == 0) ? 4 * 4 * 2 : 0;
    for (int dd = 0; dd < NDUP(7); ++dd)
    for (int it = F.vcu; it < nlat + nctx; it += F.G) {
        int b, h, qb, tq0, nt;
        if (it < nlat) { qb = it & 31; h = (it >> 5) & 3; b = it >> 7; tq0 = b * TPB + CTX + qb * 128; nt = 68; }
        else { const int i2 = it - nlat; qb = i2 & 1; h = (i2 >> 1) & 3; b = i2 >> 3; tq0 = b * TPB + qb * 128; nt = 4; }
        attn_unit(F, tq0, b * TPB, nt, h, lam, a->in[12] + (l * 4 + h) * 128, 1.0f - li);
    }
}

__device__ __forceinline__ void mini_tile(const bf16_t* A, int lda, const bf16_t* Bt, int K, int lane, int wave, f32x4 (&acc)[2]) {
    const int fr = lane & 15, fq = lane >> 4;
    const bf16_t* ap = A + (size_t)((wave >> 1) * 16 + fr) * lda + fq * 8;
    const bf16_t* bp0 = Bt + (size_t)((wave & 1) * 32 + fr) * K + fq * 8; const bf16_t* bp1 = bp0 + (size_t)16 * K;
    acc[0] = (f32x4){0.f, 0.f, 0.f, 0.f}; acc[1] = (f32x4){0.f, 0.f, 0.f, 0.f};
#pragma unroll 8
    for (int k = 0; k < K; k += 32) {
        const bf16x8 av = *(const bf16x8*)(ap + k), b0 = *(const bf16x8*)(bp0 + k), b1 = *(const bf16x8*)(bp1 + k);
        acc[0] = __builtin_amdgcn_mfma_f32_16x16x32_bf16(b0, av, acc[0], 0, 0, 0); acc[1] = __builtin_amdgcn_mfma_f32_16x16x32_bf16(b1, av, acc[1], 0, 0, 0);
    }
}
__device__ __forceinline__ void mini_merge_ctx(const Frame& F, int l) {
    const int fr = F.lane & 15, fq = F.lane >> 4;
    for (int t = F.bid; t < 256; t += F.G) {
        const int rb = t >> 4, cbk = t & 15, cr = rb * 64, tok0 = (cr >> 8) * TPB + (cr & 255), col0 = cbk * 64;
        const int row = tok0 + (F.wave >> 1) * 16 + fr, colw = col0 + (F.wave & 1) * 32 + fq * 4;
        f32x4 mg[2] = {{0.f, 0.f, 0.f, 0.f}, {0.f, 0.f, 0.f, 0.f}};
#pragma unroll 1
        for (int r = 0; r < 3; ++r) {
            f32x4 acc[2];
            mini_tile((const bf16_t*)(F.ws + OV_OA + (size_t)r * 17 * MiB) + (size_t)tok0 * 512, 512, (const bf16_t*)(F.ws + WS_WBR) + (size_t)(l * 3 + r) * 1024 * 512 + (size_t)col0 * 512, 512, F.lane, F.wave, acc);
#pragma unroll
            for (int n = 0; n < 2; ++n) { const u32x2 g = *(const u32x2*)((const bf16_t*)(F.ws + OV_G) + (size_t)row * 3072 + r * 1024 + colw + n * 16);
                mg[n][0] += sigmoidf_(bflo(g.x)) * acc[n][0]; mg[n][1] += sigmoidf_(bfhi(g.x)) * acc[n][1]; mg[n][2] += sigmoidf_(bflo(g.y)) * acc[n][2]; mg[n][3] += sigmoidf_(bfhi(g.y)) * acc[n][3]; }
        }
#pragma unroll
        for (int n = 0; n < 2; ++n) { u32x2 w; w.x = pk2(mg[n][0], mg[n][1]); w.y = pk2(mg[n][2], mg[n][3]); *(u32x2*)((bf16_t*)(F.ws + OV_MG) + (size_t)row * DM + colw + n * 16) = w; }
    }
}
__device__ __forceinline__ void mini_wout_ctx(const Frame& F, int l) {
    const int fr = F.lane & 15, fq = F.lane >> 4;
    const float* g1 = (const float*)(F.ws + WS_MOD) + (l * 5 + 4) * 6144 + 2048;
    for (int t = F.bid; t < 256; t += F.G) {
        const int rb = t >> 4, cbk = t & 15, cr = rb * 64, tok0 = (cr >> 8) * TPB + (cr & 255), col0 = cbk * 64;
        const int crow = cr + (F.wave >> 1) * 16 + fr, colw = col0 + (F.wave & 1) * 32 + fq * 4;
        f32x4 acc[2];
        mini_tile((const bf16_t*)(F.ws + OV_MG) + (size_t)tok0 * DM, DM, (const bf16_t*)(F.ws + WS_WOUT) + (size_t)l * 1048576 + (size_t)col0 * 1024, 1024, F.lane, F.wave, acc);
#pragma unroll
        for (int n = 0; n < 2; ++n) { u32x2* p = (u32x2*)((bf16_t*)((float*)(F.ws + WS_XC) + (size_t)crow * DM) + colw + n * 16); const f32x4 gv = *(const f32x4*)(g1 + colw + n * 16); const u32x2 x = *p;
            u32x2 w; w.x = pk2(bflo(x.x) * DN_ALPHA + gv[0] * acc[n][0], bfhi(x.x) * DN_ALPHA + gv[1] * acc[n][1]); w.y = pk2(bflo(x.y) * DN_ALPHA + gv[2] * acc[n][2], bfhi(x.y) * DN_ALPHA + gv[3] * acc[n][3]); *p = w; }
    }
}

constexpr int RT_AST = 1032;
__device__ __forceinline__ void phase_router(const Frame& F, CArgsP a, int l, bool dry) {
    const float* mod = (const float*)(F.ws + WS_MOD) + l * 5 * 6144; float* xc = (float*)(F.ws + WS_XC); bf16_t* H = (bf16_t*)(F.ws + WS_H);
    LAS bf16_t* AT = (LAS bf16_t*)F.lds;
    LAS float* LG = (LAS float*)(F.lds + 32 * RT_AST * 2);
    LAS unsigned* LC = (LAS unsigned*)(F.lds + 32 * RT_AST * 2 + 8192);
    const bf16_t* Wt = (const bf16_t*)(F.ws + WS_WRT) + (size_t)l * 65536; const float rb_ = a->in[29][l * 64 + F.lane];
    unsigned* cnt = (unsigned*)(F.ws + WS_CNT) + l * 4096; int* list = (int*)(F.ws + WS_LIST);
    int* toke = (int*)(F.ws + WS_TOKE); int* tokp = (int*)(F.ws + WS_TOKP); float* tokw = (float*)(F.ws + WS_TOKW);
    const int nrows = l == 0 ? T : NBATCH * SEQ, nbatch = nrows / 32;
    const int fr = F.lane & 15, fq = F.lane >> 4, mt = F.wave & 1, nt = F.wave >> 1;
    if (F.tid < 64) LC[F.tid] = 0u;
    bf16x8 bfr[32];
    { const bf16_t* bp = Wt + (size_t)(nt * 16 + fr) * 1024 + fq * 8;
#pragma unroll
      for (int ks = 0; ks < 32; ++ks) bfr[ks] = *(const bf16x8*)(bp + ks * 32); }
    for (int bt = F.bid; bt < nbatch; bt += F.G) {
        int toks[4];
#pragma unroll
        for (int r = 0; r < 4; ++r) { const int ridx = bt * 32 + F.wave * 4 + r; toks[r] = l == 0 ? ridx : (ridx >> 12) * TPB + CTX + (ridx & 4095); }
#pragma unroll
        for (int rp = 0; rp < 4; rp += 2) {
        f32x4 vv[2][4];
        row_load_bf16(resid_row(F.out, xc, toks[rp]), F.lane, vv[0]); row_load_bf16(resid_row(F.out, xc, toks[rp + 1]), F.lane, vv[1]);
#pragma unroll
        for (int r2 = 0; r2 < 2; ++r2) { const int r = rp + r2; const int tok = toks[r];
            const int b = tok / TPB; const int bsel = (tok - b * TPB) < CTX ? 4 : b;
            float* xr = resid_row(F.out, xc, tok);
            f32x4 (&v)[4] = vv[r2]; row_ln(v); row_affine(v, a->in[26] + l * DM, false, a->in[27] + l * DM, F.lane);
            row_ln(v); const float* mrow = mod + bsel * 6144; row_affine(v, mrow + 4096, true, mrow + 3072, F.lane);
#pragma unroll
            for (int j = 0; j < 4; ++j) { u32x2 w; w.x = pk2(v[j][0], v[j][1]); w.y = pk2(v[j][2], v[j][3]);
                if (!dry) *(u32x2*)(H + (size_t)tok * DM + 4 * F.lane + 256 * j) = w; *(LAS u32x2*)(AT + (F.wave * 4 + r) * RT_AST + 4 * F.lane + 256 * j) = w; }
        }
        }
        __syncthreads();
        { f32x4 d = {0.f, 0.f, 0.f, 0.f};
          const LAS bf16_t* ap = AT + (mt * 16 + fr) * RT_AST + fq * 8;
#pragma unroll
          for (int ks = 0; ks < 32; ++ks) { const bf16x8 av = *(const LAS bf16x8*)(ap + ks * 32); d = __builtin_amdgcn_mfma_f32_16x16x32_bf16(av, bfr[ks], d, 0, 0, 0); }
#pragma unroll
          for (int r = 0; r < 4; ++r) LG[(mt * 16 + fq * 4 + r) * 64 + nt * 16 + fr] = d[r]; }
        __syncthreads();
        bool selr[4]; int rkr[4], lpr[4]; float wr_[4];
#pragma unroll
        for (int r = 0; r < 4; ++r) {
            const float lg = LG[(F.wave * 4 + r) * 64 + F.lane];
            const float s = sigmoidf_(lg); const float bsc = s + rb_;
            float m1 = bsc; m1 = fmaxf(m1, WS_DPP(m1, 0xB1, 0xF, true)); m1 = fmaxf(m1, WS_DPP(m1, 0x4E, 0xF, true)); m1 = fmaxf(m1, WS_DPP(m1, 0x141, 0xF, true));
            const unsigned long long eq = __ballot(bsc == m1); const unsigned gm = (unsigned)(eq >> (F.lane & ~7)) & 0xffu; const int first = __ffs(gm) - 1;
            float m2 = ((F.lane & 7) == first) ? -INFINITY : bsc; m2 = fmaxf(m2, WS_DPP(m2, 0xB1, 0xF, true)); m2 = fmaxf(m2, WS_DPP(m2, 0x4E, 0xF, true)); m2 = fmaxf(m2, WS_DPP(m2, 0x141, 0xF, true));
            const float gs = m1 + m2; const int myg = F.lane >> 3; int grank = 0;
#pragma unroll
            for (int g = 0; g < 8; ++g) { const float og = __builtin_bit_cast(float, __builtin_amdgcn_readlane(__builtin_bit_cast(int, gs), g * 8)); grank += (int)(og > gs) + (int)((og == gs) & (g < myg)); }
            const bool gsel = grank < 4; const float mk = gsel ? bsc : -INFINITY; int rk = 64;
            { float vv_ = mk;
#pragma unroll
              for (int k = 0; k < 8; ++k) {
                  float m = vv_; m = fmaxf(m, WS_DPP(m, 0xB1, 0xF, true)); m = fmaxf(m, WS_DPP(m, 0x4E, 0xF, true)); m = fmaxf(m, WS_DPP(m, 0x141, 0xF, true)); m = fmaxf(m, WS_DPP(m, 0x140, 0xF, true));
                  const float r1 = __builtin_bit_cast(float, __builtin_amdgcn_readlane(__builtin_bit_cast(int, m), 15)), r2 = __builtin_bit_cast(float, __builtin_amdgcn_readlane(__builtin_bit_cast(int, m), 31)),
                              r3 = __builtin_bit_cast(float, __builtin_amdgcn_readlane(__builtin_bit_cast(int, m), 47)), r4 = __builtin_bit_cast(float, __builtin_amdgcn_readlane(__builtin_bit_cast(int, m), 63));
                  const float wm = fmaxf(fmaxf(r1, r2), fmaxf(r3, r4));
                  const unsigned long long bal = __ballot(vv_ == wm); const int win = __ffsll((long long)bal) - 1;
                  if (F.lane == win) { rk = k; vv_ = -INFINITY; }
              } }
            const bool sel = gsel && rk < 8 && !dry;
            const float ssum = wave_sum((gsel && rk < 8) ? s : 0.f);
            selr[r] = sel; rkr[r] = rk; wr_[r] = s / ssum * 2.5f; lpr[r] = 0;
            if (sel) lpr[r] = (int)__hip_atomic_fetch_add((LAS unsigned*)(LC + F.lane), 1u, __ATOMIC_RELAXED, __HIP_MEMORY_SCOPE_WORKGROUP);
        }
        __syncthreads();
        if (F.tid < 64) { const unsigned n = LC[F.tid]; unsigned base = 0; if (n) base = atomicAdd(cnt + F.tid * 64, n); LC[64 + F.tid] = base; LC[F.tid] = 0u; }
        __syncthreads();
#pragma unroll
        for (int r = 0; r < 4; ++r)
            if (selr[r]) { const int tok = toks[r]; const int pos = (int)LC[64 + F.lane] + lpr[r];
                list[(size_t)F.lane * T + pos] = tok; toke[tok * 8 + rkr[r]] = F.lane; tokp[tok * 8 + rkr[r]] = pos; tokw[tok * 8 + rkr[r]] = wr_[r]; }
        __syncthreads();
    }
}

__device__ __forceinline__ void build_tables(const Frame& F, int l) {
    LAS int* tb = (LAS int*)(F.lds + LDS_CTL);
    __syncthreads();
    if (F.tid < 64) tb[LC_TCNT + F.tid] = (int)__hip_atomic_load((unsigned*)(F.ws + WS_CNT) + l * 4096 + F.tid * 64, __ATOMIC_RELAXED, __HIP_MEMORY_SCOPE_AGENT);
    __syncthreads();
    if (F.tid == 0) { int tbs = 0, sbs = 0;
        for (int e = 0; e < 64; ++e) { const int c = tb[LC_TCNT + e]; tb[LC_TBASE + e] = tbs; tb[LC_SBASE + e] = sbs; tbs += (c + 255) >> 8; sbs += c; }
        tb[LC_TBASE + 64] = tbs; tb[LC_SBASE + 64] = sbs; }
    __syncthreads();
}

__device__ __forceinline__ void phase_combine(const Frame& F, CArgsP a, int l, bool dry) {
    const float* mod = (const float*)(F.ws + WS_MOD) + l * 5 * 6144; float* xc = (float*)(F.ws + WS_XC); bf16_t* H = (bf16_t*)(F.ws + WS_H);
    const unsigned char* YS = (const unsigned char*)(F.ws + OV_YS); const LAS int* tb = (const LAS int*)(F.lds + LDS_CTL);
    const int* toke = (const int*)(F.ws + WS_TOKE); const int* tokp = (const int*)(F.ws + WS_TOKP); const float* tokw = (const float*)(F.ws + WS_TOKW);
    const int nrows = l == 0 ? T : NBATCH * SEQ;
    for (int rp = F.gw * 2; rp < nrows; rp += F.NGW * 2) {
        int tok[2], bsel[2]; float* xr[2]; f32x4 y[2][4], v[2][4]; int me, mp; float mw;
#pragma unroll
        for (int q = 0; q < 2; ++q) { const int ridx = rp + q; tok[q] = l == 0 ? ridx : (ridx >> 12) * TPB + CTX + (ridx & 4095);
            const int b = tok[q] / TPB; bsel[q] = (tok[q] - b * TPB) < CTX ? 4 : b; xr[q] = resid_row(F.out, xc, tok[q]); }
        { const int q = (F.lane >> 3) & 1, k = F.lane & 7; me = toke[tok[q] * 8 + k]; mp = tokp[tok[q] * 8 + k]; mw = tokw[tok[q] * 8 + k]; }
#pragma unroll
        for (int q = 0; q < 2; ++q) { const bf16_t* sp = H + (size_t)tok[q] * DM;
#pragma unroll
            for (int j = 0; j < 4; ++j) { const u32x2 w = *(const u32x2*)(sp + 4 * F.lane + 256 * j); y[q][j] = (f32x4){bflo(w.x), bfhi(w.x), bflo(w.y), bfhi(w.y)}; }
            row_load_bf16(xr[q], F.lane, v[q]); }
#pragma unroll
        for (int q = 0; q < 2; ++q) { row_ln(v[q]); row_affine(v[q], a->in[26] + l * DM, false, a->in[27] + l * DM, F.lane); }
#pragma unroll
        for (int q = 0; q < 2; ++q)
#pragma unroll
            for (int k = 0; k < 8; ++k) { const int e = __shfl(me, q * 8 + k), p = __shfl(mp, q * 8 + k); const float wv = __shfl(mw, q * 8 + k) * 0.0625f;
                const unsigned char* yp = YS + (size_t)(tb[LC_SBASE + e] + p) * DM;
#pragma unroll
                for (int j = 0; j < 4; ++j) { const int w = (int)*(const unsigned*)(yp + 4 * F.lane + 256 * j);
                    y[q][j][0] += wv * __builtin_amdgcn_cvt_f32_fp8(w, 0); y[q][j][1] += wv * __builtin_amdgcn_cvt_f32_fp8(w, 1); y[q][j][2] += wv * __builtin_amdgcn_cvt_f32_fp8(w, 2); y[q][j][3] += wv * __builtin_amdgcn_cvt_f32_fp8(w, 3); } }
#pragma unroll
        for (int q = 0; q < 2; ++q) {
            const float* g2 = mod + bsel[q] * 6144 + 5120;
#pragma unroll
            for (int j = 0; j < 4; ++j) { const f32x4 gv = *(const f32x4*)(g2 + 4 * F.lane + 256 * j); v[q][j] = v[q][j] * DN_ALPHA + gv * y[q][j]; }
            row_ln(v[q]); row_affine(v[q], a->in[36] + l * DM, false, a->in[37] + l * DM, F.lane);
            if (!dry) { if (l == 0) row_store_bf16((bf16_t*)xr[q], F.lane, v[q]); else row_store(xr[q], F.lane, v[q]); } else asm volatile("" :: "v"(v[q][0]), "v"(v[q][1]), "v"(v[q][2]), "v"(v[q][3]));
            if (l == 0 && !dry) { row_ln(v[q]); const float* mrow = mod + 5 * 6144 + bsel[q] * 6144; row_affine(v[q], mrow + 1024, true, mrow, F.lane); row_store_bf16(H + (size_t)tok[q] * DM, F.lane, v[q]); }
        }
    }
}

constexpr int NPHASE = 22;
__global__ void __launch_bounds__(NTHR, 2) mk_fwd(Args args) {
    extern __shared__ __attribute__((aligned(16))) unsigned char lds_raw[];
    Frame F; F.lds = (LAS unsigned char*)lds_raw; F.tid = threadIdx.x; F.lane = F.tid & 63; F.wave = __builtin_amdgcn_readfirstlane(F.tid >> 6);
    F.G = gridDim.x; F.bid = blockIdx.x; F.gw = F.bid * NWAVES + F.wave; F.NGW = F.G * NWAVES; F.ws = args.ws; F.out = args.out; F.vcu = (F.G % 8 == 0) ? (F.bid % 8) * (F.G / 8) + F.bid / 8 : F.bid;
    for (int u = F.tid; u < (LDS_BYTES - LDS_CTL) / 4; u += NTHR) ((LAS unsigned*)(F.lds + LDS_CTL))[u] = 0u;
    __syncthreads();
    const int lo = args.ph_lo, hi = args.ph_hi;
    CArgsP A4 = (CArgsP)__builtin_amdgcn_kernarg_segment_ptr();
    XcdBarrier bar; bar.bar = (unsigned*)(F.ws + CW_BAR_BYTE); bar.x = 0; bar.st = nullptr;
    if (hi - lo > 1) bar = xcd_barrier_post((unsigned*)(F.ws + CW_BAR_BYTE), (volatile LAS unsigned*)(F.lds + LDS_CTL) + LC_BAR);
#ifndef PHMASK
#define PHMASK 0xfff
#endif
#define PH_EN(k) ((PHMASK >> ((k) < 2 ? (k) : 2 + (((k) - 2) % 10))) & 1)
#define IN(k) (PH_EN(k) && lo <= (k) && (k) < hi)
#define SEAM(k) do { if (IN(k) && IN((k) + 1)) { for (int dd = 0; dd < NDUP(14); ++dd) xcd_barrier(bar); } if (TSMASK != 0 && blockIdx.x == 0 && threadIdx.x == 0) { ((volatile LAS unsigned long long*)(F.lds + LDS_CTL + 2048))[(k) + 1] = __builtin_amdgcn_s_memrealtime(); } FRESH(); } while (0)
#define FRESH() do { int t_ = threadIdx.x, b_ = blockIdx.x; CArgsP p_ = (CArgsP)__builtin_amdgcn_kernarg_segment_ptr(); asm volatile("" : "+v"(t_)); asm volatile("" : "+s"(b_), "+s"(p_)); A4 = p_; unsigned char* w_ = p_->ws; float* o_ = p_->out; \
    F.tid = t_; F.lane = t_ & 63; F.wave = __builtin_amdgcn_readfirstlane(t_ >> 6); F.bid = b_; F.gw = b_ * NWAVES + F.wave; F.ws = w_; F.out = o_; F.vcu = (F.G % 8 == 0) ? (b_ % 8) * (F.G / 8) + b_ / 8 : b_; } while (0)
    if (TSMASK != 0 && blockIdx.x == 0 && threadIdx.x == 0) ((volatile LAS unsigned long long*)(F.lds + LDS_CTL + 2048))[0] = __builtin_amdgcn_s_memrealtime();
    if (IN(0)) { for (int dd = 0; dd < NDUP(0); ++dd) phase_prologue(F, A4); } SEAM(0);
    if (IN(1)) { for (int dd = 0; dd < NDUP(1); ++dd) phase_rows0(F, A4); } SEAM(1);
#pragma unroll 1
    for (int l = 0; l < 2; ++l) {
        const int pb = 2 + 10 * l; const bool lat = (l == 1);
        if (IN(pb + 0)) {
            SchedPlain S{(const char*)(F.ws + WS_H), (const char*)(F.ws + WS_WIN) + (size_t)l * INC * 1024 * 2, 1024, 68, 26, F.G, F.bid, false};
            EpiInproj E{F.ws, A4->in[7] + l * INC, (const float*)(F.ws + WS_ROPE)};
            for (int dd = 0; dd < NDUP(2); ++dd) pg8::gemm_phase(F.lds, 1024, S, E);
        } SEAM(pb + 0);
        if (IN(pb + 1)) {
            for (int dd = 0; dd < NDUP(3); ++dd) lru_phase(F, A4, l, 0, false);
            for (int dd = 0; dd < NDUP(4); ++dd) sg_phase(F, A4, l, lat);
        } SEAM(pb + 1);
        if (IN(pb + 2)) { for (int dd = 0; dd < NDUP(5); ++dd) phase_carry(F); } SEAM(pb + 2);
        if (IN(pb + 3)) { phase_attn(F, A4, l); } SEAM(pb + 3);
        if (IN(pb + 4)) {
            for (int dd = 0; dd < NDUP(8); ++dd) {
                SchedMerge S{(const char*)(F.ws + OV_OA), (const char*)(F.ws + WS_WBR) + (size_t)(l * 3) * 1024 * 512 * 2, F.G, F.bid};
                EpiMerge E{(bf16_t*)(F.ws + OV_MG), (const bf16_t*)(F.ws + OV_G)};
                pg8::gemm_phase(F.lds, 512, S, E);
            }
            if (!lat) mini_merge_ctx(F, l);
        } SEAM(pb + 4);
        if (IN(pb + 5)) {
            SchedPlain S{(const char*)(F.ws + OV_MG), (const char*)(F.ws + WS_WOUT) + (size_t)l * 1048576 * 2, 1024, 64, 4, F.G, F.bid, true};
            EpiWout E{F.out, (float*)(F.ws + WS_XC), (const float*)(F.ws + WS_MOD) + l * 5 * 6144, false};
            pg8::gemm_phase(F.lds, 1024, S, E);
            if (NDUP(11) > 1) { EpiWout E2{F.out, (float*)(F.ws + WS_XC), (const float*)(F.ws + WS_MOD) + l * 5 * 6144, true}; pg8::gemm_phase(F.lds, 1024, S, E2); }
            if (!lat) mini_wout_ctx(F, l);
        } SEAM(pb + 5);
        if (IN(pb + 6)) { phase_router(F, A4, l, false); if (NDUP(12) > 1) phase_router(F, A4, l, F.G != 12345); } SEAM(pb + 6);
        if (IN(pb + 7)) {
            build_tables(F, l);
            SchedMoe S{(const char*)(F.ws + WS_H), (const char*)(F.ws + WS_H), (const char*)(F.ws + WS_WM1), (const char*)(F.ws + WS_WSH1) + (size_t)l * 524288 * 2,
                       (const int*)(F.ws + WS_LIST), (const LAS int*)(F.lds + LDS_CTL), 1024, 2, F.G, F.vcu, lat ? 64 : 68, lat, true, (size_t)524288 * 2};
            EpiMoe1 E{(bf16_t*)(F.ws + OV_ACT), (bf16_t*)(F.ws + OV_ACTSH)};
            for (int dd = 0; dd < NDUP(9); ++dd) pg8::gemm_phase(F.lds, 1024, S, E);
        } SEAM(pb + 7);
        if (IN(pb + 8)) {
            build_tables(F, l);
            SchedMoe S{(const char*)(F.ws + OV_ACT), (const char*)(F.ws + OV_ACTSH), (const char*)(F.ws + WS_WM2), (const char*)(F.ws + WS_WSH2) + (size_t)l * 262144 * 2,
                       (const int*)(F.ws + WS_LIST), (const LAS int*)(F.lds + LDS_CTL), 256, 4, F.G, F.vcu, lat ? 64 : 68, lat, false, (size_t)262144 * 2};
            EpiMoe2 E{(unsigned char*)(F.ws + OV_YS), (bf16_t*)(F.ws + WS_H)};
            for (int dd = 0; dd < NDUP(10); ++dd) pg8::gemm_phase(F.lds, 256, S, E);
        } SEAM(pb + 8);
        if (IN(pb + 9)) {
            build_tables(F, l);
            phase_combine(F, A4, l, false);
            if (NDUP(13) > 1) phase_combine(F, A4, l, F.G != 12345);
            if (l == 0) for (int dd = 0; dd < NDUP(15); ++dd) conv_moe_layer(F, A4, 1);
        } SEAM(pb + 9);
    }
    if (TSMASK != 0 && hi - lo == NPHASE) { __syncthreads(); asm volatile("s_waitcnt vmcnt(0)" ::: "memory");
        if (blockIdx.x == 0 && threadIdx.x == 0) { volatile LAS unsigned long long* ts = (volatile LAS unsigned long long*)(F.lds + LDS_CTL + 2048);
            unsigned long long sel = 0; for (int k = 0; k < NPHASE; ++k) if ((TSMASK >> k) & 1) sel += ts[k + 1] - ts[k];
            const float frac = (float)sel / (float)(ts[NPHASE] - ts[0]); args.out[0] += 1.0f + floorf(90.0f * frac + 0.5f); } }
#undef IN
#undef SEAM
}

extern "C" void kernel_launch(void* const* d_in, const int* in_sizes, int n_in, void* d_out, int out_size, void* d_ws, size_t ws_size, hipStream_t stream) {
    static int grid = 0;
    if (grid == 0) {
        if (n_in != 38 || out_size != NBATCH * SEQ * DM || ws_size < WS_END) { fprintf(stderr, "kernel_launch: unexpected shapes (n_in %d out %d ws %zu need %zu)\n", n_in, out_size, ws_size, (size_t)WS_END); grid = -1; return; }
        int dev = 0, cus = 0;
        if (hipGetDevice(&dev) != hipSuccess || hipDeviceGetAttribute(&cus, hipDeviceAttributeMultiprocessorCount, dev) != hipSuccess) { grid = -1; return; }
        if (hipFuncSetAttribute((const void*)mk_fwd, hipFuncAttributeMaxDynamicSharedMemorySize, LDS_BYTES) != hipSuccess) { fprintf(stderr, "kernel_launch: hipFuncSetAttribute failed\n"); grid = -1; return; }
        int per_cu = 0;
        if (hipOccupancyMaxActiveBlocksPerMultiprocessor(&per_cu, (const void*)mk_fwd, NTHR, LDS_BYTES) != hipSuccess || per_cu < 1) fprintf(stderr, "kernel_launch: occupancy query says %d\n", per_cu);
        (void)hipGetLastError();
        grid = cus;
    }
    if (grid < 0) return;
    (void)hipMemsetAsync((char*)d_ws + WS_CTL, 0, CTL_ZERO_BYTES, stream);
    Args a{};
    for (int i = 0; i < 38; ++i) a.in[i] = (const float*)d_in[i];
    a.out = (float*)d_out; a.ws = (unsigned char*)d_ws;
#if MK_MULTI
    for (int p = 0; p < NPHASE; ++p) { a.ph_lo = p; a.ph_hi = p + 1; hipLaunchKernelGGL(mk_fwd, dim3(grid), dim3(NTHR), LDS_BYTES, stream, a); }
#else
    a.ph_lo = 0; a.ph_hi = NPHASE; hipLaunchKernelGGL(mk_fwd, dim3(grid), dim3(NTHR), LDS_BYTES, stream, a);
#endif
}
```

```cpp
#include <hip/hip_runtime.h>
#include <cstdio>
#include <cstdint>
#include <cmath>

#ifndef MK_MULTI
#define MK_MULTI 0
#endif
#ifndef DUPMASK
#define DUPMASK 0
#endif
#define NDUP(c) (1 + ((DUPMASK >> (c)) & 1))
#ifndef TSMASK
#define TSMASK 0
#endif
#ifndef TS_A
#define TS_A -1
#define TS_B -1
#define TS_UNIT 1.0f
#endif
#define SUBTS(i) do { if (TSMASK != 0 && blockIdx.x == 0 && threadIdx.x == 0) ((volatile __attribute__((address_space(3))) unsigned long long*)(F.lds + LDS_CTL + 2048))[32 + (i)] = __builtin_amdgcn_s_memrealtime(); } while (0)
#ifndef NAIVE_GEMM
#define NAIVE_GEMM 0
#endif

#define LAS __attribute__((address_space(3)))
#define GAS __attribute__((address_space(1)))
typedef unsigned short bf16_t;
typedef short bf16x8 __attribute__((ext_vector_type(8)));
typedef short s16x4 __attribute__((ext_vector_type(4)));
typedef float f32x4 __attribute__((ext_vector_type(4)));
typedef float f32x16 __attribute__((ext_vector_type(16)));
typedef unsigned u32x4 __attribute__((ext_vector_type(4)));
typedef unsigned u32x2 __attribute__((ext_vector_type(2)));

constexpr int DM = 1024, NBATCH = 4, SEQ = 4096, CTX = 256, TPB = SEQ + CTX  , T = NBATCH * TPB  ;
constexpr int INC = 6656, NEXP = 64;
constexpr float DN_ALPHA = 1.41421356237309515f;
constexpr float LN_EPS = 1e-6f, RMS_EPS = 1e-5f;
constexpr int NWAVES = 8, NTHR = 512;

constexpr size_t MiB = 1u << 20;
constexpr size_t WS_CTL = 0, CTL_ZERO_BYTES = 1 * MiB;
constexpr size_t CW_BAR_BYTE = 16384;
constexpr size_t WS_CNT = 65536;
constexpr size_t WS_MOD = 131072;
constexpr size_t WS_ROPE = 1 * MiB;
constexpr size_t WS_LAM = 1 * MiB + 8192;
constexpr size_t WS_SUM = 1 * MiB + 65536;
constexpr size_t WS_HIN = WS_SUM + 2304 * 1024;
constexpr size_t WS_TOKE = 5 * MiB, WS_TOKP = 6 * MiB, WS_TOKW = 7 * MiB;
constexpr size_t WS_LIST = 8 * MiB;
constexpr size_t WS_XC = 13 * MiB;
constexpr size_t WS_WLRU = 17 * MiB;
constexpr size_t WS_WSG = 17 * MiB + 512 * 1024;
constexpr size_t WS_WRT = 17 * MiB + 768 * 1024;
constexpr size_t WS_WSH1 = 18 * MiB;
constexpr size_t WS_WSH2 = 20 * MiB;
constexpr size_t WS_WOUT = 21 * MiB;
constexpr size_t WS_WBR = 25 * MiB;
constexpr size_t WS_WIN = 31 * MiB;
constexpr size_t WS_WM1 = 57 * MiB;
constexpr size_t WS_WM2 = 121 * MiB;
constexpr size_t WS_H = 153 * MiB;
constexpr size_t WS_OV = 187 * MiB;
constexpr size_t OV_Q = WS_OV, OV_K = WS_OV + 17 * MiB, OV_V = WS_OV + 34 * MiB, OV_U = WS_OV + 51 * MiB, OV_S = WS_OV + 68 * MiB,
                 OV_X = WS_OV + 85 * MiB, OV_Y = WS_OV + 102 * MiB, OV_G = WS_OV + 119 * MiB, OV_OA = WS_OV + 221 * MiB,
                 OV_OB = WS_OV + 238 * MiB, OV_OC = WS_OV + 255 * MiB, OV_MG = WS_OV + 272 * MiB;
constexpr size_t OV_ACT = WS_OV, OV_ACTSH = WS_OV + 69 * MiB, OV_YS = WS_OV + 78 * MiB;
constexpr size_t WS_END = WS_OV + 350 * MiB;

constexpr int LDS_SCRATCH = 147456;
constexpr int LDS_CTL = LDS_SCRATCH;
constexpr int LDS_BYTES = LDS_SCRATCH + 4096;
constexpr int LC_BAR = 0;
constexpr int LC_TCNT = 64, LC_TBASE = 64 + 80, LC_SBASE = 64 + 160;

struct Args { const float* in[38]; float* out; unsigned char* ws; int ph_lo, ph_hi; };
typedef const Args __attribute__((address_space(4)))* CArgsP;

__device__ __forceinline__ unsigned f2bf(float f) { unsigned u = __builtin_bit_cast(unsigned, f); return (u + 0x7fffu + ((u >> 16) & 1u)) >> 16; }
typedef float f32x2 __attribute__((ext_vector_type(2))); typedef __bf16 bf16x2_t __attribute__((ext_vector_type(2)));
__device__ __forceinline__ unsigned pk2(float lo, float hi) { const f32x2 v = {lo, hi}; const bf16x2_t b = __builtin_convertvector(v, bf16x2_t); return __builtin_bit_cast(unsigned, b); }
__device__ __forceinline__ float bflo(unsigned w) { return __builtin_bit_cast(float, w << 16); }
__device__ __forceinline__ float bfhi(unsigned w) { return __builtin_bit_cast(float, w & 0xffff0000u); }
__device__ __forceinline__ float bf2f(bf16_t b) { return __builtin_bit_cast(float, (unsigned)b << 16); }
#define WS_DPP(v, ctrl, rmask, bc) __builtin_bit_cast(float, __builtin_amdgcn_update_dpp(0, __builtin_bit_cast(int, v), ctrl, rmask, 0xF, bc))
__device__ __forceinline__ float wave_sum(float v) {
    v += WS_DPP(v, 0xB1, 0xF, true); v += WS_DPP(v, 0x4E, 0xF, true); v += WS_DPP(v, 0x141, 0xF, true); v += WS_DPP(v, 0x140, 0xF, true);
    v += WS_DPP(v, 0x142, 0xA, false); v += WS_DPP(v, 0x143, 0xC, false);
    return __builtin_bit_cast(float, __builtin_amdgcn_readlane(__builtin_bit_cast(int, v), 63));
}
__device__ __forceinline__ float sigmoidf_(float x) { return __builtin_amdgcn_rcpf(1.f + __builtin_amdgcn_exp2f(-1.4426950408889634f * x)); }
__device__ __forceinline__ float gelu_tanh(float x) { const float u = x * (0.7978845608028654f + 0.035677408136300125f * x * x); return x * __builtin_amdgcn_rcpf(1.f + __builtin_amdgcn_exp2f(-2.885390081777927f * u)); }
__device__ __forceinline__ float silu_(float x) { return x * __builtin_amdgcn_rcpf(1.f + __builtin_amdgcn_exp2f(-1.4426950408889634f * x)); }
__device__ __forceinline__ float expm1_poly(float x) { return x * (1.0f + x * (0.5f + x * ((1.0f / 6.0f) + x * ((1.0f / 24.0f) + x * (1.0f / 120.0f))))); }
__device__ __forceinline__ float expm1_neg(float x) {
    const float p = x * (1.0f + x * (0.5f + x * ((1.0f / 6.0f) + x * ((1.0f / 24.0f) + x * (1.0f / 120.0f)))));
    const float e = __builtin_amdgcn_exp2f(1.4426950408889634f * x) - 1.0f;
    return x > -0.125f ? p : e;
}
#define LDS_WAIT() asm volatile("s_waitcnt lgkmcnt(0)" ::: "memory")
#define VM_WAIT() asm volatile("s_waitcnt vmcnt(0)" ::: "memory")

#define XB_TMO      128
#define XB_XCNT(j)  (256  + 64 * (j))
#define XB_XSUB(j)  (1280 + 64 * (j))
#define XB_XGEN(j)  (2304 + 64 * (j))
#define XB_TOP      3328
#define XB_TOPGEN   3392
#define XCD_BAR_WORDS 3456
#define XB_SPIN_CAP (1u << 22)
__device__ __forceinline__ unsigned xb_ld(unsigned* p)              { return __hip_atomic_load(p, __ATOMIC_RELAXED, __HIP_MEMORY_SCOPE_AGENT); }
__device__ __forceinline__ unsigned xb_add(unsigned* p, unsigned v) { return __hip_atomic_fetch_add(p, v, __ATOMIC_RELAXED, __HIP_MEMORY_SCOPE_AGENT); }
__device__ __forceinline__ unsigned xb_xcc_id() { return (unsigned)__builtin_amdgcn_s_getreg((3 << 11) | 20) & 0xFu; }
#define XB_SPIN(cond, bar) do { unsigned _sp = 0; while (cond) { __builtin_amdgcn_s_sleep(1); \
    if ((++_sp & 255u) == 0u) { if (xb_ld(&(bar)[XB_TMO])) break; if (_sp > XB_SPIN_CAP) { atomicAdd(&(bar)[XB_TMO], 1u); break; } } } } while (0)
struct XcdBarrier { unsigned* bar; unsigned x; volatile LAS unsigned* st; };
__device__ __forceinline__ XcdBarrier xcd_barrier_post(unsigned* bar, volatile LAS unsigned* st) {
    XcdBarrier b; b.bar = bar; b.x = xb_xcc_id(); b.st = st;
    if (threadIdx.x == 0) (void)xb_add(&bar[XB_XCNT(b.x)], 1u);
    return b;
}
__device__ __forceinline__ void xcd_barrier_complete(unsigned* bar, unsigned x, unsigned& nloc, unsigned& nx) {
    const unsigned G = gridDim.x * gridDim.y * gridDim.z;
    unsigned sum, cnt, mine, sp = 0u;
    for (;;) {
        sum = 0u; cnt = 0u; mine = 0u;
#pragma unroll
        for (unsigned j = 0; j < 16; ++j) { const unsigned c = xb_ld(&bar[XB_XCNT(j)]); sum += c; cnt += (c > 0u) ? 1u : 0u; mine = (j == x) ? c : mine; }
        if (sum == G) break;
        __builtin_amdgcn_s_sleep(1);
        if ((++sp & 255u) == 0u) { if (xb_ld(&bar[XB_TMO])) break; if (sp > XB_SPIN_CAP) { atomicAdd(&bar[XB_TMO], 1u); break; } }
    }
    nloc = mine > 0u ? mine : 1u; nx = cnt > 0u ? cnt : 1u;
}
__device__ __forceinline__ void xcd_barrier(const XcdBarrier& b) {
    asm volatile("s_waitcnt vmcnt(0)" ::: "memory");
    __syncthreads();
    if (threadIdx.x == 0) {
        unsigned* bar = b.bar; asm volatile("" : "+s"(bar));
        __builtin_amdgcn_s_waitcnt(0);
        unsigned nloc = b.st[0], nx = b.st[1];
        if (nloc == 0u) { xcd_barrier_complete(bar, b.x, nloc, nx); b.st[0] = nloc; b.st[1] = nx; }
        const unsigned old = xb_add(&bar[XB_XSUB(b.x)], 1u);
        const unsigned gen = old / nloc;
        if (old + 1u == (gen + 1u) * nloc) {
            __builtin_amdgcn_fence(__ATOMIC_RELEASE, "agent");
            asm volatile("s_waitcnt vmcnt(0)" ::: "memory");
            const unsigned og = xb_add(&bar[XB_TOP], 1u);
            const unsigned tg = og / nx;
            if (og + 1u == (tg + 1u) * nx) xb_add(&bar[XB_TOPGEN], 1u);
            else XB_SPIN(xb_ld(&bar[XB_TOPGEN]) == tg, bar);
            __builtin_amdgcn_fence(__ATOMIC_ACQUIRE, "agent");
            xb_add(&bar[XB_XGEN(b.x)], 1u);
            asm volatile("s_waitcnt vmcnt(0)" ::: "memory");
        } else {
            XB_SPIN(xb_ld(&bar[XB_XGEN(b.x)]) == gen, bar);
            __builtin_amdgcn_fence(__ATOMIC_ACQUIRE, "agent");
            asm volatile("s_waitcnt vmcnt(0)" ::: "memory");
        }
    }
    __syncthreads();
}

namespace pg8 {
constexpr int BM = 256, BK = 64, HALF = 128, HTB = HALF * BK * 2, STAGE_BYTES = 8 * HTB, NXCD = 8, WGM = 8;
__host__ __device__ __forceinline__ int lds_byte(int r, int c) { const int st = (r >> 4) * 2 + (c >> 5), rr = r & 15, cc = c & 31, ob = rr * 64 + cc * 2; return st * 1024 + (ob ^ (((ob >> 9) & 1) << 5)); }
__host__ __device__ __forceinline__ void stage_rc(int b, int& R, int& C) { const int st = b / 1024, sb = b % 1024, swz = sb ^ (((sb >> 9) & 1) << 5); R = (st >> 1) * 16 + swz / 64; C = (st & 1) * 32 + (swz % 64) / 2; }
__host__ __device__ __forceinline__ int perm32(int rho) { const int n = rho >> 4, i = rho & 15; return 8 * (i >> 2) + 4 * n + (i & 3); }
struct Unit { int pm, pn, e, ti, nrows, row0; };
typedef f32x4 Acc[2][2][4][2];

template <class Epi, class Sched>
__device__ __forceinline__ void gemm_phase(LAS unsigned char* lds, const int K, const Sched& S, const Epi& E) {
    constexpr bool HN = Epi::HALFN;
    int tid_ = threadIdx.x; asm volatile("" : "+v"(tid_));
    const int tid = tid_, wid = __builtin_amdgcn_readfirstlane(tid >> 6), lane = tid & 63, wr = wid >> 2, wc = wid & 3, fr = lane & 15, fq = lane >> 4;
    (void)fr; (void)fq; (void)wc;
    Unit cur, nxt; int ui = 0;
    if (!S.next(0, cur)) return;
    Acc acc;
#pragma unroll
    for (int a = 0; a < 2; ++a)
#pragma unroll
        for (int b = 0; b < 2; ++b)
#pragma unroll
            for (int m = 0; m < 4; ++m)
#pragma unroll
                for (int n = 0; n < 2; ++n) acc[a][b][m][n] = (f32x4){0.f, 0.f, 0.f, 0.f};
#if NAIVE_GEMM
    for (;;) {
        const char* Ab = S.a_base(); const char* Bb = S.b_ptr(cur);
#pragma unroll 1
        for (int ai = 0; ai < 2; ++ai)
#pragma unroll 1
            for (int m = 0; m < 4; ++m) {
                const int rr = ai * 128 + wr * 64 + m * 16 + fr;
                const bf16_t* ap = (const bf16_t*)(Ab + S.a_off(cur, rr));
#pragma unroll
                for (int bj = 0; bj < 2; ++bj)
#pragma unroll
                    for (int n = 0; n < 2; ++n)
#pragma unroll
                        for (int j = 0; j < 4; ++j) {
                            const int cc = (int)Epi::PERM == 2 ? wc * 64 + fq * 16 + bj * 8 + n * 4 + j : Epi::PERM ? bj * 128 + wc * 32 + fq * 8 + n * 4 + j : bj * 128 + wc * 32 + n * 16 + fq * 4 + j;
                            const bf16_t* bp = (const bf16_t*)(Bb + (size_t)cc * K * 2);
                            float s = 0.f;
                            for (int k = 0; k < K; k += 8) {
                                const u32x4 av = *(const u32x4*)(ap + k), bv = *(const u32x4*)(bp + k);
                                s += bflo(av.x) * bflo(bv.x) + bfhi(av.x) * bfhi(bv.x) + bflo(av.y) * bflo(bv.y) + bfhi(av.y) * bfhi(bv.y)
                                   + bflo(av.z) * bflo(bv.z) + bfhi(av.z) * bfhi(bv.z) + bflo(av.w) * bflo(bv.w) + bfhi(av.w) * bfhi(bv.w);
                            }
                            acc[ai][bj][m][n][j] = s;
                        }
            }
        E(acc, cur, wr, wc, fr, fq);
        ++ui;
        if (!S.next(ui, cur)) break;
    }
    return;
#else
    const int nt = K / BK;
    unsigned voffB[2];
    { int Rr[2], Cc[2];
#pragma unroll
      for (int i = 0; i < 2; ++i) { stage_rc(tid * 16 + i * 8192, Rr[i], Cc[i]); const int rho_ = Rr[i] & 31; const int Rb = (int)Epi::PERM == 2 ? 64 * (Rr[i] >> 5) + 16 * ((rho_ >> 2) & 3) + 4 * (rho_ >> 4) + (rho_ & 3) : Epi::PERM ? ((Rr[i] & ~31) + perm32(rho_)) : Rr[i]; voffB[i] = (unsigned)(Rb * K + Cc[i]) * 2u; } }
#define PG8_AOFFS(U, o00, o01, o10, o11) do { int t3_ = threadIdx.x; asm volatile("" : "+v"(t3_)); int R0_, C0_, R1_, C1_; stage_rc(t3_ * 16, R0_, C0_); stage_rc(t3_ * 16 + 8192, R1_, C1_); \
        o00 = S.a_off(U, R0_) + (unsigned)C0_ * 2u; o01 = S.a_off(U, R1_) + (unsigned)C1_ * 2u; o10 = S.a_off(U, HALF + R0_) + (unsigned)C0_ * 2u; o11 = S.a_off(U, HALF + R1_) + (unsigned)C1_ * 2u; } while (0)
    const size_t kstep = (size_t)(BK * 2);
    const size_t hstep = (int)Epi::PERM == 2 ? (size_t)8 * K * 2 : (size_t)HALF * K * 2;
    const unsigned ldsw = (unsigned)wid * 1024u;
    const int aoff = lds_byte(wr * 64 + fr, fq * 8), boff = lds_byte(wc * 32 + fr, fq * 8);
#define PG8_SA(b, h) (((b) * 2 + (h)) * HTB)
#define PG8_SB(b, h) ((4 + (b) * 2 + (h)) * HTB)
#define PG8_STAGE(bufoff, gbase, v0, v1) do { \
        __builtin_amdgcn_global_load_lds((const unsigned*)((const char*)(gbase) + (v0)), (LAS unsigned*)(lds + (bufoff) + ldsw), 16, 0, 0); \
        __builtin_amdgcn_global_load_lds((const unsigned*)((const char*)(gbase) + (v1)), (LAS unsigned*)(lds + (bufoff) + ldsw + 8192), 16, 0, 0); } while (0)
#define PG8_LDA(dst, b, h) do { _Pragma("unroll") for (int m = 0; m < 4; ++m) _Pragma("unroll") for (int k = 0; k < 2; ++k) dst[m][k] = *(const LAS bf16x8*)(lds + PG8_SA(b, h) + aoff + m * 2048 + k * 1024); } while (0)
#define PG8_LDB(dst, b, h) do { _Pragma("unroll") for (int n = 0; n < 2; ++n) _Pragma("unroll") for (int k = 0; k < 2; ++k) dst[n][k] = *(const LAS bf16x8*)(lds + PG8_SB(b, h) + boff + n * 2048 + k * 1024); } while (0)
#define PG8_MMA(ai, bj, At, Bt) do { __builtin_amdgcn_s_setprio(1); _Pragma("unroll") for (int m = 0; m < 4; ++m) _Pragma("unroll") for (int n = 0; n < 2; ++n) _Pragma("unroll") for (int k = 0; k < 2; ++k) \
        acc[ai][bj][m][n] = __builtin_amdgcn_mfma_f32_16x16x32_bf16(Bt[n][k], At[m][k], acc[ai][bj][m][n], 0, 0, 0); __builtin_amdgcn_s_setprio(0); } while (0)
#define PG8_WAIT_V(n) asm volatile("s_waitcnt vmcnt(" #n ")" ::: "memory")
#define PG8_WAIT_L(n) asm volatile("s_waitcnt lgkmcnt(" #n ")" ::: "memory")
#define PG8_WAIT_VX do { if (HN) PG8_WAIT_V(6); else PG8_WAIT_V(8); } while (0)
#define PG8_BAR __builtin_amdgcn_s_barrier()
#define PG8_SCHED __builtin_amdgcn_sched_barrier(0)
    bf16x8 At[4][2], B0[2][2], B1[2][2];
    const char* const Ab = S.a_base();
    unsigned vA00, vA01, vA10, vA11;
    PG8_AOFFS(cur, vA00, vA01, vA10, vA11);
    const char* cB = S.b_ptr(cur);
    PG8_STAGE(PG8_SB(0, 0), cB, voffB[0], voffB[1]); if (!HN) PG8_STAGE(PG8_SB(0, 1), cB + hstep, voffB[0], voffB[1]); PG8_STAGE(PG8_SA(0, 0), Ab, vA00, vA01); PG8_STAGE(PG8_SA(0, 1), Ab, vA10, vA11);
    if (wr == 1) PG8_BAR;
    PG8_WAIT_V(2); PG8_BAR;
    PG8_STAGE(PG8_SB(1, 0), cB + kstep, voffB[0], voffB[1]); PG8_STAGE(PG8_SA(1, 0), Ab + kstep, vA00, vA01); if (!HN) PG8_STAGE(PG8_SB(1, 1), cB + hstep + kstep, voffB[0], voffB[1]);
    if (HN) PG8_WAIT_V(4); else PG8_WAIT_V(6);
    PG8_BAR;
    for (;;) {
        const bool has_next = S.next(ui + 1, nxt);
        unsigned vN00 = vA00, vN01 = vA01, vN10 = vA10, vN11 = vA11; const char* nB = cB;
        if (has_next) { PG8_AOFFS(nxt, vN00, vN01, vN10, vN11); nB = S.b_ptr(nxt); }
        for (int t = 0; t < nt; t += 2) {
            const bool last = (t == nt - 2);
            const char* a1 = Ab + (size_t)(t + 1) * kstep;
            const char* a2 = last ? Ab : Ab + (size_t)(t + 2) * kstep; const char* b2 = last ? nB : cB + (size_t)(t + 2) * kstep;
            const char* a3 = a2 + kstep; const char* b3 = b2 + kstep;
            const unsigned w00 = last ? vN00 : vA00, w01 = last ? vN01 : vA01, w10 = last ? vN10 : vA10, w11 = last ? vN11 : vA11;
            PG8_LDB(B0, 0, 0); if (!HN) PG8_LDB(B1, 0, 1); PG8_SCHED; PG8_LDA(At, 0, 0); PG8_STAGE(PG8_SA(1, 1), a1, vA10, vA11);
            PG8_WAIT_VX; PG8_WAIT_L(0); PG8_BAR; PG8_MMA(0, 0, At, B0); if (!HN) PG8_MMA(0, 1, At, B1); PG8_BAR; PG8_SCHED;
            PG8_LDA(At, 0, 1); PG8_STAGE(PG8_SB(0, 0), b2, voffB[0], voffB[1]); if (!HN) PG8_STAGE(PG8_SB(0, 1), b2 + hstep, voffB[0], voffB[1]); PG8_STAGE(PG8_SA(0, 0), a2, w00, w01);
            PG8_WAIT_VX; PG8_WAIT_L(0); PG8_BAR; PG8_MMA(1, 0, At, B0); if (!HN) PG8_MMA(1, 1, At, B1); PG8_BAR; PG8_SCHED;
            PG8_LDB(B0, 1, 0); if (!HN) PG8_LDB(B1, 1, 1); PG8_SCHED; PG8_LDA(At, 1, 0); PG8_STAGE(PG8_SA(0, 1), a2, w10, w11);
            PG8_WAIT_VX; PG8_WAIT_L(0); PG8_BAR; PG8_MMA(0, 0, At, B0); if (!HN) PG8_MMA(0, 1, At, B1); PG8_BAR; PG8_SCHED;
            PG8_LDA(At, 1, 1); PG8_STAGE(PG8_SB(1, 0), b3, voffB[0], voffB[1]); if (!HN) PG8_STAGE(PG8_SB(1, 1), b3 + hstep, voffB[0], voffB[1]); PG8_STAGE(PG8_SA(1, 0), a3, w00, w01);
            PG8_WAIT_VX; PG8_WAIT_L(0); PG8_BAR; PG8_MMA(1, 0, At, B0); if (!HN) PG8_MMA(1, 1, At, B1); PG8_BAR; PG8_SCHED;
        }
        if (wr == 0) PG8_BAR;
        { int t2_ = threadIdx.x; asm volatile("" : "+v"(t2_)); const int l2_ = t2_ & 63; E(acc, cur, wr, wc, l2_ & 15, l2_ >> 4); }
        if (!has_next) break;
#pragma unroll
        for (int a = 0; a < 2; ++a)
#pragma unroll
            for (int b = 0; b < (HN ? 1 : 2); ++b)
#pragma unroll
                for (int m = 0; m < 4; ++m)
#pragma unroll
                    for (int n = 0; n < 2; ++n) acc[a][b][m][n] = (f32x4){0.f, 0.f, 0.f, 0.f};
        cur = nxt; vA00 = vN00; vA01 = vN01; vA10 = vN10; vA11 = vN11; cB = nB; ++ui;
        if (wr == 1) PG8_BAR;
    }
    PG8_WAIT_V(0);
    PG8_BAR;
#undef PG8_SA
#undef PG8_AOFFS
#undef PG8_SB
#undef PG8_STAGE
#undef PG8_LDA
#undef PG8_LDB
#undef PG8_MMA
#undef PG8_WAIT_V
#undef PG8_WAIT_VX
#undef PG8_WAIT_L
#undef PG8_BAR
#undef PG8_SCHED
#endif
}
}
using pg8::Unit;
using pg8::Acc;

__device__ __forceinline__ float* resid_row(float* out, float* xc, int tok) {
    const int b = tok / TPB, j = tok - b * TPB;
    return j < CTX ? xc + ((size_t)(b * CTX + j)) * DM : out + ((size_t)(b * SEQ + j - CTX)) * DM;
}
__device__ __forceinline__ int tile_to_pm(int i, bool latent_only) { return latent_only ? (i >> 4) * 17 + 1 + (i & 15) : i; }

__device__ __forceinline__ bool static_order(int i, int G, int c, int nM, int nN, int& pm, int& pn) {
    const int nwg = nM * nN; const long L = (long)i * G + c; if (L >= nwg) return false;
    int wgid = (int)L; { const int q = nwg / 8, r = nwg % 8, xcd = wgid % 8, off = wgid / 8; wgid = (xcd < r ? xcd * (q + 1) : r * (q + 1) + (xcd - r) * q) + off; }
    const int nig = 8 * nN, gid = wgid / nig, fm = gid * 8, gsz = (nM - fm) < 8 ? (nM - fm) : 8;
    pm = fm + ((wgid % nig) % gsz); pn = (wgid % nig) / gsz; return true;
}

struct SchedPlain {
    const char* A; const char* Bt; int K, nM, nN, G, c; bool lat;
    __device__ __forceinline__ bool next(int i, Unit& u) const {
        int pm, pn; if (!static_order(i, G, c, nM, nN, pm, pn)) return false;
        u.pm = tile_to_pm(pm, lat); u.pn = pn; u.e = 0; u.ti = 0; u.nrows = 256; u.row0 = u.pm * 256; return true;
    }
    __device__ __forceinline__ const char* a_base() const { return A; }
    __device__ __forceinline__ unsigned a_off(const Unit& u, int rr) const { return (unsigned)(u.row0 + rr) * (unsigned)(K * 2); }
    __device__ __forceinline__ const char* b_ptr(const Unit& u) const { return Bt + (size_t)u.pn * 256 * K * 2; }
};

struct SchedMerge {
    const char* A0; const char* Bt0; int G, c;
    __device__ __forceinline__ bool next(int i, Unit& u) const {
        const int ti = i / 3, r = i - 3 * ti; int pm, pn; if (!static_order(ti, G, c, 64, 4, pm, pn)) return false;
        u.pm = tile_to_pm(pm, true); u.pn = pn; u.e = r; u.ti = 0; u.nrows = 256; u.row0 = u.pm * 256; return true;
    }
    __device__ __forceinline__ const char* a_base() const { return A0; }
    __device__ __forceinline__ unsigned a_off(const Unit& u, int rr) const { return (unsigned)u.e * (unsigned)(17 * MiB) + (unsigned)(u.row0 + rr) * 1024u; }
    __device__ __forceinline__ const char* b_ptr(const Unit& u) const { return Bt0 + ((size_t)u.e * 1024 * 512 + (size_t)u.pn * 256 * 512) * 2; }
};

struct SchedMergeHN {
    const char* A0; const char* Bt0; int G, c;
    __device__ __forceinline__ bool next(int i, Unit& u) const {
        const int ti = i / 3, r = i - 3 * ti; int pm, pn; if (!static_order(ti, G, c, 64, 8, pm, pn)) return false;
        u.pm = tile_to_pm(pm, true); u.pn = pn; u.e = r; u.ti = 0; u.nrows = 256; u.row0 = u.pm * 256; return true;
    }
    __device__ __forceinline__ const char* a_base() const { return A0; }
    __device__ __forceinline__ unsigned a_off(const Unit& u, int rr) const { return (unsigned)u.e * (unsigned)(17 * MiB) + (unsigned)(u.row0 + rr) * 1024u; }
    __device__ __forceinline__ const char* b_ptr(const Unit& u) const { return Bt0 + ((size_t)u.e * 1024 * 512 + (size_t)u.pn * 128 * 512) * 2; }
};

struct SchedMoe {
    const char* A;
    const char* Ash;
    const char* Bt; const char* Btsh; const int* list;
    const LAS int* tb;
    int K, nN, G, c, nsh; bool lat, gather; size_t bstride;
    __device__ __forceinline__ bool next(int i, Unit& u) const {
        const int nrt = tb[LC_TBASE + 64], L = i * G + c, tot = (nrt + nsh) * nN;
        if (L >= tot) return false;
        const int rt = L / nN; u.pn = L - rt * nN;
        if (rt < nrt) {
            int e = 0;
#pragma unroll 1
            for (int s = 32; s > 0; s >>= 1) if (e + s < 64 && tb[LC_TBASE + e + s] <= rt) e += s;
            u.e = e; u.ti = rt - tb[LC_TBASE + e]; const int cnt = tb[LC_TCNT + e]; const int rem = cnt - u.ti * 256;
            u.nrows = rem < 256 ? rem : 256; u.row0 = tb[LC_SBASE + e] + u.ti * 256; u.pm = 0;
        } else { u.e = 64; u.ti = rt - nrt; u.pm = tile_to_pm(u.ti, lat); u.nrows = 256; u.row0 = u.pm * 256; }
        return true;
    }
    __device__ __forceinline__ const char* a_base() const { return A; }
    __device__ __forceinline__ unsigned a_off(const Unit& u, int rr) const {
        if (u.e == 64) return (unsigned)(Ash - A) + (unsigned)(u.row0 + rr) * (unsigned)(K * 2);
        if (gather) { const int r2 = rr < u.nrows ? rr : u.nrows - 1; const int tok = list[(size_t)u.e * T + u.ti * 256 + r2]; return (unsigned)tok * (unsigned)(K * 2); }
        return (unsigned)(u.row0 + rr) * (unsigned)(K * 2);
    }
    __device__ __forceinline__ const char* b_ptr(const Unit& u) const { return (u.e == 64 ? Btsh : Bt + (size_t)u.e * bstride) + (size_t)u.pn * 256 * K * 2; }
};

#define EPI_FOR_ROWS  _Pragma("unroll") for (int ai = 0; ai < 2; ++ai) _Pragma("unroll") for (int m = 0; m < 4; ++m)
#define EPI_FOR_COLS  _Pragma("unroll") for (int bj = 0; bj < 2; ++bj) _Pragma("unroll") for (int n = 0; n < 2; ++n)

struct EpiInproj {
    static constexpr bool HALFN = false;
    static constexpr bool PERM = true;
    unsigned char* ws; const float* bias; const float* rope;
    __device__ __forceinline__ void operator()(const Acc& acc, const Unit& u, int wr, int wc, int fr, int fq) const {
        const int pn = u.pn; const bool isg = pn >= 14; const int seg = pn >> 1;
        bf16_t* base = (bf16_t*)(ws + (isg ? OV_G : OV_Q + (size_t)seg * 17 * MiB));
        const int ld = isg ? 3072 : 512, coff = isg ? (pn - 14) * 256 : (pn & 1) * 256;
        const bool latent = (u.pm % 17) != 0; const bool dorope = seg < 2 && !isg && latent;
        const bool gact = !isg && (seg == 3 || seg == 4 || seg == 6);
        f32x4 bv[2][2];
        EPI_FOR_COLS bv[bj][n] = *(const f32x4*)(bias + pn * 256 + bj * 128 + wc * 32 + fq * 8 + n * 4);
        const float qs = (seg == 0 && !isg) ? 0.125f * 1.4426950408889634f : 1.0f;
        const bool upper = __builtin_amdgcn_mbcnt_hi(~0u, __builtin_amdgcn_mbcnt_lo(~0u, 0u)) >= 32u;
        EPI_FOR_ROWS {
            const int row = u.row0 + ai * 128 + wr * 64 + m * 16 + fr;
            bf16_t* rp = base + (size_t)row * ld + coff + wc * 32 + fq * 8;
            f32x4 v[2][2];
            EPI_FOR_COLS v[bj][n] = acc[ai][bj][m][n] + bv[bj][n];
            if (dorope) {
                const int pos = (row % TPB) - CTX; const int pa = (wc & 1) ? (pos & 63) : (pos >> 6);
                const float* tp = rope + (pa * 16 + (fq & 1) * 8) * 2;
                f32x4 t[4];
#pragma unroll
                for (int i = 0; i < 4; ++i) t[i] = *(const f32x4*)(tp + 4 * i);
#pragma unroll
                for (int bj = 0; bj < 2; ++bj)
#pragma unroll
                    for (int n = 0; n < 2; ++n)
#pragma unroll
                        for (int j = 0; j < 4; ++j) { const float own = v[bj][n][j];
                            const auto rr = __builtin_amdgcn_permlane32_swap(__float_as_uint(own), __float_as_uint(own), false, false);
                            const float oth = upper ? __uint_as_float(rr[0]) : __uint_as_float(rr[1]);
                            const int fi = 4 * n + j; const float cs = t[fi >> 1][(fi & 1) * 2], sn = t[fi >> 1][(fi & 1) * 2 + 1];
                            v[bj][n][j] = own * cs + (upper ? oth : -oth) * sn; }
            }
            if (isg) {
                unsigned char* gp = ws + OV_G + (size_t)row * 3072 + coff + wc * 32 + fq * 8;
#pragma unroll
                for (int bj = 0; bj < 2; ++bj) { unsigned q[8];
#pragma unroll
                    for (int n = 0; n < 2; ++n)
#pragma unroll
                        for (int j = 0; j < 4; ++j) q[4 * n + j] = (unsigned)(sigmoidf_(v[bj][n][j]) * 255.0f + 0.5f);
                    u32x2 w; w.x = q[0] | (q[1] << 8) | (q[2] << 16) | (q[3] << 24); w.y = q[4] | (q[5] << 8) | (q[6] << 16) | (q[7] << 24);
                    *(u32x2*)(gp + bj * 128) = w; }
                continue;
            }
            if (gact) {
#pragma unroll
                for (int bj = 0; bj < 2; ++bj)
#pragma unroll
                    for (int n = 0; n < 2; ++n)
#pragma unroll
                        for (int j = 0; j < 4; ++j) v[bj][n][j] = gelu_tanh(v[bj][n][j]);
            }
            if (seg == 0) {
#pragma unroll
                for (int bj = 0; bj < 2; ++bj) { v[bj][0] = v[bj][0] * qs; v[bj][1] = v[bj][1] * qs; }
            }
#pragma unroll
            for (int bj = 0; bj < 2; ++bj) { const f32x4 v0 = v[bj][0], v1 = v[bj][1];
                u32x4 w; w.x = pk2(v0[0], v0[1]); w.y = pk2(v0[2], v0[3]); w.z = pk2(v1[0], v1[1]); w.w = pk2(v1[2], v1[3]); *(u32x4*)(rp + bj * 128) = w; }
        }
    }
};

__device__ __forceinline__ float gq(unsigned w, int i) { return (float)((w >> (8 * i)) & 0xffu) * (1.0f / 255.0f); }
struct EpiMerge {
    static constexpr bool HALFN = false;
    static constexpr bool PERM = true;
    bf16_t* mg; const unsigned char* gate;
    __device__ __forceinline__ void operator()(const Acc& acc, const Unit& u, int wr, int wc, int fr, int fq) const {
        const int r = u.e;
#pragma unroll
        for (int ai = 0; ai < 2; ++ai) {
            const size_t rbase = (size_t)(u.row0 + ai * 128 + wr * 64 + fr); const int col = u.pn * 256 + wc * 32 + fq * 8;
            u32x2 g[4][2]; u32x4 o[4][2];
#pragma unroll
            for (int m = 0; m < 4; ++m)
#pragma unroll
                for (int bj = 0; bj < 2; ++bj) { g[m][bj] = *(const u32x2*)(gate + (rbase + m * 16) * 3072 + r * 1024 + col + bj * 128);
                    if (r > 0) o[m][bj] = *(const u32x4*)(mg + (rbase + m * 16) * DM + col + bj * 128); else o[m][bj] = (u32x4){0u, 0u, 0u, 0u}; }
#pragma unroll
            for (int m = 0; m < 4; ++m)
#pragma unroll
                for (int bj = 0; bj < 2; ++bj) { const u32x2 gg = g[m][bj]; const u32x4 oo = o[m][bj]; const f32x4 v0 = acc[ai][bj][m][0], v1 = acc[ai][bj][m][1];
                    u32x4 w; w.x = pk2(v0[0] * gq(gg.x, 0) + bflo(oo.x), v0[1] * gq(gg.x, 1) + bfhi(oo.x)); w.y = pk2(v0[2] * gq(gg.x, 2) + bflo(oo.y), v0[3] * gq(gg.x, 3) + bfhi(oo.y));
                    w.z = pk2(v1[0] * gq(gg.y, 0) + bflo(oo.z), v1[1] * gq(gg.y, 1) + bfhi(oo.z)); w.w = pk2(v1[2] * gq(gg.y, 2) + bflo(oo.w), v1[3] * gq(gg.y, 3) + bfhi(oo.w));
                    *(u32x4*)(mg + (rbase + m * 16) * DM + col + bj * 128) = w; }
        }
    }
};

struct EpiMergeHN {
    static constexpr bool HALFN = true;
    static constexpr bool PERM = true;
    bf16_t* mg; const unsigned char* gate;
    __device__ __forceinline__ void operator()(Acc& acc, const Unit& u, int wr, int wc, int fr, int fq) const {
        const int r = u.e;
#pragma unroll
        for (int ai = 0; ai < 2; ++ai) {
            const size_t rbase = (size_t)(u.row0 + ai * 128 + wr * 64 + fr); const int col = u.pn * 128 + wc * 32 + fq * 8;
            u32x2 g[4];
#pragma unroll
            for (int m = 0; m < 4; ++m) g[m] = *(const u32x2*)(gate + (rbase + m * 16) * 3072 + r * 1024 + col);
#pragma unroll
            for (int m = 0; m < 4; ++m) { const u32x2 gg = g[m];
                f32x4 t0 = acc[ai][1][m][0], t1 = acc[ai][1][m][1]; const f32x4 v0 = acc[ai][0][m][0], v1 = acc[ai][0][m][1];
                t0[0] += v0[0] * gq(gg.x, 0); t0[1] += v0[1] * gq(gg.x, 1); t0[2] += v0[2] * gq(gg.x, 2); t0[3] += v0[3] * gq(gg.x, 3);
                t1[0] += v1[0] * gq(gg.y, 0); t1[1] += v1[1] * gq(gg.y, 1); t1[2] += v1[2] * gq(gg.y, 2); t1[3] += v1[3] * gq(gg.y, 3);
                if (r == 2) { u32x4 w; w.x = pk2(t0[0], t0[1]); w.y = pk2(t0[2], t0[3]); w.z = pk2(t1[0], t1[1]); w.w = pk2(t1[2], t1[3]);
                    *(u32x4*)(mg + (rbase + m * 16) * DM + col) = w; t0 = (f32x4){0.f, 0.f, 0.f, 0.f}; t1 = t0; }
                acc[ai][1][m][0] = t0; acc[ai][1][m][1] = t1; }
        }
    }
};

struct EpiWout {
    static constexpr bool HALFN = false;
    static constexpr bool PERM = true;
    float* out; float* xc; const float* modl; bool dry;
    __device__ __forceinline__ void operator()(const Acc& acc, const Unit& u, int wr, int wc, int fr, int fq) const {
        const int b = u.pm / 17; const int bsel = (u.pm % 17) == 0 ? 4 : b;
        const float* g1 = modl + bsel * 6144 + 2048;
        f32x4 gv[2][2];
        EPI_FOR_COLS gv[bj][n] = *(const f32x4*)(g1 + u.pn * 256 + bj * 128 + wc * 32 + fq * 8 + n * 4);
#pragma unroll
        for (int ai = 0; ai < 2; ++ai) {
            bf16_t* rp[4]; u32x4 x[4][2];
#pragma unroll
            for (int m = 0; m < 4; ++m) { rp[m] = (bf16_t*)resid_row(out, xc, u.row0 + ai * 128 + wr * 64 + m * 16 + fr) + u.pn * 256 + wc * 32 + fq * 8;
#pragma unroll
                for (int bj = 0; bj < 2; ++bj) x[m][bj] = *(const u32x4*)(rp[m] + bj * 128); }
#pragma unroll
            for (int m = 0; m < 4; ++m)
#pragma unroll
                for (int bj = 0; bj < 2; ++bj) { const u32x4 xx = x[m][bj]; const f32x4 a0 = acc[ai][bj][m][0] * gv[bj][0], a1 = acc[ai][bj][m][1] * gv[bj][1];
                    u32x4 w; w.x = pk2(bflo(xx.x) * DN_ALPHA + a0[0], bfhi(xx.x) * DN_ALPHA + a0[1]); w.y = pk2(bflo(xx.y) * DN_ALPHA + a0[2], bfhi(xx.y) * DN_ALPHA + a0[3]);
                    w.z = pk2(bflo(xx.z) * DN_ALPHA + a1[0], bfhi(xx.z) * DN_ALPHA + a1[1]); w.w = pk2(bflo(xx.w) * DN_ALPHA + a1[2], bfhi(xx.w) * DN_ALPHA + a1[3]);
                    if (!dry) *(u32x4*)(rp[m] + bj * 128) = w; else asm volatile("" :: "v"(w)); }
        }
    }
};

struct EpiMoe1 {
    static constexpr bool HALFN = false;
    static constexpr bool PERM = true;
    bf16_t* act; bf16_t* actsh;
    __device__ __forceinline__ void operator()(const Acc& acc, const Unit& u, int wr, int wc, int fr, int fq) const {
        bf16_t* base = u.e == 64 ? actsh : act;
        EPI_FOR_ROWS {
            const int rl = ai * 128 + wr * 64 + m * 16 + fr;
            if (rl < u.nrows) {
                const f32x4 g0 = acc[ai][0][m][0], g1 = acc[ai][0][m][1], p0 = acc[ai][1][m][0], p1 = acc[ai][1][m][1];
                u32x4 w; w.x = pk2(silu_(g0[0]) * p0[0], silu_(g0[1]) * p0[1]); w.y = pk2(silu_(g0[2]) * p0[2], silu_(g0[3]) * p0[3]);
                w.z = pk2(silu_(g1[0]) * p1[0], silu_(g1[1]) * p1[1]); w.w = pk2(silu_(g1[2]) * p1[2], silu_(g1[3]) * p1[3]);
                *(u32x4*)(base + (size_t)(u.row0 + rl) * 256 + u.pn * 128 + wc * 32 + fq * 8) = w;
            }
        }
    }
};

struct EpiMoe2 {
    static constexpr bool HALFN = false;
    static constexpr int PERM = 2;
    unsigned char* ys; bf16_t* sho;
    __device__ __forceinline__ void operator()(const Acc& acc, const Unit& u, int wr, int wc, int fr, int fq) const {
        EPI_FOR_ROWS {
            const int rl = ai * 128 + wr * 64 + m * 16 + fr;
            if (rl < u.nrows) {
                if (u.e == 64) {
                    bf16_t* rp = sho + (size_t)(u.row0 + rl) * DM + u.pn * 256 + wc * 64 + fq * 16;
#pragma unroll
                    for (int bj = 0; bj < 2; ++bj) { const f32x4 v0 = acc[ai][bj][m][0], v1 = acc[ai][bj][m][1];
                        u32x4 w; w.x = pk2(v0[0], v0[1]); w.y = pk2(v0[2], v0[3]); w.z = pk2(v1[0], v1[1]); w.w = pk2(v1[2], v1[3]); *(u32x4*)(rp + bj * 8) = w; }
                } else {
                    unsigned char* rp = ys + (size_t)(u.row0 + rl) * DM + u.pn * 256 + wc * 64 + fq * 16;
                    int w[4];
#pragma unroll
                    for (int bj = 0; bj < 2; ++bj) { const f32x4 v0 = acc[ai][bj][m][0], v1 = acc[ai][bj][m][1];
                        int w0 = 0, w1 = 0;
                        w0 = __builtin_amdgcn_cvt_pk_fp8_f32(v0[0], v0[1], w0, false); w0 = __builtin_amdgcn_cvt_pk_fp8_f32(v0[2], v0[3], w0, true);
                        w1 = __builtin_amdgcn_cvt_pk_fp8_f32(v1[0], v1[1], w1, false); w1 = __builtin_amdgcn_cvt_pk_fp8_f32(v1[2], v1[3], w1, true);
                        w[2 * bj] = w0; w[2 * bj + 1] = w1; }
                    *(u32x4*)rp = (u32x4){(unsigned)w[0], (unsigned)w[1], (unsigned)w[2], (unsigned)w[3]};
                }
            }
        }
    }
};

struct Frame {
    LAS unsigned char* lds; int tid, lane, wave, G, bid, gw, NGW, vcu;
    unsigned char* ws; float* out;
};

struct TDesc { const float* src; bf16_t* dst; int ldw, ldt; float sc; };
__device__ __forceinline__ void t_load(const TDesc& d, int lane, f32x4 (&v)[16]) {
    const int lk = lane >> 4, n4 = (lane & 15) * 4;
#pragma unroll
    for (int i = 0; i < 16; ++i) v[i] = *(const f32x4*)(d.src + (size_t)(4 * i + lk) * d.ldw + n4);
}
__device__ __forceinline__ void t_store(const TDesc& d, int lane, const f32x4 (&v)[16], LAS float* scr) {
    const int lk = lane >> 4, n4 = (lane & 15) * 4;
#pragma unroll
    for (int i = 0; i < 16; ++i) { const int k = 4 * i + lk; *(LAS f32x4*)(scr + k * 64 + (n4 ^ (((k >> 3) & 7) << 2))) = v[i]; }
    LDS_WAIT(); asm volatile("" ::: "memory");
    const int c = lane & 7;
#pragma unroll
    for (int j = 0; j < 8; ++j) { const int n = (lane >> 3) + 8 * j; const LAS float* sp = scr + (8 * c) * 64 + (n ^ (c << 2));
        const float sc = d.sc; u32x4 o; o.x = pk2(sp[0 * 64] * sc, sp[1 * 64] * sc); o.y = pk2(sp[2 * 64] * sc, sp[3 * 64] * sc); o.z = pk2(sp[4 * 64] * sc, sp[5 * 64] * sc); o.w = pk2(sp[6 * 64] * sc, sp[7 * 64] * sc);
        *(u32x4*)(d.dst + (size_t)n * d.ldt + 8 * c) = o; }
    LDS_WAIT(); asm volatile("" ::: "memory");
}
__device__ __forceinline__ void t_store_half(const TDesc& d, int lane, const f32x4 (&v)[16], LAS float* scr) {
    const int lk = lane >> 4, n4 = (lane & 15) * 4, c = lane & 7;
#pragma unroll
    for (int p = 0; p < 2; ++p) {
        if ((n4 >> 5) == p) {
#pragma unroll
            for (int i = 0; i < 16; ++i) { const int k = 4 * i + lk; *(LAS f32x4*)(scr + k * 32 + ((n4 & 31) ^ (((k >> 3) & 3) << 3))) = v[i]; }
        }
        LDS_WAIT(); asm volatile("" ::: "memory");
#pragma unroll
        for (int j = 0; j < 4; ++j) { const int nn = (lane >> 3) + 8 * j; const LAS float* sp = scr + (8 * c) * 32 + (nn ^ ((c & 3) << 3));
            const float sc = d.sc; u32x4 o; o.x = pk2(sp[0] * sc, sp[32] * sc); o.y = pk2(sp[64] * sc, sp[96] * sc); o.z = pk2(sp[128] * sc, sp[160] * sc); o.w = pk2(sp[192] * sc, sp[224] * sc);
            *(u32x4*)(d.dst + (size_t)(32 * p + nn) * d.ldt + 8 * c) = o; }
        LDS_WAIT(); asm volatile("" ::: "memory");
    }
}
__device__ __forceinline__ TDesc t_expert(const float* wg, const float* wu, const float* wd, bf16_t* t1, bf16_t* t2, int which, int rr, float sc_down) {
    TDesc d; d.sc = which == 2 ? sc_down : 1.0f;
    if (which < 2) { const int kb = rr >> 2, nb = rr & 3, n0 = 64 * nb, drow0 = (n0 >> 7) * 256 + (n0 & 127) + which * 128;
        d.src = (which == 0 ? wg : wu) + (size_t)(64 * kb) * 256 + n0; d.ldw = 256; d.dst = t1 + (size_t)drow0 * 1024 + 64 * kb; d.ldt = 1024; }
    else { const int kb = rr >> 4, nb = rr & 15; d.src = wd + (size_t)(64 * kb) * 1024 + 64 * nb; d.ldw = 1024; d.dst = t2 + (size_t)(64 * nb) * 256 + 64 * kb; d.ldt = 256; }
    return d;
}
constexpr int TI_IN = 2 * 1664, TI_BR = 6 * 128, TI_OUT = 2 * 256, TI_SH = 6 * 64, TI_GEN = TI_IN + TI_BR + TI_OUT + TI_SH, TI_MOE = 64 * 3 * 64;
__device__ __forceinline__ TDesc t_decode_moe(CArgsP a, unsigned char* ws, int it, int l) {
    const int idx = it >> 6, e = idx / 3, which = idx - e * 3, rr = it & 63; const size_t eo = (size_t)(l * 64 + e) * 262144;
    return t_expert(a->in[30] + eo, a->in[31] + eo, a->in[32] + eo, (bf16_t*)(ws + WS_WM1) + (size_t)e * 524288, (bf16_t*)(ws + WS_WM2) + (size_t)e * 262144, which, rr, 16.0f);
}
__device__ __forceinline__ TDesc t_decode_all(CArgsP a, unsigned char* ws, int it) {
    TDesc d; d.sc = 1.0f;
    if (it < TI_IN) { const int l = it / 1664, r = it - l * 1664, kb = r / 104, nb = r - kb * 104;
        d.src = a->in[6] + (size_t)l * 1024 * INC + (size_t)(64 * kb) * INC + 64 * nb; d.ldw = INC; d.dst = (bf16_t*)(ws + WS_WIN) + (size_t)l * INC * 1024 + (size_t)(64 * nb) * 1024 + 64 * kb; d.ldt = 1024; return d; }
    it -= TI_IN;
    if (it < TI_BR) { const int idx = it >> 7, rr = it & 127, kb = rr >> 4, nb = rr & 15;
        d.src = a->in[24] + (size_t)idx * 512 * 1024 + (size_t)(64 * kb) * 1024 + 64 * nb; d.ldw = 1024; d.dst = (bf16_t*)(ws + WS_WBR) + (size_t)idx * 1024 * 512 + (size_t)(64 * nb) * 512 + 64 * kb; d.ldt = 512; return d; }
    it -= TI_BR;
    if (it < TI_OUT) { const int l = it >> 8, rr = it & 255, kb = rr >> 4, nb = rr & 15;
        d.src = a->in[25] + (size_t)l * 1048576 + (size_t)(64 * kb) * 1024 + 64 * nb; d.ldw = 1024; d.dst = (bf16_t*)(ws + WS_WOUT) + (size_t)l * 1048576 + (size_t)(64 * nb) * 1024 + 64 * kb; d.ldt = 1024; return d; }
    it -= TI_OUT;
    if (it < TI_SH) { const int idx = it >> 6, l = idx / 3, which = idx - l * 3, rr = it & 63; const size_t lo = (size_t)l * 262144;
        return t_expert(a->in[33] + lo, a->in[34] + lo, a->in[35] + lo, (bf16_t*)(ws + WS_WSH1) + (size_t)l * 524288, (bf16_t*)(ws + WS_WSH2) + (size_t)l * 262144, which, rr, 1.0f); }
    return t_decode_moe(a, ws, it - TI_SH, 0);
}
template <bool ALL>
__device__ __forceinline__ void t_run(const Frame& F, CArgsP a, int count, int moe_l) {
    LAS float* scr = (LAS float*)(F.lds + F.wave * 16384);
    int it = F.gw; if (it >= count) return;
    f32x4 va[16], vb[16];
    TDesc da = ALL ? t_decode_all(a, F.ws, it) : t_decode_moe(a, F.ws, it, moe_l), db = da;
    t_load(da, F.lane, va);
    for (;;) {
        const int n1 = it + F.NGW; const bool h1 = n1 < count;
        if (h1) { db = ALL ? t_decode_all(a, F.ws, n1) : t_decode_moe(a, F.ws, n1, moe_l); t_load(db, F.lane, vb); }
        t_store(da, F.lane, va, scr);
        if (!h1) break;
        const int n2 = n1 + F.NGW; const bool h2 = n2 < count;
        if (h2) { da = ALL ? t_decode_all(a, F.ws, n2) : t_decode_moe(a, F.ws, n2, moe_l); t_load(da, F.lane, va); }
        t_store(db, F.lane, vb, scr);
        if (!h2) break;
        it = n2;
    }
}
__device__ __forceinline__ void conv_moe_layer(const Frame& F, CArgsP a, int l) { t_run<false>(F, a, TI_MOE, l); }

__device__ __forceinline__ void phase_prologue(const Frame& F, CArgsP a) {
    t_run<true>(F, a, TI_GEN + TI_MOE, 0);
    SUBTS(0);
    SUBTS(1);
    { const int gt = F.bid * NTHR + F.tid, NG = F.G * NTHR;
      bf16_t* wl = (bf16_t*)(F.ws + WS_WLRU);
      for (int i = gt; i < 2 * 2 * 2 * 8 * 4096; i += NG) {
          const int ii = i & 63, j = (i >> 6) & 63, cb = (i >> 12) & 7, ax = (i >> 15) & 1, d = (i >> 16) & 1, l = i >> 17;
          const float* src = ax == 0 ? a->in[19] : a->in[21];
          wl[i] = (bf16_t)f2bf(src[(size_t)((l * 2 + d) * 8 + cb) * 4096 + ii * 64 + j]); }
      bf16_t* wrt = (bf16_t*)(F.ws + WS_WRT);
      for (int i = gt; i < 2 * 64 * 1024; i += NG) { const int k = i & 1023, e = (i >> 10) & 63, l = i >> 16; wrt[i] = (bf16_t)f2bf(a->in[28][(size_t)(l * 1024 + k) * 64 + e]); }
      bf16_t* wsg = (bf16_t*)(F.ws + WS_WSG);
      for (int i = gt; i < 2 * 4 * 128 * 128; i += NG) wsg[i] = (bf16_t)f2bf(a->in[15][i]);
      if (F.bid == 0) { float* rope = (float*)(F.ws + WS_ROPE);
          for (int t = F.tid; t < 1024; t += NTHR) { const int p = t >> 4, f = t & 15; const float inv = powf(10000.0f, -(float)f / 16.0f); const float ang = (float)p * inv; rope[2 * t] = cosf(ang); rope[2 * t + 1] = sinf(ang); } }
      if (F.bid == (1 % F.G) && F.wave == 0) { float* lam = (float*)(F.ws + WS_LAM);
#pragma unroll
          for (int l = 0; l < 2; ++l) { const float s1 = wave_sum(a->in[8][l * 64 + F.lane] * a->in[9][l * 64 + F.lane]), s2 = wave_sum(a->in[10][l * 64 + F.lane] * a->in[11][l * 64 + F.lane]);
              const float li = 0.8f - 0.6f * expf(-0.3f * (float)l); if (F.lane == 0) lam[l] = expf(s1) - expf(s2) + li; } }
    }
    SUBTS(2);
    __syncthreads();
    LAS float* sl = (LAS float*)(F.lds);
    for (int i = F.tid; i < 5 * 1024; i += NTHR) { const int b = i >> 10, k = i & 1023; const float cv = b < 4 ? a->in[1][b * 1024 + k] : a->in[3][k]; sl[k * 8 + b] = silu_(cv); }
    __syncthreads();
    float* mod = (float*)(F.ws + WS_MOD);
    LAS float* part = (LAS float*)(F.lds + 32768);
    for (int c = F.bid; c < 192; c += F.G) {
        const int l = c / 96, cg = c - l * 96, c4 = (F.tid & 15) * 4, ks = F.tid >> 4;
        const float* w = a->in[4] + ((size_t)l * 1024 + ks * 32) * 6144 + cg * 64 + c4;
        f32x4 wv[32];
#pragma unroll
        for (int k = 0; k < 32; ++k) wv[k] = *(const f32x4*)(w + (size_t)k * 6144);
        f32x4 acc[5];
#pragma unroll
        for (int b = 0; b < 5; ++b) acc[b] = (f32x4){0.f, 0.f, 0.f, 0.f};
#pragma unroll
        for (int k = 0; k < 32; ++k) { const LAS float* sp = sl + (ks * 32 + k) * 8; const f32x4 s4 = *(const LAS f32x4*)sp; const float s5 = sp[4];
            acc[0] += wv[k] * s4[0]; acc[1] += wv[k] * s4[1]; acc[2] += wv[k] * s4[2]; acc[3] += wv[k] * s4[3]; acc[4] += wv[k] * s5; }
#pragma unroll
        for (int b = 0; b < 5; ++b) *(LAS f32x4*)(part + (ks * 5 + b) * 64 + c4) = acc[b];
        __syncthreads();
        if (F.tid < 320) { const int b = F.tid >> 6, col = F.tid & 63; float s = a->in[5][l * 6144 + cg * 64 + col];
#pragma unroll
            for (int k32 = 0; k32 < 32; ++k32) s += part[(k32 * 5 + b) * 64 + col];
            mod[(l * 5 + b) * 6144 + cg * 64 + col] = s; }
        __syncthreads();
    }
    SUBTS(3);
}

__device__ __forceinline__ void row_load(const float* p, int lane, f32x4 (&v)[4]) {
#pragma unroll
    for (int j = 0; j < 4; ++j) v[j] = *(const f32x4*)(p + 4 * lane + 256 * j);
}
__device__ __forceinline__ void row_load_bf16(const float* p, int lane, f32x4 (&v)[4]) {
#pragma unroll
    for (int j = 0; j < 4; ++j) { const u32x2 w = *(const u32x2*)((const bf16_t*)p + 4 * lane + 256 * j); v[j] = (f32x4){bflo(w.x), bfhi(w.x), bflo(w.y), bfhi(w.y)}; }
}
__device__ __forceinline__ void row_store(float* p, int lane, const f32x4 (&v)[4]) {
#pragma unroll
    for (int j = 0; j < 4; ++j) *(f32x4*)(p + 4 * lane + 256 * j) = v[j];
}
__device__ __forceinline__ void row_ln(f32x4 (&v)[4]) {
    float s = 0.f;
#pragma unroll
    for (int j = 0; j < 4; ++j) s += (v[j][0] + v[j][1]) + (v[j][2] + v[j][3]);
    const float mean = wave_sum(s) * (1.f / DM); float q = 0.f;
#pragma unroll
    for (int j = 0; j < 4; ++j) { v[j] = v[j] - mean; q += (v[j][0] * v[j][0] + v[j][1] * v[j][1]) + (v[j][2] * v[j][2] + v[j][3] * v[j][3]); }
    const float rstd = __builtin_amdgcn_rsqf(wave_sum(q) * (1.f / DM) + LN_EPS);
#pragma unroll
    for (int j = 0; j < 4; ++j) v[j] = v[j] * rstd;
}
__device__ __forceinline__ void row_affine(f32x4 (&v)[4], const float* scale1p  , bool plus1, const float* shift, int lane) {
#pragma unroll
    for (int j = 0; j < 4; ++j) { const f32x4 sc = *(const f32x4*)(scale1p + 4 * lane + 256 * j), sh = *(const f32x4*)(shift + 4 * lane + 256 * j);
        v[j] = plus1 ? v[j] * (sc + 1.0f) + sh : v[j] * sc + sh; }
}
__device__ __forceinline__ void row_affine_lds(f32x4 (&v)[4], const LAS float* sc, bool plus1, const LAS float* sh, int lane) {
#pragma unroll
    for (int j = 0; j < 4; ++j) { const f32x4 s = *(const LAS f32x4*)(sc + 4 * lane + 256 * j), h = *(const LAS f32x4*)(sh + 4 * lane + 256 * j);
        v[j] = plus1 ? v[j] * (s + 1.0f) + h : v[j] * s + h; }
}
__device__ __forceinline__ void row_store_bf16(bf16_t* p, int lane, const f32x4 (&v)[4]) {
#pragma unroll
    for (int j = 0; j < 4; ++j) { u32x2 w; w.x = pk2(v[j][0], v[j][1]); w.y = pk2(v[j][2], v[j][3]); *(u32x2*)(p + 4 * lane + 256 * j) = w; }
}

__device__ __forceinline__ void phase_rows0(const Frame& F, CArgsP a) {
    const float* mod = (const float*)(F.ws + WS_MOD); float* xc = (float*)(F.ws + WS_XC); bf16_t* H = (bf16_t*)(F.ws + WS_H);
    for (int tok = F.gw; tok < T; tok += F.NGW) {
        const int b = tok / TPB, j = tok - b * TPB; const bool isc = j < CTX;
        const float* src = isc ? a->in[2] + (size_t)(b * CTX + j) * DM : a->in[0] + (size_t)(b * SEQ + j - CTX) * DM;
        f32x4 v[4]; row_load(src, F.lane, v);
        row_store_bf16((bf16_t*)resid_row(F.out, xc, tok), F.lane, v);
        row_ln(v);
        const float* mrow = mod + (isc ? 4 : b) * 6144;
        row_affine(v, mrow + 1024, true, mrow, F.lane);
        row_store_bf16(H + (size_t)tok * DM, F.lane, v);
    }
}

__device__ __forceinline__ void sg_item(const Frame& F, CArgsP a, int l, int chunk, int g) {
    LAS bf16_t* vgT = (LAS bf16_t*)F.lds;
    const bf16_t* Sb = (const bf16_t*)(F.ws + OV_S); const bf16_t* Ub = (const bf16_t*)(F.ws + OV_U); bf16_t* OB = (bf16_t*)(F.ws + OV_OB);
    const int tok0 = chunk * 128;
    { const int q = F.tid >> 2, qt = F.tid & 3;
      const bf16_t* sp = Sb + (size_t)(tok0 + q) * 512 + g * 128 + qt * 32;
      float x[32];
#pragma unroll
      for (int i = 0; i < 4; ++i) { const u32x4 w = *(const u32x4*)(sp + 8 * i);
          x[8 * i + 0] = bflo(w.x); x[8 * i + 1] = bfhi(w.x); x[8 * i + 2] = bflo(w.y); x[8 * i + 3] = bfhi(w.y); x[8 * i + 4] = bflo(w.z); x[8 * i + 5] = bfhi(w.z); x[8 * i + 6] = bflo(w.w); x[8 * i + 7] = bfhi(w.w); }
      float s = 0.f;
#pragma unroll
      for (int i = 0; i < 32; ++i) s += x[i];
      s += __shfl_xor(s, 1); s += __shfl_xor(s, 2); const float mean = s * (1.f / 128.f); float qq = 0.f;
#pragma unroll
      for (int i = 0; i < 32; ++i) { x[i] -= mean; qq += x[i] * x[i]; }
      qq += __shfl_xor(qq, 1); qq += __shfl_xor(qq, 2); const float rstd = 1.f / sqrtf(qq * (1.f / 128.f) + LN_EPS);
      const float* lg = a->in[13] + l * 512 + g * 128 + qt * 32; const float* lb = a->in[14] + l * 512 + g * 128 + qt * 32;
#pragma unroll
      for (int i = 0; i < 32; ++i) vgT[(qt * 32 + i) * 136 + q] = (bf16_t)f2bf(x[i] * rstd * lg[i] + lb[i]);
    }
    __syncthreads();
    const int w = F.wave, fr = F.lane & 15, fq = F.lane >> 4;
    bf16x8 af[4];
#pragma unroll
    for (int ks = 0; ks < 4; ++ks) af[ks] = *(const LAS bf16x8*)(vgT + (w * 16 + fr) * 136 + ks * 32 + fq * 8);
    const bf16_t* W = (const bf16_t*)(F.ws + WS_WSG) + (size_t)(l * 4 + g) * 16384;
    const float* bs = a->in[16] + (l * 4 + g) * 128;
#pragma unroll 2
    for (int n = 0; n < 8; ++n) {
        f32x4 d = {0.f, 0.f, 0.f, 0.f};
#pragma unroll
        for (int ks = 0; ks < 4; ++ks) { const bf16x8 bfv = *(const bf16x8*)(W + (n * 16 + fr) * 128 + ks * 32 + fq * 8); d = __builtin_amdgcn_mfma_f32_16x16x32_bf16(af[ks], bfv, d, 0, 0, 0); }
        const int p = n * 16 + fr, c0 = w * 16 + fq * 4; const float bsp = bs[p];
        const size_t off = (size_t)(tok0 + p) * 512 + g * 128 + c0;
        const u32x2 uu = *(const u32x2*)(Ub + off);
        u32x2 o; o.x = pk2(bflo(uu.x) * (d[0] + bsp), bfhi(uu.x) * (d[1] + bsp)); o.y = pk2(bflo(uu.y) * (d[2] + bsp), bfhi(uu.y) * (d[3] + bsp));
        *(u32x2*)(OB + off) = o;
    }
    __syncthreads();
}

constexpr int SG_WOFF = 0, SG_VOFF = 34816;
__device__ __forceinline__ void sg_loads(const Frame& F, int chunk, int g, u32x4 (&sv)[4], u32x2 (&uu)[8]) {
    const bf16_t* Sb = (const bf16_t*)(F.ws + OV_S); const bf16_t* Ub = (const bf16_t*)(F.ws + OV_U);
    const int tok0 = chunk * 128, q = F.tid >> 2, qt = F.tid & 3;
    const bf16_t* sp = Sb + (size_t)(tok0 + q) * 512 + g * 128 + qt * 32;
#pragma unroll
    for (int i = 0; i < 4; ++i) sv[i] = *(const u32x4*)(sp + 8 * i);
    const int fr = F.lane & 15, fq = F.lane >> 4;
#pragma unroll
    for (int n = 0; n < 8; ++n) uu[n] = *(const u32x2*)(Ub + (size_t)(tok0 + n * 16 + fr) * 512 + g * 128 + F.wave * 16 + fq * 4);
}
__device__ __forceinline__ void sg_stage1(const Frame& F, CArgsP a, int l, int g, const u32x4 (&sv)[4], LAS bf16_t* vgT) {
    const int q = F.tid >> 2, qt = F.tid & 3;
    float x[32];
#pragma unroll
    for (int i = 0; i < 4; ++i) { const u32x4 w = sv[i];
        x[8 * i + 0] = bflo(w.x); x[8 * i + 1] = bfhi(w.x); x[8 * i + 2] = bflo(w.y); x[8 * i + 3] = bfhi(w.y); x[8 * i + 4] = bflo(w.z); x[8 * i + 5] = bfhi(w.z); x[8 * i + 6] = bflo(w.w); x[8 * i + 7] = bfhi(w.w); }
    float s = 0.f;
#pragma unroll
    for (int i = 0; i < 32; ++i) s += x[i];
    s += __shfl_xor(s, 1); s += __shfl_xor(s, 2); const float mean = s * (1.f / 128.f); float qq = 0.f;
#pragma unroll
    for (int i = 0; i < 32; ++i) { x[i] -= mean; qq += x[i] * x[i]; }
    qq += __shfl_xor(qq, 1); qq += __shfl_xor(qq, 2); const float rstd = __builtin_amdgcn_rsqf(qq * (1.f / 128.f) + LN_EPS);
    const float* lg = a->in[13] + l * 512 + g * 128 + qt * 32; const float* lb = a->in[14] + l * 512 + g * 128 + qt * 32;
    const int qs = q ^ (qt << 4);
#pragma unroll
    for (int i = 0; i < 32; ++i) vgT[(qt * 32 + i) * 136 + qs] = (bf16_t)f2bf(x[i] * rstd * lg[i] + lb[i]);
}
__device__ __forceinline__ void sg_stage2(const Frame& F, CArgsP a, int l, int chunk, int g, const u32x2 (&uu)[8], const LAS bf16_t* vgT, const LAS bf16_t* Wl) {
    bf16_t* OB = (bf16_t*)(F.ws + OV_OB);
    const int w = F.wave, fr = F.lane & 15, fq = F.lane >> 4, tok0 = chunk * 128;
    bf16x8 af[4];
#pragma unroll
    for (int ks = 0; ks < 4; ++ks) af[ks] = *(const LAS bf16x8*)(vgT + (w * 16 + fr) * 136 + ((ks * 32 + fq * 8) ^ ((w >> 1) << 4)));
    const float* bs = a->in[16] + (l * 4 + g) * 128;
#pragma unroll
    for (int n = 0; n < 8; ++n) {
        f32x4 d = {0.f, 0.f, 0.f, 0.f};
#pragma unroll
        for (int ks = 0; ks < 4; ++ks) { const bf16x8 bfv = *(const LAS bf16x8*)(Wl + (n * 16 + fr) * 136 + ks * 32 + fq * 8); d = __builtin_amdgcn_mfma_f32_16x16x32_bf16(af[ks], bfv, d, 0, 0, 0); }
        const int p = n * 16 + fr, c0 = w * 16 + fq * 4; const float bsp = bs[p];
        const u32x2 u2 = uu[n];
        u32x2 o; o.x = pk2(bflo(u2.x) * (d[0] + bsp), bfhi(u2.x) * (d[1] + bsp)); o.y = pk2(bflo(u2.y) * (d[2] + bsp), bfhi(u2.y) * (d[3] + bsp));
        *(u32x2*)(OB + (size_t)(tok0 + p) * 512 + g * 128 + c0) = o;
    }
}
__device__ __forceinline__ int sg_next(int& k, int bid, int G, bool lat) {
    const int nv = lat ? 512 : 544, nfull = (nv / G) * G, rem = nv - nfull, shift = (rem + ((G * 3 / 4) & ~3) <= G) ? ((G * 3 / 4) & ~3) : 0;
    int v = -1;
    if (k < nv / G) v = bid + k * G; else if (k == nv / G && bid >= shift && bid - shift < rem) v = nfull + bid - shift;
    ++k;
    if (v < 0) return -1;
    const int ci = v >> 2; return lat ? (ci >> 5) * 34 + 2 + (ci & 31) : ci;
}
__device__ __forceinline__ void sg_phase(const Frame& F, CArgsP a, int l, bool lat) {
    if (F.G % 4 != 0) { for (int it = F.bid; it < 136 * 4; it += F.G) { const int chunk = it >> 2; if (lat && (chunk % 34) < 2) continue; sg_item(F, a, l, chunk, it & 3); } return; }
    const int g = F.bid & 3; int it = 0;
    int c0 = sg_next(it, F.bid, F.G, lat); if (c0 < 0) return;
    LAS bf16_t* Wl = (LAS bf16_t*)(F.lds + SG_WOFF); LAS bf16_t* v0 = (LAS bf16_t*)(F.lds + SG_VOFF); LAS bf16_t* v1 = v0 + 128 * 136;
    u32x4 s0[4], s1[4]; u32x2 u0[8], u1[8];
    int c1 = sg_next(it, F.bid, F.G, lat);
    { const bf16_t* W = (const bf16_t*)(F.ws + WS_WSG) + (size_t)(l * 4 + g) * 16384; const int p = F.tid >> 2, part = F.tid & 3;
      u32x4 wv[4];
#pragma unroll
      for (int i = 0; i < 4; ++i) wv[i] = *(const u32x4*)(W + p * 128 + part * 32 + 8 * i);
      sg_loads(F, c0, g, s0, u0);
      if (c1 >= 0) sg_loads(F, c1, g, s1, u1);
#pragma unroll
      for (int i = 0; i < 4; ++i) *(LAS u32x4*)(Wl + p * 136 + part * 32 + 8 * i) = wv[i]; }
    for (;;) {
        sg_stage1(F, a, l, g, s0, v0);
        if (c1 >= 0) sg_stage1(F, a, l, g, s1, v1);
        __syncthreads();
        sg_stage2(F, a, l, c0, g, u0, v0, Wl);
        if (c1 >= 0) sg_stage2(F, a, l, c1, g, u1, v1, Wl);
        if (c1 < 0) break;
        c0 = sg_next(it, F.bid, F.G, lat); if (c0 < 0) break;
        c1 = sg_next(it, F.bid, F.G, lat);
        sg_loads(F, c0, g, s0, u0);
        if (c1 >= 0) sg_loads(F, c1, g, s1, u1);
        __syncthreads();
    }
    __syncthreads();
}

template <bool REV>
__device__ __forceinline__ void lru_scan(const f32x4 (&av)[4], const f32x4 (&bv)[4], f32x4 (&hv)[4], int lane, int mode, float hin, float& sumA, float& sumH) {
#define LRU_MI(k) (REV ? 3 - (k) : (k))
    const int fr = lane & 15, fq = lane >> 4, q = REV ? 3 - fq : fq;
    const int s1 = REV ? lane + 16 : lane - 16, s2 = REV ? lane + 32 : lane - 32, st = REV ? fr : 48 + fr;
    float Ea[4], Eh[4], Ta[4], Th[4];
#pragma unroll
    for (int m = 0; m < 4; ++m) {
        float A = 1.f, H = 0.f;
#pragma unroll
        for (int rk = 0; rk < 4; ++rk) { const int r = LRU_MI(rk); H = av[m][r] * H + bv[m][r]; A *= av[m][r]; }
        float pa = __shfl(A, s1), ph = __shfl(H, s1); if (q >= 1) { H = A * ph + H; A *= pa; }
        pa = __shfl(A, s2); ph = __shfl(H, s2); if (q >= 2) { H = A * ph + H; A *= pa; }
        float ea = __shfl(A, s1), eh = __shfl(H, s1); if (q == 0) { ea = 1.f; eh = 0.f; }
        Ea[m] = ea; Eh[m] = eh; Ta[m] = __shfl(A, st); Th[m] = __shfl(H, st);
    }
    if (mode == 0) {
        float A = 1.f, H = 0.f;
#pragma unroll
        for (int mk = 0; mk < 4; ++mk) { const int m = LRU_MI(mk); H = Ta[m] * H + Th[m]; A *= Ta[m]; }
        sumA = A; sumH = H;
    } else {
        float S = hin;
#pragma unroll
        for (int mk = 0; mk < 4; ++mk) { const int m = LRU_MI(mk); float h = Ea[m] * S + Eh[m];
#pragma unroll
            for (int rk = 0; rk < 4; ++rk) { const int r = LRU_MI(rk); h = av[m][r] * h + bv[m][r]; hv[m][r] = h; }
            S = Ta[m] * S + Th[m]; }
    }
#undef LRU_MI
}
struct LruConst { f32x4 cw[4][2]; f32x4 cbias[2]; bf16x8 wa0, wa1, wx0, wx1; float ba, bx, sp; };
struct LruIn { u32x4 x[4]; };
__device__ __forceinline__ void lru_load_const(const Frame& F, CArgsP a, int l, int cb, LruConst& c) {
    const int lane = F.lane, fr = lane & 15, fq = lane >> 4, d = F.wave >> 2, nt = F.wave & 3, ch0 = cb * 64, c8 = (F.tid & 7) * 8;
    const bf16_t* Wa = (const bf16_t*)(F.ws + WS_WLRU) + (size_t)((l * 4 + d * 2) * 8 + cb) * 4096 + (nt * 16 + fr) * 64 + fq * 8;
    c.wa0 = *(const bf16x8*)(Wa); c.wa1 = *(const bf16x8*)(Wa + 32); c.wx0 = *(const bf16x8*)(Wa + 8 * 4096); c.wx1 = *(const bf16x8*)(Wa + 8 * 4096 + 32);
    const int pidx = (l * 2 + d) * 512 + ch0 + nt * 16 + fr;
    c.ba = -1.4426950408889634f * a->in[20][pidx]; c.bx = -1.4426950408889634f * a->in[22][pidx]; { const float e = __expf(-a->in[23][pidx]);
      const float ser = e * (1.0f + e * (-0.5f + e * ((1.0f / 3.0f) + e * (-0.25f + e * (0.2f + e * (-1.0f / 6.0f))))));
      c.sp = -8.0f * (e < 0.0625f ? ser : __logf(1.0f + e)); }
#pragma unroll
    for (int jj = 0; jj < 4; ++jj) { c.cw[jj][0] = *(const f32x4*)(a->in[17] + l * 2048 + jj * 512 + ch0 + c8); c.cw[jj][1] = *(const f32x4*)(a->in[17] + l * 2048 + jj * 512 + ch0 + c8 + 4); }
    c.cbias[0] = *(const f32x4*)(a->in[18] + l * 512 + ch0 + c8); c.cbias[1] = *(const f32x4*)(a->in[18] + l * 512 + ch0 + c8 + 4);
}
constexpr size_t OV_AB = OV_MG;
__device__ __forceinline__ void lru_load_in(const Frame& F, int b, int chunk, int cb, LruIn& in) {
    const bf16_t* Xb = (const bf16_t*)(F.ws + OV_X);
    const int ch0 = cb * 64, ct = F.tid >> 3, c8 = (F.tid & 7) * 8;
    const int seg_lo = chunk < 4 ? 0 : 256, seg_hi = chunk < 4 ? 256 : TPB, j0 = chunk * 64;
#pragma unroll
    for (int jj = 0; jj < 4; ++jj) { const int j = j0 + ct + jj - 2; in.x[jj] = (u32x4){0u, 0u, 0u, 0u}; if (j >= seg_lo && j < seg_hi) in.x[jj] = *(const u32x4*)(Xb + (size_t)(b * TPB + j) * 512 + ch0 + c8); }
}
struct LruFin { u32x4 ab[4]; u32x4 y; float hin; };
__device__ __forceinline__ void lru_load_fin(const Frame& F, int it, LruFin& in, const LAS float* hl = nullptr) {
    const bf16_t* Yb = (const bf16_t*)(F.ws + OV_Y);
    const int cb = it & 7, b = (it >> 3) / 68, chunk = (it >> 3) % 68;
    const int ch0 = cb * 64, ct = F.tid >> 3, c8 = (F.tid & 7) * 8, d = F.wave >> 2, ch = (F.wave & 3) * 16 + (F.lane & 15), j0 = chunk * 64;
    const unsigned char* abp = F.ws + OV_AB + (size_t)it * 32768 + F.wave * 4096 + F.lane * 16;
#pragma unroll
    for (int m = 0; m < 4; ++m) in.ab[m] = *(const u32x4*)(abp + m * 1024);
    in.y = *(const u32x4*)(Yb + (size_t)(b * TPB + j0 + ct) * 512 + ch0 + c8);
    in.hin = hl ? hl[((chunk >> 3) * 2 + d) * 64 + ch] : ((const float*)(F.ws + WS_HIN))[(size_t)((b * 2 + d) * 68 + chunk) * 512 + ch0 + ch];
}
constexpr int LRU_BUF = 25600, LRU_HX0 = 2 * LRU_BUF;
__device__ __forceinline__ void lru_s1(const Frame& F, const LruConst& c, const u32x4 (&x)[4], LAS unsigned char* buf) {
    LAS float* xs = (LAS float*)buf; LAS bf16_t* xsb = (LAS bf16_t*)(buf + 16384);
    const int ct = F.tid >> 3, c8 = (F.tid & 7) * 8;
    f32x4 a0 = c.cbias[0], a1 = c.cbias[1];
#pragma unroll
    for (int jj = 0; jj < 4; ++jj) { const u32x4 w = x[jj];
        a0 += c.cw[jj][0] * (f32x4){bflo(w.x), bfhi(w.x), bflo(w.y), bfhi(w.y)}; a1 += c.cw[jj][1] * (f32x4){bflo(w.z), bfhi(w.z), bflo(w.w), bfhi(w.w)}; }
    *(LAS f32x4*)(xs + ct * 64 + c8) = a0; *(LAS f32x4*)(xs + ct * 64 + c8 + 4) = a1;
    u32x4 pw; pw.x = pk2(a0[0], a0[1]); pw.y = pk2(a0[2], a0[3]); pw.z = pk2(a1[0], a1[1]); pw.w = pk2(a1[2], a1[3]);
    *(LAS u32x4*)(xsb + ct * 72 + c8) = pw;
}
__device__ __forceinline__ void lru_s2(const Frame& F, const LruConst& c, const LAS unsigned char* buf, int it) {
    const LAS float* xs = (const LAS float*)buf; const LAS bf16_t* xsb = (const LAS bf16_t*)(buf + 16384);
    const int cb = it & 7, b = (it >> 3) / 68, chunk = (it >> 3) % 68, ch0 = cb * 64;
    const int lane = F.lane, fr = lane & 15, fq = lane >> 4, d = F.wave >> 2, nt = F.wave & 3, ch = nt * 16 + fr;
    unsigned char* abp = F.ws + OV_AB + (size_t)it * 32768 + F.wave * 4096 + lane * 16;
    const bool small = __all(c.sp > -0.125f);
    f32x4 av[4], bv[4], hv[4];
#pragma unroll
    for (int m = 0; m < 4; ++m) {
        const bf16x8 a0 = *(const LAS bf16x8*)(xsb + (m * 16 + fr) * 72 + fq * 8), a1 = *(const LAS bf16x8*)(xsb + (m * 16 + fr) * 72 + 32 + fq * 8);
        f32x4 da = {0.f, 0.f, 0.f, 0.f}, dx = {0.f, 0.f, 0.f, 0.f};
        da = __builtin_amdgcn_mfma_f32_16x16x32_bf16(a0, c.wa0, da, 0, 0, 0); da = __builtin_amdgcn_mfma_f32_16x16x32_bf16(a1, c.wa1, da, 0, 0, 0);
        dx = __builtin_amdgcn_mfma_f32_16x16x32_bf16(a0, c.wx0, dx, 0, 0, 0); dx = __builtin_amdgcn_mfma_f32_16x16x32_bf16(a1, c.wx1, dx, 0, 0, 0);
        float e1[4], bx[4];
#pragma unroll
        for (int r = 0; r < 4; ++r) {
            const float rg = __builtin_amdgcn_rcpf(1.f + __builtin_amdgcn_exp2f(__builtin_fmaf(da[r], -1.4426950408889634f, c.ba)));
            const float ig = __builtin_amdgcn_rcpf(1.f + __builtin_amdgcn_exp2f(__builtin_fmaf(dx[r], -1.4426950408889634f, c.bx)));
            const float la = rg * c.sp;
            e1[r] = small ? expm1_poly(la) : expm1_neg(la);
            bx[r] = __builtin_amdgcn_sqrtf(-e1[r] * (2.0f + e1[r])) * (ig * xs[(m * 16 + fq * 4 + r) * 64 + ch]); }
        u32x4 w; w.x = pk2(e1[0], e1[1]); w.y = pk2(e1[2], e1[3]); w.z = pk2(bx[0], bx[1]); w.w = pk2(bx[2], bx[3]);
        *(u32x4*)(abp + m * 1024) = w;
        av[m] = (f32x4){1.0f + e1[0], 1.0f + e1[1], 1.0f + e1[2], 1.0f + e1[3]}; bv[m] = (f32x4){bx[0], bx[1], bx[2], bx[3]}; hv[m] = (f32x4){0.f, 0.f, 0.f, 0.f};
    }
    float sumA = 1.f, sumH = 0.f;
    if (d == 0) lru_scan<false>(av, bv, hv, lane, 0, 0.f, sumA, sumH); else lru_scan<true>(av, bv, hv, lane, 0, 0.f, sumA, sumH);
    if (fq == 0) { float* sum = (float*)(F.ws + WS_SUM) + ((size_t)((b * 2 + d) * 68 + chunk) * 512 + ch0 + ch) * 2; *(float2*)sum = make_float2(sumA, sumH); }
}
__device__ __forceinline__ void lru_f2(const Frame& F, const LruFin& in, LAS float* hx) {
    const int lane = F.lane, fr = lane & 15, fq = lane >> 4, d = F.wave >> 2, nt = F.wave & 3, ch = nt * 16 + fr;
    f32x4 av[4], bv[4], hv[4];
#pragma unroll
    for (int m = 0; m < 4; ++m) { const u32x4 w = in.ab[m];
        av[m] = (f32x4){1.0f + bflo(w.x), 1.0f + bfhi(w.x), 1.0f + bflo(w.y), 1.0f + bfhi(w.y)}; bv[m] = (f32x4){bflo(w.z), bfhi(w.z), bflo(w.w), bfhi(w.w)}; hv[m] = (f32x4){0.f, 0.f, 0.f, 0.f}; }
    float sumA = 1.f, sumH = 0.f;
    if (d == 0) lru_scan<false>(av, bv, hv, lane, 1, in.hin, sumA, sumH); else lru_scan<true>(av, bv, hv, lane, 1, in.hin, sumA, sumH);
#pragma unroll
    for (int m = 0; m < 4; ++m)
#pragma unroll
        for (int r = 0; r < 4; ++r) hx[d * 4096 + (m * 16 + fq * 4 + r) * 64 + ch] = hv[m][r];
}
__device__ __forceinline__ void lru_s3(const Frame& F, const LAS float* hx, const u32x4& yv, int it) {
    bf16_t* OC = (bf16_t*)(F.ws + OV_OC);
    const int cb = it & 7, b = (it >> 3) / 68, chunk = (it >> 3) % 68;
    const int tok0 = b * TPB + chunk * 64, ch0 = cb * 64, ct = F.tid >> 3, c8 = (F.tid & 7) * 8;
    const f32x4 f0 = *(const LAS f32x4*)(hx + ct * 64 + c8), f1 = *(const LAS f32x4*)(hx + ct * 64 + c8 + 4), g0 = *(const LAS f32x4*)(hx + 4096 + ct * 64 + c8), g1 = *(const LAS f32x4*)(hx + 4096 + ct * 64 + c8 + 4);
    u32x4 o; o.x = pk2(bflo(yv.x) * (f0[0] + g0[0]), bfhi(yv.x) * (f0[1] + g0[1])); o.y = pk2(bflo(yv.y) * (f0[2] + g0[2]), bfhi(yv.y) * (f0[3] + g0[3]));
    o.z = pk2(bflo(yv.z) * (f1[0] + g1[0]), bfhi(yv.z) * (f1[1] + g1[1])); o.w = pk2(bflo(yv.w) * (f1[2] + g1[2]), bfhi(yv.w) * (f1[3] + g1[3]));
    *(u32x4*)(OC + (size_t)(tok0 + ct) * 512 + ch0 + c8) = o;
}
__device__ __forceinline__ int lru_next(int it, int G, bool skip_ctx) { it += G; while (it < 4 * 68 * 8 && skip_ctx && ((it >> 3) % 68) < 4) it += G; return it; }
__device__ __forceinline__ int lru0_item(int bid, int G, bool rebal, int j) {
    constexpr int NIT = 4 * 68 * 8;
    if (rebal) {
        if (bid >= 224) return j < 6 ? bid + j * 256 : NIT;
        if (bid >= 128 && bid < 192 && j == 8) return bid < 160 ? bid + 96 + 7 * 256 : bid + 64 + 6 * 256;
    }
    const long it = (long)bid + (long)j * G; return it < NIT ? (int)it : NIT;
}
template <bool PAIR>
__device__ __forceinline__ void lru_loop(const Frame& F, CArgsP a, int l) {
    constexpr int NIT = 4 * 68 * 8;
    const bool rebal = PAIR && F.G == 256 && l == 0;
    int j = 0;
    int i0 = lru0_item(F.bid, F.G, rebal, 0);
    if (i0 >= NIT) return;
    LruConst c; LruIn A, B, nA, nB;
    int cb = i0 & 7; lru_load_const(F, a, l, cb, c);
    int i1 = PAIR ? lru0_item(F.bid, F.G, rebal, 1) : NIT;
    lru_load_in(F, (i0 >> 3) / 68, (i0 >> 3) % 68, cb, A);
    if (PAIR && i1 < NIT) lru_load_in(F, (i1 >> 3) / 68, (i1 >> 3) % 68, cb, B);
    int ps = 0;
    for (;;) {
        const bool hb = PAIR && i1 < NIT;
        LAS unsigned char* bufA = (LAS unsigned char*)F.lds + ps * 2 * LRU_BUF; LAS unsigned char* bufB = bufA + LRU_BUF;
        lru_s1(F, c, A.x, bufA); if (hb) lru_s1(F, c, B.x, bufB);
        j += hb ? 2 : 1;
        const int n0 = lru0_item(F.bid, F.G, rebal, j), n1 = (PAIR && n0 < NIT) ? lru0_item(F.bid, F.G, rebal, j + 1) : NIT;
        if (n0 < NIT) lru_load_in(F, (n0 >> 3) / 68, (n0 >> 3) % 68, n0 & 7, nA);
        if (PAIR && n1 < NIT) lru_load_in(F, (n1 >> 3) / 68, (n1 >> 3) % 68, n1 & 7, nB);
        __syncthreads();
        lru_s2(F, c, bufA, i0);
        if (hb) lru_s2(F, c, bufB, i1);
        if (n0 >= NIT) break;
        if (!PAIR && (n0 & 7) != cb) { cb = n0 & 7; lru_load_const(F, a, l, cb, c); }
        i0 = n0; i1 = n1; A = nA; if (PAIR) B = nB; ps ^= 1;
    }
}
__device__ __forceinline__ void lru_fin(const Frame& F, bool skip_ctx) {
    constexpr int NIT = 4 * 68 * 8;
    int i0 = F.bid;
    while (i0 < NIT && skip_ctx && ((i0 >> 3) % 68) < 4) i0 += F.G;
    if (i0 >= NIT) return;
    LruFin A, B, nA, nB;
    int i1 = lru_next(i0, F.G, skip_ctx);
    lru_load_fin(F, i0, A); if (i1 < NIT) lru_load_fin(F, i1, B);
    int ps = 0;
    for (;;) {
        const bool hb = i1 < NIT;
        LAS float* hxA = (LAS float*)(F.lds + ps * 65536); LAS float* hxB = hxA + 8192;
        const int n0 = lru_next(hb ? i1 : i0, F.G, skip_ctx), n1 = n0 < NIT ? lru_next(n0, F.G, skip_ctx) : NIT;
        if (n0 < NIT) lru_load_fin(F, n0, nA);
        if (n1 < NIT) lru_load_fin(F, n1, nB);
        lru_f2(F, A, hxA); if (hb) lru_f2(F, B, hxB);
        __syncthreads();
        lru_s3(F, hxA, A.y, i0); if (hb) lru_s3(F, hxB, B.y, i1);
        if (n0 >= NIT) break;
        i0 = n0; i1 = n1; A = nA; B = nB; ps ^= 1;
    }
}
constexpr int LRU_HL = 131072;
__device__ __forceinline__ void lru_fin_local(const Frame& F, bool skip_ctx) {
    const int b = F.bid >> 6, s = (F.bid >> 3) & 7, cb = F.bid & 7;
    LAS float* hl = (LAS float*)(F.lds + LRU_HL);
    constexpr int NONE = 1 << 20;
    const int j0 = (skip_ctx && s < 4) ? 1 : 0;
    auto item = [&](int j) -> int { const int ck = s + 8 * j; return ck < 68 ? ((b * 68 + ck) * 8 + cb) : NONE; };
    int j = j0; int i0 = item(j), i1 = item(j + 1);
    LruFin A, B, nA, nB;
    lru_load_fin(F, i0, A); if (i1 < NONE) lru_load_fin(F, i1, B);
    { const int seg = F.tid & 3, ch = (F.tid >> 2) & 63, d = F.tid >> 8;
      const float* sum = (const float*)(F.ws + WS_SUM) + (size_t)((b * 2 + d) * 68) * 1024 + (cb * 64 + ch) * 2;
      float A[17], Hh[17];
#pragma unroll
      for (int i = 0; i < 17; ++i) { const int o = seg * 17 + i; const int ck = d == 0 ? o : (o < 4 ? 3 - o : 71 - o); const float2 v = *(const float2*)(sum + (size_t)ck * 1024); A[i] = v.x; Hh[i] = v.y; }
      float sa = 1.f, sh = 0.f;
#pragma unroll
      for (int i = 0; i < 17; ++i) { sh = A[i] * sh + Hh[i]; sa *= A[i]; }
      float pa = sa, ph = sh;
      { const float ua = __shfl_up(pa, 1), uh = __shfl_up(ph, 1); if (seg >= 1) { ph = pa * uh + ph; pa *= ua; } }
      { const float ua = __shfl_up(pa, 2), uh = __shfl_up(ph, 2); if (seg >= 2) { ph = pa * uh + ph; pa *= ua; } }
      float h = __shfl_up(ph, 1); if (seg == 0) h = 0.f;
#pragma unroll
      for (int i = 0; i < 17; ++i) { const int o = seg * 17 + i; const int ck = d == 0 ? o : (o < 4 ? 3 - o : 71 - o); if ((ck & 7) == s) hl[((ck >> 3) * 2 + d) * 64 + ch] = h; h = A[i] * h + Hh[i]; }
    }
    __syncthreads();
    { const int d = F.wave >> 2, ch = (F.wave & 3) * 16 + (F.lane & 15);
      A.hin = hl[((((i0 >> 3) % 68) >> 3) * 2 + d) * 64 + ch]; if (i1 < NONE) B.hin = hl[((((i1 >> 3) % 68) >> 3) * 2 + d) * 64 + ch]; }
    int ps = 0;
    for (;;) {
        const bool hb = i1 < NONE;
        LAS float* hxA = (LAS float*)(F.lds + ps * 65536); LAS float* hxB = hxA + 8192;
        j += 2;
        const int n0 = hb ? item(j) : NONE, n1 = n0 < NONE ? item(j + 1) : NONE;
        if (n0 < NONE) lru_load_fin(F, n0, nA, hl);
        if (n1 < NONE) lru_load_fin(F, n1, nB, hl);
        lru_f2(F, A, hxA); if (hb) lru_f2(F, B, hxB);
        __syncthreads();
        lru_s3(F, hxA, A.y, i0); if (hb) lru_s3(F, hxB, B.y, i1);
        if (n0 >= NONE) break;
        i0 = n0; i1 = n1; A = nA; B = nB; ps ^= 1;
    }
}
__device__ __forceinline__ void lru_phase(const Frame& F, CArgsP a, int l, int mode, bool skip_ctx, bool local_carry = false) {
    if (mode == 0) { if ((F.G % 8) == 0) lru_loop<true>(F, a, l); else lru_loop<false>(F, a, l); __syncthreads(); }
    else if (local_carry) lru_fin_local(F, skip_ctx); else lru_fin(F, skip_ctx);
}

__device__ __forceinline__ void phase_carry(const Frame& F) {
    const int gt = F.bid * NTHR + F.tid; if (gt >= 4 * 2 * 512) return;
    const int c = gt & 511, d = (gt >> 9) & 1, b = gt >> 10;
    const float* sum = (const float*)(F.ws + WS_SUM) + (size_t)((b * 2 + d) * 68) * 1024 + c * 2;
    float* hin = (float*)(F.ws + WS_HIN) + (size_t)((b * 2 + d) * 68) * 512 + c;
    float h = 0.f;
#pragma unroll 1
    for (int g0 = 0; g0 < 68; g0 += 17) {
        float A[17], Hh[17];
#pragma unroll
        for (int i = 0; i < 17; ++i) { const int o = g0 + i; const int ck = d == 0 ? o : (o < 4 ? 3 - o : 71 - o); const float2 v = *(const float2*)(sum + (size_t)ck * 1024); A[i] = v.x; Hh[i] = v.y; }
#pragma unroll
        for (int i = 0; i < 17; ++i) { const int o = g0 + i; const int ck = d == 0 ? o : (o < 4 ? 3 - o : 71 - o); hin[(size_t)ck * 512] = h; h = A[i] * h + Hh[i]; }
    }
}

constexpr int AT_KST = 272, AT_VST = 320;
constexpr int AT_KOFF = 0, AT_VOFF = 2 * 64 * AT_KST, AT_XOFF = AT_VOFF + 2 * 64 * AT_VST;
#define AT_SBAR() __builtin_amdgcn_sched_barrier(0)
struct AttnState { f32x16 o[4]; f32x16 negm; bf16x8 pfp[4]; float lrun; };
#define AT_PIN1(x) asm volatile("" : "+v"(x))
__device__ __forceinline__ float at_max3(float a, float b, float c) { float r; asm("v_max3_f32 %0, %1, %2, %3" : "=v"(r) : "v"(a), "v"(b), "v"(c)); return r; }
__device__ __forceinline__ bf16x8 at_vfrag(const LAS unsigned char* vp) {
    const s16x4 lo = __builtin_bit_cast(s16x4, __builtin_amdgcn_ds_read_tr16_b64_v4i16((LAS s16x4*)(vp)));
    const s16x4 hh = __builtin_bit_cast(s16x4, __builtin_amdgcn_ds_read_tr16_b64_v4i16((LAS s16x4*)(vp + 8 * AT_VST)));
    return (bf16x8){lo[0], lo[1], lo[2], lo[3], hh[0], hh[1], hh[2], hh[3]};
}
__device__ __forceinline__ float attn_stage1(const AttnState& st, const f32x16& p0, const f32x16& p1, f32x16& n0, f32x16& n1, const LAS unsigned char* ql, const LAS unsigned char* kf) {
    bf16x8 a0 = *(const LAS bf16x8*)(kf), a1 = *(const LAS bf16x8*)(kf + 32 * AT_KST), q = *(const LAS bf16x8*)(ql);
    AT_SBAR();
    float mx = at_max3(p0[0], p0[1], at_max3(p1[0], p1[1], p1[1]));
    mx = at_max3(at_max3(mx, p0[2], p0[3]), p1[2], p1[3]); mx = at_max3(at_max3(mx, p0[4], p0[5]), p1[4], p1[5]); AT_PIN1(mx);
    AT_SBAR();
#pragma unroll
    for (int ks = 0; ks < 4; ++ks) {
        bf16x8 b0 = a0, b1 = a1, qn = q;
        if (ks < 3) { b0 = *(const LAS bf16x8*)(kf + (ks + 1) * 32); b1 = *(const LAS bf16x8*)(kf + 32 * AT_KST + (ks + 1) * 32); qn = *(const LAS bf16x8*)(ql + (ks + 1) * 1024); }
        if (ks == 0) n0 = __builtin_amdgcn_mfma_f32_32x32x16_bf16(a0, q, st.negm, 0, 0, 0);
        else n0 = __builtin_amdgcn_mfma_f32_32x32x16_bf16(a0, q, n0, 0, 0, 0);
        if (ks < 3) { mx = at_max3(at_max3(mx, p0[4 * ks + 6], p0[4 * ks + 7]), p1[4 * ks + 6], p1[4 * ks + 7]); AT_PIN1(mx); } AT_SBAR();
        if (ks == 0) n1 = __builtin_amdgcn_mfma_f32_32x32x16_bf16(a1, q, st.negm, 0, 0, 0);
        else n1 = __builtin_amdgcn_mfma_f32_32x32x16_bf16(a1, q, n1, 0, 0, 0);
        if (ks < 2) { mx = at_max3(at_max3(mx, p0[4 * ks + 8], p0[4 * ks + 9]), p1[4 * ks + 8], p1[4 * ks + 9]); AT_PIN1(mx); } AT_SBAR();
        a0 = b0; a1 = b1; q = qn;
    }
    return mx;
}
template <bool FIRST>
__device__ __forceinline__ void attn_stage2(AttnState& st, f32x16& p0, f32x16& p1, f32x16& n0, f32x16& n1, float mx, const LAS unsigned char* vf) {
    constexpr float THR = 8.0f;
    bf16x8 vcur, vnx; if (!FIRST) { vcur = at_vfrag(vf); vnx = at_vfrag(vf + 64); }
    float tm; { auto rr = __builtin_amdgcn_permlane32_swap(__float_as_uint(mx), __float_as_uint(mx), false, false); tm = fmaxf(__uint_as_float(rr[0]), __uint_as_float(rr[1])); }
    if (FIRST || __any(tm > THR)) {
        const float dl = FIRST ? tm : fmaxf(tm, 0.f);
#pragma unroll
        for (int r = 0; r < 16; ++r) { p0[r] -= dl; p1[r] -= dl; n0[r] -= dl; n1[r] -= dl; st.negm[r] -= dl; }
        if (!FIRST) {
            const float al = __builtin_amdgcn_exp2f(-dl);
#pragma unroll
            for (int db = 0; db < 4; ++db)
#pragma unroll
                for (int r = 0; r < 16; ++r) st.o[db][r] *= al;
#pragma unroll
            for (int kk = 0; kk < 4; ++kk) { u32x4 w = __builtin_bit_cast(u32x4, st.pfp[kk]);
                w.x = pk2(bflo(w.x) * al, bfhi(w.x) * al); w.y = pk2(bflo(w.y) * al, bfhi(w.y) * al); w.z = pk2(bflo(w.z) * al, bfhi(w.z) * al); w.w = pk2(bflo(w.w) * al, bfhi(w.w) * al);
                st.pfp[kk] = __builtin_bit_cast(bf16x8, w); }
            st.lrun *= al;
        }
    }
    float ls = 0.f;
    AT_SBAR();
#pragma unroll
    for (int kk = 0; kk < 4; ++kk) {
        unsigned pw0 = 0, pw1 = 0, pw2 = 0, pw3 = 0;
#pragma unroll
        for (int db = 0; db < 4; ++db) {
            const int g = kk * 4 + db;
            if (!FIRST) {
                bf16x8 vn2 = vnx;
                if (g < 14) { const int g2 = g + 2; vn2 = at_vfrag(vf + ((g2 >> 2) * 16) * AT_VST + (g2 & 3) * 64); }
                st.o[db] = __builtin_amdgcn_mfma_f32_32x32x16_bf16(vcur, st.pfp[kk], st.o[db], 0, 0, 0);
                vcur = vnx; vnx = vn2;
            }
            const float x0 = g < 8 ? p0[2 * g] : p1[2 * g - 16], x1 = g < 8 ? p0[2 * g + 1] : p1[2 * g - 15];
            const float e0 = __builtin_amdgcn_exp2f(x0), e1 = __builtin_amdgcn_exp2f(x1);
            ls += e0 + e1; unsigned w = pk2(e0, e1); AT_PIN1(ls); AT_PIN1(w);
            if (db == 0) pw0 = w; else if (db == 1) pw1 = w; else if (db == 2) pw2 = w; else pw3 = w;
            AT_SBAR();
        }
        st.pfp[kk] = __builtin_bit_cast(bf16x8, (u32x4){pw0, pw1, pw2, pw3});
    }
    st.lrun += ls;
}
__device__ __forceinline__ void attn_unit(const Frame& F, int tokq0, int tokk0, int ntiles, int h, float lam, const float* gain, float oscale) {
    const bf16_t* Q = (const bf16_t*)(F.ws + OV_Q); const char* Kg = (const char*)(F.ws + OV_K); const char* Vg = (const char*)(F.ws + OV_V); bf16_t* OA = (bf16_t*)(F.ws + OV_OA);
    const int lane = F.lane, r32 = lane & 31, hi = lane >> 5, rb = F.wave >> 1, c = F.wave & 1;
    LAS unsigned char* ql = F.lds + AT_XOFF + F.wave * 4096 + lane * 16;
    bf16x8 qv[4];
    { const bf16_t* qp = Q + (size_t)(tokq0 + rb * 32 + r32) * 512 + h * 128 + c * 64 + hi * 8;
#pragma unroll
      for (int ks = 0; ks < 4; ++ks) qv[ks] = *(const bf16x8*)(qp + ks * 16); }
    const int srow0 = F.tid >> 4, sch = F.tid & 15;
    const unsigned goff = (unsigned)(((tokk0 + srow0) * 512 + h * 128 + sch * 8) * 2);
    LAS unsigned char* kl = F.lds + AT_KOFF + srow0 * AT_KST + sch * 16;
    LAS unsigned char* vl = F.lds + AT_VOFF + srow0 * AT_VST + sch * 16;
    const LAS unsigned char* kfb = F.lds + AT_KOFF + r32 * AT_KST + (c * 64 + hi * 8) * 2;
    const LAS unsigned char* vfb = F.lds + AT_VOFF + (4 * hi + ((lane & 15) >> 2)) * AT_VST + (((lane >> 4) & 1) * 16 + (lane & 3) * 4) * 2;
    u32x4 sv0 = *(const u32x4*)(Vg + goff), sv1 = *(const u32x4*)(Vg + goff + 32 * 1024);
    {
      const u32x4 k0 = *(const u32x4*)(Kg + goff), k1 = *(const u32x4*)(Kg + goff + 32 * 1024), k2 = *(const u32x4*)(Kg + goff + 64 * 1024), k3 = *(const u32x4*)(Kg + goff + 96 * 1024);
#pragma unroll
      for (int ks = 0; ks < 4; ++ks) *(LAS bf16x8*)(ql + ks * 1024) = qv[ks];
      *(LAS u32x4*)(kl) = k0; *(LAS u32x4*)(kl + 32 * AT_KST) = k1; *(LAS u32x4*)(kl + 64 * AT_KST) = k2; *(LAS u32x4*)(kl + 96 * AT_KST) = k3; }
    __syncthreads();
    AttnState st; st.lrun = 0.f;
#pragma unroll
    for (int r = 0; r < 16; ++r) st.negm[r] = 0.f;
#pragma unroll
    for (int db = 0; db < 4; ++db)
#pragma unroll
        for (int r = 0; r < 16; ++r) st.o[db][r] = 0.f;
    f32x16 pa0, pa1, pb0, pb1;
#pragma unroll
    for (int r = 0; r < 16; ++r) { pa0[r] = 0.f; pa1[r] = 0.f; }
#pragma unroll
    for (int ks = 0; ks < 4; ++ks) {
        const bf16x8 a0 = *(const LAS bf16x8*)(kfb + ks * 32), a1 = *(const LAS bf16x8*)(kfb + 32 * AT_KST + ks * 32);
        const bf16x8 q = *(const LAS bf16x8*)(ql + ks * 1024);
        pa0 = __builtin_amdgcn_mfma_f32_32x32x16_bf16(a0, q, pa0, 0, 0, 0); pa1 = __builtin_amdgcn_mfma_f32_32x32x16_bf16(a1, q, pa1, 0, 0, 0);
    }
    asm volatile("s_nop 15\n\ts_nop 7" : "+v"(pa0), "+v"(pa1));
#define AT_ITER(I, FIRSTF, PC0, PC1, PN0, PN1) do { \
        const int i_ = (I); const bool ldk_ = i_ + 2 < ntiles; const int sl_ = i_ & 1; \
        const float mx_ = attn_stage1(st, PC0, PC1, PN0, PN1, ql, kfb + ((i_ + 1) & 1) * (64 * AT_KST)); \
        *(LAS u32x4*)(vl + sl_ * (64 * AT_VST)) = sv0; *(LAS u32x4*)(vl + sl_ * (64 * AT_VST) + 32 * AT_VST) = sv1; \
        u32x4 sk0_, sk1_; if (ldk_) { const unsigned go_ = goff + (unsigned)(i_ + 2) * 65536u; sk0_ = *(const u32x4*)(Kg + go_); sk1_ = *(const u32x4*)(Kg + go_ + 32 * 1024); } \
        attn_stage2<FIRSTF>(st, PC0, PC1, PN0, PN1, mx_, vfb + ((i_ + 1) & 1) * (64 * AT_VST)); \
        if (ldk_) { *(LAS u32x4*)(kl + sl_ * (64 * AT_KST)) = sk0_; *(LAS u32x4*)(kl + sl_ * (64 * AT_KST) + 32 * AT_KST) = sk1_; } \
        if (i_ + 1 < ntiles) { const unsigned gv_ = goff + (unsigned)(i_ + 1) * 65536u; sv0 = *(const u32x4*)(Vg + gv_); sv1 = *(const u32x4*)(Vg + gv_ + 32 * 1024); } \
        __syncthreads(); } while (0)
    AT_ITER(0, true, pa0, pa1, pb0, pb1);
    AT_ITER(1, false, pb0, pb1, pa0, pa1);
#pragma unroll 1
    for (int i = 2; i < ntiles; i += 2) {
        AT_ITER(i, false, pa0, pa1, pb0, pb1);
        AT_ITER(i + 1, false, pb0, pb1, pa0, pa1);
    }
#undef AT_ITER
    {
      const LAS unsigned char* vf = vfb + ((ntiles - 1) & 1) * (64 * AT_VST);
#pragma unroll
      for (int db = 0; db < 4; ++db)
#pragma unroll
          for (int kk = 0; kk < 4; ++kk) {
              const LAS unsigned char* vp = vf + (kk * 16) * AT_VST + db * 64;
              const s16x4 lo = __builtin_bit_cast(s16x4, __builtin_amdgcn_ds_read_tr16_b64_v4i16((LAS s16x4*)(vp)));
              const s16x4 hh = __builtin_bit_cast(s16x4, __builtin_amdgcn_ds_read_tr16_b64_v4i16((LAS s16x4*)(vp + 8 * AT_VST)));
              const bf16x8 vfr = {lo[0], lo[1], lo[2], lo[3], hh[0], hh[1], hh[2], hh[3]};
              st.o[db] = __builtin_amdgcn_mfma_f32_32x32x16_bf16(vfr, st.pfp[kk], st.o[db], 0, 0, 0);
          } }
    float lrun = st.lrun; lrun += __shfl_xor(lrun, 32);
    const float il = 1.f / lrun;
    LAS float* ex = (LAS float*)(F.lds + AT_XOFF) + rb * 4096;
    if (c == 1) {
#pragma unroll
        for (int db = 0; db < 4; ++db)
#pragma unroll
            for (int r = 0; r < 16; ++r) ex[(db * 16 + r) * 64 + lane] = st.o[db][r] * il;
    }
    __syncthreads();
    if (c == 0) {
        float ss = 0.f;
#pragma unroll
        for (int db = 0; db < 4; ++db)
#pragma unroll
            for (int r = 0; r < 16; ++r) { const float dv = st.o[db][r] * il - lam * ex[(db * 16 + r) * 64 + lane]; st.o[db][r] = dv; ss += dv * dv; }
        ss += __shfl_xor(ss, 32);
        const float rinv = oscale / sqrtf(ss * (1.f / 128.f) + RMS_EPS);
        bf16_t* op = OA + (size_t)(tokq0 + rb * 32 + r32) * 512 + h * 128;
#pragma unroll
        for (int db = 0; db < 4; ++db)
#pragma unroll
            for (int rp = 0; rp < 2; ++rp) { u32x2 w[2];
#pragma unroll
                for (int q = 0; q < 2; ++q) { const int r4 = 2 * rp + q, dv0 = db * 32 + 8 * r4 + 4 * hi; const f32x4 gv = *(const f32x4*)(gain + dv0);
                    w[q].x = pk2(st.o[db][4 * r4] * rinv * gv[0], st.o[db][4 * r4 + 1] * rinv * gv[1]); w[q].y = pk2(st.o[db][4 * r4 + 2] * rinv * gv[2], st.o[db][4 * r4 + 3] * rinv * gv[3]); }
                const auto sx = __builtin_amdgcn_permlane32_swap(w[0].x, w[1].x, false, false), sy = __builtin_amdgcn_permlane32_swap(w[0].y, w[1].y, false, false);
                const u32x4 s4 = {sx[0], sy[0], sx[1], sy[1]};
                *(u32x4*)(op + db * 32 + 8 * (2 * rp + hi)) = s4; }
    }
    __syncthreads();
}

__device__ __forceinline__ void phase_attn(const Frame& F, CArgsP a, int l, bool local_carry) {
    const float lam = ((const float*)(F.ws + WS_LAM))[l]; const float li = 0.8f - 0.6f * expf(-0.3f * (float)l);
    for (int dd = 0; dd < NDUP(6); ++dd) lru_phase(F, a, l, 1, l == 1, local_carry);
    SUBTS(6 + 16 * l);
    __syncthreads();
    const int nlat = 4 * 4 * 32;
    for (int dd = 0; dd < NDUP(7); ++dd)
    for (int it = F.vcu; it < nlat; it += F.G) {
        const int qb = it & 31, h = (it >> 5) & 3, b = it >> 7;
        attn_unit(F, b * TPB + CTX + qb * 128, b * TPB, 68, h, lam, a->in[12] + (l * 4 + h) * 128, 1.0f - li);
    }
    SUBTS(7 + 16 * l);
}
__device__ __forceinline__ void attn_ctx_units(const Frame& F, CArgsP a, int l) {
    const float lam = ((const float*)(F.ws + WS_LAM))[l]; const float li = 0.8f - 0.6f * expf(-0.3f * (float)l);
    for (int i2 = F.G >= 32 ? F.bid - (F.G - 32) : F.bid; i2 < 32; i2 += F.G) { if (i2 < 0) continue;
        const int qb = i2 & 1, h = (i2 >> 1) & 3, b = i2 >> 3;
        attn_unit(F, b * TPB + qb * 128, b * TPB, 4, h, lam, a->in[12] + (l * 4 + h) * 128, 1.0f - li);
    }
}

__device__ __forceinline__ void mini_tile(const bf16_t* A, int lda, const bf16_t* Bt, int K, int lane, int wave, f32x4 (&acc)[2]) {
    const int fr = lane & 15, fq = lane >> 4;
    const bf16_t* ap = A + (size_t)((wave >> 1) * 16 + fr) * lda + fq * 8;
    const bf16_t* bp0 = Bt + (size_t)((wave & 1) * 32 + fr) * K + fq * 8; const bf16_t* bp1 = bp0 + (size_t)16 * K;
    acc[0] = (f32x4){0.f, 0.f, 0.f, 0.f}; acc[1] = (f32x4){0.f, 0.f, 0.f, 0.f};
#pragma unroll 8
    for (int k = 0; k < K; k += 32) {
        const bf16x8 av = *(const bf16x8*)(ap + k), b0 = *(const bf16x8*)(bp0 + k), b1 = *(const bf16x8*)(bp1 + k);
        acc[0] = __builtin_amdgcn_mfma_f32_16x16x32_bf16(b0, av, acc[0], 0, 0, 0); acc[1] = __builtin_amdgcn_mfma_f32_16x16x32_bf16(b1, av, acc[1], 0, 0, 0);
    }
}
template <int K> struct MiniFrag { bf16x8 af[K / 256][4], bfv[K / 256][4]; };
template <int K>
__device__ __forceinline__ void mini_sk_load(const bf16_t* A, int lda, const bf16_t* Bt, int lane, int wave, MiniFrag<K>& f) {
    constexpr int KS = K / 8, NS = KS / 32;
    const int fr = lane & 15, fq = lane >> 4;
#pragma unroll
    for (int ks = 0; ks < NS; ++ks) { const int k0 = wave * KS + ks * 32 + fq * 8;
#pragma unroll
        for (int i = 0; i < 4; ++i) { f.af[ks][i] = *(const bf16x8*)(A + (size_t)(16 * i + fr) * lda + k0); f.bfv[ks][i] = *(const bf16x8*)(Bt + (size_t)(16 * i + fr) * K + k0); } }
}
template <int K>
__device__ __forceinline__ void mini_sk_reduce(const MiniFrag<K>& f, LAS float* red, int tid, int lane, int wave, f32x4 (&out)[2]) {
    constexpr int NS = K / 256;
    f32x4 acc[4][4];
#pragma unroll
    for (int i = 0; i < 4; ++i)
#pragma unroll
        for (int j = 0; j < 4; ++j) acc[i][j] = (f32x4){0.f, 0.f, 0.f, 0.f};
#pragma unroll
    for (int ks = 0; ks < NS; ++ks)
#pragma unroll
        for (int i = 0; i < 4; ++i)
#pragma unroll
            for (int j = 0; j < 4; ++j) acc[i][j] = __builtin_amdgcn_mfma_f32_16x16x32_bf16(f.bfv[ks][j], f.af[ks][i], acc[i][j], 0, 0, 0);
#pragma unroll
    for (int i = 0; i < 4; ++i)
#pragma unroll
        for (int j = 0; j < 4; ++j) *(LAS f32x4*)(red + ((wave * 16 + i * 4 + j) * 64 + lane) * 4) = acc[i][j];
    __syncthreads();
    const int s = tid >> 5;
#pragma unroll
    for (int h = 0; h < 2; ++h) { const int ls = (tid & 31) * 2 + h; f32x4 v = {0.f, 0.f, 0.f, 0.f};
#pragma unroll
        for (int w = 0; w < 8; ++w) v += *(const LAS f32x4*)(red + ((w * 16 + s) * 64 + ls) * 4);
        out[h] = v; }
    __syncthreads();
}
template <int K>
__device__ __forceinline__ void mini_tile_sk(const bf16_t* A, int lda, const bf16_t* Bt, LAS float* red, int tid, int lane, int wave, f32x4 (&out)[2]) {
    MiniFrag<K> f; mini_sk_load<K>(A, lda, Bt, lane, wave, f); mini_sk_reduce<K>(f, red, tid, lane, wave, out);
}
__device__ __forceinline__ void mini_merge_ctx(const Frame& F, int l) {
    LAS float* red = (LAS float*)F.lds;
    __syncthreads();
    for (int t = F.bid; t < 256; t += F.G) {
        const int rb = t >> 4, cbk = t & 15, cr = rb * 64, tok0 = (cr >> 8) * TPB + (cr & 255), col0 = cbk * 64, s = F.tid >> 5;
        const bf16_t* Ab = (const bf16_t*)(F.ws + OV_OA) + (size_t)tok0 * 512; const bf16_t* Bb = (const bf16_t*)(F.ws + WS_WBR) + (size_t)(l * 3) * 1024 * 512 + (size_t)col0 * 512;
        f32x4 mg[2] = {{0.f, 0.f, 0.f, 0.f}, {0.f, 0.f, 0.f, 0.f}};
        unsigned gv[3][2];
#pragma unroll
        for (int r = 0; r < 3; ++r)
#pragma unroll
            for (int h = 0; h < 2; ++h) { const int ls = (F.tid & 31) * 2 + h, row = tok0 + 16 * (s >> 2) + (ls & 15), colw = col0 + 16 * (s & 3) + 4 * (ls >> 4);
                gv[r][h] = *(const unsigned*)((const unsigned char*)(F.ws + OV_G) + (size_t)row * 3072 + r * 1024 + colw); }
        MiniFrag<512> f0, f1;
        mini_sk_load<512>(Ab, 512, Bb, F.lane, F.wave, f0);
        mini_sk_load<512>(Ab + (size_t)17 * MiB / 2, 512, Bb + (size_t)1024 * 512, F.lane, F.wave, f1);
        f32x4 o[2];
        mini_sk_reduce<512>(f0, red, F.tid, F.lane, F.wave, o);
#pragma unroll
        for (int h = 0; h < 2; ++h) { mg[h][0] += gq(gv[0][h], 0) * o[h][0]; mg[h][1] += gq(gv[0][h], 1) * o[h][1]; mg[h][2] += gq(gv[0][h], 2) * o[h][2]; mg[h][3] += gq(gv[0][h], 3) * o[h][3]; }
        mini_sk_load<512>(Ab + (size_t)17 * MiB, 512, Bb + (size_t)2 * 1024 * 512, F.lane, F.wave, f0);
        mini_sk_reduce<512>(f1, red, F.tid, F.lane, F.wave, o);
#pragma unroll
        for (int h = 0; h < 2; ++h) { mg[h][0] += gq(gv[1][h], 0) * o[h][0]; mg[h][1] += gq(gv[1][h], 1) * o[h][1]; mg[h][2] += gq(gv[1][h], 2) * o[h][2]; mg[h][3] += gq(gv[1][h], 3) * o[h][3]; }
        mini_sk_reduce<512>(f0, red, F.tid, F.lane, F.wave, o);
#pragma unroll
        for (int h = 0; h < 2; ++h) { mg[h][0] += gq(gv[2][h], 0) * o[h][0]; mg[h][1] += gq(gv[2][h], 1) * o[h][1]; mg[h][2] += gq(gv[2][h], 2) * o[h][2]; mg[h][3] += gq(gv[2][h], 3) * o[h][3]; }
#pragma unroll
        for (int h = 0; h < 2; ++h) { const int ls = (F.tid & 31) * 2 + h, row = tok0 + 16 * (s >> 2) + (ls & 15), colw = col0 + 16 * (s & 3) + 4 * (ls >> 4);
            u32x2 w; w.x = pk2(mg[h][0], mg[h][1]); w.y = pk2(mg[h][2], mg[h][3]); *(u32x2*)((bf16_t*)(F.ws + OV_MG) + (size_t)row * DM + colw) = w; }
    }
}
__device__ __forceinline__ void mini_wout_ctx(const Frame& F, int l) {
    LAS float* red = (LAS float*)F.lds;
    const float* g1 = (const float*)(F.ws + WS_MOD) + (l * 5 + 4) * 6144 + 2048;
    __syncthreads();
    for (int t = F.bid; t < 256; t += F.G) {
        const int rb = t >> 4, cbk = t & 15, cr = rb * 64, tok0 = (cr >> 8) * TPB + (cr & 255), col0 = cbk * 64, s = F.tid >> 5;
        f32x4 o[2];
        mini_tile_sk<1024>((const bf16_t*)(F.ws + OV_MG) + (size_t)tok0 * DM, DM, (const bf16_t*)(F.ws + WS_WOUT) + (size_t)l * 1048576 + (size_t)col0 * 1024, red, F.tid, F.lane, F.wave, o);
#pragma unroll
        for (int h = 0; h < 2; ++h) { const int ls = (F.tid & 31) * 2 + h, crow = cr + 16 * (s >> 2) + (ls & 15), colw = col0 + 16 * (s & 3) + 4 * (ls >> 4);
            u32x2* p = (u32x2*)((bf16_t*)((float*)(F.ws + WS_XC) + (size_t)crow * DM) + colw); const f32x4 gv = *(const f32x4*)(g1 + colw); const u32x2 x = *p;
            u32x2 w; w.x = pk2(bflo(x.x) * DN_ALPHA + gv[0] * o[h][0], bfhi(x.x) * DN_ALPHA + gv[1] * o[h][1]); w.y = pk2(bflo(x.y) * DN_ALPHA + gv[2] * o[h][2], bfhi(x.y) * DN_ALPHA + gv[3] * o[h][3]); *p = w; }
    }
}

constexpr int RT_PRM = 75776;
constexpr int RT_AST = 1032;
struct RtStep { int rbase, rpw, nact; };
__device__ __forceinline__ bool rt_step(int k, int kf, int bid, int G, int nfull, int msz, int nrows, RtStep& s) {
    if (k < kf) { s.rbase = (bid + k * G) * 32; s.rpw = 4; s.nact = 8; return true; }
    if (k == kf && msz > 0) { const int r0 = nfull * 32 + bid * msz; if (r0 >= nrows) return false; s.rbase = r0; s.rpw = 1; const int left = nrows - r0; s.nact = left < msz ? left : msz; return true; }
    return false;
}
__device__ __forceinline__ void phase_router(const Frame& F, CArgsP a, int l, bool dry) {
    const float* mod = (const float*)(F.ws + WS_MOD) + l * 5 * 6144; float* xc = (float*)(F.ws + WS_XC); bf16_t* H = (bf16_t*)(F.ws + WS_H);
    LAS bf16_t* AT = (LAS bf16_t*)F.lds;
    LAS float* LG = (LAS float*)(F.lds + 32 * RT_AST * 2);
    LAS unsigned* LC = (LAS unsigned*)(F.lds + 32 * RT_AST * 2 + 8192);
    const bf16_t* Wt = (const bf16_t*)(F.ws + WS_WRT) + (size_t)l * 65536; const float rb_ = a->in[29][l * 64 + F.lane];
    unsigned* cnt = (unsigned*)(F.ws + WS_CNT) + l * 4096; int* list = (int*)(F.ws + WS_LIST);
    int* toke = (int*)(F.ws + WS_TOKE); int* tokp = (int*)(F.ws + WS_TOKP); float* tokw = (float*)(F.ws + WS_TOKW);
    const int nrows = l == 0 ? T : NBATCH * SEQ, nbatch = nrows / 32;
    const int fr = F.lane & 15, fq = F.lane >> 4, mt = F.wave & 1, nt = F.wave >> 1;
    if (F.tid < 64) LC[F.tid] = 0u;
    SUBTS(9);
    u32x2 rw[4][4];
    int nfull = (nbatch / F.G) * F.G, kf = nbatch / F.G, msz = (nrows - nfull * 32 + F.G - 1) / F.G;
    if (msz > 8) { nfull = nbatch; kf = F.bid < nbatch ? (nbatch - F.bid + F.G - 1) / F.G : 0; msz = 0; }
    RtStep cur, nx; int kstep = 0;
    bool hc = rt_step(0, kf, F.bid, F.G, nfull, msz, nrows, cur);
    if (hc) {
#pragma unroll
        for (int r = 0; r < 4; ++r) if (r < cur.rpw && F.wave < cur.nact) { const int ridx = cur.rbase + F.wave * cur.rpw + r; const int tk = l == 0 ? ridx : (ridx >> 12) * TPB + CTX + (ridx & 4095); const bf16_t* rp_ = (const bf16_t*)resid_row(F.out, xc, tk);
#pragma unroll
            for (int j = 0; j < 4; ++j) rw[r][j] = *(const u32x2*)(rp_ + 4 * F.lane + 256 * j); } }
    LAS float* PRM = (LAS float*)(F.lds + RT_PRM);
    f32x4 pv[6];
#pragma unroll
    for (int q = 0; q < 6; ++q) { const int i = F.tid + q * NTHR, arr = i >> 8, off = (i & 255) * 4;
        const float* src = arr == 0 ? a->in[26] + l * DM : arr == 1 ? a->in[27] + l * DM : arr < 7 ? mod + (arr - 2) * 6144 + 3072 : mod + (arr - 7) * 6144 + 4096;
        pv[q] = *(const f32x4*)(src + off); }
    bf16x8 bfr[32];
    { const bf16_t* bp = Wt + (size_t)(nt * 16 + fr) * 1024 + fq * 8;
#pragma unroll
      for (int ks = 0; ks < 32; ++ks) bfr[ks] = *(const bf16x8*)(bp + ks * 32); }
#pragma unroll
    for (int q = 0; q < 6; ++q) { const int i = F.tid + q * NTHR, arr = i >> 8, off = (i & 255) * 4; *(LAS f32x4*)(PRM + arr * 1024 + off) = pv[q]; }
    __syncthreads();
    while (hc) {
        if (kstep == 0) SUBTS(10);
        int toks[4]; bool rv[4];
#pragma unroll
        for (int r = 0; r < 4; ++r) { const int ridx = cur.rbase + F.wave * cur.rpw + r; rv[r] = r < cur.rpw && F.wave < cur.nact; toks[r] = l == 0 ? ridx : (ridx >> 12) * TPB + CTX + (ridx & 4095); }
#pragma unroll
        for (int r = 0; r < 4; ++r) if (rv[r]) { const int tok = toks[r];
            const int b = tok / TPB; const int bsel = (tok - b * TPB) < CTX ? 4 : b;
            f32x4 v[4];
#pragma unroll
            for (int j = 0; j < 4; ++j) v[j] = (f32x4){bflo(rw[r][j].x), bfhi(rw[r][j].x), bflo(rw[r][j].y), bfhi(rw[r][j].y)};
            row_ln(v); row_affine_lds(v, PRM, false, PRM + 1024, F.lane);
            row_ln(v); row_affine_lds(v, PRM + 7168 + bsel * 1024, true, PRM + 2048 + bsel * 1024, F.lane);
#pragma unroll
            for (int j = 0; j < 4; ++j) { u32x2 w; w.x = pk2(v[j][0], v[j][1]); w.y = pk2(v[j][2], v[j][3]);
                if (!dry) *(u32x2*)(H + (size_t)tok * DM + 4 * F.lane + 256 * j) = w; *(LAS u32x2*)(AT + (F.wave * 4 + r) * RT_AST + 4 * F.lane + 256 * j) = w; }
        }
        const bool hn = rt_step(kstep + 1, kf, F.bid, F.G, nfull, msz, nrows, nx);
        if (hn) {
#pragma unroll
            for (int r = 0; r < 4; ++r) if (r < nx.rpw && F.wave < nx.nact) { const int ridx = nx.rbase + F.wave * nx.rpw + r; const int tk = l == 0 ? ridx : (ridx >> 12) * TPB + CTX + (ridx & 4095); const bf16_t* rp_ = (const bf16_t*)resid_row(F.out, xc, tk);
#pragma unroll
                for (int j = 0; j < 4; ++j) rw[r][j] = *(const u32x2*)(rp_ + 4 * F.lane + 256 * j); } }
        if (kstep == 0) SUBTS(11);
        __syncthreads();
        { f32x4 d = {0.f, 0.f, 0.f, 0.f};
          const LAS bf16_t* ap = AT + (mt * 16 + fr) * RT_AST + fq * 8;
#pragma unroll
          for (int ks = 0; ks < 32; ++ks) { const bf16x8 av = *(const LAS bf16x8*)(ap + ks * 32); d = __builtin_amdgcn_mfma_f32_16x16x32_bf16(av, bfr[ks], d, 0, 0, 0); }
#pragma unroll
          for (int r = 0; r < 4; ++r) LG[(mt * 16 + fq * 4 + r) * 64 + nt * 16 + fr] = d[r]; }
        __syncthreads();
        if (kstep == 0) SUBTS(12);
        bool selr[4]; int rkr[4], lpr[4]; float wr_[4];
#pragma unroll
        for (int r = 0; r < 4; ++r) { selr[r] = false; rkr[r] = 0; lpr[r] = 0; wr_[r] = 0.f;
            if (!rv[r]) continue;
            const float lg = LG[(F.wave * 4 + r) * 64 + F.lane];
            const float s = sigmoidf_(lg); const float bsc = s + rb_;
            float m1 = bsc; m1 = fmaxf(m1, WS_DPP(m1, 0xB1, 0xF, true)); m1 = fmaxf(m1, WS_DPP(m1, 0x4E, 0xF, true)); m1 = fmaxf(m1, WS_DPP(m1, 0x141, 0xF, true));
            const unsigned long long eq = __ballot(bsc == m1); const unsigned gm = (unsigned)(eq >> (F.lane & ~7)) & 0xffu; const int first = __ffs(gm) - 1;
            float m2 = ((F.lane & 7) == first) ? -INFINITY : bsc; m2 = fmaxf(m2, WS_DPP(m2, 0xB1, 0xF, true)); m2 = fmaxf(m2, WS_DPP(m2, 0x4E, 0xF, true)); m2 = fmaxf(m2, WS_DPP(m2, 0x141, 0xF, true));
            const float gs = m1 + m2; const int myg = F.lane >> 3; int grank = 0;
#pragma unroll
            for (int g = 0; g < 8; ++g) { const float og = __builtin_bit_cast(float, __builtin_amdgcn_readlane(__builtin_bit_cast(int, gs), g * 8)); grank += (int)(og > gs) + (int)((og == gs) & (g < myg)); }
            const bool gsel = grank < 4; const float mk = gsel ? bsc : -INFINITY; int rk = 64;
            { float vv_ = mk;
#pragma unroll
              for (int k = 0; k < 8; ++k) {
                  float m = vv_; m = fmaxf(m, WS_DPP(m, 0xB1, 0xF, true)); m = fmaxf(m, WS_DPP(m, 0x4E, 0xF, true)); m = fmaxf(m, WS_DPP(m, 0x141, 0xF, true)); m = fmaxf(m, WS_DPP(m, 0x140, 0xF, true));
                  const float r1 = __builtin_bit_cast(float, __builtin_amdgcn_readlane(__builtin_bit_cast(int, m), 15)), r2 = __builtin_bit_cast(float, __builtin_amdgcn_readlane(__builtin_bit_cast(int, m), 31)),
                              r3 = __builtin_bit_cast(float, __builtin_amdgcn_readlane(__builtin_bit_cast(int, m), 47)), r4 = __builtin_bit_cast(float, __builtin_amdgcn_readlane(__builtin_bit_cast(int, m), 63));
                  const float wm = fmaxf(fmaxf(r1, r2), fmaxf(r3, r4));
                  const unsigned long long bal = __ballot(vv_ == wm); const int win = __ffsll((long long)bal) - 1;
                  if (F.lane == win) { rk = k; vv_ = -INFINITY; }
              } }
            const bool sel = gsel && rk < 8 && !dry;
            const float ssum = wave_sum((gsel && rk < 8) ? s : 0.f);
            selr[r] = sel; rkr[r] = rk; wr_[r] = s / ssum * 2.5f; lpr[r] = 0;
            if (sel) lpr[r] = (int)__hip_atomic_fetch_add((LAS unsigned*)(LC + F.lane), 1u, __ATOMIC_RELAXED, __HIP_MEMORY_SCOPE_WORKGROUP);
        }
        if (kstep == 0) SUBTS(13);
        __syncthreads();
        if (F.tid < 64) { const unsigned n = LC[F.tid]; unsigned base = 0; if (n) base = atomicAdd(cnt + F.tid * 64, n); LC[64 + F.tid] = base; LC[F.tid] = 0u; }
        __syncthreads();
        if (kstep == 0) SUBTS(14);
#pragma unroll
        for (int r = 0; r < 4; ++r)
            if (selr[r]) { const int tok = toks[r]; const int pos = (int)LC[64 + F.lane] + lpr[r];
                list[(size_t)F.lane * T + pos] = tok; toke[tok * 8 + rkr[r]] = F.lane; tokp[tok * 8 + rkr[r]] = pos; tokw[tok * 8 + rkr[r]] = wr_[r]; }
        __syncthreads();
        if (kstep == 0) SUBTS(15);
        cur = nx; hc = hn; ++kstep;
    }
}

__device__ __forceinline__ void build_tables(const Frame& F, int l) {
    LAS int* tb = (LAS int*)(F.lds + LDS_CTL);
    __syncthreads();
    if (F.wave == 0) {
        const int c = (int)__hip_atomic_load((unsigned*)(F.ws + WS_CNT) + l * 4096 + F.lane * 64, __ATOMIC_RELAXED, __HIP_MEMORY_SCOPE_AGENT);
        const int t0 = (c + 255) >> 8; int tl = t0, sl = c;
#pragma unroll
        for (int o = 1; o < 64; o <<= 1) { const int ta = __shfl_up(tl, o), sa = __shfl_up(sl, o); if (F.lane >= o) { tl += ta; sl += sa; } }
        tb[LC_TCNT + F.lane] = c; tb[LC_TBASE + F.lane] = tl - t0; tb[LC_SBASE + F.lane] = sl - c;
        if (F.lane == 63) { tb[LC_TBASE + 64] = tl; tb[LC_SBASE + 64] = sl; }
    }
    __syncthreads();
}

__device__ __forceinline__ void phase_combine(const Frame& F, CArgsP a, int l, bool dry, bool have_pre = false, int pre_e = 0, int pre_p = 0, float pre_w = 0.f) {
    const float* mod = (const float*)(F.ws + WS_MOD) + l * 5 * 6144; float* xc = (float*)(F.ws + WS_XC); bf16_t* H = (bf16_t*)(F.ws + WS_H);
    const unsigned char* YS = (const unsigned char*)(F.ws + OV_YS); const LAS int* tb = (const LAS int*)(F.lds + LDS_CTL);
    const int* toke = (const int*)(F.ws + WS_TOKE); const int* tokp = (const int*)(F.ws + WS_TOKP); const float* tokw = (const float*)(F.ws + WS_TOKW);
    const int nrows = l == 0 ? T : NBATCH * SEQ;
    int nme = pre_e, nmp = pre_p; float nmw = pre_w;
    if (!have_pre && F.gw * 2 < nrows) { const int ridx = F.gw * 2 + ((F.lane >> 3) & 1), tk = l == 0 ? ridx : (ridx >> 12) * TPB + CTX + (ridx & 4095), k = F.lane & 7; nme = toke[tk * 8 + k]; nmp = tokp[tk * 8 + k]; nmw = tokw[tk * 8 + k]; }
    for (int rp = F.gw * 2; rp < nrows; rp += F.NGW * 2) {
        int tok[2], bsel[2]; float* xr[2]; f32x4 y[2][4], v[2][4]; const int me = nme, mp = nmp; const float mw = nmw;
#pragma unroll
        for (int q = 0; q < 2; ++q) { const int ridx = rp + q; tok[q] = l == 0 ? ridx : (ridx >> 12) * TPB + CTX + (ridx & 4095);
            const int b = tok[q] / TPB; bsel[q] = (tok[q] - b * TPB) < CTX ? 4 : b; xr[q] = resid_row(F.out, xc, tok[q]); }
        if (rp + F.NGW * 2 < nrows) { const int ridx = rp + F.NGW * 2 + ((F.lane >> 3) & 1), tk = l == 0 ? ridx : (ridx >> 12) * TPB + CTX + (ridx & 4095), k = F.lane & 7; nme = toke[tk * 8 + k]; nmp = tokp[tk * 8 + k]; nmw = tokw[tk * 8 + k]; }
#pragma unroll
        for (int q = 0; q < 2; ++q) { const bf16_t* sp = H + (size_t)tok[q] * DM;
#pragma unroll
            for (int j = 0; j < 4; ++j) { const u32x2 w = *(const u32x2*)(sp + 4 * F.lane + 256 * j); y[q][j] = (f32x4){bflo(w.x), bfhi(w.x), bflo(w.y), bfhi(w.y)}; }
            row_load_bf16(xr[q], F.lane, v[q]); }
#pragma unroll
        for (int q = 0; q < 2; ++q) { row_ln(v[q]); row_affine(v[q], a->in[26] + l * DM, false, a->in[27] + l * DM, F.lane); }
#pragma unroll
        for (int q = 0; q < 2; ++q)
#pragma unroll
            for (int k = 0; k < 8; ++k) { const int e = __shfl(me, q * 8 + k), p = __shfl(mp, q * 8 + k); const float wv = __shfl(mw, q * 8 + k) * 0.0625f;
                const unsigned char* yp = YS + (size_t)(tb[LC_SBASE + e] + p) * DM;
#pragma unroll
                for (int j = 0; j < 4; ++j) { const int w = (int)*(const unsigned*)(yp + 4 * F.lane + 256 * j);
                    y[q][j][0] += wv * __builtin_amdgcn_cvt_f32_fp8(w, 0); y[q][j][1] += wv * __builtin_amdgcn_cvt_f32_fp8(w, 1); y[q][j][2] += wv * __builtin_amdgcn_cvt_f32_fp8(w, 2); y[q][j][3] += wv * __builtin_amdgcn_cvt_f32_fp8(w, 3); } }
#pragma unroll
        for (int q = 0; q < 2; ++q) {
            const float* g2 = mod + bsel[q] * 6144 + 5120;
#pragma unroll
            for (int j = 0; j < 4; ++j) { const f32x4 gv = *(const f32x4*)(g2 + 4 * F.lane + 256 * j); v[q][j] = v[q][j] * DN_ALPHA + gv * y[q][j]; }
            row_ln(v[q]); row_affine(v[q], a->in[36] + l * DM, false, a->in[37] + l * DM, F.lane);
            if (!dry) { if (l == 0) row_store_bf16((bf16_t*)xr[q], F.lane, v[q]); else row_store(xr[q], F.lane, v[q]); } else asm volatile("" :: "v"(v[q][0]), "v"(v[q][1]), "v"(v[q][2]), "v"(v[q][3]));
            if (l == 0 && !dry) { row_ln(v[q]); const float* mrow = mod + 5 * 6144 + bsel[q] * 6144; row_affine(v[q], mrow + 1024, true, mrow, F.lane); row_store_bf16(H + (size_t)tok[q] * DM, F.lane, v[q]); }
        }
    }
}

constexpr int NPHASE = 22;
__global__ void __launch_bounds__(NTHR, 2) mk_fwd(Args args) {
    extern __shared__ __attribute__((aligned(16))) unsigned char lds_raw[];
    Frame F; F.lds = (LAS unsigned char*)lds_raw; F.tid = threadIdx.x; F.lane = F.tid & 63; F.wave = __builtin_amdgcn_readfirstlane(F.tid >> 6);
    F.G = gridDim.x; F.bid = blockIdx.x; F.gw = F.bid * NWAVES + F.wave; F.NGW = F.G * NWAVES; F.ws = args.ws; F.out = args.out; F.vcu = (F.G % 8 == 0) ? (F.bid % 8) * (F.G / 8) + F.bid / 8 : F.bid;
    for (int u = F.tid; u < (LDS_BYTES - LDS_CTL) / 4; u += NTHR) ((LAS unsigned*)(F.lds + LDS_CTL))[u] = 0u;
    __syncthreads();
    const int lo = args.ph_lo, hi = args.ph_hi;
    CArgsP A4 = (CArgsP)__builtin_amdgcn_kernarg_segment_ptr();
    XcdBarrier bar; bar.bar = (unsigned*)(F.ws + CW_BAR_BYTE); bar.x = 0; bar.st = nullptr;
    if (hi - lo > 1) bar = xcd_barrier_post((unsigned*)(F.ws + CW_BAR_BYTE), (volatile LAS unsigned*)(F.lds + LDS_CTL) + LC_BAR);
#ifndef PHMASK
#define PHMASK 0xfff
#endif
#define PH_EN(k) ((PHMASK >> ((k) < 2 ? (k) : 2 + (((k) - 2) % 10))) & 1)
#define IN(k) (PH_EN(k) && lo <= (k) && (k) < hi)
#define SEAM(k) do { if (IN(k) && IN((k) + 1)) { for (int dd = 0; dd < NDUP(14); ++dd) xcd_barrier(bar); } if (TSMASK != 0 && blockIdx.x == 0 && threadIdx.x == 0) { ((volatile LAS unsigned long long*)(F.lds + LDS_CTL + 2048))[(k) + 1] = __builtin_amdgcn_s_memrealtime(); } FRESH(); } while (0)
#define FRESH() do { int t_ = threadIdx.x, b_ = blockIdx.x; CArgsP p_ = (CArgsP)__builtin_amdgcn_kernarg_segment_ptr(); asm volatile("" : "+v"(t_)); asm volatile("" : "+s"(b_), "+s"(p_)); A4 = p_; unsigned char* w_ = p_->ws; float* o_ = p_->out; \
    F.tid = t_; F.lane = t_ & 63; F.wave = __builtin_amdgcn_readfirstlane(t_ >> 6); F.bid = b_; F.gw = b_ * NWAVES + F.wave; F.ws = w_; F.out = o_; F.vcu = (F.G % 8 == 0) ? (b_ % 8) * (F.G / 8) + b_ / 8 : b_; } while (0)
    if (TSMASK != 0 && blockIdx.x == 0 && threadIdx.x == 0) ((volatile LAS unsigned long long*)(F.lds + LDS_CTL + 2048))[0] = __builtin_amdgcn_s_memrealtime();
    if (IN(0)) { for (int dd = 0; dd < NDUP(0); ++dd) phase_prologue(F, A4); } SEAM(0);
    if (IN(1)) { for (int dd = 0; dd < NDUP(1); ++dd) phase_rows0(F, A4); } SEAM(1);
#pragma unroll 1
    for (int l = 0; l < 2; ++l) {
        const int pb = 2 + 10 * l; const bool lat = (l == 1);
        int jpre_e = 0, jpre_p = 0; float jpre_w = 0.f;
        if (IN(pb + 0)) {
            SchedPlain S{(const char*)(F.ws + WS_H), (const char*)(F.ws + WS_WIN) + (size_t)l * INC * 1024 * 2, 1024, 68, 26, F.G, F.bid, false};
            EpiInproj E{F.ws, A4->in[7] + l * INC, (const float*)(F.ws + WS_ROPE)};
            for (int dd = 0; dd < NDUP(2); ++dd) pg8::gemm_phase(F.lds, 1024, S, E);
        } SEAM(pb + 0);
        if (IN(pb + 1)) {
            for (int dd = 0; dd < NDUP(3); ++dd) lru_phase(F, A4, l, 0, false);
            SUBTS(4);
            for (int dd = 0; dd < NDUP(4); ++dd) sg_phase(F, A4, l, lat);
            SUBTS(5);
            if (!lat) { FRESH(); attn_ctx_units(F, A4, l); }
        } SEAM(pb + 1);
        const bool foldC = F.G == 256 && IN(pb + 1) && IN(pb + 2) && IN(pb + 3);
        if (foldC) { if (TSMASK != 0 && blockIdx.x == 0 && threadIdx.x == 0) { ((volatile LAS unsigned long long*)(F.lds + LDS_CTL + 2048))[pb + 3] = __builtin_amdgcn_s_memrealtime(); } }
        else { if (IN(pb + 2)) { for (int dd = 0; dd < NDUP(5); ++dd) phase_carry(F); } SEAM(pb + 2); }
        if (IN(pb + 3)) { phase_attn(F, A4, l, foldC); } SEAM(pb + 3);
        if (IN(pb + 4)) {
            for (int dd = 0; dd < NDUP(8); ++dd) {
                SchedMergeHN S{(const char*)(F.ws + OV_OA), (const char*)(F.ws + WS_WBR) + (size_t)(l * 3) * 1024 * 512 * 2, F.G, F.bid};
                EpiMergeHN E{(bf16_t*)(F.ws + OV_MG), (const unsigned char*)(F.ws + OV_G)};
                pg8::gemm_phase(F.lds, 512, S, E);
            }
            if (!lat) mini_merge_ctx(F, l);
        } SEAM(pb + 4);
        if (IN(pb + 5)) {
            SchedPlain S{(const char*)(F.ws + OV_MG), (const char*)(F.ws + WS_WOUT) + (size_t)l * 1048576 * 2, 1024, 64, 4, F.G, F.bid, true};
            EpiWout E{F.out, (float*)(F.ws + WS_XC), (const float*)(F.ws + WS_MOD) + l * 5 * 6144, false};
            pg8::gemm_phase(F.lds, 1024, S, E);
            if (NDUP(11) > 1) { EpiWout E2{F.out, (float*)(F.ws + WS_XC), (const float*)(F.ws + WS_MOD) + l * 5 * 6144, true}; pg8::gemm_phase(F.lds, 1024, S, E2); }
            if (!lat) mini_wout_ctx(F, l);
        } SEAM(pb + 5);
        if (IN(pb + 6)) { phase_router(F, A4, l, false); if (NDUP(12) > 1) phase_router(F, A4, l, F.G != 12345); } SEAM(pb + 6);
        if (IN(pb + 7)) {
            build_tables(F, l);
            SchedMoe S{(const char*)(F.ws + WS_H), (const char*)(F.ws + WS_H), (const char*)(F.ws + WS_WM1), (const char*)(F.ws + WS_WSH1) + (size_t)l * 524288 * 2,
                       (const int*)(F.ws + WS_LIST), (const LAS int*)(F.lds + LDS_CTL), 1024, 2, F.G, F.vcu, lat ? 64 : 68, lat, true, (size_t)524288 * 2};
            EpiMoe1 E{(bf16_t*)(F.ws + OV_ACT), (bf16_t*)(F.ws + OV_ACTSH)};
            for (int dd = 0; dd < NDUP(9); ++dd) pg8::gemm_phase(F.lds, 1024, S, E);
        } SEAM(pb + 7);
        if (IN(pb + 8)) {
            if (!IN(pb + 7)) build_tables(F, l);
            SchedMoe S{(const char*)(F.ws + OV_ACT), (const char*)(F.ws + OV_ACTSH), (const char*)(F.ws + WS_WM2), (const char*)(F.ws + WS_WSH2) + (size_t)l * 262144 * 2,
                       (const int*)(F.ws + WS_LIST), (const LAS int*)(F.lds + LDS_CTL), 256, 4, F.G, F.vcu, lat ? 64 : 68, lat, false, (size_t)262144 * 2};
            EpiMoe2 E{(unsigned char*)(F.ws + OV_YS), (bf16_t*)(F.ws + WS_H)};
            for (int dd = 0; dd < NDUP(10); ++dd) pg8::gemm_phase(F.lds, 256, S, E);
            if (IN(pb + 9)) { FRESH();
                const int nrows_ = l == 0 ? T : NBATCH * SEQ;
                if (F.gw * 2 < nrows_) { const int ridx = F.gw * 2 + ((F.lane >> 3) & 1), tk = l == 0 ? ridx : (ridx >> 12) * TPB + CTX + (ridx & 4095), k = F.lane & 7;
                    jpre_e = ((const int*)(F.ws + WS_TOKE))[tk * 8 + k]; jpre_p = ((const int*)(F.ws + WS_TOKP))[tk * 8 + k]; jpre_w = ((const float*)(F.ws + WS_TOKW))[tk * 8 + k]; } }
        } SEAM(pb + 8);
        if (IN(pb + 9)) {
            if (!IN(pb + 7)) build_tables(F, l);
            phase_combine(F, A4, l, false, IN(pb + 8), jpre_e, jpre_p, jpre_w);
            if (NDUP(13) > 1) phase_combine(F, A4, l, F.G != 12345);
            SUBTS(8);
            if (l == 0) for (int dd = 0; dd < NDUP(15); ++dd) conv_moe_layer(F, A4, 1);
        } SEAM(pb + 9);
    }
    if (TSMASK != 0 && hi - lo == NPHASE) { __syncthreads(); asm volatile("s_waitcnt vmcnt(0)" ::: "memory");
        if (blockIdx.x == 0 && threadIdx.x == 0) { volatile LAS unsigned long long* ts = (volatile LAS unsigned long long*)(F.lds + LDS_CTL + 2048);
            if (TS_A >= 0) { const float us = (float)(ts[TS_B] - ts[TS_A]) * 0.01f; args.out[0] += 1.0f + floorf(us / TS_UNIT + 0.5f); }
            else { unsigned long long sel = 0; for (int k = 0; k < NPHASE; ++k) if ((TSMASK >> k) & 1) sel += ts[k + 1] - ts[k];
            const float frac = (float)sel / (float)(ts[NPHASE] - ts[0]); args.out[0] += 1.0f + floorf(90.0f * frac + 0.5f); } } }
#undef IN
#undef SEAM
}

extern "C" void kernel_launch(void* const* d_in, const int* in_sizes, int n_in, void* d_out, int out_size, void* d_ws, size_t ws_size, hipStream_t stream) {
    static int grid = 0;
    if (grid == 0) {
        if (n_in != 38 || out_size != NBATCH * SEQ * DM || ws_size < WS_END) { fprintf(stderr, "kernel_launch: unexpected shapes (n_in %d out %d ws %zu need %zu)\n", n_in, out_size, ws_size, (size_t)WS_END); grid = -1; return; }
        int dev = 0, cus = 0;
        if (hipGetDevice(&dev) != hipSuccess || hipDeviceGetAttribute(&cus, hipDeviceAttributeMultiprocessorCount, dev) != hipSuccess) { grid = -1; return; }
        if (hipFuncSetAttribute((const void*)mk_fwd, hipFuncAttributeMaxDynamicSharedMemorySize, LDS_BYTES) != hipSuccess) { fprintf(stderr, "kernel_launch: hipFuncSetAttribute failed\n"); grid = -1; return; }
        int per_cu = 0;
        if (hipOccupancyMaxActiveBlocksPerMultiprocessor(&per_cu, (const void*)mk_fwd, NTHR, LDS_BYTES) != hipSuccess || per_cu < 1) fprintf(stderr, "kernel_launch: occupancy query says %d\n", per_cu);
        (void)hipGetLastError();
        grid = cus;
    }
    if (grid < 0) return;
    (void)hipMemsetAsync((char*)d_ws + WS_CTL, 0, CTL_ZERO_BYTES, stream);
    Args a{};
    for (int i = 0; i < 38; ++i) a.in[i] = (const float*)d_in[i];
    a.out = (float*)d_out; a.ws = (unsigned char*)d_ws;
#if MK_MULTI
    for (int p = 0; p < NPHASE; ++p) { a.ph_lo = p; a.ph_hi = p + 1; hipLaunchKernelGGL(mk_fwd, dim3(grid), dim3(NTHR), LDS_BYTES, stream, a); }
#else
    a.ph_lo = 0; a.ph_hi = NPHASE; hipLaunchKernelGGL(mk_fwd, dim3(grid), dim3(NTHR), LDS_BYTES, stream, a);
#endif
}
```
